# Optimizing an MI355X kernel written in HIP

```python
import math
import jax
import jax.numpy as jnp
from jax import lax
import numpy as np

D_MODEL = 1024
BATCH = 4
SEQ = 8192
DEPTH = 2
DEC_BATCH = 8
DEC_SEQ = 8192
PAST_LEN = 128

MIX_WIDTH = D_MODEL
A_WIDTH = MIX_WIDTH // 2
A_HEAD_DIM = 64
A_HEADS = A_WIDTH // A_HEAD_DIM
DECAY_LORA = 32
ICLR_LORA = 32
VRES_LORA = 32
GATE_LORA = 96
B_WIDTH = MIX_WIDTH - A_WIDTH
B_HEAD_DIM = 64
B_HEADS = B_WIDTH // (2 * B_HEAD_DIM)
Q_BLOCK = 128
N_BUCKETS = 32
MAX_DISTANCE = 128
D_FF = 2816
LN_EPS = 1e-5
GN_EPS = 64e-5
ALPHA = (2 * DEPTH) ** 0.25
BETA = (8 * DEPTH) ** -0.25

OFF_R = 0
OFF_K = OFF_R + A_WIDTH
OFF_V = OFF_K + A_WIDTH
OFF_WD = OFF_V + A_WIDTH
OFF_AD = OFF_WD + 2 * DECAY_LORA
OFF_GD = OFF_AD + 2 * ICLR_LORA
A_COLS = OFF_GD + GATE_LORA
B_QK = B_HEADS * 2 * B_HEAD_DIM
B_COLS = 3 * B_QK
P_COLS = A_COLS + B_COLS

kernel_name = 'hybrid_rwkv7_diffattn_encoder'


def _layer_norm(x, g, b):
    xf = x.astype(jnp.float32)
    mu = jnp.mean(xf, -1, keepdims=True)
    var = jnp.mean(jnp.square(xf - mu), -1, keepdims=True)
    return ((xf - mu) * lax.rsqrt(var + LN_EPS) * g + b).astype(x.dtype)


def _shift_prev(x):
    return jnp.pad(x[:, :-1], ((0, 0), (1, 0), (0, 0)))


def _shift_next(x):
    return jnp.pad(x[:, 1:], ((0, 0), (0, 1), (0, 0)))


def _heads(t):
    return t.reshape(t.shape[:-1] + (A_HEADS, A_HEAD_DIM))


def _t5_bucket(rel):
    nb = N_BUCKETS // 2
    max_exact = nb // 2
    ret = jnp.where(rel > 0, nb, 0)
    n = jnp.abs(rel)
    nf = jnp.maximum(n, 1).astype(jnp.float32)
    large = max_exact + (jnp.log(nf / max_exact) / math.log(MAX_DISTANCE / max_exact)
                         * (nb - max_exact)).astype(jnp.int32)
    large = jnp.minimum(large, nb - 1)
    return ret + jnp.where(n < max_exact, n, large)


def _rwkv7_scan(r, w, k, v, a_, b, reverse):
    bsz, _, h, n = r.shape

    def step(S, inp):
        r_t, w_t, k_t, v_t, a_t, b_t = inp
        sa = jnp.einsum('bhij,bhj->bhi', S, a_t)
        S = S * w_t[:, :, None, :] + sa[..., None] * b_t[:, :, None, :] + v_t[..., None] * k_t[:, :, None, :]
        return S, jnp.einsum('bhij,bhj->bhi', S, r_t)

    S0 = jnp.zeros((bsz, h, n, n), jnp.float32)
    xs = tuple(jnp.moveaxis(t, 1, 0) for t in (r, w, k, v, a_, b))
    _, ys = lax.scan(step, S0, xs, reverse=reverse)
    return jnp.moveaxis(ys, 0, 1)


def _rwkv7_group(pa, l, v_first, prm):
    bsz, T, _ = pa.shape
    mu = prm['shift_mu'][l].astype(jnp.float32)
    pa = pa + mu[0] * (_shift_prev(pa) - pa) + mu[1] * (_shift_next(pa) - pa)
    r = pa[..., OFF_R:OFF_K]
    k = pa[..., OFF_K:OFF_V]
    v = pa[..., OFF_V:OFF_WD]
    wd = pa[..., OFF_WD:OFF_AD].reshape(bsz, T, 2, DECAY_LORA)
    ad = pa[..., OFF_AD:OFF_GD].reshape(bsz, T, 2, ICLR_LORA)
    gd = pa[..., OFF_GD:A_COLS]
    w_log = -jax.nn.softplus(-(prm['w0'][l] + jnp.einsum('btdr,drc->btdc', jnp.tanh(wd), prm['decay_up'][l]))) - 0.5
    decay = jnp.exp(-jnp.exp(w_log))
    a = jax.nn.sigmoid(prm['a0'][l] + jnp.einsum('btdr,drc->btdc', ad, prm['iclr_up'][l]))
    if v_first is None:
        v_first = v
    else:
        i = l - 1
        gate_v = jax.nn.sigmoid(prm['vres_0'][i] + (v @ prm['vres_down'][i]) @ prm['vres_up'][i])
        v = v + (v_first - v) * gate_v
    kk = _heads(k * prm['k_k'][l])
    kk = kk * lax.rsqrt(jnp.sum(kk * kk, -1, keepdims=True) + 1e-12)
    k_dir = k[:, :, None, :] * (1.0 + (a - 1.0) * prm['k_a'][l])
    rh, vh = _heads(r), _heads(v)
    kf, kb = _heads(k_dir[:, :, 0]), _heads(k_dir[:, :, 1])
    af, ab = _heads(a[:, :, 0]), _heads(a[:, :, 1])
    y = (_rwkv7_scan(rh, _heads(decay[:, :, 0]), kf, vh, -kk, kk * af, False)
         + _rwkv7_scan(rh, _heads(decay[:, :, 1]), kb, vh, -kk, kk * ab, True))
    ym = jnp.mean(y, -1, keepdims=True)
    yv = jnp.mean(jnp.square(y - ym), -1, keepdims=True)
    y = ((y - ym) * lax.rsqrt(yv + GN_EPS) * prm['gn_g'][l].reshape(A_HEADS, A_HEAD_DIM)
         + prm['gn_b'][l].reshape(A_HEADS, A_HEAD_DIM))
    bonus = jnp.sum(rh * (kf + kb) * prm['r_k'][l], -1, keepdims=True) * vh
    g = jax.nn.sigmoid(gd) @ prm['g_up'][l]
    return (y + bonus).reshape(bsz, T, A_WIDTH) * g, v_first


def _diff_group(pb, l, prm):
    bsz, T, _ = pb.shape
    q = pb[..., :B_QK].reshape(bsz, T, B_HEADS, 2, B_HEAD_DIM)
    k = pb[..., B_QK:2 * B_QK].reshape(bsz, T, B_HEADS, 2, B_HEAD_DIM)
    v = pb[..., 2 * B_QK:].reshape(bsz, T, B_HEADS, 2 * B_HEAD_DIM)
    lam_init = 0.8 - 0.6 * math.exp(-0.3 * l)
    lp = prm['lam'][l].astype(jnp.float32)
    lam = jnp.exp(jnp.sum(lp[0] * lp[1])) - jnp.exp(jnp.sum(lp[2] * lp[3])) + lam_init
    rel_bias = prm['rel_bias'].astype(jnp.float32)
    nblk = T // Q_BLOCK
    qb = q.reshape(bsz, nblk, Q_BLOCK, B_HEADS, 2, B_HEAD_DIM).transpose(1, 0, 2, 3, 4, 5)
    kpos = jnp.arange(T)
    scale = B_HEAD_DIM ** -0.5

    def block(args):
        i, q_blk = args
        qpos = i * Q_BLOCK + jnp.arange(Q_BLOCK)
        bias = rel_bias[_t5_bucket(kpos[None, :] - qpos[:, None])].transpose(2, 0, 1)
        s = jnp.einsum('bqhcd,bkhcd->bhcqk', q_blk, k).astype(jnp.float32) * scale + bias[None, :, None]
        p = jax.nn.softmax(s, axis=-1)
        attn = p[:, :, 0] - lam * p[:, :, 1]
        return jnp.einsum('bhqk,bkhe->bqhe', attn.astype(v.dtype), v)

    o = lax.map(block, (jnp.arange(nblk), qb))
    o = o.transpose(1, 0, 2, 3, 4).reshape(bsz, T, B_HEADS, 2 * B_HEAD_DIM).astype(jnp.float32)
    o = o * lax.rsqrt(jnp.mean(o * o, -1, keepdims=True) + LN_EPS) * prm['subln_g'][l] * (1.0 - lam_init)
    return o.reshape(bsz, T, B_WIDTH)


def _conv_ffn(x, l, prm):
    h = x @ prm['ffn_up'][l]
    cw = prm['conv_w'][l]
    h = cw[0] * _shift_prev(h) + cw[1] * h + cw[2] * _shift_next(h) + prm['conv_b'][l]
    gate, up = jnp.split(h, 2, axis=-1)
    return (jax.nn.gelu(gate, approximate=False) * up) @ prm['ffn_down'][l]


def _trunk(x, prm):
    x = _layer_norm(x, prm['ln_in_g'], prm['ln_in_b'])
    v_first = None
    for l in range(DEPTH):
        proj = x @ prm['w_in'][l]
        out_a, v_first = _rwkv7_group(proj[..., :A_COLS].astype(jnp.float32), l, v_first, prm)
        out_b = _diff_group(proj[..., A_COLS:], l, prm)
        mixed = jnp.concatenate([out_a.astype(x.dtype), out_b.astype(x.dtype)], -1) @ prm['w_out'][l]
        x = _layer_norm(ALPHA * x + mixed, prm['ln1_g'][l], prm['ln1_b'][l])
        x = _layer_norm(ALPHA * x + _conv_ffn(x, l, prm), prm['ln2_g'][l], prm['ln2_b'][l])
    return x


def setup_inputs(seed: int = 0) -> dict:
    key = jax.random.key(seed)
    ks = iter(jax.random.split(key, 40))
    f32 = jnp.float32
    L = DEPTH

    def nrm(shape, s):
        return jax.random.normal(next(ks), shape, f32) * s

    def uni(shape, lo, hi):
        return jax.random.uniform(next(ks), shape, f32, lo, hi)

    return {
        'x_prompt': nrm((BATCH, SEQ, D_MODEL), 1.0),
        'x_sample': nrm((DEC_BATCH, DEC_SEQ, D_MODEL), 1.0),
        'ln_in_g': 1.0 + nrm((D_MODEL,), 0.05),
        'ln_in_b': nrm((D_MODEL,), 0.02),
        'w_in': nrm((L, D_MODEL, P_COLS), D_MODEL ** -0.5),
        'shift_mu': uni((L, 2, A_COLS), 0.0, 0.5),
        'w0': uni((L, 2, A_WIDTH), -7.0, 0.0),
        'decay_up': nrm((L, 2, DECAY_LORA, A_WIDTH), 0.1),
        'a0': nrm((L, 2, A_WIDTH), 0.5),
        'iclr_up': nrm((L, 2, ICLR_LORA, A_WIDTH), 0.1),
        'g_up': nrm((L, GATE_LORA, A_WIDTH), GATE_LORA ** -0.5),
        'k_k': 0.85 + nrm((L, A_WIDTH), 0.05),
        'k_a': 1.0 + nrm((L, A_WIDTH), 0.05),
        'r_k': nrm((L, A_HEADS, A_HEAD_DIM), 0.1),
        'gn_g': 1.0 + nrm((L, A_WIDTH), 0.05),
        'gn_b': nrm((L, A_WIDTH), 0.02),
        'vres_down': nrm((L - 1, A_WIDTH, VRES_LORA), A_WIDTH ** -0.5),
        'vres_up': nrm((L - 1, VRES_LORA, A_WIDTH), 0.2),
        'vres_0': 1.0 + nrm((L - 1, A_WIDTH), 0.1),
        'lam': nrm((L, 4, B_HEAD_DIM), 0.1),
        'subln_g': 1.0 + nrm((L, 2 * B_HEAD_DIM), 0.05),
        'rel_bias': nrm((N_BUCKETS, B_HEADS), 0.5),
        'w_out': nrm((L, MIX_WIDTH, D_MODEL), MIX_WIDTH ** -0.5 * BETA),
        'ln1_g': 1.0 + nrm((L, D_MODEL), 0.05),
        'ln1_b': nrm((L, D_MODEL), 0.02),
        'ffn_up': nrm((L, D_MODEL, 2 * D_FF), D_MODEL ** -0.5),
        'conv_w': jnp.array([0.0, 1.0, 0.0], f32)[None, :, None] + nrm((L, 3, 2 * D_FF), 0.3),
        'conv_b': nrm((L, 2 * D_FF), 0.02),
        'ffn_down': nrm((L, D_FF, D_MODEL), D_FF ** -0.5 * BETA),
        'ln2_g': 1.0 + nrm((L, D_MODEL), 0.05),
        'ln2_b': nrm((L, D_MODEL), 0.02),
    }


def reference(x_prompt, x_sample, ln_in_g, ln_in_b, w_in, shift_mu, w0, decay_up, a0, iclr_up, g_up,
              k_k, k_a, r_k, gn_g, gn_b, vres_down, vres_up, vres_0, lam, subln_g, rel_bias, w_out,
              ln1_g, ln1_b, ffn_up, conv_w, conv_b, ffn_down, ln2_g, ln2_b):
    prm = dict(ln_in_g=ln_in_g, ln_in_b=ln_in_b, w_in=w_in, shift_mu=shift_mu, w0=w0, decay_up=decay_up,
               a0=a0, iclr_up=iclr_up, g_up=g_up, k_k=k_k, k_a=k_a, r_k=r_k, gn_g=gn_g, gn_b=gn_b,
               vres_down=vres_down, vres_up=vres_up, vres_0=vres_0, lam=lam, subln_g=subln_g,
               rel_bias=rel_bias, w_out=w_out, ln1_g=ln1_g, ln1_b=ln1_b, ffn_up=ffn_up, conv_w=conv_w,
               conv_b=conv_b, ffn_down=ffn_down, ln2_g=ln2_g, ln2_b=ln2_b)
    y_prompt = _trunk(x_prompt, prm)
    y_sample = _trunk(x_sample, prm)
    return (y_prompt, y_sample)
```

```cpp
#include <hip/hip_runtime.h>
#include <hip/hip_bf16.h>
#include <hip/hip_cooperative_groups.h>
#include <cstdio>
namespace cg = cooperative_groups;

#define DI __device__ __forceinline__
using bf16 = __hip_bfloat16;
using bf16x8 = __attribute__((ext_vector_type(8))) short;
using s16x4 = __attribute__((ext_vector_type(4))) short;
using f32x4 = __attribute__((ext_vector_type(4))) float;
using f32x16 = __attribute__((ext_vector_type(16))) float;
typedef unsigned short u16;
typedef unsigned u32x4 __attribute__((ext_vector_type(4)));
typedef unsigned u32x2 __attribute__((ext_vector_type(2)));

constexpr int D = 1024, T = 8192, NSEQ = 12, NT = NSEQ * T;
constexpr int NPROMPT_TOK = 4 * T;
constexpr int A_COLS = 1760, P_COLS = 3296, NPROJ = 3328;
constexpr int DFF = 2816, NUP = 5632;
constexpr int OFF_K = 512, OFF_V = 1024, OFF_WD = 1536, OFF_AD = 1600, OFF_GD = 1664;
constexpr float ALPHA = 1.4142135623730951f;
constexpr float LN_EPS = 1e-5f, GN_EPS = 64e-5f;
constexpr int NTHREADS = 512;
#ifndef DBGZ
#define DBGZ 0
#define DBG 0
#ifndef CHK_PROJ_ON
#define CHK_PROJ_ON 1
#endif
#ifndef CHK_ATTN_ON
#define CHK_ATTN_ON 1
#endif
#ifndef CHK_SCAN_ON
#define CHK_SCAN_ON 1
#endif
#ifndef CHK_POST_ON
#define CHK_POST_ON 1
#endif
#ifndef CHK_FFN_ON
#define CHK_FFN_ON 1
#endif
#define DBG_A 5
#define DBG_B 6
#define DBGTHR 0.05f, 0.1f, 0.1f, 0.1f, 0.01f, 0.05f
#endif
constexpr int LDS_BYTES = 163840;

constexpr size_t SZ_WIN = (size_t)2 * NPROJ * D * 2;
constexpr size_t SZ_WOUT = (size_t)2 * D * D * 2;
constexpr size_t SZ_WUP = (size_t)2 * NUP * D * 2;
constexpr size_t SZ_WDN = (size_t)2 * D * DFF * 2;
constexpr size_t OFF_WIN = 0;
constexpr size_t OFF_WOUT = OFF_WIN + SZ_WIN;
constexpr size_t OFF_WUP = OFF_WOUT + SZ_WOUT;
constexpr size_t OFF_WDN = OFF_WUP + SZ_WUP;
constexpr size_t OFF_XB = OFF_WDN + SZ_WDN;
constexpr size_t OFF_PA = OFF_XB + (size_t)NT * D * 2;
constexpr size_t OFF_PB = OFF_PA + (size_t)NT * A_COLS * 2;
constexpr size_t OFF_VT = OFF_PB + (size_t)NT * 1024 * 2;
constexpr size_t OFF_VV = OFF_VT + (size_t)NT * 512 * 2;
constexpr size_t OFF_BON = OFF_VV + (size_t)NT * 512 * 2;
constexpr size_t OFF_OSV = OFF_BON + (size_t)2 * NT * 8 * 4;
constexpr size_t OFF_DBG = OFF_OSV + (size_t)256 * 64 * 512 * 4;
constexpr size_t WS_END = OFF_DBG + 256;
static_assert((size_t)NT * DFF * 2 <= (OFF_VV - OFF_PA), "G alias");

struct Params {
  const float* in[31];
  float* out;
  unsigned char* ws;
  int ph_lo, ph_hi;
};

typedef const __attribute__((address_space(4))) Params* CParams;
DI CParams get_params() { CParams pp = (CParams)__builtin_amdgcn_kernarg_segment_ptr(); asm volatile("" : "+s"(pp)); return pp; }

DI u16 f2bf(float x) { unsigned u = __float_as_uint(x); u += 0x7fffu + ((u >> 16) & 1u); return (u16)(u >> 16); }
DI float bf2f(u16 b) { return __uint_as_float(((unsigned)b) << 16); }
DI float sigmoidf_(float x) { return 1.f / (1.f + __expf(-x)); }

template <int MODE> DI int src_col(int n) {
  if (MODE == 0) { return n < A_COLS ? n : (n < 1792 ? -1 : n - 32); }
  if (MODE == 2) { int j = n >> 8, i = n & 255; return i < 128 ? j * 128 + i : DFF + j * 128 + (i - 128); }
  return n;
}
template <int MODE>
DI void convert_weight(char* shm, const float* W, u16* WT, int K, int Nsrc, int Ndst, int gtid_block, int nblocks) {
  float* tile = (float*)shm;
  int tn = Ndst / 64, tk = K / 64;
  for (int t = gtid_block; t < tn * tk; t += nblocks) {
    int n0 = (t / tk) * 64, k0 = (t % tk) * 64;
    __syncthreads();
    for (int e = threadIdx.x; e < 4096; e += NTHREADS) {
      int kk = e >> 6, nn = e & 63;
      int sc = src_col<MODE>(n0 + nn);
      tile[kk * 65 + nn] = sc >= 0 ? W[(size_t)(k0 + kk) * Nsrc + sc] : 0.f;
    }
    __syncthreads();
    for (int e = threadIdx.x; e < 4096; e += NTHREADS) {
      int nn = e >> 6, kk = e & 63;
      WT[(size_t)(n0 + nn) * K + k0 + kk] = f2bf(tile[kk * 65 + nn]);
    }
  }
}

DI void ln_rows(const float* srcA, const float* srcB, int splitRow, float* dstF, u16* dstB, const float* g, const float* b) {
  int tid = threadIdx.x; asm volatile("" : "+v"(tid));
  int bid = blockIdx.x, gdim = gridDim.x; asm volatile("" : "+s"(bid), "+s"(gdim));
  int wave = tid >> 6, lane = tid & 63;
  int gw = bid * 8 + wave, nw = gdim * 8;
  float4 gg[4], bb[4];
  for (int i = 0; i < 4; ++i) { gg[i] = *(const float4*)(g + i * 256 + lane * 4); bb[i] = *(const float4*)(b + i * 256 + lane * 4); }
  for (int row = gw; row < NT; row += nw) {
    const float* src = row < splitRow ? srcA + (size_t)row * D : srcB + (size_t)(row - splitRow) * D;
    float4 v[4]; float s = 0.f;
    for (int i = 0; i < 4; ++i) { v[i] = *(const float4*)(src + i * 256 + lane * 4); s += v[i].x + v[i].y + v[i].z + v[i].w; }
    for (int o = 32; o > 0; o >>= 1) s += __shfl_xor(s, o);
    float mu = s * (1.f / D), q = 0.f;
    for (int i = 0; i < 4; ++i) { v[i].x -= mu; v[i].y -= mu; v[i].z -= mu; v[i].w -= mu; q += v[i].x * v[i].x + v[i].y * v[i].y + v[i].z * v[i].z + v[i].w * v[i].w; }
    for (int o = 32; o > 0; o >>= 1) q += __shfl_xor(q, o);
    float rs = rsqrtf(q * (1.f / D) + LN_EPS);
    for (int i = 0; i < 4; ++i) {
      float4 o4; o4.x = v[i].x * rs * gg[i].x + bb[i].x; o4.y = v[i].y * rs * gg[i].y + bb[i].y; o4.z = v[i].z * rs * gg[i].z + bb[i].z; o4.w = v[i].w * rs * gg[i].w + bb[i].w;
      *(float4*)(dstF + (size_t)row * D + i * 256 + lane * 4) = o4;
      ushort4 h; h.x = f2bf(o4.x); h.y = f2bf(o4.y); h.z = f2bf(o4.z); h.w = f2bf(o4.w);
      *(ushort4*)(dstB + (size_t)row * D + i * 256 + lane * 4) = h;
    }
  }
}

#define LAS __attribute__((address_space(3)))
constexpr int BK = 64, HALF = 128, HTB = HALF * BK * 2, STAGE_BYTES = 8 * HTB;
DI int lds_byte(int r, int c) { const int st = (r >> 4) * 2 + (c >> 5), rr = r & 15, cc = c & 31, ob = rr * 64 + cc * 2; return st * 1024 + (ob ^ (((ob >> 9) & 1) << 5)); }
DI void stage_rc(int b, int& R, int& C) { const int st = b / 1024, sb = b % 1024, swz = sb ^ (((sb >> 9) & 1) << 5); R = (st >> 1) * 16 + swz / 64; C = (st & 1) * 32 + (swz % 64) / 2; }
DI int perm32(int rho) { const int n = rho >> 4, i = rho & 15; return 8 * (i >> 2) + 4 * n + (i & 3); }
DI unsigned cvt_pk_bf16(float lo, float hi) { unsigned r; asm volatile("v_cvt_pk_bf16_f32 %0, %1, %2" : "=v"(r) : "v"(lo), "v"(hi)); return r; }

typedef float f32x2 __attribute__((ext_vector_type(2)));
DI float gelu1(float v) {
  const float av = __builtin_fabsf(v), d = av * 0.2316418882f + 1.0f;
  const float t = __builtin_amdgcn_rcpf(d);
  float q = t * 0.5307027145f + (-0.7265760135f); q = q * t + 0.7107068705f; q = q * t + (-0.142248368f); q = q * t + 0.127414796f; q = q * t;
  const float e = __builtin_amdgcn_exp2f((v * v) * (-0.72134752044f));
  const float m = v * (q * e), r = v - m;
  return v < 0.f ? m : r;
}
DI float dpp_shr1(float old, float src) { asm volatile("s_nop 1\n\tv_mov_b32_dpp %0, %1 row_shr:1 row_mask:0xf bank_mask:0xf\n\ts_nop 0" : "+v"(old) : "v"(src) : "memory"); return old; }
DI float dpp_shl1(float old, float src) { asm volatile("s_nop 1\n\tv_mov_b32_dpp %0, %1 row_shl:1 row_mask:0xf bank_mask:0xf\n\ts_nop 0" : "+v"(old) : "v"(src) : "memory"); return old; }
struct Unit { int pm, pn; };
struct Order {
  int nM, nN, nwg, G, c;
  DI void init(int nM_, int nN_, int G_, int c_) { nM = nM_; nN = nN_; nwg = nM * nN; G = G_; c = c_; }
  DI bool next(int i, Unit& u) const {
    const long Lq = (long)i * G + c; if (Lq >= nwg) return false;
    int wgid = (int)Lq; { const int q = nwg / 8, r = nwg % 8, xcd = wgid % 8, off = wgid / 8; wgid = (xcd < r ? xcd * (q + 1) : r * (q + 1) + (xcd - r) * q) + off; }
    const int nig = 8 * nN, gid = wgid / nig, fm = gid * 8, gsz = (nM - fm) < 8 ? (nM - fm) : 8;
    u.pm = fm + ((wgid % nig) % gsz); u.pn = (wgid % nig) / gsz; return true;
  }
};
struct Gemm { const u16* A; int lda; const u16* Bt; int K; };
template <int ROWMODE> DI const char* a_tile_ptr(const Gemm& g, int pm) {
  long row = ROWMODE == 0 ? (long)pm * 256 : (long)(pm / 33) * T + 254 * (pm % 33) - 1;
  return (const char*)g.A + row * g.lda * 2;
}
struct EpiArgs {
  u16* pa; u16* pb; u16* vt;
  float* xf;
  u16* g; const float* cw; const float* cb;
  int zero;
};
template <int EPI>
DI void epilogue(f32x4 (&acc)[2][2][4][2], const Unit& u, const EpiArgs& ea, LAS unsigned char* lds) {
  int tid2 = threadIdx.x; asm volatile("" : "+v"(tid2));
  const int wid2 = tid2 >> 6, lane2 = tid2 & 63, wr = wid2 >> 2, wc = wid2 & 3, fr = lane2 & 15, fq = lane2 >> 4;
  if (EPI == 0) {
    const int row0 = u.pm * 256 + wr * 64 + fr;
#pragma unroll
    for (int ai = 0; ai < 2; ++ai)
#pragma unroll
      for (int m = 0; m < 4; ++m) {
        const int row = row0 + ai * HALF + m * 16;
#pragma unroll
        for (int bj = 0; bj < 2; ++bj) {
          const int col = u.pn * 256 + bj * HALF + wc * 32 + 8 * fq;
          const f32x4 a0 = acc[ai][bj][m][0], a1 = acc[ai][bj][m][1];
          if (u.pn <= 10) {
            uint4 pk; pk.x = cvt_pk_bf16(a0[0], a0[1]); pk.y = cvt_pk_bf16(a0[2], a0[3]); pk.z = cvt_pk_bf16(a1[0], a1[1]); pk.w = cvt_pk_bf16(a1[2], a1[3]);
            if (u.pn <= 6) { if (col < A_COLS) *(uint4*)(ea.pa + (size_t)row * A_COLS + col) = pk; }
            else *(uint4*)(ea.pb + (size_t)row * 1024 + (col - 1792)) = pk;
          } else {
            const int c2 = col - 2816, h = c2 >> 7, e = c2 & 127, seq = row / T, t = row % T;
            u16* dst = ea.vt + ((size_t)((seq * 4 + h) * 128 + e)) * T + t;
#pragma unroll
            for (int j = 0; j < 4; ++j) { dst[(size_t)j * T] = f2bf(a0[j]); dst[(size_t)(4 + j) * T] = f2bf(a1[j]); }
          }
        }
      }
  } else if (EPI == 1) {
    const int row0 = u.pm * 256 + wr * 64 + fr, col0 = u.pn * 256 + wc * 32 + 4 * fq;
#pragma unroll
    for (int ai = 0; ai < 2; ++ai)
#pragma unroll
      for (int m = 0; m < 4; ++m) {
        float* rowp = ea.xf + (size_t)(row0 + ai * HALF + m * 16) * D + col0;
#pragma unroll
        for (int bj = 0; bj < 2; ++bj)
#pragma unroll
          for (int n = 0; n < 2; ++n) { f32x4* p4 = (f32x4*)(rowp + bj * HALF + n * 16); f32x4 x = *p4; *p4 = ea.zero ? x * ALPHA : x * ALPHA + acc[ai][bj][m][n]; }
      }
  } else {
    LAS float* E = (LAS float*)(lds + STAGE_BYTES);
    const int seq = u.pm / 33, ti = u.pm % 33;
    const int cl0 = wc * 32 + 8 * fq;
#pragma unroll
    for (int ai = 0; ai < 2; ++ai)
#pragma unroll
      for (int m = 0; m < 4; ++m) {
        const int rl = ai * HALF + wr * 64 + m * 16 + fr;
        const int tok = 254 * ti - 1 + rl;
        const bool valid = tok >= 0 && tok < T;
        const int blk = ai * 8 + wr * 4 + m;
#pragma unroll
        for (int bj = 0; bj < 2; ++bj)
#pragma unroll
          for (int n = 0; n < 2; ++n) {
            if (!valid) acc[ai][bj][m][n] = (f32x4){0.f, 0.f, 0.f, 0.f};
            if (fr == 0) *(LAS f32x4*)(E + ((blk * 2 + 0) * 2 + bj) * 128 + cl0 + 4 * n) = acc[ai][bj][m][n];
            if (fr == 15) *(LAS f32x4*)(E + ((blk * 2 + 1) * 2 + bj) * 128 + cl0 + 4 * n) = acc[ai][bj][m][n];
          }
      }
    asm volatile("s_waitcnt lgkmcnt(0)" ::: "memory");
    __builtin_amdgcn_s_barrier(); asm volatile("" ::: "memory");
    __builtin_amdgcn_s_barrier(); asm volatile("" ::: "memory");
#pragma unroll
    for (int n = 0; n < 2; ++n) {
      const int hid = u.pn * 128 + cl0 + 4 * n;
      const float* cwp = ea.cw + hid;
      const f32x4 g0 = *(const f32x4*)(cwp), g1 = *(const f32x4*)(cwp + NUP), g2 = *(const f32x4*)(cwp + 2 * NUP), gb = *(const f32x4*)(ea.cb + hid);
      const f32x4 u0 = *(const f32x4*)(cwp + DFF), u1 = *(const f32x4*)(cwp + DFF + NUP), u2 = *(const f32x4*)(cwp + DFF + 2 * NUP), ub = *(const f32x4*)(ea.cb + DFF + hid);
#pragma unroll
      for (int ai = 0; ai < 2; ++ai)
#pragma unroll
        for (int m = 0; m < 4; ++m) {
          const int blk = ai * 8 + wr * 4 + m;
          const int rl = ai * HALF + wr * 64 + m * 16 + fr;
          const int tok = 254 * ti - 1 + rl;
          f32x4 hh[2];
#pragma unroll
          for (int bj = 0; bj < 2; ++bj) {
            const f32x4 cur = acc[ai][bj][m][n];
            f32x4 ab = (f32x4){0.f, 0.f, 0.f, 0.f}, be = (f32x4){0.f, 0.f, 0.f, 0.f};
            if (fr == 0 && blk > 0) ab = *(LAS f32x4*)(E + (((blk - 1) * 2 + 1) * 2 + bj) * 128 + cl0 + 4 * n);
            if (fr == 15 && blk < 15) be = *(LAS f32x4*)(E + (((blk + 1) * 2 + 0) * 2 + bj) * 128 + cl0 + 4 * n);
            f32x4 prev, next;
#pragma unroll
            for (int j = 0; j < 4; ++j) { prev[j] = dpp_shr1(ab[j], cur[j]); next[j] = dpp_shl1(be[j], cur[j]); }
            hh[bj] = bj == 0 ? g0 * prev + g1 * cur + g2 * next + gb : u0 * prev + u1 * cur + u2 * next + ub;
          }
          f32x4 res;
#pragma unroll
          for (int j = 0; j < 4; ++j) res[j] = gelu1(hh[0][j]) * hh[1][j];
          if (rl >= 1 && rl <= 254 && tok < T) {
            u32x2 pk; pk.x = cvt_pk_bf16(res[0], res[1]); pk.y = cvt_pk_bf16(res[2], res[3]);
            *(u32x2*)(ea.g + (size_t)(seq * T + tok) * DFF + hid) = pk;
          }
        }
    }
  }
}

template <int EPI, int ROWMODE>
DI void gemm_phase(LAS unsigned char* lds, const Gemm g, int nM, int nN, const EpiArgs& ea) {
  constexpr bool PERM = (EPI != 1);
  int tid = threadIdx.x; asm volatile("" : "+v"(tid));
  int bid = blockIdx.x, gdim = gridDim.x; asm volatile("" : "+s"(bid), "+s"(gdim));
  const int wid = __builtin_amdgcn_readfirstlane(tid >> 6), lane = tid & 63, wr = wid >> 2, wc = wid & 3, fr = lane & 15, fq = lane >> 4;
  const int K = g.K, nt = K / BK;
  Order S; S.init(nM, nN, gdim, bid);
  unsigned voffA[2], voffB[2];
#pragma unroll
  for (int i = 0; i < 2; ++i) { int R, C; stage_rc(tid * 16 + i * 8192, R, C); const int Rb = PERM ? ((R & ~31) + perm32(R & 31)) : R;
    voffA[i] = (unsigned)(R * g.lda + C) * 2u; voffB[i] = (unsigned)(Rb * K + C) * 2u; }
  const size_t kstep = (size_t)(BK * 2);
  const size_t hstepA = (size_t)HALF * g.lda * 2, hstepB = (size_t)HALF * K * 2;
  const unsigned ldsw = (unsigned)wid * 1024u;
  const int aoff = lds_byte(wr * 64 + fr, fq * 8), boff = lds_byte(wc * 32 + fr, fq * 8);
#define PG8_SA(b, h) (((b) * 2 + (h)) * HTB)
#define PG8_SB(b, h) ((4 + (b) * 2 + (h)) * HTB)
#define PG8_STAGE(bufoff, gbase, voff) do { _Pragma("unroll") for (int _i = 0; _i < 2; ++_i) \
    __builtin_amdgcn_global_load_lds((const unsigned*)((const char*)(gbase) + (voff)[_i]), (LAS unsigned*)(lds + (bufoff) + ldsw + _i * 8192), 16, 0, 0); } while (0)
#define PG8_LDA(dst, b, h) do { _Pragma("unroll") for (int m = 0; m < 4; ++m) _Pragma("unroll") for (int k = 0; k < 2; ++k) dst[m][k] = *(const LAS bf16x8*)(lds + PG8_SA(b, h) + aoff + m * 2048 + k * 1024); } while (0)
#define PG8_LDB(dst, b, h) do { _Pragma("unroll") for (int n = 0; n < 2; ++n) _Pragma("unroll") for (int k = 0; k < 2; ++k) dst[n][k] = *(const LAS bf16x8*)(lds + PG8_SB(b, h) + boff + n * 2048 + k * 1024); } while (0)
#define PG8_MMA(ai, bj, At, Bq) do { __builtin_amdgcn_s_setprio(1); _Pragma("unroll") for (int m = 0; m < 4; ++m) _Pragma("unroll") for (int n = 0; n < 2; ++n) _Pragma("unroll") for (int k = 0; k < 2; ++k) \
    acc[ai][bj][m][n] = __builtin_amdgcn_mfma_f32_16x16x32_bf16(Bq[n][k], At[m][k], acc[ai][bj][m][n], 0, 0, 0); __builtin_amdgcn_s_setprio(0); } while (0)
#define PG8_WAIT_V(n) asm volatile("s_waitcnt vmcnt(" #n ")" ::: "memory")
#define PG8_WAIT_L(n) asm volatile("s_waitcnt lgkmcnt(" #n ")" ::: "memory")
#define PG8_BAR __builtin_amdgcn_s_barrier()
#define PG8_SCHED __builtin_amdgcn_sched_barrier(0)
  Unit cur, nxt; int ui = 0;
  __syncthreads();
  if (!S.next(0, cur)) return;
  f32x4 acc[2][2][4][2];
#pragma unroll
  for (int a = 0; a < 2; ++a)
#pragma unroll
    for (int b = 0; b < 2; ++b)
#pragma unroll
      for (int m = 0; m < 4; ++m)
#pragma unroll
        for (int n = 0; n < 2; ++n) acc[a][b][m][n] = (f32x4){0.f, 0.f, 0.f, 0.f};
  bf16x8 At[4][2], B0[2][2], B1[2][2];
  const char* cA = a_tile_ptr<ROWMODE>(g, cur.pm); const char* cB = (const char*)g.Bt + (size_t)cur.pn * 2 * hstepB;
  PG8_STAGE(PG8_SB(0, 0), cB, voffB); PG8_STAGE(PG8_SA(0, 0), cA, voffA); PG8_STAGE(PG8_SB(0, 1), cB + hstepB, voffB); PG8_STAGE(PG8_SA(0, 1), cA + hstepA, voffA);
  if (wr == 1) PG8_BAR;
  PG8_WAIT_V(4); PG8_BAR;
  PG8_STAGE(PG8_SB(1, 0), cB + kstep, voffB); PG8_STAGE(PG8_SA(1, 0), cA + kstep, voffA); PG8_STAGE(PG8_SB(1, 1), cB + hstepB + kstep, voffB);
  PG8_WAIT_V(6); PG8_BAR;
  for (;;) {
    const bool has_next = S.next(ui + 1, nxt);
    const char* nA = has_next ? a_tile_ptr<ROWMODE>(g, nxt.pm) : cA; const char* nB = has_next ? (const char*)g.Bt + (size_t)nxt.pn * 2 * hstepB : cB;
    for (int t = 0; t < nt; t += 2) {
      const bool last = (t == nt - 2);
      const char* a1 = cA + (size_t)(t + 1) * kstep;
      const char* a2 = last ? nA : cA + (size_t)(t + 2) * kstep; const char* b2 = last ? nB : cB + (size_t)(t + 2) * kstep;
      const char* a3 = a2 + kstep; const char* b3 = b2 + kstep;
      PG8_LDB(B0, 0, 0); PG8_SCHED; PG8_LDA(At, 0, 0); PG8_STAGE(PG8_SA(1, 1), a1 + hstepA, voffA);
      PG8_WAIT_L(8); PG8_BAR; PG8_WAIT_L(0); PG8_MMA(0, 0, At, B0); PG8_BAR; PG8_SCHED;
      PG8_LDB(B1, 0, 1); PG8_STAGE(PG8_SB(0, 0), b2, voffB);
      PG8_BAR; PG8_WAIT_L(0); PG8_MMA(0, 1, At, B1); PG8_BAR;
      PG8_LDA(At, 0, 1); PG8_STAGE(PG8_SA(0, 0), a2, voffA);
      PG8_BAR; PG8_WAIT_L(0); PG8_MMA(1, 0, At, B0); PG8_BAR; PG8_SCHED;
      PG8_STAGE(PG8_SB(0, 1), b2 + hstepB, voffB);
      PG8_WAIT_V(6); PG8_BAR; PG8_MMA(1, 1, At, B1); PG8_BAR;
      PG8_LDB(B0, 1, 0); PG8_SCHED; PG8_LDA(At, 1, 0); PG8_STAGE(PG8_SA(0, 1), a2 + hstepA, voffA);
      PG8_WAIT_L(8); PG8_BAR; PG8_WAIT_L(0); PG8_MMA(0, 0, At, B0); PG8_BAR; PG8_SCHED;
      PG8_LDB(B1, 1, 1); PG8_STAGE(PG8_SB(1, 0), b3, voffB);
      PG8_BAR; PG8_WAIT_L(0); PG8_MMA(0, 1, At, B1); PG8_BAR;
      PG8_LDA(At, 1, 1); PG8_STAGE(PG8_SA(1, 0), a3, voffA);
      PG8_BAR; PG8_WAIT_L(0); PG8_MMA(1, 0, At, B0); PG8_BAR; PG8_SCHED;
      PG8_STAGE(PG8_SB(1, 1), b3 + hstepB, voffB);
      PG8_WAIT_V(6); PG8_BAR; PG8_MMA(1, 1, At, B1); PG8_BAR;
    }
    epilogue<EPI>(acc, cur, ea, lds);
    if (!has_next) break;
#pragma unroll
    for (int a = 0; a < 2; ++a)
#pragma unroll
      for (int b = 0; b < 2; ++b)
#pragma unroll
        for (int m = 0; m < 4; ++m)
#pragma unroll
          for (int n = 0; n < 2; ++n) acc[a][b][m][n] = (f32x4){0.f, 0.f, 0.f, 0.f};
    cur = nxt; cA = nA; cB = nB; ++ui;
  }
  PG8_WAIT_V(0);
  if (wr == 0) PG8_BAR;
  PG8_BAR;
#undef PG8_SA
#undef PG8_SB
}

constexpr int KROW = 144, VROW = 144;
constexpr int KBUF = 64 * KROW, VBUF = 128 * VROW, ABUF = KBUF + VBUF;
constexpr float LOG2E = 1.4426950408889634f;
DI bf16x8 pack8(const f32x16& x, int s) {
  u32x4 p; p.x = cvt_pk_bf16(x[8 * s], x[8 * s + 1]); p.y = cvt_pk_bf16(x[8 * s + 2], x[8 * s + 3]); p.z = cvt_pk_bf16(x[8 * s + 4], x[8 * s + 5]); p.w = cvt_pk_bf16(x[8 * s + 6], x[8 * s + 7]);
  return __builtin_bit_cast(bf16x8, p);
}
DI void attn_phase(LAS unsigned char* lds, u16* PB, const u16* VT, float* OSV, const float* lamp, const float* subg, const float* relb, int layer) {
  int tid = threadIdx.x; asm volatile("" : "+v"(tid));
  int bid = blockIdx.x, gdim = gridDim.x; asm volatile("" : "+s"(bid), "+s"(gdim));
  const int wid = tid >> 6, lane = tid & 63, qi = lane & 31, g = lane >> 5;
  LAS float* tab = (LAS float*)(lds + 2 * ABUF);
  LAS float* scal = tab + 264;
  const float lam_init = 0.8f - 0.6f * __expf(-0.3f * (float)layer);
  __syncthreads();
  if (wid == 0) {
    float a = lamp[lane] * lamp[64 + lane], b = lamp[128 + lane] * lamp[192 + lane];
    for (int o = 32; o > 0; o >>= 1) { a += __shfl_xor(a, o); b += __shfl_xor(b, o); }
    if (lane == 0) scal[0] = __expf(a) - __expf(b) + lam_init;
  }
  const int m_sw = (qi & 0x13) | ((qi & 4) << 1) | ((qi & 8) >> 1);
  const int xcd = bid & 7, jq = bid >> 3;
  const int per_x = gdim >> 3;
  const float c1 = 0.125f * LOG2E;
  for (int pr = xcd; pr < 48; pr += 8) {
    const int s = pr >> 2, h = pr & 3;
    for (int qb = jq; qb < 32; qb += per_x) {
      __syncthreads();
      for (int i = tid; i < 257; i += NTHREADS) {
        const int rel = i - 128, n = rel < 0 ? -rel : rel;
        int bk = n < 8 ? n : (n <= 11 ? 8 : (n <= 15 ? 9 : (n <= 22 ? 10 : (n <= 31 ? 11 : (n <= 45 ? 12 : (n <= 63 ? 13 : (n <= 90 ? 14 : 15)))))));
        if (rel > 0) bk += 16;
        tab[i] = relb[bk * 4 + h] * LOG2E;
      }
      const int q0 = qb * 256 + wid * 32;
      const size_t tokbase = (size_t)s * T;
      float* osv = OSV + ((size_t)bid * 512 + tid) * 64;
#pragma unroll 1
      for (int c = 0; c < 2; ++c) {
        bf16x8 Q[4];
        { const u16* qp = PB + (tokbase + q0 + qi) * 1024 + h * 128 + c * 64 + g * 8;
#pragma unroll
          for (int ks = 0; ks < 4; ++ks) Q[ks] = *(const bf16x8*)(qp + ks * 16); }
        f32x16 O[4];
#pragma unroll
        for (int eb = 0; eb < 4; ++eb)
#pragma unroll
          for (int i = 0; i < 16; ++i) O[eb][i] = 0.f;
        float mrun = -1e30f, lrun = 0.f;
        const u16* kg = PB + (tokbase + (tid >> 3)) * 1024 + 512 + h * 128 + c * 64 + (tid & 7) * 8;
        const u16* vg = VT + ((size_t)((s * 4 + h) * 128 + (tid >> 2))) * T + (tid & 3) * 16;
        const unsigned kl = (tid >> 3) * KROW + (tid & 7) * 16, vl = KBUF + (tid >> 2) * VROW + (tid & 3) * 32;
        u32x4 rk0, rv0, rv1;
        rk0 = *(const u32x4*)(kg); rv0 = *(const u32x4*)(vg); rv1 = *(const u32x4*)(vg + 8);
        __syncthreads();
        *(LAS u32x4*)(lds + kl) = rk0; *(LAS u32x4*)(lds + vl) = rv0; *(LAS u32x4*)(lds + vl + 16) = rv1;
        __syncthreads();
#pragma unroll 1
        for (int kt = 0; kt < 128; ++kt) {
          LAS unsigned char* buf = lds + (kt & 1) * ABUF;
          LAS unsigned char* nbuf = lds + ((kt + 1) & 1) * ABUF;
          if (kt + 1 < 128) {
            const u16* kg2 = kg + (size_t)(kt + 1) * 64 * 1024; const u16* vg2 = vg + (kt + 1) * 64;
            rk0 = *(const u32x4*)(kg2); rv0 = *(const u32x4*)(vg2); rv1 = *(const u32x4*)(vg2 + 8);
          }
          const int kmin = kt * 64;
          const int dlo = kmin + 63 - q0, dhi = kmin - (q0 + 31);
          const int bmode = dlo <= -91 ? 0 : (dhi >= 91 ? 1 : 2);
          const float bconst = bmode == 0 ? tab[0] : tab[256];
          f32x16 S[2];
#pragma unroll
          for (int kb = 0; kb < 2; ++kb) {
#pragma unroll
            for (int i = 0; i < 16; ++i) S[kb][i] = 0.f;
#pragma unroll
            for (int ks = 0; ks < 4; ++ks) {
              const bf16x8 a = *(const LAS bf16x8*)(buf + (kb * 32 + m_sw) * KROW + (ks * 16 + g * 8) * 2);
              S[kb] = __builtin_amdgcn_mfma_f32_32x32x16_bf16(a, Q[ks], S[kb], 0, 0, 0);
            }
          }
          float mx = -1e30f;
          if (bmode == 2) {
#pragma unroll
            for (int kb = 0; kb < 2; ++kb)
#pragma unroll
              for (int r = 0; r < 16; ++r) {
                int rel = kmin + kb * 32 + 16 * (r >> 3) + 8 * g + (r & 7) - (q0 + qi);
                rel = rel < -128 ? -128 : (rel > 128 ? 128 : rel);
                S[kb][r] = S[kb][r] * c1 + tab[rel + 128];
                mx = fmaxf(mx, S[kb][r]);
              }
          } else {
#pragma unroll
            for (int kb = 0; kb < 2; ++kb)
#pragma unroll
              for (int r = 0; r < 16; ++r) { S[kb][r] = S[kb][r] * c1 + bconst; mx = fmaxf(mx, S[kb][r]); }
          }
          mx = fmaxf(mx, __shfl_xor(mx, 32));
          const float mnew = fmaxf(mrun, mx);
          const float alpha = __builtin_amdgcn_exp2f(mrun - mnew);
          mrun = mnew;
          float psum = 0.f;
#pragma unroll
          for (int kb = 0; kb < 2; ++kb)
#pragma unroll
            for (int r = 0; r < 16; ++r) { const float pv = __builtin_amdgcn_exp2f(S[kb][r] - mnew); S[kb][r] = pv; psum += pv; }
          lrun = lrun * alpha + psum;
#pragma unroll
          for (int eb = 0; eb < 4; ++eb)
#pragma unroll
            for (int i = 0; i < 16; ++i) O[eb][i] *= alpha;
#pragma unroll
          for (int kb = 0; kb < 2; ++kb)
#pragma unroll
            for (int hh = 0; hh < 2; ++hh) {
              const bf16x8 pb = pack8(S[kb], hh);
#pragma unroll
              for (int eb = 0; eb < 4; ++eb) {
                const bf16x8 va = *(const LAS bf16x8*)(buf + KBUF + (eb * 32 + qi) * VROW + (kb * 32 + hh * 16 + g * 8) * 2);
                O[eb] = __builtin_amdgcn_mfma_f32_32x32x16_bf16(va, pb, O[eb], 0, 0, 0);
              }
            }
          if (kt + 1 < 128) {
            *(LAS u32x4*)(nbuf + kl) = rk0; *(LAS u32x4*)(nbuf + vl) = rv0; *(LAS u32x4*)(nbuf + vl + 16) = rv1;
          }
          __syncthreads();
        }
        const float lt = lrun + __shfl_xor(lrun, 32);
        asm volatile("" : "+v"(osv));
        if (c == 0) {
          const float i0 = 1.f / lt;
#pragma unroll
          for (int eb = 0; eb < 4; ++eb)
#pragma unroll
            for (int i = 0; i < 16; i += 4) { f32x4 t4; t4[0] = O[eb][i] * i0; t4[1] = O[eb][i + 1] * i0; t4[2] = O[eb][i + 2] * i0; t4[3] = O[eb][i + 3] * i0; *(f32x4*)(osv + eb * 16 + i) = t4; }
        } else {
          const float i1 = scal[0] / lt;
          float ss = 0.f;
#pragma unroll
          for (int eb = 0; eb < 4; ++eb)
#pragma unroll
            for (int i = 0; i < 16; i += 4) { const f32x4 t4 = *(const f32x4*)(osv + eb * 16 + i);
#pragma unroll
              for (int j = 0; j < 4; ++j) { const float o = t4[j] - O[eb][i + j] * i1; O[eb][i + j] = o; ss += o * o; } }
          ss += __shfl_xor(ss, 32);
          const float rs = rsqrtf(ss * (1.f / 128.f) + LN_EPS) * (1.f - lam_init);
          u16* op = PB + (tokbase + q0 + qi) * 1024 + h * 128;
#pragma unroll
          for (int eb = 0; eb < 4; ++eb)
#pragma unroll
            for (int rr = 0; rr < 4; ++rr) {
              const int e = eb * 32 + 8 * rr + 4 * g;
              const f32x4 gg = *(const f32x4*)(subg + e);
              u32x2 pk; pk.x = cvt_pk_bf16(O[eb][4 * rr] * rs * gg[0], O[eb][4 * rr + 1] * rs * gg[1]); pk.y = cvt_pk_bf16(O[eb][4 * rr + 2] * rs * gg[2], O[eb][4 * rr + 3] * rs * gg[3]);
              *(u32x2*)(op + e) = pk;
            }
        }
      }
    }
  }
}

DI float softplusf_(float x) { return fmaxf(x, 0.f) + __logf(1.f + __expf(-fabsf(x))); }
DI void load_bf16x8(const u16* p, float (&o)[8]) {
  const u32x4 v = *(const u32x4*)p;
#pragma unroll
  for (int i = 0; i < 4; ++i) { o[2 * i] = __uint_as_float(v[i] << 16); o[2 * i + 1] = __uint_as_float(v[i] & 0xffff0000u); }
}
DI void shifted8(const u16* PA, size_t row, int t, int col, const float* mu0, const float* mu1, float (&o)[8]) {
  float c[8], pv[8], nx[8];
  load_bf16x8(PA + row * A_COLS + col, c);
  if (t > 0) load_bf16x8(PA + (row - 1) * A_COLS + col, pv); else { for (int i = 0; i < 8; ++i) pv[i] = 0.f; }
  if (t < T - 1) load_bf16x8(PA + (row + 1) * A_COLS + col, nx); else { for (int i = 0; i < 8; ++i) nx[i] = 0.f; }
#pragma unroll
  for (int i = 0; i < 8; ++i) o[i] = c[i] + mu0[col + i] * (pv[i] - c[i]) + mu1[col + i] * (nx[i] - c[i]);
}

DI void vprep_phase(LAS unsigned char* lds, const u16* PA, u16* VV, const float* mu, const float* vdown, const float* vup, const float* v0, int layer) {
  int tid = threadIdx.x; asm volatile("" : "+v"(tid));
  int bid = blockIdx.x, gdim = gridDim.x; asm volatile("" : "+s"(bid), "+s"(gdim));
  const int tok = tid >> 4, j = tid & 15;
  LAS float* vs = (LAS float*)lds;
  LAS float* dd = vs + 32 * 516;
  const float* mu0 = mu; const float* mu1 = mu + A_COLS;
  for (int it = bid; it < NT / 32; it += gdim) {
    const size_t row = (size_t)it * 32 + tok; const int t = (int)(row % T);
    __syncthreads();
#pragma unroll 1
    for (int q = 0; q < 4; ++q) {
      float o[8]; shifted8(PA, row, t, OFF_V + j * 32 + q * 8, mu0, mu1, o);
      if (layer == 0) {
        u32x4 pk; pk.x = cvt_pk_bf16(o[0], o[1]); pk.y = cvt_pk_bf16(o[2], o[3]); pk.z = cvt_pk_bf16(o[4], o[5]); pk.w = cvt_pk_bf16(o[6], o[7]);
        *(u32x4*)(VV + row * 512 + j * 32 + q * 8) = pk;
      } else {
#pragma unroll
        for (int i = 0; i < 8; ++i) vs[tok * 516 + j * 32 + q * 8 + i] = o[i];
      }
    }
    if (layer == 0) continue;
    __syncthreads();
    {
      float d0 = 0.f, d1 = 0.f;
#pragma unroll 4
      for (int c = 0; c < 512; ++c) { const float x = vs[tok * 516 + c]; const float2 w = *(const float2*)(vdown + c * 32 + 2 * j); d0 += x * w.x; d1 += x * w.y; }
      dd[tok * 32 + 2 * j] = d0; dd[tok * 32 + 2 * j + 1] = d1;
    }
    __syncthreads();
#pragma unroll 1
    for (int q = 0; q < 4; ++q) {
      const int c0 = j * 32 + q * 8;
      float acc[8];
#pragma unroll
      for (int i = 0; i < 8; ++i) acc[i] = v0[c0 + i];
#pragma unroll 4
      for (int r = 0; r < 32; ++r) {
        const float dv = dd[tok * 32 + r];
        const f32x4 u0 = *(const f32x4*)(vup + r * 512 + c0), u1 = *(const f32x4*)(vup + r * 512 + c0 + 4);
#pragma unroll
        for (int i = 0; i < 4; ++i) { acc[i] += dv * u0[i]; acc[4 + i] += dv * u1[i]; }
      }
      float vf[8]; load_bf16x8(VV + row * 512 + c0, vf);
      float o[8];
#pragma unroll
      for (int i = 0; i < 8; ++i) { const float x = vs[tok * 516 + c0 + i]; o[i] = x + (vf[i] - x) * sigmoidf_(acc[i]); }
      u32x4 pk; pk.x = cvt_pk_bf16(o[0], o[1]); pk.y = cvt_pk_bf16(o[2], o[3]); pk.z = cvt_pk_bf16(o[4], o[5]); pk.w = cvt_pk_bf16(o[6], o[7]);
      *(u32x4*)(VV + row * 512 + c0) = pk;
    }
  }
}

struct ScanW { const float *mu, *w0, *du, *a0, *iu, *kk_, *ka, *rk; };
constexpr int SC = 32;
DI float quad_sum(float x) {
  x += __builtin_bit_cast(float, __builtin_amdgcn_update_dpp(0, __builtin_bit_cast(int, x), 0xB1, 0xf, 0xf, true));
  x += __builtin_bit_cast(float, __builtin_amdgcn_update_dpp(0, __builtin_bit_cast(int, x), 0x4E, 0xf, 0xf, true));
  return x;
}
DI void scan_phase(LAS unsigned char* lds, const u16* PA, const u16* VV, u16* YY, float* BON, const ScanW w) {
  int tid = threadIdx.x; asm volatile("" : "+v"(tid));
  int bid = blockIdx.x, gdim = gridDim.x; asm volatile("" : "+s"(bid), "+s"(gdim));
  LAS float* AW = (LAS float*)lds;
  LAS float* AK = AW + SC * 64;
  LAS float* AB = AK + SC * 64;
  LAS float* AD = AB + SC * 64;
  LAS float* AR = AD + SC * 64;
  LAS float* AV = AR + SC * 64;
  LAS float* AY = AV + SC * 64;
  LAS float* TW = AY + SC * 64;
  LAS float* TA = TW + SC * 32;
  LAS float* DU = TA + SC * 32;
  LAS float* IU = DU + 32 * 64;
  const int tok = tid >> 4, j = tid & 15;
  const int wid = tid >> 6, lane = tid & 63;
  for (int item = bid; item < 192; item += gdim) {
    const int dir = item & 1, h = (item >> 1) & 7, sq = item >> 4;
    __syncthreads();
    for (int i = tid; i < 2048; i += NTHREADS) { const int rr = i >> 6, c = i & 63; DU[i] = w.du[(dir * 32 + rr) * 512 + h * 64 + c]; IU[i] = w.iu[(dir * 32 + rr) * 512 + h * 64 + c]; }
    const float* mu0 = w.mu; const float* mu1 = w.mu + A_COLS;
    float S[16];
#pragma unroll
    for (int e = 0; e < 16; ++e) S[e] = 0.f;
    const int irow = (wid & 3) * 16 + (lane >> 2), jseg = lane & 3;
#pragma unroll 1
    for (int ci = 0; ci < T / SC; ++ci) {
      const int t0 = dir == 0 ? ci * SC : T - SC * (ci + 1);
      const int t = t0 + tok; const size_t row = (size_t)sq * T + t;
      { const int rr = 2 * j;
        float x[2], y2[2];
#pragma unroll
        for (int q = 0; q < 2; ++q) {
          const int cw_ = OFF_WD + dir * 32 + rr + q, ca_ = OFF_AD + dir * 32 + rr + q;
          const float cwv = bf2f(PA[row * A_COLS + cw_]), cav = bf2f(PA[row * A_COLS + ca_]);
          const float pw = t > 0 ? bf2f(PA[(row - 1) * A_COLS + cw_]) : 0.f, pa_ = t > 0 ? bf2f(PA[(row - 1) * A_COLS + ca_]) : 0.f;
          const float nw = t < T - 1 ? bf2f(PA[(row + 1) * A_COLS + cw_]) : 0.f, na = t < T - 1 ? bf2f(PA[(row + 1) * A_COLS + ca_]) : 0.f;
          x[q] = cwv + mu0[cw_] * (pw - cwv) + mu1[cw_] * (nw - cwv);
          y2[q] = cav + mu0[ca_] * (pa_ - cav) + mu1[ca_] * (na - cav);
        }
        TW[tok * 32 + rr] = tanhf(x[0]); TW[tok * 32 + rr + 1] = tanhf(x[1]);
        TA[tok * 32 + rr] = y2[0]; TA[tok * 32 + rr + 1] = y2[1];
      }
      float rv[4], kv[4];
      { const int c0 = h * 64 + j * 4;
#pragma unroll
        for (int q = 0; q < 4; ++q) {
          const int cr = c0 + q, ck = OFF_K + c0 + q;
          const float cr_ = bf2f(PA[row * A_COLS + cr]), ck_ = bf2f(PA[row * A_COLS + ck]);
          const float pr_ = t > 0 ? bf2f(PA[(row - 1) * A_COLS + cr]) : 0.f, pk_ = t > 0 ? bf2f(PA[(row - 1) * A_COLS + ck]) : 0.f;
          const float nr_ = t < T - 1 ? bf2f(PA[(row + 1) * A_COLS + cr]) : 0.f, nk_ = t < T - 1 ? bf2f(PA[(row + 1) * A_COLS + ck]) : 0.f;
          rv[q] = cr_ + mu0[cr] * (pr_ - cr_) + mu1[cr] * (nr_ - cr_);
          kv[q] = ck_ + mu0[ck] * (pk_ - ck_) + mu1[ck] * (nk_ - ck_);
        }
      }
      __syncthreads();
      { float wl[4], al[4];
        const int cc = j * 4, cg_ = h * 64 + cc;
#pragma unroll
        for (int q = 0; q < 4; ++q) { wl[q] = w.w0[dir * 512 + cg_ + q]; al[q] = w.a0[dir * 512 + cg_ + q]; }
#pragma unroll 8
        for (int rr = 0; rr < 32; ++rr) {
          const float tw = TW[tok * 32 + rr], ta = TA[tok * 32 + rr];
          const f32x4 d4 = *(const LAS f32x4*)(DU + rr * 64 + cc), i4 = *(const LAS f32x4*)(IU + rr * 64 + cc);
#pragma unroll
          for (int q = 0; q < 4; ++q) { wl[q] += tw * d4[q]; al[q] += ta * i4[q]; }
        }
        float kkv[4], ss = 0.f, bs = 0.f;
        f32x4 o_w, o_k, o_b, o_d, o_r, o_v;
#pragma unroll
        for (int q = 0; q < 4; ++q) {
          const float wlog = -softplusf_(-wl[q]) - 0.5f;
          o_w[q] = __expf(-__expf(wlog));
          const float a = sigmoidf_(al[q]);
          kkv[q] = kv[q] * w.kk_[cg_ + q]; ss += kkv[q] * kkv[q];
          o_d[q] = kv[q] * (1.f + (a - 1.f) * w.ka[cg_ + q]);
          o_b[q] = a;
          o_r[q] = rv[q];
          bs += rv[q] * o_d[q] * w.rk[cg_ + q];
          o_v[q] = bf2f(VV[row * 512 + cg_ + q]);
        }
#pragma unroll
        for (int o = 1; o < 16; o <<= 1) { ss += __shfl_xor(ss, o); bs += __shfl_xor(bs, o); }
        const float rn = rsqrtf(ss + 1e-12f);
#pragma unroll
        for (int q = 0; q < 4; ++q) { o_k[q] = kkv[q] * rn; o_b[q] *= o_k[q]; }
        *(LAS f32x4*)(AW + tok * 64 + cc) = o_w; *(LAS f32x4*)(AK + tok * 64 + cc) = o_k; *(LAS f32x4*)(AB + tok * 64 + cc) = o_b;
        *(LAS f32x4*)(AD + tok * 64 + cc) = o_d; *(LAS f32x4*)(AR + tok * 64 + cc) = o_r; *(LAS f32x4*)(AV + tok * 64 + cc) = o_v;
        if (j == 0) BON[((size_t)dir * NT + row) * 8 + h] = bs;
      }
      __syncthreads();
      if (wid < 4) {
#pragma unroll 1
        for (int st = 0; st < SC; ++st) {
          const int tt = dir == 0 ? st : SC - 1 - st;
          const int o = tt * 64 + jseg * 16;
          f32x4 k4[4], w4[4], b4[4], d4[4], r4[4];
#pragma unroll
          for (int q = 0; q < 4; ++q) { k4[q] = *(const LAS f32x4*)(AK + o + q * 4); w4[q] = *(const LAS f32x4*)(AW + o + q * 4); b4[q] = *(const LAS f32x4*)(AB + o + q * 4); d4[q] = *(const LAS f32x4*)(AD + o + q * 4); r4[q] = *(const LAS f32x4*)(AR + o + q * 4); }
          const float vi = AV[tt * 64 + irow];
          float sa = 0.f;
#pragma unroll
          for (int e = 0; e < 16; ++e) sa += S[e] * k4[e >> 2][e & 3];
          sa = -quad_sum(sa);
          float y = 0.f;
#pragma unroll
          for (int e = 0; e < 16; ++e) { S[e] = S[e] * w4[e >> 2][e & 3] + sa * b4[e >> 2][e & 3] + vi * d4[e >> 2][e & 3]; y += S[e] * r4[e >> 2][e & 3]; }
          y = quad_sum(y);
          if (jseg == 0) AY[tt * 64 + irow] = y;
        }
      }
      __syncthreads();
      { const int c0 = j * 4; const f32x4 y4 = *(const LAS f32x4*)(AY + tok * 64 + c0);
        u32x2 pk; pk.x = cvt_pk_bf16(y4[0], y4[1]); pk.y = cvt_pk_bf16(y4[2], y4[3]);
        *(u32x2*)(YY + ((size_t)dir * NT + row) * 512 + h * 64 + c0) = pk; }
    }
  }
}

DI void post_phase(LAS unsigned char* lds, u16* PA, const u16* PB, const u16* VV, const u16* YY, const float* BON, const float* mu, const float* gup, const float* gng, const float* gnb) {
  int tid = threadIdx.x; asm volatile("" : "+v"(tid));
  int bid = blockIdx.x, gdim = gridDim.x; asm volatile("" : "+s"(bid), "+s"(gdim));
  const int tok = tid >> 4, j = tid & 15;
  LAS float* sg = (LAS float*)lds;
  const float* mu0 = mu; const float* mu1 = mu + A_COLS;
  for (int it = bid; it < NT / 32; it += gdim) {
    const size_t row = (size_t)it * 32 + tok; const int t = (int)(row % T);
    __syncthreads();
#pragma unroll
    for (int q = 0; q < 6; ++q) {
      const int col = OFF_GD + j * 6 + q;
      const float c = bf2f(PA[row * A_COLS + col]);
      const float pv = t > 0 ? bf2f(PA[(row - 1) * A_COLS + col]) : 0.f, nx = t < T - 1 ? bf2f(PA[(row + 1) * A_COLS + col]) : 0.f;
      sg[tok * 96 + j * 6 + q] = sigmoidf_(c + mu0[col] * (pv - c) + mu1[col] * (nx - c));
    }
    __syncthreads();
    const int c0 = j * 32, h = j >> 1;
    float y[32]; float sm = 0.f;
#pragma unroll
    for (int q = 0; q < 4; ++q) {
      float a[8], b[8]; load_bf16x8(YY + row * 512 + c0 + q * 8, a); load_bf16x8(YY + ((size_t)NT + row) * 512 + c0 + q * 8, b);
#pragma unroll
      for (int i = 0; i < 8; ++i) { y[q * 8 + i] = a[i] + b[i]; sm += y[q * 8 + i]; }
    }
    sm += __shfl_xor(sm, 1);
    const float mean = sm * (1.f / 64.f);
    float vq = 0.f;
#pragma unroll
    for (int i = 0; i < 32; ++i) { y[i] -= mean; vq += y[i] * y[i]; }
    vq += __shfl_xor(vq, 1);
    const float rs = rsqrtf(vq * (1.f / 64.f) + GN_EPS);
    const float bon = BON[row * 8 + h] + BON[((size_t)NT + row) * 8 + h];
#pragma unroll 1
    for (int q = 0; q < 4; ++q) {
      const int cc = c0 + q * 8;
      float gacc[8];
#pragma unroll
      for (int i = 0; i < 8; ++i) gacc[i] = 0.f;
#pragma unroll 4
      for (int r = 0; r < 96; ++r) {
        const float sv = sg[tok * 96 + r];
        const f32x4 u0 = *(const f32x4*)(gup + r * 512 + cc), u1 = *(const f32x4*)(gup + r * 512 + cc + 4);
#pragma unroll
        for (int i = 0; i < 4; ++i) { gacc[i] += sv * u0[i]; gacc[4 + i] += sv * u1[i]; }
      }
      float vv[8]; load_bf16x8(VV + row * 512 + cc, vv);
      float o[8];
#pragma unroll
      for (int i = 0; i < 8; ++i) {
        float yy = 0.f;
#pragma unroll
        for (int qq = 0; qq < 4; ++qq) if (qq == q) yy = y[qq * 8 + i];
        o[i] = (yy * rs * gng[cc + i] + gnb[cc + i] + bon * vv[i]) * gacc[i];
      }
      u32x4 pk; pk.x = cvt_pk_bf16(o[0], o[1]); pk.y = cvt_pk_bf16(o[2], o[3]); pk.z = cvt_pk_bf16(o[4], o[5]); pk.w = cvt_pk_bf16(o[6], o[7]);
      if (DBGZ & 1) pk = (u32x4){0u, 0u, 0u, 0u};
      *(u32x4*)(PA + row * A_COLS + cc) = pk;
      u32x4 pb4 = *(const u32x4*)(PB + row * 1024 + cc); if (DBGZ & 2) pb4 = (u32x4){0u, 0u, 0u, 0u};
      *(u32x4*)(PA + row * A_COLS + 512 + cc) = pb4;
    }
  }
}

DI unsigned hashu(unsigned x) { x ^= x >> 16; x *= 0x7feb352du; x ^= x >> 15; x *= 0x846ca68bu; x ^= x >> 16; return x; }
DI void dbg_upd(float* slot, float got, float ref, float scale) { float e = fabsf(got - ref) / scale; if (!(e == e)) e = 1e9f; atomicMax((unsigned*)slot, __float_as_uint(e)); }
DI float tshift(const u16* PA, size_t row, int col, const float* mu) {
  const int t = (int)(row % T);
  const float c = bf2f(PA[row * A_COLS + col]);
  const float pv = t > 0 ? bf2f(PA[(row - 1) * A_COLS + col]) : 0.f, nx = t < T - 1 ? bf2f(PA[(row + 1) * A_COLS + col]) : 0.f;
  return c + mu[col] * (pv - c) + mu[A_COLS + col] * (nx - c);
}
DI void chk_proj(const u16* XB, const float* win, const u16* PA, const u16* PB, const u16* VT, float* slot) {
  const int gt = blockIdx.x * NTHREADS + threadIdx.x;
  if (gt >= 4096) return;
  const int row = hashu(gt * 2 + 1) % NT, col = hashu(gt * 2 + 2) % P_COLS;
  float ref = 0.f;
  for (int k = 0; k < D; ++k) ref += bf2f(XB[(size_t)row * D + k]) * win[(size_t)k * P_COLS + col];
  float got;
  if (col < A_COLS) got = bf2f(PA[(size_t)row * A_COLS + col]);
  else if (col < A_COLS + 1024) got = bf2f(PB[(size_t)row * 1024 + col - A_COLS]);
  else { const int c2 = col - A_COLS - 1024, h = c2 >> 7, e = c2 & 127, sq = row / T, t = row % T; got = bf2f(VT[((size_t)((sq * 4 + h) * 128 + e)) * T + t]); }
  dbg_upd(slot, got, ref, 1.f);
}
DI void chk_ffn(const u16* XB, const float* wup, const float* cw, const float* cb, const u16* G, float* slot) {
  const int gt = blockIdx.x * NTHREADS + threadIdx.x;
  if (gt >= 4096) return;
  int row = hashu(gt * 2 + 11) % NT; const int n = hashu(gt * 2 + 12) % DFF;
  if (gt < 64) row = (gt & 1) ? (row / T) * T + T - 1 : (row / T) * T;
  else if (gt < 1024) row = (row / T) * T + ((row % T) / 254) * 254 + (gt & 1 ? 253 : 0), row = row >= NT ? NT - 1 : row;
  const int t = row % T;
  float hg[3] = {0.f, 0.f, 0.f}, hu[3] = {0.f, 0.f, 0.f};
#pragma unroll
  for (int d = -1; d <= 1; ++d) {
    float a = 0.f, b = 0.f;
    if (!(t + d < 0 || t + d > T - 1))
      for (int k = 0; k < D; ++k) { const float x = bf2f(XB[(size_t)(row + d) * D + k]); a += x * wup[(size_t)k * NUP + n]; b += x * wup[(size_t)k * NUP + DFF + n]; }
    hg[d + 1] = a; hu[d + 1] = b;
  }
  const float got = bf2f(G[(size_t)row * DFF + n]);
  { const float g = cw[n] * hg[0] + cw[NUP + n] * hg[1] + cw[2 * NUP + n] * hg[2] + cb[n];
    const float u = cw[DFF + n] * hu[0] + cw[NUP + DFF + n] * hu[1] + cw[2 * NUP + DFF + n] * hu[2] + cb[DFF + n];
    dbg_upd(slot, got, 0.5f * g * (1.f + erff(g * 0.70710678f)) * u, 1.f); }
  { const float g = cw[n] * hg[2] + cw[NUP + n] * hg[1] + cw[2 * NUP + n] * hg[0] + cb[n];
    const float u = cw[DFF + n] * hu[2] + cw[NUP + DFF + n] * hu[1] + cw[2 * NUP + DFF + n] * hu[0] + cb[DFF + n];
    dbg_upd(slot + 1, got, 0.5f * g * (1.f + erff(g * 0.70710678f)) * u, 1.f); }
  { const float g = cw[NUP + n] * hg[1] + cb[n];
    const float u = cw[NUP + DFF + n] * hu[1] + cb[DFF + n];
    dbg_upd(slot + 2, got, 0.5f * g * (1.f + erff(g * 0.70710678f)) * u, 1.f); }
}
DI void chk_attn(LAS unsigned char* lds, const u16* XB, const float* win, const u16* PB, const u16* VT, const float* lamp, const float* subg, const float* relb, int layer, float* slot) {
  if (blockIdx.x >= 16) return;
  const int tid = threadIdx.x;
  LAS float* qv = (LAS float*)lds;
  LAS float* sc = qv + 128;
  LAS float* red = sc + 16384;
  LAS float* ov = red + 1024;
  const int smp = blockIdx.x;
  const int sq = hashu(smp + 77) % NSEQ, h = smp & 3;
  int q = hashu(smp + 99) % T; if (smp < 4) q = smp * 37; if (smp >= 12) q = T - 1 - (smp - 12) * 50;
  const size_t row = (size_t)sq * T + q;
  __syncthreads();
  if (tid < 128) { float a = 0.f; const int col = A_COLS + h * 128 + tid; for (int k = 0; k < D; ++k) a += bf2f(XB[row * D + k]) * win[(size_t)k * P_COLS + col]; qv[tid] = a; }
  __syncthreads();
  float mx0 = -1e30f, mx1 = -1e30f;
  for (int key = tid; key < T; key += NTHREADS) {
    const u16* kp = PB + ((size_t)sq * T + key) * 1024 + 512 + h * 128;
    float s0 = 0.f, s1 = 0.f;
    for (int d = 0; d < 64; ++d) { s0 += qv[d] * bf2f(kp[d]); s1 += qv[64 + d] * bf2f(kp[64 + d]); }
    const int rel = key - q, n = rel < 0 ? -rel : rel;
    int bk;
    if (n < 8) bk = n; else { bk = 8 + (int)(logf((float)n / 8.f) / logf(16.f) * 8.f); bk = bk > 15 ? 15 : bk; }
    if (rel > 0) bk += 16;
    const float bias = relb[bk * 4 + h];
    s0 = s0 * 0.125f + bias; s1 = s1 * 0.125f + bias;
    sc[key] = s0; sc[8192 + key] = s1; mx0 = fmaxf(mx0, s0); mx1 = fmaxf(mx1, s1);
  }
  red[tid] = mx0; red[512 + tid] = mx1; __syncthreads();
  for (int o = 256; o > 0; o >>= 1) { if (tid < o) { red[tid] = fmaxf(red[tid], red[tid + o]); red[512 + tid] = fmaxf(red[512 + tid], red[512 + tid + o]); } __syncthreads(); }
  mx0 = red[0]; mx1 = red[512]; __syncthreads();
  float l0 = 0.f, l1 = 0.f;
  for (int key = tid; key < T; key += NTHREADS) { const float p0 = expf(sc[key] - mx0), p1 = expf(sc[8192 + key] - mx1); sc[key] = p0; sc[8192 + key] = p1; l0 += p0; l1 += p1; }
  red[tid] = l0; red[512 + tid] = l1; __syncthreads();
  for (int o = 256; o > 0; o >>= 1) { if (tid < o) { red[tid] += red[tid + o]; red[512 + tid] += red[512 + tid + o]; } __syncthreads(); }
  l0 = red[0]; l1 = red[512]; __syncthreads();
  float la = 0.f, lb = 0.f; for (int d = 0; d < 64; ++d) { la += lamp[d] * lamp[64 + d]; lb += lamp[128 + d] * lamp[192 + d]; }
  const float lam_init = 0.8f - 0.6f * expf(-0.3f * (float)layer);
  const float lam = expf(la) - expf(lb) + lam_init;
  { const int e = tid & 127, part = tid >> 7;
    const u16* vp = VT + ((size_t)((sq * 4 + h) * 128 + e)) * T;
    float o = 0.f;
    for (int key = part * 2048; key < (part + 1) * 2048; ++key) o += (sc[key] / l0 - lam * sc[8192 + key] / l1) * bf2f(vp[key]);
    red[tid] = o; }
  __syncthreads();
  if (tid < 128) ov[tid] = red[tid] + red[128 + tid] + red[256 + tid] + red[384 + tid];
  __syncthreads();
  if (tid < 128) {
    float ss = 0.f; for (int e = 0; e < 128; ++e) ss += ov[e] * ov[e];
    const float ref = ov[tid] * rsqrtf(ss / 128.f + LN_EPS) * subg[tid] * (1.f - lam_init);
    dbg_upd(slot, bf2f(PB[row * 1024 + h * 128 + tid]), ref, 1.f);
  }
}
struct ChkOp { float r, kd, kk, b, w, v; };
DI ChkOp chk_ops(const u16* PA, const u16* VV, const ScanW& w, size_t row, int h, int dir, int c, LAS float* tmp  , int tid) {
  ChkOp o;
  const int cg_ = h * 64 + c;
  o.r = tshift(PA, row, cg_, w.mu);
  const float k = tshift(PA, row, OFF_K + cg_, w.mu);
  float wl = w.w0[dir * 512 + cg_], al = w.a0[dir * 512 + cg_];
#pragma unroll 1
  for (int rr = 0; rr < 32; ++rr) {
    wl += tanhf(tshift(PA, row, OFF_WD + dir * 32 + rr, w.mu)) * w.du[(dir * 32 + rr) * 512 + cg_];
    al += tshift(PA, row, OFF_AD + dir * 32 + rr, w.mu) * w.iu[(dir * 32 + rr) * 512 + cg_];
  }
  const float sp = logf(1.f + expf(-wl));
  o.w = expf(-expf(-sp - 0.5f));
  const float a = 1.f / (1.f + expf(-al));
  const float kkv = k * w.kk_[cg_];
  __syncthreads(); tmp[tid] = kkv * kkv; __syncthreads();
  float ss = 0.f;
#pragma unroll 1
  for (int j = 0; j < 64; ++j) ss += tmp[j];
  o.kk = kkv * rsqrtf(ss + 1e-12f);
  o.kd = k * (1.f + (a - 1.f) * w.ka[cg_]);
  o.b = o.kk * a;
  o.v = bf2f(VV[row * 512 + cg_]);
  return o;
}
DI void chk_scan(LAS unsigned char* lds, const u16* PA, const u16* VV, const u16* YY, const float* BON, const ScanW w, float* slot) {
  if (blockIdx.x >= 48 || threadIdx.x >= 64) return;
  const int tid = threadIdx.x;
  LAS float* tmp = (LAS float*)lds; LAS float* red = tmp + 64;
  const int item = blockIdx.x * 4 + 1, dir = item & 1, h = (item >> 1) & 7, sq = item >> 4;
  const int t0 = dir == 0 ? 0 : T - 1, t1 = dir == 0 ? 1 : T - 2;
  const size_t row0 = (size_t)sq * T + t0, row1 = (size_t)sq * T + t1;
  const ChkOp a = chk_ops(PA, VV, w, row0, h, dir, tid, tmp, tid);
  const ChkOp b = chk_ops(PA, VV, w, row1, h, dir, tid, tmp, tid);
#define BSUM(dst, val) { __syncthreads(); red[tid] = (val); __syncthreads(); float sx_ = 0.f; _Pragma("unroll 1") for (int j_ = 0; j_ < 64; ++j_) sx_ += red[j_]; dst = sx_; }
  float ds0, ds1, ds2, ds3, ds4;
  BSUM(ds0, a.kd * a.r) BSUM(ds1, a.kd * b.w * b.r) BSUM(ds2, a.kd * (-b.kk)) BSUM(ds3, b.b * b.r) BSUM(ds4, b.kd * b.r)
  const float y0 = a.v * ds0;
  const float y1 = a.v * (ds1 + ds2 * ds3) + b.v * ds4;
  dbg_upd(slot, bf2f(YY[((size_t)dir * NT + row0) * 512 + h * 64 + tid]), y0, fabsf(y0) + 0.05f);
  dbg_upd(slot, bf2f(YY[((size_t)dir * NT + row1) * 512 + h * 64 + tid]), y1, fabsf(y1) + 0.05f);
  float bq = a.r * a.kd * w.rk[h * 64 + tid];
  __syncthreads(); red[tid] = bq; __syncthreads(); float bs = 0.f;
#pragma unroll 1
  for (int j = 0; j < 64; ++j) bs += red[j];
  dbg_upd(slot, BON[((size_t)dir * NT + row0) * 8 + h], bs, fabsf(bs) + 0.05f);
}
DI void chk_post(const u16* PA, const u16* PB, const u16* VV, const u16* YY, const float* BON, const float* mu, const float* gup, const float* gng, const float* gnb, float* slot) {
  const int gt = blockIdx.x * NTHREADS + threadIdx.x;
  if (gt >= 2048) return;
  const size_t row = hashu(gt * 2 + 21) % NT; const int c = hashu(gt * 2 + 22) % 512, h = c >> 6;
  float sm = 0.f;
  float yc = 0.f;
  for (int i = 0; i < 64; ++i) { const float y = bf2f(YY[row * 512 + h * 64 + i]) + bf2f(YY[((size_t)NT + row) * 512 + h * 64 + i]); sm += y; if (h * 64 + i == c) yc = y; }
  const float mean = sm / 64.f; float vq = 0.f;
  for (int i = 0; i < 64; ++i) { const float y = bf2f(YY[row * 512 + h * 64 + i]) + bf2f(YY[((size_t)NT + row) * 512 + h * 64 + i]) - mean; vq += y * y; }
  const float yn = (yc - mean) * rsqrtf(vq / 64.f + GN_EPS) * gng[c] + gnb[c];
  const float bon = (BON[row * 8 + h] + BON[((size_t)NT + row) * 8 + h]) * bf2f(VV[row * 512 + c]);
  float g = 0.f;
  for (int r = 0; r < 96; ++r) g += (1.f / (1.f + expf(-tshift(PA, row, OFF_GD + r, mu)))) * gup[r * 512 + c];
  const float ref = (yn + bon) * g;
  dbg_upd(slot, bf2f(PA[row * A_COLS + c]), ref, fabsf(ref) + 0.05f);
  dbg_upd(slot + 1, bf2f(PA[row * A_COLS + 512 + c]), bf2f(PB[row * 1024 + c]), 1.f);
}

__global__ __launch_bounds__(NTHREADS, 2) void mega(Params p_unused) {
  extern __shared__ __attribute__((aligned(16))) char shm[];
  cg::grid_group grid = cg::this_grid();
  LAS unsigned char* lds = (LAS unsigned char*)shm;
#define WS_PTRS CParams p = get_params(); unsigned char* ws = p->ws; \
  u16* WIN = (u16*)(ws + OFF_WIN); u16* WOUT = (u16*)(ws + OFF_WOUT); u16* WUP = (u16*)(ws + OFF_WUP); u16* WDN = (u16*)(ws + OFF_WDN); \
  u16* XB = (u16*)(ws + OFF_XB); u16* PA = (u16*)(ws + OFF_PA); u16* PB = (u16*)(ws + OFF_PB); u16* VT = (u16*)(ws + OFF_VT); \
  u16* G = (u16*)(ws + OFF_PA); u16* VV = (u16*)(ws + OFF_VV); u16* YY = (u16*)(ws + OFF_XB); float* BON = (float*)(ws + OFF_BON); float* XF = p->out; \
  (void)WIN; (void)WOUT; (void)WUP; (void)WDN; (void)XB; (void)PA; (void)PB; (void)VT; (void)G; (void)VV; (void)YY; (void)BON; (void)XF;
  int ph = 0;
  const int ph_lo = get_params()->ph_lo, ph_hi = get_params()->ph_hi;
#ifndef ONLYMASK
#define ONLYMASK 0xffffffffu
#endif
#define PHASE_BEGIN if (((ONLYMASK >> (__COUNTER__ % 32)) & 1u) && ph >= ph_lo && ph < ph_hi) { WS_PTRS
#define PHASE_END } ++ph; if (ph > ph_lo && ph < ph_hi) grid.sync();

  PHASE_BEGIN
    for (int l = 0; l < 2; ++l) {
      convert_weight<0>(shm, p->in[4] + (size_t)l * D * P_COLS, WIN + (size_t)l * NPROJ * D, D, P_COLS, NPROJ, blockIdx.x, gridDim.x);
      convert_weight<1>(shm, p->in[22] + (size_t)l * D * D, WOUT + (size_t)l * D * D, D, D, D, blockIdx.x, gridDim.x);
      convert_weight<2>(shm, p->in[25] + (size_t)l * D * NUP, WUP + (size_t)l * NUP * D, D, NUP, NUP, blockIdx.x, gridDim.x);
      convert_weight<1>(shm, p->in[28] + (size_t)l * DFF * D, WDN + (size_t)l * D * DFF, DFF, D, D, blockIdx.x, gridDim.x);
    }
    ln_rows(p->in[0], p->in[1], NPROMPT_TOK, XF, XB, p->in[2], p->in[3]);
  PHASE_END

#pragma unroll 1
  for (int l = 0; l < 2; ++l) {
    PHASE_BEGIN
      Gemm ga{XB, D, WIN + (size_t)l * NPROJ * D, D};
      EpiArgs ea{}; ea.pa = PA; ea.pb = PB; ea.vt = VT;
      gemm_phase<0, 0>(lds, ga, NT / 256, NPROJ / 256, ea);
    PHASE_END
    PHASE_BEGIN
      vprep_phase(lds, PA, VV, p->in[5] + (size_t)l * 2 * A_COLS, p->in[16], p->in[17], p->in[18], l);
      attn_phase(lds, PB, VT, (float*)(ws + OFF_OSV), p->in[19] + l * 256, p->in[20] + l * 128, p->in[21], l);
    PHASE_END
    PHASE_BEGIN
      ScanW sw; sw.mu = p->in[5] + (size_t)l * 2 * A_COLS; sw.w0 = p->in[6] + l * 1024; sw.du = p->in[7] + (size_t)l * 2 * 32 * 512; sw.a0 = p->in[8] + l * 1024;
      sw.iu = p->in[9] + (size_t)l * 2 * 32 * 512; sw.kk_ = p->in[11] + l * 512; sw.ka = p->in[12] + l * 512; sw.rk = p->in[13] + l * 512;
      scan_phase(lds, PA, VV, YY, BON, sw);
    PHASE_END
    PHASE_BEGIN
      post_phase(lds, PA, PB, VV, YY, BON, p->in[5] + (size_t)l * 2 * A_COLS, p->in[10] + (size_t)l * 96 * 512, p->in[14] + l * 512, p->in[15] + l * 512);
    PHASE_END
    PHASE_BEGIN
      Gemm ga{PA, A_COLS, WOUT + (size_t)l * D * D, D};
      EpiArgs ea{}; ea.xf = XF;
      gemm_phase<1, 0>(lds, ga, NT / 256, D / 256, ea);
    PHASE_END
    PHASE_BEGIN
      ln_rows(XF, XF, NT, XF, XB, p->in[23] + l * D, p->in[24] + l * D);
    PHASE_END
    PHASE_BEGIN
      Gemm ga{XB, D, WUP + (size_t)l * NUP * D, D};
      EpiArgs ea{}; ea.g = G; ea.cw = p->in[26] + (size_t)l * 3 * NUP; ea.cb = p->in[27] + (size_t)l * NUP;
      gemm_phase<2, 1>(lds, ga, NSEQ * 33, NUP / 256, ea);
    PHASE_END
    PHASE_BEGIN
      Gemm ga{G, DFF, WDN + (size_t)l * D * DFF, DFF};
      EpiArgs ea{}; ea.xf = XF; ea.zero = (DBGZ & 4) ? 1 : 0;
      gemm_phase<1, 0>(lds, ga, NT / 256, D / 256, ea);
    PHASE_END
    PHASE_BEGIN
      ln_rows(XF, XF, NT, XF, XB, p->in[29] + l * D, p->in[30] + l * D);
    PHASE_END
  }
}

#if DBG
#define DPTRS unsigned char* ws = p.ws; u16* XB = (u16*)(ws + OFF_XB); u16* PA = (u16*)(ws + OFF_PA); u16* PB = (u16*)(ws + OFF_PB); u16* VT = (u16*)(ws + OFF_VT); \
  u16* G = (u16*)(ws + OFF_PA); u16* VV = (u16*)(ws + OFF_VV); u16* YY = (u16*)(ws + OFF_XB); float* BON = (float*)(ws + OFF_BON); float* DE = (float*)(ws + OFF_DBG); \
  (void)XB; (void)PA; (void)PB; (void)VT; (void)G; (void)VV; (void)YY; (void)BON; (void)DE;
template <int which> __global__ __launch_bounds__(NTHREADS) void k_chk(Params p, int l) {
  extern __shared__ __attribute__((aligned(16))) char shm[];
  LAS unsigned char* lds = (LAS unsigned char*)shm;
  DPTRS
  if (which == 0) chk_proj(XB, p.in[4] + (size_t)l * D * P_COLS, PA, PB, VT, DE + 0);
  else if (which == 1) chk_attn(lds, XB, p.in[4] + (size_t)l * D * P_COLS, PB, VT, p.in[19] + l * 256, p.in[20] + l * 128, p.in[21], l, DE + 1);
  else if (which == 2) {
    ScanW sw; sw.mu = p.in[5] + (size_t)l * 2 * A_COLS; sw.w0 = p.in[6] + l * 1024; sw.du = p.in[7] + (size_t)l * 2 * 32 * 512; sw.a0 = p.in[8] + l * 1024;
    sw.iu = p.in[9] + (size_t)l * 2 * 32 * 512; sw.kk_ = p.in[11] + l * 512; sw.ka = p.in[12] + l * 512; sw.rk = p.in[13] + l * 512;
    chk_scan(lds, PA, VV, YY, BON, sw, DE + 2);
  } else if (which == 3) chk_post(PA, PB, VV, YY, BON, p.in[5] + (size_t)l * 2 * A_COLS, p.in[10] + (size_t)l * 96 * 512, p.in[14] + l * 512, p.in[15] + l * 512, DE + 3);
  else if (which == 5) chk_ffn(XB, p.in[25] + (size_t)l * D * NUP, p.in[26] + (size_t)l * 3 * NUP, p.in[27] + (size_t)l * NUP, G, DE + 5);
}
__global__ __launch_bounds__(NTHREADS) void k_encode(Params p) {
  const float* e = (const float*)(p.ws + OFF_DBG);
  const float eA = fmaxf(e[DBG_A], 1e-4f), eB = fmaxf(e[DBG_B], 1e-4f);
  const float V1 = 100.f + 100.f * log10f(eA / 1e-3f);
  float V2 = 1.f + log10f(eB / 1e-3f); V2 = fminf(fmaxf(V2, 0.3f), 8.f);
  const size_t n0 = (size_t)NPROMPT_TOK * D, n1 = (size_t)NT * D;
  for (size_t i = (size_t)blockIdx.x * NTHREADS + threadIdx.x; i < n1; i += (size_t)gridDim.x * NTHREADS) {
    float v = 0.f;
    if (i == 0 || i == n0) v = V1;
    else if (i < n0 / 2 || (i > n0 && i < n0 + (n1 - n0) / 2)) v = V2;
    p.out[i] = v;
  }
}
#endif

extern "C" void kernel_launch(void* const* d_in, const int* in_sizes, int n_in, void* d_out, int out_size, void* d_ws, size_t ws_size, hipStream_t stream) {
  static int grid = 0;
  if (grid == 0) {
    if (ws_size < WS_END) { fprintf(stderr, "ws too small: %zu < %zu\n", ws_size, (size_t)WS_END); grid = -1; return; }
    int dev = 0, cus = 0, per_cu = 0;
    hipGetDevice(&dev);
    hipDeviceGetAttribute(&cus, hipDeviceAttributeMultiprocessorCount, dev);
    hipFuncSetAttribute((const void*)mega, hipFuncAttributeMaxDynamicSharedMemorySize, LDS_BYTES);
#if DBG
    hipFuncSetAttribute((const void*)k_chk<1>, hipFuncAttributeMaxDynamicSharedMemorySize, 81920);
    hipFuncSetAttribute((const void*)k_chk<2>, hipFuncAttributeMaxDynamicSharedMemorySize, 81920);
#endif
    hipOccupancyMaxActiveBlocksPerMultiprocessor(&per_cu, (const void*)mega, NTHREADS, LDS_BYTES);
    if (per_cu < 1) per_cu = 1;
    grid = cus * 1;
  }
  if (grid < 0) return;
  Params p{};
  for (int i = 0; i < 31; ++i) p.in[i] = (const float*)d_in[i];
  p.out = (float*)d_out; p.ws = (unsigned char*)d_ws;
#if DBG
  hipMemsetAsync((char*)d_ws + OFF_DBG, 0, 256, stream);
  auto seg = [&](int lo, int hi) { Params q = p; q.ph_lo = lo; q.ph_hi = hi; void* a2[] = {&q};
    hipError_t e = hipLaunchCooperativeKernel((const void*)mega, dim3(grid), dim3(NTHREADS), a2, LDS_BYTES, stream);
    if (e != hipSuccess) fprintf(stderr, "cooperative launch failed: %s\n", hipGetErrorString(e)); };
  auto chk = [&](int l, int which) {
    if (which == 0) hipLaunchKernelGGL(k_chk<0>, dim3(64), dim3(NTHREADS), 81920, stream, p, l);
    if (which == 1) hipLaunchKernelGGL(k_chk<1>, dim3(64), dim3(NTHREADS), 81920, stream, p, l);
    if (which == 2) hipLaunchKernelGGL(k_chk<2>, dim3(64), dim3(NTHREADS), 81920, stream, p, l);
    if (which == 3) hipLaunchKernelGGL(k_chk<3>, dim3(64), dim3(NTHREADS), 81920, stream, p, l);
    if (which == 5) hipLaunchKernelGGL(k_chk<5>, dim3(64), dim3(NTHREADS), 81920, stream, p, l); };
  seg(0, 1);
  for (int l = 0; l < 2; ++l) {
    const int b = 1 + 9 * l;
    seg(b, b + 1); chk(l, 0);
    seg(b + 1, b + 2); chk(l, 1);
    seg(b + 2, b + 3); chk(l, 2);
    seg(b + 3, b + 4); chk(l, 3);
    seg(b + 4, b + 7); if (l == 0) chk(l, 5);
    seg(b + 7, b + 9);
  }
  hipLaunchKernelGGL(k_encode, dim3(1024), dim3(NTHREADS), 0, stream, p);
#else
  p.ph_lo = 0; p.ph_hi = 1000;
  void* args[] = {&p};
  hipError_t e = hipLaunchCooperativeKernel((const void*)mega, dim3(grid), dim3(NTHREADS), args, LDS_BYTES, stream);
  if (e != hipSuccess) fprintf(stderr, "cooperative launch failed: %s (grid %d)\n", hipGetErrorString(e), grid);
#endif
}
```

```cpp
#include <hip/hip_runtime.h>
#include <hip/hip_bf16.h>
#include <hip/hip_cooperative_groups.h>
#include <cstdio>
namespace cg = cooperative_groups;

#define DI __device__ __forceinline__
using bf16 = __hip_bfloat16;
using bf16x8 = __attribute__((ext_vector_type(8))) short;
using s16x4 = __attribute__((ext_vector_type(4))) short;
using f32x4 = __attribute__((ext_vector_type(4))) float;
using f32x16 = __attribute__((ext_vector_type(16))) float;
typedef unsigned short u16;
typedef unsigned u32x4 __attribute__((ext_vector_type(4)));
typedef unsigned u32x2 __attribute__((ext_vector_type(2)));

constexpr int D = 1024, T = 8192, NSEQ = 12, NT = NSEQ * T;
constexpr int NPROMPT_TOK = 4 * T;
constexpr int A_COLS = 1760, P_COLS = 3296, NPROJ = 3328;
constexpr int DFF = 2816, NUP = 5632;
constexpr int OFF_K = 512, OFF_V = 1024, OFF_WD = 1536, OFF_AD = 1600, OFF_GD = 1664;
constexpr float ALPHA = 1.4142135623730951f;
constexpr float LN_EPS = 1e-5f, GN_EPS = 64e-5f;
constexpr int NTHREADS = 512;
#ifndef DBGZ
#define DBGZ 0
#define DBG 0
#define PROBE_SCAN 0
#ifndef CHK_PROJ_ON
#define CHK_PROJ_ON 1
#endif
#ifndef CHK_ATTN_ON
#define CHK_ATTN_ON 1
#endif
#ifndef CHK_SCAN_ON
#define CHK_SCAN_ON 1
#endif
#ifndef CHK_POST_ON
#define CHK_POST_ON 1
#endif
#ifndef CHK_FFN_ON
#define CHK_FFN_ON 1
#endif
#define DBG_A 5
#define DBG_B 6
#define DBGTHR 0.05f, 0.1f, 0.1f, 0.1f, 0.01f, 0.05f
#endif
constexpr int LDS_BYTES = 163840;

constexpr size_t SZ_WIN = (size_t)2 * NPROJ * D * 2;
constexpr size_t SZ_WOUT = (size_t)2 * D * D * 2;
constexpr size_t SZ_WUP = (size_t)2 * NUP * D * 2;
constexpr size_t SZ_WDN = (size_t)2 * D * DFF * 2;
constexpr size_t OFF_WIN = 0;
constexpr size_t OFF_WOUT = OFF_WIN + SZ_WIN;
constexpr size_t OFF_WUP = OFF_WOUT + SZ_WOUT;
constexpr size_t OFF_WDN = OFF_WUP + SZ_WUP;
constexpr size_t OFF_XB = OFF_WDN + SZ_WDN;
constexpr size_t OFF_PA = OFF_XB + (size_t)NT * D * 2;
constexpr size_t OFF_PB = OFF_PA + (size_t)NT * A_COLS * 2;
constexpr size_t OFF_VT = OFF_PB + (size_t)NT * 1024 * 2;
constexpr size_t OFF_VV = OFF_VT + (size_t)NT * 512 * 2;
constexpr size_t OFF_BON = OFF_VV + (size_t)NT * 512 * 2;
constexpr size_t OFF_OSV = OFF_BON + (size_t)2 * NT * 8 * 4;
constexpr size_t OFF_DBG = OFF_OSV + (size_t)256 * 64 * 512 * 4;
constexpr size_t WS_END = OFF_DBG + 256;
static_assert((size_t)NT * DFF * 2 <= (OFF_VV - OFF_PA), "G alias");

struct Params {
  const float* in[31];
  float* out;
  unsigned char* ws;
  int ph_lo, ph_hi;
};

typedef const __attribute__((address_space(4))) Params* CParams;
DI CParams get_params() { CParams pp = (CParams)__builtin_amdgcn_kernarg_segment_ptr(); asm volatile("" : "+s"(pp)); return pp; }

DI u16 f2bf(float x) { unsigned u = __float_as_uint(x); u += 0x7fffu + ((u >> 16) & 1u); return (u16)(u >> 16); }
DI float bf2f(u16 b) { return __uint_as_float(((unsigned)b) << 16); }
DI float sigmoidf_(float x) { return 1.f / (1.f + __expf(-x)); }

template <int MODE> DI int src_col(int n) {
  if (MODE == 0) { return n < A_COLS ? n : (n < 1792 ? -1 : n - 32); }
  if (MODE == 2) { int j = n >> 8, i = n & 255; return i < 128 ? j * 128 + i : DFF + j * 128 + (i - 128); }
  return n;
}
template <int MODE>
DI void convert_weight(char* shm, const float* W, u16* WT, int K, int Nsrc, int Ndst, int gtid_block, int nblocks) {
  float* tile = (float*)shm;
  int tn = Ndst / 64, tk = K / 64;
  for (int t = gtid_block; t < tn * tk; t += nblocks) {
    int n0 = (t / tk) * 64, k0 = (t % tk) * 64;
    __syncthreads();
    for (int e = threadIdx.x; e < 4096; e += NTHREADS) {
      int kk = e >> 6, nn = e & 63;
      int sc = src_col<MODE>(n0 + nn);
      tile[kk * 65 + nn] = sc >= 0 ? W[(size_t)(k0 + kk) * Nsrc + sc] : 0.f;
    }
    __syncthreads();
    for (int e = threadIdx.x; e < 4096; e += NTHREADS) {
      int nn = e >> 6, kk = e & 63;
      WT[(size_t)(n0 + nn) * K + k0 + kk] = f2bf(tile[kk * 65 + nn]);
    }
  }
}

DI void ln_rows(const float* srcA, const float* srcB, int splitRow, float* dstF, u16* dstB, const float* g, const float* b) {
  int tid = threadIdx.x; asm volatile("" : "+v"(tid));
  int bid = blockIdx.x, gdim = gridDim.x; asm volatile("" : "+s"(bid), "+s"(gdim));
  int wave = tid >> 6, lane = tid & 63;
  int gw = bid * 8 + wave, nw = gdim * 8;
  float4 gg[4], bb[4];
  for (int i = 0; i < 4; ++i) { gg[i] = *(const float4*)(g + i * 256 + lane * 4); bb[i] = *(const float4*)(b + i * 256 + lane * 4); }
  for (int row = gw; row < NT; row += nw) {
    const float* src = row < splitRow ? srcA + (size_t)row * D : srcB + (size_t)(row - splitRow) * D;
    float4 v[4]; float s = 0.f;
    for (int i = 0; i < 4; ++i) { v[i] = *(const float4*)(src + i * 256 + lane * 4); s += v[i].x + v[i].y + v[i].z + v[i].w; }
    for (int o = 32; o > 0; o >>= 1) s += __shfl_xor(s, o);
    float mu = s * (1.f / D), q = 0.f;
    for (int i = 0; i < 4; ++i) { v[i].x -= mu; v[i].y -= mu; v[i].z -= mu; v[i].w -= mu; q += v[i].x * v[i].x + v[i].y * v[i].y + v[i].z * v[i].z + v[i].w * v[i].w; }
    for (int o = 32; o > 0; o >>= 1) q += __shfl_xor(q, o);
    float rs = rsqrtf(q * (1.f / D) + LN_EPS);
    for (int i = 0; i < 4; ++i) {
      float4 o4; o4.x = v[i].x * rs * gg[i].x + bb[i].x; o4.y = v[i].y * rs * gg[i].y + bb[i].y; o4.z = v[i].z * rs * gg[i].z + bb[i].z; o4.w = v[i].w * rs * gg[i].w + bb[i].w;
      *(float4*)(dstF + (size_t)row * D + i * 256 + lane * 4) = o4;
      ushort4 h; h.x = f2bf(o4.x); h.y = f2bf(o4.y); h.z = f2bf(o4.z); h.w = f2bf(o4.w);
      *(ushort4*)(dstB + (size_t)row * D + i * 256 + lane * 4) = h;
    }
  }
}

#define LAS __attribute__((address_space(3)))
constexpr int BK = 64, HALF = 128, HTB = HALF * BK * 2, STAGE_BYTES = 8 * HTB;
DI int lds_byte(int r, int c) { const int st = (r >> 4) * 2 + (c >> 5), rr = r & 15, cc = c & 31, ob = rr * 64 + cc * 2; return st * 1024 + (ob ^ (((ob >> 9) & 1) << 5)); }
DI void stage_rc(int b, int& R, int& C) { const int st = b / 1024, sb = b % 1024, swz = sb ^ (((sb >> 9) & 1) << 5); R = (st >> 1) * 16 + swz / 64; C = (st & 1) * 32 + (swz % 64) / 2; }
DI int perm32(int rho) { const int n = rho >> 4, i = rho & 15; return 8 * (i >> 2) + 4 * n + (i & 3); }
DI unsigned cvt_pk_bf16(float lo, float hi) { unsigned r; asm volatile("v_cvt_pk_bf16_f32 %0, %1, %2" : "=v"(r) : "v"(lo), "v"(hi)); return r; }

typedef float f32x2 __attribute__((ext_vector_type(2)));
DI float gelu1(float v) {
  const float av = __builtin_fabsf(v), d = av * 0.2316418882f + 1.0f;
  const float t = __builtin_amdgcn_rcpf(d);
  float q = t * 0.5307027145f + (-0.7265760135f); q = q * t + 0.7107068705f; q = q * t + (-0.142248368f); q = q * t + 0.127414796f; q = q * t;
  const float e = __builtin_amdgcn_exp2f((v * v) * (-0.72134752044f));
  const float m = v * (q * e), r = v - m;
  return v < 0.f ? m : r;
}
DI float dpp_shr1(float old, float src) { asm volatile("s_nop 1\n\tv_mov_b32_dpp %0, %1 row_shr:1 row_mask:0xf bank_mask:0xf\n\ts_nop 0" : "+v"(old) : "v"(src) : "memory"); return old; }
DI float dpp_shl1(float old, float src) { asm volatile("s_nop 1\n\tv_mov_b32_dpp %0, %1 row_shl:1 row_mask:0xf bank_mask:0xf\n\ts_nop 0" : "+v"(old) : "v"(src) : "memory"); return old; }
struct Unit { int pm, pn; };
struct Order {
  int nM, nN, nwg, G, c;
  DI void init(int nM_, int nN_, int G_, int c_) { nM = nM_; nN = nN_; nwg = nM * nN; G = G_; c = c_; }
  DI bool next(int i, Unit& u) const {
    const long Lq = (long)i * G + c; if (Lq >= nwg) return false;
    int wgid = (int)Lq; { const int q = nwg / 8, r = nwg % 8, xcd = wgid % 8, off = wgid / 8; wgid = (xcd < r ? xcd * (q + 1) : r * (q + 1) + (xcd - r) * q) + off; }
    const int nig = 8 * nN, gid = wgid / nig, fm = gid * 8, gsz = (nM - fm) < 8 ? (nM - fm) : 8;
    u.pm = fm + ((wgid % nig) % gsz); u.pn = (wgid % nig) / gsz; return true;
  }
};
struct Gemm { const u16* A; int lda; const u16* Bt; int K; };
template <int ROWMODE> DI const char* a_tile_ptr(const Gemm& g, int pm) {
  long row = ROWMODE == 0 ? (long)pm * 256 : (long)(pm / 33) * T + 254 * (pm % 33) - 1;
  return (const char*)g.A + row * g.lda * 2;
}
struct EpiArgs {
  u16* pa; u16* pb; u16* vt;
  float* xf;
  u16* g; const float* cw; const float* cb;
  int zero;
};
template <int EPI>
DI void epilogue(f32x4 (&acc)[2][2][4][2], const Unit& u, const EpiArgs& ea, LAS unsigned char* lds) {
  int tid2 = threadIdx.x; asm volatile("" : "+v"(tid2));
  const int wid2 = tid2 >> 6, lane2 = tid2 & 63, wr = wid2 >> 2, wc = wid2 & 3, fr = lane2 & 15, fq = lane2 >> 4;
  if (EPI == 0) {
    const int row0 = u.pm * 256 + wr * 64 + fr;
#pragma unroll
    for (int ai = 0; ai < 2; ++ai)
#pragma unroll
      for (int m = 0; m < 4; ++m) {
        const int row = row0 + ai * HALF + m * 16;
#pragma unroll
        for (int bj = 0; bj < 2; ++bj) {
          const int col = u.pn * 256 + bj * HALF + wc * 32 + 8 * fq;
          const f32x4 a0 = acc[ai][bj][m][0], a1 = acc[ai][bj][m][1];
          if (u.pn <= 10) {
            uint4 pk; pk.x = cvt_pk_bf16(a0[0], a0[1]); pk.y = cvt_pk_bf16(a0[2], a0[3]); pk.z = cvt_pk_bf16(a1[0], a1[1]); pk.w = cvt_pk_bf16(a1[2], a1[3]);
            if (u.pn <= 6) { if (col < A_COLS) *(uint4*)(ea.pa + (size_t)row * A_COLS + col) = pk; }
            else *(uint4*)(ea.pb + (size_t)row * 1024 + (col - 1792)) = pk;
          } else {
            const int c2 = col - 2816, h = c2 >> 7, e = c2 & 127, seq = row / T, t = row % T;
            u16* dst = ea.vt + ((size_t)((seq * 4 + h) * 128 + e)) * T + t;
#pragma unroll
            for (int j = 0; j < 4; ++j) { dst[(size_t)j * T] = f2bf(a0[j]); dst[(size_t)(4 + j) * T] = f2bf(a1[j]); }
          }
        }
      }
  } else if (EPI == 1) {
    const int row0 = u.pm * 256 + wr * 64 + fr, col0 = u.pn * 256 + wc * 32 + 4 * fq;
#pragma unroll
    for (int ai = 0; ai < 2; ++ai)
#pragma unroll
      for (int m = 0; m < 4; ++m) {
        float* rowp = ea.xf + (size_t)(row0 + ai * HALF + m * 16) * D + col0;
#pragma unroll
        for (int bj = 0; bj < 2; ++bj)
#pragma unroll
          for (int n = 0; n < 2; ++n) { f32x4* p4 = (f32x4*)(rowp + bj * HALF + n * 16); f32x4 x = *p4; *p4 = ea.zero ? x * ALPHA : x * ALPHA + acc[ai][bj][m][n]; }
      }
  } else {
    LAS float* E = (LAS float*)(lds + STAGE_BYTES);
    const int seq = u.pm / 33, ti = u.pm % 33;
    const int cl0 = wc * 32 + 8 * fq;
#pragma unroll
    for (int ai = 0; ai < 2; ++ai)
#pragma unroll
      for (int m = 0; m < 4; ++m) {
        const int rl = ai * HALF + wr * 64 + m * 16 + fr;
        const int tok = 254 * ti - 1 + rl;
        const bool valid = tok >= 0 && tok < T;
        const int blk = ai * 8 + wr * 4 + m;
#pragma unroll
        for (int bj = 0; bj < 2; ++bj)
#pragma unroll
          for (int n = 0; n < 2; ++n) {
            if (!valid) acc[ai][bj][m][n] = (f32x4){0.f, 0.f, 0.f, 0.f};
            if (fr == 0) *(LAS f32x4*)(E + ((blk * 2 + 0) * 2 + bj) * 128 + cl0 + 4 * n) = acc[ai][bj][m][n];
            if (fr == 15) *(LAS f32x4*)(E + ((blk * 2 + 1) * 2 + bj) * 128 + cl0 + 4 * n) = acc[ai][bj][m][n];
          }
      }
    asm volatile("s_waitcnt lgkmcnt(0)" ::: "memory");
    __builtin_amdgcn_s_barrier(); asm volatile("" ::: "memory");
    __builtin_amdgcn_s_barrier(); asm volatile("" ::: "memory");
#pragma unroll
    for (int n = 0; n < 2; ++n) {
      const int hid = u.pn * 128 + cl0 + 4 * n;
      const float* cwp = ea.cw + hid;
      const f32x4 g0 = *(const f32x4*)(cwp), g1 = *(const f32x4*)(cwp + NUP), g2 = *(const f32x4*)(cwp + 2 * NUP), gb = *(const f32x4*)(ea.cb + hid);
      const f32x4 u0 = *(const f32x4*)(cwp + DFF), u1 = *(const f32x4*)(cwp + DFF + NUP), u2 = *(const f32x4*)(cwp + DFF + 2 * NUP), ub = *(const f32x4*)(ea.cb + DFF + hid);
#pragma unroll
      for (int ai = 0; ai < 2; ++ai)
#pragma unroll
        for (int m = 0; m < 4; ++m) {
          const int blk = ai * 8 + wr * 4 + m;
          const int rl = ai * HALF + wr * 64 + m * 16 + fr;
          const int tok = 254 * ti - 1 + rl;
          f32x4 hh[2];
#pragma unroll
          for (int bj = 0; bj < 2; ++bj) {
            const f32x4 cur = acc[ai][bj][m][n];
            f32x4 ab = (f32x4){0.f, 0.f, 0.f, 0.f}, be = (f32x4){0.f, 0.f, 0.f, 0.f};
            if (fr == 0 && blk > 0) ab = *(LAS f32x4*)(E + (((blk - 1) * 2 + 1) * 2 + bj) * 128 + cl0 + 4 * n);
            if (fr == 15 && blk < 15) be = *(LAS f32x4*)(E + (((blk + 1) * 2 + 0) * 2 + bj) * 128 + cl0 + 4 * n);
            f32x4 prev, next;
#pragma unroll
            for (int j = 0; j < 4; ++j) { prev[j] = dpp_shr1(ab[j], cur[j]); next[j] = dpp_shl1(be[j], cur[j]); }
            hh[bj] = bj == 0 ? g0 * prev + g1 * cur + g2 * next + gb : u0 * prev + u1 * cur + u2 * next + ub;
          }
          f32x4 res;
#pragma unroll
          for (int j = 0; j < 4; ++j) res[j] = gelu1(hh[0][j]) * hh[1][j];
          if (rl >= 1 && rl <= 254 && tok < T) {
            u32x2 pk; pk.x = cvt_pk_bf16(res[0], res[1]); pk.y = cvt_pk_bf16(res[2], res[3]);
            *(u32x2*)(ea.g + (size_t)(seq * T + tok) * DFF + hid) = pk;
          }
        }
    }
  }
}

template <int EPI, int ROWMODE>
DI void gemm_phase(LAS unsigned char* lds, const Gemm g, int nM, int nN, const EpiArgs& ea) {
  constexpr bool PERM = (EPI != 1);
  int tid = threadIdx.x; asm volatile("" : "+v"(tid));
  int bid = blockIdx.x, gdim = gridDim.x; asm volatile("" : "+s"(bid), "+s"(gdim));
  const int wid = __builtin_amdgcn_readfirstlane(tid >> 6), lane = tid & 63, wr = wid >> 2, wc = wid & 3, fr = lane & 15, fq = lane >> 4;
  const int K = g.K, nt = K / BK;
  Order S; S.init(nM, nN, gdim, bid);
  unsigned voffA[2], voffB[2];
#pragma unroll
  for (int i = 0; i < 2; ++i) { int R, C; stage_rc(tid * 16 + i * 8192, R, C); const int Rb = PERM ? ((R & ~31) + perm32(R & 31)) : R;
    voffA[i] = (unsigned)(R * g.lda + C) * 2u; voffB[i] = (unsigned)(Rb * K + C) * 2u; }
  const size_t kstep = (size_t)(BK * 2);
  const size_t hstepA = (size_t)HALF * g.lda * 2, hstepB = (size_t)HALF * K * 2;
  const unsigned ldsw = (unsigned)wid * 1024u;
  const int aoff = lds_byte(wr * 64 + fr, fq * 8), boff = lds_byte(wc * 32 + fr, fq * 8);
#define PG8_SA(b, h) (((b) * 2 + (h)) * HTB)
#define PG8_SB(b, h) ((4 + (b) * 2 + (h)) * HTB)
#define PG8_STAGE(bufoff, gbase, voff) do { _Pragma("unroll") for (int _i = 0; _i < 2; ++_i) \
    __builtin_amdgcn_global_load_lds((const unsigned*)((const char*)(gbase) + (voff)[_i]), (LAS unsigned*)(lds + (bufoff) + ldsw + _i * 8192), 16, 0, 0); } while (0)
#define PG8_LDA(dst, b, h) do { _Pragma("unroll") for (int m = 0; m < 4; ++m) _Pragma("unroll") for (int k = 0; k < 2; ++k) dst[m][k] = *(const LAS bf16x8*)(lds + PG8_SA(b, h) + aoff + m * 2048 + k * 1024); } while (0)
#define PG8_LDB(dst, b, h) do { _Pragma("unroll") for (int n = 0; n < 2; ++n) _Pragma("unroll") for (int k = 0; k < 2; ++k) dst[n][k] = *(const LAS bf16x8*)(lds + PG8_SB(b, h) + boff + n * 2048 + k * 1024); } while (0)
#define PG8_MMA(ai, bj, At, Bq) do { __builtin_amdgcn_s_setprio(1); _Pragma("unroll") for (int m = 0; m < 4; ++m) _Pragma("unroll") for (int n = 0; n < 2; ++n) _Pragma("unroll") for (int k = 0; k < 2; ++k) \
    acc[ai][bj][m][n] = __builtin_amdgcn_mfma_f32_16x16x32_bf16(Bq[n][k], At[m][k], acc[ai][bj][m][n], 0, 0, 0); __builtin_amdgcn_s_setprio(0); } while (0)
#define PG8_WAIT_V(n) asm volatile("s_waitcnt vmcnt(" #n ")" ::: "memory")
#define PG8_WAIT_L(n) asm volatile("s_waitcnt lgkmcnt(" #n ")" ::: "memory")
#define PG8_BAR __builtin_amdgcn_s_barrier()
#define PG8_SCHED __builtin_amdgcn_sched_barrier(0)
  Unit cur, nxt; int ui = 0;
  __syncthreads();
  if (!S.next(0, cur)) return;
  f32x4 acc[2][2][4][2];
#pragma unroll
  for (int a = 0; a < 2; ++a)
#pragma unroll
    for (int b = 0; b < 2; ++b)
#pragma unroll
      for (int m = 0; m < 4; ++m)
#pragma unroll
        for (int n = 0; n < 2; ++n) acc[a][b][m][n] = (f32x4){0.f, 0.f, 0.f, 0.f};
  bf16x8 At[4][2], B0[2][2], B1[2][2];
  const char* cA = a_tile_ptr<ROWMODE>(g, cur.pm); const char* cB = (const char*)g.Bt + (size_t)cur.pn * 2 * hstepB;
  PG8_STAGE(PG8_SB(0, 0), cB, voffB); PG8_STAGE(PG8_SA(0, 0), cA, voffA); PG8_STAGE(PG8_SB(0, 1), cB + hstepB, voffB); PG8_STAGE(PG8_SA(0, 1), cA + hstepA, voffA);
  if (wr == 1) PG8_BAR;
  PG8_WAIT_V(4); PG8_BAR;
  PG8_STAGE(PG8_SB(1, 0), cB + kstep, voffB); PG8_STAGE(PG8_SA(1, 0), cA + kstep, voffA); PG8_STAGE(PG8_SB(1, 1), cB + hstepB + kstep, voffB);
  PG8_WAIT_V(6); PG8_BAR;
  for (;;) {
    const bool has_next = S.next(ui + 1, nxt);
    const char* nA = has_next ? a_tile_ptr<ROWMODE>(g, nxt.pm) : cA; const char* nB = has_next ? (const char*)g.Bt + (size_t)nxt.pn * 2 * hstepB : cB;
    for (int t = 0; t < nt; t += 2) {
      const bool last = (t == nt - 2);
      const char* a1 = cA + (size_t)(t + 1) * kstep;
      const char* a2 = last ? nA : cA + (size_t)(t + 2) * kstep; const char* b2 = last ? nB : cB + (size_t)(t + 2) * kstep;
      const char* a3 = a2 + kstep; const char* b3 = b2 + kstep;
      PG8_LDB(B0, 0, 0); PG8_SCHED; PG8_LDA(At, 0, 0); PG8_STAGE(PG8_SA(1, 1), a1 + hstepA, voffA);
      PG8_WAIT_L(8); PG8_BAR; PG8_WAIT_L(0); PG8_MMA(0, 0, At, B0); PG8_BAR; PG8_SCHED;
      PG8_LDB(B1, 0, 1); PG8_STAGE(PG8_SB(0, 0), b2, voffB);
      PG8_BAR; PG8_WAIT_L(0); PG8_MMA(0, 1, At, B1); PG8_BAR;
      PG8_LDA(At, 0, 1); PG8_STAGE(PG8_SA(0, 0), a2, voffA);
      PG8_BAR; PG8_WAIT_L(0); PG8_MMA(1, 0, At, B0); PG8_BAR; PG8_SCHED;
      PG8_STAGE(PG8_SB(0, 1), b2 + hstepB, voffB);
      PG8_WAIT_V(6); PG8_BAR; PG8_MMA(1, 1, At, B1); PG8_BAR;
      PG8_LDB(B0, 1, 0); PG8_SCHED; PG8_LDA(At, 1, 0); PG8_STAGE(PG8_SA(0, 1), a2 + hstepA, voffA);
      PG8_WAIT_L(8); PG8_BAR; PG8_WAIT_L(0); PG8_MMA(0, 0, At, B0); PG8_BAR; PG8_SCHED;
      PG8_LDB(B1, 1, 1); PG8_STAGE(PG8_SB(1, 0), b3, voffB);
      PG8_BAR; PG8_WAIT_L(0); PG8_MMA(0, 1, At, B1); PG8_BAR;
      PG8_LDA(At, 1, 1); PG8_STAGE(PG8_SA(1, 0), a3, voffA);
      PG8_BAR; PG8_WAIT_L(0); PG8_MMA(1, 0, At, B0); PG8_BAR; PG8_SCHED;
      PG8_STAGE(PG8_SB(1, 1), b3 + hstepB, voffB);
      PG8_WAIT_V(6); PG8_BAR; PG8_MMA(1, 1, At, B1); PG8_BAR;
    }
    epilogue<EPI>(acc, cur, ea, lds);
    if (!has_next) break;
#pragma unroll
    for (int a = 0; a < 2; ++a)
#pragma unroll
      for (int b = 0; b < 2; ++b)
#pragma unroll
        for (int m = 0; m < 4; ++m)
#pragma unroll
          for (int n = 0; n < 2; ++n) acc[a][b][m][n] = (f32x4){0.f, 0.f, 0.f, 0.f};
    cur = nxt; cA = nA; cB = nB; ++ui;
  }
  PG8_WAIT_V(0);
  if (wr == 0) PG8_BAR;
  PG8_BAR;
#undef PG8_SA
#undef PG8_SB
}

constexpr int KROW = 144, VROW = 144;
constexpr int KBUF = 64 * KROW, VBUF = 128 * VROW, ABUF = KBUF + VBUF;
constexpr float LOG2E = 1.4426950408889634f;
DI bf16x8 pack8(const f32x16& x, int s) {
  u32x4 p; p.x = cvt_pk_bf16(x[8 * s], x[8 * s + 1]); p.y = cvt_pk_bf16(x[8 * s + 2], x[8 * s + 3]); p.z = cvt_pk_bf16(x[8 * s + 4], x[8 * s + 5]); p.w = cvt_pk_bf16(x[8 * s + 6], x[8 * s + 7]);
  return __builtin_bit_cast(bf16x8, p);
}
DI void attn_phase(LAS unsigned char* lds, u16* PB, const u16* VT, float* OSV, const float* lamp, const float* subg, const float* relb, int layer) {
  int tid = threadIdx.x; asm volatile("" : "+v"(tid));
  int bid = blockIdx.x, gdim = gridDim.x; asm volatile("" : "+s"(bid), "+s"(gdim));
  const int wid = tid >> 6, lane = tid & 63, qi = lane & 31, g = lane >> 5;
  LAS float* tab = (LAS float*)(lds + 2 * ABUF);
  LAS float* scal = tab + 264;
  const float lam_init = 0.8f - 0.6f * __expf(-0.3f * (float)layer);
  __syncthreads();
  if (wid == 0) {
    float a = lamp[lane] * lamp[64 + lane], b = lamp[128 + lane] * lamp[192 + lane];
    for (int o = 32; o > 0; o >>= 1) { a += __shfl_xor(a, o); b += __shfl_xor(b, o); }
    if (lane == 0) scal[0] = __expf(a) - __expf(b) + lam_init;
  }
  const int m_sw = (qi & 0x13) | ((qi & 4) << 1) | ((qi & 8) >> 1);
  const int xcd = bid & 7, jq = bid >> 3;
  const int per_x = gdim >> 3;
  const float c1 = 0.125f * LOG2E;
  for (int pr = xcd; pr < 48; pr += 8) {
    const int s = pr >> 2, h = pr & 3;
    for (int qb = jq; qb < 32; qb += per_x) {
      __syncthreads();
      for (int i = tid; i < 257; i += NTHREADS) {
        const int rel = i - 128, n = rel < 0 ? -rel : rel;
        int bk = n < 8 ? n : (n <= 11 ? 8 : (n <= 15 ? 9 : (n <= 22 ? 10 : (n <= 31 ? 11 : (n <= 45 ? 12 : (n <= 63 ? 13 : (n <= 90 ? 14 : 15)))))));
        if (rel > 0) bk += 16;
        tab[i] = relb[bk * 4 + h] * LOG2E;
      }
      const int q0 = qb * 256 + wid * 32;
      const size_t tokbase = (size_t)s * T;
      float* osv = OSV + ((size_t)bid * 512 + tid) * 64;
#pragma unroll 1
      for (int c = 0; c < 2; ++c) {
        bf16x8 Q[4];
        { const u16* qp = PB + (tokbase + q0 + qi) * 1024 + h * 128 + c * 64 + g * 8;
#pragma unroll
          for (int ks = 0; ks < 4; ++ks) Q[ks] = *(const bf16x8*)(qp + ks * 16); }
        f32x16 O[4];
#pragma unroll
        for (int eb = 0; eb < 4; ++eb)
#pragma unroll
          for (int i = 0; i < 16; ++i) O[eb][i] = 0.f;
        float mrun = -1e30f, lrun = 0.f;
        const u16* kg = PB + (tokbase + (tid >> 3)) * 1024 + 512 + h * 128 + c * 64 + (tid & 7) * 8;
        const u16* vg = VT + ((size_t)((s * 4 + h) * 128 + (tid >> 2))) * T + (tid & 3) * 16;
        const unsigned kl = (tid >> 3) * KROW + (tid & 7) * 16, vl = KBUF + (tid >> 2) * VROW + (tid & 3) * 32;
        u32x4 rk0, rv0, rv1;
        rk0 = *(const u32x4*)(kg); rv0 = *(const u32x4*)(vg); rv1 = *(const u32x4*)(vg + 8);
        __syncthreads();
        *(LAS u32x4*)(lds + kl) = rk0; *(LAS u32x4*)(lds + vl) = rv0; *(LAS u32x4*)(lds + vl + 16) = rv1;
        __syncthreads();
#pragma unroll 1
        for (int kt = 0; kt < 128; ++kt) {
          LAS unsigned char* buf = lds + (kt & 1) * ABUF;
          LAS unsigned char* nbuf = lds + ((kt + 1) & 1) * ABUF;
          if (kt + 1 < 128) {
            const u16* kg2 = kg + (size_t)(kt + 1) * 64 * 1024; const u16* vg2 = vg + (kt + 1) * 64;
            rk0 = *(const u32x4*)(kg2); rv0 = *(const u32x4*)(vg2); rv1 = *(const u32x4*)(vg2 + 8);
          }
          const int kmin = kt * 64;
          const int dlo = kmin + 63 - q0, dhi = kmin - (q0 + 31);
          const int bmode = dlo <= -91 ? 0 : (dhi >= 91 ? 1 : 2);
          const float bconst = bmode == 0 ? tab[0] : tab[256];
          f32x16 S[2];
#pragma unroll
          for (int kb = 0; kb < 2; ++kb) {
#pragma unroll
            for (int i = 0; i < 16; ++i) S[kb][i] = 0.f;
#pragma unroll
            for (int ks = 0; ks < 4; ++ks) {
              const bf16x8 a = *(const LAS bf16x8*)(buf + (kb * 32 + m_sw) * KROW + (ks * 16 + g * 8) * 2);
              S[kb] = __builtin_amdgcn_mfma_f32_32x32x16_bf16(a, Q[ks], S[kb], 0, 0, 0);
            }
          }
          float mx = -1e30f;
          if (bmode == 2) {
#pragma unroll
            for (int kb = 0; kb < 2; ++kb)
#pragma unroll
              for (int r = 0; r < 16; ++r) {
                int rel = kmin + kb * 32 + 16 * (r >> 3) + 8 * g + (r & 7) - (q0 + qi);
                rel = rel < -128 ? -128 : (rel > 128 ? 128 : rel);
                S[kb][r] = S[kb][r] * c1 + tab[rel + 128];
                mx = fmaxf(mx, S[kb][r]);
              }
          } else {
#pragma unroll
            for (int kb = 0; kb < 2; ++kb)
#pragma unroll
              for (int r = 0; r < 16; ++r) { S[kb][r] = S[kb][r] * c1 + bconst; mx = fmaxf(mx, S[kb][r]); }
          }
          mx = fmaxf(mx, __shfl_xor(mx, 32));
          const float mnew = fmaxf(mrun, mx);
          const float alpha = __builtin_amdgcn_exp2f(mrun - mnew);
          mrun = mnew;
          float psum = 0.f;
#pragma unroll
          for (int kb = 0; kb < 2; ++kb)
#pragma unroll
            for (int r = 0; r < 16; ++r) { const float pv = __builtin_amdgcn_exp2f(S[kb][r] - mnew); S[kb][r] = pv; psum += pv; }
          lrun = lrun * alpha + psum;
#pragma unroll
          for (int eb = 0; eb < 4; ++eb)
#pragma unroll
            for (int i = 0; i < 16; ++i) O[eb][i] *= alpha;
#pragma unroll
          for (int kb = 0; kb < 2; ++kb)
#pragma unroll
            for (int hh = 0; hh < 2; ++hh) {
              const bf16x8 pb = pack8(S[kb], hh);
#pragma unroll
              for (int eb = 0; eb < 4; ++eb) {
                const bf16x8 va = *(const LAS bf16x8*)(buf + KBUF + (eb * 32 + qi) * VROW + (kb * 32 + hh * 16 + g * 8) * 2);
                O[eb] = __builtin_amdgcn_mfma_f32_32x32x16_bf16(va, pb, O[eb], 0, 0, 0);
              }
            }
          if (kt + 1 < 128) {
            *(LAS u32x4*)(nbuf + kl) = rk0; *(LAS u32x4*)(nbuf + vl) = rv0; *(LAS u32x4*)(nbuf + vl + 16) = rv1;
          }
          __syncthreads();
        }
        const float lt = lrun + __shfl_xor(lrun, 32);
        asm volatile("" : "+v"(osv));
        if (c == 0) {
          const float i0 = 1.f / lt;
#pragma unroll
          for (int eb = 0; eb < 4; ++eb)
#pragma unroll
            for (int i = 0; i < 16; i += 4) { f32x4 t4; t4[0] = O[eb][i] * i0; t4[1] = O[eb][i + 1] * i0; t4[2] = O[eb][i + 2] * i0; t4[3] = O[eb][i + 3] * i0; *(f32x4*)(osv + eb * 16 + i) = t4; }
        } else {
          const float i1 = scal[0] / lt;
          float ss = 0.f;
#pragma unroll
          for (int eb = 0; eb < 4; ++eb)
#pragma unroll
            for (int i = 0; i < 16; i += 4) { const f32x4 t4 = *(const f32x4*)(osv + eb * 16 + i);
#pragma unroll
              for (int j = 0; j < 4; ++j) { const float o = t4[j] - O[eb][i + j] * i1; O[eb][i + j] = o; ss += o * o; } }
          ss += __shfl_xor(ss, 32);
          const float rs = rsqrtf(ss * (1.f / 128.f) + LN_EPS) * (1.f - lam_init);
          u16* op = PB + (tokbase + q0 + qi) * 1024 + h * 128;
#pragma unroll
          for (int eb = 0; eb < 4; ++eb)
#pragma unroll
            for (int rr = 0; rr < 4; ++rr) {
              const int e = eb * 32 + 8 * rr + 4 * g;
              const f32x4 gg = *(const f32x4*)(subg + e);
              u32x2 pk; pk.x = cvt_pk_bf16(O[eb][4 * rr] * rs * gg[0], O[eb][4 * rr + 1] * rs * gg[1]); pk.y = cvt_pk_bf16(O[eb][4 * rr + 2] * rs * gg[2], O[eb][4 * rr + 3] * rs * gg[3]);
              *(u32x2*)(op + e) = pk;
            }
        }
      }
    }
  }
}

DI float softplusf_(float x) { return fmaxf(x, 0.f) + __logf(1.f + __expf(-fabsf(x))); }
DI void load_bf16x8(const u16* p, float (&o)[8]) {
  const u32x4 v = *(const u32x4*)p;
#pragma unroll
  for (int i = 0; i < 4; ++i) { o[2 * i] = __uint_as_float(v[i] << 16); o[2 * i + 1] = __uint_as_float(v[i] & 0xffff0000u); }
}
DI void shifted8(const u16* PA, size_t row, int t, int col, const float* mu0, const float* mu1, float (&o)[8]) {
  float c[8], pv[8], nx[8];
  load_bf16x8(PA + row * A_COLS + col, c);
  if (t > 0) load_bf16x8(PA + (row - 1) * A_COLS + col, pv); else { for (int i = 0; i < 8; ++i) pv[i] = 0.f; }
  if (t < T - 1) load_bf16x8(PA + (row + 1) * A_COLS + col, nx); else { for (int i = 0; i < 8; ++i) nx[i] = 0.f; }
#pragma unroll
  for (int i = 0; i < 8; ++i) o[i] = c[i] + mu0[col + i] * (pv[i] - c[i]) + mu1[col + i] * (nx[i] - c[i]);
}

DI void vprep_phase(LAS unsigned char* lds, const u16* PA, u16* VV, const float* mu, const float* vdown, const float* vup, const float* v0, int layer) {
  int tid = threadIdx.x; asm volatile("" : "+v"(tid));
  int bid = blockIdx.x, gdim = gridDim.x; asm volatile("" : "+s"(bid), "+s"(gdim));
  const int tok = tid >> 4, j = tid & 15;
  LAS float* vs = (LAS float*)lds;
  LAS float* dd = vs + 32 * 516;
  const float* mu0 = mu; const float* mu1 = mu + A_COLS;
  for (int it = bid; it < NT / 32; it += gdim) {
    const size_t row = (size_t)it * 32 + tok; const int t = (int)(row % T);
    __syncthreads();
#pragma unroll 1
    for (int q = 0; q < 4; ++q) {
      float o[8]; shifted8(PA, row, t, OFF_V + j * 32 + q * 8, mu0, mu1, o);
      if (layer == 0) {
        u32x4 pk; pk.x = cvt_pk_bf16(o[0], o[1]); pk.y = cvt_pk_bf16(o[2], o[3]); pk.z = cvt_pk_bf16(o[4], o[5]); pk.w = cvt_pk_bf16(o[6], o[7]);
        *(u32x4*)(VV + row * 512 + j * 32 + q * 8) = pk;
      } else {
#pragma unroll
        for (int i = 0; i < 8; ++i) vs[tok * 516 + j * 32 + q * 8 + i] = o[i];
      }
    }
    if (layer == 0) continue;
    __syncthreads();
    {
      float d0 = 0.f, d1 = 0.f;
#pragma unroll 4
      for (int c = 0; c < 512; ++c) { const float x = vs[tok * 516 + c]; const float2 w = *(const float2*)(vdown + c * 32 + 2 * j); d0 += x * w.x; d1 += x * w.y; }
      dd[tok * 32 + 2 * j] = d0; dd[tok * 32 + 2 * j + 1] = d1;
    }
    __syncthreads();
#pragma unroll 1
    for (int q = 0; q < 4; ++q) {
      const int c0 = j * 32 + q * 8;
      float acc[8];
#pragma unroll
      for (int i = 0; i < 8; ++i) acc[i] = v0[c0 + i];
#pragma unroll 4
      for (int r = 0; r < 32; ++r) {
        const float dv = dd[tok * 32 + r];
        const f32x4 u0 = *(const f32x4*)(vup + r * 512 + c0), u1 = *(const f32x4*)(vup + r * 512 + c0 + 4);
#pragma unroll
        for (int i = 0; i < 4; ++i) { acc[i] += dv * u0[i]; acc[4 + i] += dv * u1[i]; }
      }
      float vf[8]; load_bf16x8(VV + row * 512 + c0, vf);
      float o[8];
#pragma unroll
      for (int i = 0; i < 8; ++i) { const float x = vs[tok * 516 + c0 + i]; o[i] = x + (vf[i] - x) * sigmoidf_(acc[i]); }
      u32x4 pk; pk.x = cvt_pk_bf16(o[0], o[1]); pk.y = cvt_pk_bf16(o[2], o[3]); pk.z = cvt_pk_bf16(o[4], o[5]); pk.w = cvt_pk_bf16(o[6], o[7]);
      *(u32x4*)(VV + row * 512 + c0) = pk;
    }
  }
}

struct ScanW { const float *mu, *w0, *du, *a0, *iu, *kk_, *ka, *rk; };
constexpr int SC = 32;
DI float quad_sum(float x) {
  x += __builtin_bit_cast(float, __builtin_amdgcn_update_dpp(0, __builtin_bit_cast(int, x), 0xB1, 0xf, 0xf, true));
  x += __builtin_bit_cast(float, __builtin_amdgcn_update_dpp(0, __builtin_bit_cast(int, x), 0x4E, 0xf, 0xf, true));
  return x;
}
#define BFLO(x) __uint_as_float((x) << 16)
#define BFHI(x) __uint_as_float((x) & 0xffff0000u)
DI float tanh_fast(float x) { x = fminf(fmaxf(x, -15.f), 15.f); const float t = __expf(2.f * x); return (t - 1.f) / (t + 1.f); }
DI float shift1(float c, float p, float n, float m0, float m1) { return c + m0 * (p - c) + m1 * (n - c); }
DI void scan_produce(LAS float* buf, LAS float* TW, LAS float* TA, LAS const float* DU, LAS const float* IU, const u16* PA, const u16* VV, float* BON,
                     const ScanW& w, int ptid, int sq, int h, int dir, int t0) {
  const int tok = ptid >> 3, j = ptid & 7;
  const int t = t0 + tok; const size_t row = (size_t)sq * T + t;
  const float* mu0 = w.mu; const float* mu1 = w.mu + A_COLS;
  const int cr = h * 64 + j * 8, ck = OFF_K + cr, cw_ = OFF_WD + dir * 32 + j * 4, ca_ = OFF_AD + dir * 32 + j * 4;
  const u16* pc = PA + row * A_COLS;
  const bool hp = t > 0, hn = t < T - 1;
  {
    const u32x2 w_c = *(const u32x2*)(pc + cw_), a_c = *(const u32x2*)(pc + ca_);
    u32x2 w_p = (u32x2){0u, 0u}, a_p = w_p, w_n = w_p, a_n = w_p;
    if (hp) { w_p = *(const u32x2*)(pc - A_COLS + cw_); a_p = *(const u32x2*)(pc - A_COLS + ca_); }
    if (hn) { w_n = *(const u32x2*)(pc + A_COLS + cw_); a_n = *(const u32x2*)(pc + A_COLS + ca_); }
    const f32x4 mw0 = *(const f32x4*)(mu0 + cw_), mw1 = *(const f32x4*)(mu1 + cw_), ma0 = *(const f32x4*)(mu0 + ca_), ma1 = *(const f32x4*)(mu1 + ca_);
    f32x4 tw, ta;
#pragma unroll
    for (int i = 0; i < 2; ++i) {
      tw[2 * i] = tanh_fast(shift1(BFLO(w_c[i]), BFLO(w_p[i]), BFLO(w_n[i]), mw0[2 * i], mw1[2 * i]));
      tw[2 * i + 1] = tanh_fast(shift1(BFHI(w_c[i]), BFHI(w_p[i]), BFHI(w_n[i]), mw0[2 * i + 1], mw1[2 * i + 1]));
      ta[2 * i] = shift1(BFLO(a_c[i]), BFLO(a_p[i]), BFLO(a_n[i]), ma0[2 * i], ma1[2 * i]);
      ta[2 * i + 1] = shift1(BFHI(a_c[i]), BFHI(a_p[i]), BFHI(a_n[i]), ma0[2 * i + 1], ma1[2 * i + 1]);
    }
    *(LAS f32x4*)(TW + tok * 32 + j * 4) = tw; *(LAS f32x4*)(TA + tok * 32 + j * 4) = ta;
  }
  asm volatile("s_waitcnt lgkmcnt(0)" ::: "memory");
  float wl[8], al[8];
  const int cc = j * 8, cg_ = h * 64 + cc;
  { const f32x4 x0 = *(const f32x4*)(w.w0 + dir * 512 + cg_), x1 = *(const f32x4*)(w.w0 + dir * 512 + cg_ + 4), y0 = *(const f32x4*)(w.a0 + dir * 512 + cg_), y1 = *(const f32x4*)(w.a0 + dir * 512 + cg_ + 4);
#pragma unroll
    for (int q = 0; q < 4; ++q) { wl[q] = x0[q]; wl[4 + q] = x1[q]; al[q] = y0[q]; al[4 + q] = y1[q]; } }
#pragma unroll 2
  for (int rr = 0; rr < 32; ++rr) {
    const float twv = TW[tok * 32 + rr], tav = TA[tok * 32 + rr];
    const f32x4 d0 = *(const LAS f32x4*)(DU + rr * 64 + cc), d1 = *(const LAS f32x4*)(DU + rr * 64 + cc + 4), i0 = *(const LAS f32x4*)(IU + rr * 64 + cc), i1 = *(const LAS f32x4*)(IU + rr * 64 + cc + 4);
#pragma unroll
    for (int q = 0; q < 4; ++q) { wl[q] += twv * d0[q]; wl[4 + q] += twv * d1[q]; al[q] += tav * i0[q]; al[4 + q] += tav * i1[q]; }
  }
#pragma unroll
  for (int q = 0; q < 8; ++q) { asm volatile("" : "+v"(wl[q]), "+v"(al[q])); }
  LAS float* AW = buf; LAS float* AK = buf + 2048; LAS float* AB = buf + 4096; LAS float* AD = buf + 6144; LAS float* AR = buf + 8192; LAS float* AV = buf + 10240;
  const int o = tok * 64 + cc;
  float ss = 0.f, bs = 0.f;
  float ok[8], av[8];
#pragma unroll
  for (int hq = 0; hq < 2; ++hq) {
    const int c4 = 4 * hq;
    const u32x2 r_c = *(const u32x2*)(pc + cr + c4), k_c = *(const u32x2*)(pc + ck + c4);
    u32x2 r_p = (u32x2){0u, 0u}, k_p = r_p, r_n = r_p, k_n = r_p;
    if (hp) { r_p = *(const u32x2*)(pc - A_COLS + cr + c4); k_p = *(const u32x2*)(pc - A_COLS + ck + c4); }
    if (hn) { r_n = *(const u32x2*)(pc + A_COLS + cr + c4); k_n = *(const u32x2*)(pc + A_COLS + ck + c4); }
    const u32x2 v_c = *(const u32x2*)(VV + row * 512 + cr + c4);
    const f32x4 mr0 = *(const f32x4*)(mu0 + cr + c4), mr1 = *(const f32x4*)(mu1 + cr + c4), mk0 = *(const f32x4*)(mu0 + ck + c4), mk1 = *(const f32x4*)(mu1 + ck + c4);
    const f32x4 kk4 = *(const f32x4*)(w.kk_ + cg_ + c4), ka4 = *(const f32x4*)(w.ka + cg_ + c4), rk4 = *(const f32x4*)(w.rk + cg_ + c4);
    f32x4 rv, kv, vv, ow, od;
#pragma unroll
    for (int i = 0; i < 2; ++i) {
      rv[2 * i] = shift1(BFLO(r_c[i]), BFLO(r_p[i]), BFLO(r_n[i]), mr0[2 * i], mr1[2 * i]);
      rv[2 * i + 1] = shift1(BFHI(r_c[i]), BFHI(r_p[i]), BFHI(r_n[i]), mr0[2 * i + 1], mr1[2 * i + 1]);
      kv[2 * i] = shift1(BFLO(k_c[i]), BFLO(k_p[i]), BFLO(k_n[i]), mk0[2 * i], mk1[2 * i]);
      kv[2 * i + 1] = shift1(BFHI(k_c[i]), BFHI(k_p[i]), BFHI(k_n[i]), mk0[2 * i + 1], mk1[2 * i + 1]);
      vv[2 * i] = BFLO(v_c[i]); vv[2 * i + 1] = BFHI(v_c[i]);
    }
#pragma unroll
    for (int q = 0; q < 4; ++q) {
      const float wlog = -softplusf_(-wl[c4 + q]) - 0.5f;
      ow[q] = __expf(-__expf(wlog));
      const float a = sigmoidf_(al[c4 + q]);
      av[c4 + q] = a;
      ok[c4 + q] = kv[q] * kk4[q]; ss += ok[c4 + q] * ok[c4 + q];
      od[q] = kv[q] * (1.f + (a - 1.f) * ka4[q]);
      bs += rv[q] * od[q] * rk4[q];
    }
    *(LAS f32x4*)(AW + o + c4) = ow; *(LAS f32x4*)(AD + o + c4) = od; *(LAS f32x4*)(AR + o + c4) = rv; *(LAS f32x4*)(AV + o + c4) = vv;
  }
#pragma unroll
  for (int sft = 1; sft < 8; sft <<= 1) { ss += __shfl_xor(ss, sft); bs += __shfl_xor(bs, sft); }
  const float rn = rsqrtf(ss + 1e-12f);
#pragma unroll
  for (int hq = 0; hq < 2; ++hq) {
    f32x4 k4, b4;
#pragma unroll
    for (int q = 0; q < 4; ++q) { k4[q] = ok[4 * hq + q] * rn; b4[q] = k4[q] * av[4 * hq + q]; }
    *(LAS f32x4*)(AK + o + 4 * hq) = k4; *(LAS f32x4*)(AB + o + 4 * hq) = b4;
  }
  if (j == 0) BON[((size_t)dir * NT + row) * 8 + h] = bs;
}
struct ScanOps { f32x4 k4[4], w4[4], b4[4], d4[4]; float vi; };
DI void scan_load(ScanOps& o, LAS const float* buf, int tt, int jseg, int irow) {
  const int off = tt * 64 + jseg * 16;
#pragma unroll
  for (int q = 0; q < 4; ++q) {
    o.w4[q] = *(const LAS f32x4*)(buf + off + q * 4); o.k4[q] = *(const LAS f32x4*)(buf + 2048 + off + q * 4); o.b4[q] = *(const LAS f32x4*)(buf + 4096 + off + q * 4);
    o.d4[q] = *(const LAS f32x4*)(buf + 6144 + off + q * 4);
  }
  o.vi = buf[10240 + tt * 64 + irow];
}
DI float scan_step(f32x4 (&S)[4], const ScanOps& o, LAS const float* buf, int tt, int jseg) {
  f32x4 r4[4];
#pragma unroll
  for (int q = 0; q < 4; ++q) r4[q] = *(const LAS f32x4*)(buf + 8192 + tt * 64 + jseg * 16 + q * 4);
  f32x4 a4 = S[0] * o.k4[0] + S[1] * o.k4[1] + S[2] * o.k4[2] + S[3] * o.k4[3];
  float sa = -quad_sum((a4[0] + a4[1]) + (a4[2] + a4[3]));
  f32x4 y4 = (f32x4){0.f, 0.f, 0.f, 0.f};
#pragma unroll
  for (int q = 0; q < 4; ++q) { S[q] = S[q] * o.w4[q] + (o.b4[q] * sa + o.d4[q] * o.vi); y4 += S[q] * r4[q]; }
  return quad_sum((y4[0] + y4[1]) + (y4[2] + y4[3]));
}
DI void scan_phase(LAS unsigned char* lds, const u16* PA, const u16* VV, u16* YY, float* BON, const ScanW w) {
  int tid = threadIdx.x; asm volatile("" : "+v"(tid));
  int bid = blockIdx.x, gdim = gridDim.x; asm volatile("" : "+s"(bid), "+s"(gdim));
  LAS float* BUF = (LAS float*)lds;
  LAS float* AY = BUF + 2 * 12288;
  LAS float* TW = AY + 2 * 2048;
  LAS float* TA = TW + SC * 32;
  LAS float* DU = TA + SC * 32;
  LAS float* IU = DU + 2048;
  const int wid = __builtin_amdgcn_readfirstlane(tid >> 6), lane = tid & 63;
  const int NCH = T / SC;
  for (int item = bid; item < 192; item += gdim) {
    const int dir = item & 1, h = (item >> 1) & 7, sq = item >> 4;
    __syncthreads();
    for (int i = tid; i < 2048; i += NTHREADS) { const int rr = i >> 6, c = i & 63; DU[i] = w.du[(dir * 32 + rr) * 512 + h * 64 + c]; IU[i] = w.iu[(dir * 32 + rr) * 512 + h * 64 + c]; }
    __syncthreads();
    f32x4 S[4];
#pragma unroll
    for (int q = 0; q < 4; ++q) S[q] = (f32x4){0.f, 0.f, 0.f, 0.f};
    const int irow = (wid & 3) * 16 + (lane >> 2), jseg = lane & 3;
    if (wid >= 4) scan_produce(BUF, TW, TA, DU, IU, PA, VV, BON, w, tid - 256, sq, h, dir, dir == 0 ? 0 : T - SC);
    __syncthreads();
#pragma unroll 1
    for (int ci = 0; ci < NCH; ++ci) {
      LAS float* buf = BUF + (ci & 1) * 12288;
      LAS float* ay = AY + (ci & 1) * 2048;
      if (wid < 4) {
        ScanOps o0, o1;
        scan_load(o0, buf, dir == 0 ? 0 : SC - 1, jseg, irow);
#pragma unroll 1
        for (int st = 0; st < SC; st += 2) {
          const int t0_ = dir == 0 ? st : SC - 1 - st, t1_ = dir == 0 ? st + 1 : SC - 2 - st;
          scan_load(o1, buf, t1_, jseg, irow);
          const float y0 = scan_step(S, o0, buf, t0_, jseg);
          if (jseg == 0) ay[t0_ * 64 + irow] = y0;
          if (st + 2 < SC) scan_load(o0, buf, dir == 0 ? st + 2 : SC - 3 - st, jseg, irow);
          const float y1 = scan_step(S, o1, buf, t1_, jseg);
          if (jseg == 0) ay[t1_ * 64 + irow] = y1;
        }
      } else {
        const int ptid = tid - 256;
        if (ci + 1 < NCH) scan_produce(BUF + ((ci + 1) & 1) * 12288, TW, TA, DU, IU, PA, VV, BON, w, ptid, sq, h, dir, dir == 0 ? (ci + 1) * SC : T - SC * (ci + 2));
        if (ci > 0) {
          LAS const float* py = AY + ((ci - 1) & 1) * 2048;
          const int t0p = dir == 0 ? (ci - 1) * SC : T - SC * ci;
          const int tok = ptid >> 3, c0 = (ptid & 7) * 8;
          const f32x4 ya = *(const LAS f32x4*)(py + tok * 64 + c0), yb = *(const LAS f32x4*)(py + tok * 64 + c0 + 4);
          u32x4 pk; pk.x = cvt_pk_bf16(ya[0], ya[1]); pk.y = cvt_pk_bf16(ya[2], ya[3]); pk.z = cvt_pk_bf16(yb[0], yb[1]); pk.w = cvt_pk_bf16(yb[2], yb[3]);
          *(u32x4*)(YY + ((size_t)dir * NT + (size_t)sq * T + t0p + tok) * 512 + h * 64 + c0) = pk;
        }
      }
      __syncthreads();
    }
    if (wid >= 4) {
      const int ptid = tid - 256;
      LAS const float* py = AY + ((NCH - 1) & 1) * 2048;
      const int t0p = dir == 0 ? (NCH - 1) * SC : 0;
      const int tok = ptid >> 3, c0 = (ptid & 7) * 8;
      const f32x4 ya = *(const LAS f32x4*)(py + tok * 64 + c0), yb = *(const LAS f32x4*)(py + tok * 64 + c0 + 4);
      u32x4 pk; pk.x = cvt_pk_bf16(ya[0], ya[1]); pk.y = cvt_pk_bf16(ya[2], ya[3]); pk.z = cvt_pk_bf16(yb[0], yb[1]); pk.w = cvt_pk_bf16(yb[2], yb[3]);
      *(u32x4*)(YY + ((size_t)dir * NT + (size_t)sq * T + t0p + tok) * 512 + h * 64 + c0) = pk;
    }
  }
}

DI void post_phase(LAS unsigned char* lds, u16* PA, const u16* PB, const u16* VV, const u16* YY, const float* BON, const float* mu, const float* gup, const float* gng, const float* gnb) {
  int tid = threadIdx.x; asm volatile("" : "+v"(tid));
  int bid = blockIdx.x, gdim = gridDim.x; asm volatile("" : "+s"(bid), "+s"(gdim));
  const int tok = tid >> 4, j = tid & 15;
  LAS float* sg = (LAS float*)lds;
  const float* mu0 = mu; const float* mu1 = mu + A_COLS;
  for (int it = bid; it < NT / 32; it += gdim) {
    const size_t row = (size_t)it * 32 + tok; const int t = (int)(row % T);
    __syncthreads();
#pragma unroll
    for (int q = 0; q < 6; ++q) {
      const int col = OFF_GD + j * 6 + q;
      const float c = bf2f(PA[row * A_COLS + col]);
      const float pv = t > 0 ? bf2f(PA[(row - 1) * A_COLS + col]) : 0.f, nx = t < T - 1 ? bf2f(PA[(row + 1) * A_COLS + col]) : 0.f;
      sg[tok * 96 + j * 6 + q] = sigmoidf_(c + mu0[col] * (pv - c) + mu1[col] * (nx - c));
    }
    __syncthreads();
    const int c0 = j * 32, h = j >> 1;
    float y[32]; float sm = 0.f;
#pragma unroll
    for (int q = 0; q < 4; ++q) {
      float a[8], b[8]; load_bf16x8(YY + row * 512 + c0 + q * 8, a); load_bf16x8(YY + ((size_t)NT + row) * 512 + c0 + q * 8, b);
#pragma unroll
      for (int i = 0; i < 8; ++i) { y[q * 8 + i] = a[i] + b[i]; sm += y[q * 8 + i]; }
    }
    sm += __shfl_xor(sm, 1);
    const float mean = sm * (1.f / 64.f);
    float vq = 0.f;
#pragma unroll
    for (int i = 0; i < 32; ++i) { y[i] -= mean; vq += y[i] * y[i]; }
    vq += __shfl_xor(vq, 1);
    const float rs = rsqrtf(vq * (1.f / 64.f) + GN_EPS);
    const float bon = BON[row * 8 + h] + BON[((size_t)NT + row) * 8 + h];
#pragma unroll 1
    for (int q = 0; q < 4; ++q) {
      const int cc = c0 + q * 8;
      float gacc[8];
#pragma unroll
      for (int i = 0; i < 8; ++i) gacc[i] = 0.f;
#pragma unroll 4
      for (int r = 0; r < 96; ++r) {
        const float sv = sg[tok * 96 + r];
        const f32x4 u0 = *(const f32x4*)(gup + r * 512 + cc), u1 = *(const f32x4*)(gup + r * 512 + cc + 4);
#pragma unroll
        for (int i = 0; i < 4; ++i) { gacc[i] += sv * u0[i]; gacc[4 + i] += sv * u1[i]; }
      }
      float vv[8]; load_bf16x8(VV + row * 512 + cc, vv);
      float o[8];
#pragma unroll
      for (int i = 0; i < 8; ++i) {
        float yy = 0.f;
#pragma unroll
        for (int qq = 0; qq < 4; ++qq) if (qq == q) yy = y[qq * 8 + i];
        o[i] = (yy * rs * gng[cc + i] + gnb[cc + i] + bon * vv[i]) * gacc[i];
      }
      u32x4 pk; pk.x = cvt_pk_bf16(o[0], o[1]); pk.y = cvt_pk_bf16(o[2], o[3]); pk.z = cvt_pk_bf16(o[4], o[5]); pk.w = cvt_pk_bf16(o[6], o[7]);
      if (DBGZ & 1) pk = (u32x4){0u, 0u, 0u, 0u};
      *(u32x4*)(PA + row * A_COLS + cc) = pk;
      u32x4 pb4 = *(const u32x4*)(PB + row * 1024 + cc); if (DBGZ & 2) pb4 = (u32x4){0u, 0u, 0u, 0u};
      *(u32x4*)(PA + row * A_COLS + 512 + cc) = pb4;
    }
  }
}

DI unsigned hashu(unsigned x) { x ^= x >> 16; x *= 0x7feb352du; x ^= x >> 15; x *= 0x846ca68bu; x ^= x >> 16; return x; }
DI void dbg_upd(float* slot, float got, float ref, float scale) { float e = fabsf(got - ref) / scale; if (!(e == e)) e = 1e9f; atomicMax((unsigned*)slot, __float_as_uint(e)); }
DI float tshift(const u16* PA, size_t row, int col, const float* mu) {
  const int t = (int)(row % T);
  const float c = bf2f(PA[row * A_COLS + col]);
  const float pv = t > 0 ? bf2f(PA[(row - 1) * A_COLS + col]) : 0.f, nx = t < T - 1 ? bf2f(PA[(row + 1) * A_COLS + col]) : 0.f;
  return c + mu[col] * (pv - c) + mu[A_COLS + col] * (nx - c);
}
DI void chk_proj(const u16* XB, const float* win, const u16* PA, const u16* PB, const u16* VT, float* slot) {
  const int gt = blockIdx.x * NTHREADS + threadIdx.x;
  if (gt >= 4096) return;
  const int row = hashu(gt * 2 + 1) % NT, col = hashu(gt * 2 + 2) % P_COLS;
  float ref = 0.f;
  for (int k = 0; k < D; ++k) ref += bf2f(XB[(size_t)row * D + k]) * win[(size_t)k * P_COLS + col];
  float got;
  if (col < A_COLS) got = bf2f(PA[(size_t)row * A_COLS + col]);
  else if (col < A_COLS + 1024) got = bf2f(PB[(size_t)row * 1024 + col - A_COLS]);
  else { const int c2 = col - A_COLS - 1024, h = c2 >> 7, e = c2 & 127, sq = row / T, t = row % T; got = bf2f(VT[((size_t)((sq * 4 + h) * 128 + e)) * T + t]); }
  dbg_upd(slot, got, ref, 1.f);
}
DI void chk_ffn(const u16* XB, const float* wup, const float* cw, const float* cb, const u16* G, float* slot) {
  const int gt = blockIdx.x * NTHREADS + threadIdx.x;
  if (gt >= 4096) return;
  int row = hashu(gt * 2 + 11) % NT; const int n = hashu(gt * 2 + 12) % DFF;
  if (gt < 64) row = (gt & 1) ? (row / T) * T + T - 1 : (row / T) * T;
  else if (gt < 1024) row = (row / T) * T + ((row % T) / 254) * 254 + (gt & 1 ? 253 : 0), row = row >= NT ? NT - 1 : row;
  const int t = row % T;
  float hg[3] = {0.f, 0.f, 0.f}, hu[3] = {0.f, 0.f, 0.f};
#pragma unroll
  for (int d = -1; d <= 1; ++d) {
    float a = 0.f, b = 0.f;
    if (!(t + d < 0 || t + d > T - 1))
      for (int k = 0; k < D; ++k) { const float x = bf2f(XB[(size_t)(row + d) * D + k]); a += x * wup[(size_t)k * NUP + n]; b += x * wup[(size_t)k * NUP + DFF + n]; }
    hg[d + 1] = a; hu[d + 1] = b;
  }
  const float got = bf2f(G[(size_t)row * DFF + n]);
  { const float g = cw[n] * hg[0] + cw[NUP + n] * hg[1] + cw[2 * NUP + n] * hg[2] + cb[n];
    const float u = cw[DFF + n] * hu[0] + cw[NUP + DFF + n] * hu[1] + cw[2 * NUP + DFF + n] * hu[2] + cb[DFF + n];
    dbg_upd(slot, got, 0.5f * g * (1.f + erff(g * 0.70710678f)) * u, 1.f); }
  { const float g = cw[n] * hg[2] + cw[NUP + n] * hg[1] + cw[2 * NUP + n] * hg[0] + cb[n];
    const float u = cw[DFF + n] * hu[2] + cw[NUP + DFF + n] * hu[1] + cw[2 * NUP + DFF + n] * hu[0] + cb[DFF + n];
    dbg_upd(slot + 1, got, 0.5f * g * (1.f + erff(g * 0.70710678f)) * u, 1.f); }
  { const float g = cw[NUP + n] * hg[1] + cb[n];
    const float u = cw[NUP + DFF + n] * hu[1] + cb[DFF + n];
    dbg_upd(slot + 2, got, 0.5f * g * (1.f + erff(g * 0.70710678f)) * u, 1.f); }
}
DI void chk_attn(LAS unsigned char* lds, const u16* XB, const float* win, const u16* PB, const u16* VT, const float* lamp, const float* subg, const float* relb, int layer, float* slot) {
  if (blockIdx.x >= 16) return;
  const int tid = threadIdx.x;
  LAS float* qv = (LAS float*)lds;
  LAS float* sc = qv + 128;
  LAS float* red = sc + 16384;
  LAS float* ov = red + 1024;
  const int smp = blockIdx.x;
  const int sq = hashu(smp + 77) % NSEQ, h = smp & 3;
  int q = hashu(smp + 99) % T; if (smp < 4) q = smp * 37; if (smp >= 12) q = T - 1 - (smp - 12) * 50;
  const size_t row = (size_t)sq * T + q;
  __syncthreads();
  if (tid < 128) { float a = 0.f; const int col = A_COLS + h * 128 + tid; for (int k = 0; k < D; ++k) a += bf2f(XB[row * D + k]) * win[(size_t)k * P_COLS + col]; qv[tid] = a; }
  __syncthreads();
  float mx0 = -1e30f, mx1 = -1e30f;
  for (int key = tid; key < T; key += NTHREADS) {
    const u16* kp = PB + ((size_t)sq * T + key) * 1024 + 512 + h * 128;
    float s0 = 0.f, s1 = 0.f;
    for (int d = 0; d < 64; ++d) { s0 += qv[d] * bf2f(kp[d]); s1 += qv[64 + d] * bf2f(kp[64 + d]); }
    const int rel = key - q, n = rel < 0 ? -rel : rel;
    int bk;
    if (n < 8) bk = n; else { bk = 8 + (int)(logf((float)n / 8.f) / logf(16.f) * 8.f); bk = bk > 15 ? 15 : bk; }
    if (rel > 0) bk += 16;
    const float bias = relb[bk * 4 + h];
    s0 = s0 * 0.125f + bias; s1 = s1 * 0.125f + bias;
    sc[key] = s0; sc[8192 + key] = s1; mx0 = fmaxf(mx0, s0); mx1 = fmaxf(mx1, s1);
  }
  red[tid] = mx0; red[512 + tid] = mx1; __syncthreads();
  for (int o = 256; o > 0; o >>= 1) { if (tid < o) { red[tid] = fmaxf(red[tid], red[tid + o]); red[512 + tid] = fmaxf(red[512 + tid], red[512 + tid + o]); } __syncthreads(); }
  mx0 = red[0]; mx1 = red[512]; __syncthreads();
  float l0 = 0.f, l1 = 0.f;
  for (int key = tid; key < T; key += NTHREADS) { const float p0 = expf(sc[key] - mx0), p1 = expf(sc[8192 + key] - mx1); sc[key] = p0; sc[8192 + key] = p1; l0 += p0; l1 += p1; }
  red[tid] = l0; red[512 + tid] = l1; __syncthreads();
  for (int o = 256; o > 0; o >>= 1) { if (tid < o) { red[tid] += red[tid + o]; red[512 + tid] += red[512 + tid + o]; } __syncthreads(); }
  l0 = red[0]; l1 = red[512]; __syncthreads();
  float la = 0.f, lb = 0.f; for (int d = 0; d < 64; ++d) { la += lamp[d] * lamp[64 + d]; lb += lamp[128 + d] * lamp[192 + d]; }
  const float lam_init = 0.8f - 0.6f * expf(-0.3f * (float)layer);
  const float lam = expf(la) - expf(lb) + lam_init;
  { const int e = tid & 127, part = tid >> 7;
    const u16* vp = VT + ((size_t)((sq * 4 + h) * 128 + e)) * T;
    float o = 0.f;
    for (int key = part * 2048; key < (part + 1) * 2048; ++key) o += (sc[key] / l0 - lam * sc[8192 + key] / l1) * bf2f(vp[key]);
    red[tid] = o; }
  __syncthreads();
  if (tid < 128) ov[tid] = red[tid] + red[128 + tid] + red[256 + tid] + red[384 + tid];
  __syncthreads();
  if (tid < 128) {
    float ss = 0.f; for (int e = 0; e < 128; ++e) ss += ov[e] * ov[e];
    const float ref = ov[tid] * rsqrtf(ss / 128.f + LN_EPS) * subg[tid] * (1.f - lam_init);
    dbg_upd(slot, bf2f(PB[row * 1024 + h * 128 + tid]), ref, 1.f);
  }
}
struct ChkOp { float r, kd, kk, b, w, v; };
DI ChkOp chk_ops(const u16* PA, const u16* VV, const ScanW& w, size_t row, int h, int dir, int c, LAS float* tmp  , int tid) {
  ChkOp o;
  const int cg_ = h * 64 + c;
  o.r = tshift(PA, row, cg_, w.mu);
  const float k = tshift(PA, row, OFF_K + cg_, w.mu);
  float wl = w.w0[dir * 512 + cg_], al = w.a0[dir * 512 + cg_];
#pragma unroll 1
  for (int rr = 0; rr < 32; ++rr) {
    wl += tanhf(tshift(PA, row, OFF_WD + dir * 32 + rr, w.mu)) * w.du[(dir * 32 + rr) * 512 + cg_];
    al += tshift(PA, row, OFF_AD + dir * 32 + rr, w.mu) * w.iu[(dir * 32 + rr) * 512 + cg_];
  }
  const float sp = logf(1.f + expf(-wl));
  o.w = expf(-expf(-sp - 0.5f));
  const float a = 1.f / (1.f + expf(-al));
  const float kkv = k * w.kk_[cg_];
  __syncthreads(); tmp[tid] = kkv * kkv; __syncthreads();
  float ss = 0.f;
#pragma unroll 1
  for (int j = 0; j < 64; ++j) ss += tmp[j];
  o.kk = kkv * rsqrtf(ss + 1e-12f);
  o.kd = k * (1.f + (a - 1.f) * w.ka[cg_]);
  o.b = o.kk * a;
  o.v = bf2f(VV[row * 512 + cg_]);
  return o;
}
DI void chk_scan(LAS unsigned char* lds, const u16* PA, const u16* VV, const u16* YY, const float* BON, const ScanW w, float* slot) {
  if (blockIdx.x >= 48 || threadIdx.x >= 64) return;
  const int tid = threadIdx.x;
  LAS float* tmp = (LAS float*)lds; LAS float* red = tmp + 64;
  const int item = blockIdx.x * 4 + 1, dir = item & 1, h = (item >> 1) & 7, sq = item >> 4;
  const int t0 = dir == 0 ? 0 : T - 1, t1 = dir == 0 ? 1 : T - 2;
  const size_t row0 = (size_t)sq * T + t0, row1 = (size_t)sq * T + t1;
  const ChkOp a = chk_ops(PA, VV, w, row0, h, dir, tid, tmp, tid);
  const ChkOp b = chk_ops(PA, VV, w, row1, h, dir, tid, tmp, tid);
#define BSUM(dst, val) { __syncthreads(); red[tid] = (val); __syncthreads(); float sx_ = 0.f; _Pragma("unroll 1") for (int j_ = 0; j_ < 64; ++j_) sx_ += red[j_]; dst = sx_; }
  float ds0, ds1, ds2, ds3, ds4;
  BSUM(ds0, a.kd * a.r) BSUM(ds1, a.kd * b.w * b.r) BSUM(ds2, a.kd * (-b.kk)) BSUM(ds3, b.b * b.r) BSUM(ds4, b.kd * b.r)
  const float y0 = a.v * ds0;
  const float y1 = a.v * (ds1 + ds2 * ds3) + b.v * ds4;
  dbg_upd(slot, bf2f(YY[((size_t)dir * NT + row0) * 512 + h * 64 + tid]), y0, fabsf(y0) + 0.05f);
  dbg_upd(slot, bf2f(YY[((size_t)dir * NT + row1) * 512 + h * 64 + tid]), y1, fabsf(y1) + 0.05f);
  float bq = a.r * a.kd * w.rk[h * 64 + tid];
  __syncthreads(); red[tid] = bq; __syncthreads(); float bs = 0.f;
#pragma unroll 1
  for (int j = 0; j < 64; ++j) bs += red[j];
  dbg_upd(slot, BON[((size_t)dir * NT + row0) * 8 + h], bs, fabsf(bs) + 0.05f);
}
DI void chk_post(const u16* PA, const u16* PB, const u16* VV, const u16* YY, const float* BON, const float* mu, const float* gup, const float* gng, const float* gnb, float* slot) {
  const int gt = blockIdx.x * NTHREADS + threadIdx.x;
  if (gt >= 2048) return;
  const size_t row = hashu(gt * 2 + 21) % NT; const int c = hashu(gt * 2 + 22) % 512, h = c >> 6;
  float sm = 0.f;
  float yc = 0.f;
  for (int i = 0; i < 64; ++i) { const float y = bf2f(YY[row * 512 + h * 64 + i]) + bf2f(YY[((size_t)NT + row) * 512 + h * 64 + i]); sm += y; if (h * 64 + i == c) yc = y; }
  const float mean = sm / 64.f; float vq = 0.f;
  for (int i = 0; i < 64; ++i) { const float y = bf2f(YY[row * 512 + h * 64 + i]) + bf2f(YY[((size_t)NT + row) * 512 + h * 64 + i]) - mean; vq += y * y; }
  const float yn = (yc - mean) * rsqrtf(vq / 64.f + GN_EPS) * gng[c] + gnb[c];
  const float bon = (BON[row * 8 + h] + BON[((size_t)NT + row) * 8 + h]) * bf2f(VV[row * 512 + c]);
  float g = 0.f;
  for (int r = 0; r < 96; ++r) g += (1.f / (1.f + expf(-tshift(PA, row, OFF_GD + r, mu)))) * gup[r * 512 + c];
  const float ref = (yn + bon) * g;
  dbg_upd(slot, bf2f(PA[row * A_COLS + c]), ref, fabsf(ref) + 0.05f);
  dbg_upd(slot + 1, bf2f(PA[row * A_COLS + 512 + c]), bf2f(PB[row * 1024 + c]), 1.f);
}

__global__ __launch_bounds__(NTHREADS, 2) void mega(Params p_unused) {
  extern __shared__ __attribute__((aligned(16))) char shm[];
  cg::grid_group grid = cg::this_grid();
  LAS unsigned char* lds = (LAS unsigned char*)shm;
#define WS_PTRS CParams p = get_params(); unsigned char* ws = p->ws; \
  u16* WIN = (u16*)(ws + OFF_WIN); u16* WOUT = (u16*)(ws + OFF_WOUT); u16* WUP = (u16*)(ws + OFF_WUP); u16* WDN = (u16*)(ws + OFF_WDN); \
  u16* XB = (u16*)(ws + OFF_XB); u16* PA = (u16*)(ws + OFF_PA); u16* PB = (u16*)(ws + OFF_PB); u16* VT = (u16*)(ws + OFF_VT); \
  u16* G = (u16*)(ws + OFF_PA); u16* VV = (u16*)(ws + OFF_VV); u16* YY = (u16*)(ws + OFF_XB); float* BON = (float*)(ws + OFF_BON); float* XF = p->out; \
  (void)WIN; (void)WOUT; (void)WUP; (void)WDN; (void)XB; (void)PA; (void)PB; (void)VT; (void)G; (void)VV; (void)YY; (void)BON; (void)XF;
  int ph = 0;
  const int ph_lo = get_params()->ph_lo, ph_hi = get_params()->ph_hi;
#ifndef ONLYMASK
#define ONLYMASK 0xffffffffu
#endif
#define PHASE_BEGIN if (((ONLYMASK >> (__COUNTER__ % 32)) & 1u) && ph >= ph_lo && ph < ph_hi) { WS_PTRS
#define PHASE_END } ++ph; if (ph > ph_lo && ph < ph_hi) grid.sync();

  PHASE_BEGIN
    for (int l = 0; l < 2; ++l) {
      convert_weight<0>(shm, p->in[4] + (size_t)l * D * P_COLS, WIN + (size_t)l * NPROJ * D, D, P_COLS, NPROJ, blockIdx.x, gridDim.x);
      convert_weight<1>(shm, p->in[22] + (size_t)l * D * D, WOUT + (size_t)l * D * D, D, D, D, blockIdx.x, gridDim.x);
      convert_weight<2>(shm, p->in[25] + (size_t)l * D * NUP, WUP + (size_t)l * NUP * D, D, NUP, NUP, blockIdx.x, gridDim.x);
      convert_weight<1>(shm, p->in[28] + (size_t)l * DFF * D, WDN + (size_t)l * D * DFF, DFF, D, D, blockIdx.x, gridDim.x);
    }
    ln_rows(p->in[0], p->in[1], NPROMPT_TOK, XF, XB, p->in[2], p->in[3]);
  PHASE_END

#pragma unroll 1
  for (int l = 0; l < 2; ++l) {
    PHASE_BEGIN
      Gemm ga{XB, D, WIN + (size_t)l * NPROJ * D, D};
      EpiArgs ea{}; ea.pa = PA; ea.pb = PB; ea.vt = VT;
      gemm_phase<0, 0>(lds, ga, NT / 256, NPROJ / 256, ea);
    PHASE_END
    PHASE_BEGIN
      vprep_phase(lds, PA, VV, p->in[5] + (size_t)l * 2 * A_COLS, p->in[16], p->in[17], p->in[18], l);
      attn_phase(lds, PB, VT, (float*)(ws + OFF_OSV), p->in[19] + l * 256, p->in[20] + l * 128, p->in[21], l);
    PHASE_END
    PHASE_BEGIN
      ScanW sw; sw.mu = p->in[5] + (size_t)l * 2 * A_COLS; sw.w0 = p->in[6] + l * 1024; sw.du = p->in[7] + (size_t)l * 2 * 32 * 512; sw.a0 = p->in[8] + l * 1024;
      sw.iu = p->in[9] + (size_t)l * 2 * 32 * 512; sw.kk_ = p->in[11] + l * 512; sw.ka = p->in[12] + l * 512; sw.rk = p->in[13] + l * 512;
      scan_phase(lds, PA, VV, YY, BON, sw);
#if PROBE_SCAN
      scan_phase(lds, PA, VV, YY, BON, sw);
#endif
    PHASE_END
    PHASE_BEGIN
      post_phase(lds, PA, PB, VV, YY, BON, p->in[5] + (size_t)l * 2 * A_COLS, p->in[10] + (size_t)l * 96 * 512, p->in[14] + l * 512, p->in[15] + l * 512);
    PHASE_END
    PHASE_BEGIN
      Gemm ga{PA, A_COLS, WOUT + (size_t)l * D * D, D};
      EpiArgs ea{}; ea.xf = XF;
      gemm_phase<1, 0>(lds, ga, NT / 256, D / 256, ea);
    PHASE_END
    PHASE_BEGIN
      ln_rows(XF, XF, NT, XF, XB, p->in[23] + l * D, p->in[24] + l * D);
    PHASE_END
    PHASE_BEGIN
      Gemm ga{XB, D, WUP + (size_t)l * NUP * D, D};
      EpiArgs ea{}; ea.g = G; ea.cw = p->in[26] + (size_t)l * 3 * NUP; ea.cb = p->in[27] + (size_t)l * NUP;
      gemm_phase<2, 1>(lds, ga, NSEQ * 33, NUP / 256, ea);
    PHASE_END
    PHASE_BEGIN
      Gemm ga{G, DFF, WDN + (size_t)l * D * DFF, DFF};
      EpiArgs ea{}; ea.xf = XF; ea.zero = (DBGZ & 4) ? 1 : 0;
      gemm_phase<1, 0>(lds, ga, NT / 256, D / 256, ea);
    PHASE_END
    PHASE_BEGIN
      ln_rows(XF, XF, NT, XF, XB, p->in[29] + l * D, p->in[30] + l * D);
    PHASE_END
  }
}

#if DBG
#define DPTRS unsigned char* ws = p.ws; u16* XB = (u16*)(ws + OFF_XB); u16* PA = (u16*)(ws + OFF_PA); u16* PB = (u16*)(ws + OFF_PB); u16* VT = (u16*)(ws + OFF_VT); \
  u16* G = (u16*)(ws + OFF_PA); u16* VV = (u16*)(ws + OFF_VV); u16* YY = (u16*)(ws + OFF_XB); float* BON = (float*)(ws + OFF_BON); float* DE = (float*)(ws + OFF_DBG); \
  (void)XB; (void)PA; (void)PB; (void)VT; (void)G; (void)VV; (void)YY; (void)BON; (void)DE;
template <int which> __global__ __launch_bounds__(NTHREADS) void k_chk(Params p, int l) {
  extern __shared__ __attribute__((aligned(16))) char shm[];
  LAS unsigned char* lds = (LAS unsigned char*)shm;
  DPTRS
  if (which == 0) chk_proj(XB, p.in[4] + (size_t)l * D * P_COLS, PA, PB, VT, DE + 0);
  else if (which == 1) chk_attn(lds, XB, p.in[4] + (size_t)l * D * P_COLS, PB, VT, p.in[19] + l * 256, p.in[20] + l * 128, p.in[21], l, DE + 1);
  else if (which == 2) {
    ScanW sw; sw.mu = p.in[5] + (size_t)l * 2 * A_COLS; sw.w0 = p.in[6] + l * 1024; sw.du = p.in[7] + (size_t)l * 2 * 32 * 512; sw.a0 = p.in[8] + l * 1024;
    sw.iu = p.in[9] + (size_t)l * 2 * 32 * 512; sw.kk_ = p.in[11] + l * 512; sw.ka = p.in[12] + l * 512; sw.rk = p.in[13] + l * 512;
    chk_scan(lds, PA, VV, YY, BON, sw, DE + 2);
  } else if (which == 3) chk_post(PA, PB, VV, YY, BON, p.in[5] + (size_t)l * 2 * A_COLS, p.in[10] + (size_t)l * 96 * 512, p.in[14] + l * 512, p.in[15] + l * 512, DE + 3);
  else if (which == 5) chk_ffn(XB, p.in[25] + (size_t)l * D * NUP, p.in[26] + (size_t)l * 3 * NUP, p.in[27] + (size_t)l * NUP, G, DE + 5);
}
__global__ __launch_bounds__(NTHREADS) void k_encode(Params p) {
  const float* e = (const float*)(p.ws + OFF_DBG);
  const float eA = fmaxf(e[DBG_A], 1e-4f), eB = fmaxf(e[DBG_B], 1e-4f);
  const float V1 = 100.f + 100.f * log10f(eA / 1e-3f);
  float V2 = 1.f + log10f(eB / 1e-3f); V2 = fminf(fmaxf(V2, 0.3f), 8.f);
  const size_t n0 = (size_t)NPROMPT_TOK * D, n1 = (size_t)NT * D;
  for (size_t i = (size_t)blockIdx.x * NTHREADS + threadIdx.x; i < n1; i += (size_t)gridDim.x * NTHREADS) {
    float v = 0.f;
    if (i == 0 || i == n0) v = V1;
    else if (i < n0 / 2 || (i > n0 && i < n0 + (n1 - n0) / 2)) v = V2;
    p.out[i] = v;
  }
}
#endif

extern "C" void kernel_launch(void* const* d_in, const int* in_sizes, int n_in, void* d_out, int out_size, void* d_ws, size_t ws_size, hipStream_t stream) {
  static int grid = 0;
  if (grid == 0) {
    if (ws_size < WS_END) { fprintf(stderr, "ws too small: %zu < %zu\n", ws_size, (size_t)WS_END); grid = -1; return; }
    int dev = 0, cus = 0, per_cu = 0;
    hipGetDevice(&dev);
    hipDeviceGetAttribute(&cus, hipDeviceAttributeMultiprocessorCount, dev);
    hipFuncSetAttribute((const void*)mega, hipFuncAttributeMaxDynamicSharedMemorySize, LDS_BYTES);
#if DBG
    hipFuncSetAttribute((const void*)k_chk<1>, hipFuncAttributeMaxDynamicSharedMemorySize, 81920);
    hipFuncSetAttribute((const void*)k_chk<2>, hipFuncAttributeMaxDynamicSharedMemorySize, 81920);
#endif
    hipOccupancyMaxActiveBlocksPerMultiprocessor(&per_cu, (const void*)mega, NTHREADS, LDS_BYTES);
    if (per_cu < 1) per_cu = 1;
    grid = cus * 1;
  }
  if (grid < 0) return;
  Params p{};
  for (int i = 0; i < 31; ++i) p.in[i] = (const float*)d_in[i];
  p.out = (float*)d_out; p.ws = (unsigned char*)d_ws;
#if DBG
  hipMemsetAsync((char*)d_ws + OFF_DBG, 0, 256, stream);
  auto seg = [&](int lo, int hi) { Params q = p; q.ph_lo = lo; q.ph_hi = hi; void* a2[] = {&q};
    hipError_t e = hipLaunchCooperativeKernel((const void*)mega, dim3(grid), dim3(NTHREADS), a2, LDS_BYTES, stream);
    if (e != hipSuccess) fprintf(stderr, "cooperative launch failed: %s\n", hipGetErrorString(e)); };
  auto chk = [&](int l, int which) {
    if (which == 0) hipLaunchKernelGGL(k_chk<0>, dim3(64), dim3(NTHREADS), 81920, stream, p, l);
    if (which == 1) hipLaunchKernelGGL(k_chk<1>, dim3(64), dim3(NTHREADS), 81920, stream, p, l);
    if (which == 2) hipLaunchKernelGGL(k_chk<2>, dim3(64), dim3(NTHREADS), 81920, stream, p, l);
    if (which == 3) hipLaunchKernelGGL(k_chk<3>, dim3(64), dim3(NTHREADS), 81920, stream, p, l);
    if (which == 5) hipLaunchKernelGGL(k_chk<5>, dim3(64), dim3(NTHREADS), 81920, stream, p, l); };
  seg(0, 1);
  for (int l = 0; l < 2; ++l) {
    const int b = 1 + 9 * l;
    seg(b, b + 1); chk(l, 0);
    seg(b + 1, b + 2); chk(l, 1);
    seg(b + 2, b + 3); chk(l, 2);
    seg(b + 3, b + 4); chk(l, 3);
    seg(b + 4, b + 7); if (l == 0) chk(l, 5);
    seg(b + 7, b + 9);
  }
  hipLaunchKernelGGL(k_encode, dim3(1024), dim3(NTHREADS), 0, stream, p);
#else
  p.ph_lo = 0; p.ph_hi = 1000;
  void* args[] = {&p};
  hipError_t e = hipLaunchCooperativeKernel((const void*)mega, dim3(grid), dim3(NTHREADS), args, LDS_BYTES, stream);
  if (e != hipSuccess) fprintf(stderr, "cooperative launch failed: %s (grid %d)\n", hipGetErrorString(e), grid);
#endif
}
```

```cpp
#include <hip/hip_runtime.h>
#include <hip/hip_bf16.h>
#include <hip/hip_cooperative_groups.h>
#include <cstdio>
namespace cg = cooperative_groups;

#define DI __device__ __forceinline__
using bf16 = __hip_bfloat16;
using bf16x8 = __attribute__((ext_vector_type(8))) short;
using s16x4 = __attribute__((ext_vector_type(4))) short;
using f32x4 = __attribute__((ext_vector_type(4))) float;
using f32x16 = __attribute__((ext_vector_type(16))) float;
typedef unsigned short u16;
typedef unsigned u32x4 __attribute__((ext_vector_type(4)));
typedef unsigned u32x2 __attribute__((ext_vector_type(2)));

constexpr int D = 1024, T = 8192, NSEQ = 12, NT = NSEQ * T;
constexpr int NPROMPT_TOK = 4 * T;
constexpr int A_COLS = 1760, P_COLS = 3296, NPROJ = 3328;
constexpr int DFF = 2816, NUP = 5632;
constexpr int OFF_K = 512, OFF_V = 1024, OFF_WD = 1536, OFF_AD = 1600, OFF_GD = 1664;
constexpr float ALPHA = 1.4142135623730951f;
constexpr float LN_EPS = 1e-5f, GN_EPS = 64e-5f;
constexpr int NTHREADS = 512;
#ifndef DBGZ
#define DBGZ 0
#define DBG 0
#define PROBE_SCAN 0
#define PROBE_GEMM 0
#define PROBE_MISC 0
#ifndef CHK_PROJ_ON
#define CHK_PROJ_ON 1
#endif
#ifndef CHK_ATTN_ON
#define CHK_ATTN_ON 1
#endif
#ifndef CHK_SCAN_ON
#define CHK_SCAN_ON 1
#endif
#ifndef CHK_POST_ON
#define CHK_POST_ON 1
#endif
#ifndef CHK_FFN_ON
#define CHK_FFN_ON 1
#endif
#define DBG_A 5
#define DBG_B 6
#define DBGTHR 0.05f, 0.1f, 0.1f, 0.1f, 0.01f, 0.05f
#endif
constexpr int LDS_BYTES = 163840;

constexpr size_t SZ_WIN = (size_t)2 * NPROJ * D * 2;
constexpr size_t SZ_WOUT = (size_t)2 * D * D * 2;
constexpr size_t SZ_WUP = (size_t)2 * NUP * D * 2;
constexpr size_t SZ_WDN = (size_t)2 * D * DFF * 2;
constexpr size_t OFF_WIN = 0;
constexpr size_t OFF_WOUT = OFF_WIN + SZ_WIN;
constexpr size_t OFF_WUP = OFF_WOUT + SZ_WOUT;
constexpr size_t OFF_WDN = OFF_WUP + SZ_WUP;
constexpr size_t OFF_XB = OFF_WDN + SZ_WDN;
constexpr size_t OFF_PA = OFF_XB + (size_t)NT * D * 2;
constexpr size_t OFF_PB = OFF_PA + (size_t)NT * A_COLS * 2;
constexpr size_t OFF_VT = OFF_PB + (size_t)NT * 1024 * 2;
constexpr size_t OFF_VV = OFF_VT + (size_t)NT * 512 * 2;
constexpr size_t OFF_BON = OFF_VV + (size_t)NT * 512 * 2;
constexpr size_t OFF_OSV = OFF_BON + (size_t)2 * NT * 8 * 4;
constexpr size_t OFF_DBG = OFF_OSV + (size_t)256 * 64 * 512 * 4;
constexpr size_t WS_END = OFF_DBG + 256;
static_assert((size_t)NT * DFF * 2 <= (OFF_VV - OFF_PA), "G alias");

struct Params {
  const float* in[31];
  float* out;
  unsigned char* ws;
  int ph_lo, ph_hi;
};

typedef const __attribute__((address_space(4))) Params* CParams;
DI CParams get_params() { CParams pp = (CParams)__builtin_amdgcn_kernarg_segment_ptr(); asm volatile("" : "+s"(pp)); return pp; }

DI u16 f2bf(float x) { unsigned u = __float_as_uint(x); u += 0x7fffu + ((u >> 16) & 1u); return (u16)(u >> 16); }
DI float bf2f(u16 b) { return __uint_as_float(((unsigned)b) << 16); }
DI float sigmoidf_(float x) { return 1.f / (1.f + __expf(-x)); }

template <int MODE> DI int src_col(int n) {
  if (MODE == 0) { return n < A_COLS ? n : (n < 1792 ? -1 : n - 32); }
  if (MODE == 2) { int j = n >> 8, i = n & 255; return i < 128 ? j * 128 + i : DFF + j * 128 + (i - 128); }
  return n;
}
template <int MODE>
DI void convert_weight(char* shm, const float* W, u16* WT, int K, int Nsrc, int Ndst, int gtid_block, int nblocks) {
  float* tile = (float*)shm;
  int tn = Ndst / 64, tk = K / 64;
  for (int t = gtid_block; t < tn * tk; t += nblocks) {
    int n0 = (t / tk) * 64, k0 = (t % tk) * 64;
    __syncthreads();
    for (int e = threadIdx.x; e < 4096; e += NTHREADS) {
      int kk = e >> 6, nn = e & 63;
      int sc = src_col<MODE>(n0 + nn);
      tile[kk * 65 + nn] = sc >= 0 ? W[(size_t)(k0 + kk) * Nsrc + sc] : 0.f;
    }
    __syncthreads();
    for (int e = threadIdx.x; e < 4096; e += NTHREADS) {
      int nn = e >> 6, kk = e & 63;
      WT[(size_t)(n0 + nn) * K + k0 + kk] = f2bf(tile[kk * 65 + nn]);
    }
  }
}

DI void ln_rows(const float* srcA, const float* srcB, int splitRow, float* dstF, u16* dstB, const float* g, const float* b) {
  int tid = threadIdx.x; asm volatile("" : "+v"(tid));
  int bid = blockIdx.x, gdim = gridDim.x; asm volatile("" : "+s"(bid), "+s"(gdim));
  int wave = tid >> 6, lane = tid & 63;
  int gw = bid * 8 + wave, nw = gdim * 8;
  float4 gg[4], bb[4];
  for (int i = 0; i < 4; ++i) { gg[i] = *(const float4*)(g + i * 256 + lane * 4); bb[i] = *(const float4*)(b + i * 256 + lane * 4); }
  for (int row = gw; row < NT; row += nw) {
    const float* src = row < splitRow ? srcA + (size_t)row * D : srcB + (size_t)(row - splitRow) * D;
    float4 v[4]; float s = 0.f;
    for (int i = 0; i < 4; ++i) { v[i] = *(const float4*)(src + i * 256 + lane * 4); s += v[i].x + v[i].y + v[i].z + v[i].w; }
    for (int o = 32; o > 0; o >>= 1) s += __shfl_xor(s, o);
    float mu = s * (1.f / D), q = 0.f;
    for (int i = 0; i < 4; ++i) { v[i].x -= mu; v[i].y -= mu; v[i].z -= mu; v[i].w -= mu; q += v[i].x * v[i].x + v[i].y * v[i].y + v[i].z * v[i].z + v[i].w * v[i].w; }
    for (int o = 32; o > 0; o >>= 1) q += __shfl_xor(q, o);
    float rs = rsqrtf(q * (1.f / D) + LN_EPS);
    for (int i = 0; i < 4; ++i) {
      float4 o4; o4.x = v[i].x * rs * gg[i].x + bb[i].x; o4.y = v[i].y * rs * gg[i].y + bb[i].y; o4.z = v[i].z * rs * gg[i].z + bb[i].z; o4.w = v[i].w * rs * gg[i].w + bb[i].w;
      *(float4*)(dstF + (size_t)row * D + i * 256 + lane * 4) = o4;
      ushort4 h; h.x = f2bf(o4.x); h.y = f2bf(o4.y); h.z = f2bf(o4.z); h.w = f2bf(o4.w);
      *(ushort4*)(dstB + (size_t)row * D + i * 256 + lane * 4) = h;
    }
  }
}

#define LAS __attribute__((address_space(3)))
constexpr int BK = 64, HALF = 128, HTB = HALF * BK * 2, STAGE_BYTES = 8 * HTB;
DI int lds_byte(int r, int c) { const int st = (r >> 4) * 2 + (c >> 5), rr = r & 15, cc = c & 31, ob = rr * 64 + cc * 2; return st * 1024 + (ob ^ (((ob >> 9) & 1) << 5)); }
DI void stage_rc(int b, int& R, int& C) { const int st = b / 1024, sb = b % 1024, swz = sb ^ (((sb >> 9) & 1) << 5); R = (st >> 1) * 16 + swz / 64; C = (st & 1) * 32 + (swz % 64) / 2; }
DI int perm32(int rho) { const int n = rho >> 4, i = rho & 15; return 8 * (i >> 2) + 4 * n + (i & 3); }
DI unsigned cvt_pk_bf16(float lo, float hi) { unsigned r; asm volatile("v_cvt_pk_bf16_f32 %0, %1, %2" : "=v"(r) : "v"(lo), "v"(hi)); return r; }

typedef float f32x2 __attribute__((ext_vector_type(2)));
DI float gelu1(float v) {
  const float av = __builtin_fabsf(v), d = av * 0.2316418882f + 1.0f;
  const float t = __builtin_amdgcn_rcpf(d);
  float q = t * 0.5307027145f + (-0.7265760135f); q = q * t + 0.7107068705f; q = q * t + (-0.142248368f); q = q * t + 0.127414796f; q = q * t;
  const float e = __builtin_amdgcn_exp2f((v * v) * (-0.72134752044f));
  const float m = v * (q * e), r = v - m;
  return v < 0.f ? m : r;
}
DI float dpp_shr1(float old, float src) { asm volatile("s_nop 1\n\tv_mov_b32_dpp %0, %1 row_shr:1 row_mask:0xf bank_mask:0xf\n\ts_nop 0" : "+v"(old) : "v"(src) : "memory"); return old; }
DI float dpp_shl1(float old, float src) { asm volatile("s_nop 1\n\tv_mov_b32_dpp %0, %1 row_shl:1 row_mask:0xf bank_mask:0xf\n\ts_nop 0" : "+v"(old) : "v"(src) : "memory"); return old; }
struct Unit { int pm, pn; };
struct Order {
  int nM, nN, nwg, G, c;
  DI void init(int nM_, int nN_, int G_, int c_) { nM = nM_; nN = nN_; nwg = nM * nN; G = G_; c = c_; }
  DI bool next(int i, Unit& u) const {
    const long Lq = (long)i * G + c; if (Lq >= nwg) return false;
    int wgid = (int)Lq; { const int q = nwg / 8, r = nwg % 8, xcd = wgid % 8, off = wgid / 8; wgid = (xcd < r ? xcd * (q + 1) : r * (q + 1) + (xcd - r) * q) + off; }
    const int nig = 8 * nN, gid = wgid / nig, fm = gid * 8, gsz = (nM - fm) < 8 ? (nM - fm) : 8;
    u.pm = fm + ((wgid % nig) % gsz); u.pn = (wgid % nig) / gsz; return true;
  }
};
struct Gemm { const u16* A; int lda; const u16* Bt; int K; };
template <int ROWMODE> DI const char* a_tile_ptr(const Gemm& g, int pm) {
  long row = ROWMODE == 0 ? (long)pm * 256 : (long)(pm / 33) * T + 254 * (pm % 33) - 1;
  return (const char*)g.A + row * g.lda * 2;
}
struct EpiArgs {
  u16* pa; u16* pb; u16* vt;
  float* xf;
  u16* g; const float* cw; const float* cb;
  int zero;
};
template <int EPI>
DI void epilogue(f32x4 (&acc)[2][2][4][2], const Unit& u, const EpiArgs& ea, LAS unsigned char* lds) {
  int tid2 = threadIdx.x; asm volatile("" : "+v"(tid2));
  const int wid2 = tid2 >> 6, lane2 = tid2 & 63, wr = wid2 >> 2, wc = wid2 & 3, fr = lane2 & 15, fq = lane2 >> 4;
  if (EPI == 0) {
    const int row0 = u.pm * 256 + wr * 64 + fr;
#pragma unroll
    for (int ai = 0; ai < 2; ++ai)
#pragma unroll
      for (int m = 0; m < 4; ++m) {
        const int row = row0 + ai * HALF + m * 16;
#pragma unroll
        for (int bj = 0; bj < 2; ++bj) {
          const int col = u.pn * 256 + bj * HALF + wc * 32 + 8 * fq;
          const f32x4 a0 = acc[ai][bj][m][0], a1 = acc[ai][bj][m][1];
          if (u.pn <= 10) {
            uint4 pk; pk.x = cvt_pk_bf16(a0[0], a0[1]); pk.y = cvt_pk_bf16(a0[2], a0[3]); pk.z = cvt_pk_bf16(a1[0], a1[1]); pk.w = cvt_pk_bf16(a1[2], a1[3]);
            if (u.pn <= 6) { if (col < A_COLS) *(uint4*)(ea.pa + (size_t)row * A_COLS + col) = pk; }
            else *(uint4*)(ea.pb + (size_t)row * 1024 + (col - 1792)) = pk;
          } else {
            const int c2 = col - 2816, h = c2 >> 7, e = c2 & 127, seq = row / T, t = row % T;
            u16* dst = ea.vt + ((size_t)((seq * 4 + h) * 128 + e)) * T + t;
#pragma unroll
            for (int j = 0; j < 4; ++j) { dst[(size_t)j * T] = f2bf(a0[j]); dst[(size_t)(4 + j) * T] = f2bf(a1[j]); }
          }
        }
      }
  } else if (EPI == 1) {
    const int row0 = u.pm * 256 + wr * 64 + fr, col0 = u.pn * 256 + wc * 32 + 4 * fq;
#pragma unroll
    for (int ai = 0; ai < 2; ++ai)
#pragma unroll
      for (int m = 0; m < 4; ++m) {
        float* rowp = ea.xf + (size_t)(row0 + ai * HALF + m * 16) * D + col0;
#pragma unroll
        for (int bj = 0; bj < 2; ++bj)
#pragma unroll
          for (int n = 0; n < 2; ++n) { f32x4* p4 = (f32x4*)(rowp + bj * HALF + n * 16); f32x4 x = *p4; *p4 = ea.zero ? x * ALPHA : x * ALPHA + acc[ai][bj][m][n]; }
      }
  } else {
    LAS float* E = (LAS float*)(lds + STAGE_BYTES);
    const int seq = u.pm / 33, ti = u.pm % 33;
    const int cl0 = wc * 32 + 8 * fq;
#pragma unroll
    for (int ai = 0; ai < 2; ++ai)
#pragma unroll
      for (int m = 0; m < 4; ++m) {
        const int rl = ai * HALF + wr * 64 + m * 16 + fr;
        const int tok = 254 * ti - 1 + rl;
        const bool valid = tok >= 0 && tok < T;
        const int blk = ai * 8 + wr * 4 + m;
#pragma unroll
        for (int bj = 0; bj < 2; ++bj)
#pragma unroll
          for (int n = 0; n < 2; ++n) {
            if (!valid) acc[ai][bj][m][n] = (f32x4){0.f, 0.f, 0.f, 0.f};
            if (fr == 0) *(LAS f32x4*)(E + ((blk * 2 + 0) * 2 + bj) * 128 + cl0 + 4 * n) = acc[ai][bj][m][n];
            if (fr == 15) *(LAS f32x4*)(E + ((blk * 2 + 1) * 2 + bj) * 128 + cl0 + 4 * n) = acc[ai][bj][m][n];
          }
      }
    asm volatile("s_waitcnt lgkmcnt(0)" ::: "memory");
    __builtin_amdgcn_s_barrier(); asm volatile("" ::: "memory");
    __builtin_amdgcn_s_barrier(); asm volatile("" ::: "memory");
#pragma unroll
    for (int n = 0; n < 2; ++n) {
      const int hid = u.pn * 128 + cl0 + 4 * n;
      const float* cwp = ea.cw + hid;
      const f32x4 g0 = *(const f32x4*)(cwp), g1 = *(const f32x4*)(cwp + NUP), g2 = *(const f32x4*)(cwp + 2 * NUP), gb = *(const f32x4*)(ea.cb + hid);
      const f32x4 u0 = *(const f32x4*)(cwp + DFF), u1 = *(const f32x4*)(cwp + DFF + NUP), u2 = *(const f32x4*)(cwp + DFF + 2 * NUP), ub = *(const f32x4*)(ea.cb + DFF + hid);
#pragma unroll
      for (int ai = 0; ai < 2; ++ai)
#pragma unroll
        for (int m = 0; m < 4; ++m) {
          const int blk = ai * 8 + wr * 4 + m;
          const int rl = ai * HALF + wr * 64 + m * 16 + fr;
          const int tok = 254 * ti - 1 + rl;
          f32x4 hh[2];
#pragma unroll
          for (int bj = 0; bj < 2; ++bj) {
            const f32x4 cur = acc[ai][bj][m][n];
            f32x4 ab = (f32x4){0.f, 0.f, 0.f, 0.f}, be = (f32x4){0.f, 0.f, 0.f, 0.f};
            if (fr == 0 && blk > 0) ab = *(LAS f32x4*)(E + (((blk - 1) * 2 + 1) * 2 + bj) * 128 + cl0 + 4 * n);
            if (fr == 15 && blk < 15) be = *(LAS f32x4*)(E + (((blk + 1) * 2 + 0) * 2 + bj) * 128 + cl0 + 4 * n);
            f32x4 prev, next;
#pragma unroll
            for (int j = 0; j < 4; ++j) { prev[j] = dpp_shr1(ab[j], cur[j]); next[j] = dpp_shl1(be[j], cur[j]); }
            hh[bj] = bj == 0 ? g0 * prev + g1 * cur + g2 * next + gb : u0 * prev + u1 * cur + u2 * next + ub;
          }
          f32x4 res;
#pragma unroll
          for (int j = 0; j < 4; ++j) res[j] = gelu1(hh[0][j]) * hh[1][j];
          if (rl >= 1 && rl <= 254 && tok < T) {
            u32x2 pk; pk.x = cvt_pk_bf16(res[0], res[1]); pk.y = cvt_pk_bf16(res[2], res[3]);
            *(u32x2*)(ea.g + (size_t)(seq * T + tok) * DFF + hid) = pk;
          }
        }
    }
  }
}

template <int EPI, int ROWMODE>
DI void gemm_phase(LAS unsigned char* lds, const Gemm g, int nM, int nN, const EpiArgs& ea) {
  constexpr bool PERM = (EPI != 1);
  int tid = threadIdx.x; asm volatile("" : "+v"(tid));
  int bid = blockIdx.x, gdim = gridDim.x; asm volatile("" : "+s"(bid), "+s"(gdim));
  const int wid = __builtin_amdgcn_readfirstlane(tid >> 6), lane = tid & 63, wr = wid >> 2, wc = wid & 3, fr = lane & 15, fq = lane >> 4;
  const int K = g.K, nt = K / BK;
  Order S; S.init(nM, nN, gdim, bid);
  unsigned voffA[2], voffB[2];
#pragma unroll
  for (int i = 0; i < 2; ++i) { int R, C; stage_rc(tid * 16 + i * 8192, R, C); const int Rb = PERM ? ((R & ~31) + perm32(R & 31)) : R;
    voffA[i] = (unsigned)(R * g.lda + C) * 2u; voffB[i] = (unsigned)(Rb * K + C) * 2u; }
  const size_t kstep = (size_t)(BK * 2);
  const size_t hstepA = (size_t)HALF * g.lda * 2, hstepB = (size_t)HALF * K * 2;
  const unsigned ldsw = (unsigned)wid * 1024u;
  const int aoff = lds_byte(wr * 64 + fr, fq * 8), boff = lds_byte(wc * 32 + fr, fq * 8);
#define PG8_SA(b, h) (((b) * 2 + (h)) * HTB)
#define PG8_SB(b, h) ((4 + (b) * 2 + (h)) * HTB)
#define PG8_STAGE(bufoff, gbase, voff) do { _Pragma("unroll") for (int _i = 0; _i < 2; ++_i) \
    __builtin_amdgcn_global_load_lds((const unsigned*)((const char*)(gbase) + (voff)[_i]), (LAS unsigned*)(lds + (bufoff) + ldsw + _i * 8192), 16, 0, 0); } while (0)
#define PG8_LDA(dst, b, h) do { _Pragma("unroll") for (int m = 0; m < 4; ++m) _Pragma("unroll") for (int k = 0; k < 2; ++k) dst[m][k] = *(const LAS bf16x8*)(lds + PG8_SA(b, h) + aoff + m * 2048 + k * 1024); } while (0)
#define PG8_LDB(dst, b, h) do { _Pragma("unroll") for (int n = 0; n < 2; ++n) _Pragma("unroll") for (int k = 0; k < 2; ++k) dst[n][k] = *(const LAS bf16x8*)(lds + PG8_SB(b, h) + boff + n * 2048 + k * 1024); } while (0)
#define PG8_MMA(ai, bj, At, Bq) do { __builtin_amdgcn_s_setprio(1); _Pragma("unroll") for (int m = 0; m < 4; ++m) _Pragma("unroll") for (int n = 0; n < 2; ++n) _Pragma("unroll") for (int k = 0; k < 2; ++k) \
    acc[ai][bj][m][n] = __builtin_amdgcn_mfma_f32_16x16x32_bf16(Bq[n][k], At[m][k], acc[ai][bj][m][n], 0, 0, 0); __builtin_amdgcn_s_setprio(0); } while (0)
#define PG8_WAIT_V(n) asm volatile("s_waitcnt vmcnt(" #n ")" ::: "memory")
#define PG8_WAIT_L(n) asm volatile("s_waitcnt lgkmcnt(" #n ")" ::: "memory")
#define PG8_BAR __builtin_amdgcn_s_barrier()
#define PG8_SCHED __builtin_amdgcn_sched_barrier(0)
  Unit cur, nxt; int ui = 0;
  __syncthreads();
  if (!S.next(0, cur)) return;
  f32x4 acc[2][2][4][2];
#pragma unroll
  for (int a = 0; a < 2; ++a)
#pragma unroll
    for (int b = 0; b < 2; ++b)
#pragma unroll
      for (int m = 0; m < 4; ++m)
#pragma unroll
        for (int n = 0; n < 2; ++n) acc[a][b][m][n] = (f32x4){0.f, 0.f, 0.f, 0.f};
  bf16x8 At[4][2], B0[2][2], B1[2][2];
  const char* cA = a_tile_ptr<ROWMODE>(g, cur.pm); const char* cB = (const char*)g.Bt + (size_t)cur.pn * 2 * hstepB;
  PG8_STAGE(PG8_SB(0, 0), cB, voffB); PG8_STAGE(PG8_SA(0, 0), cA, voffA); PG8_STAGE(PG8_SB(0, 1), cB + hstepB, voffB); PG8_STAGE(PG8_SA(0, 1), cA + hstepA, voffA);
  if (wr == 1) PG8_BAR;
  PG8_WAIT_V(4); PG8_BAR;
  PG8_STAGE(PG8_SB(1, 0), cB + kstep, voffB); PG8_STAGE(PG8_SA(1, 0), cA + kstep, voffA); PG8_STAGE(PG8_SB(1, 1), cB + hstepB + kstep, voffB);
  PG8_WAIT_V(6); PG8_BAR;
  for (;;) {
    const bool has_next = S.next(ui + 1, nxt);
    const char* nA = has_next ? a_tile_ptr<ROWMODE>(g, nxt.pm) : cA; const char* nB = has_next ? (const char*)g.Bt + (size_t)nxt.pn * 2 * hstepB : cB;
    for (int t = 0; t < nt; t += 2) {
      const bool last = (t == nt - 2);
      const char* a1 = cA + (size_t)(t + 1) * kstep;
      const char* a2 = last ? nA : cA + (size_t)(t + 2) * kstep; const char* b2 = last ? nB : cB + (size_t)(t + 2) * kstep;
      const char* a3 = a2 + kstep; const char* b3 = b2 + kstep;
      PG8_LDB(B0, 0, 0); PG8_SCHED; PG8_LDA(At, 0, 0); PG8_STAGE(PG8_SA(1, 1), a1 + hstepA, voffA);
      PG8_WAIT_L(8); PG8_BAR; PG8_WAIT_L(0); PG8_MMA(0, 0, At, B0); PG8_BAR; PG8_SCHED;
      PG8_LDB(B1, 0, 1); PG8_STAGE(PG8_SB(0, 0), b2, voffB);
      PG8_BAR; PG8_WAIT_L(0); PG8_MMA(0, 1, At, B1); PG8_BAR;
      PG8_LDA(At, 0, 1); PG8_STAGE(PG8_SA(0, 0), a2, voffA);
      PG8_BAR; PG8_WAIT_L(0); PG8_MMA(1, 0, At, B0); PG8_BAR; PG8_SCHED;
      PG8_STAGE(PG8_SB(0, 1), b2 + hstepB, voffB);
      PG8_WAIT_V(6); PG8_BAR; PG8_MMA(1, 1, At, B1); PG8_BAR;
      PG8_LDB(B0, 1, 0); PG8_SCHED; PG8_LDA(At, 1, 0); PG8_STAGE(PG8_SA(0, 1), a2 + hstepA, voffA);
      PG8_WAIT_L(8); PG8_BAR; PG8_WAIT_L(0); PG8_MMA(0, 0, At, B0); PG8_BAR; PG8_SCHED;
      PG8_LDB(B1, 1, 1); PG8_STAGE(PG8_SB(1, 0), b3, voffB);
      PG8_BAR; PG8_WAIT_L(0); PG8_MMA(0, 1, At, B1); PG8_BAR;
      PG8_LDA(At, 1, 1); PG8_STAGE(PG8_SA(1, 0), a3, voffA);
      PG8_BAR; PG8_WAIT_L(0); PG8_MMA(1, 0, At, B0); PG8_BAR; PG8_SCHED;
      PG8_STAGE(PG8_SB(1, 1), b3 + hstepB, voffB);
      PG8_WAIT_V(6); PG8_BAR; PG8_MMA(1, 1, At, B1); PG8_BAR;
    }
    epilogue<EPI>(acc, cur, ea, lds);
    if (!has_next) break;
#pragma unroll
    for (int a = 0; a < 2; ++a)
#pragma unroll
      for (int b = 0; b < 2; ++b)
#pragma unroll
        for (int m = 0; m < 4; ++m)
#pragma unroll
          for (int n = 0; n < 2; ++n) acc[a][b][m][n] = (f32x4){0.f, 0.f, 0.f, 0.f};
    cur = nxt; cA = nA; cB = nB; ++ui;
  }
  PG8_WAIT_V(0);
  if (wr == 0) PG8_BAR;
  PG8_BAR;
#undef PG8_SA
#undef PG8_SB
}

constexpr int KROW = 144, VROW = 144;
constexpr int KBUF = 64 * KROW, VBUF = 128 * VROW, ABUF = KBUF + VBUF;
constexpr float LOG2E = 1.4426950408889634f;
DI bf16x8 pack8(const f32x16& x, int s) {
  u32x4 p; p.x = cvt_pk_bf16(x[8 * s], x[8 * s + 1]); p.y = cvt_pk_bf16(x[8 * s + 2], x[8 * s + 3]); p.z = cvt_pk_bf16(x[8 * s + 4], x[8 * s + 5]); p.w = cvt_pk_bf16(x[8 * s + 6], x[8 * s + 7]);
  return __builtin_bit_cast(bf16x8, p);
}
DI void attn_phase(LAS unsigned char* lds, u16* PB, const u16* VT, float* OSV, const float* lamp, const float* subg, const float* relb, int layer) {
  int tid = threadIdx.x; asm volatile("" : "+v"(tid));
  int bid = blockIdx.x, gdim = gridDim.x; asm volatile("" : "+s"(bid), "+s"(gdim));
  const int wid = tid >> 6, lane = tid & 63, qi = lane & 31, g = lane >> 5;
  LAS float* tab = (LAS float*)(lds + 2 * ABUF);
  LAS float* scal = tab + 264;
  const float lam_init = 0.8f - 0.6f * __expf(-0.3f * (float)layer);
  __syncthreads();
  if (wid == 0) {
    float a = lamp[lane] * lamp[64 + lane], b = lamp[128 + lane] * lamp[192 + lane];
    for (int o = 32; o > 0; o >>= 1) { a += __shfl_xor(a, o); b += __shfl_xor(b, o); }
    if (lane == 0) scal[0] = __expf(a) - __expf(b) + lam_init;
  }
  const int m_sw = (qi & 0x13) | ((qi & 4) << 1) | ((qi & 8) >> 1);
  const int xcd = bid & 7, jq = bid >> 3;
  const int per_x = gdim >> 3;
  const float c1 = 0.125f * LOG2E;
  for (int pr = xcd; pr < 48; pr += 8) {
    const int s = pr >> 2, h = pr & 3;
    for (int qb = jq; qb < 32; qb += per_x) {
      __syncthreads();
      for (int i = tid; i < 257; i += NTHREADS) {
        const int rel = i - 128, n = rel < 0 ? -rel : rel;
        int bk = n < 8 ? n : (n <= 11 ? 8 : (n <= 15 ? 9 : (n <= 22 ? 10 : (n <= 31 ? 11 : (n <= 45 ? 12 : (n <= 63 ? 13 : (n <= 90 ? 14 : 15)))))));
        if (rel > 0) bk += 16;
        tab[i] = relb[bk * 4 + h] * LOG2E;
      }
      const int q0 = qb * 256 + wid * 32;
      const size_t tokbase = (size_t)s * T;
      float* osv = OSV + ((size_t)bid * 512 + tid) * 64;
#pragma unroll 1
      for (int c = 0; c < 2; ++c) {
        bf16x8 Q[4];
        { const u16* qp = PB + (tokbase + q0 + qi) * 1024 + h * 128 + c * 64 + g * 8;
#pragma unroll
          for (int ks = 0; ks < 4; ++ks) Q[ks] = *(const bf16x8*)(qp + ks * 16); }
        f32x16 O[4];
#pragma unroll
        for (int eb = 0; eb < 4; ++eb)
#pragma unroll
          for (int i = 0; i < 16; ++i) O[eb][i] = 0.f;
        float mrun = -1e30f, lrun = 0.f;
        const u16* kg = PB + (tokbase + (tid >> 3)) * 1024 + 512 + h * 128 + c * 64 + (tid & 7) * 8;
        const u16* vg = VT + ((size_t)((s * 4 + h) * 128 + (tid >> 2))) * T + (tid & 3) * 16;
        const unsigned kl = (tid >> 3) * KROW + (tid & 7) * 16, vl = KBUF + (tid >> 2) * VROW + (tid & 3) * 32;
        u32x4 rk0, rv0, rv1;
        rk0 = *(const u32x4*)(kg); rv0 = *(const u32x4*)(vg); rv1 = *(const u32x4*)(vg + 8);
        __syncthreads();
        *(LAS u32x4*)(lds + kl) = rk0; *(LAS u32x4*)(lds + vl) = rv0; *(LAS u32x4*)(lds + vl + 16) = rv1;
        __syncthreads();
        auto compute_tile = [&](const int kt, LAS unsigned char* buf) {
          const int kmin = kt * 64;
          const int dlo = kmin + 63 - q0, dhi = kmin - (q0 + 31);
          const int bmode = dlo <= -91 ? 0 : (dhi >= 91 ? 1 : 2);
          const float bconst = bmode == 0 ? tab[0] : tab[256];
          f32x16 S[2];
          {
            bf16x8 kf[2][4];
#pragma unroll
            for (int kb = 0; kb < 2; ++kb)
#pragma unroll
              for (int ks = 0; ks < 4; ++ks) kf[kb][ks] = *(const LAS bf16x8*)(buf + (kb * 32 + m_sw) * KROW + (ks * 16 + g * 8) * 2);
            __builtin_amdgcn_sched_barrier(0);
#pragma unroll
            for (int kb = 0; kb < 2; ++kb) {
#pragma unroll
              for (int i = 0; i < 16; ++i) S[kb][i] = 0.f;
#pragma unroll
              for (int ks = 0; ks < 4; ++ks) S[kb] = __builtin_amdgcn_mfma_f32_32x32x16_bf16(kf[kb][ks], Q[ks], S[kb], 0, 0, 0);
            }
          }
          bf16x8 vf[2][4];
          float sc = c1, off = bconst;
          if (bmode == 2) {
#pragma unroll
            for (int kb = 0; kb < 2; ++kb)
#pragma unroll
              for (int r = 0; r < 16; ++r) {
                int rel = kmin + kb * 32 + 16 * (r >> 3) + 8 * g + (r & 7) - (q0 + qi);
                rel = rel < -128 ? -128 : (rel > 128 ? 128 : rel);
                S[kb][r] = S[kb][r] * c1 + tab[rel + 128];
              }
            sc = 1.f; off = 0.f;
          }
          float mx = -3e38f;
#pragma unroll
          for (int kb = 0; kb < 2; ++kb)
#pragma unroll
            for (int r = 0; r < 16; ++r) mx = fmaxf(mx, S[kb][r]);
          mx = fmaxf(mx, __shfl_xor(mx, 32));
          mx = mx * sc + off;
          if (__any(mx > mrun + 8.f)) {
            const float mnew = mx > mrun + 8.f ? mx : mrun;
            const float alpha = __builtin_amdgcn_exp2f(mrun - mnew);
            mrun = mnew; lrun *= alpha;
#pragma unroll
            for (int eb = 0; eb < 4; ++eb)
#pragma unroll
              for (int i = 0; i < 16; ++i) O[eb][i] *= alpha;
          }
          const float sh = off - mrun;
          float psum = 0.f;
#pragma unroll
          for (int kb = 0; kb < 2; ++kb)
#pragma unroll
            for (int r = 0; r < 16; ++r) { const float pv = __builtin_amdgcn_exp2f(S[kb][r] * sc + sh); S[kb][r] = pv; psum += pv; }
          lrun += psum;
          __builtin_amdgcn_sched_barrier(0);
#pragma unroll
          for (int eb = 0; eb < 4; ++eb) vf[0][eb] = *(const LAS bf16x8*)(buf + KBUF + (eb * 32 + qi) * VROW + (g * 8) * 2);
#pragma unroll
          for (int stp = 0; stp < 4; ++stp) {
            const int kb = stp >> 1, hh = stp & 1;
            if (stp < 3) {
#pragma unroll
              for (int eb = 0; eb < 4; ++eb) vf[(stp + 1) & 1][eb] = *(const LAS bf16x8*)(buf + KBUF + (eb * 32 + qi) * VROW + ((stp + 1) * 16 + g * 8) * 2);
            }
            const bf16x8 pb = pack8(S[kb], hh);
#pragma unroll
            for (int eb = 0; eb < 4; ++eb) O[eb] = __builtin_amdgcn_mfma_f32_32x32x16_bf16(vf[stp & 1][eb], pb, O[eb], 0, 0, 0);
          }
        };
        u32x4 rkB, rvB0, rvB1;
        { const u16* kg2 = kg + (size_t)1 * 64 * 1024; const u16* vg2 = vg + 64;
          rk0 = *(const u32x4*)(kg2); rv0 = *(const u32x4*)(vg2); rv1 = *(const u32x4*)(vg2 + 8);
          const u16* kg3 = kg + (size_t)2 * 64 * 1024; const u16* vg3 = vg + 128;
          rkB = *(const u32x4*)(kg3); rvB0 = *(const u32x4*)(vg3); rvB1 = *(const u32x4*)(vg3 + 8); }
#pragma unroll 1
        for (int kt = 0; kt < 128; kt += 2) {
          LAS unsigned char* buf0 = lds; LAS unsigned char* buf1 = lds + ABUF;
          compute_tile(kt, buf0);
          *(LAS u32x4*)(buf1 + kl) = rk0; *(LAS u32x4*)(buf1 + vl) = rv0; *(LAS u32x4*)(buf1 + vl + 16) = rv1;
          { const int tn = kt + 3 < 128 ? kt + 3 : 127; const u16* kg2 = kg + (size_t)tn * 64 * 1024; const u16* vg2 = vg + tn * 64;
            rk0 = *(const u32x4*)(kg2); rv0 = *(const u32x4*)(vg2); rv1 = *(const u32x4*)(vg2 + 8); }
          __syncthreads();
          compute_tile(kt + 1, buf1);
          *(LAS u32x4*)(buf0 + kl) = rkB; *(LAS u32x4*)(buf0 + vl) = rvB0; *(LAS u32x4*)(buf0 + vl + 16) = rvB1;
          { const int tn = kt + 4 < 128 ? kt + 4 : 127; const u16* kg2 = kg + (size_t)tn * 64 * 1024; const u16* vg2 = vg + tn * 64;
            rkB = *(const u32x4*)(kg2); rvB0 = *(const u32x4*)(vg2); rvB1 = *(const u32x4*)(vg2 + 8); }
          __syncthreads();
        }
        const float lt = lrun + __shfl_xor(lrun, 32);
        asm volatile("" : "+v"(osv));
        if (c == 0) {
          const float i0 = 1.f / lt;
#pragma unroll
          for (int eb = 0; eb < 4; ++eb)
#pragma unroll
            for (int i = 0; i < 16; i += 4) { f32x4 t4; t4[0] = O[eb][i] * i0; t4[1] = O[eb][i + 1] * i0; t4[2] = O[eb][i + 2] * i0; t4[3] = O[eb][i + 3] * i0; *(f32x4*)(osv + eb * 16 + i) = t4; }
        } else {
          const float i1 = scal[0] / lt;
          float ss = 0.f;
#pragma unroll
          for (int eb = 0; eb < 4; ++eb)
#pragma unroll
            for (int i = 0; i < 16; i += 4) { const f32x4 t4 = *(const f32x4*)(osv + eb * 16 + i);
#pragma unroll
              for (int j = 0; j < 4; ++j) { const float o = t4[j] - O[eb][i + j] * i1; O[eb][i + j] = o; ss += o * o; } }
          ss += __shfl_xor(ss, 32);
          const float rs = rsqrtf(ss * (1.f / 128.f) + LN_EPS) * (1.f - lam_init);
          u16* op = PB + (tokbase + q0 + qi) * 1024 + h * 128;
#pragma unroll
          for (int eb = 0; eb < 4; ++eb)
#pragma unroll
            for (int rr = 0; rr < 4; ++rr) {
              const int e = eb * 32 + 8 * rr + 4 * g;
              const f32x4 gg = *(const f32x4*)(subg + e);
              u32x2 pk; pk.x = cvt_pk_bf16(O[eb][4 * rr] * rs * gg[0], O[eb][4 * rr + 1] * rs * gg[1]); pk.y = cvt_pk_bf16(O[eb][4 * rr + 2] * rs * gg[2], O[eb][4 * rr + 3] * rs * gg[3]);
              *(u32x2*)(op + e) = pk;
            }
        }
      }
    }
  }
}

DI float softplusf_(float x) { return fmaxf(x, 0.f) + __logf(1.f + __expf(-fabsf(x))); }
DI void load_bf16x8(const u16* p, float (&o)[8]) {
  const u32x4 v = *(const u32x4*)p;
#pragma unroll
  for (int i = 0; i < 4; ++i) { o[2 * i] = __uint_as_float(v[i] << 16); o[2 * i + 1] = __uint_as_float(v[i] & 0xffff0000u); }
}
DI void shifted8(const u16* PA, size_t row, int t, int col, const float* mu0, const float* mu1, float (&o)[8]) {
  float c[8], pv[8], nx[8];
  load_bf16x8(PA + row * A_COLS + col, c);
  if (t > 0) load_bf16x8(PA + (row - 1) * A_COLS + col, pv); else { for (int i = 0; i < 8; ++i) pv[i] = 0.f; }
  if (t < T - 1) load_bf16x8(PA + (row + 1) * A_COLS + col, nx); else { for (int i = 0; i < 8; ++i) nx[i] = 0.f; }
#pragma unroll
  for (int i = 0; i < 8; ++i) o[i] = c[i] + mu0[col + i] * (pv[i] - c[i]) + mu1[col + i] * (nx[i] - c[i]);
}

DI void vprep_phase(LAS unsigned char* lds, const u16* PA, u16* VV, const float* mu, const float* vdown, const float* vup, const float* v0, int layer) {
  int tid = threadIdx.x; asm volatile("" : "+v"(tid));
  int bid = blockIdx.x, gdim = gridDim.x; asm volatile("" : "+s"(bid), "+s"(gdim));
  const int tok = tid >> 4, j = tid & 15;
  LAS float* vs = (LAS float*)lds;
  LAS float* dd = vs + 32 * 516;
  LAS unsigned* DN = (LAS unsigned*)(dd + 1024);
  LAS unsigned* UP = DN + 512 * 16;
  const float* mu0 = mu; const float* mu1 = mu + A_COLS;
  __syncthreads();
  if (layer != 0) {
    for (int i = tid; i < 512 * 16; i += NTHREADS) { const float2 w2 = *(const float2*)(vdown + 2 * i); DN[i] = cvt_pk_bf16(w2.x, w2.y); }
    for (int i = tid; i < 32 * 256; i += NTHREADS) { const float2 w2 = *(const float2*)(vup + 2 * i); UP[i] = cvt_pk_bf16(w2.x, w2.y); }
  }
  for (int it = bid; it < NT / 32; it += gdim) {
    const size_t row = (size_t)it * 32 + tok; const int t = (int)(row % T);
    __syncthreads();
#pragma unroll 1
    for (int q = 0; q < 4; ++q) {
      const int cc = q * 128 + j * 8;
      float o[8]; shifted8(PA, row, t, OFF_V + cc, mu0, mu1, o);
      if (layer == 0) {
        u32x4 pk; pk.x = cvt_pk_bf16(o[0], o[1]); pk.y = cvt_pk_bf16(o[2], o[3]); pk.z = cvt_pk_bf16(o[4], o[5]); pk.w = cvt_pk_bf16(o[6], o[7]);
        *(u32x4*)(VV + row * 512 + cc) = pk;
      } else {
        *(LAS f32x4*)(vs + tok * 516 + cc) = (f32x4){o[0], o[1], o[2], o[3]}; *(LAS f32x4*)(vs + tok * 516 + cc + 4) = (f32x4){o[4], o[5], o[6], o[7]};
      }
    }
    if (layer == 0) continue;
    __syncthreads();
    {
      float d0 = 0.f, d1 = 0.f;
#pragma unroll 8
      for (int c = 0; c < 512; ++c) { const float x = vs[tok * 516 + c]; const unsigned w2 = DN[c * 16 + j]; d0 += x * __uint_as_float(w2 << 16); d1 += x * __uint_as_float(w2 & 0xffff0000u); }
      dd[tok * 32 + 2 * j] = d0; dd[tok * 32 + 2 * j + 1] = d1;
    }
    __syncthreads();
#pragma unroll 1
    for (int q = 0; q < 4; ++q) {
      const int c0 = q * 128 + j * 8;
      float acc[8];
      { const f32x4 a0 = *(const f32x4*)(v0 + c0), a1 = *(const f32x4*)(v0 + c0 + 4);
#pragma unroll
        for (int i = 0; i < 4; ++i) { acc[i] = a0[i]; acc[4 + i] = a1[i]; } }
#pragma unroll 8
      for (int r = 0; r < 32; ++r) {
        const float dv = dd[tok * 32 + r];
        const u32x4 w8 = *(const LAS u32x4*)(UP + r * 256 + (c0 >> 1));
#pragma unroll
        for (int i = 0; i < 4; ++i) { acc[2 * i] += dv * __uint_as_float(w8[i] << 16); acc[2 * i + 1] += dv * __uint_as_float(w8[i] & 0xffff0000u); }
      }
      float vf[8]; load_bf16x8(VV + row * 512 + c0, vf);
      const f32x4 x0 = *(const LAS f32x4*)(vs + tok * 516 + c0), x1 = *(const LAS f32x4*)(vs + tok * 516 + c0 + 4);
      float o[8];
#pragma unroll
      for (int i = 0; i < 4; ++i) { o[i] = x0[i] + (vf[i] - x0[i]) * sigmoidf_(acc[i]); o[4 + i] = x1[i] + (vf[4 + i] - x1[i]) * sigmoidf_(acc[4 + i]); }
      u32x4 pk; pk.x = cvt_pk_bf16(o[0], o[1]); pk.y = cvt_pk_bf16(o[2], o[3]); pk.z = cvt_pk_bf16(o[4], o[5]); pk.w = cvt_pk_bf16(o[6], o[7]);
      *(u32x4*)(VV + row * 512 + c0) = pk;
    }
  }
}

struct ScanW { const float *mu, *w0, *du, *a0, *iu, *kk_, *ka, *rk; };
constexpr int SC = 32;
DI float quad_sum(float x) {
  x += __builtin_bit_cast(float, __builtin_amdgcn_update_dpp(0, __builtin_bit_cast(int, x), 0xB1, 0xf, 0xf, true));
  x += __builtin_bit_cast(float, __builtin_amdgcn_update_dpp(0, __builtin_bit_cast(int, x), 0x4E, 0xf, 0xf, true));
  return x;
}
#define BFLO(x) __uint_as_float((x) << 16)
#define BFHI(x) __uint_as_float((x) & 0xffff0000u)
DI float tanh_fast(float x) { x = fminf(fmaxf(x, -15.f), 15.f); const float t = __expf(2.f * x); return (t - 1.f) / (t + 1.f); }
DI float shift1(float c, float p, float n, float m0, float m1) { return c + m0 * (p - c) + m1 * (n - c); }
DI void scan_produce(LAS float* buf, LAS float* TW, LAS float* TA, LAS const float* DU, LAS const float* IU, const u16* PA, const u16* VV, float* BON,
                     const ScanW& w, int ptid, int sq, int h, int dir, int t0) {
  const int tok = ptid >> 3, j = ptid & 7;
  const int t = t0 + tok; const size_t row = (size_t)sq * T + t;
  const float* mu0 = w.mu; const float* mu1 = w.mu + A_COLS;
  const int cr = h * 64 + j * 8, ck = OFF_K + cr, cw_ = OFF_WD + dir * 32 + j * 4, ca_ = OFF_AD + dir * 32 + j * 4;
  const u16* pc = PA + row * A_COLS;
  const bool hp = t > 0, hn = t < T - 1;
  {
    const u32x2 w_c = *(const u32x2*)(pc + cw_), a_c = *(const u32x2*)(pc + ca_);
    u32x2 w_p = (u32x2){0u, 0u}, a_p = w_p, w_n = w_p, a_n = w_p;
    if (hp) { w_p = *(const u32x2*)(pc - A_COLS + cw_); a_p = *(const u32x2*)(pc - A_COLS + ca_); }
    if (hn) { w_n = *(const u32x2*)(pc + A_COLS + cw_); a_n = *(const u32x2*)(pc + A_COLS + ca_); }
    const f32x4 mw0 = *(const f32x4*)(mu0 + cw_), mw1 = *(const f32x4*)(mu1 + cw_), ma0 = *(const f32x4*)(mu0 + ca_), ma1 = *(const f32x4*)(mu1 + ca_);
    f32x4 tw, ta;
#pragma unroll
    for (int i = 0; i < 2; ++i) {
      tw[2 * i] = tanh_fast(shift1(BFLO(w_c[i]), BFLO(w_p[i]), BFLO(w_n[i]), mw0[2 * i], mw1[2 * i]));
      tw[2 * i + 1] = tanh_fast(shift1(BFHI(w_c[i]), BFHI(w_p[i]), BFHI(w_n[i]), mw0[2 * i + 1], mw1[2 * i + 1]));
      ta[2 * i] = shift1(BFLO(a_c[i]), BFLO(a_p[i]), BFLO(a_n[i]), ma0[2 * i], ma1[2 * i]);
      ta[2 * i + 1] = shift1(BFHI(a_c[i]), BFHI(a_p[i]), BFHI(a_n[i]), ma0[2 * i + 1], ma1[2 * i + 1]);
    }
    *(LAS f32x4*)(TW + tok * 32 + j * 4) = tw; *(LAS f32x4*)(TA + tok * 32 + j * 4) = ta;
  }
  asm volatile("s_waitcnt lgkmcnt(0)" ::: "memory");
  float wl[8], al[8];
  const int cc = j * 8, cg_ = h * 64 + cc;
  { const f32x4 x0 = *(const f32x4*)(w.w0 + dir * 512 + cg_), x1 = *(const f32x4*)(w.w0 + dir * 512 + cg_ + 4), y0 = *(const f32x4*)(w.a0 + dir * 512 + cg_), y1 = *(const f32x4*)(w.a0 + dir * 512 + cg_ + 4);
#pragma unroll
    for (int q = 0; q < 4; ++q) { wl[q] = x0[q]; wl[4 + q] = x1[q]; al[q] = y0[q]; al[4 + q] = y1[q]; } }
#pragma unroll 2
  for (int rr = 0; rr < 32; ++rr) {
    const float twv = TW[tok * 32 + rr], tav = TA[tok * 32 + rr];
    const f32x4 d0 = *(const LAS f32x4*)(DU + rr * 64 + cc), d1 = *(const LAS f32x4*)(DU + rr * 64 + cc + 4), i0 = *(const LAS f32x4*)(IU + rr * 64 + cc), i1 = *(const LAS f32x4*)(IU + rr * 64 + cc + 4);
#pragma unroll
    for (int q = 0; q < 4; ++q) { wl[q] += twv * d0[q]; wl[4 + q] += twv * d1[q]; al[q] += tav * i0[q]; al[4 + q] += tav * i1[q]; }
  }
#pragma unroll
  for (int q = 0; q < 8; ++q) { asm volatile("" : "+v"(wl[q]), "+v"(al[q])); }
  LAS float* AW = buf; LAS float* AK = buf + 2048; LAS float* AB = buf + 4096; LAS float* AD = buf + 6144; LAS float* AR = buf + 8192; LAS float* AV = buf + 10240;
  const int o = tok * 64 + cc;
  float ss = 0.f, bs = 0.f;
  float ok[8], av[8];
#pragma unroll
  for (int hq = 0; hq < 2; ++hq) {
    const int c4 = 4 * hq;
    const u32x2 r_c = *(const u32x2*)(pc + cr + c4), k_c = *(const u32x2*)(pc + ck + c4);
    u32x2 r_p = (u32x2){0u, 0u}, k_p = r_p, r_n = r_p, k_n = r_p;
    if (hp) { r_p = *(const u32x2*)(pc - A_COLS + cr + c4); k_p = *(const u32x2*)(pc - A_COLS + ck + c4); }
    if (hn) { r_n = *(const u32x2*)(pc + A_COLS + cr + c4); k_n = *(const u32x2*)(pc + A_COLS + ck + c4); }
    const u32x2 v_c = *(const u32x2*)(VV + row * 512 + cr + c4);
    const f32x4 mr0 = *(const f32x4*)(mu0 + cr + c4), mr1 = *(const f32x4*)(mu1 + cr + c4), mk0 = *(const f32x4*)(mu0 + ck + c4), mk1 = *(const f32x4*)(mu1 + ck + c4);
    const f32x4 kk4 = *(const f32x4*)(w.kk_ + cg_ + c4), ka4 = *(const f32x4*)(w.ka + cg_ + c4), rk4 = *(const f32x4*)(w.rk + cg_ + c4);
    f32x4 rv, kv, vv, ow, od;
#pragma unroll
    for (int i = 0; i < 2; ++i) {
      rv[2 * i] = shift1(BFLO(r_c[i]), BFLO(r_p[i]), BFLO(r_n[i]), mr0[2 * i], mr1[2 * i]);
      rv[2 * i + 1] = shift1(BFHI(r_c[i]), BFHI(r_p[i]), BFHI(r_n[i]), mr0[2 * i + 1], mr1[2 * i + 1]);
      kv[2 * i] = shift1(BFLO(k_c[i]), BFLO(k_p[i]), BFLO(k_n[i]), mk0[2 * i], mk1[2 * i]);
      kv[2 * i + 1] = shift1(BFHI(k_c[i]), BFHI(k_p[i]), BFHI(k_n[i]), mk0[2 * i + 1], mk1[2 * i + 1]);
      vv[2 * i] = BFLO(v_c[i]); vv[2 * i + 1] = BFHI(v_c[i]);
    }
#pragma unroll
    for (int q = 0; q < 4; ++q) {
      const float wlog = -softplusf_(-wl[c4 + q]) - 0.5f;
      ow[q] = __expf(-__expf(wlog));
      const float a = sigmoidf_(al[c4 + q]);
      av[c4 + q] = a;
      ok[c4 + q] = kv[q] * kk4[q]; ss += ok[c4 + q] * ok[c4 + q];
      od[q] = kv[q] * (1.f + (a - 1.f) * ka4[q]);
      bs += rv[q] * od[q] * rk4[q];
    }
    *(LAS f32x4*)(AW + o + c4) = ow; *(LAS f32x4*)(AD + o + c4) = od; *(LAS f32x4*)(AR + o + c4) = rv; *(LAS f32x4*)(AV + o + c4) = vv;
  }
#pragma unroll
  for (int sft = 1; sft < 8; sft <<= 1) { ss += __shfl_xor(ss, sft); bs += __shfl_xor(bs, sft); }
  const float rn = rsqrtf(ss + 1e-12f);
#pragma unroll
  for (int hq = 0; hq < 2; ++hq) {
    f32x4 k4, b4;
#pragma unroll
    for (int q = 0; q < 4; ++q) { k4[q] = ok[4 * hq + q] * rn; b4[q] = k4[q] * av[4 * hq + q]; }
    *(LAS f32x4*)(AK + o + 4 * hq) = k4; *(LAS f32x4*)(AB + o + 4 * hq) = b4;
  }
  if (j == 0) BON[((size_t)dir * NT + row) * 8 + h] = bs;
}
struct ScanOps { f32x4 k4[4], w4[4], b4[4], d4[4]; float vi; };
DI void scan_load(ScanOps& o, LAS const float* buf, int tt, int jseg, int irow) {
  const int off = tt * 64 + jseg * 16;
#pragma unroll
  for (int q = 0; q < 4; ++q) {
    o.w4[q] = *(const LAS f32x4*)(buf + off + q * 4); o.k4[q] = *(const LAS f32x4*)(buf + 2048 + off + q * 4); o.b4[q] = *(const LAS f32x4*)(buf + 4096 + off + q * 4);
    o.d4[q] = *(const LAS f32x4*)(buf + 6144 + off + q * 4);
  }
  o.vi = buf[10240 + tt * 64 + irow];
}
DI float scan_step(f32x4 (&S)[4], const ScanOps& o, LAS const float* buf, int tt, int jseg) {
  f32x4 r4[4];
#pragma unroll
  for (int q = 0; q < 4; ++q) r4[q] = *(const LAS f32x4*)(buf + 8192 + tt * 64 + jseg * 16 + q * 4);
  f32x4 a4 = S[0] * o.k4[0] + S[1] * o.k4[1] + S[2] * o.k4[2] + S[3] * o.k4[3];
  float sa = -quad_sum((a4[0] + a4[1]) + (a4[2] + a4[3]));
  f32x4 y4 = (f32x4){0.f, 0.f, 0.f, 0.f};
#pragma unroll
  for (int q = 0; q < 4; ++q) { S[q] = S[q] * o.w4[q] + (o.b4[q] * sa + o.d4[q] * o.vi); y4 += S[q] * r4[q]; }
  return quad_sum((y4[0] + y4[1]) + (y4[2] + y4[3]));
}
DI void scan_phase(LAS unsigned char* lds, const u16* PA, const u16* VV, u16* YY, float* BON, const ScanW w) {
  int tid = threadIdx.x; asm volatile("" : "+v"(tid));
  int bid = blockIdx.x, gdim = gridDim.x; asm volatile("" : "+s"(bid), "+s"(gdim));
  LAS float* BUF = (LAS float*)lds;
  LAS float* AY = BUF + 2 * 12288;
  LAS float* TW = AY + 2 * 2048;
  LAS float* TA = TW + SC * 32;
  LAS float* DU = TA + SC * 32;
  LAS float* IU = DU + 2048;
  const int wid = __builtin_amdgcn_readfirstlane(tid >> 6), lane = tid & 63;
  const int NCH = T / SC;
  for (int item = bid; item < 192; item += gdim) {
    const int dir = item & 1, h = (item >> 1) & 7, sq = item >> 4;
    __syncthreads();
    for (int i = tid; i < 2048; i += NTHREADS) { const int rr = i >> 6, c = i & 63; DU[i] = w.du[(dir * 32 + rr) * 512 + h * 64 + c]; IU[i] = w.iu[(dir * 32 + rr) * 512 + h * 64 + c]; }
    __syncthreads();
    f32x4 S[4];
#pragma unroll
    for (int q = 0; q < 4; ++q) S[q] = (f32x4){0.f, 0.f, 0.f, 0.f};
    const int irow = (wid & 3) * 16 + (lane >> 2), jseg = lane & 3;
    if (wid >= 4) scan_produce(BUF, TW, TA, DU, IU, PA, VV, BON, w, tid - 256, sq, h, dir, dir == 0 ? 0 : T - SC);
    __syncthreads();
#pragma unroll 1
    for (int ci = 0; ci < NCH; ++ci) {
      LAS float* buf = BUF + (ci & 1) * 12288;
      LAS float* ay = AY + (ci & 1) * 2048;
      if (wid < 4) {
        ScanOps o0, o1;
        scan_load(o0, buf, dir == 0 ? 0 : SC - 1, jseg, irow);
#pragma unroll 1
        for (int st = 0; st < SC; st += 2) {
          const int t0_ = dir == 0 ? st : SC - 1 - st, t1_ = dir == 0 ? st + 1 : SC - 2 - st;
          scan_load(o1, buf, t1_, jseg, irow);
          const float y0 = scan_step(S, o0, buf, t0_, jseg);
          if (jseg == 0) ay[t0_ * 64 + irow] = y0;
          if (st + 2 < SC) scan_load(o0, buf, dir == 0 ? st + 2 : SC - 3 - st, jseg, irow);
          const float y1 = scan_step(S, o1, buf, t1_, jseg);
          if (jseg == 0) ay[t1_ * 64 + irow] = y1;
        }
      } else {
        const int ptid = tid - 256;
        if (ci + 1 < NCH) scan_produce(BUF + ((ci + 1) & 1) * 12288, TW, TA, DU, IU, PA, VV, BON, w, ptid, sq, h, dir, dir == 0 ? (ci + 1) * SC : T - SC * (ci + 2));
        if (ci > 0) {
          LAS const float* py = AY + ((ci - 1) & 1) * 2048;
          const int t0p = dir == 0 ? (ci - 1) * SC : T - SC * ci;
          const int tok = ptid >> 3, c0 = (ptid & 7) * 8;
          const f32x4 ya = *(const LAS f32x4*)(py + tok * 64 + c0), yb = *(const LAS f32x4*)(py + tok * 64 + c0 + 4);
          u32x4 pk; pk.x = cvt_pk_bf16(ya[0], ya[1]); pk.y = cvt_pk_bf16(ya[2], ya[3]); pk.z = cvt_pk_bf16(yb[0], yb[1]); pk.w = cvt_pk_bf16(yb[2], yb[3]);
          *(u32x4*)(YY + ((size_t)dir * NT + (size_t)sq * T + t0p + tok) * 512 + h * 64 + c0) = pk;
        }
      }
      __syncthreads();
    }
    if (wid >= 4) {
      const int ptid = tid - 256;
      LAS const float* py = AY + ((NCH - 1) & 1) * 2048;
      const int t0p = dir == 0 ? (NCH - 1) * SC : 0;
      const int tok = ptid >> 3, c0 = (ptid & 7) * 8;
      const f32x4 ya = *(const LAS f32x4*)(py + tok * 64 + c0), yb = *(const LAS f32x4*)(py + tok * 64 + c0 + 4);
      u32x4 pk; pk.x = cvt_pk_bf16(ya[0], ya[1]); pk.y = cvt_pk_bf16(ya[2], ya[3]); pk.z = cvt_pk_bf16(yb[0], yb[1]); pk.w = cvt_pk_bf16(yb[2], yb[3]);
      *(u32x4*)(YY + ((size_t)dir * NT + (size_t)sq * T + t0p + tok) * 512 + h * 64 + c0) = pk;
    }
  }
}

DI void post_phase(LAS unsigned char* lds, u16* PA, const u16* PB, const u16* VV, const u16* YY, const float* BON, const float* mu, const float* gup, const float* gng, const float* gnb) {
  int tid = threadIdx.x; asm volatile("" : "+v"(tid));
  int bid = blockIdx.x, gdim = gridDim.x; asm volatile("" : "+s"(bid), "+s"(gdim));
  const int tok = tid >> 4, j = tid & 15;
  LAS float* sg = (LAS float*)lds;
  LAS unsigned* GU = (LAS unsigned*)(lds + 16384);
  const float* mu0 = mu; const float* mu1 = mu + A_COLS;
  __syncthreads();
  for (int i = tid; i < 96 * 256; i += NTHREADS) { const float2 w2 = *(const float2*)(gup + 2 * i); GU[i] = cvt_pk_bf16(w2.x, w2.y); }
  for (int it = bid; it < NT / 32; it += gdim) {
    const size_t row = (size_t)it * 32 + tok; const int t = (int)(row % T);
    __syncthreads();
#pragma unroll
    for (int q = 0; q < 6; ++q) {
      const int col = OFF_GD + j * 6 + q;
      const float c = bf2f(PA[row * A_COLS + col]);
      const float pv = t > 0 ? bf2f(PA[(row - 1) * A_COLS + col]) : 0.f, nx = t < T - 1 ? bf2f(PA[(row + 1) * A_COLS + col]) : 0.f;
      sg[tok * 96 + j * 6 + q] = sigmoidf_(c + mu0[col] * (pv - c) + mu1[col] * (nx - c));
    }
    __syncthreads();
#pragma unroll 1
    for (int q = 0; q < 4; ++q) {
      const int cc = q * 128 + j * 8, h = 2 * q + (j >> 3);
      float y[8]; float sm = 0.f;
      { float a[8], b[8]; load_bf16x8(YY + row * 512 + cc, a); load_bf16x8(YY + ((size_t)NT + row) * 512 + cc, b);
#pragma unroll
        for (int i = 0; i < 8; ++i) { y[i] = a[i] + b[i]; sm += y[i]; } }
      sm += __shfl_xor(sm, 1); sm += __shfl_xor(sm, 2); sm += __shfl_xor(sm, 4);
      const float mean = sm * (1.f / 64.f);
      float vq = 0.f;
#pragma unroll
      for (int i = 0; i < 8; ++i) { y[i] -= mean; vq += y[i] * y[i]; }
      vq += __shfl_xor(vq, 1); vq += __shfl_xor(vq, 2); vq += __shfl_xor(vq, 4);
      const float rs = rsqrtf(vq * (1.f / 64.f) + GN_EPS);
      const float bon = BON[row * 8 + h] + BON[((size_t)NT + row) * 8 + h];
      float gacc[8];
#pragma unroll
      for (int i = 0; i < 8; ++i) gacc[i] = 0.f;
#pragma unroll 8
      for (int r = 0; r < 96; ++r) {
        const float sv = sg[tok * 96 + r];
        const u32x4 w8 = *(const LAS u32x4*)(GU + r * 256 + (cc >> 1));
#pragma unroll
        for (int i = 0; i < 4; ++i) { gacc[2 * i] += sv * __uint_as_float(w8[i] << 16); gacc[2 * i + 1] += sv * __uint_as_float(w8[i] & 0xffff0000u); }
      }
      float vv[8]; load_bf16x8(VV + row * 512 + cc, vv);
      const f32x4 g0 = *(const f32x4*)(gng + cc), g1 = *(const f32x4*)(gng + cc + 4), b0 = *(const f32x4*)(gnb + cc), b1 = *(const f32x4*)(gnb + cc + 4);
      float o[8];
#pragma unroll
      for (int i = 0; i < 4; ++i) { o[i] = (y[i] * rs * g0[i] + b0[i] + bon * vv[i]) * gacc[i]; o[4 + i] = (y[4 + i] * rs * g1[i] + b1[i] + bon * vv[4 + i]) * gacc[4 + i]; }
      u32x4 pk; pk.x = cvt_pk_bf16(o[0], o[1]); pk.y = cvt_pk_bf16(o[2], o[3]); pk.z = cvt_pk_bf16(o[4], o[5]); pk.w = cvt_pk_bf16(o[6], o[7]);
      if (DBGZ & 1) pk = (u32x4){0u, 0u, 0u, 0u};
      *(u32x4*)(PA + row * A_COLS + cc) = pk;
      u32x4 pb4 = *(const u32x4*)(PB + row * 1024 + cc); if (DBGZ & 2) pb4 = (u32x4){0u, 0u, 0u, 0u};
      *(u32x4*)(PA + row * A_COLS + 512 + cc) = pb4;
    }
  }
}

DI unsigned hashu(unsigned x) { x ^= x >> 16; x *= 0x7feb352du; x ^= x >> 15; x *= 0x846ca68bu; x ^= x >> 16; return x; }
DI void dbg_upd(float* slot, float got, float ref, float scale) { float e = fabsf(got - ref) / scale; if (!(e == e)) e = 1e9f; atomicMax((unsigned*)slot, __float_as_uint(e)); }
DI float tshift(const u16* PA, size_t row, int col, const float* mu) {
  const int t = (int)(row % T);
  const float c = bf2f(PA[row * A_COLS + col]);
  const float pv = t > 0 ? bf2f(PA[(row - 1) * A_COLS + col]) : 0.f, nx = t < T - 1 ? bf2f(PA[(row + 1) * A_COLS + col]) : 0.f;
  return c + mu[col] * (pv - c) + mu[A_COLS + col] * (nx - c);
}
DI void chk_proj(const u16* XB, const float* win, const u16* PA, const u16* PB, const u16* VT, float* slot) {
  const int gt = blockIdx.x * NTHREADS + threadIdx.x;
  if (gt >= 4096) return;
  const int row = hashu(gt * 2 + 1) % NT, col = hashu(gt * 2 + 2) % P_COLS;
  float ref = 0.f;
  for (int k = 0; k < D; ++k) ref += bf2f(XB[(size_t)row * D + k]) * win[(size_t)k * P_COLS + col];
  float got;
  if (col < A_COLS) got = bf2f(PA[(size_t)row * A_COLS + col]);
  else if (col < A_COLS + 1024) got = bf2f(PB[(size_t)row * 1024 + col - A_COLS]);
  else { const int c2 = col - A_COLS - 1024, h = c2 >> 7, e = c2 & 127, sq = row / T, t = row % T; got = bf2f(VT[((size_t)((sq * 4 + h) * 128 + e)) * T + t]); }
  dbg_upd(slot, got, ref, 1.f);
}
DI void chk_ffn(const u16* XB, const float* wup, const float* cw, const float* cb, const u16* G, float* slot) {
  const int gt = blockIdx.x * NTHREADS + threadIdx.x;
  if (gt >= 4096) return;
  int row = hashu(gt * 2 + 11) % NT; const int n = hashu(gt * 2 + 12) % DFF;
  if (gt < 64) row = (gt & 1) ? (row / T) * T + T - 1 : (row / T) * T;
  else if (gt < 1024) row = (row / T) * T + ((row % T) / 254) * 254 + (gt & 1 ? 253 : 0), row = row >= NT ? NT - 1 : row;
  const int t = row % T;
  float hg[3] = {0.f, 0.f, 0.f}, hu[3] = {0.f, 0.f, 0.f};
#pragma unroll
  for (int d = -1; d <= 1; ++d) {
    float a = 0.f, b = 0.f;
    if (!(t + d < 0 || t + d > T - 1))
      for (int k = 0; k < D; ++k) { const float x = bf2f(XB[(size_t)(row + d) * D + k]); a += x * wup[(size_t)k * NUP + n]; b += x * wup[(size_t)k * NUP + DFF + n]; }
    hg[d + 1] = a; hu[d + 1] = b;
  }
  const float got = bf2f(G[(size_t)row * DFF + n]);
  { const float g = cw[n] * hg[0] + cw[NUP + n] * hg[1] + cw[2 * NUP + n] * hg[2] + cb[n];
    const float u = cw[DFF + n] * hu[0] + cw[NUP + DFF + n] * hu[1] + cw[2 * NUP + DFF + n] * hu[2] + cb[DFF + n];
    dbg_upd(slot, got, 0.5f * g * (1.f + erff(g * 0.70710678f)) * u, 1.f); }
  { const float g = cw[n] * hg[2] + cw[NUP + n] * hg[1] + cw[2 * NUP + n] * hg[0] + cb[n];
    const float u = cw[DFF + n] * hu[2] + cw[NUP + DFF + n] * hu[1] + cw[2 * NUP + DFF + n] * hu[0] + cb[DFF + n];
    dbg_upd(slot + 1, got, 0.5f * g * (1.f + erff(g * 0.70710678f)) * u, 1.f); }
  { const float g = cw[NUP + n] * hg[1] + cb[n];
    const float u = cw[NUP + DFF + n] * hu[1] + cb[DFF + n];
    dbg_upd(slot + 2, got, 0.5f * g * (1.f + erff(g * 0.70710678f)) * u, 1.f); }
}
DI void chk_attn(LAS unsigned char* lds, const u16* XB, const float* win, const u16* PB, const u16* VT, const float* lamp, const float* subg, const float* relb, int layer, float* slot) {
  if (blockIdx.x >= 16) return;
  const int tid = threadIdx.x;
  LAS float* qv = (LAS float*)lds;
  LAS float* sc = qv + 128;
  LAS float* red = sc + 16384;
  LAS float* ov = red + 1024;
  const int smp = blockIdx.x;
  const int sq = hashu(smp + 77) % NSEQ, h = smp & 3;
  int q = hashu(smp + 99) % T; if (smp < 4) q = smp * 37; if (smp >= 12) q = T - 1 - (smp - 12) * 50;
  const size_t row = (size_t)sq * T + q;
  __syncthreads();
  if (tid < 128) { float a = 0.f; const int col = A_COLS + h * 128 + tid; for (int k = 0; k < D; ++k) a += bf2f(XB[row * D + k]) * win[(size_t)k * P_COLS + col]; qv[tid] = a; }
  __syncthreads();
  float mx0 = -1e30f, mx1 = -1e30f;
  for (int key = tid; key < T; key += NTHREADS) {
    const u16* kp = PB + ((size_t)sq * T + key) * 1024 + 512 + h * 128;
    float s0 = 0.f, s1 = 0.f;
    for (int d = 0; d < 64; ++d) { s0 += qv[d] * bf2f(kp[d]); s1 += qv[64 + d] * bf2f(kp[64 + d]); }
    const int rel = key - q, n = rel < 0 ? -rel : rel;
    int bk;
    if (n < 8) bk = n; else { bk = 8 + (int)(logf((float)n / 8.f) / logf(16.f) * 8.f); bk = bk > 15 ? 15 : bk; }
    if (rel > 0) bk += 16;
    const float bias = relb[bk * 4 + h];
    s0 = s0 * 0.125f + bias; s1 = s1 * 0.125f + bias;
    sc[key] = s0; sc[8192 + key] = s1; mx0 = fmaxf(mx0, s0); mx1 = fmaxf(mx1, s1);
  }
  red[tid] = mx0; red[512 + tid] = mx1; __syncthreads();
  for (int o = 256; o > 0; o >>= 1) { if (tid < o) { red[tid] = fmaxf(red[tid], red[tid + o]); red[512 + tid] = fmaxf(red[512 + tid], red[512 + tid + o]); } __syncthreads(); }
  mx0 = red[0]; mx1 = red[512]; __syncthreads();
  float l0 = 0.f, l1 = 0.f;
  for (int key = tid; key < T; key += NTHREADS) { const float p0 = expf(sc[key] - mx0), p1 = expf(sc[8192 + key] - mx1); sc[key] = p0; sc[8192 + key] = p1; l0 += p0; l1 += p1; }
  red[tid] = l0; red[512 + tid] = l1; __syncthreads();
  for (int o = 256; o > 0; o >>= 1) { if (tid < o) { red[tid] += red[tid + o]; red[512 + tid] += red[512 + tid + o]; } __syncthreads(); }
  l0 = red[0]; l1 = red[512]; __syncthreads();
  float la = 0.f, lb = 0.f; for (int d = 0; d < 64; ++d) { la += lamp[d] * lamp[64 + d]; lb += lamp[128 + d] * lamp[192 + d]; }
  const float lam_init = 0.8f - 0.6f * expf(-0.3f * (float)layer);
  const float lam = expf(la) - expf(lb) + lam_init;
  { const int e = tid & 127, part = tid >> 7;
    const u16* vp = VT + ((size_t)((sq * 4 + h) * 128 + e)) * T;
    float o = 0.f;
    for (int key = part * 2048; key < (part + 1) * 2048; ++key) o += (sc[key] / l0 - lam * sc[8192 + key] / l1) * bf2f(vp[key]);
    red[tid] = o; }
  __syncthreads();
  if (tid < 128) ov[tid] = red[tid] + red[128 + tid] + red[256 + tid] + red[384 + tid];
  __syncthreads();
  if (tid < 128) {
    float ss = 0.f; for (int e = 0; e < 128; ++e) ss += ov[e] * ov[e];
    const float ref = ov[tid] * rsqrtf(ss / 128.f + LN_EPS) * subg[tid] * (1.f - lam_init);
    dbg_upd(slot, bf2f(PB[row * 1024 + h * 128 + tid]), ref, 1.f);
  }
}
struct ChkOp { float r, kd, kk, b, w, v; };
DI ChkOp chk_ops(const u16* PA, const u16* VV, const ScanW& w, size_t row, int h, int dir, int c, LAS float* tmp  , int tid) {
  ChkOp o;
  const int cg_ = h * 64 + c;
  o.r = tshift(PA, row, cg_, w.mu);
  const float k = tshift(PA, row, OFF_K + cg_, w.mu);
  float wl = w.w0[dir * 512 + cg_], al = w.a0[dir * 512 + cg_];
#pragma unroll 1
  for (int rr = 0; rr < 32; ++rr) {
    wl += tanhf(tshift(PA, row, OFF_WD + dir * 32 + rr, w.mu)) * w.du[(dir * 32 + rr) * 512 + cg_];
    al += tshift(PA, row, OFF_AD + dir * 32 + rr, w.mu) * w.iu[(dir * 32 + rr) * 512 + cg_];
  }
  const float sp = logf(1.f + expf(-wl));
  o.w = expf(-expf(-sp - 0.5f));
  const float a = 1.f / (1.f + expf(-al));
  const float kkv = k * w.kk_[cg_];
  __syncthreads(); tmp[tid] = kkv * kkv; __syncthreads();
  float ss = 0.f;
#pragma unroll 1
  for (int j = 0; j < 64; ++j) ss += tmp[j];
  o.kk = kkv * rsqrtf(ss + 1e-12f);
  o.kd = k * (1.f + (a - 1.f) * w.ka[cg_]);
  o.b = o.kk * a;
  o.v = bf2f(VV[row * 512 + cg_]);
  return o;
}
DI void chk_scan(LAS unsigned char* lds, const u16* PA, const u16* VV, const u16* YY, const float* BON, const ScanW w, float* slot) {
  if (blockIdx.x >= 48 || threadIdx.x >= 64) return;
  const int tid = threadIdx.x;
  LAS float* tmp = (LAS float*)lds; LAS float* red = tmp + 64;
  const int item = blockIdx.x * 4 + 1, dir = item & 1, h = (item >> 1) & 7, sq = item >> 4;
  const int t0 = dir == 0 ? 0 : T - 1, t1 = dir == 0 ? 1 : T - 2;
  const size_t row0 = (size_t)sq * T + t0, row1 = (size_t)sq * T + t1;
  const ChkOp a = chk_ops(PA, VV, w, row0, h, dir, tid, tmp, tid);
  const ChkOp b = chk_ops(PA, VV, w, row1, h, dir, tid, tmp, tid);
#define BSUM(dst, val) { __syncthreads(); red[tid] = (val); __syncthreads(); float sx_ = 0.f; _Pragma("unroll 1") for (int j_ = 0; j_ < 64; ++j_) sx_ += red[j_]; dst = sx_; }
  float ds0, ds1, ds2, ds3, ds4;
  BSUM(ds0, a.kd * a.r) BSUM(ds1, a.kd * b.w * b.r) BSUM(ds2, a.kd * (-b.kk)) BSUM(ds3, b.b * b.r) BSUM(ds4, b.kd * b.r)
  const float y0 = a.v * ds0;
  const float y1 = a.v * (ds1 + ds2 * ds3) + b.v * ds4;
  dbg_upd(slot, bf2f(YY[((size_t)dir * NT + row0) * 512 + h * 64 + tid]), y0, fabsf(y0) + 0.05f);
  dbg_upd(slot, bf2f(YY[((size_t)dir * NT + row1) * 512 + h * 64 + tid]), y1, fabsf(y1) + 0.05f);
  float bq = a.r * a.kd * w.rk[h * 64 + tid];
  __syncthreads(); red[tid] = bq; __syncthreads(); float bs = 0.f;
#pragma unroll 1
  for (int j = 0; j < 64; ++j) bs += red[j];
  dbg_upd(slot, BON[((size_t)dir * NT + row0) * 8 + h], bs, fabsf(bs) + 0.05f);
}
DI void chk_post(const u16* PA, const u16* PB, const u16* VV, const u16* YY, const float* BON, const float* mu, const float* gup, const float* gng, const float* gnb, float* slot) {
  const int gt = blockIdx.x * NTHREADS + threadIdx.x;
  if (gt >= 2048) return;
  const size_t row = hashu(gt * 2 + 21) % NT; const int c = hashu(gt * 2 + 22) % 512, h = c >> 6;
  float sm = 0.f;
  float yc = 0.f;
  for (int i = 0; i < 64; ++i) { const float y = bf2f(YY[row * 512 + h * 64 + i]) + bf2f(YY[((size_t)NT + row) * 512 + h * 64 + i]); sm += y; if (h * 64 + i == c) yc = y; }
  const float mean = sm / 64.f; float vq = 0.f;
  for (int i = 0; i < 64; ++i) { const float y = bf2f(YY[row * 512 + h * 64 + i]) + bf2f(YY[((size_t)NT + row) * 512 + h * 64 + i]) - mean; vq += y * y; }
  const float yn = (yc - mean) * rsqrtf(vq / 64.f + GN_EPS) * gng[c] + gnb[c];
  const float bon = (BON[row * 8 + h] + BON[((size_t)NT + row) * 8 + h]) * bf2f(VV[row * 512 + c]);
  float g = 0.f;
  for (int r = 0; r < 96; ++r) g += (1.f / (1.f + expf(-tshift(PA, row, OFF_GD + r, mu)))) * gup[r * 512 + c];
  const float ref = (yn + bon) * g;
  dbg_upd(slot, bf2f(PA[row * A_COLS + c]), ref, fabsf(ref) + 0.05f);
  dbg_upd(slot + 1, bf2f(PA[row * A_COLS + 512 + c]), bf2f(PB[row * 1024 + c]), 1.f);
}

__global__ __launch_bounds__(NTHREADS, 2) void mega(Params p_unused) {
  extern __shared__ __attribute__((aligned(16))) char shm[];
  cg::grid_group grid = cg::this_grid();
  LAS unsigned char* lds = (LAS unsigned char*)shm;
#define WS_PTRS CParams p = get_params(); unsigned char* ws = p->ws; \
  u16* WIN = (u16*)(ws + OFF_WIN); u16* WOUT = (u16*)(ws + OFF_WOUT); u16* WUP = (u16*)(ws + OFF_WUP); u16* WDN = (u16*)(ws + OFF_WDN); \
  u16* XB = (u16*)(ws + OFF_XB); u16* PA = (u16*)(ws + OFF_PA); u16* PB = (u16*)(ws + OFF_PB); u16* VT = (u16*)(ws + OFF_VT); \
  u16* G = (u16*)(ws + OFF_PA); u16* VV = (u16*)(ws + OFF_VV); u16* YY = (u16*)(ws + OFF_XB); float* BON = (float*)(ws + OFF_BON); float* XF = p->out; \
  (void)WIN; (void)WOUT; (void)WUP; (void)WDN; (void)XB; (void)PA; (void)PB; (void)VT; (void)G; (void)VV; (void)YY; (void)BON; (void)XF;
  int ph = 0;
  const int ph_lo = get_params()->ph_lo, ph_hi = get_params()->ph_hi;
#ifndef ONLYMASK
#define ONLYMASK 0xffffffffu
#endif
#define PHASE_BEGIN if (((ONLYMASK >> (__COUNTER__ % 32)) & 1u) && ph >= ph_lo && ph < ph_hi) { WS_PTRS
#define PHASE_END } ++ph; if (ph > ph_lo && ph < ph_hi) grid.sync();

  PHASE_BEGIN
    for (int l = 0; l < 2; ++l) {
      convert_weight<0>(shm, p->in[4] + (size_t)l * D * P_COLS, WIN + (size_t)l * NPROJ * D, D, P_COLS, NPROJ, blockIdx.x, gridDim.x);
      convert_weight<1>(shm, p->in[22] + (size_t)l * D * D, WOUT + (size_t)l * D * D, D, D, D, blockIdx.x, gridDim.x);
      convert_weight<2>(shm, p->in[25] + (size_t)l * D * NUP, WUP + (size_t)l * NUP * D, D, NUP, NUP, blockIdx.x, gridDim.x);
      convert_weight<1>(shm, p->in[28] + (size_t)l * DFF * D, WDN + (size_t)l * D * DFF, DFF, D, D, blockIdx.x, gridDim.x);
    }
    ln_rows(p->in[0], p->in[1], NPROMPT_TOK, XF, XB, p->in[2], p->in[3]);
#if PROBE_MISC
    ln_rows(p->in[0], p->in[1], NPROMPT_TOK, XF, XB, p->in[2], p->in[3]);
#endif
  PHASE_END

#pragma unroll 1
  for (int l = 0; l < 2; ++l) {
    PHASE_BEGIN
      Gemm ga{XB, D, WIN + (size_t)l * NPROJ * D, D};
      EpiArgs ea{}; ea.pa = PA; ea.pb = PB; ea.vt = VT;
      gemm_phase<0, 0>(lds, ga, NT / 256, NPROJ / 256, ea);
#if PROBE_GEMM
      gemm_phase<0, 0>(lds, ga, NT / 256, NPROJ / 256, ea);
#endif
    PHASE_END
    PHASE_BEGIN
      vprep_phase(lds, PA, VV, p->in[5] + (size_t)l * 2 * A_COLS, p->in[16], p->in[17], p->in[18], l);
      attn_phase(lds, PB, VT, (float*)(ws + OFF_OSV), p->in[19] + l * 256, p->in[20] + l * 128, p->in[21], l);
    PHASE_END
    PHASE_BEGIN
      ScanW sw; sw.mu = p->in[5] + (size_t)l * 2 * A_COLS; sw.w0 = p->in[6] + l * 1024; sw.du = p->in[7] + (size_t)l * 2 * 32 * 512; sw.a0 = p->in[8] + l * 1024;
      sw.iu = p->in[9] + (size_t)l * 2 * 32 * 512; sw.kk_ = p->in[11] + l * 512; sw.ka = p->in[12] + l * 512; sw.rk = p->in[13] + l * 512;
      scan_phase(lds, PA, VV, YY, BON, sw);
#if PROBE_SCAN
      scan_phase(lds, PA, VV, YY, BON, sw);
#endif
    PHASE_END
    PHASE_BEGIN
      post_phase(lds, PA, PB, VV, YY, BON, p->in[5] + (size_t)l * 2 * A_COLS, p->in[10] + (size_t)l * 96 * 512, p->in[14] + l * 512, p->in[15] + l * 512);
#if PROBE_MISC
      post_phase(lds, PA, PB, VV, YY, BON, p->in[5] + (size_t)l * 2 * A_COLS, p->in[10] + (size_t)l * 96 * 512, p->in[14] + l * 512, p->in[15] + l * 512);
#endif
    PHASE_END
    PHASE_BEGIN
      Gemm ga{PA, A_COLS, WOUT + (size_t)l * D * D, D};
      EpiArgs ea{}; ea.xf = XF;
      gemm_phase<1, 0>(lds, ga, NT / 256, D / 256, ea);
    PHASE_END
    PHASE_BEGIN
      ln_rows(XF, XF, NT, XF, XB, p->in[23] + l * D, p->in[24] + l * D);
    PHASE_END
    PHASE_BEGIN
      Gemm ga{XB, D, WUP + (size_t)l * NUP * D, D};
      EpiArgs ea{}; ea.g = G; ea.cw = p->in[26] + (size_t)l * 3 * NUP; ea.cb = p->in[27] + (size_t)l * NUP;
      gemm_phase<2, 1>(lds, ga, NSEQ * 33, NUP / 256, ea);
#if PROBE_GEMM
      gemm_phase<2, 1>(lds, ga, NSEQ * 33, NUP / 256, ea);
#endif
    PHASE_END
    PHASE_BEGIN
      Gemm ga{G, DFF, WDN + (size_t)l * D * DFF, DFF};
      EpiArgs ea{}; ea.xf = XF; ea.zero = (DBGZ & 4) ? 1 : 0;
      gemm_phase<1, 0>(lds, ga, NT / 256, D / 256, ea);
    PHASE_END
    PHASE_BEGIN
      ln_rows(XF, XF, NT, XF, XB, p->in[29] + l * D, p->in[30] + l * D);
    PHASE_END
  }
}

#if DBG
#define DPTRS unsigned char* ws = p.ws; u16* XB = (u16*)(ws + OFF_XB); u16* PA = (u16*)(ws + OFF_PA); u16* PB = (u16*)(ws + OFF_PB); u16* VT = (u16*)(ws + OFF_VT); \
  u16* G = (u16*)(ws + OFF_PA); u16* VV = (u16*)(ws + OFF_VV); u16* YY = (u16*)(ws + OFF_XB); float* BON = (float*)(ws + OFF_BON); float* DE = (float*)(ws + OFF_DBG); \
  (void)XB; (void)PA; (void)PB; (void)VT; (void)G; (void)VV; (void)YY; (void)BON; (void)DE;
template <int which> __global__ __launch_bounds__(NTHREADS) void k_chk(Params p, int l) {
  extern __shared__ __attribute__((aligned(16))) char shm[];
  LAS unsigned char* lds = (LAS unsigned char*)shm;
  DPTRS
  if (which == 0) chk_proj(XB, p.in[4] + (size_t)l * D * P_COLS, PA, PB, VT, DE + 0);
  else if (which == 1) chk_attn(lds, XB, p.in[4] + (size_t)l * D * P_COLS, PB, VT, p.in[19] + l * 256, p.in[20] + l * 128, p.in[21], l, DE + 1);
  else if (which == 2) {
    ScanW sw; sw.mu = p.in[5] + (size_t)l * 2 * A_COLS; sw.w0 = p.in[6] + l * 1024; sw.du = p.in[7] + (size_t)l * 2 * 32 * 512; sw.a0 = p.in[8] + l * 1024;
    sw.iu = p.in[9] + (size_t)l * 2 * 32 * 512; sw.kk_ = p.in[11] + l * 512; sw.ka = p.in[12] + l * 512; sw.rk = p.in[13] + l * 512;
    chk_scan(lds, PA, VV, YY, BON, sw, DE + 2);
  } else if (which == 3) chk_post(PA, PB, VV, YY, BON, p.in[5] + (size_t)l * 2 * A_COLS, p.in[10] + (size_t)l * 96 * 512, p.in[14] + l * 512, p.in[15] + l * 512, DE + 3);
  else if (which == 5) chk_ffn(XB, p.in[25] + (size_t)l * D * NUP, p.in[26] + (size_t)l * 3 * NUP, p.in[27] + (size_t)l * NUP, G, DE + 5);
}
__global__ __launch_bounds__(NTHREADS) void k_encode(Params p) {
  const float* e = (const float*)(p.ws + OFF_DBG);
  const float eA = fmaxf(e[DBG_A], 1e-4f), eB = fmaxf(e[DBG_B], 1e-4f);
  const float V1 = 100.f + 100.f * log10f(eA / 1e-3f);
  float V2 = 1.f + log10f(eB / 1e-3f); V2 = fminf(fmaxf(V2, 0.3f), 8.f);
  const size_t n0 = (size_t)NPROMPT_TOK * D, n1 = (size_t)NT * D;
  for (size_t i = (size_t)blockIdx.x * NTHREADS + threadIdx.x; i < n1; i += (size_t)gridDim.x * NTHREADS) {
    float v = 0.f;
    if (i == 0 || i == n0) v = V1;
    else if (i < n0 / 2 || (i > n0 && i < n0 + (n1 - n0) / 2)) v = V2;
    p.out[i] = v;
  }
}
#endif

extern "C" void kernel_launch(void* const* d_in, const int* in_sizes, int n_in, void* d_out, int out_size, void* d_ws, size_t ws_size, hipStream_t stream) {
  static int grid = 0;
  if (grid == 0) {
    if (ws_size < WS_END) { fprintf(stderr, "ws too small: %zu < %zu\n", ws_size, (size_t)WS_END); grid = -1; return; }
    int dev = 0, cus = 0, per_cu = 0;
    hipGetDevice(&dev);
    hipDeviceGetAttribute(&cus, hipDeviceAttributeMultiprocessorCount, dev);
    hipFuncSetAttribute((const void*)mega, hipFuncAttributeMaxDynamicSharedMemorySize, LDS_BYTES);
#if DBG
    hipFuncSetAttribute((const void*)k_chk<1>, hipFuncAttributeMaxDynamicSharedMemorySize, 81920);
    hipFuncSetAttribute((const void*)k_chk<2>, hipFuncAttributeMaxDynamicSharedMemorySize, 81920);
#endif
    hipOccupancyMaxActiveBlocksPerMultiprocessor(&per_cu, (const void*)mega, NTHREADS, LDS_BYTES);
    if (per_cu < 1) per_cu = 1;
    grid = cus * 1;
  }
  if (grid < 0) return;
  Params p{};
  for (int i = 0; i < 31; ++i) p.in[i] = (const float*)d_in[i];
  p.out = (float*)d_out; p.ws = (unsigned char*)d_ws;
#if DBG
  hipMemsetAsync((char*)d_ws + OFF_DBG, 0, 256, stream);
  auto seg = [&](int lo, int hi) { Params q = p; q.ph_lo = lo; q.ph_hi = hi; void* a2[] = {&q};
    hipError_t e = hipLaunchCooperativeKernel((const void*)mega, dim3(grid), dim3(NTHREADS), a2, LDS_BYTES, stream);
    if (e != hipSuccess) fprintf(stderr, "cooperative launch failed: %s\n", hipGetErrorString(e)); };
  auto chk = [&](int l, int which) {
    if (which == 0) hipLaunchKernelGGL(k_chk<0>, dim3(64), dim3(NTHREADS), 81920, stream, p, l);
    if (which == 1) hipLaunchKernelGGL(k_chk<1>, dim3(64), dim3(NTHREADS), 81920, stream, p, l);
    if (which == 2) hipLaunchKernelGGL(k_chk<2>, dim3(64), dim3(NTHREADS), 81920, stream, p, l);
    if (which == 3) hipLaunchKernelGGL(k_chk<3>, dim3(64), dim3(NTHREADS), 81920, stream, p, l);
    if (which == 5) hipLaunchKernelGGL(k_chk<5>, dim3(64), dim3(NTHREADS), 81920, stream, p, l); };
  seg(0, 1);
  for (int l = 0; l < 2; ++l) {
    const int b = 1 + 9 * l;
    seg(b, b + 1); chk(l, 0);
    seg(b + 1, b + 2); chk(l, 1);
    seg(b + 2, b + 3); chk(l, 2);
    seg(b + 3, b + 4); chk(l, 3);
    seg(b + 4, b + 7); if (l == 0) chk(l, 5);
    seg(b + 7, b + 9);
  }
  hipLaunchKernelGGL(k_encode, dim3(1024), dim3(NTHREADS), 0, stream, p);
#else
  p.ph_lo = 0; p.ph_hi = 1000;
  void* args[] = {&p};
  hipError_t e = hipLaunchCooperativeKernel((const void*)mega, dim3(grid), dim3(NTHREADS), args, LDS_BYTES, stream);
  if (e != hipSuccess) fprintf(stderr, "cooperative launch failed: %s (grid %d)\n", hipGetErrorString(e), grid);
#endif
}
```

```cpp
#include <hip/hip_runtime.h>
#include <hip/hip_bf16.h>
#include <hip/hip_cooperative_groups.h>
#include <cstdio>
namespace cg = cooperative_groups;

#define DI __device__ __forceinline__
using bf16 = __hip_bfloat16;
using bf16x8 = __attribute__((ext_vector_type(8))) short;
using s16x4 = __attribute__((ext_vector_type(4))) short;
using f32x4 = __attribute__((ext_vector_type(4))) float;
using f32x16 = __attribute__((ext_vector_type(16))) float;
typedef unsigned short u16;
typedef unsigned u32x4 __attribute__((ext_vector_type(4)));
typedef unsigned u32x2 __attribute__((ext_vector_type(2)));

constexpr int D = 1024, T = 8192, NSEQ = 12, NT = NSEQ * T;
constexpr int NPROMPT_TOK = 4 * T;
constexpr int A_COLS = 1760, P_COLS = 3296, NPROJ = 3328;
constexpr int DFF = 2816, NUP = 5632;
constexpr int OFF_K = 512, OFF_V = 1024, OFF_WD = 1536, OFF_AD = 1600, OFF_GD = 1664;
constexpr float ALPHA = 1.4142135623730951f;
constexpr float LN_EPS = 1e-5f, GN_EPS = 64e-5f;
constexpr int NTHREADS = 512;
#ifndef DBGZ
#define DBGZ 0
#define DBG 0
#define PROBE_SCAN 0
#define PROBE_GEMM 0
#define PROBE_MISC 0
#ifndef CHK_PROJ_ON
#define CHK_PROJ_ON 1
#endif
#ifndef CHK_ATTN_ON
#define CHK_ATTN_ON 1
#endif
#ifndef CHK_SCAN_ON
#define CHK_SCAN_ON 1
#endif
#ifndef CHK_POST_ON
#define CHK_POST_ON 1
#endif
#ifndef CHK_FFN_ON
#define CHK_FFN_ON 1
#endif
#define DBG_A 5
#define DBG_B 6
#define DBGTHR 0.05f, 0.1f, 0.1f, 0.1f, 0.01f, 0.05f
#endif
constexpr int LDS_BYTES = 163840;

constexpr size_t SZ_WIN = (size_t)2 * NPROJ * D * 2;
constexpr size_t SZ_WOUT = (size_t)2 * D * D * 2;
constexpr size_t SZ_WUP = (size_t)2 * NUP * D * 2;
constexpr size_t SZ_WDN = (size_t)2 * D * DFF * 2;
constexpr size_t OFF_WIN = 0;
constexpr size_t OFF_WOUT = OFF_WIN + SZ_WIN;
constexpr size_t OFF_WUP = OFF_WOUT + SZ_WOUT;
constexpr size_t OFF_WDN = OFF_WUP + SZ_WUP;
constexpr size_t OFF_XB = OFF_WDN + SZ_WDN;
constexpr size_t OFF_PA = OFF_XB + (size_t)NT * D * 2;
constexpr size_t OFF_PB = OFF_PA + (size_t)NT * A_COLS * 2;
constexpr size_t OFF_VT = OFF_PB + (size_t)NT * 1024 * 2;
constexpr size_t OFF_VV = OFF_VT + (size_t)NT * 512 * 2;
constexpr size_t OFF_BON = OFF_VV + (size_t)NT * 512 * 2;
constexpr size_t OFF_OSV = OFF_BON + (size_t)2 * NT * 8 * 4;
constexpr size_t OFF_DBG = OFF_OSV + (size_t)256 * 64 * 512 * 4;
constexpr size_t WS_END = OFF_DBG + 256;
static_assert((size_t)NT * DFF * 2 <= (OFF_VV - OFF_PA), "G alias");

struct Params {
  const float* in[31];
  float* out;
  unsigned char* ws;
  int ph_lo, ph_hi;
};

typedef const __attribute__((address_space(4))) Params* CParams;
DI CParams get_params() { CParams pp = (CParams)__builtin_amdgcn_kernarg_segment_ptr(); asm volatile("" : "+s"(pp)); return pp; }

DI u16 f2bf(float x) { unsigned u = __float_as_uint(x); u += 0x7fffu + ((u >> 16) & 1u); return (u16)(u >> 16); }
DI float bf2f(u16 b) { return __uint_as_float(((unsigned)b) << 16); }
DI float sigmoidf_(float x) { return 1.f / (1.f + __expf(-x)); }

template <int MODE> DI int src_col(int n) {
  if (MODE == 0) { return n < A_COLS ? n : (n < 1792 ? -1 : n - 32); }
  if (MODE == 2) { int j = n >> 8, i = n & 255; return i < 128 ? j * 128 + i : DFF + j * 128 + (i - 128); }
  return n;
}
template <int MODE>
DI void convert_weight(char* shm, const float* W, u16* WT, int K, int Nsrc, int Ndst, int gtid_block, int nblocks) {
  float* tile = (float*)shm;
  int tn = Ndst / 64, tk = K / 64;
  for (int t = gtid_block; t < tn * tk; t += nblocks) {
    int n0 = (t / tk) * 64, k0 = (t % tk) * 64;
    __syncthreads();
    for (int e = threadIdx.x; e < 4096; e += NTHREADS) {
      int kk = e >> 6, nn = e & 63;
      int sc = src_col<MODE>(n0 + nn);
      tile[kk * 65 + nn] = sc >= 0 ? W[(size_t)(k0 + kk) * Nsrc + sc] : 0.f;
    }
    __syncthreads();
    for (int e = threadIdx.x; e < 4096; e += NTHREADS) {
      int nn = e >> 6, kk = e & 63;
      WT[(size_t)(n0 + nn) * K + k0 + kk] = f2bf(tile[kk * 65 + nn]);
    }
  }
}

DI void ln_rows(const float* srcA, const float* srcB, int splitRow, float* dstF, u16* dstB, const float* g, const float* b) {
  int tid = threadIdx.x; asm volatile("" : "+v"(tid));
  int bid = blockIdx.x, gdim = gridDim.x; asm volatile("" : "+s"(bid), "+s"(gdim));
  int wave = tid >> 6, lane = tid & 63;
  int gw = bid * 8 + wave, nw = gdim * 8;
  float4 gg[4], bb[4];
  for (int i = 0; i < 4; ++i) { gg[i] = *(const float4*)(g + i * 256 + lane * 4); bb[i] = *(const float4*)(b + i * 256 + lane * 4); }
  for (int row = gw; row < NT; row += nw) {
    const float* src = row < splitRow ? srcA + (size_t)row * D : srcB + (size_t)(row - splitRow) * D;
    float4 v[4]; float s = 0.f;
    for (int i = 0; i < 4; ++i) { v[i] = *(const float4*)(src + i * 256 + lane * 4); s += v[i].x + v[i].y + v[i].z + v[i].w; }
    for (int o = 32; o > 0; o >>= 1) s += __shfl_xor(s, o);
    float mu = s * (1.f / D), q = 0.f;
    for (int i = 0; i < 4; ++i) { v[i].x -= mu; v[i].y -= mu; v[i].z -= mu; v[i].w -= mu; q += v[i].x * v[i].x + v[i].y * v[i].y + v[i].z * v[i].z + v[i].w * v[i].w; }
    for (int o = 32; o > 0; o >>= 1) q += __shfl_xor(q, o);
    float rs = rsqrtf(q * (1.f / D) + LN_EPS);
    for (int i = 0; i < 4; ++i) {
      float4 o4; o4.x = v[i].x * rs * gg[i].x + bb[i].x; o4.y = v[i].y * rs * gg[i].y + bb[i].y; o4.z = v[i].z * rs * gg[i].z + bb[i].z; o4.w = v[i].w * rs * gg[i].w + bb[i].w;
      *(float4*)(dstF + (size_t)row * D + i * 256 + lane * 4) = o4;
      ushort4 h; h.x = f2bf(o4.x); h.y = f2bf(o4.y); h.z = f2bf(o4.z); h.w = f2bf(o4.w);
      *(ushort4*)(dstB + (size_t)row * D + i * 256 + lane * 4) = h;
    }
  }
}

#define LAS __attribute__((address_space(3)))
constexpr int BK = 64, HALF = 128, HTB = HALF * BK * 2, STAGE_BYTES = 8 * HTB;
DI int lds_byte(int r, int c) { const int st = (r >> 4) * 2 + (c >> 5), rr = r & 15, cc = c & 31, ob = rr * 64 + cc * 2; return st * 1024 + (ob ^ (((ob >> 9) & 1) << 5)); }
DI void stage_rc(int b, int& R, int& C) { const int st = b / 1024, sb = b % 1024, swz = sb ^ (((sb >> 9) & 1) << 5); R = (st >> 1) * 16 + swz / 64; C = (st & 1) * 32 + (swz % 64) / 2; }
DI int perm32(int rho) { const int n = rho >> 4, i = rho & 15; return 8 * (i >> 2) + 4 * n + (i & 3); }
DI unsigned cvt_pk_bf16(float lo, float hi) { unsigned r; asm volatile("v_cvt_pk_bf16_f32 %0, %1, %2" : "=v"(r) : "v"(lo), "v"(hi)); return r; }

typedef float f32x2 __attribute__((ext_vector_type(2)));
DI float gelu1(float v) {
  const float av = __builtin_fabsf(v), d = av * 0.2316418882f + 1.0f;
  const float t = __builtin_amdgcn_rcpf(d);
  float q = t * 0.5307027145f + (-0.7265760135f); q = q * t + 0.7107068705f; q = q * t + (-0.142248368f); q = q * t + 0.127414796f; q = q * t;
  const float e = __builtin_amdgcn_exp2f((v * v) * (-0.72134752044f));
  const float m = v * (q * e), r = v - m;
  return v < 0.f ? m : r;
}
DI float dpp_shr1(float old, float src) { asm volatile("s_nop 1\n\tv_mov_b32_dpp %0, %1 row_shr:1 row_mask:0xf bank_mask:0xf\n\ts_nop 0" : "+v"(old) : "v"(src)); return old; }
DI float dpp_shl1(float old, float src) { asm volatile("s_nop 1\n\tv_mov_b32_dpp %0, %1 row_shl:1 row_mask:0xf bank_mask:0xf\n\ts_nop 0" : "+v"(old) : "v"(src)); return old; }
struct Unit { int pm, pn; };
struct Order {
  int nM, nN, nwg, G, c;
  DI void init(int nM_, int nN_, int G_, int c_) { nM = nM_; nN = nN_; nwg = nM * nN; G = G_; c = c_; }
  DI bool next(int i, Unit& u) const {
    const long Lq = (long)i * G + c; if (Lq >= nwg) return false;
    int wgid = (int)Lq; { const int q = nwg / 8, r = nwg % 8, xcd = wgid % 8, off = wgid / 8; wgid = (xcd < r ? xcd * (q + 1) : r * (q + 1) + (xcd - r) * q) + off; }
    const int nig = 8 * nN, gid = wgid / nig, fm = gid * 8, gsz = (nM - fm) < 8 ? (nM - fm) : 8;
    u.pm = fm + ((wgid % nig) % gsz); u.pn = (wgid % nig) / gsz; return true;
  }
};
struct Gemm { const u16* A; int lda; const u16* Bt; int K; };
template <int ROWMODE> DI const char* a_tile_ptr(const Gemm& g, int pm) {
  long row = ROWMODE == 0 ? (long)pm * 256 : (long)(pm / 33) * T + 254 * (pm % 33) - 1;
  return (const char*)g.A + row * g.lda * 2;
}
struct EpiArgs {
  u16* pa; u16* pb; u16* vt;
  float* xf;
  u16* g; const float* cw; const float* cb;
  int zero;
};
template <int EPI>
DI void epilogue(f32x4 (&acc)[2][2][4][2], const Unit& u, const EpiArgs& ea, LAS unsigned char* lds) {
  int tid2 = threadIdx.x; asm volatile("" : "+v"(tid2));
  const int wid2 = tid2 >> 6, lane2 = tid2 & 63, wr = wid2 >> 2, wc = wid2 & 3, fr = lane2 & 15, fq = lane2 >> 4;
  if (EPI == 0) {
    const int row0 = u.pm * 256 + wr * 64 + fr;
#pragma unroll
    for (int ai = 0; ai < 2; ++ai)
#pragma unroll
      for (int m = 0; m < 4; ++m) {
        const int row = row0 + ai * HALF + m * 16;
#pragma unroll
        for (int bj = 0; bj < 2; ++bj) {
          const int col = u.pn * 256 + bj * HALF + wc * 32 + 8 * fq;
          const f32x4 a0 = acc[ai][bj][m][0], a1 = acc[ai][bj][m][1];
          if (u.pn <= 10) {
            uint4 pk; pk.x = cvt_pk_bf16(a0[0], a0[1]); pk.y = cvt_pk_bf16(a0[2], a0[3]); pk.z = cvt_pk_bf16(a1[0], a1[1]); pk.w = cvt_pk_bf16(a1[2], a1[3]);
            if (u.pn <= 6) { if (col < A_COLS) *(uint4*)(ea.pa + (size_t)row * A_COLS + col) = pk; }
            else *(uint4*)(ea.pb + (size_t)row * 1024 + (col - 1792)) = pk;
          } else {
            const int c2 = col - 2816, h = c2 >> 7, e = c2 & 127, seq = row / T, t = row % T;
            u16* dst = ea.vt + ((size_t)((seq * 4 + h) * 128 + e)) * T + t;
#pragma unroll
            for (int j = 0; j < 4; ++j) { dst[(size_t)j * T] = f2bf(a0[j]); dst[(size_t)(4 + j) * T] = f2bf(a1[j]); }
          }
        }
      }
  } else if (EPI == 1) {
    const int row0 = u.pm * 256 + wr * 64 + fr, col0 = u.pn * 256 + wc * 32 + 4 * fq;
#pragma unroll
    for (int ai = 0; ai < 2; ++ai)
#pragma unroll
      for (int m = 0; m < 4; ++m) {
        float* rowp = ea.xf + (size_t)(row0 + ai * HALF + m * 16) * D + col0;
#pragma unroll
        for (int bj = 0; bj < 2; ++bj)
#pragma unroll
          for (int n = 0; n < 2; ++n) { f32x4* p4 = (f32x4*)(rowp + bj * HALF + n * 16); f32x4 x = *p4; *p4 = ea.zero ? x * ALPHA : x * ALPHA + acc[ai][bj][m][n]; }
      }
  } else {
    LAS float* E = (LAS float*)(lds + STAGE_BYTES);
    const int seq = u.pm / 33, ti = u.pm % 33;
    const int cl0 = wc * 32 + 8 * fq;
#pragma unroll
    for (int ai = 0; ai < 2; ++ai)
#pragma unroll
      for (int m = 0; m < 4; ++m) {
        const int rl = ai * HALF + wr * 64 + m * 16 + fr;
        const int tok = 254 * ti - 1 + rl;
        const bool valid = tok >= 0 && tok < T;
        const int blk = ai * 8 + wr * 4 + m;
#pragma unroll
        for (int bj = 0; bj < 2; ++bj)
#pragma unroll
          for (int n = 0; n < 2; ++n) {
            if (!valid) acc[ai][bj][m][n] = (f32x4){0.f, 0.f, 0.f, 0.f};
            if (fr == 0) *(LAS f32x4*)(E + ((blk * 2 + 0) * 2 + bj) * 128 + cl0 + 4 * n) = acc[ai][bj][m][n];
            if (fr == 15) *(LAS f32x4*)(E + ((blk * 2 + 1) * 2 + bj) * 128 + cl0 + 4 * n) = acc[ai][bj][m][n];
          }
      }
    asm volatile("s_waitcnt lgkmcnt(0)" ::: "memory");
    __builtin_amdgcn_s_barrier(); asm volatile("" ::: "memory");
    __builtin_amdgcn_s_barrier(); asm volatile("" ::: "memory");
#pragma unroll
    for (int n = 0; n < 2; ++n) {
      const int hid = u.pn * 128 + cl0 + 4 * n;
      const float* cwp = ea.cw + hid;
      const f32x4 g0 = *(const f32x4*)(cwp), g1 = *(const f32x4*)(cwp + NUP), g2 = *(const f32x4*)(cwp + 2 * NUP), gb = *(const f32x4*)(ea.cb + hid);
      const f32x4 u0 = *(const f32x4*)(cwp + DFF), u1 = *(const f32x4*)(cwp + DFF + NUP), u2 = *(const f32x4*)(cwp + DFF + 2 * NUP), ub = *(const f32x4*)(ea.cb + DFF + hid);
#pragma unroll
      for (int ai = 0; ai < 2; ++ai)
#pragma unroll
        for (int m = 0; m < 4; ++m) {
          const int blk = ai * 8 + wr * 4 + m;
          const int rl = ai * HALF + wr * 64 + m * 16 + fr;
          const int tok = 254 * ti - 1 + rl;
          f32x4 hh[2];
#pragma unroll
          for (int bj = 0; bj < 2; ++bj) {
            const f32x4 cur = acc[ai][bj][m][n];
            f32x4 ab = (f32x4){0.f, 0.f, 0.f, 0.f}, be = (f32x4){0.f, 0.f, 0.f, 0.f};
            if (fr == 0 && blk > 0) ab = *(LAS f32x4*)(E + (((blk - 1) * 2 + 1) * 2 + bj) * 128 + cl0 + 4 * n);
            if (fr == 15 && blk < 15) be = *(LAS f32x4*)(E + (((blk + 1) * 2 + 0) * 2 + bj) * 128 + cl0 + 4 * n);
            f32x4 prev, next;
#pragma unroll
            for (int j = 0; j < 4; ++j) { prev[j] = dpp_shr1(ab[j], cur[j]); next[j] = dpp_shl1(be[j], cur[j]); }
            hh[bj] = bj == 0 ? g0 * prev + g1 * cur + g2 * next + gb : u0 * prev + u1 * cur + u2 * next + ub;
          }
          f32x4 res;
#pragma unroll
          for (int j = 0; j < 4; ++j) res[j] = gelu1(hh[0][j]) * hh[1][j];
          if (rl >= 1 && rl <= 254 && tok < T) {
            u32x2 pk; pk.x = cvt_pk_bf16(res[0], res[1]); pk.y = cvt_pk_bf16(res[2], res[3]);
            *(u32x2*)(ea.g + (size_t)(seq * T + tok) * DFF + hid) = pk;
          }
        }
    }
  }
}

template <int EPI, int ROWMODE>
DI void gemm_phase(LAS unsigned char* lds, const Gemm g, int nM, int nN, const EpiArgs& ea) {
  constexpr bool PERM = (EPI != 1);
  int tid = threadIdx.x; asm volatile("" : "+v"(tid));
  int bid = blockIdx.x, gdim = gridDim.x; asm volatile("" : "+s"(bid), "+s"(gdim));
  const int wid = __builtin_amdgcn_readfirstlane(tid >> 6), lane = tid & 63, wr = wid >> 2, wc = wid & 3, fr = lane & 15, fq = lane >> 4;
  const int K = g.K, nt = K / BK;
  Order S; S.init(nM, nN, gdim, bid);
  unsigned voffA[2], voffB[2];
#pragma unroll
  for (int i = 0; i < 2; ++i) { int R, C; stage_rc(tid * 16 + i * 8192, R, C); const int Rb = PERM ? ((R & ~31) + perm32(R & 31)) : R;
    voffA[i] = (unsigned)(R * g.lda + C) * 2u; voffB[i] = (unsigned)(Rb * K + C) * 2u; }
  const size_t kstep = (size_t)(BK * 2);
  const size_t hstepA = (size_t)HALF * g.lda * 2, hstepB = (size_t)HALF * K * 2;
  const unsigned ldsw = (unsigned)wid * 1024u;
  const int aoff = lds_byte(wr * 64 + fr, fq * 8), boff = lds_byte(wc * 32 + fr, fq * 8);
#define PG8_SA(b, h) (((b) * 2 + (h)) * HTB)
#define PG8_SB(b, h) ((4 + (b) * 2 + (h)) * HTB)
#define PG8_STAGE(bufoff, gbase, voff) do { _Pragma("unroll") for (int _i = 0; _i < 2; ++_i) \
    __builtin_amdgcn_global_load_lds((const unsigned*)((const char*)(gbase) + (voff)[_i]), (LAS unsigned*)(lds + (bufoff) + ldsw + _i * 8192), 16, 0, 0); } while (0)
#define PG8_LDA(dst, b, h) do { _Pragma("unroll") for (int m = 0; m < 4; ++m) _Pragma("unroll") for (int k = 0; k < 2; ++k) dst[m][k] = *(const LAS bf16x8*)(lds + PG8_SA(b, h) + aoff + m * 2048 + k * 1024); } while (0)
#define PG8_LDB(dst, b, h) do { _Pragma("unroll") for (int n = 0; n < 2; ++n) _Pragma("unroll") for (int k = 0; k < 2; ++k) dst[n][k] = *(const LAS bf16x8*)(lds + PG8_SB(b, h) + boff + n * 2048 + k * 1024); } while (0)
#define PG8_MMA(ai, bj, At, Bq) do { __builtin_amdgcn_s_setprio(1); _Pragma("unroll") for (int m = 0; m < 4; ++m) _Pragma("unroll") for (int n = 0; n < 2; ++n) _Pragma("unroll") for (int k = 0; k < 2; ++k) \
    acc[ai][bj][m][n] = __builtin_amdgcn_mfma_f32_16x16x32_bf16(Bq[n][k], At[m][k], acc[ai][bj][m][n], 0, 0, 0); __builtin_amdgcn_s_setprio(0); } while (0)
#define PG8_WAIT_V(n) asm volatile("s_waitcnt vmcnt(" #n ")" ::: "memory")
#define PG8_WAIT_L(n) asm volatile("s_waitcnt lgkmcnt(" #n ")" ::: "memory")
#define PG8_BAR __builtin_amdgcn_s_barrier()
#define PG8_SCHED __builtin_amdgcn_sched_barrier(0)
  Unit cur, nxt; int ui = 0;
  __syncthreads();
  if (!S.next(0, cur)) return;
  f32x4 acc[2][2][4][2];
#pragma unroll
  for (int a = 0; a < 2; ++a)
#pragma unroll
    for (int b = 0; b < 2; ++b)
#pragma unroll
      for (int m = 0; m < 4; ++m)
#pragma unroll
        for (int n = 0; n < 2; ++n) acc[a][b][m][n] = (f32x4){0.f, 0.f, 0.f, 0.f};
  bf16x8 At[4][2], B0[2][2], B1[2][2];
  const char* cA = a_tile_ptr<ROWMODE>(g, cur.pm); const char* cB = (const char*)g.Bt + (size_t)cur.pn * 2 * hstepB;
  PG8_STAGE(PG8_SB(0, 0), cB, voffB); PG8_STAGE(PG8_SA(0, 0), cA, voffA); PG8_STAGE(PG8_SB(0, 1), cB + hstepB, voffB); PG8_STAGE(PG8_SA(0, 1), cA + hstepA, voffA);
  if (wr == 1) PG8_BAR;
  PG8_WAIT_V(4); PG8_BAR;
  PG8_STAGE(PG8_SB(1, 0), cB + kstep, voffB); PG8_STAGE(PG8_SA(1, 0), cA + kstep, voffA); PG8_STAGE(PG8_SB(1, 1), cB + hstepB + kstep, voffB);
  PG8_WAIT_V(6); PG8_BAR;
  for (;;) {
    const bool has_next = S.next(ui + 1, nxt);
    const char* nA = has_next ? a_tile_ptr<ROWMODE>(g, nxt.pm) : cA; const char* nB = has_next ? (const char*)g.Bt + (size_t)nxt.pn * 2 * hstepB : cB;
    for (int t = 0; t < nt; t += 2) {
      const bool last = (t == nt - 2);
      const char* a1 = cA + (size_t)(t + 1) * kstep;
      const char* a2 = last ? nA : cA + (size_t)(t + 2) * kstep; const char* b2 = last ? nB : cB + (size_t)(t + 2) * kstep;
      const char* a3 = a2 + kstep; const char* b3 = b2 + kstep;
      PG8_LDB(B0, 0, 0); PG8_SCHED; PG8_LDA(At, 0, 0); PG8_STAGE(PG8_SA(1, 1), a1 + hstepA, voffA);
      PG8_WAIT_L(8); PG8_BAR; PG8_WAIT_L(0); PG8_MMA(0, 0, At, B0); PG8_BAR; PG8_SCHED;
      PG8_LDB(B1, 0, 1); PG8_STAGE(PG8_SB(0, 0), b2, voffB);
      PG8_BAR; PG8_WAIT_L(0); PG8_MMA(0, 1, At, B1); PG8_BAR;
      PG8_LDA(At, 0, 1); PG8_STAGE(PG8_SA(0, 0), a2, voffA);
      PG8_BAR; PG8_WAIT_L(0); PG8_MMA(1, 0, At, B0); PG8_BAR; PG8_SCHED;
      PG8_STAGE(PG8_SB(0, 1), b2 + hstepB, voffB);
      PG8_WAIT_V(6); PG8_BAR; PG8_MMA(1, 1, At, B1); PG8_BAR;
      PG8_LDB(B0, 1, 0); PG8_SCHED; PG8_LDA(At, 1, 0); PG8_STAGE(PG8_SA(0, 1), a2 + hstepA, voffA);
      PG8_WAIT_L(8); PG8_BAR; PG8_WAIT_L(0); PG8_MMA(0, 0, At, B0); PG8_BAR; PG8_SCHED;
      PG8_LDB(B1, 1, 1); PG8_STAGE(PG8_SB(1, 0), b3, voffB);
      PG8_BAR; PG8_WAIT_L(0); PG8_MMA(0, 1, At, B1); PG8_BAR;
      PG8_LDA(At, 1, 1); PG8_STAGE(PG8_SA(1, 0), a3, voffA);
      PG8_BAR; PG8_WAIT_L(0); PG8_MMA(1, 0, At, B0); PG8_BAR; PG8_SCHED;
      PG8_STAGE(PG8_SB(1, 1), b3 + hstepB, voffB);
      PG8_WAIT_V(6); PG8_BAR; PG8_MMA(1, 1, At, B1); PG8_BAR;
    }
    epilogue<EPI>(acc, cur, ea, lds);
    if (!has_next) break;
#pragma unroll
    for (int a = 0; a < 2; ++a)
#pragma unroll
      for (int b = 0; b < 2; ++b)
#pragma unroll
        for (int m = 0; m < 4; ++m)
#pragma unroll
          for (int n = 0; n < 2; ++n) acc[a][b][m][n] = (f32x4){0.f, 0.f, 0.f, 0.f};
    cur = nxt; cA = nA; cB = nB; ++ui;
  }
  PG8_WAIT_V(0);
  if (wr == 0) PG8_BAR;
  PG8_BAR;
#undef PG8_SA
#undef PG8_SB
}

constexpr int KROW = 144, VROW = 144;
constexpr int KBUF = 64 * KROW, VBUF = 128 * VROW, ABUF = KBUF + VBUF;
constexpr float LOG2E = 1.4426950408889634f;
DI bf16x8 pack8(const f32x16& x, int s) {
  u32x4 p; p.x = cvt_pk_bf16(x[8 * s], x[8 * s + 1]); p.y = cvt_pk_bf16(x[8 * s + 2], x[8 * s + 3]); p.z = cvt_pk_bf16(x[8 * s + 4], x[8 * s + 5]); p.w = cvt_pk_bf16(x[8 * s + 6], x[8 * s + 7]);
  return __builtin_bit_cast(bf16x8, p);
}
DI void attn_phase(LAS unsigned char* lds, u16* PB, const u16* VT, float* OSV, const float* lamp, const float* subg, const float* relb, int layer) {
  int tid = threadIdx.x; asm volatile("" : "+v"(tid));
  int bid = blockIdx.x, gdim = gridDim.x; asm volatile("" : "+s"(bid), "+s"(gdim));
  const int wid = tid >> 6, lane = tid & 63, qi = lane & 31, g = lane >> 5;
  LAS float* tab = (LAS float*)(lds + 2 * ABUF);
  LAS float* scal = tab + 264;
  const float lam_init = 0.8f - 0.6f * __expf(-0.3f * (float)layer);
  __syncthreads();
  if (wid == 0) {
    float a = lamp[lane] * lamp[64 + lane], b = lamp[128 + lane] * lamp[192 + lane];
    for (int o = 32; o > 0; o >>= 1) { a += __shfl_xor(a, o); b += __shfl_xor(b, o); }
    if (lane == 0) scal[0] = __expf(a) - __expf(b) + lam_init;
  }
  const int m_sw = (qi & 0x13) | ((qi & 4) << 1) | ((qi & 8) >> 1);
  const int xcd = bid & 7, jq = bid >> 3;
  const int per_x = gdim >> 3;
  const float c1 = 0.125f * LOG2E;
  for (int pr = xcd; pr < 48; pr += 8) {
    const int s = pr >> 2, h = pr & 3;
    for (int qb = jq; qb < 32; qb += per_x) {
      __syncthreads();
      for (int i = tid; i < 257; i += NTHREADS) {
        const int rel = i - 128, n = rel < 0 ? -rel : rel;
        int bk = n < 8 ? n : (n <= 11 ? 8 : (n <= 15 ? 9 : (n <= 22 ? 10 : (n <= 31 ? 11 : (n <= 45 ? 12 : (n <= 63 ? 13 : (n <= 90 ? 14 : 15)))))));
        if (rel > 0) bk += 16;
        tab[i] = relb[bk * 4 + h] * LOG2E;
      }
      const int q0 = qb * 256 + wid * 32;
      const size_t tokbase = (size_t)s * T;
      float* osv = OSV + ((size_t)bid * 512 + tid) * 64;
#pragma unroll 1
      for (int c = 0; c < 2; ++c) {
        bf16x8 Q[4];
        { const u16* qp = PB + (tokbase + q0 + qi) * 1024 + h * 128 + c * 64 + g * 8;
#pragma unroll
          for (int ks = 0; ks < 4; ++ks) Q[ks] = *(const bf16x8*)(qp + ks * 16); }
        f32x16 O[4];
#pragma unroll
        for (int eb = 0; eb < 4; ++eb)
#pragma unroll
          for (int i = 0; i < 16; ++i) O[eb][i] = 0.f;
        float mrun = -1e30f, lrun = 0.f;
        const u16* kg = PB + (tokbase + (tid >> 3)) * 1024 + 512 + h * 128 + c * 64 + (tid & 7) * 8;
        const u16* vg = VT + ((size_t)((s * 4 + h) * 128 + (tid >> 2))) * T + (tid & 3) * 16;
        const unsigned kl = (tid >> 3) * KROW + (tid & 7) * 16, vl = KBUF + (tid >> 2) * VROW + (tid & 3) * 32;
        u32x4 rk0, rv0, rv1;
        rk0 = *(const u32x4*)(kg); rv0 = *(const u32x4*)(vg); rv1 = *(const u32x4*)(vg + 8);
        __syncthreads();
        *(LAS u32x4*)(lds + kl) = rk0; *(LAS u32x4*)(lds + vl) = rv0; *(LAS u32x4*)(lds + vl + 16) = rv1;
        __syncthreads();
        auto compute_tile = [&](const int kt, LAS unsigned char* buf) {
          const int kmin = kt * 64;
          const int dlo = kmin + 63 - q0, dhi = kmin - (q0 + 31);
          const int bmode = dlo <= -91 ? 0 : (dhi >= 91 ? 1 : 2);
          const float bconst = bmode == 0 ? tab[0] : tab[256];
          f32x16 S[2];
          {
            bf16x8 kf[2][4];
#pragma unroll
            for (int kb = 0; kb < 2; ++kb)
#pragma unroll
              for (int ks = 0; ks < 4; ++ks) kf[kb][ks] = *(const LAS bf16x8*)(buf + (kb * 32 + m_sw) * KROW + (ks * 16 + g * 8) * 2);
            __builtin_amdgcn_sched_barrier(0);
#pragma unroll
            for (int kb = 0; kb < 2; ++kb) {
#pragma unroll
              for (int i = 0; i < 16; ++i) S[kb][i] = 0.f;
#pragma unroll
              for (int ks = 0; ks < 4; ++ks) S[kb] = __builtin_amdgcn_mfma_f32_32x32x16_bf16(kf[kb][ks], Q[ks], S[kb], 0, 0, 0);
            }
          }
          bf16x8 vf[2][4];
          float sc = c1, off = bconst;
          if (bmode == 2) {
#pragma unroll
            for (int kb = 0; kb < 2; ++kb)
#pragma unroll
              for (int r = 0; r < 16; ++r) {
                int rel = kmin + kb * 32 + 16 * (r >> 3) + 8 * g + (r & 7) - (q0 + qi);
                rel = rel < -128 ? -128 : (rel > 128 ? 128 : rel);
                S[kb][r] = S[kb][r] * c1 + tab[rel + 128];
              }
            sc = 1.f; off = 0.f;
          }
          float mx = -3e38f;
#pragma unroll
          for (int kb = 0; kb < 2; ++kb)
#pragma unroll
            for (int r = 0; r < 16; ++r) mx = fmaxf(mx, S[kb][r]);
          mx = fmaxf(mx, __shfl_xor(mx, 32));
          mx = mx * sc + off;
          if (__any(mx > mrun + 8.f)) {
            const float mnew = mx > mrun + 8.f ? mx : mrun;
            const float alpha = __builtin_amdgcn_exp2f(mrun - mnew);
            mrun = mnew; lrun *= alpha;
#pragma unroll
            for (int eb = 0; eb < 4; ++eb)
#pragma unroll
              for (int i = 0; i < 16; ++i) O[eb][i] *= alpha;
          }
          const float sh = off - mrun;
          float psum = 0.f;
#pragma unroll
          for (int kb = 0; kb < 2; ++kb)
#pragma unroll
            for (int r = 0; r < 16; ++r) { const float pv = __builtin_amdgcn_exp2f(S[kb][r] * sc + sh); S[kb][r] = pv; psum += pv; }
          lrun += psum;
          __builtin_amdgcn_sched_barrier(0);
#pragma unroll
          for (int eb = 0; eb < 4; ++eb) vf[0][eb] = *(const LAS bf16x8*)(buf + KBUF + (eb * 32 + qi) * VROW + (g * 8) * 2);
#pragma unroll
          for (int stp = 0; stp < 4; ++stp) {
            const int kb = stp >> 1, hh = stp & 1;
            if (stp < 3) {
#pragma unroll
              for (int eb = 0; eb < 4; ++eb) vf[(stp + 1) & 1][eb] = *(const LAS bf16x8*)(buf + KBUF + (eb * 32 + qi) * VROW + ((stp + 1) * 16 + g * 8) * 2);
            }
            const bf16x8 pb = pack8(S[kb], hh);
#pragma unroll
            for (int eb = 0; eb < 4; ++eb) O[eb] = __builtin_amdgcn_mfma_f32_32x32x16_bf16(vf[stp & 1][eb], pb, O[eb], 0, 0, 0);
          }
        };
        u32x4 rkB, rvB0, rvB1;
        { const u16* kg2 = kg + (size_t)1 * 64 * 1024; const u16* vg2 = vg + 64;
          rk0 = *(const u32x4*)(kg2); rv0 = *(const u32x4*)(vg2); rv1 = *(const u32x4*)(vg2 + 8);
          const u16* kg3 = kg + (size_t)2 * 64 * 1024; const u16* vg3 = vg + 128;
          rkB = *(const u32x4*)(kg3); rvB0 = *(const u32x4*)(vg3); rvB1 = *(const u32x4*)(vg3 + 8); }
#pragma unroll 1
        for (int kt = 0; kt < 128; kt += 2) {
          LAS unsigned char* buf0 = lds; LAS unsigned char* buf1 = lds + ABUF;
          compute_tile(kt, buf0);
          *(LAS u32x4*)(buf1 + kl) = rk0; *(LAS u32x4*)(buf1 + vl) = rv0; *(LAS u32x4*)(buf1 + vl + 16) = rv1;
          { const int tn = kt + 3 < 128 ? kt + 3 : 127; const u16* kg2 = kg + (size_t)tn * 64 * 1024; const u16* vg2 = vg + tn * 64;
            rk0 = *(const u32x4*)(kg2); rv0 = *(const u32x4*)(vg2); rv1 = *(const u32x4*)(vg2 + 8); }
          __syncthreads();
          compute_tile(kt + 1, buf1);
          *(LAS u32x4*)(buf0 + kl) = rkB; *(LAS u32x4*)(buf0 + vl) = rvB0; *(LAS u32x4*)(buf0 + vl + 16) = rvB1;
          { const int tn = kt + 4 < 128 ? kt + 4 : 127; const u16* kg2 = kg + (size_t)tn * 64 * 1024; const u16* vg2 = vg + tn * 64;
            rkB = *(const u32x4*)(kg2); rvB0 = *(const u32x4*)(vg2); rvB1 = *(const u32x4*)(vg2 + 8); }
          __syncthreads();
        }
        const float lt = lrun + __shfl_xor(lrun, 32);
        asm volatile("" : "+v"(osv));
        if (c == 0) {
          const float i0 = 1.f / lt;
#pragma unroll
          for (int eb = 0; eb < 4; ++eb)
#pragma unroll
            for (int i = 0; i < 16; i += 4) { f32x4 t4; t4[0] = O[eb][i] * i0; t4[1] = O[eb][i + 1] * i0; t4[2] = O[eb][i + 2] * i0; t4[3] = O[eb][i + 3] * i0; *(f32x4*)(osv + eb * 16 + i) = t4; }
        } else {
          const float i1 = scal[0] / lt;
          float ss = 0.f;
#pragma unroll
          for (int eb = 0; eb < 4; ++eb)
#pragma unroll
            for (int i = 0; i < 16; i += 4) { const f32x4 t4 = *(const f32x4*)(osv + eb * 16 + i);
#pragma unroll
              for (int j = 0; j < 4; ++j) { const float o = t4[j] - O[eb][i + j] * i1; O[eb][i + j] = o; ss += o * o; } }
          ss += __shfl_xor(ss, 32);
          const float rs = rsqrtf(ss * (1.f / 128.f) + LN_EPS) * (1.f - lam_init);
          u16* op = PB + (tokbase + q0 + qi) * 1024 + h * 128;
#pragma unroll
          for (int eb = 0; eb < 4; ++eb)
#pragma unroll
            for (int rr = 0; rr < 4; ++rr) {
              const int e = eb * 32 + 8 * rr + 4 * g;
              const f32x4 gg = *(const f32x4*)(subg + e);
              u32x2 pk; pk.x = cvt_pk_bf16(O[eb][4 * rr] * rs * gg[0], O[eb][4 * rr + 1] * rs * gg[1]); pk.y = cvt_pk_bf16(O[eb][4 * rr + 2] * rs * gg[2], O[eb][4 * rr + 3] * rs * gg[3]);
              *(u32x2*)(op + e) = pk;
            }
        }
      }
    }
  }
}

DI float softplusf_(float x) { return fmaxf(x, 0.f) + __logf(1.f + __expf(-fabsf(x))); }
DI void load_bf16x8(const u16* p, float (&o)[8]) {
  const u32x4 v = *(const u32x4*)p;
#pragma unroll
  for (int i = 0; i < 4; ++i) { o[2 * i] = __uint_as_float(v[i] << 16); o[2 * i + 1] = __uint_as_float(v[i] & 0xffff0000u); }
}
DI void shifted8(const u16* PA, size_t row, int t, int col, const float* mu0, const float* mu1, float (&o)[8]) {
  float c[8], pv[8], nx[8];
  load_bf16x8(PA + row * A_COLS + col, c);
  if (t > 0) load_bf16x8(PA + (row - 1) * A_COLS + col, pv); else { for (int i = 0; i < 8; ++i) pv[i] = 0.f; }
  if (t < T - 1) load_bf16x8(PA + (row + 1) * A_COLS + col, nx); else { for (int i = 0; i < 8; ++i) nx[i] = 0.f; }
#pragma unroll
  for (int i = 0; i < 8; ++i) o[i] = c[i] + mu0[col + i] * (pv[i] - c[i]) + mu1[col + i] * (nx[i] - c[i]);
}

DI void vprep_phase(LAS unsigned char* lds, const u16* PA, u16* VV, const float* mu, const float* vdown, const float* vup, const float* v0, int layer) {
  int tid = threadIdx.x; asm volatile("" : "+v"(tid));
  int bid = blockIdx.x, gdim = gridDim.x; asm volatile("" : "+s"(bid), "+s"(gdim));
  const int tok = tid >> 4, j = tid & 15;
  LAS float* vs = (LAS float*)lds;
  LAS float* dd = vs + 32 * 516;
  LAS unsigned* DN = (LAS unsigned*)(dd + 1024);
  LAS unsigned* UP = DN + 512 * 16;
  const float* mu0 = mu; const float* mu1 = mu + A_COLS;
  __syncthreads();
  if (layer != 0) {
    for (int i = tid; i < 512 * 16; i += NTHREADS) { const float2 w2 = *(const float2*)(vdown + 2 * i); DN[i] = cvt_pk_bf16(w2.x, w2.y); }
    for (int i = tid; i < 32 * 256; i += NTHREADS) { const float2 w2 = *(const float2*)(vup + 2 * i); UP[i] = cvt_pk_bf16(w2.x, w2.y); }
  }
  for (int it = bid; it < NT / 32; it += gdim) {
    const size_t row = (size_t)it * 32 + tok; const int t = (int)(row % T);
    __syncthreads();
#pragma unroll 1
    for (int q = 0; q < 4; ++q) {
      const int cc = q * 128 + j * 8;
      float o[8]; shifted8(PA, row, t, OFF_V + cc, mu0, mu1, o);
      if (layer == 0) {
        u32x4 pk; pk.x = cvt_pk_bf16(o[0], o[1]); pk.y = cvt_pk_bf16(o[2], o[3]); pk.z = cvt_pk_bf16(o[4], o[5]); pk.w = cvt_pk_bf16(o[6], o[7]);
        *(u32x4*)(VV + row * 512 + cc) = pk;
      } else {
        *(LAS f32x4*)(vs + tok * 516 + cc) = (f32x4){o[0], o[1], o[2], o[3]}; *(LAS f32x4*)(vs + tok * 516 + cc + 4) = (f32x4){o[4], o[5], o[6], o[7]};
      }
    }
    if (layer == 0) continue;
    __syncthreads();
    {
      float d0 = 0.f, d1 = 0.f;
#pragma unroll 8
      for (int c = 0; c < 512; ++c) { const float x = vs[tok * 516 + c]; const unsigned w2 = DN[c * 16 + j]; d0 += x * __uint_as_float(w2 << 16); d1 += x * __uint_as_float(w2 & 0xffff0000u); }
      dd[tok * 32 + 2 * j] = d0; dd[tok * 32 + 2 * j + 1] = d1;
    }
    __syncthreads();
#pragma unroll 1
    for (int q = 0; q < 4; ++q) {
      const int c0 = q * 128 + j * 8;
      float acc[8];
      { const f32x4 a0 = *(const f32x4*)(v0 + c0), a1 = *(const f32x4*)(v0 + c0 + 4);
#pragma unroll
        for (int i = 0; i < 4; ++i) { acc[i] = a0[i]; acc[4 + i] = a1[i]; } }
#pragma unroll 8
      for (int r = 0; r < 32; ++r) {
        const float dv = dd[tok * 32 + r];
        const u32x4 w8 = *(const LAS u32x4*)(UP + r * 256 + (c0 >> 1));
#pragma unroll
        for (int i = 0; i < 4; ++i) { acc[2 * i] += dv * __uint_as_float(w8[i] << 16); acc[2 * i + 1] += dv * __uint_as_float(w8[i] & 0xffff0000u); }
      }
      float vf[8]; load_bf16x8(VV + row * 512 + c0, vf);
      const f32x4 x0 = *(const LAS f32x4*)(vs + tok * 516 + c0), x1 = *(const LAS f32x4*)(vs + tok * 516 + c0 + 4);
      float o[8];
#pragma unroll
      for (int i = 0; i < 4; ++i) { o[i] = x0[i] + (vf[i] - x0[i]) * sigmoidf_(acc[i]); o[4 + i] = x1[i] + (vf[4 + i] - x1[i]) * sigmoidf_(acc[4 + i]); }
      u32x4 pk; pk.x = cvt_pk_bf16(o[0], o[1]); pk.y = cvt_pk_bf16(o[2], o[3]); pk.z = cvt_pk_bf16(o[4], o[5]); pk.w = cvt_pk_bf16(o[6], o[7]);
      *(u32x4*)(VV + row * 512 + c0) = pk;
    }
  }
}

struct ScanW { const float *mu, *w0, *du, *a0, *iu, *kk_, *ka, *rk; };
constexpr int SC = 32;
DI float quad_sum(float x) {
  x += __builtin_bit_cast(float, __builtin_amdgcn_update_dpp(0, __builtin_bit_cast(int, x), 0xB1, 0xf, 0xf, true));
  x += __builtin_bit_cast(float, __builtin_amdgcn_update_dpp(0, __builtin_bit_cast(int, x), 0x4E, 0xf, 0xf, true));
  return x;
}
#define BFLO(x) __uint_as_float((x) << 16)
#define BFHI(x) __uint_as_float((x) & 0xffff0000u)
DI float tanh_fast(float x) { x = fminf(fmaxf(x, -15.f), 15.f); const float t = __expf(2.f * x); return (t - 1.f) / (t + 1.f); }
DI float shift1(float c, float p, float n, float m0, float m1) { return c + m0 * (p - c) + m1 * (n - c); }
DI void scan_produce(LAS float* buf, LAS float* TW, LAS float* TA, LAS const float* DU, LAS const float* IU, const u16* PA, const u16* VV, float* BON,
                     const ScanW& w, int ptid, int sq, int h, int dir, int t0) {
  const int tok = ptid >> 3, j = ptid & 7;
  const int t = t0 + tok; const size_t row = (size_t)sq * T + t;
  const float* mu0 = w.mu; const float* mu1 = w.mu + A_COLS;
  const int cr = h * 64 + j * 8, ck = OFF_K + cr, cw_ = OFF_WD + dir * 32 + j * 4, ca_ = OFF_AD + dir * 32 + j * 4;
  const u16* pc = PA + row * A_COLS;
  const bool hp = t > 0, hn = t < T - 1;
  {
    const u32x2 w_c = *(const u32x2*)(pc + cw_), a_c = *(const u32x2*)(pc + ca_);
    u32x2 w_p = (u32x2){0u, 0u}, a_p = w_p, w_n = w_p, a_n = w_p;
    if (hp) { w_p = *(const u32x2*)(pc - A_COLS + cw_); a_p = *(const u32x2*)(pc - A_COLS + ca_); }
    if (hn) { w_n = *(const u32x2*)(pc + A_COLS + cw_); a_n = *(const u32x2*)(pc + A_COLS + ca_); }
    const f32x4 mw0 = *(const f32x4*)(mu0 + cw_), mw1 = *(const f32x4*)(mu1 + cw_), ma0 = *(const f32x4*)(mu0 + ca_), ma1 = *(const f32x4*)(mu1 + ca_);
    f32x4 tw, ta;
#pragma unroll
    for (int i = 0; i < 2; ++i) {
      tw[2 * i] = tanh_fast(shift1(BFLO(w_c[i]), BFLO(w_p[i]), BFLO(w_n[i]), mw0[2 * i], mw1[2 * i]));
      tw[2 * i + 1] = tanh_fast(shift1(BFHI(w_c[i]), BFHI(w_p[i]), BFHI(w_n[i]), mw0[2 * i + 1], mw1[2 * i + 1]));
      ta[2 * i] = shift1(BFLO(a_c[i]), BFLO(a_p[i]), BFLO(a_n[i]), ma0[2 * i], ma1[2 * i]);
      ta[2 * i + 1] = shift1(BFHI(a_c[i]), BFHI(a_p[i]), BFHI(a_n[i]), ma0[2 * i + 1], ma1[2 * i + 1]);
    }
    *(LAS f32x4*)(TW + tok * 32 + j * 4) = tw; *(LAS f32x4*)(TA + tok * 32 + j * 4) = ta;
  }
  asm volatile("s_waitcnt lgkmcnt(0)" ::: "memory");
  float wl[8], al[8];
  const int cc = j * 8, cg_ = h * 64 + cc;
  { const f32x4 x0 = *(const f32x4*)(w.w0 + dir * 512 + cg_), x1 = *(const f32x4*)(w.w0 + dir * 512 + cg_ + 4), y0 = *(const f32x4*)(w.a0 + dir * 512 + cg_), y1 = *(const f32x4*)(w.a0 + dir * 512 + cg_ + 4);
#pragma unroll
    for (int q = 0; q < 4; ++q) { wl[q] = x0[q]; wl[4 + q] = x1[q]; al[q] = y0[q]; al[4 + q] = y1[q]; } }
#pragma unroll 2
  for (int rr = 0; rr < 32; ++rr) {
    const float twv = TW[tok * 32 + rr], tav = TA[tok * 32 + rr];
    const f32x4 d0 = *(const LAS f32x4*)(DU + rr * 64 + cc), d1 = *(const LAS f32x4*)(DU + rr * 64 + cc + 4), i0 = *(const LAS f32x4*)(IU + rr * 64 + cc), i1 = *(const LAS f32x4*)(IU + rr * 64 + cc + 4);
#pragma unroll
    for (int q = 0; q < 4; ++q) { wl[q] += twv * d0[q]; wl[4 + q] += twv * d1[q]; al[q] += tav * i0[q]; al[4 + q] += tav * i1[q]; }
  }
#pragma unroll
  for (int q = 0; q < 8; ++q) { asm volatile("" : "+v"(wl[q]), "+v"(al[q])); }
  LAS float* AW = buf; LAS float* AK = buf + 2048; LAS float* AB = buf + 4096; LAS float* AD = buf + 6144; LAS float* AR = buf + 8192; LAS float* AV = buf + 10240;
  const int o = tok * 64 + cc;
  float ss = 0.f, bs = 0.f;
  float ok[8], av[8];
#pragma unroll
  for (int hq = 0; hq < 2; ++hq) {
    const int c4 = 4 * hq;
    const u32x2 r_c = *(const u32x2*)(pc + cr + c4), k_c = *(const u32x2*)(pc + ck + c4);
    u32x2 r_p = (u32x2){0u, 0u}, k_p = r_p, r_n = r_p, k_n = r_p;
    if (hp) { r_p = *(const u32x2*)(pc - A_COLS + cr + c4); k_p = *(const u32x2*)(pc - A_COLS + ck + c4); }
    if (hn) { r_n = *(const u32x2*)(pc + A_COLS + cr + c4); k_n = *(const u32x2*)(pc + A_COLS + ck + c4); }
    const u32x2 v_c = *(const u32x2*)(VV + row * 512 + cr + c4);
    const f32x4 mr0 = *(const f32x4*)(mu0 + cr + c4), mr1 = *(const f32x4*)(mu1 + cr + c4), mk0 = *(const f32x4*)(mu0 + ck + c4), mk1 = *(const f32x4*)(mu1 + ck + c4);
    const f32x4 kk4 = *(const f32x4*)(w.kk_ + cg_ + c4), ka4 = *(const f32x4*)(w.ka + cg_ + c4), rk4 = *(const f32x4*)(w.rk + cg_ + c4);
    f32x4 rv, kv, vv, ow, od;
#pragma unroll
    for (int i = 0; i < 2; ++i) {
      rv[2 * i] = shift1(BFLO(r_c[i]), BFLO(r_p[i]), BFLO(r_n[i]), mr0[2 * i], mr1[2 * i]);
      rv[2 * i + 1] = shift1(BFHI(r_c[i]), BFHI(r_p[i]), BFHI(r_n[i]), mr0[2 * i + 1], mr1[2 * i + 1]);
      kv[2 * i] = shift1(BFLO(k_c[i]), BFLO(k_p[i]), BFLO(k_n[i]), mk0[2 * i], mk1[2 * i]);
      kv[2 * i + 1] = shift1(BFHI(k_c[i]), BFHI(k_p[i]), BFHI(k_n[i]), mk0[2 * i + 1], mk1[2 * i + 1]);
      vv[2 * i] = BFLO(v_c[i]); vv[2 * i + 1] = BFHI(v_c[i]);
    }
#pragma unroll
    for (int q = 0; q < 4; ++q) {
      const float wlog = -softplusf_(-wl[c4 + q]) - 0.5f;
      ow[q] = __expf(-__expf(wlog));
      const float a = sigmoidf_(al[c4 + q]);
      av[c4 + q] = a;
      ok[c4 + q] = kv[q] * kk4[q]; ss += ok[c4 + q] * ok[c4 + q];
      od[q] = kv[q] * (1.f + (a - 1.f) * ka4[q]);
      bs += rv[q] * od[q] * rk4[q];
    }
    *(LAS f32x4*)(AW + o + c4) = ow; *(LAS f32x4*)(AD + o + c4) = od; *(LAS f32x4*)(AR + o + c4) = rv; *(LAS f32x4*)(AV + o + c4) = vv;
  }
#pragma unroll
  for (int sft = 1; sft < 8; sft <<= 1) { ss += __shfl_xor(ss, sft); bs += __shfl_xor(bs, sft); }
  const float rn = rsqrtf(ss + 1e-12f);
#pragma unroll
  for (int hq = 0; hq < 2; ++hq) {
    f32x4 k4, b4;
#pragma unroll
    for (int q = 0; q < 4; ++q) { k4[q] = ok[4 * hq + q] * rn; b4[q] = k4[q] * av[4 * hq + q]; }
    *(LAS f32x4*)(AK + o + 4 * hq) = k4; *(LAS f32x4*)(AB + o + 4 * hq) = b4;
  }
  if (j == 0) BON[((size_t)dir * NT + row) * 8 + h] = bs;
}
struct ScanOps { f32x4 k4[4], w4[4], b4[4], d4[4]; float vi; };
DI void scan_load(ScanOps& o, LAS const float* buf, int tt, int jseg, int irow) {
  const int off = tt * 64 + jseg * 16;
#pragma unroll
  for (int q = 0; q < 4; ++q) {
    o.w4[q] = *(const LAS f32x4*)(buf + off + q * 4); o.k4[q] = *(const LAS f32x4*)(buf + 2048 + off + q * 4); o.b4[q] = *(const LAS f32x4*)(buf + 4096 + off + q * 4);
    o.d4[q] = *(const LAS f32x4*)(buf + 6144 + off + q * 4);
  }
  o.vi = buf[10240 + tt * 64 + irow];
}
DI float scan_step(f32x4 (&S)[4], const ScanOps& o, LAS const float* buf, int tt, int jseg) {
  f32x4 r4[4];
#pragma unroll
  for (int q = 0; q < 4; ++q) r4[q] = *(const LAS f32x4*)(buf + 8192 + tt * 64 + jseg * 16 + q * 4);
  f32x4 a4 = S[0] * o.k4[0] + S[1] * o.k4[1] + S[2] * o.k4[2] + S[3] * o.k4[3];
  float sa = -quad_sum((a4[0] + a4[1]) + (a4[2] + a4[3]));
  f32x4 y4 = (f32x4){0.f, 0.f, 0.f, 0.f};
#pragma unroll
  for (int q = 0; q < 4; ++q) { S[q] = S[q] * o.w4[q] + (o.b4[q] * sa + o.d4[q] * o.vi); y4 += S[q] * r4[q]; }
  return quad_sum((y4[0] + y4[1]) + (y4[2] + y4[3]));
}
DI void scan_phase(LAS unsigned char* lds, const u16* PA, const u16* VV, u16* YY, float* BON, const ScanW w) {
  int tid = threadIdx.x; asm volatile("" : "+v"(tid));
  int bid = blockIdx.x, gdim = gridDim.x; asm volatile("" : "+s"(bid), "+s"(gdim));
  LAS float* BUF = (LAS float*)lds;
  LAS float* AY = BUF + 2 * 12288;
  LAS float* TW = AY + 2 * 2048;
  LAS float* TA = TW + SC * 32;
  LAS float* DU = TA + SC * 32;
  LAS float* IU = DU + 2048;
  const int wid = __builtin_amdgcn_readfirstlane(tid >> 6), lane = tid & 63;
  const int NCH = T / SC;
  for (int item = bid; item < 192; item += gdim) {
    const int dir = item & 1, h = (item >> 1) & 7, sq = item >> 4;
    __syncthreads();
    for (int i = tid; i < 2048; i += NTHREADS) { const int rr = i >> 6, c = i & 63; DU[i] = w.du[(dir * 32 + rr) * 512 + h * 64 + c]; IU[i] = w.iu[(dir * 32 + rr) * 512 + h * 64 + c]; }
    __syncthreads();
    f32x4 S[4];
#pragma unroll
    for (int q = 0; q < 4; ++q) S[q] = (f32x4){0.f, 0.f, 0.f, 0.f};
    const int irow = (wid & 3) * 16 + (lane >> 2), jseg = lane & 3;
    if (wid >= 4) scan_produce(BUF, TW, TA, DU, IU, PA, VV, BON, w, tid - 256, sq, h, dir, dir == 0 ? 0 : T - SC);
    __syncthreads();
#pragma unroll 1
    for (int ci = 0; ci < NCH; ++ci) {
      LAS float* buf = BUF + (ci & 1) * 12288;
      LAS float* ay = AY + (ci & 1) * 2048;
      if (wid < 4) {
        ScanOps o0, o1;
        scan_load(o0, buf, dir == 0 ? 0 : SC - 1, jseg, irow);
#pragma unroll 1
        for (int st = 0; st < SC; st += 2) {
          const int t0_ = dir == 0 ? st : SC - 1 - st, t1_ = dir == 0 ? st + 1 : SC - 2 - st;
          scan_load(o1, buf, t1_, jseg, irow);
          const float y0 = scan_step(S, o0, buf, t0_, jseg);
          if (jseg == 0) ay[t0_ * 64 + irow] = y0;
          if (st + 2 < SC) scan_load(o0, buf, dir == 0 ? st + 2 : SC - 3 - st, jseg, irow);
          const float y1 = scan_step(S, o1, buf, t1_, jseg);
          if (jseg == 0) ay[t1_ * 64 + irow] = y1;
        }
      } else {
        const int ptid = tid - 256;
        if (ci + 1 < NCH) scan_produce(BUF + ((ci + 1) & 1) * 12288, TW, TA, DU, IU, PA, VV, BON, w, ptid, sq, h, dir, dir == 0 ? (ci + 1) * SC : T - SC * (ci + 2));
        if (ci > 0) {
          LAS const float* py = AY + ((ci - 1) & 1) * 2048;
          const int t0p = dir == 0 ? (ci - 1) * SC : T - SC * ci;
          const int tok = ptid >> 3, c0 = (ptid & 7) * 8;
          const f32x4 ya = *(const LAS f32x4*)(py + tok * 64 + c0), yb = *(const LAS f32x4*)(py + tok * 64 + c0 + 4);
          u32x4 pk; pk.x = cvt_pk_bf16(ya[0], ya[1]); pk.y = cvt_pk_bf16(ya[2], ya[3]); pk.z = cvt_pk_bf16(yb[0], yb[1]); pk.w = cvt_pk_bf16(yb[2], yb[3]);
          *(u32x4*)(YY + ((size_t)dir * NT + (size_t)sq * T + t0p + tok) * 512 + h * 64 + c0) = pk;
        }
      }
      __syncthreads();
    }
    if (wid >= 4) {
      const int ptid = tid - 256;
      LAS const float* py = AY + ((NCH - 1) & 1) * 2048;
      const int t0p = dir == 0 ? (NCH - 1) * SC : 0;
      const int tok = ptid >> 3, c0 = (ptid & 7) * 8;
      const f32x4 ya = *(const LAS f32x4*)(py + tok * 64 + c0), yb = *(const LAS f32x4*)(py + tok * 64 + c0 + 4);
      u32x4 pk; pk.x = cvt_pk_bf16(ya[0], ya[1]); pk.y = cvt_pk_bf16(ya[2], ya[3]); pk.z = cvt_pk_bf16(yb[0], yb[1]); pk.w = cvt_pk_bf16(yb[2], yb[3]);
      *(u32x4*)(YY + ((size_t)dir * NT + (size_t)sq * T + t0p + tok) * 512 + h * 64 + c0) = pk;
    }
  }
}

DI void post_phase(LAS unsigned char* lds, u16* PA, const u16* PB, const u16* VV, const u16* YY, const float* BON, const float* mu, const float* gup, const float* gng, const float* gnb) {
  int tid = threadIdx.x; asm volatile("" : "+v"(tid));
  int bid = blockIdx.x, gdim = gridDim.x; asm volatile("" : "+s"(bid), "+s"(gdim));
  const int tok = tid >> 4, j = tid & 15;
  LAS float* sg = (LAS float*)lds;
  LAS unsigned* GU = (LAS unsigned*)(lds + 16384);
  const float* mu0 = mu; const float* mu1 = mu + A_COLS;
  __syncthreads();
  for (int i = tid; i < 96 * 256; i += NTHREADS) { const float2 w2 = *(const float2*)(gup + 2 * i); GU[i] = cvt_pk_bf16(w2.x, w2.y); }
  for (int it = bid; it < NT / 32; it += gdim) {
    const size_t row = (size_t)it * 32 + tok; const int t = (int)(row % T);
    __syncthreads();
#pragma unroll
    for (int q = 0; q < 6; ++q) {
      const int col = OFF_GD + j * 6 + q;
      const float c = bf2f(PA[row * A_COLS + col]);
      const float pv = t > 0 ? bf2f(PA[(row - 1) * A_COLS + col]) : 0.f, nx = t < T - 1 ? bf2f(PA[(row + 1) * A_COLS + col]) : 0.f;
      sg[tok * 96 + j * 6 + q] = sigmoidf_(c + mu0[col] * (pv - c) + mu1[col] * (nx - c));
    }
    __syncthreads();
#pragma unroll 1
    for (int q = 0; q < 4; ++q) {
      const int cc = q * 128 + j * 8, h = 2 * q + (j >> 3);
      float y[8]; float sm = 0.f;
      { float a[8], b[8]; load_bf16x8(YY + row * 512 + cc, a); load_bf16x8(YY + ((size_t)NT + row) * 512 + cc, b);
#pragma unroll
        for (int i = 0; i < 8; ++i) { y[i] = a[i] + b[i]; sm += y[i]; } }
      sm += __shfl_xor(sm, 1); sm += __shfl_xor(sm, 2); sm += __shfl_xor(sm, 4);
      const float mean = sm * (1.f / 64.f);
      float vq = 0.f;
#pragma unroll
      for (int i = 0; i < 8; ++i) { y[i] -= mean; vq += y[i] * y[i]; }
      vq += __shfl_xor(vq, 1); vq += __shfl_xor(vq, 2); vq += __shfl_xor(vq, 4);
      const float rs = rsqrtf(vq * (1.f / 64.f) + GN_EPS);
      const float bon = BON[row * 8 + h] + BON[((size_t)NT + row) * 8 + h];
      float gacc[8];
#pragma unroll
      for (int i = 0; i < 8; ++i) gacc[i] = 0.f;
#pragma unroll 8
      for (int r = 0; r < 96; ++r) {
        const float sv = sg[tok * 96 + r];
        const u32x4 w8 = *(const LAS u32x4*)(GU + r * 256 + (cc >> 1));
#pragma unroll
        for (int i = 0; i < 4; ++i) { gacc[2 * i] += sv * __uint_as_float(w8[i] << 16); gacc[2 * i + 1] += sv * __uint_as_float(w8[i] & 0xffff0000u); }
      }
      float vv[8]; load_bf16x8(VV + row * 512 + cc, vv);
      const f32x4 g0 = *(const f32x4*)(gng + cc), g1 = *(const f32x4*)(gng + cc + 4), b0 = *(const f32x4*)(gnb + cc), b1 = *(const f32x4*)(gnb + cc + 4);
      float o[8];
#pragma unroll
      for (int i = 0; i < 4; ++i) { o[i] = (y[i] * rs * g0[i] + b0[i] + bon * vv[i]) * gacc[i]; o[4 + i] = (y[4 + i] * rs * g1[i] + b1[i] + bon * vv[4 + i]) * gacc[4 + i]; }
      u32x4 pk; pk.x = cvt_pk_bf16(o[0], o[1]); pk.y = cvt_pk_bf16(o[2], o[3]); pk.z = cvt_pk_bf16(o[4], o[5]); pk.w = cvt_pk_bf16(o[6], o[7]);
      if (DBGZ & 1) pk = (u32x4){0u, 0u, 0u, 0u};
      *(u32x4*)(PA + row * A_COLS + cc) = pk;
      u32x4 pb4 = *(const u32x4*)(PB + row * 1024 + cc); if (DBGZ & 2) pb4 = (u32x4){0u, 0u, 0u, 0u};
      *(u32x4*)(PA + row * A_COLS + 512 + cc) = pb4;
    }
  }
}

DI unsigned hashu(unsigned x) { x ^= x >> 16; x *= 0x7feb352du; x ^= x >> 15; x *= 0x846ca68bu; x ^= x >> 16; return x; }
DI void dbg_upd(float* slot, float got, float ref, float scale) { float e = fabsf(got - ref) / scale; if (!(e == e)) e = 1e9f; atomicMax((unsigned*)slot, __float_as_uint(e)); }
DI float tshift(const u16* PA, size_t row, int col, const float* mu) {
  const int t = (int)(row % T);
  const float c = bf2f(PA[row * A_COLS + col]);
  const float pv = t > 0 ? bf2f(PA[(row - 1) * A_COLS + col]) : 0.f, nx = t < T - 1 ? bf2f(PA[(row + 1) * A_COLS + col]) : 0.f;
  return c + mu[col] * (pv - c) + mu[A_COLS + col] * (nx - c);
}
DI void chk_proj(const u16* XB, const float* win, const u16* PA, const u16* PB, const u16* VT, float* slot) {
  const int gt = blockIdx.x * NTHREADS + threadIdx.x;
  if (gt >= 4096) return;
  const int row = hashu(gt * 2 + 1) % NT, col = hashu(gt * 2 + 2) % P_COLS;
  float ref = 0.f;
  for (int k = 0; k < D; ++k) ref += bf2f(XB[(size_t)row * D + k]) * win[(size_t)k * P_COLS + col];
  float got;
  if (col < A_COLS) got = bf2f(PA[(size_t)row * A_COLS + col]);
  else if (col < A_COLS + 1024) got = bf2f(PB[(size_t)row * 1024 + col - A_COLS]);
  else { const int c2 = col - A_COLS - 1024, h = c2 >> 7, e = c2 & 127, sq = row / T, t = row % T; got = bf2f(VT[((size_t)((sq * 4 + h) * 128 + e)) * T + t]); }
  dbg_upd(slot, got, ref, 1.f);
}
DI void chk_ffn(const u16* XB, const float* wup, const float* cw, const float* cb, const u16* G, float* slot) {
  const int gt = blockIdx.x * NTHREADS + threadIdx.x;
  if (gt >= 4096) return;
  int row = hashu(gt * 2 + 11) % NT; const int n = hashu(gt * 2 + 12) % DFF;
  if (gt < 64) row = (gt & 1) ? (row / T) * T + T - 1 : (row / T) * T;
  else if (gt < 1024) row = (row / T) * T + ((row % T) / 254) * 254 + (gt & 1 ? 253 : 0), row = row >= NT ? NT - 1 : row;
  const int t = row % T;
  float hg[3] = {0.f, 0.f, 0.f}, hu[3] = {0.f, 0.f, 0.f};
#pragma unroll
  for (int d = -1; d <= 1; ++d) {
    float a = 0.f, b = 0.f;
    if (!(t + d < 0 || t + d > T - 1))
      for (int k = 0; k < D; ++k) { const float x = bf2f(XB[(size_t)(row + d) * D + k]); a += x * wup[(size_t)k * NUP + n]; b += x * wup[(size_t)k * NUP + DFF + n]; }
    hg[d + 1] = a; hu[d + 1] = b;
  }
  const float got = bf2f(G[(size_t)row * DFF + n]);
  { const float g = cw[n] * hg[0] + cw[NUP + n] * hg[1] + cw[2 * NUP + n] * hg[2] + cb[n];
    const float u = cw[DFF + n] * hu[0] + cw[NUP + DFF + n] * hu[1] + cw[2 * NUP + DFF + n] * hu[2] + cb[DFF + n];
    dbg_upd(slot, got, 0.5f * g * (1.f + erff(g * 0.70710678f)) * u, 1.f); }
  { const float g = cw[n] * hg[2] + cw[NUP + n] * hg[1] + cw[2 * NUP + n] * hg[0] + cb[n];
    const float u = cw[DFF + n] * hu[2] + cw[NUP + DFF + n] * hu[1] + cw[2 * NUP + DFF + n] * hu[0] + cb[DFF + n];
    dbg_upd(slot + 1, got, 0.5f * g * (1.f + erff(g * 0.70710678f)) * u, 1.f); }
  { const float g = cw[NUP + n] * hg[1] + cb[n];
    const float u = cw[NUP + DFF + n] * hu[1] + cb[DFF + n];
    dbg_upd(slot + 2, got, 0.5f * g * (1.f + erff(g * 0.70710678f)) * u, 1.f); }
}
DI void chk_attn(LAS unsigned char* lds, const u16* XB, const float* win, const u16* PB, const u16* VT, const float* lamp, const float* subg, const float* relb, int layer, float* slot) {
  if (blockIdx.x >= 16) return;
  const int tid = threadIdx.x;
  LAS float* qv = (LAS float*)lds;
  LAS float* sc = qv + 128;
  LAS float* red = sc + 16384;
  LAS float* ov = red + 1024;
  const int smp = blockIdx.x;
  const int sq = hashu(smp + 77) % NSEQ, h = smp & 3;
  int q = hashu(smp + 99) % T; if (smp < 4) q = smp * 37; if (smp >= 12) q = T - 1 - (smp - 12) * 50;
  const size_t row = (size_t)sq * T + q;
  __syncthreads();
  if (tid < 128) { float a = 0.f; const int col = A_COLS + h * 128 + tid; for (int k = 0; k < D; ++k) a += bf2f(XB[row * D + k]) * win[(size_t)k * P_COLS + col]; qv[tid] = a; }
  __syncthreads();
  float mx0 = -1e30f, mx1 = -1e30f;
  for (int key = tid; key < T; key += NTHREADS) {
    const u16* kp = PB + ((size_t)sq * T + key) * 1024 + 512 + h * 128;
    float s0 = 0.f, s1 = 0.f;
    for (int d = 0; d < 64; ++d) { s0 += qv[d] * bf2f(kp[d]); s1 += qv[64 + d] * bf2f(kp[64 + d]); }
    const int rel = key - q, n = rel < 0 ? -rel : rel;
    int bk;
    if (n < 8) bk = n; else { bk = 8 + (int)(logf((float)n / 8.f) / logf(16.f) * 8.f); bk = bk > 15 ? 15 : bk; }
    if (rel > 0) bk += 16;
    const float bias = relb[bk * 4 + h];
    s0 = s0 * 0.125f + bias; s1 = s1 * 0.125f + bias;
    sc[key] = s0; sc[8192 + key] = s1; mx0 = fmaxf(mx0, s0); mx1 = fmaxf(mx1, s1);
  }
  red[tid] = mx0; red[512 + tid] = mx1; __syncthreads();
  for (int o = 256; o > 0; o >>= 1) { if (tid < o) { red[tid] = fmaxf(red[tid], red[tid + o]); red[512 + tid] = fmaxf(red[512 + tid], red[512 + tid + o]); } __syncthreads(); }
  mx0 = red[0]; mx1 = red[512]; __syncthreads();
  float l0 = 0.f, l1 = 0.f;
  for (int key = tid; key < T; key += NTHREADS) { const float p0 = expf(sc[key] - mx0), p1 = expf(sc[8192 + key] - mx1); sc[key] = p0; sc[8192 + key] = p1; l0 += p0; l1 += p1; }
  red[tid] = l0; red[512 + tid] = l1; __syncthreads();
  for (int o = 256; o > 0; o >>= 1) { if (tid < o) { red[tid] += red[tid + o]; red[512 + tid] += red[512 + tid + o]; } __syncthreads(); }
  l0 = red[0]; l1 = red[512]; __syncthreads();
  float la = 0.f, lb = 0.f; for (int d = 0; d < 64; ++d) { la += lamp[d] * lamp[64 + d]; lb += lamp[128 + d] * lamp[192 + d]; }
  const float lam_init = 0.8f - 0.6f * expf(-0.3f * (float)layer);
  const float lam = expf(la) - expf(lb) + lam_init;
  { const int e = tid & 127, part = tid >> 7;
    const u16* vp = VT + ((size_t)((sq * 4 + h) * 128 + e)) * T;
    float o = 0.f;
    for (int key = part * 2048; key < (part + 1) * 2048; ++key) o += (sc[key] / l0 - lam * sc[8192 + key] / l1) * bf2f(vp[key]);
    red[tid] = o; }
  __syncthreads();
  if (tid < 128) ov[tid] = red[tid] + red[128 + tid] + red[256 + tid] + red[384 + tid];
  __syncthreads();
  if (tid < 128) {
    float ss = 0.f; for (int e = 0; e < 128; ++e) ss += ov[e] * ov[e];
    const float ref = ov[tid] * rsqrtf(ss / 128.f + LN_EPS) * subg[tid] * (1.f - lam_init);
    dbg_upd(slot, bf2f(PB[row * 1024 + h * 128 + tid]), ref, 1.f);
  }
}
struct ChkOp { float r, kd, kk, b, w, v; };
DI ChkOp chk_ops(const u16* PA, const u16* VV, const ScanW& w, size_t row, int h, int dir, int c, LAS float* tmp  , int tid) {
  ChkOp o;
  const int cg_ = h * 64 + c;
  o.r = tshift(PA, row, cg_, w.mu);
  const float k = tshift(PA, row, OFF_K + cg_, w.mu);
  float wl = w.w0[dir * 512 + cg_], al = w.a0[dir * 512 + cg_];
#pragma unroll 1
  for (int rr = 0; rr < 32; ++rr) {
    wl += tanhf(tshift(PA, row, OFF_WD + dir * 32 + rr, w.mu)) * w.du[(dir * 32 + rr) * 512 + cg_];
    al += tshift(PA, row, OFF_AD + dir * 32 + rr, w.mu) * w.iu[(dir * 32 + rr) * 512 + cg_];
  }
  const float sp = logf(1.f + expf(-wl));
  o.w = expf(-expf(-sp - 0.5f));
  const float a = 1.f / (1.f + expf(-al));
  const float kkv = k * w.kk_[cg_];
  __syncthreads(); tmp[tid] = kkv * kkv; __syncthreads();
  float ss = 0.f;
#pragma unroll 1
  for (int j = 0; j < 64; ++j) ss += tmp[j];
  o.kk = kkv * rsqrtf(ss + 1e-12f);
  o.kd = k * (1.f + (a - 1.f) * w.ka[cg_]);
  o.b = o.kk * a;
  o.v = bf2f(VV[row * 512 + cg_]);
  return o;
}
DI void chk_scan(LAS unsigned char* lds, const u16* PA, const u16* VV, const u16* YY, const float* BON, const ScanW w, float* slot) {
  if (blockIdx.x >= 48 || threadIdx.x >= 64) return;
  const int tid = threadIdx.x;
  LAS float* tmp = (LAS float*)lds; LAS float* red = tmp + 64;
  const int item = blockIdx.x * 4 + 1, dir = item & 1, h = (item >> 1) & 7, sq = item >> 4;
  const int t0 = dir == 0 ? 0 : T - 1, t1 = dir == 0 ? 1 : T - 2;
  const size_t row0 = (size_t)sq * T + t0, row1 = (size_t)sq * T + t1;
  const ChkOp a = chk_ops(PA, VV, w, row0, h, dir, tid, tmp, tid);
  const ChkOp b = chk_ops(PA, VV, w, row1, h, dir, tid, tmp, tid);
#define BSUM(dst, val) { __syncthreads(); red[tid] = (val); __syncthreads(); float sx_ = 0.f; _Pragma("unroll 1") for (int j_ = 0; j_ < 64; ++j_) sx_ += red[j_]; dst = sx_; }
  float ds0, ds1, ds2, ds3, ds4;
  BSUM(ds0, a.kd * a.r) BSUM(ds1, a.kd * b.w * b.r) BSUM(ds2, a.kd * (-b.kk)) BSUM(ds3, b.b * b.r) BSUM(ds4, b.kd * b.r)
  const float y0 = a.v * ds0;
  const float y1 = a.v * (ds1 + ds2 * ds3) + b.v * ds4;
  dbg_upd(slot, bf2f(YY[((size_t)dir * NT + row0) * 512 + h * 64 + tid]), y0, fabsf(y0) + 0.05f);
  dbg_upd(slot, bf2f(YY[((size_t)dir * NT + row1) * 512 + h * 64 + tid]), y1, fabsf(y1) + 0.05f);
  float bq = a.r * a.kd * w.rk[h * 64 + tid];
  __syncthreads(); red[tid] = bq; __syncthreads(); float bs = 0.f;
#pragma unroll 1
  for (int j = 0; j < 64; ++j) bs += red[j];
  dbg_upd(slot, BON[((size_t)dir * NT + row0) * 8 + h], bs, fabsf(bs) + 0.05f);
}
DI void chk_post(const u16* PA, const u16* PB, const u16* VV, const u16* YY, const float* BON, const float* mu, const float* gup, const float* gng, const float* gnb, float* slot) {
  const int gt = blockIdx.x * NTHREADS + threadIdx.x;
  if (gt >= 2048) return;
  const size_t row = hashu(gt * 2 + 21) % NT; const int c = hashu(gt * 2 + 22) % 512, h = c >> 6;
  float sm = 0.f;
  float yc = 0.f;
  for (int i = 0; i < 64; ++i) { const float y = bf2f(YY[row * 512 + h * 64 + i]) + bf2f(YY[((size_t)NT + row) * 512 + h * 64 + i]); sm += y; if (h * 64 + i == c) yc = y; }
  const float mean = sm / 64.f; float vq = 0.f;
  for (int i = 0; i < 64; ++i) { const float y = bf2f(YY[row * 512 + h * 64 + i]) + bf2f(YY[((size_t)NT + row) * 512 + h * 64 + i]) - mean; vq += y * y; }
  const float yn = (yc - mean) * rsqrtf(vq / 64.f + GN_EPS) * gng[c] + gnb[c];
  const float bon = (BON[row * 8 + h] + BON[((size_t)NT + row) * 8 + h]) * bf2f(VV[row * 512 + c]);
  float g = 0.f;
  for (int r = 0; r < 96; ++r) g += (1.f / (1.f + expf(-tshift(PA, row, OFF_GD + r, mu)))) * gup[r * 512 + c];
  const float ref = (yn + bon) * g;
  dbg_upd(slot, bf2f(PA[row * A_COLS + c]), ref, fabsf(ref) + 0.05f);
  dbg_upd(slot + 1, bf2f(PA[row * A_COLS + 512 + c]), bf2f(PB[row * 1024 + c]), 1.f);
}

__global__ __launch_bounds__(NTHREADS, 2) void mega(Params p_unused) {
  extern __shared__ __attribute__((aligned(16))) char shm[];
  cg::grid_group grid = cg::this_grid();
  LAS unsigned char* lds = (LAS unsigned char*)shm;
#define WS_PTRS CParams p = get_params(); unsigned char* ws = p->ws; \
  u16* WIN = (u16*)(ws + OFF_WIN); u16* WOUT = (u16*)(ws + OFF_WOUT); u16* WUP = (u16*)(ws + OFF_WUP); u16* WDN = (u16*)(ws + OFF_WDN); \
  u16* XB = (u16*)(ws + OFF_XB); u16* PA = (u16*)(ws + OFF_PA); u16* PB = (u16*)(ws + OFF_PB); u16* VT = (u16*)(ws + OFF_VT); \
  u16* G = (u16*)(ws + OFF_PA); u16* VV = (u16*)(ws + OFF_VV); u16* YY = (u16*)(ws + OFF_XB); float* BON = (float*)(ws + OFF_BON); float* XF = p->out; \
  (void)WIN; (void)WOUT; (void)WUP; (void)WDN; (void)XB; (void)PA; (void)PB; (void)VT; (void)G; (void)VV; (void)YY; (void)BON; (void)XF;
  int ph = 0;
  const int ph_lo = get_params()->ph_lo, ph_hi = get_params()->ph_hi;
#ifndef ONLYMASK
#define ONLYMASK 0xffffffffu
#endif
#define PHASE_BEGIN if (((ONLYMASK >> (__COUNTER__ % 32)) & 1u) && ph >= ph_lo && ph < ph_hi) { WS_PTRS
#define PHASE_END } ++ph; if (ph > ph_lo && ph < ph_hi) grid.sync();

  PHASE_BEGIN
    for (int l = 0; l < 2; ++l) {
      convert_weight<0>(shm, p->in[4] + (size_t)l * D * P_COLS, WIN + (size_t)l * NPROJ * D, D, P_COLS, NPROJ, blockIdx.x, gridDim.x);
      convert_weight<1>(shm, p->in[22] + (size_t)l * D * D, WOUT + (size_t)l * D * D, D, D, D, blockIdx.x, gridDim.x);
      convert_weight<2>(shm, p->in[25] + (size_t)l * D * NUP, WUP + (size_t)l * NUP * D, D, NUP, NUP, blockIdx.x, gridDim.x);
      convert_weight<1>(shm, p->in[28] + (size_t)l * DFF * D, WDN + (size_t)l * D * DFF, DFF, D, D, blockIdx.x, gridDim.x);
    }
    ln_rows(p->in[0], p->in[1], NPROMPT_TOK, XF, XB, p->in[2], p->in[3]);
#if PROBE_MISC
    ln_rows(p->in[0], p->in[1], NPROMPT_TOK, XF, XB, p->in[2], p->in[3]);
#endif
  PHASE_END

#pragma unroll 1
  for (int l = 0; l < 2; ++l) {
    PHASE_BEGIN
      Gemm ga{XB, D, WIN + (size_t)l * NPROJ * D, D};
      EpiArgs ea{}; ea.pa = PA; ea.pb = PB; ea.vt = VT;
      gemm_phase<0, 0>(lds, ga, NT / 256, NPROJ / 256, ea);
#if PROBE_GEMM
      gemm_phase<0, 0>(lds, ga, NT / 256, NPROJ / 256, ea);
#endif
    PHASE_END
    PHASE_BEGIN
      vprep_phase(lds, PA, VV, p->in[5] + (size_t)l * 2 * A_COLS, p->in[16], p->in[17], p->in[18], l);
      attn_phase(lds, PB, VT, (float*)(ws + OFF_OSV), p->in[19] + l * 256, p->in[20] + l * 128, p->in[21], l);
    PHASE_END
    PHASE_BEGIN
      ScanW sw; sw.mu = p->in[5] + (size_t)l * 2 * A_COLS; sw.w0 = p->in[6] + l * 1024; sw.du = p->in[7] + (size_t)l * 2 * 32 * 512; sw.a0 = p->in[8] + l * 1024;
      sw.iu = p->in[9] + (size_t)l * 2 * 32 * 512; sw.kk_ = p->in[11] + l * 512; sw.ka = p->in[12] + l * 512; sw.rk = p->in[13] + l * 512;
      scan_phase(lds, PA, VV, YY, BON, sw);
#if PROBE_SCAN
      scan_phase(lds, PA, VV, YY, BON, sw);
#endif
    PHASE_END
    PHASE_BEGIN
      post_phase(lds, PA, PB, VV, YY, BON, p->in[5] + (size_t)l * 2 * A_COLS, p->in[10] + (size_t)l * 96 * 512, p->in[14] + l * 512, p->in[15] + l * 512);
#if PROBE_MISC
      post_phase(lds, PA, PB, VV, YY, BON, p->in[5] + (size_t)l * 2 * A_COLS, p->in[10] + (size_t)l * 96 * 512, p->in[14] + l * 512, p->in[15] + l * 512);
#endif
    PHASE_END
    PHASE_BEGIN
      Gemm ga{PA, A_COLS, WOUT + (size_t)l * D * D, D};
      EpiArgs ea{}; ea.xf = XF;
      gemm_phase<1, 0>(lds, ga, NT / 256, D / 256, ea);
    PHASE_END
    PHASE_BEGIN
      ln_rows(XF, XF, NT, XF, XB, p->in[23] + l * D, p->in[24] + l * D);
    PHASE_END
    PHASE_BEGIN
      Gemm ga{XB, D, WUP + (size_t)l * NUP * D, D};
      EpiArgs ea{}; ea.g = G; ea.cw = p->in[26] + (size_t)l * 3 * NUP; ea.cb = p->in[27] + (size_t)l * NUP;
      gemm_phase<2, 1>(lds, ga, NSEQ * 33, NUP / 256, ea);
#if PROBE_GEMM
      gemm_phase<2, 1>(lds, ga, NSEQ * 33, NUP / 256, ea);
#endif
    PHASE_END
    PHASE_BEGIN
      Gemm ga{G, DFF, WDN + (size_t)l * D * DFF, DFF};
      EpiArgs ea{}; ea.xf = XF; ea.zero = (DBGZ & 4) ? 1 : 0;
      gemm_phase<1, 0>(lds, ga, NT / 256, D / 256, ea);
    PHASE_END
    PHASE_BEGIN
      ln_rows(XF, XF, NT, XF, XB, p->in[29] + l * D, p->in[30] + l * D);
    PHASE_END
  }
}

#if DBG
#define DPTRS unsigned char* ws = p.ws; u16* XB = (u16*)(ws + OFF_XB); u16* PA = (u16*)(ws + OFF_PA); u16* PB = (u16*)(ws + OFF_PB); u16* VT = (u16*)(ws + OFF_VT); \
  u16* G = (u16*)(ws + OFF_PA); u16* VV = (u16*)(ws + OFF_VV); u16* YY = (u16*)(ws + OFF_XB); float* BON = (float*)(ws + OFF_BON); float* DE = (float*)(ws + OFF_DBG); \
  (void)XB; (void)PA; (void)PB; (void)VT; (void)G; (void)VV; (void)YY; (void)BON; (void)DE;
template <int which> __global__ __launch_bounds__(NTHREADS) void k_chk(Params p, int l) {
  extern __shared__ __attribute__((aligned(16))) char shm[];
  LAS unsigned char* lds = (LAS unsigned char*)shm;
  DPTRS
  if (which == 0) chk_proj(XB, p.in[4] + (size_t)l * D * P_COLS, PA, PB, VT, DE + 0);
  else if (which == 1) chk_attn(lds, XB, p.in[4] + (size_t)l * D * P_COLS, PB, VT, p.in[19] + l * 256, p.in[20] + l * 128, p.in[21], l, DE + 1);
  else if (which == 2) {
    ScanW sw; sw.mu = p.in[5] + (size_t)l * 2 * A_COLS; sw.w0 = p.in[6] + l * 1024; sw.du = p.in[7] + (size_t)l * 2 * 32 * 512; sw.a0 = p.in[8] + l * 1024;
    sw.iu = p.in[9] + (size_t)l * 2 * 32 * 512; sw.kk_ = p.in[11] + l * 512; sw.ka = p.in[12] + l * 512; sw.rk = p.in[13] + l * 512;
    chk_scan(lds, PA, VV, YY, BON, sw, DE + 2);
  } else if (which == 3) chk_post(PA, PB, VV, YY, BON, p.in[5] + (size_t)l * 2 * A_COLS, p.in[10] + (size_t)l * 96 * 512, p.in[14] + l * 512, p.in[15] + l * 512, DE + 3);
  else if (which == 5) chk_ffn(XB, p.in[25] + (size_t)l * D * NUP, p.in[26] + (size_t)l * 3 * NUP, p.in[27] + (size_t)l * NUP, G, DE + 5);
}
__global__ __launch_bounds__(NTHREADS) void k_encode(Params p) {
  const float* e = (const float*)(p.ws + OFF_DBG);
  const float eA = fmaxf(e[DBG_A], 1e-4f), eB = fmaxf(e[DBG_B], 1e-4f);
  const float V1 = 100.f + 100.f * log10f(eA / 1e-3f);
  float V2 = 1.f + log10f(eB / 1e-3f); V2 = fminf(fmaxf(V2, 0.3f), 8.f);
  const size_t n0 = (size_t)NPROMPT_TOK * D, n1 = (size_t)NT * D;
  for (size_t i = (size_t)blockIdx.x * NTHREADS + threadIdx.x; i < n1; i += (size_t)gridDim.x * NTHREADS) {
    float v = 0.f;
    if (i == 0 || i == n0) v = V1;
    else if (i < n0 / 2 || (i > n0 && i < n0 + (n1 - n0) / 2)) v = V2;
    p.out[i] = v;
  }
}
#endif

extern "C" void kernel_launch(void* const* d_in, const int* in_sizes, int n_in, void* d_out, int out_size, void* d_ws, size_t ws_size, hipStream_t stream) {
  static int grid = 0;
  if (grid == 0) {
    if (ws_size < WS_END) { fprintf(stderr, "ws too small: %zu < %zu\n", ws_size, (size_t)WS_END); grid = -1; return; }
    int dev = 0, cus = 0, per_cu = 0;
    hipGetDevice(&dev);
    hipDeviceGetAttribute(&cus, hipDeviceAttributeMultiprocessorCount, dev);
    hipFuncSetAttribute((const void*)mega, hipFuncAttributeMaxDynamicSharedMemorySize, LDS_BYTES);
#if DBG
    hipFuncSetAttribute((const void*)k_chk<1>, hipFuncAttributeMaxDynamicSharedMemorySize, 81920);
    hipFuncSetAttribute((const void*)k_chk<2>, hipFuncAttributeMaxDynamicSharedMemorySize, 81920);
#endif
    hipOccupancyMaxActiveBlocksPerMultiprocessor(&per_cu, (const void*)mega, NTHREADS, LDS_BYTES);
    if (per_cu < 1) per_cu = 1;
    grid = cus * 1;
  }
  if (grid < 0) return;
  Params p{};
  for (int i = 0; i < 31; ++i) p.in[i] = (const float*)d_in[i];
  p.out = (float*)d_out; p.ws = (unsigned char*)d_ws;
#if DBG
  hipMemsetAsync((char*)d_ws + OFF_DBG, 0, 256, stream);
  auto seg = [&](int lo, int hi) { Params q = p; q.ph_lo = lo; q.ph_hi = hi; void* a2[] = {&q};
    hipError_t e = hipLaunchCooperativeKernel((const void*)mega, dim3(grid), dim3(NTHREADS), a2, LDS_BYTES, stream);
    if (e != hipSuccess) fprintf(stderr, "cooperative launch failed: %s\n", hipGetErrorString(e)); };
  auto chk = [&](int l, int which) {
    if (which == 0) hipLaunchKernelGGL(k_chk<0>, dim3(64), dim3(NTHREADS), 81920, stream, p, l);
    if (which == 1) hipLaunchKernelGGL(k_chk<1>, dim3(64), dim3(NTHREADS), 81920, stream, p, l);
    if (which == 2) hipLaunchKernelGGL(k_chk<2>, dim3(64), dim3(NTHREADS), 81920, stream, p, l);
    if (which == 3) hipLaunchKernelGGL(k_chk<3>, dim3(64), dim3(NTHREADS), 81920, stream, p, l);
    if (which == 5) hipLaunchKernelGGL(k_chk<5>, dim3(64), dim3(NTHREADS), 81920, stream, p, l); };
  seg(0, 1);
  for (int l = 0; l < 2; ++l) {
    const int b = 1 + 9 * l;
    seg(b, b + 1); chk(l, 0);
    seg(b + 1, b + 2); chk(l, 1);
    seg(b + 2, b + 3); chk(l, 2);
    seg(b + 3, b + 4); chk(l, 3);
    seg(b + 4, b + 7); if (l == 0) chk(l, 5);
    seg(b + 7, b + 9);
  }
  hipLaunchKernelGGL(k_encode, dim3(1024), dim3(NTHREADS), 0, stream, p);
#else
  p.ph_lo = 0; p.ph_hi = 1000;
  void* args[] = {&p};
  hipError_t e = hipLaunchCooperativeKernel((const void*)mega, dim3(grid), dim3(NTHREADS), args, LDS_BYTES, stream);
  if (e != hipSuccess) fprintf(stderr, "cooperative launch failed: %s (grid %d)\n", hipGetErrorString(e), grid);
#endif
}
```

```cpp
#include <hip/hip_runtime.h>
#include <hip/hip_bf16.h>
#include <hip/hip_cooperative_groups.h>
#include <cstdio>
namespace cg = cooperative_groups;

#define DI __device__ __forceinline__
using bf16 = __hip_bfloat16;
using bf16x8 = __attribute__((ext_vector_type(8))) short;
using s16x4 = __attribute__((ext_vector_type(4))) short;
using f32x4 = __attribute__((ext_vector_type(4))) float;
using f32x16 = __attribute__((ext_vector_type(16))) float;
typedef unsigned short u16;
typedef unsigned u32x4 __attribute__((ext_vector_type(4)));
typedef unsigned u32x2 __attribute__((ext_vector_type(2)));

constexpr int D = 1024, T = 8192, NSEQ = 12, NT = NSEQ * T;
constexpr int NPROMPT_TOK = 4 * T;
constexpr int A_COLS = 1760, P_COLS = 3296, NPROJ = 3328;
constexpr int DFF = 2816, NUP = 5632;
constexpr int OFF_K = 512, OFF_V = 1024, OFF_WD = 1536, OFF_AD = 1600, OFF_GD = 1664;
constexpr float ALPHA = 1.4142135623730951f;
constexpr float LN_EPS = 1e-5f, GN_EPS = 64e-5f;
constexpr int NTHREADS = 512;
#ifndef DBGZ
#define DBGZ 0
#define DBG 0
#define PROBE_SCAN 0
#define PROBE_GEMM 0
#define PROBE_MISC 0
#ifndef CHK_PROJ_ON
#define CHK_PROJ_ON 1
#endif
#ifndef CHK_ATTN_ON
#define CHK_ATTN_ON 1
#endif
#ifndef CHK_SCAN_ON
#define CHK_SCAN_ON 1
#endif
#ifndef CHK_POST_ON
#define CHK_POST_ON 1
#endif
#ifndef CHK_FFN_ON
#define CHK_FFN_ON 1
#endif
#define DBG_A 5
#define DBG_B 6
#define DBGTHR 0.05f, 0.1f, 0.1f, 0.1f, 0.01f, 0.05f
#endif
constexpr int LDS_BYTES = 163840;

constexpr size_t SZ_WIN = (size_t)2 * NPROJ * D * 2;
constexpr size_t SZ_WOUT = (size_t)2 * D * D * 2;
constexpr size_t SZ_WUP = (size_t)2 * NUP * D * 2;
constexpr size_t SZ_WDN = (size_t)2 * D * DFF * 2;
constexpr size_t OFF_WIN = 0;
constexpr size_t OFF_WOUT = OFF_WIN + SZ_WIN;
constexpr size_t OFF_WUP = OFF_WOUT + SZ_WOUT;
constexpr size_t OFF_WDN = OFF_WUP + SZ_WUP;
constexpr size_t OFF_XB = OFF_WDN + SZ_WDN;
constexpr size_t OFF_PA = OFF_XB + (size_t)NT * D * 2;
constexpr size_t OFF_PB = OFF_PA + (size_t)NT * A_COLS * 2;
constexpr size_t OFF_VT = OFF_PB + (size_t)NT * 1024 * 2;
constexpr size_t OFF_VV = OFF_VT + (size_t)NT * 512 * 2;
constexpr size_t OFF_BON = OFF_VV + (size_t)NT * 512 * 2;
constexpr size_t OFF_OSV = OFF_BON + (size_t)2 * NT * 8 * 4;
constexpr size_t OFF_DBG = OFF_OSV + (size_t)256 * 64 * 512 * 4;
constexpr size_t WS_END = OFF_DBG + 256;
static_assert((size_t)NT * DFF * 2 <= (OFF_VV - OFF_PA), "G alias");

struct Params {
  const float* in[31];
  float* out;
  unsigned char* ws;
  int ph_lo, ph_hi;
};

typedef const __attribute__((address_space(4))) Params* CParams;
DI CParams get_params() { CParams pp = (CParams)__builtin_amdgcn_kernarg_segment_ptr(); asm volatile("" : "+s"(pp)); return pp; }

DI u16 f2bf(float x) { unsigned u = __float_as_uint(x); u += 0x7fffu + ((u >> 16) & 1u); return (u16)(u >> 16); }
DI float bf2f(u16 b) { return __uint_as_float(((unsigned)b) << 16); }
DI float sigmoidf_(float x) { return 1.f / (1.f + __expf(-x)); }

template <int MODE> DI int src_col(int n) {
  if (MODE == 0) { return n < A_COLS ? n : (n < 1792 ? -1 : n - 32); }
  if (MODE == 2) { int j = n >> 8, i = n & 255; return i < 128 ? j * 128 + i : DFF + j * 128 + (i - 128); }
  return n;
}
template <int MODE>
DI void convert_weight(char* shm, const float* W, u16* WT, int K, int Nsrc, int Ndst, int gtid_block, int nblocks) {
  float* tile = (float*)shm;
  int tn = Ndst / 64, tk = K / 64;
  for (int t = gtid_block; t < tn * tk; t += nblocks) {
    int n0 = (t / tk) * 64, k0 = (t % tk) * 64;
    __syncthreads();
    for (int e = threadIdx.x; e < 4096; e += NTHREADS) {
      int kk = e >> 6, nn = e & 63;
      int sc = src_col<MODE>(n0 + nn);
      tile[kk * 65 + nn] = sc >= 0 ? W[(size_t)(k0 + kk) * Nsrc + sc] : 0.f;
    }
    __syncthreads();
    for (int e = threadIdx.x; e < 4096; e += NTHREADS) {
      int nn = e >> 6, kk = e & 63;
      WT[(size_t)(n0 + nn) * K + k0 + kk] = f2bf(tile[kk * 65 + nn]);
    }
  }
}

DI void ln_rows(const float* srcA, const float* srcB, int splitRow, float* dstF, u16* dstB, const float* g, const float* b) {
  int tid = threadIdx.x; asm volatile("" : "+v"(tid));
  int bid = blockIdx.x, gdim = gridDim.x; asm volatile("" : "+s"(bid), "+s"(gdim));
  int wave = tid >> 6, lane = tid & 63;
  int gw = bid * 8 + wave, nw = gdim * 8;
  float4 gg[4], bb[4];
  for (int i = 0; i < 4; ++i) { gg[i] = *(const float4*)(g + i * 256 + lane * 4); bb[i] = *(const float4*)(b + i * 256 + lane * 4); }
  for (int row = gw; row < NT; row += nw) {
    const float* src = row < splitRow ? srcA + (size_t)row * D : srcB + (size_t)(row - splitRow) * D;
    float4 v[4]; float s = 0.f;
    for (int i = 0; i < 4; ++i) { v[i] = *(const float4*)(src + i * 256 + lane * 4); s += v[i].x + v[i].y + v[i].z + v[i].w; }
    for (int o = 32; o > 0; o >>= 1) s += __shfl_xor(s, o);
    float mu = s * (1.f / D), q = 0.f;
    for (int i = 0; i < 4; ++i) { v[i].x -= mu; v[i].y -= mu; v[i].z -= mu; v[i].w -= mu; q += v[i].x * v[i].x + v[i].y * v[i].y + v[i].z * v[i].z + v[i].w * v[i].w; }
    for (int o = 32; o > 0; o >>= 1) q += __shfl_xor(q, o);
    float rs = rsqrtf(q * (1.f / D) + LN_EPS);
    for (int i = 0; i < 4; ++i) {
      float4 o4; o4.x = v[i].x * rs * gg[i].x + bb[i].x; o4.y = v[i].y * rs * gg[i].y + bb[i].y; o4.z = v[i].z * rs * gg[i].z + bb[i].z; o4.w = v[i].w * rs * gg[i].w + bb[i].w;
      *(float4*)(dstF + (size_t)row * D + i * 256 + lane * 4) = o4;
      ushort4 h; h.x = f2bf(o4.x); h.y = f2bf(o4.y); h.z = f2bf(o4.z); h.w = f2bf(o4.w);
      *(ushort4*)(dstB + (size_t)row * D + i * 256 + lane * 4) = h;
    }
  }
}

#define LAS __attribute__((address_space(3)))
constexpr int BK = 64, HALF = 128, HTB = HALF * BK * 2, STAGE_BYTES = 8 * HTB;
DI int lds_byte(int r, int c) { const int st = (r >> 4) * 2 + (c >> 5), rr = r & 15, cc = c & 31, ob = rr * 64 + cc * 2; return st * 1024 + (ob ^ (((ob >> 9) & 1) << 5)); }
DI void stage_rc(int b, int& R, int& C) { const int st = b / 1024, sb = b % 1024, swz = sb ^ (((sb >> 9) & 1) << 5); R = (st >> 1) * 16 + swz / 64; C = (st & 1) * 32 + (swz % 64) / 2; }
DI int perm32(int rho) { const int n = rho >> 4, i = rho & 15; return 8 * (i >> 2) + 4 * n + (i & 3); }
DI unsigned cvt_pk_bf16(float lo, float hi) { unsigned r; asm volatile("v_cvt_pk_bf16_f32 %0, %1, %2" : "=v"(r) : "v"(lo), "v"(hi)); return r; }

typedef float f32x2 __attribute__((ext_vector_type(2)));
DI float gelu1(float v) {
  const float av = __builtin_fabsf(v), d = av * 0.2316418882f + 1.0f;
  const float t = __builtin_amdgcn_rcpf(d);
  float q = t * 0.5307027145f + (-0.7265760135f); q = q * t + 0.7107068705f; q = q * t + (-0.142248368f); q = q * t + 0.127414796f; q = q * t;
  const float e = __builtin_amdgcn_exp2f((v * v) * (-0.72134752044f));
  const float m = v * (q * e), r = v - m;
  return v < 0.f ? m : r;
}
DI float dpp_shr1(float old, float src) { asm volatile("s_nop 1\n\tv_mov_b32_dpp %0, %1 row_shr:1 row_mask:0xf bank_mask:0xf\n\ts_nop 0" : "+v"(old) : "v"(src)); return old; }
DI float dpp_shl1(float old, float src) { asm volatile("s_nop 1\n\tv_mov_b32_dpp %0, %1 row_shl:1 row_mask:0xf bank_mask:0xf\n\ts_nop 0" : "+v"(old) : "v"(src)); return old; }
struct Unit { int pm, pn; };
struct Order {
  int nM, nN, nwg, G, c;
  DI void init(int nM_, int nN_, int G_, int c_) { nM = nM_; nN = nN_; nwg = nM * nN; G = G_; c = c_; }
  DI bool next(int i, Unit& u) const {
    const long Lq = (long)i * G + c; if (Lq >= nwg) return false;
    int wgid = (int)Lq; { const int q = nwg / 8, r = nwg % 8, xcd = wgid % 8, off = wgid / 8; wgid = (xcd < r ? xcd * (q + 1) : r * (q + 1) + (xcd - r) * q) + off; }
    const int nig = 8 * nN, gid = wgid / nig, fm = gid * 8, gsz = (nM - fm) < 8 ? (nM - fm) : 8;
    u.pm = fm + ((wgid % nig) % gsz); u.pn = (wgid % nig) / gsz; return true;
  }
};
struct Gemm { const u16* A; int lda; const u16* Bt; int K; };
template <int ROWMODE> DI const char* a_tile_ptr(const Gemm& g, int pm) {
  long row = ROWMODE == 0 ? (long)pm * 256 : (long)(pm / 33) * T + 254 * (pm % 33) - 1;
  return (const char*)g.A + row * g.lda * 2;
}
struct EpiArgs {
  u16* pa; u16* pb; u16* vt;
  float* xf;
  u16* g; const float* cw; const float* cb;
  int zero;
};
template <int EPI>
DI void epilogue(f32x4 (&acc)[2][2][4][2], const Unit& u, const EpiArgs& ea, LAS unsigned char* lds) {
  int tid2 = threadIdx.x; asm volatile("" : "+v"(tid2));
  const int wid2 = tid2 >> 6, lane2 = tid2 & 63, wr = wid2 >> 2, wc = wid2 & 3, fr = lane2 & 15, fq = lane2 >> 4;
  if (EPI == 0) {
    const int row0 = u.pm * 256 + wr * 64 + fr;
#pragma unroll
    for (int ai = 0; ai < 2; ++ai)
#pragma unroll
      for (int m = 0; m < 4; ++m) {
        const int row = row0 + ai * HALF + m * 16;
#pragma unroll
        for (int bj = 0; bj < 2; ++bj) {
          const int col = u.pn * 256 + bj * HALF + wc * 32 + 8 * fq;
          const f32x4 a0 = acc[ai][bj][m][0], a1 = acc[ai][bj][m][1];
          if (u.pn <= 10) {
            uint4 pk; pk.x = cvt_pk_bf16(a0[0], a0[1]); pk.y = cvt_pk_bf16(a0[2], a0[3]); pk.z = cvt_pk_bf16(a1[0], a1[1]); pk.w = cvt_pk_bf16(a1[2], a1[3]);
            if (u.pn <= 6) { if (col < A_COLS) *(uint4*)(ea.pa + (size_t)row * A_COLS + col) = pk; }
            else *(uint4*)(ea.pb + (size_t)row * 1024 + (col - 1792)) = pk;
          } else {
            const int c2 = col - 2816, h = c2 >> 7, e = c2 & 127, seq = row / T, t = row % T;
            u16* dst = ea.vt + ((size_t)((seq * 4 + h) * 128 + e)) * T + t;
#pragma unroll
            for (int j = 0; j < 4; ++j) { dst[(size_t)j * T] = f2bf(a0[j]); dst[(size_t)(4 + j) * T] = f2bf(a1[j]); }
          }
        }
      }
  } else if (EPI == 1) {
    const int row0 = u.pm * 256 + wr * 64 + fr, col0 = u.pn * 256 + wc * 32 + 4 * fq;
#pragma unroll
    for (int ai = 0; ai < 2; ++ai)
#pragma unroll
      for (int m = 0; m < 4; ++m) {
        float* rowp = ea.xf + (size_t)(row0 + ai * HALF + m * 16) * D + col0;
#pragma unroll
        for (int bj = 0; bj < 2; ++bj)
#pragma unroll
          for (int n = 0; n < 2; ++n) { f32x4* p4 = (f32x4*)(rowp + bj * HALF + n * 16); f32x4 x = *p4; *p4 = ea.zero ? x * ALPHA : x * ALPHA + acc[ai][bj][m][n]; }
      }
  } else {
    LAS float* E = (LAS float*)(lds + STAGE_BYTES);
    const int seq = u.pm / 33, ti = u.pm % 33;
    const int cl0 = wc * 32 + 8 * fq;
#pragma unroll
    for (int ai = 0; ai < 2; ++ai)
#pragma unroll
      for (int m = 0; m < 4; ++m) {
        const int rl = ai * HALF + wr * 64 + m * 16 + fr;
        const int tok = 254 * ti - 1 + rl;
        const bool valid = tok >= 0 && tok < T;
        const int blk = ai * 8 + wr * 4 + m;
#pragma unroll
        for (int bj = 0; bj < 2; ++bj)
#pragma unroll
          for (int n = 0; n < 2; ++n) {
            if (!valid) acc[ai][bj][m][n] = (f32x4){0.f, 0.f, 0.f, 0.f};
            if (fr == 0) *(LAS f32x4*)(E + ((blk * 2 + 0) * 2 + bj) * 128 + cl0 + 4 * n) = acc[ai][bj][m][n];
            if (fr == 15) *(LAS f32x4*)(E + ((blk * 2 + 1) * 2 + bj) * 128 + cl0 + 4 * n) = acc[ai][bj][m][n];
          }
      }
    asm volatile("s_waitcnt lgkmcnt(0)" ::: "memory");
    __builtin_amdgcn_s_barrier(); asm volatile("" ::: "memory");
    __builtin_amdgcn_s_barrier(); asm volatile("" ::: "memory");
#pragma unroll
    for (int n = 0; n < 2; ++n) {
      const int hid = u.pn * 128 + cl0 + 4 * n;
      const float* cwp = ea.cw + hid;
      const f32x4 g0 = *(const f32x4*)(cwp), g1 = *(const f32x4*)(cwp + NUP), g2 = *(const f32x4*)(cwp + 2 * NUP), gb = *(const f32x4*)(ea.cb + hid);
      const f32x4 u0 = *(const f32x4*)(cwp + DFF), u1 = *(const f32x4*)(cwp + DFF + NUP), u2 = *(const f32x4*)(cwp + DFF + 2 * NUP), ub = *(const f32x4*)(ea.cb + DFF + hid);
#pragma unroll
      for (int ai = 0; ai < 2; ++ai)
#pragma unroll
        for (int m = 0; m < 4; ++m) {
          const int blk = ai * 8 + wr * 4 + m;
          const int rl = ai * HALF + wr * 64 + m * 16 + fr;
          const int tok = 254 * ti - 1 + rl;
          f32x4 hh[2];
#pragma unroll
          for (int bj = 0; bj < 2; ++bj) {
            const f32x4 cur = acc[ai][bj][m][n];
            f32x4 ab = (f32x4){0.f, 0.f, 0.f, 0.f}, be = (f32x4){0.f, 0.f, 0.f, 0.f};
            if (fr == 0 && blk > 0) ab = *(LAS f32x4*)(E + (((blk - 1) * 2 + 1) * 2 + bj) * 128 + cl0 + 4 * n);
            if (fr == 15 && blk < 15) be = *(LAS f32x4*)(E + (((blk + 1) * 2 + 0) * 2 + bj) * 128 + cl0 + 4 * n);
            f32x4 prev, next;
#pragma unroll
            for (int j = 0; j < 4; ++j) { prev[j] = dpp_shr1(ab[j], cur[j]); next[j] = dpp_shl1(be[j], cur[j]); }
            hh[bj] = bj == 0 ? g0 * prev + g1 * cur + g2 * next + gb : u0 * prev + u1 * cur + u2 * next + ub;
          }
          f32x4 res;
#pragma unroll
          for (int j = 0; j < 4; ++j) res[j] = gelu1(hh[0][j]) * hh[1][j];
          if (rl >= 1 && rl <= 254 && tok < T) {
            u32x2 pk; pk.x = cvt_pk_bf16(res[0], res[1]); pk.y = cvt_pk_bf16(res[2], res[3]);
            *(u32x2*)(ea.g + (size_t)(seq * T + tok) * DFF + hid) = pk;
          }
        }
    }
  }
}

template <int EPI, int ROWMODE>
DI void gemm_phase(LAS unsigned char* lds, const Gemm g, int nM, int nN, const EpiArgs& ea) {
  constexpr bool PERM = (EPI != 1);
  int tid = threadIdx.x; asm volatile("" : "+v"(tid));
  int bid = blockIdx.x, gdim = gridDim.x; asm volatile("" : "+s"(bid), "+s"(gdim));
  const int wid = __builtin_amdgcn_readfirstlane(tid >> 6), lane = tid & 63, wr = wid >> 2, wc = wid & 3, fr = lane & 15, fq = lane >> 4;
  const int K = g.K, nt = K / BK;
  Order S; S.init(nM, nN, gdim, bid);
  unsigned voffA[2], voffB[2];
#pragma unroll
  for (int i = 0; i < 2; ++i) { int R, C; stage_rc(tid * 16 + i * 8192, R, C); const int Rb = PERM ? ((R & ~31) + perm32(R & 31)) : R;
    voffA[i] = (unsigned)(R * g.lda + C) * 2u; voffB[i] = (unsigned)(Rb * K + C) * 2u; }
  const size_t kstep = (size_t)(BK * 2);
  const size_t hstepA = (size_t)HALF * g.lda * 2, hstepB = (size_t)HALF * K * 2;
  const unsigned ldsw = (unsigned)wid * 1024u;
  const int aoff = lds_byte(wr * 64 + fr, fq * 8), boff = lds_byte(wc * 32 + fr, fq * 8);
#define PG8_SA(b, h) (((b) * 2 + (h)) * HTB)
#define PG8_SB(b, h) ((4 + (b) * 2 + (h)) * HTB)
#define PG8_STAGE(bufoff, gbase, voff) do { _Pragma("unroll") for (int _i = 0; _i < 2; ++_i) \
    __builtin_amdgcn_global_load_lds((const unsigned*)((const char*)(gbase) + (voff)[_i]), (LAS unsigned*)(lds + (bufoff) + ldsw + _i * 8192), 16, 0, 0); } while (0)
#define PG8_LDA(dst, b, h) do { _Pragma("unroll") for (int m = 0; m < 4; ++m) _Pragma("unroll") for (int k = 0; k < 2; ++k) dst[m][k] = *(const LAS bf16x8*)(lds + PG8_SA(b, h) + aoff + m * 2048 + k * 1024); } while (0)
#define PG8_LDB(dst, b, h) do { _Pragma("unroll") for (int n = 0; n < 2; ++n) _Pragma("unroll") for (int k = 0; k < 2; ++k) dst[n][k] = *(const LAS bf16x8*)(lds + PG8_SB(b, h) + boff + n * 2048 + k * 1024); } while (0)
#define PG8_MMA(ai, bj, At, Bq) do { __builtin_amdgcn_s_setprio(1); _Pragma("unroll") for (int m = 0; m < 4; ++m) _Pragma("unroll") for (int n = 0; n < 2; ++n) _Pragma("unroll") for (int k = 0; k < 2; ++k) \
    acc[ai][bj][m][n] = __builtin_amdgcn_mfma_f32_16x16x32_bf16(Bq[n][k], At[m][k], acc[ai][bj][m][n], 0, 0, 0); __builtin_amdgcn_s_setprio(0); } while (0)
#define PG8_WAIT_V(n) asm volatile("s_waitcnt vmcnt(" #n ")" ::: "memory")
#define PG8_WAIT_L(n) asm volatile("s_waitcnt lgkmcnt(" #n ")" ::: "memory")
#define PG8_BAR __builtin_amdgcn_s_barrier()
#define PG8_SCHED __builtin_amdgcn_sched_barrier(0)
  Unit cur, nxt; int ui = 0;
  __syncthreads();
  if (!S.next(0, cur)) return;
  f32x4 acc[2][2][4][2];
#pragma unroll
  for (int a = 0; a < 2; ++a)
#pragma unroll
    for (int b = 0; b < 2; ++b)
#pragma unroll
      for (int m = 0; m < 4; ++m)
#pragma unroll
        for (int n = 0; n < 2; ++n) acc[a][b][m][n] = (f32x4){0.f, 0.f, 0.f, 0.f};
  bf16x8 At[4][2], B0[2][2], B1[2][2];
  const char* cA = a_tile_ptr<ROWMODE>(g, cur.pm); const char* cB = (const char*)g.Bt + (size_t)cur.pn * 2 * hstepB;
  PG8_STAGE(PG8_SB(0, 0), cB, voffB); PG8_STAGE(PG8_SA(0, 0), cA, voffA); PG8_STAGE(PG8_SB(0, 1), cB + hstepB, voffB); PG8_STAGE(PG8_SA(0, 1), cA + hstepA, voffA);
  if (wr == 1) PG8_BAR;
  PG8_WAIT_V(4); PG8_BAR;
  PG8_STAGE(PG8_SB(1, 0), cB + kstep, voffB); PG8_STAGE(PG8_SA(1, 0), cA + kstep, voffA); PG8_STAGE(PG8_SB(1, 1), cB + hstepB + kstep, voffB);
  PG8_WAIT_V(6); PG8_BAR;
  for (;;) {
    const bool has_next = S.next(ui + 1, nxt);
    const char* nA = has_next ? a_tile_ptr<ROWMODE>(g, nxt.pm) : cA; const char* nB = has_next ? (const char*)g.Bt + (size_t)nxt.pn * 2 * hstepB : cB;
    for (int t = 0; t < nt; t += 2) {
      const bool last = (t == nt - 2);
      const char* a1 = cA + (size_t)(t + 1) * kstep;
      const char* a2 = last ? nA : cA + (size_t)(t + 2) * kstep; const char* b2 = last ? nB : cB + (size_t)(t + 2) * kstep;
      const char* a3 = a2 + kstep; const char* b3 = b2 + kstep;
      PG8_LDB(B0, 0, 0); PG8_SCHED; PG8_LDA(At, 0, 0); PG8_STAGE(PG8_SA(1, 1), a1 + hstepA, voffA);
      PG8_WAIT_L(8); PG8_BAR; PG8_WAIT_L(0); PG8_MMA(0, 0, At, B0); PG8_BAR; PG8_SCHED;
      PG8_LDB(B1, 0, 1); PG8_STAGE(PG8_SB(0, 0), b2, voffB);
      PG8_BAR; PG8_WAIT_L(0); PG8_MMA(0, 1, At, B1); PG8_BAR;
      PG8_LDA(At, 0, 1); PG8_STAGE(PG8_SA(0, 0), a2, voffA);
      PG8_BAR; PG8_WAIT_L(0); PG8_MMA(1, 0, At, B0); PG8_BAR; PG8_SCHED;
      PG8_STAGE(PG8_SB(0, 1), b2 + hstepB, voffB);
      PG8_WAIT_V(6); PG8_BAR; PG8_MMA(1, 1, At, B1); PG8_BAR;
      PG8_LDB(B0, 1, 0); PG8_SCHED; PG8_LDA(At, 1, 0); PG8_STAGE(PG8_SA(0, 1), a2 + hstepA, voffA);
      PG8_WAIT_L(8); PG8_BAR; PG8_WAIT_L(0); PG8_MMA(0, 0, At, B0); PG8_BAR; PG8_SCHED;
      PG8_LDB(B1, 1, 1); PG8_STAGE(PG8_SB(1, 0), b3, voffB);
      PG8_BAR; PG8_WAIT_L(0); PG8_MMA(0, 1, At, B1); PG8_BAR;
      PG8_LDA(At, 1, 1); PG8_STAGE(PG8_SA(1, 0), a3, voffA);
      PG8_BAR; PG8_WAIT_L(0); PG8_MMA(1, 0, At, B0); PG8_BAR; PG8_SCHED;
      PG8_STAGE(PG8_SB(1, 1), b3 + hstepB, voffB);
      PG8_WAIT_V(6); PG8_BAR; PG8_MMA(1, 1, At, B1); PG8_BAR;
    }
    epilogue<EPI>(acc, cur, ea, lds);
    if (!has_next) break;
#pragma unroll
    for (int a = 0; a < 2; ++a)
#pragma unroll
      for (int b = 0; b < 2; ++b)
#pragma unroll
        for (int m = 0; m < 4; ++m)
#pragma unroll
          for (int n = 0; n < 2; ++n) acc[a][b][m][n] = (f32x4){0.f, 0.f, 0.f, 0.f};
    cur = nxt; cA = nA; cB = nB; ++ui;
  }
  PG8_WAIT_V(0);
  if (wr == 0) PG8_BAR;
  PG8_BAR;
#undef PG8_SA
#undef PG8_SB
}

constexpr int KROW = 144, VROW = 144;
constexpr int KBUF = 64 * KROW, VBUF = 128 * VROW, ABUF = KBUF + VBUF;
constexpr float LOG2E = 1.4426950408889634f;
DI bf16x8 pack8(const f32x16& x, int s) {
  u32x4 p; p.x = cvt_pk_bf16(x[8 * s], x[8 * s + 1]); p.y = cvt_pk_bf16(x[8 * s + 2], x[8 * s + 3]); p.z = cvt_pk_bf16(x[8 * s + 4], x[8 * s + 5]); p.w = cvt_pk_bf16(x[8 * s + 6], x[8 * s + 7]);
  return __builtin_bit_cast(bf16x8, p);
}
DI void attn_phase(LAS unsigned char* lds, u16* PB, const u16* VT, float* OSV, const float* lamp, const float* subg, const float* relb, int layer, int pair_lo, int pair_hi, int wg_lo, int wg_cnt) {
  int tid = threadIdx.x; asm volatile("" : "+v"(tid));
  int bid = blockIdx.x, gdim = gridDim.x; asm volatile("" : "+s"(bid), "+s"(gdim));
  const int wid = tid >> 6, lane = tid & 63, qi = lane & 31, g = lane >> 5;
  LAS float* tab = (LAS float*)(lds + 2 * ABUF);
  LAS float* scal = tab + 264;
  const float lam_init = 0.8f - 0.6f * __expf(-0.3f * (float)layer);
  __syncthreads();
  if (wid == 0) {
    float a = lamp[lane] * lamp[64 + lane], b = lamp[128 + lane] * lamp[192 + lane];
    for (int o = 32; o > 0; o >>= 1) { a += __shfl_xor(a, o); b += __shfl_xor(b, o); }
    if (lane == 0) scal[0] = __expf(a) - __expf(b) + lam_init;
  }
  const int m_sw = (qi & 0x13) | ((qi & 4) << 1) | ((qi & 8) >> 1);
  if (bid < wg_lo || bid >= wg_lo + wg_cnt) return;
  const int xcd = bid & 7, jq = (bid - wg_lo) >> 3;
  const int per_x = wg_cnt >> 3;
  const float c1 = 0.125f * LOG2E;
  for (int pr = pair_lo + xcd; pr < pair_hi; pr += 8) {
    const int s = pr >> 2, h = pr & 3;
    for (int qb = jq; qb < 32; qb += per_x) {
      __syncthreads();
      for (int i = tid; i < 257; i += NTHREADS) {
        const int rel = i - 128, n = rel < 0 ? -rel : rel;
        int bk = n < 8 ? n : (n <= 11 ? 8 : (n <= 15 ? 9 : (n <= 22 ? 10 : (n <= 31 ? 11 : (n <= 45 ? 12 : (n <= 63 ? 13 : (n <= 90 ? 14 : 15)))))));
        if (rel > 0) bk += 16;
        tab[i] = relb[bk * 4 + h] * LOG2E;
      }
      const int q0 = qb * 256 + wid * 32;
      const size_t tokbase = (size_t)s * T;
      float* osv = OSV + ((size_t)bid * 512 + tid) * 64;
#pragma unroll 1
      for (int c = 0; c < 2; ++c) {
        bf16x8 Q[4];
        { const u16* qp = PB + (tokbase + q0 + qi) * 1024 + h * 128 + c * 64 + g * 8;
#pragma unroll
          for (int ks = 0; ks < 4; ++ks) Q[ks] = *(const bf16x8*)(qp + ks * 16); }
        f32x16 O[4];
#pragma unroll
        for (int eb = 0; eb < 4; ++eb)
#pragma unroll
          for (int i = 0; i < 16; ++i) O[eb][i] = 0.f;
        float mrun = -1e30f, lrun = 0.f;
        const u16* kg = PB + (tokbase + (tid >> 3)) * 1024 + 512 + h * 128 + c * 64 + (tid & 7) * 8;
        const u16* vg = VT + ((size_t)((s * 4 + h) * 128 + (tid >> 2))) * T + (tid & 3) * 16;
        const unsigned kl = (tid >> 3) * KROW + (tid & 7) * 16, vl = KBUF + (tid >> 2) * VROW + (tid & 3) * 32;
        u32x4 rk0, rv0, rv1;
        rk0 = *(const u32x4*)(kg); rv0 = *(const u32x4*)(vg); rv1 = *(const u32x4*)(vg + 8);
        __syncthreads();
        *(LAS u32x4*)(lds + kl) = rk0; *(LAS u32x4*)(lds + vl) = rv0; *(LAS u32x4*)(lds + vl + 16) = rv1;
        __syncthreads();
        auto compute_tile = [&](const int kt, LAS unsigned char* buf) {
          const int kmin = kt * 64;
          const int dlo = kmin + 63 - q0, dhi = kmin - (q0 + 31);
          const int bmode = dlo <= -91 ? 0 : (dhi >= 91 ? 1 : 2);
          const float bconst = bmode == 0 ? tab[0] : tab[256];
          f32x16 S[2];
          {
            bf16x8 kf[2][4];
#pragma unroll
            for (int kb = 0; kb < 2; ++kb)
#pragma unroll
              for (int ks = 0; ks < 4; ++ks) kf[kb][ks] = *(const LAS bf16x8*)(buf + (kb * 32 + m_sw) * KROW + (ks * 16 + g * 8) * 2);
            __builtin_amdgcn_sched_barrier(0);
#pragma unroll
            for (int kb = 0; kb < 2; ++kb) {
#pragma unroll
              for (int i = 0; i < 16; ++i) S[kb][i] = 0.f;
#pragma unroll
              for (int ks = 0; ks < 4; ++ks) S[kb] = __builtin_amdgcn_mfma_f32_32x32x16_bf16(kf[kb][ks], Q[ks], S[kb], 0, 0, 0);
            }
          }
          bf16x8 vf[2][4];
          float sc = c1, off = bconst;
          if (bmode == 2) {
#pragma unroll
            for (int kb = 0; kb < 2; ++kb)
#pragma unroll
              for (int r = 0; r < 16; ++r) {
                int rel = kmin + kb * 32 + 16 * (r >> 3) + 8 * g + (r & 7) - (q0 + qi);
                rel = rel < -128 ? -128 : (rel > 128 ? 128 : rel);
                S[kb][r] = S[kb][r] * c1 + tab[rel + 128];
              }
            sc = 1.f; off = 0.f;
          }
          float mx = -3e38f;
#pragma unroll
          for (int kb = 0; kb < 2; ++kb)
#pragma unroll
            for (int r = 0; r < 16; ++r) mx = fmaxf(mx, S[kb][r]);
          mx = fmaxf(mx, __shfl_xor(mx, 32));
          mx = mx * sc + off;
          if (__any(mx > mrun + 8.f)) {
            const float mnew = mx > mrun + 8.f ? mx : mrun;
            const float alpha = __builtin_amdgcn_exp2f(mrun - mnew);
            mrun = mnew; lrun *= alpha;
#pragma unroll
            for (int eb = 0; eb < 4; ++eb)
#pragma unroll
              for (int i = 0; i < 16; ++i) O[eb][i] *= alpha;
          }
          const float sh = off - mrun;
          float psum = 0.f;
#pragma unroll
          for (int kb = 0; kb < 2; ++kb)
#pragma unroll
            for (int r = 0; r < 16; ++r) { const float pv = __builtin_amdgcn_exp2f(S[kb][r] * sc + sh); S[kb][r] = pv; psum += pv; }
          lrun += psum;
          __builtin_amdgcn_sched_barrier(0);
#pragma unroll
          for (int eb = 0; eb < 4; ++eb) vf[0][eb] = *(const LAS bf16x8*)(buf + KBUF + (eb * 32 + qi) * VROW + (g * 8) * 2);
#pragma unroll
          for (int stp = 0; stp < 4; ++stp) {
            const int kb = stp >> 1, hh = stp & 1;
            if (stp < 3) {
#pragma unroll
              for (int eb = 0; eb < 4; ++eb) vf[(stp + 1) & 1][eb] = *(const LAS bf16x8*)(buf + KBUF + (eb * 32 + qi) * VROW + ((stp + 1) * 16 + g * 8) * 2);
            }
            const bf16x8 pb = pack8(S[kb], hh);
#pragma unroll
            for (int eb = 0; eb < 4; ++eb) O[eb] = __builtin_amdgcn_mfma_f32_32x32x16_bf16(vf[stp & 1][eb], pb, O[eb], 0, 0, 0);
          }
        };
        u32x4 rkB, rvB0, rvB1;
        { const u16* kg2 = kg + (size_t)1 * 64 * 1024; const u16* vg2 = vg + 64;
          rk0 = *(const u32x4*)(kg2); rv0 = *(const u32x4*)(vg2); rv1 = *(const u32x4*)(vg2 + 8);
          const u16* kg3 = kg + (size_t)2 * 64 * 1024; const u16* vg3 = vg + 128;
          rkB = *(const u32x4*)(kg3); rvB0 = *(const u32x4*)(vg3); rvB1 = *(const u32x4*)(vg3 + 8); }
#pragma unroll 1
        for (int kt = 0; kt < 128; kt += 2) {
          LAS unsigned char* buf0 = lds; LAS unsigned char* buf1 = lds + ABUF;
          compute_tile(kt, buf0);
          *(LAS u32x4*)(buf1 + kl) = rk0; *(LAS u32x4*)(buf1 + vl) = rv0; *(LAS u32x4*)(buf1 + vl + 16) = rv1;
          { const int tn = kt + 3 < 128 ? kt + 3 : 127; const u16* kg2 = kg + (size_t)tn * 64 * 1024; const u16* vg2 = vg + tn * 64;
            rk0 = *(const u32x4*)(kg2); rv0 = *(const u32x4*)(vg2); rv1 = *(const u32x4*)(vg2 + 8); }
          __syncthreads();
          compute_tile(kt + 1, buf1);
          *(LAS u32x4*)(buf0 + kl) = rkB; *(LAS u32x4*)(buf0 + vl) = rvB0; *(LAS u32x4*)(buf0 + vl + 16) = rvB1;
          { const int tn = kt + 4 < 128 ? kt + 4 : 127; const u16* kg2 = kg + (size_t)tn * 64 * 1024; const u16* vg2 = vg + tn * 64;
            rkB = *(const u32x4*)(kg2); rvB0 = *(const u32x4*)(vg2); rvB1 = *(const u32x4*)(vg2 + 8); }
          __syncthreads();
        }
        const float lt = lrun + __shfl_xor(lrun, 32);
        asm volatile("" : "+v"(osv));
        if (c == 0) {
          const float i0 = 1.f / lt;
#pragma unroll
          for (int eb = 0; eb < 4; ++eb)
#pragma unroll
            for (int i = 0; i < 16; i += 4) { f32x4 t4; t4[0] = O[eb][i] * i0; t4[1] = O[eb][i + 1] * i0; t4[2] = O[eb][i + 2] * i0; t4[3] = O[eb][i + 3] * i0; *(f32x4*)(osv + eb * 16 + i) = t4; }
        } else {
          const float i1 = scal[0] / lt;
          float ss = 0.f;
#pragma unroll
          for (int eb = 0; eb < 4; ++eb)
#pragma unroll
            for (int i = 0; i < 16; i += 4) { const f32x4 t4 = *(const f32x4*)(osv + eb * 16 + i);
#pragma unroll
              for (int j = 0; j < 4; ++j) { const float o = t4[j] - O[eb][i + j] * i1; O[eb][i + j] = o; ss += o * o; } }
          ss += __shfl_xor(ss, 32);
          const float rs = rsqrtf(ss * (1.f / 128.f) + LN_EPS) * (1.f - lam_init);
          u16* op = PB + (tokbase + q0 + qi) * 1024 + h * 128;
#pragma unroll
          for (int eb = 0; eb < 4; ++eb)
#pragma unroll
            for (int rr = 0; rr < 4; ++rr) {
              const int e = eb * 32 + 8 * rr + 4 * g;
              const f32x4 gg = *(const f32x4*)(subg + e);
              u32x2 pk; pk.x = cvt_pk_bf16(O[eb][4 * rr] * rs * gg[0], O[eb][4 * rr + 1] * rs * gg[1]); pk.y = cvt_pk_bf16(O[eb][4 * rr + 2] * rs * gg[2], O[eb][4 * rr + 3] * rs * gg[3]);
              *(u32x2*)(op + e) = pk;
            }
        }
      }
    }
  }
}

DI float softplusf_(float x) { return fmaxf(x, 0.f) + __logf(1.f + __expf(-fabsf(x))); }
DI void load_bf16x8(const u16* p, float (&o)[8]) {
  const u32x4 v = *(const u32x4*)p;
#pragma unroll
  for (int i = 0; i < 4; ++i) { o[2 * i] = __uint_as_float(v[i] << 16); o[2 * i + 1] = __uint_as_float(v[i] & 0xffff0000u); }
}
DI void shifted8(const u16* PA, size_t row, int t, int col, const float* mu0, const float* mu1, float (&o)[8]) {
  float c[8], pv[8], nx[8];
  load_bf16x8(PA + row * A_COLS + col, c);
  if (t > 0) load_bf16x8(PA + (row - 1) * A_COLS + col, pv); else { for (int i = 0; i < 8; ++i) pv[i] = 0.f; }
  if (t < T - 1) load_bf16x8(PA + (row + 1) * A_COLS + col, nx); else { for (int i = 0; i < 8; ++i) nx[i] = 0.f; }
#pragma unroll
  for (int i = 0; i < 8; ++i) o[i] = c[i] + mu0[col + i] * (pv[i] - c[i]) + mu1[col + i] * (nx[i] - c[i]);
}

DI void vprep_phase(LAS unsigned char* lds, const u16* PA, u16* VV, const float* mu, const float* vdown, const float* vup, const float* v0, int layer) {
  int tid = threadIdx.x; asm volatile("" : "+v"(tid));
  int bid = blockIdx.x, gdim = gridDim.x; asm volatile("" : "+s"(bid), "+s"(gdim));
  const int tok = tid >> 4, j = tid & 15;
  LAS float* vs = (LAS float*)lds;
  LAS float* dd = vs + 32 * 516;
  LAS unsigned* DN = (LAS unsigned*)(dd + 1024);
  LAS unsigned* UP = DN + 512 * 16;
  const float* mu0 = mu; const float* mu1 = mu + A_COLS;
  __syncthreads();
  if (layer != 0) {
    for (int i = tid; i < 512 * 16; i += NTHREADS) { const float2 w2 = *(const float2*)(vdown + 2 * i); DN[i] = cvt_pk_bf16(w2.x, w2.y); }
    for (int i = tid; i < 32 * 256; i += NTHREADS) { const float2 w2 = *(const float2*)(vup + 2 * i); UP[i] = cvt_pk_bf16(w2.x, w2.y); }
  }
  for (int it = bid; it < NT / 32; it += gdim) {
    const size_t row = (size_t)it * 32 + tok; const int t = (int)(row % T);
    __syncthreads();
#pragma unroll 1
    for (int q = 0; q < 4; ++q) {
      const int cc = q * 128 + j * 8;
      float o[8]; shifted8(PA, row, t, OFF_V + cc, mu0, mu1, o);
      if (layer == 0) {
        u32x4 pk; pk.x = cvt_pk_bf16(o[0], o[1]); pk.y = cvt_pk_bf16(o[2], o[3]); pk.z = cvt_pk_bf16(o[4], o[5]); pk.w = cvt_pk_bf16(o[6], o[7]);
        *(u32x4*)(VV + row * 512 + cc) = pk;
      } else {
        *(LAS f32x4*)(vs + tok * 516 + cc) = (f32x4){o[0], o[1], o[2], o[3]}; *(LAS f32x4*)(vs + tok * 516 + cc + 4) = (f32x4){o[4], o[5], o[6], o[7]};
      }
    }
    if (layer == 0) continue;
    __syncthreads();
    {
      float d0 = 0.f, d1 = 0.f;
#pragma unroll 8
      for (int c = 0; c < 512; ++c) { const float x = vs[tok * 516 + c]; const unsigned w2 = DN[c * 16 + j]; d0 += x * __uint_as_float(w2 << 16); d1 += x * __uint_as_float(w2 & 0xffff0000u); }
      dd[tok * 32 + 2 * j] = d0; dd[tok * 32 + 2 * j + 1] = d1;
    }
    __syncthreads();
#pragma unroll 1
    for (int q = 0; q < 4; ++q) {
      const int c0 = q * 128 + j * 8;
      float acc[8];
      { const f32x4 a0 = *(const f32x4*)(v0 + c0), a1 = *(const f32x4*)(v0 + c0 + 4);
#pragma unroll
        for (int i = 0; i < 4; ++i) { acc[i] = a0[i]; acc[4 + i] = a1[i]; } }
#pragma unroll 8
      for (int r = 0; r < 32; ++r) {
        const float dv = dd[tok * 32 + r];
        const u32x4 w8 = *(const LAS u32x4*)(UP + r * 256 + (c0 >> 1));
#pragma unroll
        for (int i = 0; i < 4; ++i) { acc[2 * i] += dv * __uint_as_float(w8[i] << 16); acc[2 * i + 1] += dv * __uint_as_float(w8[i] & 0xffff0000u); }
      }
      float vf[8]; load_bf16x8(VV + row * 512 + c0, vf);
      const f32x4 x0 = *(const LAS f32x4*)(vs + tok * 516 + c0), x1 = *(const LAS f32x4*)(vs + tok * 516 + c0 + 4);
      float o[8];
#pragma unroll
      for (int i = 0; i < 4; ++i) { o[i] = x0[i] + (vf[i] - x0[i]) * sigmoidf_(acc[i]); o[4 + i] = x1[i] + (vf[4 + i] - x1[i]) * sigmoidf_(acc[4 + i]); }
      u32x4 pk; pk.x = cvt_pk_bf16(o[0], o[1]); pk.y = cvt_pk_bf16(o[2], o[3]); pk.z = cvt_pk_bf16(o[4], o[5]); pk.w = cvt_pk_bf16(o[6], o[7]);
      *(u32x4*)(VV + row * 512 + c0) = pk;
    }
  }
}

struct ScanW { const float *mu, *w0, *du, *a0, *iu, *kk_, *ka, *rk; };
constexpr int SC = 32;
DI float quad_sum(float x) {
  x += __builtin_bit_cast(float, __builtin_amdgcn_update_dpp(0, __builtin_bit_cast(int, x), 0xB1, 0xf, 0xf, true));
  x += __builtin_bit_cast(float, __builtin_amdgcn_update_dpp(0, __builtin_bit_cast(int, x), 0x4E, 0xf, 0xf, true));
  return x;
}
#define BFLO(x) __uint_as_float((x) << 16)
#define BFHI(x) __uint_as_float((x) & 0xffff0000u)
DI float tanh_fast(float x) { x = fminf(fmaxf(x, -15.f), 15.f); const float t = __expf(2.f * x); return (t - 1.f) / (t + 1.f); }
DI float shift1(float c, float p, float n, float m0, float m1) { return c + m0 * (p - c) + m1 * (n - c); }
DI void scan_produce(LAS float* buf, LAS float* TW, LAS float* TA, LAS const float* DU, LAS const float* IU, const u16* PA, const u16* VV, float* BON,
                     const ScanW& w, int ptid, int sq, int h, int dir, int t0) {
  const int tok = ptid >> 3, j = ptid & 7;
  const int t = t0 + tok; const size_t row = (size_t)sq * T + t;
  const float* mu0 = w.mu; const float* mu1 = w.mu + A_COLS;
  const int cr = h * 64 + j * 8, ck = OFF_K + cr, cw_ = OFF_WD + dir * 32 + j * 4, ca_ = OFF_AD + dir * 32 + j * 4;
  const u16* pc = PA + row * A_COLS;
  const bool hp = t > 0, hn = t < T - 1;
  {
    const u32x2 w_c = *(const u32x2*)(pc + cw_), a_c = *(const u32x2*)(pc + ca_);
    u32x2 w_p = (u32x2){0u, 0u}, a_p = w_p, w_n = w_p, a_n = w_p;
    if (hp) { w_p = *(const u32x2*)(pc - A_COLS + cw_); a_p = *(const u32x2*)(pc - A_COLS + ca_); }
    if (hn) { w_n = *(const u32x2*)(pc + A_COLS + cw_); a_n = *(const u32x2*)(pc + A_COLS + ca_); }
    const f32x4 mw0 = *(const f32x4*)(mu0 + cw_), mw1 = *(const f32x4*)(mu1 + cw_), ma0 = *(const f32x4*)(mu0 + ca_), ma1 = *(const f32x4*)(mu1 + ca_);
    f32x4 tw, ta;
#pragma unroll
    for (int i = 0; i < 2; ++i) {
      tw[2 * i] = tanh_fast(shift1(BFLO(w_c[i]), BFLO(w_p[i]), BFLO(w_n[i]), mw0[2 * i], mw1[2 * i]));
      tw[2 * i + 1] = tanh_fast(shift1(BFHI(w_c[i]), BFHI(w_p[i]), BFHI(w_n[i]), mw0[2 * i + 1], mw1[2 * i + 1]));
      ta[2 * i] = shift1(BFLO(a_c[i]), BFLO(a_p[i]), BFLO(a_n[i]), ma0[2 * i], ma1[2 * i]);
      ta[2 * i + 1] = shift1(BFHI(a_c[i]), BFHI(a_p[i]), BFHI(a_n[i]), ma0[2 * i + 1], ma1[2 * i + 1]);
    }
    *(LAS f32x4*)(TW + tok * 32 + j * 4) = tw; *(LAS f32x4*)(TA + tok * 32 + j * 4) = ta;
  }
  asm volatile("s_waitcnt lgkmcnt(0)" ::: "memory");
  float wl[8], al[8];
  const int cc = j * 8, cg_ = h * 64 + cc;
  { const f32x4 x0 = *(const f32x4*)(w.w0 + dir * 512 + cg_), x1 = *(const f32x4*)(w.w0 + dir * 512 + cg_ + 4), y0 = *(const f32x4*)(w.a0 + dir * 512 + cg_), y1 = *(const f32x4*)(w.a0 + dir * 512 + cg_ + 4);
#pragma unroll
    for (int q = 0; q < 4; ++q) { wl[q] = x0[q]; wl[4 + q] = x1[q]; al[q] = y0[q]; al[4 + q] = y1[q]; } }
#pragma unroll 2
  for (int rr = 0; rr < 32; ++rr) {
    const float twv = TW[tok * 32 + rr], tav = TA[tok * 32 + rr];
    const f32x4 d0 = *(const LAS f32x4*)(DU + rr * 64 + cc), d1 = *(const LAS f32x4*)(DU + rr * 64 + cc + 4), i0 = *(const LAS f32x4*)(IU + rr * 64 + cc), i1 = *(const LAS f32x4*)(IU + rr * 64 + cc + 4);
#pragma unroll
    for (int q = 0; q < 4; ++q) { wl[q] += twv * d0[q]; wl[4 + q] += twv * d1[q]; al[q] += tav * i0[q]; al[4 + q] += tav * i1[q]; }
  }
#pragma unroll
  for (int q = 0; q < 8; ++q) { asm volatile("" : "+v"(wl[q]), "+v"(al[q])); }
  LAS float* AW = buf; LAS float* AK = buf + 2048; LAS float* AB = buf + 4096; LAS float* AD = buf + 6144; LAS float* AR = buf + 8192; LAS float* AV = buf + 10240;
  const int o = tok * 64 + cc;
  float ss = 0.f, bs = 0.f;
  float ok[8], av[8];
#pragma unroll
  for (int hq = 0; hq < 2; ++hq) {
    const int c4 = 4 * hq;
    const u32x2 r_c = *(const u32x2*)(pc + cr + c4), k_c = *(const u32x2*)(pc + ck + c4);
    u32x2 r_p = (u32x2){0u, 0u}, k_p = r_p, r_n = r_p, k_n = r_p;
    if (hp) { r_p = *(const u32x2*)(pc - A_COLS + cr + c4); k_p = *(const u32x2*)(pc - A_COLS + ck + c4); }
    if (hn) { r_n = *(const u32x2*)(pc + A_COLS + cr + c4); k_n = *(const u32x2*)(pc + A_COLS + ck + c4); }
    const u32x2 v_c = *(const u32x2*)(VV + row * 512 + cr + c4);
    const f32x4 mr0 = *(const f32x4*)(mu0 + cr + c4), mr1 = *(const f32x4*)(mu1 + cr + c4), mk0 = *(const f32x4*)(mu0 + ck + c4), mk1 = *(const f32x4*)(mu1 + ck + c4);
    const f32x4 kk4 = *(const f32x4*)(w.kk_ + cg_ + c4), ka4 = *(const f32x4*)(w.ka + cg_ + c4), rk4 = *(const f32x4*)(w.rk + cg_ + c4);
    f32x4 rv, kv, vv, ow, od;
#pragma unroll
    for (int i = 0; i < 2; ++i) {
      rv[2 * i] = shift1(BFLO(r_c[i]), BFLO(r_p[i]), BFLO(r_n[i]), mr0[2 * i], mr1[2 * i]);
      rv[2 * i + 1] = shift1(BFHI(r_c[i]), BFHI(r_p[i]), BFHI(r_n[i]), mr0[2 * i + 1], mr1[2 * i + 1]);
      kv[2 * i] = shift1(BFLO(k_c[i]), BFLO(k_p[i]), BFLO(k_n[i]), mk0[2 * i], mk1[2 * i]);
      kv[2 * i + 1] = shift1(BFHI(k_c[i]), BFHI(k_p[i]), BFHI(k_n[i]), mk0[2 * i + 1], mk1[2 * i + 1]);
      vv[2 * i] = BFLO(v_c[i]); vv[2 * i + 1] = BFHI(v_c[i]);
    }
#pragma unroll
    for (int q = 0; q < 4; ++q) {
      const float wlog = -softplusf_(-wl[c4 + q]) - 0.5f;
      ow[q] = __expf(-__expf(wlog));
      const float a = sigmoidf_(al[c4 + q]);
      av[c4 + q] = a;
      ok[c4 + q] = kv[q] * kk4[q]; ss += ok[c4 + q] * ok[c4 + q];
      od[q] = kv[q] * (1.f + (a - 1.f) * ka4[q]);
      bs += rv[q] * od[q] * rk4[q];
    }
    *(LAS f32x4*)(AW + o + c4) = ow; *(LAS f32x4*)(AD + o + c4) = od; *(LAS f32x4*)(AR + o + c4) = rv; *(LAS f32x4*)(AV + o + c4) = vv;
  }
#pragma unroll
  for (int sft = 1; sft < 8; sft <<= 1) { ss += __shfl_xor(ss, sft); bs += __shfl_xor(bs, sft); }
  const float rn = rsqrtf(ss + 1e-12f);
#pragma unroll
  for (int hq = 0; hq < 2; ++hq) {
    f32x4 k4, b4;
#pragma unroll
    for (int q = 0; q < 4; ++q) { k4[q] = ok[4 * hq + q] * rn; b4[q] = k4[q] * av[4 * hq + q]; }
    *(LAS f32x4*)(AK + o + 4 * hq) = k4; *(LAS f32x4*)(AB + o + 4 * hq) = b4;
  }
  if (j == 0) BON[((size_t)dir * NT + row) * 8 + h] = bs;
}
struct ScanOps { f32x4 k4[4], w4[4], b4[4], d4[4]; float vi; };
DI void scan_load(ScanOps& o, LAS const float* buf, int tt, int jseg, int irow) {
  const int off = tt * 64 + jseg * 16;
#pragma unroll
  for (int q = 0; q < 4; ++q) {
    o.w4[q] = *(const LAS f32x4*)(buf + off + q * 4); o.k4[q] = *(const LAS f32x4*)(buf + 2048 + off + q * 4); o.b4[q] = *(const LAS f32x4*)(buf + 4096 + off + q * 4);
    o.d4[q] = *(const LAS f32x4*)(buf + 6144 + off + q * 4);
  }
  o.vi = buf[10240 + tt * 64 + irow];
}
DI float scan_step(f32x4 (&S)[4], const ScanOps& o, LAS const float* buf, int tt, int jseg) {
  f32x4 r4[4];
#pragma unroll
  for (int q = 0; q < 4; ++q) r4[q] = *(const LAS f32x4*)(buf + 8192 + tt * 64 + jseg * 16 + q * 4);
  f32x4 a4 = S[0] * o.k4[0] + S[1] * o.k4[1] + S[2] * o.k4[2] + S[3] * o.k4[3];
  float sa = -quad_sum((a4[0] + a4[1]) + (a4[2] + a4[3]));
  f32x4 y4 = (f32x4){0.f, 0.f, 0.f, 0.f};
#pragma unroll
  for (int q = 0; q < 4; ++q) { S[q] = S[q] * o.w4[q] + (o.b4[q] * sa + o.d4[q] * o.vi); y4 += S[q] * r4[q]; }
  return quad_sum((y4[0] + y4[1]) + (y4[2] + y4[3]));
}
DI void scan_phase(LAS unsigned char* lds, const u16* PA, const u16* VV, u16* YY, float* BON, const ScanW w) {
  int tid = threadIdx.x; asm volatile("" : "+v"(tid));
  int bid = blockIdx.x, gdim = gridDim.x; asm volatile("" : "+s"(bid), "+s"(gdim));
  LAS float* BUF = (LAS float*)lds;
  LAS float* AY = BUF + 2 * 12288;
  LAS float* TW = AY + 2 * 2048;
  LAS float* TA = TW + SC * 32;
  LAS float* DU = TA + SC * 32;
  LAS float* IU = DU + 2048;
  const int wid = __builtin_amdgcn_readfirstlane(tid >> 6), lane = tid & 63;
  const int NCH = T / SC;
  for (int item = bid; item < 192; item += gdim) {
    const int dir = item & 1, h = (item >> 1) & 7, sq = item >> 4;
    __syncthreads();
    for (int i = tid; i < 2048; i += NTHREADS) { const int rr = i >> 6, c = i & 63; DU[i] = w.du[(dir * 32 + rr) * 512 + h * 64 + c]; IU[i] = w.iu[(dir * 32 + rr) * 512 + h * 64 + c]; }
    __syncthreads();
    f32x4 S[4];
#pragma unroll
    for (int q = 0; q < 4; ++q) S[q] = (f32x4){0.f, 0.f, 0.f, 0.f};
    const int irow = (wid & 3) * 16 + (lane >> 2), jseg = lane & 3;
    if (wid >= 4) scan_produce(BUF, TW, TA, DU, IU, PA, VV, BON, w, tid - 256, sq, h, dir, dir == 0 ? 0 : T - SC);
    __syncthreads();
#pragma unroll 1
    for (int ci = 0; ci < NCH; ++ci) {
      LAS float* buf = BUF + (ci & 1) * 12288;
      LAS float* ay = AY + (ci & 1) * 2048;
      if (wid < 4) {
        ScanOps o0, o1;
        scan_load(o0, buf, dir == 0 ? 0 : SC - 1, jseg, irow);
#pragma unroll 1
        for (int st = 0; st < SC; st += 2) {
          const int t0_ = dir == 0 ? st : SC - 1 - st, t1_ = dir == 0 ? st + 1 : SC - 2 - st;
          scan_load(o1, buf, t1_, jseg, irow);
          const float y0 = scan_step(S, o0, buf, t0_, jseg);
          if (jseg == 0) ay[t0_ * 64 + irow] = y0;
          if (st + 2 < SC) scan_load(o0, buf, dir == 0 ? st + 2 : SC - 3 - st, jseg, irow);
          const float y1 = scan_step(S, o1, buf, t1_, jseg);
          if (jseg == 0) ay[t1_ * 64 + irow] = y1;
        }
      } else {
        const int ptid = tid - 256;
        if (ci + 1 < NCH) scan_produce(BUF + ((ci + 1) & 1) * 12288, TW, TA, DU, IU, PA, VV, BON, w, ptid, sq, h, dir, dir == 0 ? (ci + 1) * SC : T - SC * (ci + 2));
        if (ci > 0) {
          LAS const float* py = AY + ((ci - 1) & 1) * 2048;
          const int t0p = dir == 0 ? (ci - 1) * SC : T - SC * ci;
          const int tok = ptid >> 3, c0 = (ptid & 7) * 8;
          const f32x4 ya = *(const LAS f32x4*)(py + tok * 64 + c0), yb = *(const LAS f32x4*)(py + tok * 64 + c0 + 4);
          u32x4 pk; pk.x = cvt_pk_bf16(ya[0], ya[1]); pk.y = cvt_pk_bf16(ya[2], ya[3]); pk.z = cvt_pk_bf16(yb[0], yb[1]); pk.w = cvt_pk_bf16(yb[2], yb[3]);
          *(u32x4*)(YY + ((size_t)dir * NT + (size_t)sq * T + t0p + tok) * 512 + h * 64 + c0) = pk;
        }
      }
      __syncthreads();
    }
    if (wid >= 4) {
      const int ptid = tid - 256;
      LAS const float* py = AY + ((NCH - 1) & 1) * 2048;
      const int t0p = dir == 0 ? (NCH - 1) * SC : 0;
      const int tok = ptid >> 3, c0 = (ptid & 7) * 8;
      const f32x4 ya = *(const LAS f32x4*)(py + tok * 64 + c0), yb = *(const LAS f32x4*)(py + tok * 64 + c0 + 4);
      u32x4 pk; pk.x = cvt_pk_bf16(ya[0], ya[1]); pk.y = cvt_pk_bf16(ya[2], ya[3]); pk.z = cvt_pk_bf16(yb[0], yb[1]); pk.w = cvt_pk_bf16(yb[2], yb[3]);
      *(u32x4*)(YY + ((size_t)dir * NT + (size_t)sq * T + t0p + tok) * 512 + h * 64 + c0) = pk;
    }
  }
}

DI void post_phase(LAS unsigned char* lds, u16* PA, const u16* PB, const u16* VV, const u16* YY, const float* BON, const float* mu, const float* gup, const float* gng, const float* gnb) {
  int tid = threadIdx.x; asm volatile("" : "+v"(tid));
  int bid = blockIdx.x, gdim = gridDim.x; asm volatile("" : "+s"(bid), "+s"(gdim));
  const int tok = tid >> 4, j = tid & 15;
  LAS float* sg = (LAS float*)lds;
  LAS unsigned* GU = (LAS unsigned*)(lds + 16384);
  const float* mu0 = mu; const float* mu1 = mu + A_COLS;
  __syncthreads();
  for (int i = tid; i < 96 * 256; i += NTHREADS) { const float2 w2 = *(const float2*)(gup + 2 * i); GU[i] = cvt_pk_bf16(w2.x, w2.y); }
  for (int it = bid; it < NT / 32; it += gdim) {
    const size_t row = (size_t)it * 32 + tok; const int t = (int)(row % T);
    __syncthreads();
#pragma unroll
    for (int q = 0; q < 6; ++q) {
      const int col = OFF_GD + j * 6 + q;
      const float c = bf2f(PA[row * A_COLS + col]);
      const float pv = t > 0 ? bf2f(PA[(row - 1) * A_COLS + col]) : 0.f, nx = t < T - 1 ? bf2f(PA[(row + 1) * A_COLS + col]) : 0.f;
      sg[tok * 96 + j * 6 + q] = sigmoidf_(c + mu0[col] * (pv - c) + mu1[col] * (nx - c));
    }
    __syncthreads();
#pragma unroll 1
    for (int q = 0; q < 4; ++q) {
      const int cc = q * 128 + j * 8, h = 2 * q + (j >> 3);
      float y[8]; float sm = 0.f;
      { float a[8], b[8]; load_bf16x8(YY + row * 512 + cc, a); load_bf16x8(YY + ((size_t)NT + row) * 512 + cc, b);
#pragma unroll
        for (int i = 0; i < 8; ++i) { y[i] = a[i] + b[i]; sm += y[i]; } }
      sm += __shfl_xor(sm, 1); sm += __shfl_xor(sm, 2); sm += __shfl_xor(sm, 4);
      const float mean = sm * (1.f / 64.f);
      float vq = 0.f;
#pragma unroll
      for (int i = 0; i < 8; ++i) { y[i] -= mean; vq += y[i] * y[i]; }
      vq += __shfl_xor(vq, 1); vq += __shfl_xor(vq, 2); vq += __shfl_xor(vq, 4);
      const float rs = rsqrtf(vq * (1.f / 64.f) + GN_EPS);
      const float bon = BON[row * 8 + h] + BON[((size_t)NT + row) * 8 + h];
      float gacc[8];
#pragma unroll
      for (int i = 0; i < 8; ++i) gacc[i] = 0.f;
#pragma unroll 8
      for (int r = 0; r < 96; ++r) {
        const float sv = sg[tok * 96 + r];
        const u32x4 w8 = *(const LAS u32x4*)(GU + r * 256 + (cc >> 1));
#pragma unroll
        for (int i = 0; i < 4; ++i) { gacc[2 * i] += sv * __uint_as_float(w8[i] << 16); gacc[2 * i + 1] += sv * __uint_as_float(w8[i] & 0xffff0000u); }
      }
      float vv[8]; load_bf16x8(VV + row * 512 + cc, vv);
      const f32x4 g0 = *(const f32x4*)(gng + cc), g1 = *(const f32x4*)(gng + cc + 4), b0 = *(const f32x4*)(gnb + cc), b1 = *(const f32x4*)(gnb + cc + 4);
      float o[8];
#pragma unroll
      for (int i = 0; i < 4; ++i) { o[i] = (y[i] * rs * g0[i] + b0[i] + bon * vv[i]) * gacc[i]; o[4 + i] = (y[4 + i] * rs * g1[i] + b1[i] + bon * vv[4 + i]) * gacc[4 + i]; }
      u32x4 pk; pk.x = cvt_pk_bf16(o[0], o[1]); pk.y = cvt_pk_bf16(o[2], o[3]); pk.z = cvt_pk_bf16(o[4], o[5]); pk.w = cvt_pk_bf16(o[6], o[7]);
      if (DBGZ & 1) pk = (u32x4){0u, 0u, 0u, 0u};
      *(u32x4*)(PA + row * A_COLS + cc) = pk;
      u32x4 pb4 = *(const u32x4*)(PB + row * 1024 + cc); if (DBGZ & 2) pb4 = (u32x4){0u, 0u, 0u, 0u};
      *(u32x4*)(PA + row * A_COLS + 512 + cc) = pb4;
    }
  }
}

DI unsigned hashu(unsigned x) { x ^= x >> 16; x *= 0x7feb352du; x ^= x >> 15; x *= 0x846ca68bu; x ^= x >> 16; return x; }
DI void dbg_upd(float* slot, float got, float ref, float scale) { float e = fabsf(got - ref) / scale; if (!(e == e)) e = 1e9f; atomicMax((unsigned*)slot, __float_as_uint(e)); }
DI float tshift(const u16* PA, size_t row, int col, const float* mu) {
  const int t = (int)(row % T);
  const float c = bf2f(PA[row * A_COLS + col]);
  const float pv = t > 0 ? bf2f(PA[(row - 1) * A_COLS + col]) : 0.f, nx = t < T - 1 ? bf2f(PA[(row + 1) * A_COLS + col]) : 0.f;
  return c + mu[col] * (pv - c) + mu[A_COLS + col] * (nx - c);
}
DI void chk_proj(const u16* XB, const float* win, const u16* PA, const u16* PB, const u16* VT, float* slot) {
  const int gt = blockIdx.x * NTHREADS + threadIdx.x;
  if (gt >= 4096) return;
  const int row = hashu(gt * 2 + 1) % NT, col = hashu(gt * 2 + 2) % P_COLS;
  float ref = 0.f;
  for (int k = 0; k < D; ++k) ref += bf2f(XB[(size_t)row * D + k]) * win[(size_t)k * P_COLS + col];
  float got;
  if (col < A_COLS) got = bf2f(PA[(size_t)row * A_COLS + col]);
  else if (col < A_COLS + 1024) got = bf2f(PB[(size_t)row * 1024 + col - A_COLS]);
  else { const int c2 = col - A_COLS - 1024, h = c2 >> 7, e = c2 & 127, sq = row / T, t = row % T; got = bf2f(VT[((size_t)((sq * 4 + h) * 128 + e)) * T + t]); }
  dbg_upd(slot, got, ref, 1.f);
}
DI void chk_ffn(const u16* XB, const float* wup, const float* cw, const float* cb, const u16* G, float* slot) {
  const int gt = blockIdx.x * NTHREADS + threadIdx.x;
  if (gt >= 4096) return;
  int row = hashu(gt * 2 + 11) % NT; const int n = hashu(gt * 2 + 12) % DFF;
  if (gt < 64) row = (gt & 1) ? (row / T) * T + T - 1 : (row / T) * T;
  else if (gt < 1024) row = (row / T) * T + ((row % T) / 254) * 254 + (gt & 1 ? 253 : 0), row = row >= NT ? NT - 1 : row;
  const int t = row % T;
  float hg[3] = {0.f, 0.f, 0.f}, hu[3] = {0.f, 0.f, 0.f};
#pragma unroll
  for (int d = -1; d <= 1; ++d) {
    float a = 0.f, b = 0.f;
    if (!(t + d < 0 || t + d > T - 1))
      for (int k = 0; k < D; ++k) { const float x = bf2f(XB[(size_t)(row + d) * D + k]); a += x * wup[(size_t)k * NUP + n]; b += x * wup[(size_t)k * NUP + DFF + n]; }
    hg[d + 1] = a; hu[d + 1] = b;
  }
  const float got = bf2f(G[(size_t)row * DFF + n]);
  { const float g = cw[n] * hg[0] + cw[NUP + n] * hg[1] + cw[2 * NUP + n] * hg[2] + cb[n];
    const float u = cw[DFF + n] * hu[0] + cw[NUP + DFF + n] * hu[1] + cw[2 * NUP + DFF + n] * hu[2] + cb[DFF + n];
    dbg_upd(slot, got, 0.5f * g * (1.f + erff(g * 0.70710678f)) * u, 1.f); }
  { const float g = cw[n] * hg[2] + cw[NUP + n] * hg[1] + cw[2 * NUP + n] * hg[0] + cb[n];
    const float u = cw[DFF + n] * hu[2] + cw[NUP + DFF + n] * hu[1] + cw[2 * NUP + DFF + n] * hu[0] + cb[DFF + n];
    dbg_upd(slot + 1, got, 0.5f * g * (1.f + erff(g * 0.70710678f)) * u, 1.f); }
  { const float g = cw[NUP + n] * hg[1] + cb[n];
    const float u = cw[NUP + DFF + n] * hu[1] + cb[DFF + n];
    dbg_upd(slot + 2, got, 0.5f * g * (1.f + erff(g * 0.70710678f)) * u, 1.f); }
}
DI void chk_attn(LAS unsigned char* lds, const u16* XB, const float* win, const u16* PB, const u16* VT, const float* lamp, const float* subg, const float* relb, int layer, float* slot) {
  if (blockIdx.x >= 16) return;
  const int tid = threadIdx.x;
  LAS float* qv = (LAS float*)lds;
  LAS float* sc = qv + 128;
  LAS float* red = sc + 16384;
  LAS float* ov = red + 1024;
  const int smp = blockIdx.x;
  const int sq = hashu(smp + 77) % NSEQ, h = smp & 3;
  int q = hashu(smp + 99) % T; if (smp < 4) q = smp * 37; if (smp >= 12) q = T - 1 - (smp - 12) * 50;
  const size_t row = (size_t)sq * T + q;
  __syncthreads();
  if (tid < 128) { float a = 0.f; const int col = A_COLS + h * 128 + tid; for (int k = 0; k < D; ++k) a += bf2f(XB[row * D + k]) * win[(size_t)k * P_COLS + col]; qv[tid] = a; }
  __syncthreads();
  float mx0 = -1e30f, mx1 = -1e30f;
  for (int key = tid; key < T; key += NTHREADS) {
    const u16* kp = PB + ((size_t)sq * T + key) * 1024 + 512 + h * 128;
    float s0 = 0.f, s1 = 0.f;
    for (int d = 0; d < 64; ++d) { s0 += qv[d] * bf2f(kp[d]); s1 += qv[64 + d] * bf2f(kp[64 + d]); }
    const int rel = key - q, n = rel < 0 ? -rel : rel;
    int bk;
    if (n < 8) bk = n; else { bk = 8 + (int)(logf((float)n / 8.f) / logf(16.f) * 8.f); bk = bk > 15 ? 15 : bk; }
    if (rel > 0) bk += 16;
    const float bias = relb[bk * 4 + h];
    s0 = s0 * 0.125f + bias; s1 = s1 * 0.125f + bias;
    sc[key] = s0; sc[8192 + key] = s1; mx0 = fmaxf(mx0, s0); mx1 = fmaxf(mx1, s1);
  }
  red[tid] = mx0; red[512 + tid] = mx1; __syncthreads();
  for (int o = 256; o > 0; o >>= 1) { if (tid < o) { red[tid] = fmaxf(red[tid], red[tid + o]); red[512 + tid] = fmaxf(red[512 + tid], red[512 + tid + o]); } __syncthreads(); }
  mx0 = red[0]; mx1 = red[512]; __syncthreads();
  float l0 = 0.f, l1 = 0.f;
  for (int key = tid; key < T; key += NTHREADS) { const float p0 = expf(sc[key] - mx0), p1 = expf(sc[8192 + key] - mx1); sc[key] = p0; sc[8192 + key] = p1; l0 += p0; l1 += p1; }
  red[tid] = l0; red[512 + tid] = l1; __syncthreads();
  for (int o = 256; o > 0; o >>= 1) { if (tid < o) { red[tid] += red[tid + o]; red[512 + tid] += red[512 + tid + o]; } __syncthreads(); }
  l0 = red[0]; l1 = red[512]; __syncthreads();
  float la = 0.f, lb = 0.f; for (int d = 0; d < 64; ++d) { la += lamp[d] * lamp[64 + d]; lb += lamp[128 + d] * lamp[192 + d]; }
  const float lam_init = 0.8f - 0.6f * expf(-0.3f * (float)layer);
  const float lam = expf(la) - expf(lb) + lam_init;
  { const int e = tid & 127, part = tid >> 7;
    const u16* vp = VT + ((size_t)((sq * 4 + h) * 128 + e)) * T;
    float o = 0.f;
    for (int key = part * 2048; key < (part + 1) * 2048; ++key) o += (sc[key] / l0 - lam * sc[8192 + key] / l1) * bf2f(vp[key]);
    red[tid] = o; }
  __syncthreads();
  if (tid < 128) ov[tid] = red[tid] + red[128 + tid] + red[256 + tid] + red[384 + tid];
  __syncthreads();
  if (tid < 128) {
    float ss = 0.f; for (int e = 0; e < 128; ++e) ss += ov[e] * ov[e];
    const float ref = ov[tid] * rsqrtf(ss / 128.f + LN_EPS) * subg[tid] * (1.f - lam_init);
    dbg_upd(slot, bf2f(PB[row * 1024 + h * 128 + tid]), ref, 1.f);
  }
}
struct ChkOp { float r, kd, kk, b, w, v; };
DI ChkOp chk_ops(const u16* PA, const u16* VV, const ScanW& w, size_t row, int h, int dir, int c, LAS float* tmp  , int tid) {
  ChkOp o;
  const int cg_ = h * 64 + c;
  o.r = tshift(PA, row, cg_, w.mu);
  const float k = tshift(PA, row, OFF_K + cg_, w.mu);
  float wl = w.w0[dir * 512 + cg_], al = w.a0[dir * 512 + cg_];
#pragma unroll 1
  for (int rr = 0; rr < 32; ++rr) {
    wl += tanhf(tshift(PA, row, OFF_WD + dir * 32 + rr, w.mu)) * w.du[(dir * 32 + rr) * 512 + cg_];
    al += tshift(PA, row, OFF_AD + dir * 32 + rr, w.mu) * w.iu[(dir * 32 + rr) * 512 + cg_];
  }
  const float sp = logf(1.f + expf(-wl));
  o.w = expf(-expf(-sp - 0.5f));
  const float a = 1.f / (1.f + expf(-al));
  const float kkv = k * w.kk_[cg_];
  __syncthreads(); tmp[tid] = kkv * kkv; __syncthreads();
  float ss = 0.f;
#pragma unroll 1
  for (int j = 0; j < 64; ++j) ss += tmp[j];
  o.kk = kkv * rsqrtf(ss + 1e-12f);
  o.kd = k * (1.f + (a - 1.f) * w.ka[cg_]);
  o.b = o.kk * a;
  o.v = bf2f(VV[row * 512 + cg_]);
  return o;
}
DI void chk_scan(LAS unsigned char* lds, const u16* PA, const u16* VV, const u16* YY, const float* BON, const ScanW w, float* slot) {
  if (blockIdx.x >= 48 || threadIdx.x >= 64) return;
  const int tid = threadIdx.x;
  LAS float* tmp = (LAS float*)lds; LAS float* red = tmp + 64;
  const int item = blockIdx.x * 4 + 1, dir = item & 1, h = (item >> 1) & 7, sq = item >> 4;
  const int t0 = dir == 0 ? 0 : T - 1, t1 = dir == 0 ? 1 : T - 2;
  const size_t row0 = (size_t)sq * T + t0, row1 = (size_t)sq * T + t1;
  const ChkOp a = chk_ops(PA, VV, w, row0, h, dir, tid, tmp, tid);
  const ChkOp b = chk_ops(PA, VV, w, row1, h, dir, tid, tmp, tid);
#define BSUM(dst, val) { __syncthreads(); red[tid] = (val); __syncthreads(); float sx_ = 0.f; _Pragma("unroll 1") for (int j_ = 0; j_ < 64; ++j_) sx_ += red[j_]; dst = sx_; }
  float ds0, ds1, ds2, ds3, ds4;
  BSUM(ds0, a.kd * a.r) BSUM(ds1, a.kd * b.w * b.r) BSUM(ds2, a.kd * (-b.kk)) BSUM(ds3, b.b * b.r) BSUM(ds4, b.kd * b.r)
  const float y0 = a.v * ds0;
  const float y1 = a.v * (ds1 + ds2 * ds3) + b.v * ds4;
  dbg_upd(slot, bf2f(YY[((size_t)dir * NT + row0) * 512 + h * 64 + tid]), y0, fabsf(y0) + 0.05f);
  dbg_upd(slot, bf2f(YY[((size_t)dir * NT + row1) * 512 + h * 64 + tid]), y1, fabsf(y1) + 0.05f);
  float bq = a.r * a.kd * w.rk[h * 64 + tid];
  __syncthreads(); red[tid] = bq; __syncthreads(); float bs = 0.f;
#pragma unroll 1
  for (int j = 0; j < 64; ++j) bs += red[j];
  dbg_upd(slot, BON[((size_t)dir * NT + row0) * 8 + h], bs, fabsf(bs) + 0.05f);
}
DI void chk_post(const u16* PA, const u16* PB, const u16* VV, const u16* YY, const float* BON, const float* mu, const float* gup, const float* gng, const float* gnb, float* slot) {
  const int gt = blockIdx.x * NTHREADS + threadIdx.x;
  if (gt >= 2048) return;
  const size_t row = hashu(gt * 2 + 21) % NT; const int c = hashu(gt * 2 + 22) % 512, h = c >> 6;
  float sm = 0.f;
  float yc = 0.f;
  for (int i = 0; i < 64; ++i) { const float y = bf2f(YY[row * 512 + h * 64 + i]) + bf2f(YY[((size_t)NT + row) * 512 + h * 64 + i]); sm += y; if (h * 64 + i == c) yc = y; }
  const float mean = sm / 64.f; float vq = 0.f;
  for (int i = 0; i < 64; ++i) { const float y = bf2f(YY[row * 512 + h * 64 + i]) + bf2f(YY[((size_t)NT + row) * 512 + h * 64 + i]) - mean; vq += y * y; }
  const float yn = (yc - mean) * rsqrtf(vq / 64.f + GN_EPS) * gng[c] + gnb[c];
  const float bon = (BON[row * 8 + h] + BON[((size_t)NT + row) * 8 + h]) * bf2f(VV[row * 512 + c]);
  float g = 0.f;
  for (int r = 0; r < 96; ++r) g += (1.f / (1.f + expf(-tshift(PA, row, OFF_GD + r, mu)))) * gup[r * 512 + c];
  const float ref = (yn + bon) * g;
  dbg_upd(slot, bf2f(PA[row * A_COLS + c]), ref, fabsf(ref) + 0.05f);
  dbg_upd(slot + 1, bf2f(PA[row * A_COLS + 512 + c]), bf2f(PB[row * 1024 + c]), 1.f);
}

__global__ __launch_bounds__(NTHREADS, 2) void mega(Params p_unused) {
  extern __shared__ __attribute__((aligned(16))) char shm[];
  cg::grid_group grid = cg::this_grid();
  LAS unsigned char* lds = (LAS unsigned char*)shm;
#define WS_PTRS CParams p = get_params(); unsigned char* ws = p->ws; \
  u16* WIN = (u16*)(ws + OFF_WIN); u16* WOUT = (u16*)(ws + OFF_WOUT); u16* WUP = (u16*)(ws + OFF_WUP); u16* WDN = (u16*)(ws + OFF_WDN); \
  u16* XB = (u16*)(ws + OFF_XB); u16* PA = (u16*)(ws + OFF_PA); u16* PB = (u16*)(ws + OFF_PB); u16* VT = (u16*)(ws + OFF_VT); \
  u16* G = (u16*)(ws + OFF_PA); u16* VV = (u16*)(ws + OFF_VV); u16* YY = (u16*)(ws + OFF_XB); float* BON = (float*)(ws + OFF_BON); float* XF = p->out; \
  (void)WIN; (void)WOUT; (void)WUP; (void)WDN; (void)XB; (void)PA; (void)PB; (void)VT; (void)G; (void)VV; (void)YY; (void)BON; (void)XF;
  int ph = 0;
  const int ph_lo = get_params()->ph_lo, ph_hi = get_params()->ph_hi;
#ifndef ONLYMASK
#define ONLYMASK 0xffffffffu
#endif
#define PHASE_BEGIN if (((ONLYMASK >> (__COUNTER__ % 32)) & 1u) && ph >= ph_lo && ph < ph_hi) { WS_PTRS
#define PHASE_END } ++ph; if (ph > ph_lo && ph < ph_hi) grid.sync();

  PHASE_BEGIN
    for (int l = 0; l < 2; ++l) {
      convert_weight<0>(shm, p->in[4] + (size_t)l * D * P_COLS, WIN + (size_t)l * NPROJ * D, D, P_COLS, NPROJ, blockIdx.x, gridDim.x);
      convert_weight<1>(shm, p->in[22] + (size_t)l * D * D, WOUT + (size_t)l * D * D, D, D, D, blockIdx.x, gridDim.x);
      convert_weight<2>(shm, p->in[25] + (size_t)l * D * NUP, WUP + (size_t)l * NUP * D, D, NUP, NUP, blockIdx.x, gridDim.x);
      convert_weight<1>(shm, p->in[28] + (size_t)l * DFF * D, WDN + (size_t)l * D * DFF, DFF, D, D, blockIdx.x, gridDim.x);
    }
    ln_rows(p->in[0], p->in[1], NPROMPT_TOK, XF, XB, p->in[2], p->in[3]);
#if PROBE_MISC
    ln_rows(p->in[0], p->in[1], NPROMPT_TOK, XF, XB, p->in[2], p->in[3]);
#endif
  PHASE_END

#pragma unroll 1
  for (int l = 0; l < 2; ++l) {
    PHASE_BEGIN
      Gemm ga{XB, D, WIN + (size_t)l * NPROJ * D, D};
      EpiArgs ea{}; ea.pa = PA; ea.pb = PB; ea.vt = VT;
      gemm_phase<0, 0>(lds, ga, NT / 256, NPROJ / 256, ea);
#if PROBE_GEMM
      gemm_phase<0, 0>(lds, ga, NT / 256, NPROJ / 256, ea);
#endif
    PHASE_END
#pragma unroll 1
    for (int rnd = 0; rnd < 2; ++rnd) {
      if (ph >= ph_lo && ph < ph_hi) { WS_PTRS
        int bidu = blockIdx.x, gdu = gridDim.x; asm volatile("" : "+s"(bidu), "+s"(gdu));
        const bool split = (gdu == 256);
        if (rnd == 0) vprep_phase(lds, PA, VV, p->in[5] + (size_t)l * 2 * A_COLS, p->in[16], p->in[17], p->in[18], l);
        if (rnd == 1 && (!split || bidu < 192)) {
          ScanW sw; sw.mu = p->in[5] + (size_t)l * 2 * A_COLS; sw.w0 = p->in[6] + l * 1024; sw.du = p->in[7] + (size_t)l * 2 * 32 * 512; sw.a0 = p->in[8] + l * 1024;
          sw.iu = p->in[9] + (size_t)l * 2 * 32 * 512; sw.kk_ = p->in[11] + l * 512; sw.ka = p->in[12] + l * 512; sw.rk = p->in[13] + l * 512;
          scan_phase(lds, PA, VV, YY, BON, sw);
        } else if (rnd == 0 || split) {
          const int plo = rnd == 0 ? 0 : 40, phi = (rnd == 0 && split) ? 40 : 48;
          const int wlo = rnd == 0 ? 0 : 192, wcnt = rnd == 0 ? (gdu & ~7) : 64;
          attn_phase(lds, PB, VT, (float*)(ws + OFF_OSV), p->in[19] + l * 256, p->in[20] + l * 128, p->in[21], l, plo, phi, wlo, wcnt);
        }
      }
      ++ph; if (ph > ph_lo && ph < ph_hi) grid.sync();
    }
    PHASE_BEGIN
      post_phase(lds, PA, PB, VV, YY, BON, p->in[5] + (size_t)l * 2 * A_COLS, p->in[10] + (size_t)l * 96 * 512, p->in[14] + l * 512, p->in[15] + l * 512);
#if PROBE_MISC
      post_phase(lds, PA, PB, VV, YY, BON, p->in[5] + (size_t)l * 2 * A_COLS, p->in[10] + (size_t)l * 96 * 512, p->in[14] + l * 512, p->in[15] + l * 512);
#endif
    PHASE_END
    PHASE_BEGIN
      Gemm ga{PA, A_COLS, WOUT + (size_t)l * D * D, D};
      EpiArgs ea{}; ea.xf = XF;
      gemm_phase<1, 0>(lds, ga, NT / 256, D / 256, ea);
    PHASE_END
    PHASE_BEGIN
      ln_rows(XF, XF, NT, XF, XB, p->in[23] + l * D, p->in[24] + l * D);
    PHASE_END
    PHASE_BEGIN
      Gemm ga{XB, D, WUP + (size_t)l * NUP * D, D};
      EpiArgs ea{}; ea.g = G; ea.cw = p->in[26] + (size_t)l * 3 * NUP; ea.cb = p->in[27] + (size_t)l * NUP;
      gemm_phase<2, 1>(lds, ga, NSEQ * 33, NUP / 256, ea);
#if PROBE_GEMM
      gemm_phase<2, 1>(lds, ga, NSEQ * 33, NUP / 256, ea);
#endif
    PHASE_END
    PHASE_BEGIN
      Gemm ga{G, DFF, WDN + (size_t)l * D * DFF, DFF};
      EpiArgs ea{}; ea.xf = XF; ea.zero = (DBGZ & 4) ? 1 : 0;
      gemm_phase<1, 0>(lds, ga, NT / 256, D / 256, ea);
    PHASE_END
    PHASE_BEGIN
      ln_rows(XF, XF, NT, XF, XB, p->in[29] + l * D, p->in[30] + l * D);
    PHASE_END
  }
}

#if DBG
#define DPTRS unsigned char* ws = p.ws; u16* XB = (u16*)(ws + OFF_XB); u16* PA = (u16*)(ws + OFF_PA); u16* PB = (u16*)(ws + OFF_PB); u16* VT = (u16*)(ws + OFF_VT); \
  u16* G = (u16*)(ws + OFF_PA); u16* VV = (u16*)(ws + OFF_VV); u16* YY = (u16*)(ws + OFF_XB); float* BON = (float*)(ws + OFF_BON); float* DE = (float*)(ws + OFF_DBG); \
  (void)XB; (void)PA; (void)PB; (void)VT; (void)G; (void)VV; (void)YY; (void)BON; (void)DE;
template <int which> __global__ __launch_bounds__(NTHREADS) void k_chk(Params p, int l) {
  extern __shared__ __attribute__((aligned(16))) char shm[];
  LAS unsigned char* lds = (LAS unsigned char*)shm;
  DPTRS
  if (which == 0) chk_proj(XB, p.in[4] + (size_t)l * D * P_COLS, PA, PB, VT, DE + 0);
  else if (which == 1) chk_attn(lds, XB, p.in[4] + (size_t)l * D * P_COLS, PB, VT, p.in[19] + l * 256, p.in[20] + l * 128, p.in[21], l, DE + 1);
  else if (which == 2) {
    ScanW sw; sw.mu = p.in[5] + (size_t)l * 2 * A_COLS; sw.w0 = p.in[6] + l * 1024; sw.du = p.in[7] + (size_t)l * 2 * 32 * 512; sw.a0 = p.in[8] + l * 1024;
    sw.iu = p.in[9] + (size_t)l * 2 * 32 * 512; sw.kk_ = p.in[11] + l * 512; sw.ka = p.in[12] + l * 512; sw.rk = p.in[13] + l * 512;
    chk_scan(lds, PA, VV, YY, BON, sw, DE + 2);
  } else if (which == 3) chk_post(PA, PB, VV, YY, BON, p.in[5] + (size_t)l * 2 * A_COLS, p.in[10] + (size_t)l * 96 * 512, p.in[14] + l * 512, p.in[15] + l * 512, DE + 3);
  else if (which == 5) chk_ffn(XB, p.in[25] + (size_t)l * D * NUP, p.in[26] + (size_t)l * 3 * NUP, p.in[27] + (size_t)l * NUP, G, DE + 5);
}
__global__ __launch_bounds__(NTHREADS) void k_encode(Params p) {
  const float* e = (const float*)(p.ws + OFF_DBG);
  const float eA = fmaxf(e[DBG_A], 1e-4f), eB = fmaxf(e[DBG_B], 1e-4f);
  const float V1 = 100.f + 100.f * log10f(eA / 1e-3f);
  float V2 = 1.f + log10f(eB / 1e-3f); V2 = fminf(fmaxf(V2, 0.3f), 8.f);
  const size_t n0 = (size_t)NPROMPT_TOK * D, n1 = (size_t)NT * D;
  for (size_t i = (size_t)blockIdx.x * NTHREADS + threadIdx.x; i < n1; i += (size_t)gridDim.x * NTHREADS) {
    float v = 0.f;
    if (i == 0 || i == n0) v = V1;
    else if (i < n0 / 2 || (i > n0 && i < n0 + (n1 - n0) / 2)) v = V2;
    p.out[i] = v;
  }
}
#endif

extern "C" void kernel_launch(void* const* d_in, const int* in_sizes, int n_in, void* d_out, int out_size, void* d_ws, size_t ws_size, hipStream_t stream) {
  static int grid = 0;
  if (grid == 0) {
    if (ws_size < WS_END) { fprintf(stderr, "ws too small: %zu < %zu\n", ws_size, (size_t)WS_END); grid = -1; return; }
    int dev = 0, cus = 0, per_cu = 0;
    hipGetDevice(&dev);
    hipDeviceGetAttribute(&cus, hipDeviceAttributeMultiprocessorCount, dev);
    hipFuncSetAttribute((const void*)mega, hipFuncAttributeMaxDynamicSharedMemorySize, LDS_BYTES);
#if DBG
    hipFuncSetAttribute((const void*)k_chk<1>, hipFuncAttributeMaxDynamicSharedMemorySize, 81920);
    hipFuncSetAttribute((const void*)k_chk<2>, hipFuncAttributeMaxDynamicSharedMemorySize, 81920);
#endif
    hipOccupancyMaxActiveBlocksPerMultiprocessor(&per_cu, (const void*)mega, NTHREADS, LDS_BYTES);
    if (per_cu < 1) per_cu = 1;
    grid = cus * 1;
  }
  if (grid < 0) return;
  Params p{};
  for (int i = 0; i < 31; ++i) p.in[i] = (const float*)d_in[i];
  p.out = (float*)d_out; p.ws = (unsigned char*)d_ws;
#if DBG
  hipMemsetAsync((char*)d_ws + OFF_DBG, 0, 256, stream);
  auto seg = [&](int lo, int hi) { Params q = p; q.ph_lo = lo; q.ph_hi = hi; void* a2[] = {&q};
    hipError_t e = hipLaunchCooperativeKernel((const void*)mega, dim3(grid), dim3(NTHREADS), a2, LDS_BYTES, stream);
    if (e != hipSuccess) fprintf(stderr, "cooperative launch failed: %s\n", hipGetErrorString(e)); };
  auto chk = [&](int l, int which) {
    if (which == 0) hipLaunchKernelGGL(k_chk<0>, dim3(64), dim3(NTHREADS), 81920, stream, p, l);
    if (which == 1) hipLaunchKernelGGL(k_chk<1>, dim3(64), dim3(NTHREADS), 81920, stream, p, l);
    if (which == 2) hipLaunchKernelGGL(k_chk<2>, dim3(64), dim3(NTHREADS), 81920, stream, p, l);
    if (which == 3) hipLaunchKernelGGL(k_chk<3>, dim3(64), dim3(NTHREADS), 81920, stream, p, l);
    if (which == 5) hipLaunchKernelGGL(k_chk<5>, dim3(64), dim3(NTHREADS), 81920, stream, p, l); };
  seg(0, 1);
  for (int l = 0; l < 2; ++l) {
    const int b = 1 + 9 * l;
    seg(b, b + 1); chk(l, 0);
    seg(b + 1, b + 2); chk(l, 1);
    seg(b + 2, b + 3); chk(l, 2);
    seg(b + 3, b + 4); chk(l, 3);
    seg(b + 4, b + 7); if (l == 0) chk(l, 5);
    seg(b + 7, b + 9);
  }
  hipLaunchKernelGGL(k_encode, dim3(1024), dim3(NTHREADS), 0, stream, p);
#else
  p.ph_lo = 0; p.ph_hi = 1000;
  void* args[] = {&p};
  hipError_t e = hipLaunchCooperativeKernel((const void*)mega, dim3(grid), dim3(NTHREADS), args, LDS_BYTES, stream);
  if (e != hipSuccess) fprintf(stderr, "cooperative launch failed: %s (grid %d)\n", hipGetErrorString(e), grid);
#endif
}
```

```cpp
#include <hip/hip_runtime.h>
#include <hip/hip_bf16.h>
#include <hip/hip_cooperative_groups.h>
#include <cstdio>
namespace cg = cooperative_groups;

#define DI __device__ __forceinline__
using bf16 = __hip_bfloat16;
using bf16x8 = __attribute__((ext_vector_type(8))) short;
using s16x4 = __attribute__((ext_vector_type(4))) short;
using f32x4 = __attribute__((ext_vector_type(4))) float;
using f32x16 = __attribute__((ext_vector_type(16))) float;
typedef unsigned short u16;
typedef unsigned u32x4 __attribute__((ext_vector_type(4)));
typedef unsigned u32x2 __attribute__((ext_vector_type(2)));

constexpr int D = 1024, T = 8192, NSEQ = 12, NT = NSEQ * T;
constexpr int NPROMPT_TOK = 4 * T;
constexpr int A_COLS = 1760, P_COLS = 3296, NPROJ = 3328;
constexpr int DFF = 2816, NUP = 5632;
constexpr int OFF_K = 512, OFF_V = 1024, OFF_WD = 1536, OFF_AD = 1600, OFF_GD = 1664;
constexpr float ALPHA = 1.4142135623730951f;
constexpr float LN_EPS = 1e-5f, GN_EPS = 64e-5f;
constexpr int NTHREADS = 512;
#ifndef DBGZ
#define DBGZ 0
#define DBG 0
#define PROBE_SCAN 0
#define PROBE_GEMM 0
#define PROBE_MISC 0
#ifndef CHK_PROJ_ON
#define CHK_PROJ_ON 1
#endif
#ifndef CHK_ATTN_ON
#define CHK_ATTN_ON 1
#endif
#ifndef CHK_SCAN_ON
#define CHK_SCAN_ON 1
#endif
#ifndef CHK_POST_ON
#define CHK_POST_ON 1
#endif
#ifndef CHK_FFN_ON
#define CHK_FFN_ON 1
#endif
#define DBG_A 5
#define DBG_B 6
#define DBGTHR 0.05f, 0.1f, 0.1f, 0.1f, 0.01f, 0.05f
#endif
constexpr int LDS_BYTES = 163840;

constexpr size_t SZ_WIN = (size_t)2 * NPROJ * D * 2;
constexpr size_t SZ_WOUT = (size_t)2 * D * D * 2;
constexpr size_t SZ_WUP = (size_t)2 * NUP * D * 2;
constexpr size_t SZ_WDN = (size_t)2 * D * DFF * 2;
constexpr size_t OFF_WIN = 0;
constexpr size_t OFF_WOUT = OFF_WIN + SZ_WIN;
constexpr size_t OFF_WUP = OFF_WOUT + SZ_WOUT;
constexpr size_t OFF_WDN = OFF_WUP + SZ_WUP;
constexpr size_t OFF_XB = OFF_WDN + SZ_WDN;
constexpr size_t OFF_PA = OFF_XB + (size_t)NT * D * 2;
constexpr size_t OFF_PB = OFF_PA + (size_t)NT * A_COLS * 2;
constexpr size_t OFF_VT = OFF_PB + (size_t)NT * 1024 * 2;
constexpr size_t OFF_VV = OFF_VT + (size_t)NT * 512 * 2;
constexpr size_t OFF_BON = OFF_VV + (size_t)NT * 512 * 2;
constexpr size_t OFF_OSV = OFF_BON + (size_t)2 * NT * 8 * 4;
constexpr size_t OFF_DBG = OFF_OSV + (size_t)256 * 64 * 512 * 4;
constexpr size_t WS_END = OFF_DBG + 256;
static_assert((size_t)NT * DFF * 2 <= (OFF_VV - OFF_PA), "G alias");

struct Params {
  const float* in[31];
  float* out;
  unsigned char* ws;
  int ph_lo, ph_hi;
};

typedef const __attribute__((address_space(4))) Params* CParams;
DI CParams get_params() { CParams pp = (CParams)__builtin_amdgcn_kernarg_segment_ptr(); asm volatile("" : "+s"(pp)); return pp; }

DI u16 f2bf(float x) { unsigned u = __float_as_uint(x); u += 0x7fffu + ((u >> 16) & 1u); return (u16)(u >> 16); }
DI unsigned cvt_pk_bf16(float lo, float hi) { unsigned r; asm volatile("v_cvt_pk_bf16_f32 %0, %1, %2" : "=v"(r) : "v"(lo), "v"(hi)); return r; }
DI float bf2f(u16 b) { return __uint_as_float(((unsigned)b) << 16); }
DI float sigmoidf_(float x) { return 1.f / (1.f + __expf(-x)); }

template <int MODE> DI int src_col(int n) {
  if (MODE == 0) { return n < A_COLS ? n : (n < 1792 ? -1 : n - 32); }
  if (MODE == 2) { int j = n >> 8, i = n & 255; return i < 128 ? j * 128 + i : DFF + j * 128 + (i - 128); }
  return n;
}
template <int MODE>
DI void convert_weight(char* shm, const float* W, u16* WT, int K, int Nsrc, int Ndst, int gtid_block, int nblocks) {
  float* tile = (float*)shm;
  int tn = Ndst / 64, tk = K / 64;
  for (int t = gtid_block; t < tn * tk; t += nblocks) {
    int n0 = (t / tk) * 64, k0 = (t % tk) * 64;
    __syncthreads();
    for (int e = threadIdx.x; e < 4096; e += NTHREADS) {
      int kk = e >> 6, nn = e & 63;
      int sc = src_col<MODE>(n0 + nn);
      tile[kk * 65 + nn] = sc >= 0 ? W[(size_t)(k0 + kk) * Nsrc + sc] : 0.f;
    }
    __syncthreads();
    for (int e = threadIdx.x; e < 4096; e += NTHREADS) {
      int nn = e >> 6, kk = e & 63;
      WT[(size_t)(n0 + nn) * K + k0 + kk] = f2bf(tile[kk * 65 + nn]);
    }
  }
}

constexpr int LNR = 4;
DI void ln_rows(const float* srcA, const float* srcB, int splitRow, float* dstF, u16* dstB, const float* g, const float* b, bool writeF) {
  int tid = threadIdx.x; asm volatile("" : "+v"(tid));
  int bid = blockIdx.x, gdim = gridDim.x; asm volatile("" : "+s"(bid), "+s"(gdim));
  int wave = tid >> 6, lane = tid & 63;
  int gw = bid * 8 + wave, nw = gdim * 8;
  for (int base = gw * LNR; base < NT; base += nw * LNR) {
    f32x4 v[LNR][4]; float s[LNR], q[LNR];
#pragma unroll
    for (int r = 0; r < LNR; ++r) {
      const int row = base + r;
      const float* src = row < splitRow ? srcA + (size_t)row * D : srcB + (size_t)(row - splitRow) * D;
#pragma unroll
      for (int i = 0; i < 4; ++i) v[r][i] = *(const f32x4*)(src + i * 256 + lane * 4);
    }
#pragma unroll
    for (int r = 0; r < LNR; ++r) { s[r] = 0.f;
#pragma unroll
      for (int i = 0; i < 4; ++i) s[r] += (v[r][i][0] + v[r][i][1]) + (v[r][i][2] + v[r][i][3]); }
#pragma unroll
    for (int o = 32; o > 0; o >>= 1)
#pragma unroll
      for (int r = 0; r < LNR; ++r) s[r] += __shfl_xor(s[r], o);
#pragma unroll
    for (int r = 0; r < LNR; ++r) { const float mu = s[r] * (1.f / D); q[r] = 0.f;
#pragma unroll
      for (int i = 0; i < 4; ++i) { v[r][i] -= mu; const f32x4 t = v[r][i] * v[r][i]; q[r] += (t[0] + t[1]) + (t[2] + t[3]); } }
#pragma unroll
    for (int o = 32; o > 0; o >>= 1)
#pragma unroll
      for (int r = 0; r < LNR; ++r) q[r] += __shfl_xor(q[r], o);
#pragma unroll
    for (int i = 0; i < 4; ++i) {
      const f32x4 gg = *(const f32x4*)(g + i * 256 + lane * 4), bb = *(const f32x4*)(b + i * 256 + lane * 4);
#pragma unroll
      for (int r = 0; r < LNR; ++r) {
        const int row = base + r;
        const float rs = rsqrtf(q[r] * (1.f / D) + LN_EPS);
        const f32x4 o4 = v[r][i] * rs * gg + bb;
        if (writeF) *(f32x4*)(dstF + (size_t)row * D + i * 256 + lane * 4) = o4;
        u32x2 h; h.x = cvt_pk_bf16(o4[0], o4[1]); h.y = cvt_pk_bf16(o4[2], o4[3]);
        *(u32x2*)(dstB + (size_t)row * D + i * 256 + lane * 4) = h;
      }
    }
  }
}

#define LAS __attribute__((address_space(3)))
constexpr int BK = 64, HALF = 128, HTB = HALF * BK * 2, STAGE_BYTES = 8 * HTB;
DI int lds_byte(int r, int c) { const int st = (r >> 4) * 2 + (c >> 5), rr = r & 15, cc = c & 31, ob = rr * 64 + cc * 2; return st * 1024 + (ob ^ (((ob >> 9) & 1) << 5)); }
DI void stage_rc(int b, int& R, int& C) { const int st = b / 1024, sb = b % 1024, swz = sb ^ (((sb >> 9) & 1) << 5); R = (st >> 1) * 16 + swz / 64; C = (st & 1) * 32 + (swz % 64) / 2; }
DI int perm32(int rho) { const int n = rho >> 4, i = rho & 15; return 8 * (i >> 2) + 4 * n + (i & 3); }

typedef float f32x2 __attribute__((ext_vector_type(2)));
DI float gelu1(float v) {
  const float av = __builtin_fabsf(v), d = av * 0.2316418882f + 1.0f;
  const float t = __builtin_amdgcn_rcpf(d);
  float q = t * 0.5307027145f + (-0.7265760135f); q = q * t + 0.7107068705f; q = q * t + (-0.142248368f); q = q * t + 0.127414796f; q = q * t;
  const float e = __builtin_amdgcn_exp2f((v * v) * (-0.72134752044f));
  const float m = v * (q * e), r = v - m;
  return v < 0.f ? m : r;
}
DI float dpp_shr1(float old, float src) { asm volatile("s_nop 1\n\tv_mov_b32_dpp %0, %1 row_shr:1 row_mask:0xf bank_mask:0xf\n\ts_nop 0" : "+v"(old) : "v"(src)); return old; }
DI float dpp_shl1(float old, float src) { asm volatile("s_nop 1\n\tv_mov_b32_dpp %0, %1 row_shl:1 row_mask:0xf bank_mask:0xf\n\ts_nop 0" : "+v"(old) : "v"(src)); return old; }
struct Unit { int pm, pn; };
struct Order {
  int nM, nN, nwg, G, c;
  DI void init(int nM_, int nN_, int G_, int c_) { nM = nM_; nN = nN_; nwg = nM * nN; G = G_; c = c_; }
  DI bool next(int i, Unit& u) const {
    const long Lq = (long)i * G + c; if (Lq >= nwg) return false;
    int wgid = (int)Lq; { const int q = nwg / 8, r = nwg % 8, xcd = wgid % 8, off = wgid / 8; wgid = (xcd < r ? xcd * (q + 1) : r * (q + 1) + (xcd - r) * q) + off; }
    const int nig = 8 * nN, gid = wgid / nig, fm = gid * 8, gsz = (nM - fm) < 8 ? (nM - fm) : 8;
    u.pm = fm + ((wgid % nig) % gsz); u.pn = (wgid % nig) / gsz; return true;
  }
};
struct Gemm { const u16* A; int lda; const u16* Bt; int K; };
template <int ROWMODE> DI const char* a_tile_ptr(const Gemm& g, int pm) {
  long row = ROWMODE == 0 ? (long)pm * 256 : (long)(pm / 33) * T + 254 * (pm % 33) - 1;
  return (const char*)g.A + row * g.lda * 2;
}
struct EpiArgs {
  u16* pa; u16* pb; u16* vt;
  float* xf; const u16* xb;
  u16* g; const float* cw; const float* cb;
  int zero;
};
template <int EPI>
DI void epilogue(f32x4 (&acc)[2][2][4][2], const Unit& u, const EpiArgs& ea, LAS unsigned char* lds) {
  int tid2 = threadIdx.x; asm volatile("" : "+v"(tid2));
  const int wid2 = tid2 >> 6, lane2 = tid2 & 63, wr = wid2 >> 2, wc = wid2 & 3, fr = lane2 & 15, fq = lane2 >> 4;
  if (EPI == 0) {
    const int row0 = u.pm * 256 + wr * 64 + fr;
#pragma unroll
    for (int ai = 0; ai < 2; ++ai)
#pragma unroll
      for (int m = 0; m < 4; ++m) {
        const int row = row0 + ai * HALF + m * 16;
#pragma unroll
        for (int bj = 0; bj < 2; ++bj) {
          const int col = u.pn * 256 + bj * HALF + wc * 32 + 8 * fq;
          const f32x4 a0 = acc[ai][bj][m][0], a1 = acc[ai][bj][m][1];
          if (u.pn <= 10) {
            uint4 pk; pk.x = cvt_pk_bf16(a0[0], a0[1]); pk.y = cvt_pk_bf16(a0[2], a0[3]); pk.z = cvt_pk_bf16(a1[0], a1[1]); pk.w = cvt_pk_bf16(a1[2], a1[3]);
            if (u.pn <= 6) { if (col < A_COLS) *(uint4*)(ea.pa + (size_t)row * A_COLS + col) = pk; }
            else *(uint4*)(ea.pb + (size_t)row * 1024 + (col - 1792)) = pk;
          } else {
            const int c2 = col - 2816, h = c2 >> 7, e = c2 & 127, seq = row / T, t = row % T;
            u16* dst = ea.vt + ((size_t)((seq * 4 + h) * 128 + e)) * T + t;
#pragma unroll
            for (int j = 0; j < 4; ++j) { dst[(size_t)j * T] = f2bf(a0[j]); dst[(size_t)(4 + j) * T] = f2bf(a1[j]); }
          }
        }
      }
  } else if (EPI == 1) {
    const int row0 = u.pm * 256 + wr * 64 + fr, col0 = u.pn * 256 + wc * 32 + 4 * fq;
#pragma unroll
    for (int ai = 0; ai < 2; ++ai)
#pragma unroll
      for (int m = 0; m < 4; ++m) {
        float* rowp = ea.xf + (size_t)(row0 + ai * HALF + m * 16) * D + col0;
        const u16* rowb = ea.xb + (size_t)(row0 + ai * HALF + m * 16) * D + col0;
#pragma unroll
        for (int bj = 0; bj < 2; ++bj)
#pragma unroll
          for (int n = 0; n < 2; ++n) { f32x4* p4 = (f32x4*)(rowp + bj * HALF + n * 16); const u32x2 xr = *(const u32x2*)(rowb + bj * HALF + n * 16);
            f32x4 x; x[0] = __uint_as_float(xr.x << 16); x[1] = __uint_as_float(xr.x & 0xffff0000u); x[2] = __uint_as_float(xr.y << 16); x[3] = __uint_as_float(xr.y & 0xffff0000u);
            *p4 = x * ALPHA + acc[ai][bj][m][n]; }
      }
  } else {
    LAS float* E = (LAS float*)(lds + STAGE_BYTES);
    const int seq = u.pm / 33, ti = u.pm % 33;
    const int cl0 = wc * 32 + 8 * fq;
#pragma unroll
    for (int ai = 0; ai < 2; ++ai)
#pragma unroll
      for (int m = 0; m < 4; ++m) {
        const int rl = ai * HALF + wr * 64 + m * 16 + fr;
        const int tok = 254 * ti - 1 + rl;
        const bool valid = tok >= 0 && tok < T;
        const int blk = ai * 8 + wr * 4 + m;
#pragma unroll
        for (int bj = 0; bj < 2; ++bj)
#pragma unroll
          for (int n = 0; n < 2; ++n) {
            if (!valid) acc[ai][bj][m][n] = (f32x4){0.f, 0.f, 0.f, 0.f};
            if (fr == 0) *(LAS f32x4*)(E + ((blk * 2 + 0) * 2 + bj) * 128 + cl0 + 4 * n) = acc[ai][bj][m][n];
            if (fr == 15) *(LAS f32x4*)(E + ((blk * 2 + 1) * 2 + bj) * 128 + cl0 + 4 * n) = acc[ai][bj][m][n];
          }
      }
    asm volatile("s_waitcnt lgkmcnt(0)" ::: "memory");
    __builtin_amdgcn_s_barrier(); asm volatile("" ::: "memory");
    __builtin_amdgcn_s_barrier(); asm volatile("" ::: "memory");
#pragma unroll
    for (int n = 0; n < 2; ++n) {
      const int hid = u.pn * 128 + cl0 + 4 * n;
      const float* cwp = ea.cw + hid;
      const f32x4 g0 = *(const f32x4*)(cwp), g1 = *(const f32x4*)(cwp + NUP), g2 = *(const f32x4*)(cwp + 2 * NUP), gb = *(const f32x4*)(ea.cb + hid);
      const f32x4 u0 = *(const f32x4*)(cwp + DFF), u1 = *(const f32x4*)(cwp + DFF + NUP), u2 = *(const f32x4*)(cwp + DFF + 2 * NUP), ub = *(const f32x4*)(ea.cb + DFF + hid);
#pragma unroll
      for (int ai = 0; ai < 2; ++ai)
#pragma unroll
        for (int m = 0; m < 4; ++m) {
          const int blk = ai * 8 + wr * 4 + m;
          const int rl = ai * HALF + wr * 64 + m * 16 + fr;
          const int tok = 254 * ti - 1 + rl;
          f32x4 hh[2];
#pragma unroll
          for (int bj = 0; bj < 2; ++bj) {
            const f32x4 cur = acc[ai][bj][m][n];
            f32x4 ab = (f32x4){0.f, 0.f, 0.f, 0.f}, be = (f32x4){0.f, 0.f, 0.f, 0.f};
            if (fr == 0 && blk > 0) ab = *(LAS f32x4*)(E + (((blk - 1) * 2 + 1) * 2 + bj) * 128 + cl0 + 4 * n);
            if (fr == 15 && blk < 15) be = *(LAS f32x4*)(E + (((blk + 1) * 2 + 0) * 2 + bj) * 128 + cl0 + 4 * n);
            f32x4 prev, next;
#pragma unroll
            for (int j = 0; j < 4; ++j) { prev[j] = dpp_shr1(ab[j], cur[j]); next[j] = dpp_shl1(be[j], cur[j]); }
            hh[bj] = bj == 0 ? g0 * prev + g1 * cur + g2 * next + gb : u0 * prev + u1 * cur + u2 * next + ub;
          }
          f32x4 res;
#pragma unroll
          for (int j = 0; j < 4; ++j) res[j] = gelu1(hh[0][j]) * hh[1][j];
          if (rl >= 1 && rl <= 254 && tok < T) {
            u32x2 pk; pk.x = cvt_pk_bf16(res[0], res[1]); pk.y = cvt_pk_bf16(res[2], res[3]);
            *(u32x2*)(ea.g + (size_t)(seq * T + tok) * DFF + hid) = pk;
          }
        }
    }
  }
}

template <int EPI, int ROWMODE>
DI void gemm_phase(LAS unsigned char* lds, const Gemm g, int nM, int nN, const EpiArgs& ea) {
  constexpr bool PERM = (EPI != 1);
  int tid = threadIdx.x; asm volatile("" : "+v"(tid));
  int bid = blockIdx.x, gdim = gridDim.x; asm volatile("" : "+s"(bid), "+s"(gdim));
  const int wid = __builtin_amdgcn_readfirstlane(tid >> 6), lane = tid & 63, wr = wid >> 2, wc = wid & 3, fr = lane & 15, fq = lane >> 4;
  const int K = g.K, nt = K / BK;
  Order S; S.init(nM, nN, gdim, bid);
  unsigned voffA[2], voffB[2];
#pragma unroll
  for (int i = 0; i < 2; ++i) { int R, C; stage_rc(tid * 16 + i * 8192, R, C); const int Rb = PERM ? ((R & ~31) + perm32(R & 31)) : R;
    voffA[i] = (unsigned)(R * g.lda + C) * 2u; voffB[i] = (unsigned)(Rb * K + C) * 2u; }
  const size_t kstep = (size_t)(BK * 2);
  const size_t hstepA = (size_t)HALF * g.lda * 2, hstepB = (size_t)HALF * K * 2;
  const unsigned ldsw = (unsigned)wid * 1024u;
  const int aoff = lds_byte(wr * 64 + fr, fq * 8), boff = lds_byte(wc * 32 + fr, fq * 8);
#define PG8_SA(b, h) (((b) * 2 + (h)) * HTB)
#define PG8_SB(b, h) ((4 + (b) * 2 + (h)) * HTB)
#define PG8_STAGE(bufoff, gbase, voff) do { _Pragma("unroll") for (int _i = 0; _i < 2; ++_i) \
    __builtin_amdgcn_global_load_lds((const unsigned*)((const char*)(gbase) + (voff)[_i]), (LAS unsigned*)(lds + (bufoff) + ldsw + _i * 8192), 16, 0, 0); } while (0)
#define PG8_LDA(dst, b, h) do { _Pragma("unroll") for (int m = 0; m < 4; ++m) _Pragma("unroll") for (int k = 0; k < 2; ++k) dst[m][k] = *(const LAS bf16x8*)(lds + PG8_SA(b, h) + aoff + m * 2048 + k * 1024); } while (0)
#define PG8_LDB(dst, b, h) do { _Pragma("unroll") for (int n = 0; n < 2; ++n) _Pragma("unroll") for (int k = 0; k < 2; ++k) dst[n][k] = *(const LAS bf16x8*)(lds + PG8_SB(b, h) + boff + n * 2048 + k * 1024); } while (0)
#define PG8_MMA(ai, bj, At, Bq) do { __builtin_amdgcn_s_setprio(1); _Pragma("unroll") for (int m = 0; m < 4; ++m) _Pragma("unroll") for (int n = 0; n < 2; ++n) _Pragma("unroll") for (int k = 0; k < 2; ++k) \
    acc[ai][bj][m][n] = __builtin_amdgcn_mfma_f32_16x16x32_bf16(Bq[n][k], At[m][k], acc[ai][bj][m][n], 0, 0, 0); __builtin_amdgcn_s_setprio(0); } while (0)
#define PG8_WAIT_V(n) asm volatile("s_waitcnt vmcnt(" #n ")" ::: "memory")
#define PG8_WAIT_L(n) asm volatile("s_waitcnt lgkmcnt(" #n ")" ::: "memory")
#define PG8_BAR __builtin_amdgcn_s_barrier()
#define PG8_SCHED __builtin_amdgcn_sched_barrier(0)
  Unit cur, nxt; int ui = 0;
  __syncthreads();
  if (!S.next(0, cur)) return;
  f32x4 acc[2][2][4][2];
#pragma unroll
  for (int a = 0; a < 2; ++a)
#pragma unroll
    for (int b = 0; b < 2; ++b)
#pragma unroll
      for (int m = 0; m < 4; ++m)
#pragma unroll
        for (int n = 0; n < 2; ++n) acc[a][b][m][n] = (f32x4){0.f, 0.f, 0.f, 0.f};
  bf16x8 At[4][2], B0[2][2], B1[2][2];
  const char* cA = a_tile_ptr<ROWMODE>(g, cur.pm); const char* cB = (const char*)g.Bt + (size_t)cur.pn * 2 * hstepB;
  PG8_STAGE(PG8_SB(0, 0), cB, voffB); PG8_STAGE(PG8_SA(0, 0), cA, voffA); PG8_STAGE(PG8_SB(0, 1), cB + hstepB, voffB); PG8_STAGE(PG8_SA(0, 1), cA + hstepA, voffA);
  if (wr == 1) PG8_BAR;
  PG8_WAIT_V(4); PG8_BAR;
  PG8_STAGE(PG8_SB(1, 0), cB + kstep, voffB); PG8_STAGE(PG8_SA(1, 0), cA + kstep, voffA); PG8_STAGE(PG8_SB(1, 1), cB + hstepB + kstep, voffB);
  PG8_WAIT_V(6); PG8_BAR;
  for (;;) {
    const bool has_next = S.next(ui + 1, nxt);
    const char* nA = has_next ? a_tile_ptr<ROWMODE>(g, nxt.pm) : cA; const char* nB = has_next ? (const char*)g.Bt + (size_t)nxt.pn * 2 * hstepB : cB;
    for (int t = 0; t < nt; t += 2) {
      const bool last = (t == nt - 2);
      const char* a1 = cA + (size_t)(t + 1) * kstep;
      const char* a2 = last ? nA : cA + (size_t)(t + 2) * kstep; const char* b2 = last ? nB : cB + (size_t)(t + 2) * kstep;
      const char* a3 = a2 + kstep; const char* b3 = b2 + kstep;
      PG8_LDB(B0, 0, 0); PG8_SCHED; PG8_LDA(At, 0, 0); PG8_STAGE(PG8_SA(1, 1), a1 + hstepA, voffA);
      PG8_WAIT_L(8); PG8_BAR; PG8_WAIT_L(0); PG8_MMA(0, 0, At, B0); PG8_BAR; PG8_SCHED;
      PG8_LDB(B1, 0, 1); PG8_STAGE(PG8_SB(0, 0), b2, voffB);
      PG8_BAR; PG8_WAIT_L(0); PG8_MMA(0, 1, At, B1); PG8_BAR;
      PG8_LDA(At, 0, 1); PG8_STAGE(PG8_SA(0, 0), a2, voffA);
      PG8_BAR; PG8_WAIT_L(0); PG8_MMA(1, 0, At, B0); PG8_BAR; PG8_SCHED;
      PG8_STAGE(PG8_SB(0, 1), b2 + hstepB, voffB);
      PG8_WAIT_V(6); PG8_BAR; PG8_MMA(1, 1, At, B1); PG8_BAR;
      PG8_LDB(B0, 1, 0); PG8_SCHED; PG8_LDA(At, 1, 0); PG8_STAGE(PG8_SA(0, 1), a2 + hstepA, voffA);
      PG8_WAIT_L(8); PG8_BAR; PG8_WAIT_L(0); PG8_MMA(0, 0, At, B0); PG8_BAR; PG8_SCHED;
      PG8_LDB(B1, 1, 1); PG8_STAGE(PG8_SB(1, 0), b3, voffB);
      PG8_BAR; PG8_WAIT_L(0); PG8_MMA(0, 1, At, B1); PG8_BAR;
      PG8_LDA(At, 1, 1); PG8_STAGE(PG8_SA(1, 0), a3, voffA);
      PG8_BAR; PG8_WAIT_L(0); PG8_MMA(1, 0, At, B0); PG8_BAR; PG8_SCHED;
      PG8_STAGE(PG8_SB(1, 1), b3 + hstepB, voffB);
      PG8_WAIT_V(6); PG8_BAR; PG8_MMA(1, 1, At, B1); PG8_BAR;
    }
    epilogue<EPI>(acc, cur, ea, lds);
    if (!has_next) break;
#pragma unroll
    for (int a = 0; a < 2; ++a)
#pragma unroll
      for (int b = 0; b < 2; ++b)
#pragma unroll
        for (int m = 0; m < 4; ++m)
#pragma unroll
          for (int n = 0; n < 2; ++n) acc[a][b][m][n] = (f32x4){0.f, 0.f, 0.f, 0.f};
    cur = nxt; cA = nA; cB = nB; ++ui;
  }
  PG8_WAIT_V(0);
  if (wr == 0) PG8_BAR;
  PG8_BAR;
#undef PG8_SA
#undef PG8_SB
}

constexpr int KROW = 144, VROW = 144;
constexpr int KBUF = 64 * KROW, VBUF = 128 * VROW, ABUF = KBUF + VBUF;
constexpr float LOG2E = 1.4426950408889634f;
DI bf16x8 pack8(const f32x16& x, int s) {
  u32x4 p; p.x = cvt_pk_bf16(x[8 * s], x[8 * s + 1]); p.y = cvt_pk_bf16(x[8 * s + 2], x[8 * s + 3]); p.z = cvt_pk_bf16(x[8 * s + 4], x[8 * s + 5]); p.w = cvt_pk_bf16(x[8 * s + 6], x[8 * s + 7]);
  return __builtin_bit_cast(bf16x8, p);
}
DI void attn_phase(LAS unsigned char* lds, u16* PB, const u16* VT, float* OSV, const float* lamp, const float* subg, const float* relb, int layer, int pair_lo, int pair_hi, int wg_lo, int wg_cnt) {
  int tid = threadIdx.x; asm volatile("" : "+v"(tid));
  int bid = blockIdx.x, gdim = gridDim.x; asm volatile("" : "+s"(bid), "+s"(gdim));
  const int wid = tid >> 6, lane = tid & 63, qi = lane & 31, g = lane >> 5;
  LAS float* tab = (LAS float*)(lds + 2 * ABUF);
  LAS float* scal = tab + 264;
  const float lam_init = 0.8f - 0.6f * __expf(-0.3f * (float)layer);
  __syncthreads();
  if (wid == 0) {
    float a = lamp[lane] * lamp[64 + lane], b = lamp[128 + lane] * lamp[192 + lane];
    for (int o = 32; o > 0; o >>= 1) { a += __shfl_xor(a, o); b += __shfl_xor(b, o); }
    if (lane == 0) scal[0] = __expf(a) - __expf(b) + lam_init;
  }
  const int m_sw = (qi & 0x13) | ((qi & 4) << 1) | ((qi & 8) >> 1);
  if (bid < wg_lo || bid >= wg_lo + wg_cnt) return;
  const int xcd = bid & 7, jq = (bid - wg_lo) >> 3;
  const int per_x = wg_cnt >> 3;
  const float c1 = 0.125f * LOG2E;
  for (int pr = pair_lo + xcd; pr < pair_hi; pr += 8) {
    const int s = pr >> 2, h = pr & 3;
    for (int qb = jq; qb < 32; qb += per_x) {
      __syncthreads();
      for (int i = tid; i < 257; i += NTHREADS) {
        const int rel = i - 128, n = rel < 0 ? -rel : rel;
        int bk = n < 8 ? n : (n <= 11 ? 8 : (n <= 15 ? 9 : (n <= 22 ? 10 : (n <= 31 ? 11 : (n <= 45 ? 12 : (n <= 63 ? 13 : (n <= 90 ? 14 : 15)))))));
        if (rel > 0) bk += 16;
        tab[i] = relb[bk * 4 + h] * LOG2E;
      }
      const int q0 = qb * 256 + wid * 32;
      const size_t tokbase = (size_t)s * T;
      float* osv = OSV + ((size_t)bid * 512 + tid) * 64;
#pragma unroll 1
      for (int c = 0; c < 2; ++c) {
        bf16x8 Q[4];
        { const u16* qp = PB + (tokbase + q0 + qi) * 1024 + h * 128 + c * 64 + g * 8;
#pragma unroll
          for (int ks = 0; ks < 4; ++ks) Q[ks] = *(const bf16x8*)(qp + ks * 16); }
        f32x16 O[4];
#pragma unroll
        for (int eb = 0; eb < 4; ++eb)
#pragma unroll
          for (int i = 0; i < 16; ++i) O[eb][i] = 0.f;
        float mrun = -1e30f, lrun = 0.f;
        const u16* kg = PB + (tokbase + (tid >> 3)) * 1024 + 512 + h * 128 + c * 64 + (tid & 7) * 8;
        const u16* vg = VT + ((size_t)((s * 4 + h) * 128 + (tid >> 2))) * T + (tid & 3) * 16;
        const unsigned kl = (tid >> 3) * KROW + (tid & 7) * 16, vl = KBUF + (tid >> 2) * VROW + (tid & 3) * 32;
        u32x4 rk0, rv0, rv1;
        rk0 = *(const u32x4*)(kg); rv0 = *(const u32x4*)(vg); rv1 = *(const u32x4*)(vg + 8);
        __syncthreads();
        *(LAS u32x4*)(lds + kl) = rk0; *(LAS u32x4*)(lds + vl) = rv0; *(LAS u32x4*)(lds + vl + 16) = rv1;
        __syncthreads();
        auto compute_tile = [&](const int kt, LAS unsigned char* buf) {
          const int kmin = kt * 64;
          const int dlo = kmin + 63 - q0, dhi = kmin - (q0 + 31);
          const int bmode = dlo <= -91 ? 0 : (dhi >= 91 ? 1 : 2);
          const float bconst = bmode == 0 ? tab[0] : tab[256];
          f32x16 S[2];
          {
            bf16x8 kf[2][4];
#pragma unroll
            for (int kb = 0; kb < 2; ++kb)
#pragma unroll
              for (int ks = 0; ks < 4; ++ks) kf[kb][ks] = *(const LAS bf16x8*)(buf + (kb * 32 + m_sw) * KROW + (ks * 16 + g * 8) * 2);
            __builtin_amdgcn_sched_barrier(0);
#pragma unroll
            for (int kb = 0; kb < 2; ++kb) {
#pragma unroll
              for (int i = 0; i < 16; ++i) S[kb][i] = 0.f;
#pragma unroll
              for (int ks = 0; ks < 4; ++ks) S[kb] = __builtin_amdgcn_mfma_f32_32x32x16_bf16(kf[kb][ks], Q[ks], S[kb], 0, 0, 0);
            }
          }
          bf16x8 vf[2][4];
          float sc = c1, off = bconst;
          if (bmode == 2) {
#pragma unroll
            for (int kb = 0; kb < 2; ++kb)
#pragma unroll
              for (int r = 0; r < 16; ++r) {
                int rel = kmin + kb * 32 + 16 * (r >> 3) + 8 * g + (r & 7) - (q0 + qi);
                rel = rel < -128 ? -128 : (rel > 128 ? 128 : rel);
                S[kb][r] = S[kb][r] * c1 + tab[rel + 128];
              }
            sc = 1.f; off = 0.f;
          }
          float mx = -3e38f;
#pragma unroll
          for (int kb = 0; kb < 2; ++kb)
#pragma unroll
            for (int r = 0; r < 16; ++r) mx = fmaxf(mx, S[kb][r]);
          mx = fmaxf(mx, __shfl_xor(mx, 32));
          mx = mx * sc + off;
          if (__any(mx > mrun + 8.f)) {
            const float mnew = mx > mrun + 8.f ? mx : mrun;
            const float alpha = __builtin_amdgcn_exp2f(mrun - mnew);
            mrun = mnew; lrun *= alpha;
#pragma unroll
            for (int eb = 0; eb < 4; ++eb)
#pragma unroll
              for (int i = 0; i < 16; ++i) O[eb][i] *= alpha;
          }
          const float sh = off - mrun;
          float psum = 0.f;
#pragma unroll
          for (int kb = 0; kb < 2; ++kb)
#pragma unroll
            for (int r = 0; r < 16; ++r) { const float pv = __builtin_amdgcn_exp2f(S[kb][r] * sc + sh); S[kb][r] = pv; psum += pv; }
          lrun += psum;
          __builtin_amdgcn_sched_barrier(0);
#pragma unroll
          for (int eb = 0; eb < 4; ++eb) vf[0][eb] = *(const LAS bf16x8*)(buf + KBUF + (eb * 32 + qi) * VROW + (g * 8) * 2);
#pragma unroll
          for (int stp = 0; stp < 4; ++stp) {
            const int kb = stp >> 1, hh = stp & 1;
            if (stp < 3) {
#pragma unroll
              for (int eb = 0; eb < 4; ++eb) vf[(stp + 1) & 1][eb] = *(const LAS bf16x8*)(buf + KBUF + (eb * 32 + qi) * VROW + ((stp + 1) * 16 + g * 8) * 2);
            }
            const bf16x8 pb = pack8(S[kb], hh);
#pragma unroll
            for (int eb = 0; eb < 4; ++eb) O[eb] = __builtin_amdgcn_mfma_f32_32x32x16_bf16(vf[stp & 1][eb], pb, O[eb], 0, 0, 0);
          }
        };
        u32x4 rkB, rvB0, rvB1;
        { const u16* kg2 = kg + (size_t)1 * 64 * 1024; const u16* vg2 = vg + 64;
          rk0 = *(const u32x4*)(kg2); rv0 = *(const u32x4*)(vg2); rv1 = *(const u32x4*)(vg2 + 8);
          const u16* kg3 = kg + (size_t)2 * 64 * 1024; const u16* vg3 = vg + 128;
          rkB = *(const u32x4*)(kg3); rvB0 = *(const u32x4*)(vg3); rvB1 = *(const u32x4*)(vg3 + 8); }
#pragma unroll 1
        for (int kt = 0; kt < 128; kt += 2) {
          LAS unsigned char* buf0 = lds; LAS unsigned char* buf1 = lds + ABUF;
          compute_tile(kt, buf0);
          *(LAS u32x4*)(buf1 + kl) = rk0; *(LAS u32x4*)(buf1 + vl) = rv0; *(LAS u32x4*)(buf1 + vl + 16) = rv1;
          { const int tn = kt + 3 < 128 ? kt + 3 : 127; const u16* kg2 = kg + (size_t)tn * 64 * 1024; const u16* vg2 = vg + tn * 64;
            rk0 = *(const u32x4*)(kg2); rv0 = *(const u32x4*)(vg2); rv1 = *(const u32x4*)(vg2 + 8); }
          __syncthreads();
          compute_tile(kt + 1, buf1);
          *(LAS u32x4*)(buf0 + kl) = rkB; *(LAS u32x4*)(buf0 + vl) = rvB0; *(LAS u32x4*)(buf0 + vl + 16) = rvB1;
          { const int tn = kt + 4 < 128 ? kt + 4 : 127; const u16* kg2 = kg + (size_t)tn * 64 * 1024; const u16* vg2 = vg + tn * 64;
            rkB = *(const u32x4*)(kg2); rvB0 = *(const u32x4*)(vg2); rvB1 = *(const u32x4*)(vg2 + 8); }
          __syncthreads();
        }
        const float lt = lrun + __shfl_xor(lrun, 32);
        asm volatile("" : "+v"(osv));
        if (c == 0) {
          const float i0 = 1.f / lt;
#pragma unroll
          for (int eb = 0; eb < 4; ++eb)
#pragma unroll
            for (int i = 0; i < 16; i += 4) { f32x4 t4; t4[0] = O[eb][i] * i0; t4[1] = O[eb][i + 1] * i0; t4[2] = O[eb][i + 2] * i0; t4[3] = O[eb][i + 3] * i0; *(f32x4*)(osv + eb * 16 + i) = t4; }
        } else {
          const float i1 = scal[0] / lt;
          float ss = 0.f;
#pragma unroll
          for (int eb = 0; eb < 4; ++eb)
#pragma unroll
            for (int i = 0; i < 16; i += 4) { const f32x4 t4 = *(const f32x4*)(osv + eb * 16 + i);
#pragma unroll
              for (int j = 0; j < 4; ++j) { const float o = t4[j] - O[eb][i + j] * i1; O[eb][i + j] = o; ss += o * o; } }
          ss += __shfl_xor(ss, 32);
          const float rs = rsqrtf(ss * (1.f / 128.f) + LN_EPS) * (1.f - lam_init);
          u16* op = PB + (tokbase + q0 + qi) * 1024 + h * 128;
#pragma unroll
          for (int eb = 0; eb < 4; ++eb)
#pragma unroll
            for (int rr = 0; rr < 4; ++rr) {
              const int e = eb * 32 + 8 * rr + 4 * g;
              const f32x4 gg = *(const f32x4*)(subg + e);
              u32x2 pk; pk.x = cvt_pk_bf16(O[eb][4 * rr] * rs * gg[0], O[eb][4 * rr + 1] * rs * gg[1]); pk.y = cvt_pk_bf16(O[eb][4 * rr + 2] * rs * gg[2], O[eb][4 * rr + 3] * rs * gg[3]);
              *(u32x2*)(op + e) = pk;
            }
        }
      }
    }
  }
}

DI float softplusf_(float x) { return fmaxf(x, 0.f) + __logf(1.f + __expf(-fabsf(x))); }
DI void load_bf16x8(const u16* p, float (&o)[8]) {
  const u32x4 v = *(const u32x4*)p;
#pragma unroll
  for (int i = 0; i < 4; ++i) { o[2 * i] = __uint_as_float(v[i] << 16); o[2 * i + 1] = __uint_as_float(v[i] & 0xffff0000u); }
}
DI void shifted8(const u16* PA, size_t row, int t, int col, const float* mu0, const float* mu1, float (&o)[8]) {
  float c[8], pv[8], nx[8];
  load_bf16x8(PA + row * A_COLS + col, c);
  if (t > 0) load_bf16x8(PA + (row - 1) * A_COLS + col, pv); else { for (int i = 0; i < 8; ++i) pv[i] = 0.f; }
  if (t < T - 1) load_bf16x8(PA + (row + 1) * A_COLS + col, nx); else { for (int i = 0; i < 8; ++i) nx[i] = 0.f; }
#pragma unroll
  for (int i = 0; i < 8; ++i) o[i] = c[i] + mu0[col + i] * (pv[i] - c[i]) + mu1[col + i] * (nx[i] - c[i]);
}

DI void vprep_phase(LAS unsigned char* lds, const u16* PA, u16* VV, const float* mu, const float* vdown, const float* vup, const float* v0, int layer) {
  int tid = threadIdx.x; asm volatile("" : "+v"(tid));
  int bid = blockIdx.x, gdim = gridDim.x; asm volatile("" : "+s"(bid), "+s"(gdim));
  const int tok = tid >> 4, j = tid & 15;
  LAS float* vs = (LAS float*)lds;
  LAS float* dd = vs + 32 * 516;
  LAS unsigned* DN = (LAS unsigned*)(dd + 1024);
  LAS unsigned* UP = DN + 512 * 16;
  const float* mu0 = mu; const float* mu1 = mu + A_COLS;
  __syncthreads();
  if (layer != 0) {
    for (int i = tid; i < 512 * 16; i += NTHREADS) { const float2 w2 = *(const float2*)(vdown + 2 * i); DN[i] = cvt_pk_bf16(w2.x, w2.y); }
    for (int i = tid; i < 32 * 256; i += NTHREADS) { const float2 w2 = *(const float2*)(vup + 2 * i); UP[i] = cvt_pk_bf16(w2.x, w2.y); }
  }
  for (int it = bid; it < NT / 32; it += gdim) {
    const size_t row = (size_t)it * 32 + tok; const int t = (int)(row % T);
    __syncthreads();
#pragma unroll 1
    for (int q = 0; q < 4; ++q) {
      const int cc = q * 128 + j * 8;
      float o[8]; shifted8(PA, row, t, OFF_V + cc, mu0, mu1, o);
      if (layer == 0) {
        u32x4 pk; pk.x = cvt_pk_bf16(o[0], o[1]); pk.y = cvt_pk_bf16(o[2], o[3]); pk.z = cvt_pk_bf16(o[4], o[5]); pk.w = cvt_pk_bf16(o[6], o[7]);
        *(u32x4*)(VV + row * 512 + cc) = pk;
      } else {
        *(LAS f32x4*)(vs + tok * 516 + cc) = (f32x4){o[0], o[1], o[2], o[3]}; *(LAS f32x4*)(vs + tok * 516 + cc + 4) = (f32x4){o[4], o[5], o[6], o[7]};
      }
    }
    if (layer == 0) continue;
    __syncthreads();
    {
      float d0 = 0.f, d1 = 0.f;
#pragma unroll 8
      for (int c = 0; c < 512; ++c) { const float x = vs[tok * 516 + c]; const unsigned w2 = DN[c * 16 + j]; d0 += x * __uint_as_float(w2 << 16); d1 += x * __uint_as_float(w2 & 0xffff0000u); }
      dd[tok * 32 + 2 * j] = d0; dd[tok * 32 + 2 * j + 1] = d1;
    }
    __syncthreads();
#pragma unroll 1
    for (int q = 0; q < 4; ++q) {
      const int c0 = q * 128 + j * 8;
      float acc[8];
      { const f32x4 a0 = *(const f32x4*)(v0 + c0), a1 = *(const f32x4*)(v0 + c0 + 4);
#pragma unroll
        for (int i = 0; i < 4; ++i) { acc[i] = a0[i]; acc[4 + i] = a1[i]; } }
#pragma unroll 8
      for (int r = 0; r < 32; ++r) {
        const float dv = dd[tok * 32 + r];
        const u32x4 w8 = *(const LAS u32x4*)(UP + r * 256 + (c0 >> 1));
#pragma unroll
        for (int i = 0; i < 4; ++i) { acc[2 * i] += dv * __uint_as_float(w8[i] << 16); acc[2 * i + 1] += dv * __uint_as_float(w8[i] & 0xffff0000u); }
      }
      float vf[8]; load_bf16x8(VV + row * 512 + c0, vf);
      const f32x4 x0 = *(const LAS f32x4*)(vs + tok * 516 + c0), x1 = *(const LAS f32x4*)(vs + tok * 516 + c0 + 4);
      float o[8];
#pragma unroll
      for (int i = 0; i < 4; ++i) { o[i] = x0[i] + (vf[i] - x0[i]) * sigmoidf_(acc[i]); o[4 + i] = x1[i] + (vf[4 + i] - x1[i]) * sigmoidf_(acc[4 + i]); }
      u32x4 pk; pk.x = cvt_pk_bf16(o[0], o[1]); pk.y = cvt_pk_bf16(o[2], o[3]); pk.z = cvt_pk_bf16(o[4], o[5]); pk.w = cvt_pk_bf16(o[6], o[7]);
      *(u32x4*)(VV + row * 512 + c0) = pk;
    }
  }
}

struct ScanW { const float *mu, *w0, *du, *a0, *iu, *kk_, *ka, *rk; };
constexpr int SC = 32;
DI float quad_sum(float x) {
  x += __builtin_bit_cast(float, __builtin_amdgcn_update_dpp(0, __builtin_bit_cast(int, x), 0xB1, 0xf, 0xf, true));
  x += __builtin_bit_cast(float, __builtin_amdgcn_update_dpp(0, __builtin_bit_cast(int, x), 0x4E, 0xf, 0xf, true));
  return x;
}
#define BFLO(x) __uint_as_float((x) << 16)
#define BFHI(x) __uint_as_float((x) & 0xffff0000u)
DI float tanh_fast(float x) { x = fminf(fmaxf(x, -15.f), 15.f); const float t = __expf(2.f * x); return (t - 1.f) / (t + 1.f); }
DI float shift1(float c, float p, float n, float m0, float m1) { return c + m0 * (p - c) + m1 * (n - c); }
DI void scan_produce(LAS float* buf, LAS float* TW, LAS float* TA, LAS const float* DU, LAS const float* IU, const u16* PA, const u16* VV, float* BON,
                     const ScanW& w, int ptid, int sq, int h, int dir, int t0) {
  const int tok = ptid >> 3, j = ptid & 7;
  const int t = t0 + tok; const size_t row = (size_t)sq * T + t;
  const float* mu0 = w.mu; const float* mu1 = w.mu + A_COLS;
  const int cr = h * 64 + j * 8, ck = OFF_K + cr, cw_ = OFF_WD + dir * 32 + j * 4, ca_ = OFF_AD + dir * 32 + j * 4;
  const u16* pc = PA + row * A_COLS;
  const bool hp = t > 0, hn = t < T - 1;
  {
    const u32x2 w_c = *(const u32x2*)(pc + cw_), a_c = *(const u32x2*)(pc + ca_);
    u32x2 w_p = (u32x2){0u, 0u}, a_p = w_p, w_n = w_p, a_n = w_p;
    if (hp) { w_p = *(const u32x2*)(pc - A_COLS + cw_); a_p = *(const u32x2*)(pc - A_COLS + ca_); }
    if (hn) { w_n = *(const u32x2*)(pc + A_COLS + cw_); a_n = *(const u32x2*)(pc + A_COLS + ca_); }
    const f32x4 mw0 = *(const f32x4*)(mu0 + cw_), mw1 = *(const f32x4*)(mu1 + cw_), ma0 = *(const f32x4*)(mu0 + ca_), ma1 = *(const f32x4*)(mu1 + ca_);
    f32x4 tw, ta;
#pragma unroll
    for (int i = 0; i < 2; ++i) {
      tw[2 * i] = tanh_fast(shift1(BFLO(w_c[i]), BFLO(w_p[i]), BFLO(w_n[i]), mw0[2 * i], mw1[2 * i]));
      tw[2 * i + 1] = tanh_fast(shift1(BFHI(w_c[i]), BFHI(w_p[i]), BFHI(w_n[i]), mw0[2 * i + 1], mw1[2 * i + 1]));
      ta[2 * i] = shift1(BFLO(a_c[i]), BFLO(a_p[i]), BFLO(a_n[i]), ma0[2 * i], ma1[2 * i]);
      ta[2 * i + 1] = shift1(BFHI(a_c[i]), BFHI(a_p[i]), BFHI(a_n[i]), ma0[2 * i + 1], ma1[2 * i + 1]);
    }
    *(LAS f32x4*)(TW + tok * 32 + j * 4) = tw; *(LAS f32x4*)(TA + tok * 32 + j * 4) = ta;
  }
  asm volatile("s_waitcnt lgkmcnt(0)" ::: "memory");
  float wl[8], al[8];
  const int cc = j * 8, cg_ = h * 64 + cc;
  { const f32x4 x0 = *(const f32x4*)(w.w0 + dir * 512 + cg_), x1 = *(const f32x4*)(w.w0 + dir * 512 + cg_ + 4), y0 = *(const f32x4*)(w.a0 + dir * 512 + cg_), y1 = *(const f32x4*)(w.a0 + dir * 512 + cg_ + 4);
#pragma unroll
    for (int q = 0; q < 4; ++q) { wl[q] = x0[q]; wl[4 + q] = x1[q]; al[q] = y0[q]; al[4 + q] = y1[q]; } }
#pragma unroll 2
  for (int rr = 0; rr < 32; ++rr) {
    const float twv = TW[tok * 32 + rr], tav = TA[tok * 32 + rr];
    const f32x4 d0 = *(const LAS f32x4*)(DU + rr * 64 + cc), d1 = *(const LAS f32x4*)(DU + rr * 64 + cc + 4), i0 = *(const LAS f32x4*)(IU + rr * 64 + cc), i1 = *(const LAS f32x4*)(IU + rr * 64 + cc + 4);
#pragma unroll
    for (int q = 0; q < 4; ++q) { wl[q] += twv * d0[q]; wl[4 + q] += twv * d1[q]; al[q] += tav * i0[q]; al[4 + q] += tav * i1[q]; }
  }
#pragma unroll
  for (int q = 0; q < 8; ++q) { asm volatile("" : "+v"(wl[q]), "+v"(al[q])); }
  LAS float* AW = buf; LAS float* AK = buf + 2048; LAS float* AB = buf + 4096; LAS float* AD = buf + 6144; LAS float* AR = buf + 8192; LAS float* AV = buf + 10240;
  const int o = tok * 64 + cc;
  float ss = 0.f, bs = 0.f;
  float ok[8], av[8];
#pragma unroll
  for (int hq = 0; hq < 2; ++hq) {
    const int c4 = 4 * hq;
    const u32x2 r_c = *(const u32x2*)(pc + cr + c4), k_c = *(const u32x2*)(pc + ck + c4);
    u32x2 r_p = (u32x2){0u, 0u}, k_p = r_p, r_n = r_p, k_n = r_p;
    if (hp) { r_p = *(const u32x2*)(pc - A_COLS + cr + c4); k_p = *(const u32x2*)(pc - A_COLS + ck + c4); }
    if (hn) { r_n = *(const u32x2*)(pc + A_COLS + cr + c4); k_n = *(const u32x2*)(pc + A_COLS + ck + c4); }
    const u32x2 v_c = *(const u32x2*)(VV + row * 512 + cr + c4);
    const f32x4 mr0 = *(const f32x4*)(mu0 + cr + c4), mr1 = *(const f32x4*)(mu1 + cr + c4), mk0 = *(const f32x4*)(mu0 + ck + c4), mk1 = *(const f32x4*)(mu1 + ck + c4);
    const f32x4 kk4 = *(const f32x4*)(w.kk_ + cg_ + c4), ka4 = *(const f32x4*)(w.ka + cg_ + c4), rk4 = *(const f32x4*)(w.rk + cg_ + c4);
    f32x4 rv, kv, vv, ow, od;
#pragma unroll
    for (int i = 0; i < 2; ++i) {
      rv[2 * i] = shift1(BFLO(r_c[i]), BFLO(r_p[i]), BFLO(r_n[i]), mr0[2 * i], mr1[2 * i]);
      rv[2 * i + 1] = shift1(BFHI(r_c[i]), BFHI(r_p[i]), BFHI(r_n[i]), mr0[2 * i + 1], mr1[2 * i + 1]);
      kv[2 * i] = shift1(BFLO(k_c[i]), BFLO(k_p[i]), BFLO(k_n[i]), mk0[2 * i], mk1[2 * i]);
      kv[2 * i + 1] = shift1(BFHI(k_c[i]), BFHI(k_p[i]), BFHI(k_n[i]), mk0[2 * i + 1], mk1[2 * i + 1]);
      vv[2 * i] = BFLO(v_c[i]); vv[2 * i + 1] = BFHI(v_c[i]);
    }
#pragma unroll
    for (int q = 0; q < 4; ++q) {
      const float wlog = -softplusf_(-wl[c4 + q]) - 0.5f;
      ow[q] = __expf(-__expf(wlog));
      const float a = sigmoidf_(al[c4 + q]);
      av[c4 + q] = a;
      ok[c4 + q] = kv[q] * kk4[q]; ss += ok[c4 + q] * ok[c4 + q];
      od[q] = kv[q] * (1.f + (a - 1.f) * ka4[q]);
      bs += rv[q] * od[q] * rk4[q];
    }
    *(LAS f32x4*)(AW + o + c4) = ow; *(LAS f32x4*)(AD + o + c4) = od; *(LAS f32x4*)(AR + o + c4) = rv; *(LAS f32x4*)(AV + o + c4) = vv;
  }
#pragma unroll
  for (int sft = 1; sft < 8; sft <<= 1) { ss += __shfl_xor(ss, sft); bs += __shfl_xor(bs, sft); }
  const float rn = rsqrtf(ss + 1e-12f);
#pragma unroll
  for (int hq = 0; hq < 2; ++hq) {
    f32x4 k4, b4;
#pragma unroll
    for (int q = 0; q < 4; ++q) { k4[q] = ok[4 * hq + q] * rn; b4[q] = k4[q] * av[4 * hq + q]; }
    *(LAS f32x4*)(AK + o + 4 * hq) = k4; *(LAS f32x4*)(AB + o + 4 * hq) = b4;
  }
  if (j == 0) BON[((size_t)dir * NT + row) * 8 + h] = bs;
}
struct ScanOps { f32x4 k4[4], w4[4], b4[4], d4[4]; float vi; };
DI void scan_load(ScanOps& o, LAS const float* buf, int tt, int jseg, int irow) {
  const int off = tt * 64 + jseg * 16;
#pragma unroll
  for (int q = 0; q < 4; ++q) {
    o.w4[q] = *(const LAS f32x4*)(buf + off + q * 4); o.k4[q] = *(const LAS f32x4*)(buf + 2048 + off + q * 4); o.b4[q] = *(const LAS f32x4*)(buf + 4096 + off + q * 4);
    o.d4[q] = *(const LAS f32x4*)(buf + 6144 + off + q * 4);
  }
  o.vi = buf[10240 + tt * 64 + irow];
}
DI float scan_step(f32x4 (&S)[4], const ScanOps& o, LAS const float* buf, int tt, int jseg) {
  f32x4 r4[4];
#pragma unroll
  for (int q = 0; q < 4; ++q) r4[q] = *(const LAS f32x4*)(buf + 8192 + tt * 64 + jseg * 16 + q * 4);
  f32x4 a4 = S[0] * o.k4[0] + S[1] * o.k4[1] + S[2] * o.k4[2] + S[3] * o.k4[3];
  float sa = -quad_sum((a4[0] + a4[1]) + (a4[2] + a4[3]));
  f32x4 y4 = (f32x4){0.f, 0.f, 0.f, 0.f};
#pragma unroll
  for (int q = 0; q < 4; ++q) { S[q] = S[q] * o.w4[q] + (o.b4[q] * sa + o.d4[q] * o.vi); y4 += S[q] * r4[q]; }
  return quad_sum((y4[0] + y4[1]) + (y4[2] + y4[3]));
}
DI void scan_phase(LAS unsigned char* lds, const u16* PA, const u16* VV, u16* YY, float* BON, const ScanW w) {
  int tid = threadIdx.x; asm volatile("" : "+v"(tid));
  int bid = blockIdx.x, gdim = gridDim.x; asm volatile("" : "+s"(bid), "+s"(gdim));
  LAS float* BUF = (LAS float*)lds;
  LAS float* AY = BUF + 2 * 12288;
  LAS float* TW = AY + 2 * 2048;
  LAS float* TA = TW + SC * 32;
  LAS float* DU = TA + SC * 32;
  LAS float* IU = DU + 2048;
  const int wid = __builtin_amdgcn_readfirstlane(tid >> 6), lane = tid & 63;
  const int NCH = T / SC;
  for (int item = bid; item < 192; item += gdim) {
    const int dir = item & 1, h = (item >> 1) & 7, sq = item >> 4;
    __syncthreads();
    for (int i = tid; i < 2048; i += NTHREADS) { const int rr = i >> 6, c = i & 63; DU[i] = w.du[(dir * 32 + rr) * 512 + h * 64 + c]; IU[i] = w.iu[(dir * 32 + rr) * 512 + h * 64 + c]; }
    __syncthreads();
    f32x4 S[4];
#pragma unroll
    for (int q = 0; q < 4; ++q) S[q] = (f32x4){0.f, 0.f, 0.f, 0.f};
    const int irow = (wid & 3) * 16 + (lane >> 2), jseg = lane & 3;
    if (wid >= 4) scan_produce(BUF, TW, TA, DU, IU, PA, VV, BON, w, tid - 256, sq, h, dir, dir == 0 ? 0 : T - SC);
    __syncthreads();
#pragma unroll 1
    for (int ci = 0; ci < NCH; ++ci) {
      LAS float* buf = BUF + (ci & 1) * 12288;
      LAS float* ay = AY + (ci & 1) * 2048;
      if (wid < 4) {
        ScanOps o0, o1;
        scan_load(o0, buf, dir == 0 ? 0 : SC - 1, jseg, irow);
#pragma unroll 1
        for (int st = 0; st < SC; st += 2) {
          const int t0_ = dir == 0 ? st : SC - 1 - st, t1_ = dir == 0 ? st + 1 : SC - 2 - st;
          scan_load(o1, buf, t1_, jseg, irow);
          const float y0 = scan_step(S, o0, buf, t0_, jseg);
          if (jseg == 0) ay[t0_ * 64 + irow] = y0;
          if (st + 2 < SC) scan_load(o0, buf, dir == 0 ? st + 2 : SC - 3 - st, jseg, irow);
          const float y1 = scan_step(S, o1, buf, t1_, jseg);
          if (jseg == 0) ay[t1_ * 64 + irow] = y1;
        }
      } else {
        const int ptid = tid - 256;
        if (ci + 1 < NCH) scan_produce(BUF + ((ci + 1) & 1) * 12288, TW, TA, DU, IU, PA, VV, BON, w, ptid, sq, h, dir, dir == 0 ? (ci + 1) * SC : T - SC * (ci + 2));
        if (ci > 0) {
          LAS const float* py = AY + ((ci - 1) & 1) * 2048;
          const int t0p = dir == 0 ? (ci - 1) * SC : T - SC * ci;
          const int tok = ptid >> 3, c0 = (ptid & 7) * 8;
          const f32x4 ya = *(const LAS f32x4*)(py + tok * 64 + c0), yb = *(const LAS f32x4*)(py + tok * 64 + c0 + 4);
          u32x4 pk; pk.x = cvt_pk_bf16(ya[0], ya[1]); pk.y = cvt_pk_bf16(ya[2], ya[3]); pk.z = cvt_pk_bf16(yb[0], yb[1]); pk.w = cvt_pk_bf16(yb[2], yb[3]);
          *(u32x4*)(YY + ((size_t)dir * NT + (size_t)sq * T + t0p + tok) * 512 + h * 64 + c0) = pk;
        }
      }
      __syncthreads();
    }
    if (wid >= 4) {
      const int ptid = tid - 256;
      LAS const float* py = AY + ((NCH - 1) & 1) * 2048;
      const int t0p = dir == 0 ? (NCH - 1) * SC : 0;
      const int tok = ptid >> 3, c0 = (ptid & 7) * 8;
      const f32x4 ya = *(const LAS f32x4*)(py + tok * 64 + c0), yb = *(const LAS f32x4*)(py + tok * 64 + c0 + 4);
      u32x4 pk; pk.x = cvt_pk_bf16(ya[0], ya[1]); pk.y = cvt_pk_bf16(ya[2], ya[3]); pk.z = cvt_pk_bf16(yb[0], yb[1]); pk.w = cvt_pk_bf16(yb[2], yb[3]);
      *(u32x4*)(YY + ((size_t)dir * NT + (size_t)sq * T + t0p + tok) * 512 + h * 64 + c0) = pk;
    }
  }
}

DI void post_phase(LAS unsigned char* lds, u16* PA, const u16* PB, const u16* VV, const u16* YY, const float* BON, const float* mu, const float* gup, const float* gng, const float* gnb) {
  int tid = threadIdx.x; asm volatile("" : "+v"(tid));
  int bid = blockIdx.x, gdim = gridDim.x; asm volatile("" : "+s"(bid), "+s"(gdim));
  const int tok = tid >> 4, j = tid & 15;
  LAS float* sg = (LAS float*)lds;
  LAS unsigned* GU = (LAS unsigned*)(lds + 16384);
  const float* mu0 = mu; const float* mu1 = mu + A_COLS;
  __syncthreads();
  for (int i = tid; i < 96 * 256; i += NTHREADS) { const float2 w2 = *(const float2*)(gup + 2 * i); GU[i] = cvt_pk_bf16(w2.x, w2.y); }
  for (int it = bid; it < NT / 32; it += gdim) {
    const size_t row = (size_t)it * 32 + tok; const int t = (int)(row % T);
    __syncthreads();
#pragma unroll
    for (int q = 0; q < 6; ++q) {
      const int col = OFF_GD + j * 6 + q;
      const float c = bf2f(PA[row * A_COLS + col]);
      const float pv = t > 0 ? bf2f(PA[(row - 1) * A_COLS + col]) : 0.f, nx = t < T - 1 ? bf2f(PA[(row + 1) * A_COLS + col]) : 0.f;
      sg[tok * 96 + j * 6 + q] = sigmoidf_(c + mu0[col] * (pv - c) + mu1[col] * (nx - c));
    }
    __syncthreads();
#pragma unroll 1
    for (int q = 0; q < 4; ++q) {
      const int cc = q * 128 + j * 8, h = 2 * q + (j >> 3);
      float y[8]; float sm = 0.f;
      { float a[8], b[8]; load_bf16x8(YY + row * 512 + cc, a); load_bf16x8(YY + ((size_t)NT + row) * 512 + cc, b);
#pragma unroll
        for (int i = 0; i < 8; ++i) { y[i] = a[i] + b[i]; sm += y[i]; } }
      sm += __shfl_xor(sm, 1); sm += __shfl_xor(sm, 2); sm += __shfl_xor(sm, 4);
      const float mean = sm * (1.f / 64.f);
      float vq = 0.f;
#pragma unroll
      for (int i = 0; i < 8; ++i) { y[i] -= mean; vq += y[i] * y[i]; }
      vq += __shfl_xor(vq, 1); vq += __shfl_xor(vq, 2); vq += __shfl_xor(vq, 4);
      const float rs = rsqrtf(vq * (1.f / 64.f) + GN_EPS);
      const float bon = BON[row * 8 + h] + BON[((size_t)NT + row) * 8 + h];
      float gacc[8];
#pragma unroll
      for (int i = 0; i < 8; ++i) gacc[i] = 0.f;
#pragma unroll 8
      for (int r = 0; r < 96; ++r) {
        const float sv = sg[tok * 96 + r];
        const u32x4 w8 = *(const LAS u32x4*)(GU + r * 256 + (cc >> 1));
#pragma unroll
        for (int i = 0; i < 4; ++i) { gacc[2 * i] += sv * __uint_as_float(w8[i] << 16); gacc[2 * i + 1] += sv * __uint_as_float(w8[i] & 0xffff0000u); }
      }
      float vv[8]; load_bf16x8(VV + row * 512 + cc, vv);
      const f32x4 g0 = *(const f32x4*)(gng + cc), g1 = *(const f32x4*)(gng + cc + 4), b0 = *(const f32x4*)(gnb + cc), b1 = *(const f32x4*)(gnb + cc + 4);
      float o[8];
#pragma unroll
      for (int i = 0; i < 4; ++i) { o[i] = (y[i] * rs * g0[i] + b0[i] + bon * vv[i]) * gacc[i]; o[4 + i] = (y[4 + i] * rs * g1[i] + b1[i] + bon * vv[4 + i]) * gacc[4 + i]; }
      u32x4 pk; pk.x = cvt_pk_bf16(o[0], o[1]); pk.y = cvt_pk_bf16(o[2], o[3]); pk.z = cvt_pk_bf16(o[4], o[5]); pk.w = cvt_pk_bf16(o[6], o[7]);
      if (DBGZ & 1) pk = (u32x4){0u, 0u, 0u, 0u};
      *(u32x4*)(PA + row * A_COLS + cc) = pk;
      u32x4 pb4 = *(const u32x4*)(PB + row * 1024 + cc); if (DBGZ & 2) pb4 = (u32x4){0u, 0u, 0u, 0u};
      *(u32x4*)(PA + row * A_COLS + 512 + cc) = pb4;
    }
  }
}

DI unsigned hashu(unsigned x) { x ^= x >> 16; x *= 0x7feb352du; x ^= x >> 15; x *= 0x846ca68bu; x ^= x >> 16; return x; }
DI void dbg_upd(float* slot, float got, float ref, float scale) { float e = fabsf(got - ref) / scale; if (!(e == e)) e = 1e9f; atomicMax((unsigned*)slot, __float_as_uint(e)); }
DI float tshift(const u16* PA, size_t row, int col, const float* mu) {
  const int t = (int)(row % T);
  const float c = bf2f(PA[row * A_COLS + col]);
  const float pv = t > 0 ? bf2f(PA[(row - 1) * A_COLS + col]) : 0.f, nx = t < T - 1 ? bf2f(PA[(row + 1) * A_COLS + col]) : 0.f;
  return c + mu[col] * (pv - c) + mu[A_COLS + col] * (nx - c);
}
DI void chk_proj(const u16* XB, const float* win, const u16* PA, const u16* PB, const u16* VT, float* slot) {
  const int gt = blockIdx.x * NTHREADS + threadIdx.x;
  if (gt >= 4096) return;
  const int row = hashu(gt * 2 + 1) % NT, col = hashu(gt * 2 + 2) % P_COLS;
  float ref = 0.f;
  for (int k = 0; k < D; ++k) ref += bf2f(XB[(size_t)row * D + k]) * win[(size_t)k * P_COLS + col];
  float got;
  if (col < A_COLS) got = bf2f(PA[(size_t)row * A_COLS + col]);
  else if (col < A_COLS + 1024) got = bf2f(PB[(size_t)row * 1024 + col - A_COLS]);
  else { const int c2 = col - A_COLS - 1024, h = c2 >> 7, e = c2 & 127, sq = row / T, t = row % T; got = bf2f(VT[((size_t)((sq * 4 + h) * 128 + e)) * T + t]); }
  dbg_upd(slot, got, ref, 1.f);
}
DI void chk_ffn(const u16* XB, const float* wup, const float* cw, const float* cb, const u16* G, float* slot) {
  const int gt = blockIdx.x * NTHREADS + threadIdx.x;
  if (gt >= 4096) return;
  int row = hashu(gt * 2 + 11) % NT; const int n = hashu(gt * 2 + 12) % DFF;
  if (gt < 64) row = (gt & 1) ? (row / T) * T + T - 1 : (row / T) * T;
  else if (gt < 1024) row = (row / T) * T + ((row % T) / 254) * 254 + (gt & 1 ? 253 : 0), row = row >= NT ? NT - 1 : row;
  const int t = row % T;
  float hg[3] = {0.f, 0.f, 0.f}, hu[3] = {0.f, 0.f, 0.f};
#pragma unroll
  for (int d = -1; d <= 1; ++d) {
    float a = 0.f, b = 0.f;
    if (!(t + d < 0 || t + d > T - 1))
      for (int k = 0; k < D; ++k) { const float x = bf2f(XB[(size_t)(row + d) * D + k]); a += x * wup[(size_t)k * NUP + n]; b += x * wup[(size_t)k * NUP + DFF + n]; }
    hg[d + 1] = a; hu[d + 1] = b;
  }
  const float got = bf2f(G[(size_t)row * DFF + n]);
  { const float g = cw[n] * hg[0] + cw[NUP + n] * hg[1] + cw[2 * NUP + n] * hg[2] + cb[n];
    const float u = cw[DFF + n] * hu[0] + cw[NUP + DFF + n] * hu[1] + cw[2 * NUP + DFF + n] * hu[2] + cb[DFF + n];
    dbg_upd(slot, got, 0.5f * g * (1.f + erff(g * 0.70710678f)) * u, 1.f); }
  { const float g = cw[n] * hg[2] + cw[NUP + n] * hg[1] + cw[2 * NUP + n] * hg[0] + cb[n];
    const float u = cw[DFF + n] * hu[2] + cw[NUP + DFF + n] * hu[1] + cw[2 * NUP + DFF + n] * hu[0] + cb[DFF + n];
    dbg_upd(slot + 1, got, 0.5f * g * (1.f + erff(g * 0.70710678f)) * u, 1.f); }
  { const float g = cw[NUP + n] * hg[1] + cb[n];
    const float u = cw[NUP + DFF + n] * hu[1] + cb[DFF + n];
    dbg_upd(slot + 2, got, 0.5f * g * (1.f + erff(g * 0.70710678f)) * u, 1.f); }
}
DI void chk_attn(LAS unsigned char* lds, const u16* XB, const float* win, const u16* PB, const u16* VT, const float* lamp, const float* subg, const float* relb, int layer, float* slot) {
  if (blockIdx.x >= 16) return;
  const int tid = threadIdx.x;
  LAS float* qv = (LAS float*)lds;
  LAS float* sc = qv + 128;
  LAS float* red = sc + 16384;
  LAS float* ov = red + 1024;
  const int smp = blockIdx.x;
  const int sq = hashu(smp + 77) % NSEQ, h = smp & 3;
  int q = hashu(smp + 99) % T; if (smp < 4) q = smp * 37; if (smp >= 12) q = T - 1 - (smp - 12) * 50;
  const size_t row = (size_t)sq * T + q;
  __syncthreads();
  if (tid < 128) { float a = 0.f; const int col = A_COLS + h * 128 + tid; for (int k = 0; k < D; ++k) a += bf2f(XB[row * D + k]) * win[(size_t)k * P_COLS + col]; qv[tid] = a; }
  __syncthreads();
  float mx0 = -1e30f, mx1 = -1e30f;
  for (int key = tid; key < T; key += NTHREADS) {
    const u16* kp = PB + ((size_t)sq * T + key) * 1024 + 512 + h * 128;
    float s0 = 0.f, s1 = 0.f;
    for (int d = 0; d < 64; ++d) { s0 += qv[d] * bf2f(kp[d]); s1 += qv[64 + d] * bf2f(kp[64 + d]); }
    const int rel = key - q, n = rel < 0 ? -rel : rel;
    int bk;
    if (n < 8) bk = n; else { bk = 8 + (int)(logf((float)n / 8.f) / logf(16.f) * 8.f); bk = bk > 15 ? 15 : bk; }
    if (rel > 0) bk += 16;
    const float bias = relb[bk * 4 + h];
    s0 = s0 * 0.125f + bias; s1 = s1 * 0.125f + bias;
    sc[key] = s0; sc[8192 + key] = s1; mx0 = fmaxf(mx0, s0); mx1 = fmaxf(mx1, s1);
  }
  red[tid] = mx0; red[512 + tid] = mx1; __syncthreads();
  for (int o = 256; o > 0; o >>= 1) { if (tid < o) { red[tid] = fmaxf(red[tid], red[tid + o]); red[512 + tid] = fmaxf(red[512 + tid], red[512 + tid + o]); } __syncthreads(); }
  mx0 = red[0]; mx1 = red[512]; __syncthreads();
  float l0 = 0.f, l1 = 0.f;
  for (int key = tid; key < T; key += NTHREADS) { const float p0 = expf(sc[key] - mx0), p1 = expf(sc[8192 + key] - mx1); sc[key] = p0; sc[8192 + key] = p1; l0 += p0; l1 += p1; }
  red[tid] = l0; red[512 + tid] = l1; __syncthreads();
  for (int o = 256; o > 0; o >>= 1) { if (tid < o) { red[tid] += red[tid + o]; red[512 + tid] += red[512 + tid + o]; } __syncthreads(); }
  l0 = red[0]; l1 = red[512]; __syncthreads();
  float la = 0.f, lb = 0.f; for (int d = 0; d < 64; ++d) { la += lamp[d] * lamp[64 + d]; lb += lamp[128 + d] * lamp[192 + d]; }
  const float lam_init = 0.8f - 0.6f * expf(-0.3f * (float)layer);
  const float lam = expf(la) - expf(lb) + lam_init;
  { const int e = tid & 127, part = tid >> 7;
    const u16* vp = VT + ((size_t)((sq * 4 + h) * 128 + e)) * T;
    float o = 0.f;
    for (int key = part * 2048; key < (part + 1) * 2048; ++key) o += (sc[key] / l0 - lam * sc[8192 + key] / l1) * bf2f(vp[key]);
    red[tid] = o; }
  __syncthreads();
  if (tid < 128) ov[tid] = red[tid] + red[128 + tid] + red[256 + tid] + red[384 + tid];
  __syncthreads();
  if (tid < 128) {
    float ss = 0.f; for (int e = 0; e < 128; ++e) ss += ov[e] * ov[e];
    const float ref = ov[tid] * rsqrtf(ss / 128.f + LN_EPS) * subg[tid] * (1.f - lam_init);
    dbg_upd(slot, bf2f(PB[row * 1024 + h * 128 + tid]), ref, 1.f);
  }
}
struct ChkOp { float r, kd, kk, b, w, v; };
DI ChkOp chk_ops(const u16* PA, const u16* VV, const ScanW& w, size_t row, int h, int dir, int c, LAS float* tmp  , int tid) {
  ChkOp o;
  const int cg_ = h * 64 + c;
  o.r = tshift(PA, row, cg_, w.mu);
  const float k = tshift(PA, row, OFF_K + cg_, w.mu);
  float wl = w.w0[dir * 512 + cg_], al = w.a0[dir * 512 + cg_];
#pragma unroll 1
  for (int rr = 0; rr < 32; ++rr) {
    wl += tanhf(tshift(PA, row, OFF_WD + dir * 32 + rr, w.mu)) * w.du[(dir * 32 + rr) * 512 + cg_];
    al += tshift(PA, row, OFF_AD + dir * 32 + rr, w.mu) * w.iu[(dir * 32 + rr) * 512 + cg_];
  }
  const float sp = logf(1.f + expf(-wl));
  o.w = expf(-expf(-sp - 0.5f));
  const float a = 1.f / (1.f + expf(-al));
  const float kkv = k * w.kk_[cg_];
  __syncthreads(); tmp[tid] = kkv * kkv; __syncthreads();
  float ss = 0.f;
#pragma unroll 1
  for (int j = 0; j < 64; ++j) ss += tmp[j];
  o.kk = kkv * rsqrtf(ss + 1e-12f);
  o.kd = k * (1.f + (a - 1.f) * w.ka[cg_]);
  o.b = o.kk * a;
  o.v = bf2f(VV[row * 512 + cg_]);
  return o;
}
DI void chk_scan(LAS unsigned char* lds, const u16* PA, const u16* VV, const u16* YY, const float* BON, const ScanW w, float* slot) {
  if (blockIdx.x >= 48 || threadIdx.x >= 64) return;
  const int tid = threadIdx.x;
  LAS float* tmp = (LAS float*)lds; LAS float* red = tmp + 64;
  const int item = blockIdx.x * 4 + 1, dir = item & 1, h = (item >> 1) & 7, sq = item >> 4;
  const int t0 = dir == 0 ? 0 : T - 1, t1 = dir == 0 ? 1 : T - 2;
  const size_t row0 = (size_t)sq * T + t0, row1 = (size_t)sq * T + t1;
  const ChkOp a = chk_ops(PA, VV, w, row0, h, dir, tid, tmp, tid);
  const ChkOp b = chk_ops(PA, VV, w, row1, h, dir, tid, tmp, tid);
#define BSUM(dst, val) { __syncthreads(); red[tid] = (val); __syncthreads(); float sx_ = 0.f; _Pragma("unroll 1") for (int j_ = 0; j_ < 64; ++j_) sx_ += red[j_]; dst = sx_; }
  float ds0, ds1, ds2, ds3, ds4;
  BSUM(ds0, a.kd * a.r) BSUM(ds1, a.kd * b.w * b.r) BSUM(ds2, a.kd * (-b.kk)) BSUM(ds3, b.b * b.r) BSUM(ds4, b.kd * b.r)
  const float y0 = a.v * ds0;
  const float y1 = a.v * (ds1 + ds2 * ds3) + b.v * ds4;
  dbg_upd(slot, bf2f(YY[((size_t)dir * NT + row0) * 512 + h * 64 + tid]), y0, fabsf(y0) + 0.05f);
  dbg_upd(slot, bf2f(YY[((size_t)dir * NT + row1) * 512 + h * 64 + tid]), y1, fabsf(y1) + 0.05f);
  float bq = a.r * a.kd * w.rk[h * 64 + tid];
  __syncthreads(); red[tid] = bq; __syncthreads(); float bs = 0.f;
#pragma unroll 1
  for (int j = 0; j < 64; ++j) bs += red[j];
  dbg_upd(slot, BON[((size_t)dir * NT + row0) * 8 + h], bs, fabsf(bs) + 0.05f);
}
DI void chk_post(const u16* PA, const u16* PB, const u16* VV, const u16* YY, const float* BON, const float* mu, const float* gup, const float* gng, const float* gnb, float* slot) {
  const int gt = blockIdx.x * NTHREADS + threadIdx.x;
  if (gt >= 2048) return;
  const size_t row = hashu(gt * 2 + 21) % NT; const int c = hashu(gt * 2 + 22) % 512, h = c >> 6;
  float sm = 0.f;
  float yc = 0.f;
  for (int i = 0; i < 64; ++i) { const float y = bf2f(YY[row * 512 + h * 64 + i]) + bf2f(YY[((size_t)NT + row) * 512 + h * 64 + i]); sm += y; if (h * 64 + i == c) yc = y; }
  const float mean = sm / 64.f; float vq = 0.f;
  for (int i = 0; i < 64; ++i) { const float y = bf2f(YY[row * 512 + h * 64 + i]) + bf2f(YY[((size_t)NT + row) * 512 + h * 64 + i]) - mean; vq += y * y; }
  const float yn = (yc - mean) * rsqrtf(vq / 64.f + GN_EPS) * gng[c] + gnb[c];
  const float bon = (BON[row * 8 + h] + BON[((size_t)NT + row) * 8 + h]) * bf2f(VV[row * 512 + c]);
  float g = 0.f;
  for (int r = 0; r < 96; ++r) g += (1.f / (1.f + expf(-tshift(PA, row, OFF_GD + r, mu)))) * gup[r * 512 + c];
  const float ref = (yn + bon) * g;
  dbg_upd(slot, bf2f(PA[row * A_COLS + c]), ref, fabsf(ref) + 0.05f);
  dbg_upd(slot + 1, bf2f(PA[row * A_COLS + 512 + c]), bf2f(PB[row * 1024 + c]), 1.f);
}

__global__ __launch_bounds__(NTHREADS, 2) void mega(Params p_unused) {
  extern __shared__ __attribute__((aligned(16))) char shm[];
  cg::grid_group grid = cg::this_grid();
  LAS unsigned char* lds = (LAS unsigned char*)shm;
#define WS_PTRS CParams p = get_params(); unsigned char* ws = p->ws; \
  u16* WIN = (u16*)(ws + OFF_WIN); u16* WOUT = (u16*)(ws + OFF_WOUT); u16* WUP = (u16*)(ws + OFF_WUP); u16* WDN = (u16*)(ws + OFF_WDN); \
  u16* XB = (u16*)(ws + OFF_XB); u16* PA = (u16*)(ws + OFF_PA); u16* PB = (u16*)(ws + OFF_PB); u16* VT = (u16*)(ws + OFF_VT); \
  u16* G = (u16*)(ws + OFF_PA); u16* VV = (u16*)(ws + OFF_VV); u16* YY = (u16*)p->out; float* BON = (float*)(ws + OFF_BON); float* XF = p->out; \
  (void)WIN; (void)WOUT; (void)WUP; (void)WDN; (void)XB; (void)PA; (void)PB; (void)VT; (void)G; (void)VV; (void)YY; (void)BON; (void)XF;
  int ph = 0;
  const int ph_lo = get_params()->ph_lo, ph_hi = get_params()->ph_hi;
#ifndef ONLYMASK
#define ONLYMASK 0xffffffffu
#endif
#define PHASE_BEGIN if (((ONLYMASK >> (__COUNTER__ % 32)) & 1u) && ph >= ph_lo && ph < ph_hi) { WS_PTRS
#define PHASE_END } ++ph; if (ph > ph_lo && ph < ph_hi) grid.sync();

  PHASE_BEGIN
    for (int l = 0; l < 2; ++l) {
      convert_weight<0>(shm, p->in[4] + (size_t)l * D * P_COLS, WIN + (size_t)l * NPROJ * D, D, P_COLS, NPROJ, blockIdx.x, gridDim.x);
      convert_weight<1>(shm, p->in[22] + (size_t)l * D * D, WOUT + (size_t)l * D * D, D, D, D, blockIdx.x, gridDim.x);
      convert_weight<2>(shm, p->in[25] + (size_t)l * D * NUP, WUP + (size_t)l * NUP * D, D, NUP, NUP, blockIdx.x, gridDim.x);
      convert_weight<1>(shm, p->in[28] + (size_t)l * DFF * D, WDN + (size_t)l * D * DFF, DFF, D, D, blockIdx.x, gridDim.x);
    }
    ln_rows(p->in[0], p->in[1], NPROMPT_TOK, XF, XB, p->in[2], p->in[3], false);
  PHASE_END

#pragma unroll 1
  for (int l = 0; l < 2; ++l) {
    PHASE_BEGIN
      Gemm ga{XB, D, WIN + (size_t)l * NPROJ * D, D};
      EpiArgs ea{}; ea.pa = PA; ea.pb = PB; ea.vt = VT;
      gemm_phase<0, 0>(lds, ga, NT / 256, NPROJ / 256, ea);
#if PROBE_GEMM
      gemm_phase<0, 0>(lds, ga, NT / 256, NPROJ / 256, ea);
#endif
    PHASE_END
#pragma unroll 1
    for (int rnd = 0; rnd < 2; ++rnd) {
      if (ph >= ph_lo && ph < ph_hi) { WS_PTRS
        int bidu = blockIdx.x, gdu = gridDim.x; asm volatile("" : "+s"(bidu), "+s"(gdu));
        const bool split = (gdu == 256);
        if (rnd == 0) vprep_phase(lds, PA, VV, p->in[5] + (size_t)l * 2 * A_COLS, p->in[16], p->in[17], p->in[18], l);
        if (rnd == 1 && (!split || bidu < 192)) {
          ScanW sw; sw.mu = p->in[5] + (size_t)l * 2 * A_COLS; sw.w0 = p->in[6] + l * 1024; sw.du = p->in[7] + (size_t)l * 2 * 32 * 512; sw.a0 = p->in[8] + l * 1024;
          sw.iu = p->in[9] + (size_t)l * 2 * 32 * 512; sw.kk_ = p->in[11] + l * 512; sw.ka = p->in[12] + l * 512; sw.rk = p->in[13] + l * 512;
          scan_phase(lds, PA, VV, YY, BON, sw);
        } else if (rnd == 0 || split) {
          const int plo = rnd == 0 ? 0 : 40, phi = (rnd == 0 && split) ? 40 : 48;
          const int wlo = rnd == 0 ? 0 : 192, wcnt = rnd == 0 ? (gdu & ~7) : 64;
          attn_phase(lds, PB, VT, (float*)(ws + OFF_OSV), p->in[19] + l * 256, p->in[20] + l * 128, p->in[21], l, plo, phi, wlo, wcnt);
        }
      }
      ++ph; if (ph > ph_lo && ph < ph_hi) grid.sync();
    }
    PHASE_BEGIN
      post_phase(lds, PA, PB, VV, YY, BON, p->in[5] + (size_t)l * 2 * A_COLS, p->in[10] + (size_t)l * 96 * 512, p->in[14] + l * 512, p->in[15] + l * 512);
#if PROBE_MISC
      post_phase(lds, PA, PB, VV, YY, BON, p->in[5] + (size_t)l * 2 * A_COLS, p->in[10] + (size_t)l * 96 * 512, p->in[14] + l * 512, p->in[15] + l * 512);
#endif
    PHASE_END
    PHASE_BEGIN
      Gemm ga{PA, A_COLS, WOUT + (size_t)l * D * D, D};
      EpiArgs ea{}; ea.xf = XF; ea.xb = XB;
      gemm_phase<1, 0>(lds, ga, NT / 256, D / 256, ea);
    PHASE_END
    PHASE_BEGIN
      ln_rows(XF, XF, NT, XF, XB, p->in[23] + l * D, p->in[24] + l * D, false);
    PHASE_END
    PHASE_BEGIN
      Gemm ga{XB, D, WUP + (size_t)l * NUP * D, D};
      EpiArgs ea{}; ea.g = G; ea.cw = p->in[26] + (size_t)l * 3 * NUP; ea.cb = p->in[27] + (size_t)l * NUP;
      gemm_phase<2, 1>(lds, ga, NSEQ * 33, NUP / 256, ea);
#if PROBE_GEMM
      gemm_phase<2, 1>(lds, ga, NSEQ * 33, NUP / 256, ea);
#endif
    PHASE_END
    PHASE_BEGIN
      Gemm ga{G, DFF, WDN + (size_t)l * D * DFF, DFF};
      EpiArgs ea{}; ea.xf = XF; ea.xb = XB; ea.zero = (DBGZ & 4) ? 1 : 0;
      gemm_phase<1, 0>(lds, ga, NT / 256, D / 256, ea);
    PHASE_END
    PHASE_BEGIN
      ln_rows(XF, XF, NT, XF, XB, p->in[29] + l * D, p->in[30] + l * D, l == 1);
    PHASE_END
  }
}

#if DBG
#define DPTRS unsigned char* ws = p.ws; u16* XB = (u16*)(ws + OFF_XB); u16* PA = (u16*)(ws + OFF_PA); u16* PB = (u16*)(ws + OFF_PB); u16* VT = (u16*)(ws + OFF_VT); \
  u16* G = (u16*)(ws + OFF_PA); u16* VV = (u16*)(ws + OFF_VV); u16* YY = (u16*)(ws + OFF_XB); float* BON = (float*)(ws + OFF_BON); float* DE = (float*)(ws + OFF_DBG); \
  (void)XB; (void)PA; (void)PB; (void)VT; (void)G; (void)VV; (void)YY; (void)BON; (void)DE;
template <int which> __global__ __launch_bounds__(NTHREADS) void k_chk(Params p, int l) {
  extern __shared__ __attribute__((aligned(16))) char shm[];
  LAS unsigned char* lds = (LAS unsigned char*)shm;
  DPTRS
  if (which == 0) chk_proj(XB, p.in[4] + (size_t)l * D * P_COLS, PA, PB, VT, DE + 0);
  else if (which == 1) chk_attn(lds, XB, p.in[4] + (size_t)l * D * P_COLS, PB, VT, p.in[19] + l * 256, p.in[20] + l * 128, p.in[21], l, DE + 1);
  else if (which == 2) {
    ScanW sw; sw.mu = p.in[5] + (size_t)l * 2 * A_COLS; sw.w0 = p.in[6] + l * 1024; sw.du = p.in[7] + (size_t)l * 2 * 32 * 512; sw.a0 = p.in[8] + l * 1024;
    sw.iu = p.in[9] + (size_t)l * 2 * 32 * 512; sw.kk_ = p.in[11] + l * 512; sw.ka = p.in[12] + l * 512; sw.rk = p.in[13] + l * 512;
    chk_scan(lds, PA, VV, YY, BON, sw, DE + 2);
  } else if (which == 3) chk_post(PA, PB, VV, YY, BON, p.in[5] + (size_t)l * 2 * A_COLS, p.in[10] + (size_t)l * 96 * 512, p.in[14] + l * 512, p.in[15] + l * 512, DE + 3);
  else if (which == 5) chk_ffn(XB, p.in[25] + (size_t)l * D * NUP, p.in[26] + (size_t)l * 3 * NUP, p.in[27] + (size_t)l * NUP, G, DE + 5);
}
__global__ __launch_bounds__(NTHREADS) void k_encode(Params p) {
  const float* e = (const float*)(p.ws + OFF_DBG);
  const float eA = fmaxf(e[DBG_A], 1e-4f), eB = fmaxf(e[DBG_B], 1e-4f);
  const float V1 = 100.f + 100.f * log10f(eA / 1e-3f);
  float V2 = 1.f + log10f(eB / 1e-3f); V2 = fminf(fmaxf(V2, 0.3f), 8.f);
  const size_t n0 = (size_t)NPROMPT_TOK * D, n1 = (size_t)NT * D;
  for (size_t i = (size_t)blockIdx.x * NTHREADS + threadIdx.x; i < n1; i += (size_t)gridDim.x * NTHREADS) {
    float v = 0.f;
    if (i == 0 || i == n0) v = V1;
    else if (i < n0 / 2 || (i > n0 && i < n0 + (n1 - n0) / 2)) v = V2;
    p.out[i] = v;
  }
}
#endif

extern "C" void kernel_launch(void* const* d_in, const int* in_sizes, int n_in, void* d_out, int out_size, void* d_ws, size_t ws_size, hipStream_t stream) {
  static int grid = 0;
  if (grid == 0) {
    if (ws_size < WS_END) { fprintf(stderr, "ws too small: %zu < %zu\n", ws_size, (size_t)WS_END); grid = -1; return; }
    int dev = 0, cus = 0, per_cu = 0;
    hipGetDevice(&dev);
    hipDeviceGetAttribute(&cus, hipDeviceAttributeMultiprocessorCount, dev);
    hipFuncSetAttribute((const void*)mega, hipFuncAttributeMaxDynamicSharedMemorySize, LDS_BYTES);
#if DBG
    hipFuncSetAttribute((const void*)k_chk<1>, hipFuncAttributeMaxDynamicSharedMemorySize, 81920);
    hipFuncSetAttribute((const void*)k_chk<2>, hipFuncAttributeMaxDynamicSharedMemorySize, 81920);
#endif
    hipOccupancyMaxActiveBlocksPerMultiprocessor(&per_cu, (const void*)mega, NTHREADS, LDS_BYTES);
    if (per_cu < 1) per_cu = 1;
    grid = cus * 1;
  }
  if (grid < 0) return;
  Params p{};
  for (int i = 0; i < 31; ++i) p.in[i] = (const float*)d_in[i];
  p.out = (float*)d_out; p.ws = (unsigned char*)d_ws;
#if DBG
  hipMemsetAsync((char*)d_ws + OFF_DBG, 0, 256, stream);
  auto seg = [&](int lo, int hi) { Params q = p; q.ph_lo = lo; q.ph_hi = hi; void* a2[] = {&q};
    hipError_t e = hipLaunchCooperativeKernel((const void*)mega, dim3(grid), dim3(NTHREADS), a2, LDS_BYTES, stream);
    if (e != hipSuccess) fprintf(stderr, "cooperative launch failed: %s\n", hipGetErrorString(e)); };
  auto chk = [&](int l, int which) {
    if (which == 0) hipLaunchKernelGGL(k_chk<0>, dim3(64), dim3(NTHREADS), 81920, stream, p, l);
    if (which == 1) hipLaunchKernelGGL(k_chk<1>, dim3(64), dim3(NTHREADS), 81920, stream, p, l);
    if (which == 2) hipLaunchKernelGGL(k_chk<2>, dim3(64), dim3(NTHREADS), 81920, stream, p, l);
    if (which == 3) hipLaunchKernelGGL(k_chk<3>, dim3(64), dim3(NTHREADS), 81920, stream, p, l);
    if (which == 5) hipLaunchKernelGGL(k_chk<5>, dim3(64), dim3(NTHREADS), 81920, stream, p, l); };
  seg(0, 1);
  for (int l = 0; l < 2; ++l) {
    const int b = 1 + 9 * l;
    seg(b, b + 1); chk(l, 0);
    seg(b + 1, b + 2); chk(l, 1);
    seg(b + 2, b + 3); chk(l, 2);
    seg(b + 3, b + 4); chk(l, 3);
    seg(b + 4, b + 7); if (l == 0) chk(l, 5);
    seg(b + 7, b + 9);
  }
  hipLaunchKernelGGL(k_encode, dim3(1024), dim3(NTHREADS), 0, stream, p);
#else
  p.ph_lo = 0; p.ph_hi = 1000;
  void* args[] = {&p};
  hipError_t e = hipLaunchCooperativeKernel((const void*)mega, dim3(grid), dim3(NTHREADS), args, LDS_BYTES, stream);
  if (e != hipSuccess) fprintf(stderr, "cooperative launch failed: %s (grid %d)\n", hipGetErrorString(e), grid);
#endif
}
```

```cpp
#include <hip/hip_runtime.h>
#include <hip/hip_bf16.h>
#include <hip/hip_cooperative_groups.h>
#include <cstdio>
namespace cg = cooperative_groups;

#define DI __device__ __forceinline__
using bf16 = __hip_bfloat16;
using bf16x8 = __attribute__((ext_vector_type(8))) short;
using s16x4 = __attribute__((ext_vector_type(4))) short;
using f32x4 = __attribute__((ext_vector_type(4))) float;
using f32x16 = __attribute__((ext_vector_type(16))) float;
typedef unsigned short u16;
typedef __bf16 bf2 __attribute__((ext_vector_type(2)));
typedef unsigned u32x4 __attribute__((ext_vector_type(4)));
typedef unsigned u32x2 __attribute__((ext_vector_type(2)));

constexpr int D = 1024, T = 8192, NSEQ = 12, NT = NSEQ * T;
constexpr int NPROMPT_TOK = 4 * T;
constexpr int A_COLS = 1760, P_COLS = 3296, NPROJ = 3328;
constexpr int DFF = 2816, NUP = 5632;
constexpr int OFF_K = 512, OFF_V = 1024, OFF_WD = 1536, OFF_AD = 1600, OFF_GD = 1664;
constexpr float ALPHA = 1.4142135623730951f;
constexpr float LN_EPS = 1e-5f, GN_EPS = 64e-5f;
constexpr int NTHREADS = 512;
#ifndef DBGZ
#define DBGZ 0
#define DBG 0
#define PROBE_SCAN 0
#define PROBE_GEMM 0
#define PROBE_MISC 0
#ifndef CHK_PROJ_ON
#define CHK_PROJ_ON 1
#endif
#ifndef CHK_ATTN_ON
#define CHK_ATTN_ON 1
#endif
#ifndef CHK_SCAN_ON
#define CHK_SCAN_ON 1
#endif
#ifndef CHK_POST_ON
#define CHK_POST_ON 1
#endif
#ifndef CHK_FFN_ON
#define CHK_FFN_ON 1
#endif
#define DBG_A 5
#define DBG_B 6
#define DBGTHR 0.05f, 0.1f, 0.1f, 0.1f, 0.01f, 0.05f
#endif
constexpr int LDS_BYTES = 163840;

constexpr size_t SZ_WIN = (size_t)2 * NPROJ * D * 2;
constexpr size_t SZ_WOUT = (size_t)2 * D * D * 2;
constexpr size_t SZ_WUP = (size_t)2 * NUP * D * 2;
constexpr size_t SZ_WDN = (size_t)2 * D * DFF * 2;
constexpr size_t OFF_WIN = 0;
constexpr size_t OFF_WOUT = OFF_WIN + SZ_WIN;
constexpr size_t OFF_WUP = OFF_WOUT + SZ_WOUT;
constexpr size_t OFF_WDN = OFF_WUP + SZ_WUP;
constexpr size_t OFF_XB = OFF_WDN + SZ_WDN;
constexpr size_t OFF_PA = OFF_XB + (size_t)NT * D * 2;
constexpr size_t OFF_PB = OFF_PA + (size_t)NT * A_COLS * 2;
constexpr size_t OFF_VT = OFF_PB + (size_t)NT * 1024 * 2;
constexpr size_t OFF_VV = OFF_VT + (size_t)NT * 512 * 2;
constexpr size_t OFF_BON = OFF_VV + (size_t)NT * 512 * 2;
constexpr size_t OFF_OSV = OFF_BON + (size_t)2 * NT * 8 * 4;
constexpr size_t OFF_DBG = OFF_OSV + (size_t)256 * 64 * 512 * 4;
constexpr size_t WS_END = OFF_DBG + 256;
static_assert((size_t)NT * DFF * 2 <= (OFF_VV - OFF_PA), "G alias");

struct Params {
  const float* in[31];
  float* out;
  unsigned char* ws;
  int ph_lo, ph_hi;
};

typedef const __attribute__((address_space(4))) Params* CParams;
DI CParams get_params() { CParams pp = (CParams)__builtin_amdgcn_kernarg_segment_ptr(); asm volatile("" : "+s"(pp)); return pp; }

DI u16 f2bf(float x) { unsigned u = __float_as_uint(x); u += 0x7fffu + ((u >> 16) & 1u); return (u16)(u >> 16); }
DI unsigned cvt_pk_bf16(float lo, float hi) { unsigned r; asm volatile("v_cvt_pk_bf16_f32 %0, %1, %2" : "=v"(r) : "v"(lo), "v"(hi)); return r; }
DI float bf2f(u16 b) { return __uint_as_float(((unsigned)b) << 16); }
DI float sigmoidf_(float x) { return 1.f / (1.f + __expf(-x)); }

template <int MODE> DI int src_col(int n) {
  if (MODE == 0) { return n < A_COLS ? n : (n < 1792 ? -1 : n - 32); }
  if (MODE == 2) { int j = n >> 8, i = n & 255; return i < 128 ? j * 128 + i : DFF + j * 128 + (i - 128); }
  return n;
}
template <int MODE>
DI void convert_weight(char* shm, const float* W, u16* WT, int K, int Nsrc, int Ndst, int gtid_block, int nblocks) {
  float* tile = (float*)shm;
  int tn = Ndst / 64, tk = K / 64;
  for (int t = gtid_block; t < tn * tk; t += nblocks) {
    int n0 = (t / tk) * 64, k0 = (t % tk) * 64;
    __syncthreads();
    for (int e = threadIdx.x; e < 4096; e += NTHREADS) {
      int kk = e >> 6, nn = e & 63;
      int sc = src_col<MODE>(n0 + nn);
      tile[kk * 65 + nn] = sc >= 0 ? W[(size_t)(k0 + kk) * Nsrc + sc] : 0.f;
    }
    __syncthreads();
    for (int e = threadIdx.x; e < 4096; e += NTHREADS) {
      int nn = e >> 6, kk = e & 63;
      WT[(size_t)(n0 + nn) * K + k0 + kk] = f2bf(tile[kk * 65 + nn]);
    }
  }
}

constexpr int LNR = 4;
DI void ln_rows(const float* srcA, const float* srcB, int splitRow, float* dstF, u16* dstB, const float* g, const float* b, bool writeF) {
  int tid = threadIdx.x; asm volatile("" : "+v"(tid));
  int bid = blockIdx.x, gdim = gridDim.x; asm volatile("" : "+s"(bid), "+s"(gdim));
  int wave = tid >> 6, lane = tid & 63;
  int gw = bid * 8 + wave, nw = gdim * 8;
  for (int base = gw * LNR; base < NT; base += nw * LNR) {
    f32x4 v[LNR][4]; float s[LNR], q[LNR];
#pragma unroll
    for (int r = 0; r < LNR; ++r) {
      const int row = base + r;
      const float* src = row < splitRow ? srcA + (size_t)row * D : srcB + (size_t)(row - splitRow) * D;
#pragma unroll
      for (int i = 0; i < 4; ++i) v[r][i] = *(const f32x4*)(src + i * 256 + lane * 4);
    }
#pragma unroll
    for (int r = 0; r < LNR; ++r) { s[r] = 0.f;
#pragma unroll
      for (int i = 0; i < 4; ++i) s[r] += (v[r][i][0] + v[r][i][1]) + (v[r][i][2] + v[r][i][3]); }
#pragma unroll
    for (int o = 32; o > 0; o >>= 1)
#pragma unroll
      for (int r = 0; r < LNR; ++r) s[r] += __shfl_xor(s[r], o);
#pragma unroll
    for (int r = 0; r < LNR; ++r) { const float mu = s[r] * (1.f / D); q[r] = 0.f;
#pragma unroll
      for (int i = 0; i < 4; ++i) { v[r][i] -= mu; const f32x4 t = v[r][i] * v[r][i]; q[r] += (t[0] + t[1]) + (t[2] + t[3]); } }
#pragma unroll
    for (int o = 32; o > 0; o >>= 1)
#pragma unroll
      for (int r = 0; r < LNR; ++r) q[r] += __shfl_xor(q[r], o);
#pragma unroll
    for (int i = 0; i < 4; ++i) {
      const f32x4 gg = *(const f32x4*)(g + i * 256 + lane * 4), bb = *(const f32x4*)(b + i * 256 + lane * 4);
#pragma unroll
      for (int r = 0; r < LNR; ++r) {
        const int row = base + r;
        const float rs = rsqrtf(q[r] * (1.f / D) + LN_EPS);
        const f32x4 o4 = v[r][i] * rs * gg + bb;
        if (writeF) *(f32x4*)(dstF + (size_t)row * D + i * 256 + lane * 4) = o4;
        u32x2 h; h.x = cvt_pk_bf16(o4[0], o4[1]); h.y = cvt_pk_bf16(o4[2], o4[3]);
        *(u32x2*)(dstB + (size_t)row * D + i * 256 + lane * 4) = h;
      }
    }
  }
}

#define LAS __attribute__((address_space(3)))
constexpr int BK = 64, HALF = 128, HTB = HALF * BK * 2, STAGE_BYTES = 8 * HTB;
DI int lds_byte(int r, int c) { const int st = (r >> 4) * 2 + (c >> 5), rr = r & 15, cc = c & 31, ob = rr * 64 + cc * 2; return st * 1024 + (ob ^ (((ob >> 9) & 1) << 5)); }
DI void stage_rc(int b, int& R, int& C) { const int st = b / 1024, sb = b % 1024, swz = sb ^ (((sb >> 9) & 1) << 5); R = (st >> 1) * 16 + swz / 64; C = (st & 1) * 32 + (swz % 64) / 2; }
DI int perm32(int rho) { const int n = rho >> 4, i = rho & 15; return 8 * (i >> 2) + 4 * n + (i & 3); }

typedef float f32x2 __attribute__((ext_vector_type(2)));
DI float gelu1(float v) {
  const float av = __builtin_fabsf(v), d = av * 0.2316418882f + 1.0f;
  const float t = __builtin_amdgcn_rcpf(d);
  float q = t * 0.5307027145f + (-0.7265760135f); q = q * t + 0.7107068705f; q = q * t + (-0.142248368f); q = q * t + 0.127414796f; q = q * t;
  const float e = __builtin_amdgcn_exp2f((v * v) * (-0.72134752044f));
  const float m = v * (q * e), r = v - m;
  return v < 0.f ? m : r;
}
DI float dpp_shr1(float old, float src) { asm volatile("s_nop 1\n\tv_mov_b32_dpp %0, %1 row_shr:1 row_mask:0xf bank_mask:0xf\n\ts_nop 0" : "+v"(old) : "v"(src)); return old; }
DI float dpp_shl1(float old, float src) { asm volatile("s_nop 1\n\tv_mov_b32_dpp %0, %1 row_shl:1 row_mask:0xf bank_mask:0xf\n\ts_nop 0" : "+v"(old) : "v"(src)); return old; }
struct Unit { int pm, pn; };
struct Order {
  int nM, nN, nwg, G, c;
  DI void init(int nM_, int nN_, int G_, int c_) { nM = nM_; nN = nN_; nwg = nM * nN; G = G_; c = c_; }
  DI bool next(int i, Unit& u) const {
    const long Lq = (long)i * G + c; if (Lq >= nwg) return false;
    int wgid = (int)Lq; { const int q = nwg / 8, r = nwg % 8, xcd = wgid % 8, off = wgid / 8; wgid = (xcd < r ? xcd * (q + 1) : r * (q + 1) + (xcd - r) * q) + off; }
    const int nig = 8 * nN, gid = wgid / nig, fm = gid * 8, gsz = (nM - fm) < 8 ? (nM - fm) : 8;
    u.pm = fm + ((wgid % nig) % gsz); u.pn = (wgid % nig) / gsz; return true;
  }
};
struct Gemm { const u16* A; int lda; const u16* Bt; int K; };
template <int ROWMODE> DI const char* a_tile_ptr(const Gemm& g, int pm) {
  long row = ROWMODE == 0 ? (long)pm * 256 : (long)(pm / 33) * T + 254 * (pm % 33) - 1;
  return (const char*)g.A + row * g.lda * 2;
}
struct EpiArgs {
  u16* pa; u16* pb; u16* vt;
  float* xf; const u16* xb;
  u16* g; const float* cw; const float* cb;
  int zero;
};
template <int EPI>
DI void epilogue(f32x4 (&acc)[2][2][4][2], const Unit& u, const EpiArgs& ea, LAS unsigned char* lds) {
  int tid2 = threadIdx.x; asm volatile("" : "+v"(tid2));
  const int wid2 = tid2 >> 6, lane2 = tid2 & 63, wr = wid2 >> 2, wc = wid2 & 3, fr = lane2 & 15, fq = lane2 >> 4;
  if (EPI == 0) {
    const int row0 = u.pm * 256 + wr * 64 + fr;
#pragma unroll
    for (int ai = 0; ai < 2; ++ai)
#pragma unroll
      for (int m = 0; m < 4; ++m) {
        const int row = row0 + ai * HALF + m * 16;
#pragma unroll
        for (int bj = 0; bj < 2; ++bj) {
          const int col = u.pn * 256 + bj * HALF + wc * 32 + 8 * fq;
          const f32x4 a0 = acc[ai][bj][m][0], a1 = acc[ai][bj][m][1];
          if (u.pn <= 10) {
            uint4 pk; pk.x = cvt_pk_bf16(a0[0], a0[1]); pk.y = cvt_pk_bf16(a0[2], a0[3]); pk.z = cvt_pk_bf16(a1[0], a1[1]); pk.w = cvt_pk_bf16(a1[2], a1[3]);
            if (u.pn <= 6) { if (col < A_COLS) *(uint4*)(ea.pa + (size_t)row * A_COLS + col) = pk; }
            else *(uint4*)(ea.pb + (size_t)row * 1024 + (col - 1792)) = pk;
          } else {
            const int c2 = col - 2816, h = c2 >> 7, e = c2 & 127, seq = row / T, t = row % T;
            u16* dst = ea.vt + ((size_t)((seq * 4 + h) * 128 + e)) * T + t;
#pragma unroll
            for (int j = 0; j < 4; ++j) { dst[(size_t)j * T] = f2bf(a0[j]); dst[(size_t)(4 + j) * T] = f2bf(a1[j]); }
          }
        }
      }
  } else if (EPI == 1) {
    const int row0 = u.pm * 256 + wr * 64 + fr, col0 = u.pn * 256 + wc * 32 + 4 * fq;
#pragma unroll
    for (int ai = 0; ai < 2; ++ai)
#pragma unroll
      for (int m = 0; m < 4; ++m) {
        float* rowp = ea.xf + (size_t)(row0 + ai * HALF + m * 16) * D + col0;
        const u16* rowb = ea.xb + (size_t)(row0 + ai * HALF + m * 16) * D + col0;
#pragma unroll
        for (int bj = 0; bj < 2; ++bj)
#pragma unroll
          for (int n = 0; n < 2; ++n) { f32x4* p4 = (f32x4*)(rowp + bj * HALF + n * 16); const u32x2 xr = *(const u32x2*)(rowb + bj * HALF + n * 16);
            f32x4 x; x[0] = __uint_as_float(xr.x << 16); x[1] = __uint_as_float(xr.x & 0xffff0000u); x[2] = __uint_as_float(xr.y << 16); x[3] = __uint_as_float(xr.y & 0xffff0000u);
            *p4 = x * ALPHA + acc[ai][bj][m][n]; }
      }
  } else {
    LAS float* E = (LAS float*)(lds + STAGE_BYTES);
    const int seq = u.pm / 33, ti = u.pm % 33;
    const int cl0 = wc * 32 + 8 * fq;
#pragma unroll
    for (int ai = 0; ai < 2; ++ai)
#pragma unroll
      for (int m = 0; m < 4; ++m) {
        const int rl = ai * HALF + wr * 64 + m * 16 + fr;
        const int tok = 254 * ti - 1 + rl;
        const bool valid = tok >= 0 && tok < T;
        const int blk = ai * 8 + wr * 4 + m;
#pragma unroll
        for (int bj = 0; bj < 2; ++bj)
#pragma unroll
          for (int n = 0; n < 2; ++n) {
            if (!valid) acc[ai][bj][m][n] = (f32x4){0.f, 0.f, 0.f, 0.f};
            if (fr == 0) *(LAS f32x4*)(E + ((blk * 2 + 0) * 2 + bj) * 128 + cl0 + 4 * n) = acc[ai][bj][m][n];
            if (fr == 15) *(LAS f32x4*)(E + ((blk * 2 + 1) * 2 + bj) * 128 + cl0 + 4 * n) = acc[ai][bj][m][n];
          }
      }
    asm volatile("s_waitcnt lgkmcnt(0)" ::: "memory");
    __builtin_amdgcn_s_barrier(); asm volatile("" ::: "memory");
    __builtin_amdgcn_s_barrier(); asm volatile("" ::: "memory");
#pragma unroll
    for (int n = 0; n < 2; ++n) {
      const int hid = u.pn * 128 + cl0 + 4 * n;
      const float* cwp = ea.cw + hid;
      const f32x4 g0 = *(const f32x4*)(cwp), g1 = *(const f32x4*)(cwp + NUP), g2 = *(const f32x4*)(cwp + 2 * NUP), gb = *(const f32x4*)(ea.cb + hid);
      const f32x4 u0 = *(const f32x4*)(cwp + DFF), u1 = *(const f32x4*)(cwp + DFF + NUP), u2 = *(const f32x4*)(cwp + DFF + 2 * NUP), ub = *(const f32x4*)(ea.cb + DFF + hid);
#pragma unroll
      for (int ai = 0; ai < 2; ++ai)
#pragma unroll
        for (int m = 0; m < 4; ++m) {
          const int blk = ai * 8 + wr * 4 + m;
          const int rl = ai * HALF + wr * 64 + m * 16 + fr;
          const int tok = 254 * ti - 1 + rl;
          f32x4 hh[2];
#pragma unroll
          for (int bj = 0; bj < 2; ++bj) {
            const f32x4 cur = acc[ai][bj][m][n];
            f32x4 ab = (f32x4){0.f, 0.f, 0.f, 0.f}, be = (f32x4){0.f, 0.f, 0.f, 0.f};
            if (fr == 0 && blk > 0) ab = *(LAS f32x4*)(E + (((blk - 1) * 2 + 1) * 2 + bj) * 128 + cl0 + 4 * n);
            if (fr == 15 && blk < 15) be = *(LAS f32x4*)(E + (((blk + 1) * 2 + 0) * 2 + bj) * 128 + cl0 + 4 * n);
            f32x4 prev, next;
#pragma unroll
            for (int j = 0; j < 4; ++j) { prev[j] = dpp_shr1(ab[j], cur[j]); next[j] = dpp_shl1(be[j], cur[j]); }
            hh[bj] = bj == 0 ? g0 * prev + g1 * cur + g2 * next + gb : u0 * prev + u1 * cur + u2 * next + ub;
          }
          f32x4 res;
#pragma unroll
          for (int j = 0; j < 4; ++j) res[j] = gelu1(hh[0][j]) * hh[1][j];
          if (rl >= 1 && rl <= 254 && tok < T) {
            u32x2 pk; pk.x = cvt_pk_bf16(res[0], res[1]); pk.y = cvt_pk_bf16(res[2], res[3]);
            *(u32x2*)(ea.g + (size_t)(seq * T + tok) * DFF + hid) = pk;
          }
        }
    }
  }
}

template <int EPI, int ROWMODE>
DI void gemm_phase(LAS unsigned char* lds, const Gemm g, int nM, int nN, const EpiArgs& ea) {
  constexpr bool PERM = (EPI != 1);
  int tid = threadIdx.x; asm volatile("" : "+v"(tid));
  int bid = blockIdx.x, gdim = gridDim.x; asm volatile("" : "+s"(bid), "+s"(gdim));
  const int wid = __builtin_amdgcn_readfirstlane(tid >> 6), lane = tid & 63, wr = wid >> 2, wc = wid & 3, fr = lane & 15, fq = lane >> 4;
  const int K = g.K, nt = K / BK;
  Order S; S.init(nM, nN, gdim, bid);
  unsigned voffA[2], voffB[2];
#pragma unroll
  for (int i = 0; i < 2; ++i) { int R, C; stage_rc(tid * 16 + i * 8192, R, C); const int Rb = PERM ? ((R & ~31) + perm32(R & 31)) : R;
    voffA[i] = (unsigned)(R * g.lda + C) * 2u; voffB[i] = (unsigned)(Rb * K + C) * 2u; }
  const size_t kstep = (size_t)(BK * 2);
  const size_t hstepA = (size_t)HALF * g.lda * 2, hstepB = (size_t)HALF * K * 2;
  const unsigned ldsw = (unsigned)wid * 1024u;
  const int aoff = lds_byte(wr * 64 + fr, fq * 8), boff = lds_byte(wc * 32 + fr, fq * 8);
#define PG8_SA(b, h) (((b) * 2 + (h)) * HTB)
#define PG8_SB(b, h) ((4 + (b) * 2 + (h)) * HTB)
#define PG8_STAGE(bufoff, gbase, voff) do { _Pragma("unroll") for (int _i = 0; _i < 2; ++_i) \
    __builtin_amdgcn_global_load_lds((const unsigned*)((const char*)(gbase) + (voff)[_i]), (LAS unsigned*)(lds + (bufoff) + ldsw + _i * 8192), 16, 0, 0); } while (0)
#define PG8_LDA(dst, b, h) do { _Pragma("unroll") for (int m = 0; m < 4; ++m) _Pragma("unroll") for (int k = 0; k < 2; ++k) dst[m][k] = *(const LAS bf16x8*)(lds + PG8_SA(b, h) + aoff + m * 2048 + k * 1024); } while (0)
#define PG8_LDB(dst, b, h) do { _Pragma("unroll") for (int n = 0; n < 2; ++n) _Pragma("unroll") for (int k = 0; k < 2; ++k) dst[n][k] = *(const LAS bf16x8*)(lds + PG8_SB(b, h) + boff + n * 2048 + k * 1024); } while (0)
#define PG8_MMA(ai, bj, At, Bq) do { __builtin_amdgcn_s_setprio(1); _Pragma("unroll") for (int m = 0; m < 4; ++m) _Pragma("unroll") for (int n = 0; n < 2; ++n) _Pragma("unroll") for (int k = 0; k < 2; ++k) \
    acc[ai][bj][m][n] = __builtin_amdgcn_mfma_f32_16x16x32_bf16(Bq[n][k], At[m][k], acc[ai][bj][m][n], 0, 0, 0); __builtin_amdgcn_s_setprio(0); } while (0)
#define PG8_WAIT_V(n) asm volatile("s_waitcnt vmcnt(" #n ")" ::: "memory")
#define PG8_WAIT_L(n) asm volatile("s_waitcnt lgkmcnt(" #n ")" ::: "memory")
#define PG8_BAR __builtin_amdgcn_s_barrier()
#define PG8_SCHED __builtin_amdgcn_sched_barrier(0)
  Unit cur, nxt; int ui = 0;
  __syncthreads();
  if (!S.next(0, cur)) return;
  f32x4 acc[2][2][4][2];
#pragma unroll
  for (int a = 0; a < 2; ++a)
#pragma unroll
    for (int b = 0; b < 2; ++b)
#pragma unroll
      for (int m = 0; m < 4; ++m)
#pragma unroll
        for (int n = 0; n < 2; ++n) acc[a][b][m][n] = (f32x4){0.f, 0.f, 0.f, 0.f};
  bf16x8 At[4][2], B0[2][2], B1[2][2];
  const char* cA = a_tile_ptr<ROWMODE>(g, cur.pm); const char* cB = (const char*)g.Bt + (size_t)cur.pn * 2 * hstepB;
  PG8_STAGE(PG8_SB(0, 0), cB, voffB); PG8_STAGE(PG8_SA(0, 0), cA, voffA); PG8_STAGE(PG8_SB(0, 1), cB + hstepB, voffB); PG8_STAGE(PG8_SA(0, 1), cA + hstepA, voffA);
  if (wr == 1) PG8_BAR;
  PG8_WAIT_V(4); PG8_BAR;
  PG8_STAGE(PG8_SB(1, 0), cB + kstep, voffB); PG8_STAGE(PG8_SA(1, 0), cA + kstep, voffA); PG8_STAGE(PG8_SB(1, 1), cB + hstepB + kstep, voffB);
  PG8_WAIT_V(6); PG8_BAR;
  for (;;) {
    const bool has_next = S.next(ui + 1, nxt);
    const char* nA = has_next ? a_tile_ptr<ROWMODE>(g, nxt.pm) : cA; const char* nB = has_next ? (const char*)g.Bt + (size_t)nxt.pn * 2 * hstepB : cB;
    for (int t = 0; t < nt; t += 2) {
      const bool last = (t == nt - 2);
      const char* a1 = cA + (size_t)(t + 1) * kstep;
      const char* a2 = last ? nA : cA + (size_t)(t + 2) * kstep; const char* b2 = last ? nB : cB + (size_t)(t + 2) * kstep;
      const char* a3 = a2 + kstep; const char* b3 = b2 + kstep;
      PG8_LDB(B0, 0, 0); PG8_SCHED; PG8_LDA(At, 0, 0); PG8_STAGE(PG8_SA(1, 1), a1 + hstepA, voffA);
      PG8_WAIT_L(8); PG8_BAR; PG8_WAIT_L(0); PG8_MMA(0, 0, At, B0); PG8_BAR; PG8_SCHED;
      PG8_LDB(B1, 0, 1); PG8_STAGE(PG8_SB(0, 0), b2, voffB);
      PG8_BAR; PG8_WAIT_L(0); PG8_MMA(0, 1, At, B1); PG8_BAR;
      PG8_LDA(At, 0, 1); PG8_STAGE(PG8_SA(0, 0), a2, voffA);
      PG8_BAR; PG8_WAIT_L(0); PG8_MMA(1, 0, At, B0); PG8_BAR; PG8_SCHED;
      PG8_STAGE(PG8_SB(0, 1), b2 + hstepB, voffB);
      PG8_WAIT_V(6); PG8_BAR; PG8_MMA(1, 1, At, B1); PG8_BAR;
      PG8_LDB(B0, 1, 0); PG8_SCHED; PG8_LDA(At, 1, 0); PG8_STAGE(PG8_SA(0, 1), a2 + hstepA, voffA);
      PG8_WAIT_L(8); PG8_BAR; PG8_WAIT_L(0); PG8_MMA(0, 0, At, B0); PG8_BAR; PG8_SCHED;
      PG8_LDB(B1, 1, 1); PG8_STAGE(PG8_SB(1, 0), b3, voffB);
      PG8_BAR; PG8_WAIT_L(0); PG8_MMA(0, 1, At, B1); PG8_BAR;
      PG8_LDA(At, 1, 1); PG8_STAGE(PG8_SA(1, 0), a3, voffA);
      PG8_BAR; PG8_WAIT_L(0); PG8_MMA(1, 0, At, B0); PG8_BAR; PG8_SCHED;
      PG8_STAGE(PG8_SB(1, 1), b3 + hstepB, voffB);
      PG8_WAIT_V(6); PG8_BAR; PG8_MMA(1, 1, At, B1); PG8_BAR;
    }
    epilogue<EPI>(acc, cur, ea, lds);
    if (!has_next) break;
#pragma unroll
    for (int a = 0; a < 2; ++a)
#pragma unroll
      for (int b = 0; b < 2; ++b)
#pragma unroll
        for (int m = 0; m < 4; ++m)
#pragma unroll
          for (int n = 0; n < 2; ++n) acc[a][b][m][n] = (f32x4){0.f, 0.f, 0.f, 0.f};
    cur = nxt; cA = nA; cB = nB; ++ui;
  }
  PG8_WAIT_V(0);
  if (wr == 0) PG8_BAR;
  PG8_BAR;
#undef PG8_SA
#undef PG8_SB
}

constexpr int KROW = 144, VROW = 144;
constexpr int KBUF = 64 * KROW, VBUF = 128 * VROW, ABUF = KBUF + VBUF;
constexpr float LOG2E = 1.4426950408889634f;
DI bf16x8 pack8(const f32x16& x, int s) {
  u32x4 p; p.x = cvt_pk_bf16(x[8 * s], x[8 * s + 1]); p.y = cvt_pk_bf16(x[8 * s + 2], x[8 * s + 3]); p.z = cvt_pk_bf16(x[8 * s + 4], x[8 * s + 5]); p.w = cvt_pk_bf16(x[8 * s + 6], x[8 * s + 7]);
  return __builtin_bit_cast(bf16x8, p);
}
DI void attn_phase(LAS unsigned char* lds, u16* PB, const u16* VT, float* OSV, const float* lamp, const float* subg, const float* relb, int layer, int pair_lo, int pair_hi, int wg_lo, int wg_cnt) {
  int tid = threadIdx.x; asm volatile("" : "+v"(tid));
  int bid = blockIdx.x, gdim = gridDim.x; asm volatile("" : "+s"(bid), "+s"(gdim));
  const int wid = tid >> 6, lane = tid & 63, qi = lane & 31, g = lane >> 5;
  LAS float* tab = (LAS float*)(lds + 2 * ABUF);
  LAS float* scal = tab + 264;
  const float lam_init = 0.8f - 0.6f * __expf(-0.3f * (float)layer);
  __syncthreads();
  if (wid == 0) {
    float a = lamp[lane] * lamp[64 + lane], b = lamp[128 + lane] * lamp[192 + lane];
    for (int o = 32; o > 0; o >>= 1) { a += __shfl_xor(a, o); b += __shfl_xor(b, o); }
    if (lane == 0) scal[0] = __expf(a) - __expf(b) + lam_init;
  }
  const int m_sw = (qi & 0x13) | ((qi & 4) << 1) | ((qi & 8) >> 1);
  if (bid < wg_lo || bid >= wg_lo + wg_cnt) return;
  const int xcd = bid & 7, jq = (bid - wg_lo) >> 3;
  const int per_x = wg_cnt >> 3;
  const float c1 = 0.125f * LOG2E;
  for (int pr = pair_lo + xcd; pr < pair_hi; pr += 8) {
    const int s = pr >> 2, h = pr & 3;
    for (int qb = jq; qb < 32; qb += per_x) {
      __syncthreads();
      for (int i = tid; i < 257; i += NTHREADS) {
        const int rel = i - 128, n = rel < 0 ? -rel : rel;
        int bk = n < 8 ? n : (n <= 11 ? 8 : (n <= 15 ? 9 : (n <= 22 ? 10 : (n <= 31 ? 11 : (n <= 45 ? 12 : (n <= 63 ? 13 : (n <= 90 ? 14 : 15)))))));
        if (rel > 0) bk += 16;
        tab[i] = relb[bk * 4 + h] * LOG2E;
      }
      const int q0 = qb * 256 + wid * 32;
      const size_t tokbase = (size_t)s * T;
      float* osv = OSV + ((size_t)bid * 512 + tid) * 64;
#pragma unroll 1
      for (int c = 0; c < 2; ++c) {
        bf16x8 Q[4];
        { const u16* qp = PB + (tokbase + q0 + qi) * 1024 + h * 128 + c * 64 + g * 8;
#pragma unroll
          for (int ks = 0; ks < 4; ++ks) Q[ks] = *(const bf16x8*)(qp + ks * 16); }
        f32x16 O[4];
#pragma unroll
        for (int eb = 0; eb < 4; ++eb)
#pragma unroll
          for (int i = 0; i < 16; ++i) O[eb][i] = 0.f;
        float mrun = -1e30f, lrun = 0.f;
        const u16* kg = PB + (tokbase + (tid >> 3)) * 1024 + 512 + h * 128 + c * 64 + (tid & 7) * 8;
        const u16* vg = VT + ((size_t)((s * 4 + h) * 128 + (tid >> 2))) * T + (tid & 3) * 16;
        const unsigned kl = (tid >> 3) * KROW + (tid & 7) * 16, vl = KBUF + (tid >> 2) * VROW + (tid & 3) * 32;
        u32x4 rk0, rv0, rv1;
        rk0 = *(const u32x4*)(kg); rv0 = *(const u32x4*)(vg); rv1 = *(const u32x4*)(vg + 8);
        __syncthreads();
        *(LAS u32x4*)(lds + kl) = rk0; *(LAS u32x4*)(lds + vl) = rv0; *(LAS u32x4*)(lds + vl + 16) = rv1;
        __syncthreads();
        auto compute_tile = [&](const int kt, LAS unsigned char* buf) {
          const int kmin = kt * 64;
          const int dlo = kmin + 63 - q0, dhi = kmin - (q0 + 31);
          const int bmode = dlo <= -91 ? 0 : (dhi >= 91 ? 1 : 2);
          const float bconst = bmode == 0 ? tab[0] : tab[256];
          f32x16 S[2];
          {
            bf16x8 kf[2][4];
#pragma unroll
            for (int kb = 0; kb < 2; ++kb)
#pragma unroll
              for (int ks = 0; ks < 4; ++ks) kf[kb][ks] = *(const LAS bf16x8*)(buf + (kb * 32 + m_sw) * KROW + (ks * 16 + g * 8) * 2);
            __builtin_amdgcn_sched_barrier(0);
#pragma unroll
            for (int kb = 0; kb < 2; ++kb) {
#pragma unroll
              for (int i = 0; i < 16; ++i) S[kb][i] = 0.f;
#pragma unroll
              for (int ks = 0; ks < 4; ++ks) S[kb] = __builtin_amdgcn_mfma_f32_32x32x16_bf16(kf[kb][ks], Q[ks], S[kb], 0, 0, 0);
            }
          }
          bf16x8 vf[2][4];
          float sc = c1, off = bconst;
          if (bmode == 2) {
#pragma unroll
            for (int kb = 0; kb < 2; ++kb)
#pragma unroll
              for (int r = 0; r < 16; ++r) {
                int rel = kmin + kb * 32 + 16 * (r >> 3) + 8 * g + (r & 7) - (q0 + qi);
                rel = rel < -128 ? -128 : (rel > 128 ? 128 : rel);
                S[kb][r] = S[kb][r] * c1 + tab[rel + 128];
              }
            sc = 1.f; off = 0.f;
          }
          float mx = -3e38f;
#pragma unroll
          for (int kb = 0; kb < 2; ++kb)
#pragma unroll
            for (int r = 0; r < 16; ++r) mx = fmaxf(mx, S[kb][r]);
          mx = fmaxf(mx, __shfl_xor(mx, 32));
          mx = mx * sc + off;
          if (__any(mx > mrun + 8.f)) {
            const float mnew = mx > mrun + 8.f ? mx : mrun;
            const float alpha = __builtin_amdgcn_exp2f(mrun - mnew);
            mrun = mnew; lrun *= alpha;
#pragma unroll
            for (int eb = 0; eb < 4; ++eb)
#pragma unroll
              for (int i = 0; i < 16; ++i) O[eb][i] *= alpha;
          }
          const float sh = off - mrun;
          float psum = 0.f;
#pragma unroll
          for (int kb = 0; kb < 2; ++kb)
#pragma unroll
            for (int r = 0; r < 16; ++r) { const float pv = __builtin_amdgcn_exp2f(S[kb][r] * sc + sh); S[kb][r] = pv; psum += pv; }
          lrun += psum;
          __builtin_amdgcn_sched_barrier(0);
#pragma unroll
          for (int eb = 0; eb < 4; ++eb) vf[0][eb] = *(const LAS bf16x8*)(buf + KBUF + (eb * 32 + qi) * VROW + (g * 8) * 2);
#pragma unroll
          for (int stp = 0; stp < 4; ++stp) {
            const int kb = stp >> 1, hh = stp & 1;
            if (stp < 3) {
#pragma unroll
              for (int eb = 0; eb < 4; ++eb) vf[(stp + 1) & 1][eb] = *(const LAS bf16x8*)(buf + KBUF + (eb * 32 + qi) * VROW + ((stp + 1) * 16 + g * 8) * 2);
            }
            const bf16x8 pb = pack8(S[kb], hh);
#pragma unroll
            for (int eb = 0; eb < 4; ++eb) O[eb] = __builtin_amdgcn_mfma_f32_32x32x16_bf16(vf[stp & 1][eb], pb, O[eb], 0, 0, 0);
          }
        };
        u32x4 rkB, rvB0, rvB1;
        { const u16* kg2 = kg + (size_t)1 * 64 * 1024; const u16* vg2 = vg + 64;
          rk0 = *(const u32x4*)(kg2); rv0 = *(const u32x4*)(vg2); rv1 = *(const u32x4*)(vg2 + 8);
          const u16* kg3 = kg + (size_t)2 * 64 * 1024; const u16* vg3 = vg + 128;
          rkB = *(const u32x4*)(kg3); rvB0 = *(const u32x4*)(vg3); rvB1 = *(const u32x4*)(vg3 + 8); }
#pragma unroll 1
        for (int kt = 0; kt < 128; kt += 2) {
          LAS unsigned char* buf0 = lds; LAS unsigned char* buf1 = lds + ABUF;
          compute_tile(kt, buf0);
          *(LAS u32x4*)(buf1 + kl) = rk0; *(LAS u32x4*)(buf1 + vl) = rv0; *(LAS u32x4*)(buf1 + vl + 16) = rv1;
          { const int tn = kt + 3 < 128 ? kt + 3 : 127; const u16* kg2 = kg + (size_t)tn * 64 * 1024; const u16* vg2 = vg + tn * 64;
            rk0 = *(const u32x4*)(kg2); rv0 = *(const u32x4*)(vg2); rv1 = *(const u32x4*)(vg2 + 8); }
          __syncthreads();
          compute_tile(kt + 1, buf1);
          *(LAS u32x4*)(buf0 + kl) = rkB; *(LAS u32x4*)(buf0 + vl) = rvB0; *(LAS u32x4*)(buf0 + vl + 16) = rvB1;
          { const int tn = kt + 4 < 128 ? kt + 4 : 127; const u16* kg2 = kg + (size_t)tn * 64 * 1024; const u16* vg2 = vg + tn * 64;
            rkB = *(const u32x4*)(kg2); rvB0 = *(const u32x4*)(vg2); rvB1 = *(const u32x4*)(vg2 + 8); }
          __syncthreads();
        }
        const float lt = lrun + __shfl_xor(lrun, 32);
        asm volatile("" : "+v"(osv));
        if (c == 0) {
          const float i0 = 1.f / lt;
#pragma unroll
          for (int eb = 0; eb < 4; ++eb)
#pragma unroll
            for (int i = 0; i < 16; i += 4) { f32x4 t4; t4[0] = O[eb][i] * i0; t4[1] = O[eb][i + 1] * i0; t4[2] = O[eb][i + 2] * i0; t4[3] = O[eb][i + 3] * i0; *(f32x4*)(osv + eb * 16 + i) = t4; }
        } else {
          const float i1 = scal[0] / lt;
          float ss = 0.f;
#pragma unroll
          for (int eb = 0; eb < 4; ++eb)
#pragma unroll
            for (int i = 0; i < 16; i += 4) { const f32x4 t4 = *(const f32x4*)(osv + eb * 16 + i);
#pragma unroll
              for (int j = 0; j < 4; ++j) { const float o = t4[j] - O[eb][i + j] * i1; O[eb][i + j] = o; ss += o * o; } }
          ss += __shfl_xor(ss, 32);
          const float rs = rsqrtf(ss * (1.f / 128.f) + LN_EPS) * (1.f - lam_init);
          u16* op = PB + (tokbase + q0 + qi) * 1024 + h * 128;
#pragma unroll
          for (int eb = 0; eb < 4; ++eb)
#pragma unroll
            for (int rr = 0; rr < 4; ++rr) {
              const int e = eb * 32 + 8 * rr + 4 * g;
              const f32x4 gg = *(const f32x4*)(subg + e);
              u32x2 pk; pk.x = cvt_pk_bf16(O[eb][4 * rr] * rs * gg[0], O[eb][4 * rr + 1] * rs * gg[1]); pk.y = cvt_pk_bf16(O[eb][4 * rr + 2] * rs * gg[2], O[eb][4 * rr + 3] * rs * gg[3]);
              *(u32x2*)(op + e) = pk;
            }
        }
      }
    }
  }
}

DI float softplusf_(float x) { return fmaxf(x, 0.f) + __logf(1.f + __expf(-fabsf(x))); }
DI void load_bf16x8(const u16* p, float (&o)[8]) {
  const u32x4 v = *(const u32x4*)p;
#pragma unroll
  for (int i = 0; i < 4; ++i) { o[2 * i] = __uint_as_float(v[i] << 16); o[2 * i + 1] = __uint_as_float(v[i] & 0xffff0000u); }
}
DI void shifted8(const u16* PA, size_t row, int t, int col, const float* mu0, const float* mu1, float (&o)[8]) {
  float c[8], pv[8], nx[8];
  load_bf16x8(PA + row * A_COLS + col, c);
  if (t > 0) load_bf16x8(PA + (row - 1) * A_COLS + col, pv); else { for (int i = 0; i < 8; ++i) pv[i] = 0.f; }
  if (t < T - 1) load_bf16x8(PA + (row + 1) * A_COLS + col, nx); else { for (int i = 0; i < 8; ++i) nx[i] = 0.f; }
#pragma unroll
  for (int i = 0; i < 8; ++i) o[i] = c[i] + mu0[col + i] * (pv[i] - c[i]) + mu1[col + i] * (nx[i] - c[i]);
}

DI void vprep_phase(LAS unsigned char* lds, const u16* PA, u16* VV, const float* mu, const float* vdown, const float* vup, const float* v0, int layer) {
  int tid = threadIdx.x; asm volatile("" : "+v"(tid));
  int bid = blockIdx.x, gdim = gridDim.x; asm volatile("" : "+s"(bid), "+s"(gdim));
  const int tok = tid >> 4, j = tid & 15;
  LAS float* vs = (LAS float*)lds;
  LAS float* dd = vs + 32 * 516;
  LAS unsigned* DN = (LAS unsigned*)(dd + 1024);
  LAS unsigned* UP = DN + 512 * 16;
  const float* mu0 = mu; const float* mu1 = mu + A_COLS;
  __syncthreads();
  if (layer != 0) {
    for (int i = tid; i < 512 * 16; i += NTHREADS) { const float2 w2 = *(const float2*)(vdown + 2 * i); DN[i] = cvt_pk_bf16(w2.x, w2.y); }
    for (int i = tid; i < 32 * 256; i += NTHREADS) { const float2 w2 = *(const float2*)(vup + 2 * i); UP[i] = cvt_pk_bf16(w2.x, w2.y); }
  }
  for (int it = bid; it < NT / 32; it += gdim) {
    const size_t row = (size_t)it * 32 + tok; const int t = (int)(row % T);
    __syncthreads();
#pragma unroll 1
    for (int q = 0; q < 4; ++q) {
      const int cc = q * 128 + j * 8;
      float o[8]; shifted8(PA, row, t, OFF_V + cc, mu0, mu1, o);
      if (layer == 0) {
        u32x4 pk; pk.x = cvt_pk_bf16(o[0], o[1]); pk.y = cvt_pk_bf16(o[2], o[3]); pk.z = cvt_pk_bf16(o[4], o[5]); pk.w = cvt_pk_bf16(o[6], o[7]);
        *(u32x4*)(VV + row * 512 + cc) = pk;
      } else {
        *(LAS f32x4*)(vs + tok * 516 + cc) = (f32x4){o[0], o[1], o[2], o[3]}; *(LAS f32x4*)(vs + tok * 516 + cc + 4) = (f32x4){o[4], o[5], o[6], o[7]};
      }
    }
    if (layer == 0) continue;
    __syncthreads();
    {
      float d0 = 0.f, d1 = 0.f;
#pragma unroll 8
      for (int c = 0; c < 512; ++c) { const float x = vs[tok * 516 + c]; const unsigned w2 = DN[c * 16 + j]; d0 += x * __uint_as_float(w2 << 16); d1 += x * __uint_as_float(w2 & 0xffff0000u); }
      dd[tok * 32 + 2 * j] = d0; dd[tok * 32 + 2 * j + 1] = d1;
    }
    __syncthreads();
#pragma unroll 1
    for (int q = 0; q < 4; ++q) {
      const int c0 = q * 128 + j * 8;
      float acc[8];
      { const f32x4 a0 = *(const f32x4*)(v0 + c0), a1 = *(const f32x4*)(v0 + c0 + 4);
#pragma unroll
        for (int i = 0; i < 4; ++i) { acc[i] = a0[i]; acc[4 + i] = a1[i]; } }
#pragma unroll 8
      for (int r = 0; r < 32; ++r) {
        const float dv = dd[tok * 32 + r];
        const u32x4 w8 = *(const LAS u32x4*)(UP + r * 256 + (c0 >> 1));
#pragma unroll
        for (int i = 0; i < 4; ++i) { acc[2 * i] += dv * __uint_as_float(w8[i] << 16); acc[2 * i + 1] += dv * __uint_as_float(w8[i] & 0xffff0000u); }
      }
      float vf[8]; load_bf16x8(VV + row * 512 + c0, vf);
      const f32x4 x0 = *(const LAS f32x4*)(vs + tok * 516 + c0), x1 = *(const LAS f32x4*)(vs + tok * 516 + c0 + 4);
      float o[8];
#pragma unroll
      for (int i = 0; i < 4; ++i) { o[i] = x0[i] + (vf[i] - x0[i]) * sigmoidf_(acc[i]); o[4 + i] = x1[i] + (vf[4 + i] - x1[i]) * sigmoidf_(acc[4 + i]); }
      u32x4 pk; pk.x = cvt_pk_bf16(o[0], o[1]); pk.y = cvt_pk_bf16(o[2], o[3]); pk.z = cvt_pk_bf16(o[4], o[5]); pk.w = cvt_pk_bf16(o[6], o[7]);
      *(u32x4*)(VV + row * 512 + c0) = pk;
    }
  }
}

struct ScanW { const float *mu, *w0, *du, *a0, *iu, *kk_, *ka, *rk; };
constexpr int SC = 32;
DI float quad_sum(float x) {
  x += __builtin_bit_cast(float, __builtin_amdgcn_update_dpp(0, __builtin_bit_cast(int, x), 0xB1, 0xf, 0xf, true));
  x += __builtin_bit_cast(float, __builtin_amdgcn_update_dpp(0, __builtin_bit_cast(int, x), 0x4E, 0xf, 0xf, true));
  return x;
}
#define BFLO(x) __uint_as_float((x) << 16)
#define BFHI(x) __uint_as_float((x) & 0xffff0000u)
DI float tanh_fast(float x) { x = fminf(fmaxf(x, -15.f), 15.f); const float t = __expf(2.f * x); return (t - 1.f) / (t + 1.f); }
DI float shift1(float c, float p, float n, float m0, float m1) { return c + m0 * (p - c) + m1 * (n - c); }
DI void scan_produce(LAS float* buf, LAS float* TW, LAS float* TA, LAS const float* DU, LAS const float* IU, const u16* PA, const u16* VV, float* BON,
                     const ScanW& w, int ptid, int sq, int h, int dir, int t0) {
  const int tok = ptid >> 3, j = ptid & 7;
  const int t = t0 + tok; const size_t row = (size_t)sq * T + t;
  const float* mu0 = w.mu; const float* mu1 = w.mu + A_COLS;
  const int cr = h * 64 + j * 8, ck = OFF_K + cr, cw_ = OFF_WD + dir * 32 + j * 4, ca_ = OFF_AD + dir * 32 + j * 4;
  const u16* pc = PA + row * A_COLS;
  const bool hp = t > 0, hn = t < T - 1;
  {
    const u32x2 w_c = *(const u32x2*)(pc + cw_), a_c = *(const u32x2*)(pc + ca_);
    u32x2 w_p = (u32x2){0u, 0u}, a_p = w_p, w_n = w_p, a_n = w_p;
    if (hp) { w_p = *(const u32x2*)(pc - A_COLS + cw_); a_p = *(const u32x2*)(pc - A_COLS + ca_); }
    if (hn) { w_n = *(const u32x2*)(pc + A_COLS + cw_); a_n = *(const u32x2*)(pc + A_COLS + ca_); }
    const f32x4 mw0 = *(const f32x4*)(mu0 + cw_), mw1 = *(const f32x4*)(mu1 + cw_), ma0 = *(const f32x4*)(mu0 + ca_), ma1 = *(const f32x4*)(mu1 + ca_);
    f32x4 tw, ta;
#pragma unroll
    for (int i = 0; i < 2; ++i) {
      tw[2 * i] = tanh_fast(shift1(BFLO(w_c[i]), BFLO(w_p[i]), BFLO(w_n[i]), mw0[2 * i], mw1[2 * i]));
      tw[2 * i + 1] = tanh_fast(shift1(BFHI(w_c[i]), BFHI(w_p[i]), BFHI(w_n[i]), mw0[2 * i + 1], mw1[2 * i + 1]));
      ta[2 * i] = shift1(BFLO(a_c[i]), BFLO(a_p[i]), BFLO(a_n[i]), ma0[2 * i], ma1[2 * i]);
      ta[2 * i + 1] = shift1(BFHI(a_c[i]), BFHI(a_p[i]), BFHI(a_n[i]), ma0[2 * i + 1], ma1[2 * i + 1]);
    }
    *(LAS f32x4*)(TW + tok * 32 + j * 4) = tw; *(LAS f32x4*)(TA + tok * 32 + j * 4) = ta;
  }
  asm volatile("s_waitcnt lgkmcnt(0)" ::: "memory");
  float wl[8], al[8];
  const int cc = j * 8, cg_ = h * 64 + cc;
  { const f32x4 x0 = *(const f32x4*)(w.w0 + dir * 512 + cg_), x1 = *(const f32x4*)(w.w0 + dir * 512 + cg_ + 4), y0 = *(const f32x4*)(w.a0 + dir * 512 + cg_), y1 = *(const f32x4*)(w.a0 + dir * 512 + cg_ + 4);
#pragma unroll
    for (int q = 0; q < 4; ++q) { wl[q] = x0[q]; wl[4 + q] = x1[q]; al[q] = y0[q]; al[4 + q] = y1[q]; } }
#pragma unroll 2
  for (int rr = 0; rr < 32; ++rr) {
    const float twv = TW[tok * 32 + rr], tav = TA[tok * 32 + rr];
    const f32x4 d0 = *(const LAS f32x4*)(DU + rr * 64 + cc), d1 = *(const LAS f32x4*)(DU + rr * 64 + cc + 4), i0 = *(const LAS f32x4*)(IU + rr * 64 + cc), i1 = *(const LAS f32x4*)(IU + rr * 64 + cc + 4);
#pragma unroll
    for (int q = 0; q < 4; ++q) { wl[q] += twv * d0[q]; wl[4 + q] += twv * d1[q]; al[q] += tav * i0[q]; al[4 + q] += tav * i1[q]; }
  }
#pragma unroll
  for (int q = 0; q < 8; ++q) { asm volatile("" : "+v"(wl[q]), "+v"(al[q])); }
  LAS float* AW = buf; LAS float* AK = buf + 2048; LAS float* AB = buf + 4096; LAS float* AD = buf + 6144; LAS float* AR = buf + 8192; LAS float* AV = buf + 10240;
  const int o = tok * 64 + cc;
  float ss = 0.f, bs = 0.f;
  float ok[8], av[8];
#pragma unroll
  for (int hq = 0; hq < 2; ++hq) {
    const int c4 = 4 * hq;
    const u32x2 r_c = *(const u32x2*)(pc + cr + c4), k_c = *(const u32x2*)(pc + ck + c4);
    u32x2 r_p = (u32x2){0u, 0u}, k_p = r_p, r_n = r_p, k_n = r_p;
    if (hp) { r_p = *(const u32x2*)(pc - A_COLS + cr + c4); k_p = *(const u32x2*)(pc - A_COLS + ck + c4); }
    if (hn) { r_n = *(const u32x2*)(pc + A_COLS + cr + c4); k_n = *(const u32x2*)(pc + A_COLS + ck + c4); }
    const u32x2 v_c = *(const u32x2*)(VV + row * 512 + cr + c4);
    const f32x4 mr0 = *(const f32x4*)(mu0 + cr + c4), mr1 = *(const f32x4*)(mu1 + cr + c4), mk0 = *(const f32x4*)(mu0 + ck + c4), mk1 = *(const f32x4*)(mu1 + ck + c4);
    const f32x4 kk4 = *(const f32x4*)(w.kk_ + cg_ + c4), ka4 = *(const f32x4*)(w.ka + cg_ + c4), rk4 = *(const f32x4*)(w.rk + cg_ + c4);
    f32x4 rv, kv, vv, ow, od;
#pragma unroll
    for (int i = 0; i < 2; ++i) {
      rv[2 * i] = shift1(BFLO(r_c[i]), BFLO(r_p[i]), BFLO(r_n[i]), mr0[2 * i], mr1[2 * i]);
      rv[2 * i + 1] = shift1(BFHI(r_c[i]), BFHI(r_p[i]), BFHI(r_n[i]), mr0[2 * i + 1], mr1[2 * i + 1]);
      kv[2 * i] = shift1(BFLO(k_c[i]), BFLO(k_p[i]), BFLO(k_n[i]), mk0[2 * i], mk1[2 * i]);
      kv[2 * i + 1] = shift1(BFHI(k_c[i]), BFHI(k_p[i]), BFHI(k_n[i]), mk0[2 * i + 1], mk1[2 * i + 1]);
      vv[2 * i] = BFLO(v_c[i]); vv[2 * i + 1] = BFHI(v_c[i]);
    }
#pragma unroll
    for (int q = 0; q < 4; ++q) {
      const float wlog = -softplusf_(-wl[c4 + q]) - 0.5f;
      ow[q] = __expf(-__expf(wlog));
      const float a = sigmoidf_(al[c4 + q]);
      av[c4 + q] = a;
      ok[c4 + q] = kv[q] * kk4[q]; ss += ok[c4 + q] * ok[c4 + q];
      od[q] = kv[q] * (1.f + (a - 1.f) * ka4[q]);
      bs += rv[q] * od[q] * rk4[q];
    }
    *(LAS f32x4*)(AW + o + c4) = ow; *(LAS f32x4*)(AD + o + c4) = od; *(LAS f32x4*)(AR + o + c4) = rv; *(LAS f32x4*)(AV + o + c4) = vv;
  }
#pragma unroll
  for (int sft = 1; sft < 8; sft <<= 1) { ss += __shfl_xor(ss, sft); bs += __shfl_xor(bs, sft); }
  const float rn = rsqrtf(ss + 1e-12f);
#pragma unroll
  for (int hq = 0; hq < 2; ++hq) {
    f32x4 k4, b4;
#pragma unroll
    for (int q = 0; q < 4; ++q) { k4[q] = ok[4 * hq + q] * rn; b4[q] = k4[q] * av[4 * hq + q]; }
    *(LAS f32x4*)(AK + o + 4 * hq) = k4; *(LAS f32x4*)(AB + o + 4 * hq) = b4;
  }
  if (j == 0) BON[((size_t)dir * NT + row) * 8 + h] = bs;
}
struct ScanOps { f32x4 k4[4], w4[4], b4[4], d4[4]; float vi; };
DI void scan_load(ScanOps& o, LAS const float* buf, int tt, int jseg, int irow) {
  const int off = tt * 64 + jseg * 16;
#pragma unroll
  for (int q = 0; q < 4; ++q) {
    o.w4[q] = *(const LAS f32x4*)(buf + off + q * 4); o.k4[q] = *(const LAS f32x4*)(buf + 2048 + off + q * 4); o.b4[q] = *(const LAS f32x4*)(buf + 4096 + off + q * 4);
    o.d4[q] = *(const LAS f32x4*)(buf + 6144 + off + q * 4);
  }
  o.vi = buf[10240 + tt * 64 + irow];
}
DI float scan_step(f32x4 (&S)[4], const ScanOps& o, LAS const float* buf, int tt, int jseg) {
  f32x4 r4[4];
#pragma unroll
  for (int q = 0; q < 4; ++q) r4[q] = *(const LAS f32x4*)(buf + 8192 + tt * 64 + jseg * 16 + q * 4);
  f32x4 a4 = S[0] * o.k4[0] + S[1] * o.k4[1] + S[2] * o.k4[2] + S[3] * o.k4[3];
  float sa = -quad_sum((a4[0] + a4[1]) + (a4[2] + a4[3]));
  f32x4 y4 = (f32x4){0.f, 0.f, 0.f, 0.f};
#pragma unroll
  for (int q = 0; q < 4; ++q) { S[q] = S[q] * o.w4[q] + (o.b4[q] * sa + o.d4[q] * o.vi); y4 += S[q] * r4[q]; }
  return quad_sum((y4[0] + y4[1]) + (y4[2] + y4[3]));
}
DI void scan_phase(LAS unsigned char* lds, const u16* PA, const u16* VV, u16* YY, float* BON, const ScanW w) {
  int tid = threadIdx.x; asm volatile("" : "+v"(tid));
  int bid = blockIdx.x, gdim = gridDim.x; asm volatile("" : "+s"(bid), "+s"(gdim));
  LAS float* BUF = (LAS float*)lds;
  LAS float* AY = BUF + 2 * 12288;
  LAS float* TW = AY + 2 * 2048;
  LAS float* TA = TW + SC * 32;
  LAS float* DU = TA + SC * 32;
  LAS float* IU = DU + 2048;
  const int wid = __builtin_amdgcn_readfirstlane(tid >> 6), lane = tid & 63;
  const int NCH = T / SC;
  for (int item = bid; item < 192; item += gdim) {
    const int dir = item & 1, h = (item >> 1) & 7, sq = item >> 4;
    __syncthreads();
    for (int i = tid; i < 2048; i += NTHREADS) { const int rr = i >> 6, c = i & 63; DU[i] = w.du[(dir * 32 + rr) * 512 + h * 64 + c]; IU[i] = w.iu[(dir * 32 + rr) * 512 + h * 64 + c]; }
    __syncthreads();
    f32x4 S[4];
#pragma unroll
    for (int q = 0; q < 4; ++q) S[q] = (f32x4){0.f, 0.f, 0.f, 0.f};
    const int irow = (wid & 3) * 16 + (lane >> 2), jseg = lane & 3;
    if (wid >= 4) scan_produce(BUF, TW, TA, DU, IU, PA, VV, BON, w, tid - 256, sq, h, dir, dir == 0 ? 0 : T - SC);
    __syncthreads();
#pragma unroll 1
    for (int ci = 0; ci < NCH; ++ci) {
      LAS float* buf = BUF + (ci & 1) * 12288;
      LAS float* ay = AY + (ci & 1) * 2048;
      if (wid < 4) {
        ScanOps o0, o1;
        scan_load(o0, buf, dir == 0 ? 0 : SC - 1, jseg, irow);
#pragma unroll 1
        for (int st = 0; st < SC; st += 2) {
          const int t0_ = dir == 0 ? st : SC - 1 - st, t1_ = dir == 0 ? st + 1 : SC - 2 - st;
          scan_load(o1, buf, t1_, jseg, irow);
          const float y0 = scan_step(S, o0, buf, t0_, jseg);
          if (jseg == 0) ay[t0_ * 64 + irow] = y0;
          if (st + 2 < SC) scan_load(o0, buf, dir == 0 ? st + 2 : SC - 3 - st, jseg, irow);
          const float y1 = scan_step(S, o1, buf, t1_, jseg);
          if (jseg == 0) ay[t1_ * 64 + irow] = y1;
        }
      } else {
        const int ptid = tid - 256;
        if (ci + 1 < NCH) scan_produce(BUF + ((ci + 1) & 1) * 12288, TW, TA, DU, IU, PA, VV, BON, w, ptid, sq, h, dir, dir == 0 ? (ci + 1) * SC : T - SC * (ci + 2));
        if (ci > 0) {
          LAS const float* py = AY + ((ci - 1) & 1) * 2048;
          const int t0p = dir == 0 ? (ci - 1) * SC : T - SC * ci;
          const int tok = ptid >> 3, c0 = (ptid & 7) * 8;
          const f32x4 ya = *(const LAS f32x4*)(py + tok * 64 + c0), yb = *(const LAS f32x4*)(py + tok * 64 + c0 + 4);
          u32x4 pk; pk.x = cvt_pk_bf16(ya[0], ya[1]); pk.y = cvt_pk_bf16(ya[2], ya[3]); pk.z = cvt_pk_bf16(yb[0], yb[1]); pk.w = cvt_pk_bf16(yb[2], yb[3]);
          *(u32x4*)(YY + ((size_t)dir * NT + (size_t)sq * T + t0p + tok) * 512 + h * 64 + c0) = pk;
        }
      }
      __syncthreads();
    }
    if (wid >= 4) {
      const int ptid = tid - 256;
      LAS const float* py = AY + ((NCH - 1) & 1) * 2048;
      const int t0p = dir == 0 ? (NCH - 1) * SC : 0;
      const int tok = ptid >> 3, c0 = (ptid & 7) * 8;
      const f32x4 ya = *(const LAS f32x4*)(py + tok * 64 + c0), yb = *(const LAS f32x4*)(py + tok * 64 + c0 + 4);
      u32x4 pk; pk.x = cvt_pk_bf16(ya[0], ya[1]); pk.y = cvt_pk_bf16(ya[2], ya[3]); pk.z = cvt_pk_bf16(yb[0], yb[1]); pk.w = cvt_pk_bf16(yb[2], yb[3]);
      *(u32x4*)(YY + ((size_t)dir * NT + (size_t)sq * T + t0p + tok) * 512 + h * 64 + c0) = pk;
    }
  }
}

DI void post_phase(LAS unsigned char* lds, u16* PA, const u16* PB, const u16* VV, const u16* YY, const float* BON, const float* mu, const float* gup, const float* gng, const float* gnb) {
  int tid = threadIdx.x; asm volatile("" : "+v"(tid));
  int bid = blockIdx.x, gdim = gridDim.x; asm volatile("" : "+s"(bid), "+s"(gdim));
  const int tok = tid >> 4, j = tid & 15;
  LAS unsigned* SG2 = (LAS unsigned*)lds;
  LAS unsigned* GU = (LAS unsigned*)(lds + 16384);
  const float* mu0 = mu; const float* mu1 = mu + A_COLS;
  __syncthreads();
  for (int e = tid; e < 48 * 512; e += NTHREADS) { const int r2 = e >> 9, c = e & 511; GU[(r2 * 2 + ((c >> 2) & 1)) * 256 + (c >> 3) * 4 + (c & 3)] = cvt_pk_bf16(gup[(2 * r2) * 512 + c], gup[(2 * r2 + 1) * 512 + c]); }
  for (int it = bid; it < NT / 32; it += gdim) {
    const size_t row = (size_t)it * 32 + tok; const int t = (int)(row % T);
    __syncthreads();
    { float sv[6];
#pragma unroll
      for (int q = 0; q < 6; ++q) {
        const int col = OFF_GD + j * 6 + q;
        const float c = bf2f(PA[row * A_COLS + col]);
        const float pv = t > 0 ? bf2f(PA[(row - 1) * A_COLS + col]) : 0.f, nx = t < T - 1 ? bf2f(PA[(row + 1) * A_COLS + col]) : 0.f;
        sv[q] = sigmoidf_(c + mu0[col] * (pv - c) + mu1[col] * (nx - c));
      }
#pragma unroll
      for (int pq = 0; pq < 3; ++pq) SG2[tok * 48 + j * 3 + pq] = cvt_pk_bf16(sv[2 * pq], sv[2 * pq + 1]); }
    __syncthreads();
#pragma unroll 1
    for (int q = 0; q < 4; ++q) {
      const int cc = q * 128 + j * 8, h = 2 * q + (j >> 3);
      float y[8]; float sm = 0.f;
      { float a[8], b[8]; load_bf16x8(YY + row * 512 + cc, a); load_bf16x8(YY + ((size_t)NT + row) * 512 + cc, b);
#pragma unroll
        for (int i = 0; i < 8; ++i) { y[i] = a[i] + b[i]; sm += y[i]; } }
      sm += __shfl_xor(sm, 1); sm += __shfl_xor(sm, 2); sm += __shfl_xor(sm, 4);
      const float mean = sm * (1.f / 64.f);
      float vq = 0.f;
#pragma unroll
      for (int i = 0; i < 8; ++i) { y[i] -= mean; vq += y[i] * y[i]; }
      vq += __shfl_xor(vq, 1); vq += __shfl_xor(vq, 2); vq += __shfl_xor(vq, 4);
      const float rs = rsqrtf(vq * (1.f / 64.f) + GN_EPS);
      const float bon = BON[row * 8 + h] + BON[((size_t)NT + row) * 8 + h];
      float gacc[8];
#pragma unroll
      for (int i = 0; i < 8; ++i) gacc[i] = 0.f;
#pragma unroll 8
      for (int r2 = 0; r2 < 48; ++r2) {
        const bf2 sv = __builtin_bit_cast(bf2, SG2[tok * 48 + r2]);
        const u32x4 wa = *(const LAS u32x4*)(GU + (r2 * 2 + 0) * 256 + (cc >> 3) * 4), wb = *(const LAS u32x4*)(GU + (r2 * 2 + 1) * 256 + (cc >> 3) * 4);
#pragma unroll
        for (int i = 0; i < 4; ++i) { unsigned ua = wa[i], ub = wb[i]; asm volatile("" : "+v"(ua), "+v"(ub));
          gacc[i] = __builtin_amdgcn_fdot2_f32_bf16(sv, __builtin_bit_cast(bf2, ua), gacc[i], false); gacc[4 + i] = __builtin_amdgcn_fdot2_f32_bf16(sv, __builtin_bit_cast(bf2, ub), gacc[4 + i], false); }
      }
      float vv[8]; load_bf16x8(VV + row * 512 + cc, vv);
      const f32x4 g0 = *(const f32x4*)(gng + cc), g1 = *(const f32x4*)(gng + cc + 4), b0 = *(const f32x4*)(gnb + cc), b1 = *(const f32x4*)(gnb + cc + 4);
      float o[8];
#pragma unroll
      for (int i = 0; i < 4; ++i) { o[i] = (y[i] * rs * g0[i] + b0[i] + bon * vv[i]) * gacc[i]; o[4 + i] = (y[4 + i] * rs * g1[i] + b1[i] + bon * vv[4 + i]) * gacc[4 + i]; }
      u32x4 pk; pk.x = cvt_pk_bf16(o[0], o[1]); pk.y = cvt_pk_bf16(o[2], o[3]); pk.z = cvt_pk_bf16(o[4], o[5]); pk.w = cvt_pk_bf16(o[6], o[7]);
      if (DBGZ & 1) pk = (u32x4){0u, 0u, 0u, 0u};
      *(u32x4*)(PA + row * A_COLS + cc) = pk;
      u32x4 pb4 = *(const u32x4*)(PB + row * 1024 + cc); if (DBGZ & 2) pb4 = (u32x4){0u, 0u, 0u, 0u};
      *(u32x4*)(PA + row * A_COLS + 512 + cc) = pb4;
    }
  }
}

DI unsigned hashu(unsigned x) { x ^= x >> 16; x *= 0x7feb352du; x ^= x >> 15; x *= 0x846ca68bu; x ^= x >> 16; return x; }
DI void dbg_upd(float* slot, float got, float ref, float scale) { float e = fabsf(got - ref) / scale; if (!(e == e)) e = 1e9f; atomicMax((unsigned*)slot, __float_as_uint(e)); }
DI float tshift(const u16* PA, size_t row, int col, const float* mu) {
  const int t = (int)(row % T);
  const float c = bf2f(PA[row * A_COLS + col]);
  const float pv = t > 0 ? bf2f(PA[(row - 1) * A_COLS + col]) : 0.f, nx = t < T - 1 ? bf2f(PA[(row + 1) * A_COLS + col]) : 0.f;
  return c + mu[col] * (pv - c) + mu[A_COLS + col] * (nx - c);
}
DI void chk_proj(const u16* XB, const float* win, const u16* PA, const u16* PB, const u16* VT, float* slot) {
  const int gt = blockIdx.x * NTHREADS + threadIdx.x;
  if (gt >= 4096) return;
  const int row = hashu(gt * 2 + 1) % NT, col = hashu(gt * 2 + 2) % P_COLS;
  float ref = 0.f;
  for (int k = 0; k < D; ++k) ref += bf2f(XB[(size_t)row * D + k]) * win[(size_t)k * P_COLS + col];
  float got;
  if (col < A_COLS) got = bf2f(PA[(size_t)row * A_COLS + col]);
  else if (col < A_COLS + 1024) got = bf2f(PB[(size_t)row * 1024 + col - A_COLS]);
  else { const int c2 = col - A_COLS - 1024, h = c2 >> 7, e = c2 & 127, sq = row / T, t = row % T; got = bf2f(VT[((size_t)((sq * 4 + h) * 128 + e)) * T + t]); }
  dbg_upd(slot, got, ref, 1.f);
}
DI void chk_ffn(const u16* XB, const float* wup, const float* cw, const float* cb, const u16* G, float* slot) {
  const int gt = blockIdx.x * NTHREADS + threadIdx.x;
  if (gt >= 4096) return;
  int row = hashu(gt * 2 + 11) % NT; const int n = hashu(gt * 2 + 12) % DFF;
  if (gt < 64) row = (gt & 1) ? (row / T) * T + T - 1 : (row / T) * T;
  else if (gt < 1024) row = (row / T) * T + ((row % T) / 254) * 254 + (gt & 1 ? 253 : 0), row = row >= NT ? NT - 1 : row;
  const int t = row % T;
  float hg[3] = {0.f, 0.f, 0.f}, hu[3] = {0.f, 0.f, 0.f};
#pragma unroll
  for (int d = -1; d <= 1; ++d) {
    float a = 0.f, b = 0.f;
    if (!(t + d < 0 || t + d > T - 1))
      for (int k = 0; k < D; ++k) { const float x = bf2f(XB[(size_t)(row + d) * D + k]); a += x * wup[(size_t)k * NUP + n]; b += x * wup[(size_t)k * NUP + DFF + n]; }
    hg[d + 1] = a; hu[d + 1] = b;
  }
  const float got = bf2f(G[(size_t)row * DFF + n]);
  { const float g = cw[n] * hg[0] + cw[NUP + n] * hg[1] + cw[2 * NUP + n] * hg[2] + cb[n];
    const float u = cw[DFF + n] * hu[0] + cw[NUP + DFF + n] * hu[1] + cw[2 * NUP + DFF + n] * hu[2] + cb[DFF + n];
    dbg_upd(slot, got, 0.5f * g * (1.f + erff(g * 0.70710678f)) * u, 1.f); }
  { const float g = cw[n] * hg[2] + cw[NUP + n] * hg[1] + cw[2 * NUP + n] * hg[0] + cb[n];
    const float u = cw[DFF + n] * hu[2] + cw[NUP + DFF + n] * hu[1] + cw[2 * NUP + DFF + n] * hu[0] + cb[DFF + n];
    dbg_upd(slot + 1, got, 0.5f * g * (1.f + erff(g * 0.70710678f)) * u, 1.f); }
  { const float g = cw[NUP + n] * hg[1] + cb[n];
    const float u = cw[NUP + DFF + n] * hu[1] + cb[DFF + n];
    dbg_upd(slot + 2, got, 0.5f * g * (1.f + erff(g * 0.70710678f)) * u, 1.f); }
}
DI void chk_attn(LAS unsigned char* lds, const u16* XB, const float* win, const u16* PB, const u16* VT, const float* lamp, const float* subg, const float* relb, int layer, float* slot) {
  if (blockIdx.x >= 16) return;
  const int tid = threadIdx.x;
  LAS float* qv = (LAS float*)lds;
  LAS float* sc = qv + 128;
  LAS float* red = sc + 16384;
  LAS float* ov = red + 1024;
  const int smp = blockIdx.x;
  const int sq = hashu(smp + 77) % NSEQ, h = smp & 3;
  int q = hashu(smp + 99) % T; if (smp < 4) q = smp * 37; if (smp >= 12) q = T - 1 - (smp - 12) * 50;
  const size_t row = (size_t)sq * T + q;
  __syncthreads();
  if (tid < 128) { float a = 0.f; const int col = A_COLS + h * 128 + tid; for (int k = 0; k < D; ++k) a += bf2f(XB[row * D + k]) * win[(size_t)k * P_COLS + col]; qv[tid] = a; }
  __syncthreads();
  float mx0 = -1e30f, mx1 = -1e30f;
  for (int key = tid; key < T; key += NTHREADS) {
    const u16* kp = PB + ((size_t)sq * T + key) * 1024 + 512 + h * 128;
    float s0 = 0.f, s1 = 0.f;
    for (int d = 0; d < 64; ++d) { s0 += qv[d] * bf2f(kp[d]); s1 += qv[64 + d] * bf2f(kp[64 + d]); }
    const int rel = key - q, n = rel < 0 ? -rel : rel;
    int bk;
    if (n < 8) bk = n; else { bk = 8 + (int)(logf((float)n / 8.f) / logf(16.f) * 8.f); bk = bk > 15 ? 15 : bk; }
    if (rel > 0) bk += 16;
    const float bias = relb[bk * 4 + h];
    s0 = s0 * 0.125f + bias; s1 = s1 * 0.125f + bias;
    sc[key] = s0; sc[8192 + key] = s1; mx0 = fmaxf(mx0, s0); mx1 = fmaxf(mx1, s1);
  }
  red[tid] = mx0; red[512 + tid] = mx1; __syncthreads();
  for (int o = 256; o > 0; o >>= 1) { if (tid < o) { red[tid] = fmaxf(red[tid], red[tid + o]); red[512 + tid] = fmaxf(red[512 + tid], red[512 + tid + o]); } __syncthreads(); }
  mx0 = red[0]; mx1 = red[512]; __syncthreads();
  float l0 = 0.f, l1 = 0.f;
  for (int key = tid; key < T; key += NTHREADS) { const float p0 = expf(sc[key] - mx0), p1 = expf(sc[8192 + key] - mx1); sc[key] = p0; sc[8192 + key] = p1; l0 += p0; l1 += p1; }
  red[tid] = l0; red[512 + tid] = l1; __syncthreads();
  for (int o = 256; o > 0; o >>= 1) { if (tid < o) { red[tid] += red[tid + o]; red[512 + tid] += red[512 + tid + o]; } __syncthreads(); }
  l0 = red[0]; l1 = red[512]; __syncthreads();
  float la = 0.f, lb = 0.f; for (int d = 0; d < 64; ++d) { la += lamp[d] * lamp[64 + d]; lb += lamp[128 + d] * lamp[192 + d]; }
  const float lam_init = 0.8f - 0.6f * expf(-0.3f * (float)layer);
  const float lam = expf(la) - expf(lb) + lam_init;
  { const int e = tid & 127, part = tid >> 7;
    const u16* vp = VT + ((size_t)((sq * 4 + h) * 128 + e)) * T;
    float o = 0.f;
    for (int key = part * 2048; key < (part + 1) * 2048; ++key) o += (sc[key] / l0 - lam * sc[8192 + key] / l1) * bf2f(vp[key]);
    red[tid] = o; }
  __syncthreads();
  if (tid < 128) ov[tid] = red[tid] + red[128 + tid] + red[256 + tid] + red[384 + tid];
  __syncthreads();
  if (tid < 128) {
    float ss = 0.f; for (int e = 0; e < 128; ++e) ss += ov[e] * ov[e];
    const float ref = ov[tid] * rsqrtf(ss / 128.f + LN_EPS) * subg[tid] * (1.f - lam_init);
    dbg_upd(slot, bf2f(PB[row * 1024 + h * 128 + tid]), ref, 1.f);
  }
}
struct ChkOp { float r, kd, kk, b, w, v; };
DI ChkOp chk_ops(const u16* PA, const u16* VV, const ScanW& w, size_t row, int h, int dir, int c, LAS float* tmp  , int tid) {
  ChkOp o;
  const int cg_ = h * 64 + c;
  o.r = tshift(PA, row, cg_, w.mu);
  const float k = tshift(PA, row, OFF_K + cg_, w.mu);
  float wl = w.w0[dir * 512 + cg_], al = w.a0[dir * 512 + cg_];
#pragma unroll 1
  for (int rr = 0; rr < 32; ++rr) {
    wl += tanhf(tshift(PA, row, OFF_WD + dir * 32 + rr, w.mu)) * w.du[(dir * 32 + rr) * 512 + cg_];
    al += tshift(PA, row, OFF_AD + dir * 32 + rr, w.mu) * w.iu[(dir * 32 + rr) * 512 + cg_];
  }
  const float sp = logf(1.f + expf(-wl));
  o.w = expf(-expf(-sp - 0.5f));
  const float a = 1.f / (1.f + expf(-al));
  const float kkv = k * w.kk_[cg_];
  __syncthreads(); tmp[tid] = kkv * kkv; __syncthreads();
  float ss = 0.f;
#pragma unroll 1
  for (int j = 0; j < 64; ++j) ss += tmp[j];
  o.kk = kkv * rsqrtf(ss + 1e-12f);
  o.kd = k * (1.f + (a - 1.f) * w.ka[cg_]);
  o.b = o.kk * a;
  o.v = bf2f(VV[row * 512 + cg_]);
  return o;
}
DI void chk_scan(LAS unsigned char* lds, const u16* PA, const u16* VV, const u16* YY, const float* BON, const ScanW w, float* slot) {
  if (blockIdx.x >= 48 || threadIdx.x >= 64) return;
  const int tid = threadIdx.x;
  LAS float* tmp = (LAS float*)lds; LAS float* red = tmp + 64;
  const int item = blockIdx.x * 4 + 1, dir = item & 1, h = (item >> 1) & 7, sq = item >> 4;
  const int t0 = dir == 0 ? 0 : T - 1, t1 = dir == 0 ? 1 : T - 2;
  const size_t row0 = (size_t)sq * T + t0, row1 = (size_t)sq * T + t1;
  const ChkOp a = chk_ops(PA, VV, w, row0, h, dir, tid, tmp, tid);
  const ChkOp b = chk_ops(PA, VV, w, row1, h, dir, tid, tmp, tid);
#define BSUM(dst, val) { __syncthreads(); red[tid] = (val); __syncthreads(); float sx_ = 0.f; _Pragma("unroll 1") for (int j_ = 0; j_ < 64; ++j_) sx_ += red[j_]; dst = sx_; }
  float ds0, ds1, ds2, ds3, ds4;
  BSUM(ds0, a.kd * a.r) BSUM(ds1, a.kd * b.w * b.r) BSUM(ds2, a.kd * (-b.kk)) BSUM(ds3, b.b * b.r) BSUM(ds4, b.kd * b.r)
  const float y0 = a.v * ds0;
  const float y1 = a.v * (ds1 + ds2 * ds3) + b.v * ds4;
  dbg_upd(slot, bf2f(YY[((size_t)dir * NT + row0) * 512 + h * 64 + tid]), y0, fabsf(y0) + 0.05f);
  dbg_upd(slot, bf2f(YY[((size_t)dir * NT + row1) * 512 + h * 64 + tid]), y1, fabsf(y1) + 0.05f);
  float bq = a.r * a.kd * w.rk[h * 64 + tid];
  __syncthreads(); red[tid] = bq; __syncthreads(); float bs = 0.f;
#pragma unroll 1
  for (int j = 0; j < 64; ++j) bs += red[j];
  dbg_upd(slot, BON[((size_t)dir * NT + row0) * 8 + h], bs, fabsf(bs) + 0.05f);
}
DI void chk_post(const u16* PA, const u16* PB, const u16* VV, const u16* YY, const float* BON, const float* mu, const float* gup, const float* gng, const float* gnb, float* slot) {
  const int gt = blockIdx.x * NTHREADS + threadIdx.x;
  if (gt >= 2048) return;
  const size_t row = hashu(gt * 2 + 21) % NT; const int c = hashu(gt * 2 + 22) % 512, h = c >> 6;
  float sm = 0.f;
  float yc = 0.f;
  for (int i = 0; i < 64; ++i) { const float y = bf2f(YY[row * 512 + h * 64 + i]) + bf2f(YY[((size_t)NT + row) * 512 + h * 64 + i]); sm += y; if (h * 64 + i == c) yc = y; }
  const float mean = sm / 64.f; float vq = 0.f;
  for (int i = 0; i < 64; ++i) { const float y = bf2f(YY[row * 512 + h * 64 + i]) + bf2f(YY[((size_t)NT + row) * 512 + h * 64 + i]) - mean; vq += y * y; }
  const float yn = (yc - mean) * rsqrtf(vq / 64.f + GN_EPS) * gng[c] + gnb[c];
  const float bon = (BON[row * 8 + h] + BON[((size_t)NT + row) * 8 + h]) * bf2f(VV[row * 512 + c]);
  float g = 0.f;
  for (int r = 0; r < 96; ++r) g += (1.f / (1.f + expf(-tshift(PA, row, OFF_GD + r, mu)))) * gup[r * 512 + c];
  const float ref = (yn + bon) * g;
  dbg_upd(slot, bf2f(PA[row * A_COLS + c]), ref, fabsf(ref) + 0.05f);
  dbg_upd(slot + 1, bf2f(PA[row * A_COLS + 512 + c]), bf2f(PB[row * 1024 + c]), 1.f);
}

__global__ __launch_bounds__(NTHREADS, 2) void mega(Params p_unused) {
  extern __shared__ __attribute__((aligned(16))) char shm[];
  cg::grid_group grid = cg::this_grid();
  LAS unsigned char* lds = (LAS unsigned char*)shm;
#define WS_PTRS CParams p = get_params(); unsigned char* ws = p->ws; \
  u16* WIN = (u16*)(ws + OFF_WIN); u16* WOUT = (u16*)(ws + OFF_WOUT); u16* WUP = (u16*)(ws + OFF_WUP); u16* WDN = (u16*)(ws + OFF_WDN); \
  u16* XB = (u16*)(ws + OFF_XB); u16* PA = (u16*)(ws + OFF_PA); u16* PB = (u16*)(ws + OFF_PB); u16* VT = (u16*)(ws + OFF_VT); \
  u16* G = (u16*)(ws + OFF_PA); u16* VV = (u16*)(ws + OFF_VV); u16* YY = (u16*)p->out; float* BON = (float*)(ws + OFF_BON); float* XF = p->out; \
  (void)WIN; (void)WOUT; (void)WUP; (void)WDN; (void)XB; (void)PA; (void)PB; (void)VT; (void)G; (void)VV; (void)YY; (void)BON; (void)XF;
  int ph = 0;
  const int ph_lo = get_params()->ph_lo, ph_hi = get_params()->ph_hi;
#ifndef ONLYMASK
#define ONLYMASK 0xffffffffu
#endif
#define PHASE_BEGIN if (((ONLYMASK >> (__COUNTER__ % 32)) & 1u) && ph >= ph_lo && ph < ph_hi) { WS_PTRS
#define PHASE_END } ++ph; if (ph > ph_lo && ph < ph_hi) grid.sync();

  PHASE_BEGIN
    for (int l = 0; l < 2; ++l) {
      convert_weight<0>(shm, p->in[4] + (size_t)l * D * P_COLS, WIN + (size_t)l * NPROJ * D, D, P_COLS, NPROJ, blockIdx.x, gridDim.x);
      convert_weight<1>(shm, p->in[22] + (size_t)l * D * D, WOUT + (size_t)l * D * D, D, D, D, blockIdx.x, gridDim.x);
      convert_weight<2>(shm, p->in[25] + (size_t)l * D * NUP, WUP + (size_t)l * NUP * D, D, NUP, NUP, blockIdx.x, gridDim.x);
      convert_weight<1>(shm, p->in[28] + (size_t)l * DFF * D, WDN + (size_t)l * D * DFF, DFF, D, D, blockIdx.x, gridDim.x);
    }
    ln_rows(p->in[0], p->in[1], NPROMPT_TOK, XF, XB, p->in[2], p->in[3], false);
  PHASE_END

#pragma unroll 1
  for (int l = 0; l < 2; ++l) {
    PHASE_BEGIN
      Gemm ga{XB, D, WIN + (size_t)l * NPROJ * D, D};
      EpiArgs ea{}; ea.pa = PA; ea.pb = PB; ea.vt = VT;
      gemm_phase<0, 0>(lds, ga, NT / 256, NPROJ / 256, ea);
#if PROBE_GEMM
      gemm_phase<0, 0>(lds, ga, NT / 256, NPROJ / 256, ea);
#endif
    PHASE_END
#pragma unroll 1
    for (int rnd = 0; rnd < 2; ++rnd) {
      if (ph >= ph_lo && ph < ph_hi) { WS_PTRS
        int bidu = blockIdx.x, gdu = gridDim.x; asm volatile("" : "+s"(bidu), "+s"(gdu));
        const bool split = (gdu == 256);
        if (rnd == 0) vprep_phase(lds, PA, VV, p->in[5] + (size_t)l * 2 * A_COLS, p->in[16], p->in[17], p->in[18], l);
        if (rnd == 1 && (!split || bidu < 192)) {
          ScanW sw; sw.mu = p->in[5] + (size_t)l * 2 * A_COLS; sw.w0 = p->in[6] + l * 1024; sw.du = p->in[7] + (size_t)l * 2 * 32 * 512; sw.a0 = p->in[8] + l * 1024;
          sw.iu = p->in[9] + (size_t)l * 2 * 32 * 512; sw.kk_ = p->in[11] + l * 512; sw.ka = p->in[12] + l * 512; sw.rk = p->in[13] + l * 512;
          scan_phase(lds, PA, VV, YY, BON, sw);
        } else if (rnd == 0 || split) {
          const int plo = rnd == 0 ? 0 : 40, phi = (rnd == 0 && split) ? 40 : 48;
          const int wlo = rnd == 0 ? 0 : 192, wcnt = rnd == 0 ? (gdu & ~7) : 64;
          attn_phase(lds, PB, VT, (float*)(ws + OFF_OSV), p->in[19] + l * 256, p->in[20] + l * 128, p->in[21], l, plo, phi, wlo, wcnt);
        }
      }
      ++ph; if (ph > ph_lo && ph < ph_hi) grid.sync();
    }
    PHASE_BEGIN
      post_phase(lds, PA, PB, VV, YY, BON, p->in[5] + (size_t)l * 2 * A_COLS, p->in[10] + (size_t)l * 96 * 512, p->in[14] + l * 512, p->in[15] + l * 512);
#if PROBE_MISC
      post_phase(lds, PA, PB, VV, YY, BON, p->in[5] + (size_t)l * 2 * A_COLS, p->in[10] + (size_t)l * 96 * 512, p->in[14] + l * 512, p->in[15] + l * 512);
#endif
    PHASE_END
    PHASE_BEGIN
      Gemm ga{PA, A_COLS, WOUT + (size_t)l * D * D, D};
      EpiArgs ea{}; ea.xf = XF; ea.xb = XB;
      gemm_phase<1, 0>(lds, ga, NT / 256, D / 256, ea);
    PHASE_END
    PHASE_BEGIN
      ln_rows(XF, XF, NT, XF, XB, p->in[23] + l * D, p->in[24] + l * D, false);
    PHASE_END
    PHASE_BEGIN
      Gemm ga{XB, D, WUP + (size_t)l * NUP * D, D};
      EpiArgs ea{}; ea.g = G; ea.cw = p->in[26] + (size_t)l * 3 * NUP; ea.cb = p->in[27] + (size_t)l * NUP;
      gemm_phase<2, 1>(lds, ga, NSEQ * 33, NUP / 256, ea);
#if PROBE_GEMM
      gemm_phase<2, 1>(lds, ga, NSEQ * 33, NUP / 256, ea);
#endif
    PHASE_END
    PHASE_BEGIN
      Gemm ga{G, DFF, WDN + (size_t)l * D * DFF, DFF};
      EpiArgs ea{}; ea.xf = XF; ea.xb = XB; ea.zero = (DBGZ & 4) ? 1 : 0;
      gemm_phase<1, 0>(lds, ga, NT / 256, D / 256, ea);
    PHASE_END
    PHASE_BEGIN
      ln_rows(XF, XF, NT, XF, XB, p->in[29] + l * D, p->in[30] + l * D, l == 1);
    PHASE_END
  }
}

#if DBG
#define DPTRS unsigned char* ws = p.ws; u16* XB = (u16*)(ws + OFF_XB); u16* PA = (u16*)(ws + OFF_PA); u16* PB = (u16*)(ws + OFF_PB); u16* VT = (u16*)(ws + OFF_VT); \
  u16* G = (u16*)(ws + OFF_PA); u16* VV = (u16*)(ws + OFF_VV); u16* YY = (u16*)(ws + OFF_XB); float* BON = (float*)(ws + OFF_BON); float* DE = (float*)(ws + OFF_DBG); \
  (void)XB; (void)PA; (void)PB; (void)VT; (void)G; (void)VV; (void)YY; (void)BON; (void)DE;
template <int which> __global__ __launch_bounds__(NTHREADS) void k_chk(Params p, int l) {
  extern __shared__ __attribute__((aligned(16))) char shm[];
  LAS unsigned char* lds = (LAS unsigned char*)shm;
  DPTRS
  if (which == 0) chk_proj(XB, p.in[4] + (size_t)l * D * P_COLS, PA, PB, VT, DE + 0);
  else if (which == 1) chk_attn(lds, XB, p.in[4] + (size_t)l * D * P_COLS, PB, VT, p.in[19] + l * 256, p.in[20] + l * 128, p.in[21], l, DE + 1);
  else if (which == 2) {
    ScanW sw; sw.mu = p.in[5] + (size_t)l * 2 * A_COLS; sw.w0 = p.in[6] + l * 1024; sw.du = p.in[7] + (size_t)l * 2 * 32 * 512; sw.a0 = p.in[8] + l * 1024;
    sw.iu = p.in[9] + (size_t)l * 2 * 32 * 512; sw.kk_ = p.in[11] + l * 512; sw.ka = p.in[12] + l * 512; sw.rk = p.in[13] + l * 512;
    chk_scan(lds, PA, VV, YY, BON, sw, DE + 2);
  } else if (which == 3) chk_post(PA, PB, VV, YY, BON, p.in[5] + (size_t)l * 2 * A_COLS, p.in[10] + (size_t)l * 96 * 512, p.in[14] + l * 512, p.in[15] + l * 512, DE + 3);
  else if (which == 5) chk_ffn(XB, p.in[25] + (size_t)l * D * NUP, p.in[26] + (size_t)l * 3 * NUP, p.in[27] + (size_t)l * NUP, G, DE + 5);
}
__global__ __launch_bounds__(NTHREADS) void k_encode(Params p) {
  const float* e = (const float*)(p.ws + OFF_DBG);
  const float eA = fmaxf(e[DBG_A], 1e-4f), eB = fmaxf(e[DBG_B], 1e-4f);
  const float V1 = 100.f + 100.f * log10f(eA / 1e-3f);
  float V2 = 1.f + log10f(eB / 1e-3f); V2 = fminf(fmaxf(V2, 0.3f), 8.f);
  const size_t n0 = (size_t)NPROMPT_TOK * D, n1 = (size_t)NT * D;
  for (size_t i = (size_t)blockIdx.x * NTHREADS + threadIdx.x; i < n1; i += (size_t)gridDim.x * NTHREADS) {
    float v = 0.f;
    if (i == 0 || i == n0) v = V1;
    else if (i < n0 / 2 || (i > n0 && i < n0 + (n1 - n0) / 2)) v = V2;
    p.out[i] = v;
  }
}
#endif

extern "C" void kernel_launch(void* const* d_in, const int* in_sizes, int n_in, void* d_out, int out_size, void* d_ws, size_t ws_size, hipStream_t stream) {
  static int grid = 0;
  if (grid == 0) {
    if (ws_size < WS_END) { fprintf(stderr, "ws too small: %zu < %zu\n", ws_size, (size_t)WS_END); grid = -1; return; }
    int dev = 0, cus = 0, per_cu = 0;
    hipGetDevice(&dev);
    hipDeviceGetAttribute(&cus, hipDeviceAttributeMultiprocessorCount, dev);
    hipFuncSetAttribute((const void*)mega, hipFuncAttributeMaxDynamicSharedMemorySize, LDS_BYTES);
#if DBG
    hipFuncSetAttribute((const void*)k_chk<1>, hipFuncAttributeMaxDynamicSharedMemorySize, 81920);
    hipFuncSetAttribute((const void*)k_chk<2>, hipFuncAttributeMaxDynamicSharedMemorySize, 81920);
#endif
    hipOccupancyMaxActiveBlocksPerMultiprocessor(&per_cu, (const void*)mega, NTHREADS, LDS_BYTES);
    if (per_cu < 1) per_cu = 1;
    grid = cus * 1;
  }
  if (grid < 0) return;
  Params p{};
  for (int i = 0; i < 31; ++i) p.in[i] = (const float*)d_in[i];
  p.out = (float*)d_out; p.ws = (unsigned char*)d_ws;
#if DBG
  hipMemsetAsync((char*)d_ws + OFF_DBG, 0, 256, stream);
  auto seg = [&](int lo, int hi) { Params q = p; q.ph_lo = lo; q.ph_hi = hi; void* a2[] = {&q};
    hipError_t e = hipLaunchCooperativeKernel((const void*)mega, dim3(grid), dim3(NTHREADS), a2, LDS_BYTES, stream);
    if (e != hipSuccess) fprintf(stderr, "cooperative launch failed: %s\n", hipGetErrorString(e)); };
  auto chk = [&](int l, int which) {
    if (which == 0) hipLaunchKernelGGL(k_chk<0>, dim3(64), dim3(NTHREADS), 81920, stream, p, l);
    if (which == 1) hipLaunchKernelGGL(k_chk<1>, dim3(64), dim3(NTHREADS), 81920, stream, p, l);
    if (which == 2) hipLaunchKernelGGL(k_chk<2>, dim3(64), dim3(NTHREADS), 81920, stream, p, l);
    if (which == 3) hipLaunchKernelGGL(k_chk<3>, dim3(64), dim3(NTHREADS), 81920, stream, p, l);
    if (which == 5) hipLaunchKernelGGL(k_chk<5>, dim3(64), dim3(NTHREADS), 81920, stream, p, l); };
  seg(0, 1);
  for (int l = 0; l < 2; ++l) {
    const int b = 1 + 9 * l;
    seg(b, b + 1); chk(l, 0);
    seg(b + 1, b + 2); chk(l, 1);
    seg(b + 2, b + 3); chk(l, 2);
    seg(b + 3, b + 4); chk(l, 3);
    seg(b + 4, b + 7); if (l == 0) chk(l, 5);
    seg(b + 7, b + 9);
  }
  hipLaunchKernelGGL(k_encode, dim3(1024), dim3(NTHREADS), 0, stream, p);
#else
  p.ph_lo = 0; p.ph_hi = 1000;
  void* args[] = {&p};
  hipError_t e = hipLaunchCooperativeKernel((const void*)mega, dim3(grid), dim3(NTHREADS), args, LDS_BYTES, stream);
  if (e != hipSuccess) fprintf(stderr, "cooperative launch failed: %s (grid %d)\n", hipGetErrorString(e), grid);
#endif
}
```

```cpp
#include <hip/hip_runtime.h>
#include <hip/hip_bf16.h>
#include <hip/hip_cooperative_groups.h>
#include <cstdio>
namespace cg = cooperative_groups;

#define DI __device__ __forceinline__
using bf16 = __hip_bfloat16;
using bf16x8 = __attribute__((ext_vector_type(8))) short;
using s16x4 = __attribute__((ext_vector_type(4))) short;
using f32x4 = __attribute__((ext_vector_type(4))) float;
using f32x16 = __attribute__((ext_vector_type(16))) float;
typedef unsigned short u16;
typedef __bf16 bf2 __attribute__((ext_vector_type(2)));
typedef unsigned u32x4 __attribute__((ext_vector_type(4)));
typedef unsigned u32x2 __attribute__((ext_vector_type(2)));

constexpr int D = 1024, T = 8192, NSEQ = 12, NT = NSEQ * T;
constexpr int NPROMPT_TOK = 4 * T;
constexpr int A_COLS = 1760, P_COLS = 3296, NPROJ = 3328;
constexpr int DFF = 2816, NUP = 5632;
constexpr int OFF_K = 512, OFF_V = 1024, OFF_WD = 1536, OFF_AD = 1600, OFF_GD = 1664;
constexpr float ALPHA = 1.4142135623730951f;
constexpr float LN_EPS = 1e-5f, GN_EPS = 64e-5f;
constexpr int NTHREADS = 512;
#ifndef DBGZ
#define DBGZ 0
#define DBG 0
#define PROBE_SCAN 0
#define PROBE_GEMM 0
#define PROBE_MISC 0
#ifndef CHK_PROJ_ON
#define CHK_PROJ_ON 1
#endif
#ifndef CHK_ATTN_ON
#define CHK_ATTN_ON 1
#endif
#ifndef CHK_SCAN_ON
#define CHK_SCAN_ON 1
#endif
#ifndef CHK_POST_ON
#define CHK_POST_ON 1
#endif
#ifndef CHK_FFN_ON
#define CHK_FFN_ON 1
#endif
#define DBG_A 5
#define DBG_B 6
#define DBGTHR 0.05f, 0.1f, 0.1f, 0.1f, 0.01f, 0.05f
#endif
constexpr int LDS_BYTES = 163840;

constexpr size_t SZ_WIN = (size_t)2 * NPROJ * D * 2;
constexpr size_t SZ_WOUT = (size_t)2 * D * D * 2;
constexpr size_t SZ_WUP = (size_t)2 * NUP * D * 2;
constexpr size_t SZ_WDN = (size_t)2 * D * DFF * 2;
constexpr size_t OFF_WIN = 0;
constexpr size_t OFF_WOUT = OFF_WIN + SZ_WIN;
constexpr size_t OFF_WUP = OFF_WOUT + SZ_WOUT;
constexpr size_t OFF_WDN = OFF_WUP + SZ_WUP;
constexpr size_t OFF_XB = OFF_WDN + SZ_WDN;
constexpr size_t OFF_PA = OFF_XB + (size_t)NT * D * 2;
constexpr size_t OFF_PB = OFF_PA + (size_t)NT * A_COLS * 2;
constexpr size_t OFF_VT = OFF_PB + (size_t)NT * 1024 * 2;
constexpr size_t OFF_VV = OFF_VT + (size_t)NT * 512 * 2;
constexpr size_t OFF_BON = OFF_VV + (size_t)NT * 512 * 2;
constexpr size_t OFF_OSV = OFF_BON + (size_t)2 * NT * 8 * 4;
constexpr size_t OFF_DBG = OFF_OSV + (size_t)256 * 64 * 512 * 4;
constexpr size_t WS_END = OFF_DBG + 256;
static_assert((size_t)NT * DFF * 2 <= (OFF_VV - OFF_PA), "G alias");

struct Params {
  const float* in[31];
  float* out;
  unsigned char* ws;
  int ph_lo, ph_hi;
};

typedef const __attribute__((address_space(4))) Params* CParams;
DI CParams get_params() { CParams pp = (CParams)__builtin_amdgcn_kernarg_segment_ptr(); asm volatile("" : "+s"(pp)); return pp; }

DI u16 f2bf(float x) { unsigned u = __float_as_uint(x); u += 0x7fffu + ((u >> 16) & 1u); return (u16)(u >> 16); }
DI unsigned cvt_pk_bf16(float lo, float hi) { unsigned r; asm volatile("v_cvt_pk_bf16_f32 %0, %1, %2" : "=v"(r) : "v"(lo), "v"(hi)); return r; }
DI float bf2f(u16 b) { return __uint_as_float(((unsigned)b) << 16); }
DI float sigmoidf_(float x) { return 1.f / (1.f + __expf(-x)); }

template <int MODE> DI int src_col(int n) {
  if (MODE == 0) { return n < A_COLS ? n : (n < 1792 ? -1 : n - 32); }
  if (MODE == 2) { int j = n >> 8, i = n & 255; return i < 128 ? j * 128 + i : DFF + j * 128 + (i - 128); }
  return n;
}
template <int MODE>
DI void convert_weight(char* shm, const float* W, u16* WT, int K, int Nsrc, int Ndst, int gtid_block, int nblocks) {
  float* tile = (float*)shm;
  int tn = Ndst / 64, tk = K / 64;
  for (int t = gtid_block; t < tn * tk; t += nblocks) {
    int n0 = (t / tk) * 64, k0 = (t % tk) * 64;
    __syncthreads();
    for (int e = threadIdx.x; e < 4096; e += NTHREADS) {
      int kk = e >> 6, nn = e & 63;
      int sc = src_col<MODE>(n0 + nn);
      tile[kk * 65 + nn] = sc >= 0 ? W[(size_t)(k0 + kk) * Nsrc + sc] : 0.f;
    }
    __syncthreads();
    for (int e = threadIdx.x; e < 4096; e += NTHREADS) {
      int nn = e >> 6, kk = e & 63;
      WT[(size_t)(n0 + nn) * K + k0 + kk] = f2bf(tile[kk * 65 + nn]);
    }
  }
}

constexpr int LNR = 4;
DI void ln_rows(const float* srcA, const float* srcB, int splitRow, float* dstF, u16* dstB, const float* g, const float* b, bool writeF) {
  int tid = threadIdx.x; asm volatile("" : "+v"(tid));
  int bid = blockIdx.x, gdim = gridDim.x; asm volatile("" : "+s"(bid), "+s"(gdim));
  int wave = tid >> 6, lane = tid & 63;
  int gw = bid * 8 + wave, nw = gdim * 8;
  for (int base = gw * LNR; base < NT; base += nw * LNR) {
    f32x4 v[LNR][4]; float s[LNR], q[LNR];
#pragma unroll
    for (int r = 0; r < LNR; ++r) {
      const int row = base + r;
      const float* src = row < splitRow ? srcA + (size_t)row * D : srcB + (size_t)(row - splitRow) * D;
#pragma unroll
      for (int i = 0; i < 4; ++i) v[r][i] = *(const f32x4*)(src + i * 256 + lane * 4);
    }
#pragma unroll
    for (int r = 0; r < LNR; ++r) { s[r] = 0.f;
#pragma unroll
      for (int i = 0; i < 4; ++i) s[r] += (v[r][i][0] + v[r][i][1]) + (v[r][i][2] + v[r][i][3]); }
#pragma unroll
    for (int o = 32; o > 0; o >>= 1)
#pragma unroll
      for (int r = 0; r < LNR; ++r) s[r] += __shfl_xor(s[r], o);
#pragma unroll
    for (int r = 0; r < LNR; ++r) { const float mu = s[r] * (1.f / D); q[r] = 0.f;
#pragma unroll
      for (int i = 0; i < 4; ++i) { v[r][i] -= mu; const f32x4 t = v[r][i] * v[r][i]; q[r] += (t[0] + t[1]) + (t[2] + t[3]); } }
#pragma unroll
    for (int o = 32; o > 0; o >>= 1)
#pragma unroll
      for (int r = 0; r < LNR; ++r) q[r] += __shfl_xor(q[r], o);
#pragma unroll
    for (int i = 0; i < 4; ++i) {
      const f32x4 gg = *(const f32x4*)(g + i * 256 + lane * 4), bb = *(const f32x4*)(b + i * 256 + lane * 4);
#pragma unroll
      for (int r = 0; r < LNR; ++r) {
        const int row = base + r;
        const float rs = rsqrtf(q[r] * (1.f / D) + LN_EPS);
        const f32x4 o4 = v[r][i] * rs * gg + bb;
        if (writeF) *(f32x4*)(dstF + (size_t)row * D + i * 256 + lane * 4) = o4;
        u32x2 h; h.x = cvt_pk_bf16(o4[0], o4[1]); h.y = cvt_pk_bf16(o4[2], o4[3]);
        *(u32x2*)(dstB + (size_t)row * D + i * 256 + lane * 4) = h;
      }
    }
  }
}

#define LAS __attribute__((address_space(3)))
constexpr int BK = 64, HALF = 128, HTB = HALF * BK * 2, STAGE_BYTES = 8 * HTB;
DI int lds_byte(int r, int c) { const int st = (r >> 4) * 2 + (c >> 5), rr = r & 15, cc = c & 31, ob = rr * 64 + cc * 2; return st * 1024 + (ob ^ (((ob >> 9) & 1) << 5)); }
DI void stage_rc(int b, int& R, int& C) { const int st = b / 1024, sb = b % 1024, swz = sb ^ (((sb >> 9) & 1) << 5); R = (st >> 1) * 16 + swz / 64; C = (st & 1) * 32 + (swz % 64) / 2; }
DI int perm32(int rho) { const int n = rho >> 4, i = rho & 15; return 8 * (i >> 2) + 4 * n + (i & 3); }

typedef float f32x2 __attribute__((ext_vector_type(2)));
DI float gelu1(float v) {
  const float av = __builtin_fabsf(v), d = av * 0.2316418882f + 1.0f;
  const float t = __builtin_amdgcn_rcpf(d);
  float q = t * 0.5307027145f + (-0.7265760135f); q = q * t + 0.7107068705f; q = q * t + (-0.142248368f); q = q * t + 0.127414796f; q = q * t;
  const float e = __builtin_amdgcn_exp2f((v * v) * (-0.72134752044f));
  const float m = v * (q * e), r = v - m;
  return v < 0.f ? m : r;
}
DI float dpp_shr1(float old, float src) { asm volatile("s_nop 1\n\tv_mov_b32_dpp %0, %1 row_shr:1 row_mask:0xf bank_mask:0xf\n\ts_nop 0" : "+v"(old) : "v"(src)); return old; }
DI float dpp_shl1(float old, float src) { asm volatile("s_nop 1\n\tv_mov_b32_dpp %0, %1 row_shl:1 row_mask:0xf bank_mask:0xf\n\ts_nop 0" : "+v"(old) : "v"(src)); return old; }
struct Unit { int pm, pn; };
struct Order {
  int nM, nN, nwg, G, c;
  DI void init(int nM_, int nN_, int G_, int c_) { nM = nM_; nN = nN_; nwg = nM * nN; G = G_; c = c_; }
  DI bool next(int i, Unit& u) const {
    const long Lq = (long)i * G + c; if (Lq >= nwg) return false;
    int wgid = (int)Lq; { const int q = nwg / 8, r = nwg % 8, xcd = wgid % 8, off = wgid / 8; wgid = (xcd < r ? xcd * (q + 1) : r * (q + 1) + (xcd - r) * q) + off; }
    const int nig = 8 * nN, gid = wgid / nig, fm = gid * 8, gsz = (nM - fm) < 8 ? (nM - fm) : 8;
    u.pm = fm + ((wgid % nig) % gsz); u.pn = (wgid % nig) / gsz; return true;
  }
};
struct Gemm { const u16* A; int lda; const u16* Bt; int K; };
template <int ROWMODE> DI const char* a_tile_ptr(const Gemm& g, int pm) {
  long row = ROWMODE == 0 ? (long)pm * 256 : (long)(pm / 33) * T + 254 * (pm % 33) - 1;
  return (const char*)g.A + row * g.lda * 2;
}
struct EpiArgs {
  u16* pa; u16* pb; u16* vt;
  float* xf; const u16* xb;
  u16* g; const float* cw; const float* cb;
  int zero;
};
template <int EPI>
DI void epilogue(f32x4 (&acc)[2][2][4][2], const Unit& u, const EpiArgs& ea, LAS unsigned char* lds) {
  int tid2 = threadIdx.x; asm volatile("" : "+v"(tid2));
  const int wid2 = tid2 >> 6, lane2 = tid2 & 63, wr = wid2 >> 2, wc = wid2 & 3, fr = lane2 & 15, fq = lane2 >> 4;
  if (EPI == 0) {
    const int row0 = u.pm * 256 + wr * 64 + fr;
#pragma unroll
    for (int ai = 0; ai < 2; ++ai)
#pragma unroll
      for (int m = 0; m < 4; ++m) {
        const int row = row0 + ai * HALF + m * 16;
#pragma unroll
        for (int bj = 0; bj < 2; ++bj) {
          const int col = u.pn * 256 + bj * HALF + wc * 32 + 8 * fq;
          const f32x4 a0 = acc[ai][bj][m][0], a1 = acc[ai][bj][m][1];
          if (u.pn <= 10) {
            uint4 pk; pk.x = cvt_pk_bf16(a0[0], a0[1]); pk.y = cvt_pk_bf16(a0[2], a0[3]); pk.z = cvt_pk_bf16(a1[0], a1[1]); pk.w = cvt_pk_bf16(a1[2], a1[3]);
            if (u.pn <= 6) { if (col < A_COLS) *(uint4*)(ea.pa + (size_t)row * A_COLS + col) = pk; }
            else *(uint4*)(ea.pb + (size_t)row * 1024 + (col - 1792)) = pk;
          } else {
            const int c2 = col - 2816, h = c2 >> 7, e = c2 & 127, seq = row / T, t = row % T;
            u16* dst = ea.vt + ((size_t)((seq * 4 + h) * 128 + e)) * T + t;
#pragma unroll
            for (int j = 0; j < 4; ++j) { dst[(size_t)j * T] = f2bf(a0[j]); dst[(size_t)(4 + j) * T] = f2bf(a1[j]); }
          }
        }
      }
  } else if (EPI == 1) {
    const int row0 = u.pm * 256 + wr * 64 + fr, col0 = u.pn * 256 + wc * 32 + 4 * fq;
#pragma unroll
    for (int ai = 0; ai < 2; ++ai)
#pragma unroll
      for (int m = 0; m < 4; ++m) {
        float* rowp = ea.xf + (size_t)(row0 + ai * HALF + m * 16) * D + col0;
        const u16* rowb = ea.xb + (size_t)(row0 + ai * HALF + m * 16) * D + col0;
#pragma unroll
        for (int bj = 0; bj < 2; ++bj)
#pragma unroll
          for (int n = 0; n < 2; ++n) { f32x4* p4 = (f32x4*)(rowp + bj * HALF + n * 16); const u32x2 xr = *(const u32x2*)(rowb + bj * HALF + n * 16);
            f32x4 x; x[0] = __uint_as_float(xr.x << 16); x[1] = __uint_as_float(xr.x & 0xffff0000u); x[2] = __uint_as_float(xr.y << 16); x[3] = __uint_as_float(xr.y & 0xffff0000u);
            *p4 = x * ALPHA + acc[ai][bj][m][n]; }
      }
  } else {
    LAS float* E = (LAS float*)(lds + STAGE_BYTES);
    const int seq = u.pm / 33, ti = u.pm % 33;
    const int cl0 = wc * 32 + 8 * fq;
#pragma unroll
    for (int ai = 0; ai < 2; ++ai)
#pragma unroll
      for (int m = 0; m < 4; ++m) {
        const int rl = ai * HALF + wr * 64 + m * 16 + fr;
        const int tok = 254 * ti - 1 + rl;
        const bool valid = tok >= 0 && tok < T;
        const int blk = ai * 8 + wr * 4 + m;
#pragma unroll
        for (int bj = 0; bj < 2; ++bj)
#pragma unroll
          for (int n = 0; n < 2; ++n) {
            if (!valid) acc[ai][bj][m][n] = (f32x4){0.f, 0.f, 0.f, 0.f};
            if (fr == 0) *(LAS f32x4*)(E + ((blk * 2 + 0) * 2 + bj) * 128 + cl0 + 4 * n) = acc[ai][bj][m][n];
            if (fr == 15) *(LAS f32x4*)(E + ((blk * 2 + 1) * 2 + bj) * 128 + cl0 + 4 * n) = acc[ai][bj][m][n];
          }
      }
    asm volatile("s_waitcnt lgkmcnt(0)" ::: "memory");
    __builtin_amdgcn_s_barrier(); asm volatile("" ::: "memory");
    __builtin_amdgcn_s_barrier(); asm volatile("" ::: "memory");
#pragma unroll
    for (int n = 0; n < 2; ++n) {
      const int hid = u.pn * 128 + cl0 + 4 * n;
      const float* cwp = ea.cw + hid;
      const f32x4 g0 = *(const f32x4*)(cwp), g1 = *(const f32x4*)(cwp + NUP), g2 = *(const f32x4*)(cwp + 2 * NUP), gb = *(const f32x4*)(ea.cb + hid);
      const f32x4 u0 = *(const f32x4*)(cwp + DFF), u1 = *(const f32x4*)(cwp + DFF + NUP), u2 = *(const f32x4*)(cwp + DFF + 2 * NUP), ub = *(const f32x4*)(ea.cb + DFF + hid);
#pragma unroll
      for (int ai = 0; ai < 2; ++ai)
#pragma unroll
        for (int m = 0; m < 4; ++m) {
          const int blk = ai * 8 + wr * 4 + m;
          const int rl = ai * HALF + wr * 64 + m * 16 + fr;
          const int tok = 254 * ti - 1 + rl;
          f32x4 hh[2];
#pragma unroll
          for (int bj = 0; bj < 2; ++bj) {
            const f32x4 cur = acc[ai][bj][m][n];
            f32x4 ab = (f32x4){0.f, 0.f, 0.f, 0.f}, be = (f32x4){0.f, 0.f, 0.f, 0.f};
            if (fr == 0 && blk > 0) ab = *(LAS f32x4*)(E + (((blk - 1) * 2 + 1) * 2 + bj) * 128 + cl0 + 4 * n);
            if (fr == 15 && blk < 15) be = *(LAS f32x4*)(E + (((blk + 1) * 2 + 0) * 2 + bj) * 128 + cl0 + 4 * n);
            f32x4 prev, next;
#pragma unroll
            for (int j = 0; j < 4; ++j) { prev[j] = dpp_shr1(ab[j], cur[j]); next[j] = dpp_shl1(be[j], cur[j]); }
            hh[bj] = bj == 0 ? g0 * prev + g1 * cur + g2 * next + gb : u0 * prev + u1 * cur + u2 * next + ub;
          }
          f32x4 res;
#pragma unroll
          for (int j = 0; j < 4; ++j) res[j] = gelu1(hh[0][j]) * hh[1][j];
          if (rl >= 1 && rl <= 254 && tok < T) {
            u32x2 pk; pk.x = cvt_pk_bf16(res[0], res[1]); pk.y = cvt_pk_bf16(res[2], res[3]);
            *(u32x2*)(ea.g + (size_t)(seq * T + tok) * DFF + hid) = pk;
          }
        }
    }
  }
}

template <int EPI, int ROWMODE>
DI void gemm_phase(LAS unsigned char* lds, const Gemm g, int nM, int nN, const EpiArgs& ea) {
  constexpr bool PERM = (EPI != 1);
  int tid = threadIdx.x; asm volatile("" : "+v"(tid));
  int bid = blockIdx.x, gdim = gridDim.x; asm volatile("" : "+s"(bid), "+s"(gdim));
  const int wid = __builtin_amdgcn_readfirstlane(tid >> 6), lane = tid & 63, wr = wid >> 2, wc = wid & 3, fr = lane & 15, fq = lane >> 4;
  const int K = g.K, nt = K / BK;
  Order S; S.init(nM, nN, gdim, bid);
  unsigned voffA[2], voffB[2];
#pragma unroll
  for (int i = 0; i < 2; ++i) { int R, C; stage_rc(tid * 16 + i * 8192, R, C); const int Rb = PERM ? ((R & ~31) + perm32(R & 31)) : R;
    voffA[i] = (unsigned)(R * g.lda + C) * 2u; voffB[i] = (unsigned)(Rb * K + C) * 2u; }
  const size_t kstep = (size_t)(BK * 2);
  const size_t hstepA = (size_t)HALF * g.lda * 2, hstepB = (size_t)HALF * K * 2;
  const unsigned ldsw = (unsigned)wid * 1024u;
  const int aoff = lds_byte(wr * 64 + fr, fq * 8), boff = lds_byte(wc * 32 + fr, fq * 8);
#define PG8_SA(b, h) (((b) * 2 + (h)) * HTB)
#define PG8_SB(b, h) ((4 + (b) * 2 + (h)) * HTB)
#define PG8_STAGE(bufoff, gbase, voff) do { _Pragma("unroll") for (int _i = 0; _i < 2; ++_i) \
    __builtin_amdgcn_global_load_lds((const unsigned*)((const char*)(gbase) + (voff)[_i]), (LAS unsigned*)(lds + (bufoff) + ldsw + _i * 8192), 16, 0, 0); } while (0)
#define PG8_LDA(dst, b, h) do { _Pragma("unroll") for (int m = 0; m < 4; ++m) _Pragma("unroll") for (int k = 0; k < 2; ++k) dst[m][k] = *(const LAS bf16x8*)(lds + PG8_SA(b, h) + aoff + m * 2048 + k * 1024); } while (0)
#define PG8_LDB(dst, b, h) do { _Pragma("unroll") for (int n = 0; n < 2; ++n) _Pragma("unroll") for (int k = 0; k < 2; ++k) dst[n][k] = *(const LAS bf16x8*)(lds + PG8_SB(b, h) + boff + n * 2048 + k * 1024); } while (0)
#define PG8_MMA(ai, bj, At, Bq) do { __builtin_amdgcn_s_setprio(1); _Pragma("unroll") for (int m = 0; m < 4; ++m) _Pragma("unroll") for (int n = 0; n < 2; ++n) _Pragma("unroll") for (int k = 0; k < 2; ++k) \
    acc[ai][bj][m][n] = __builtin_amdgcn_mfma_f32_16x16x32_bf16(Bq[n][k], At[m][k], acc[ai][bj][m][n], 0, 0, 0); __builtin_amdgcn_s_setprio(0); } while (0)
#define PG8_WAIT_V(n) asm volatile("s_waitcnt vmcnt(" #n ")" ::: "memory")
#define PG8_WAIT_L(n) asm volatile("s_waitcnt lgkmcnt(" #n ")" ::: "memory")
#define PG8_BAR __builtin_amdgcn_s_barrier()
#define PG8_SCHED __builtin_amdgcn_sched_barrier(0)
  Unit cur, nxt; int ui = 0;
  __syncthreads();
  if (!S.next(0, cur)) return;
  f32x4 acc[2][2][4][2];
#pragma unroll
  for (int a = 0; a < 2; ++a)
#pragma unroll
    for (int b = 0; b < 2; ++b)
#pragma unroll
      for (int m = 0; m < 4; ++m)
#pragma unroll
        for (int n = 0; n < 2; ++n) acc[a][b][m][n] = (f32x4){0.f, 0.f, 0.f, 0.f};
  bf16x8 At[4][2], B0[2][2], B1[2][2];
  const char* cA = a_tile_ptr<ROWMODE>(g, cur.pm); const char* cB = (const char*)g.Bt + (size_t)cur.pn * 2 * hstepB;
  PG8_STAGE(PG8_SB(0, 0), cB, voffB); PG8_STAGE(PG8_SA(0, 0), cA, voffA); PG8_STAGE(PG8_SB(0, 1), cB + hstepB, voffB); PG8_STAGE(PG8_SA(0, 1), cA + hstepA, voffA);
  if (wr == 1) PG8_BAR;
  PG8_WAIT_V(4); PG8_BAR;
  PG8_STAGE(PG8_SB(1, 0), cB + kstep, voffB); PG8_STAGE(PG8_SA(1, 0), cA + kstep, voffA); PG8_STAGE(PG8_SB(1, 1), cB + hstepB + kstep, voffB);
  PG8_WAIT_V(6); PG8_BAR;
  for (;;) {
    const bool has_next = S.next(ui + 1, nxt);
    const char* nA = has_next ? a_tile_ptr<ROWMODE>(g, nxt.pm) : cA; const char* nB = has_next ? (const char*)g.Bt + (size_t)nxt.pn * 2 * hstepB : cB;
    for (int t = 0; t < nt; t += 2) {
      const bool last = (t == nt - 2);
      const char* a1 = cA + (size_t)(t + 1) * kstep;
      const char* a2 = last ? nA : cA + (size_t)(t + 2) * kstep; const char* b2 = last ? nB : cB + (size_t)(t + 2) * kstep;
      const char* a3 = a2 + kstep; const char* b3 = b2 + kstep;
      PG8_LDB(B0, 0, 0); PG8_SCHED; PG8_LDA(At, 0, 0); PG8_STAGE(PG8_SA(1, 1), a1 + hstepA, voffA);
      PG8_WAIT_L(8); PG8_BAR; PG8_WAIT_L(0); PG8_MMA(0, 0, At, B0); PG8_BAR; PG8_SCHED;
      PG8_LDB(B1, 0, 1); PG8_STAGE(PG8_SB(0, 0), b2, voffB);
      PG8_BAR; PG8_WAIT_L(0); PG8_MMA(0, 1, At, B1); PG8_BAR;
      PG8_LDA(At, 0, 1); PG8_STAGE(PG8_SA(0, 0), a2, voffA);
      PG8_BAR; PG8_WAIT_L(0); PG8_MMA(1, 0, At, B0); PG8_BAR; PG8_SCHED;
      PG8_STAGE(PG8_SB(0, 1), b2 + hstepB, voffB);
      PG8_WAIT_V(6); PG8_BAR; PG8_MMA(1, 1, At, B1); PG8_BAR;
      PG8_LDB(B0, 1, 0); PG8_SCHED; PG8_LDA(At, 1, 0); PG8_STAGE(PG8_SA(0, 1), a2 + hstepA, voffA);
      PG8_WAIT_L(8); PG8_BAR; PG8_WAIT_L(0); PG8_MMA(0, 0, At, B0); PG8_BAR; PG8_SCHED;
      PG8_LDB(B1, 1, 1); PG8_STAGE(PG8_SB(1, 0), b3, voffB);
      PG8_BAR; PG8_WAIT_L(0); PG8_MMA(0, 1, At, B1); PG8_BAR;
      PG8_LDA(At, 1, 1); PG8_STAGE(PG8_SA(1, 0), a3, voffA);
      PG8_BAR; PG8_WAIT_L(0); PG8_MMA(1, 0, At, B0); PG8_BAR; PG8_SCHED;
      PG8_STAGE(PG8_SB(1, 1), b3 + hstepB, voffB);
      PG8_WAIT_V(6); PG8_BAR; PG8_MMA(1, 1, At, B1); PG8_BAR;
    }
    epilogue<EPI>(acc, cur, ea, lds);
    if (!has_next) break;
#pragma unroll
    for (int a = 0; a < 2; ++a)
#pragma unroll
      for (int b = 0; b < 2; ++b)
#pragma unroll
        for (int m = 0; m < 4; ++m)
#pragma unroll
          for (int n = 0; n < 2; ++n) acc[a][b][m][n] = (f32x4){0.f, 0.f, 0.f, 0.f};
    cur = nxt; cA = nA; cB = nB; ++ui;
  }
  PG8_WAIT_V(0);
  if (wr == 0) PG8_BAR;
  PG8_BAR;
#undef PG8_SA
#undef PG8_SB
}

constexpr int KROW = 144, VROW = 144;
constexpr int KBUF = 64 * KROW, VBUF = 128 * VROW, ABUF = KBUF + VBUF;
constexpr float LOG2E = 1.4426950408889634f;
DI bf16x8 pack8(const f32x16& x, int s) {
  u32x4 p; p.x = cvt_pk_bf16(x[8 * s], x[8 * s + 1]); p.y = cvt_pk_bf16(x[8 * s + 2], x[8 * s + 3]); p.z = cvt_pk_bf16(x[8 * s + 4], x[8 * s + 5]); p.w = cvt_pk_bf16(x[8 * s + 6], x[8 * s + 7]);
  return __builtin_bit_cast(bf16x8, p);
}
DI void attn_phase(LAS unsigned char* lds, u16* PB, const u16* VT, float* OSV, const float* lamp, const float* subg, const float* relb, int layer, int pair_lo, int pair_hi, int wg_lo, int wg_cnt) {
  int tid = threadIdx.x; asm volatile("" : "+v"(tid));
  int bid = blockIdx.x, gdim = gridDim.x; asm volatile("" : "+s"(bid), "+s"(gdim));
  const int wid = tid >> 6, lane = tid & 63, qi = lane & 31, g = lane >> 5;
  LAS float* tab = (LAS float*)(lds + 2 * ABUF);
  LAS float* scal = tab + 264;
  const float lam_init = 0.8f - 0.6f * __expf(-0.3f * (float)layer);
  __syncthreads();
  if (wid == 0) {
    float a = lamp[lane] * lamp[64 + lane], b = lamp[128 + lane] * lamp[192 + lane];
    for (int o = 32; o > 0; o >>= 1) { a += __shfl_xor(a, o); b += __shfl_xor(b, o); }
    if (lane == 0) scal[0] = __expf(a) - __expf(b) + lam_init;
  }
  const int m_sw = (qi & 0x13) | ((qi & 4) << 1) | ((qi & 8) >> 1);
  if (bid < wg_lo || bid >= wg_lo + wg_cnt) return;
  const int xcd = bid & 7, jq = (bid - wg_lo) >> 3;
  const int per_x = wg_cnt >> 3;
  const float c1 = 0.125f * LOG2E;
  for (int pr = pair_lo + xcd; pr < pair_hi; pr += 8) {
    const int s = pr >> 2, h = pr & 3;
    for (int qb = jq; qb < 32; qb += per_x) {
      __syncthreads();
      for (int i = tid; i < 257; i += NTHREADS) {
        const int rel = i - 128, n = rel < 0 ? -rel : rel;
        int bk = n < 8 ? n : (n <= 11 ? 8 : (n <= 15 ? 9 : (n <= 22 ? 10 : (n <= 31 ? 11 : (n <= 45 ? 12 : (n <= 63 ? 13 : (n <= 90 ? 14 : 15)))))));
        if (rel > 0) bk += 16;
        tab[i] = relb[bk * 4 + h] * LOG2E;
      }
      const int q0 = qb * 256 + wid * 32;
      const size_t tokbase = (size_t)s * T;
      float* osv = OSV + ((size_t)bid * 512 + tid) * 64;
#pragma unroll 1
      for (int c = 0; c < 2; ++c) {
        bf16x8 Q[4];
        { const u16* qp = PB + (tokbase + q0 + qi) * 1024 + h * 128 + c * 64 + g * 8;
#pragma unroll
          for (int ks = 0; ks < 4; ++ks) Q[ks] = *(const bf16x8*)(qp + ks * 16); }
        f32x16 O[4];
#pragma unroll
        for (int eb = 0; eb < 4; ++eb)
#pragma unroll
          for (int i = 0; i < 16; ++i) O[eb][i] = 0.f;
        float mrun = -1e30f, lrun = 0.f;
        const u16* kg = PB + (tokbase + (tid >> 3)) * 1024 + 512 + h * 128 + c * 64 + (tid & 7) * 8;
        const u16* vg = VT + ((size_t)((s * 4 + h) * 128 + (tid >> 2))) * T + (tid & 3) * 16;
        const unsigned kl = (tid >> 3) * KROW + (tid & 7) * 16, vl = KBUF + (tid >> 2) * VROW + (tid & 3) * 32;
        u32x4 rk0, rv0, rv1;
        rk0 = *(const u32x4*)(kg); rv0 = *(const u32x4*)(vg); rv1 = *(const u32x4*)(vg + 8);
        __syncthreads();
        *(LAS u32x4*)(lds + kl) = rk0; *(LAS u32x4*)(lds + vl) = rv0; *(LAS u32x4*)(lds + vl + 16) = rv1;
        __syncthreads();
        auto compute_tile = [&](const int kt, LAS unsigned char* buf) {
          const int kmin = kt * 64;
          const int dlo = kmin + 63 - q0, dhi = kmin - (q0 + 31);
          const int bmode = dlo <= -91 ? 0 : (dhi >= 91 ? 1 : 2);
          const float bconst = bmode == 0 ? tab[0] : tab[256];
          f32x16 S[2];
          {
            bf16x8 kf[2][4];
#pragma unroll
            for (int kb = 0; kb < 2; ++kb)
#pragma unroll
              for (int ks = 0; ks < 4; ++ks) kf[kb][ks] = *(const LAS bf16x8*)(buf + (kb * 32 + m_sw) * KROW + (ks * 16 + g * 8) * 2);
            __builtin_amdgcn_sched_barrier(0);
#pragma unroll
            for (int kb = 0; kb < 2; ++kb) {
#pragma unroll
              for (int i = 0; i < 16; ++i) S[kb][i] = 0.f;
#pragma unroll
              for (int ks = 0; ks < 4; ++ks) S[kb] = __builtin_amdgcn_mfma_f32_32x32x16_bf16(kf[kb][ks], Q[ks], S[kb], 0, 0, 0);
            }
          }
          bf16x8 vf[2][4];
          float sc = c1, off = bconst;
          if (bmode == 2) {
#pragma unroll
            for (int kb = 0; kb < 2; ++kb)
#pragma unroll
              for (int r = 0; r < 16; ++r) {
                int rel = kmin + kb * 32 + 16 * (r >> 3) + 8 * g + (r & 7) - (q0 + qi);
                rel = rel < -128 ? -128 : (rel > 128 ? 128 : rel);
                S[kb][r] = S[kb][r] * c1 + tab[rel + 128];
              }
            sc = 1.f; off = 0.f;
          }
          float mx = -3e38f;
#pragma unroll
          for (int kb = 0; kb < 2; ++kb)
#pragma unroll
            for (int r = 0; r < 16; ++r) mx = fmaxf(mx, S[kb][r]);
          mx = fmaxf(mx, __shfl_xor(mx, 32));
          mx = mx * sc + off;
          if (__any(mx > mrun + 8.f)) {
            const float mnew = mx > mrun + 8.f ? mx : mrun;
            const float alpha = __builtin_amdgcn_exp2f(mrun - mnew);
            mrun = mnew; lrun *= alpha;
#pragma unroll
            for (int eb = 0; eb < 4; ++eb)
#pragma unroll
              for (int i = 0; i < 16; ++i) O[eb][i] *= alpha;
          }
          const float sh = off - mrun;
          float psum = 0.f;
#pragma unroll
          for (int kb = 0; kb < 2; ++kb)
#pragma unroll
            for (int r = 0; r < 16; ++r) { const float pv = __builtin_amdgcn_exp2f(S[kb][r] * sc + sh); S[kb][r] = pv; psum += pv; }
          lrun += psum;
          __builtin_amdgcn_sched_barrier(0);
#pragma unroll
          for (int eb = 0; eb < 4; ++eb) vf[0][eb] = *(const LAS bf16x8*)(buf + KBUF + (eb * 32 + qi) * VROW + (g * 8) * 2);
#pragma unroll
          for (int stp = 0; stp < 4; ++stp) {
            const int kb = stp >> 1, hh = stp & 1;
            if (stp < 3) {
#pragma unroll
              for (int eb = 0; eb < 4; ++eb) vf[(stp + 1) & 1][eb] = *(const LAS bf16x8*)(buf + KBUF + (eb * 32 + qi) * VROW + ((stp + 1) * 16 + g * 8) * 2);
            }
            const bf16x8 pb = pack8(S[kb], hh);
#pragma unroll
            for (int eb = 0; eb < 4; ++eb) O[eb] = __builtin_amdgcn_mfma_f32_32x32x16_bf16(vf[stp & 1][eb], pb, O[eb], 0, 0, 0);
          }
        };
        u32x4 rkB, rvB0, rvB1;
        { const u16* kg2 = kg + (size_t)1 * 64 * 1024; const u16* vg2 = vg + 64;
          rk0 = *(const u32x4*)(kg2); rv0 = *(const u32x4*)(vg2); rv1 = *(const u32x4*)(vg2 + 8);
          const u16* kg3 = kg + (size_t)2 * 64 * 1024; const u16* vg3 = vg + 128;
          rkB = *(const u32x4*)(kg3); rvB0 = *(const u32x4*)(vg3); rvB1 = *(const u32x4*)(vg3 + 8); }
#pragma unroll 1
        for (int kt = 0; kt < 128; kt += 2) {
          LAS unsigned char* buf0 = lds; LAS unsigned char* buf1 = lds + ABUF;
          compute_tile(kt, buf0);
          *(LAS u32x4*)(buf1 + kl) = rk0; *(LAS u32x4*)(buf1 + vl) = rv0; *(LAS u32x4*)(buf1 + vl + 16) = rv1;
          { const int tn = kt + 3 < 128 ? kt + 3 : 127; const u16* kg2 = kg + (size_t)tn * 64 * 1024; const u16* vg2 = vg + tn * 64;
            rk0 = *(const u32x4*)(kg2); rv0 = *(const u32x4*)(vg2); rv1 = *(const u32x4*)(vg2 + 8); }
          __syncthreads();
          compute_tile(kt + 1, buf1);
          *(LAS u32x4*)(buf0 + kl) = rkB; *(LAS u32x4*)(buf0 + vl) = rvB0; *(LAS u32x4*)(buf0 + vl + 16) = rvB1;
          { const int tn = kt + 4 < 128 ? kt + 4 : 127; const u16* kg2 = kg + (size_t)tn * 64 * 1024; const u16* vg2 = vg + tn * 64;
            rkB = *(const u32x4*)(kg2); rvB0 = *(const u32x4*)(vg2); rvB1 = *(const u32x4*)(vg2 + 8); }
          __syncthreads();
        }
        const float lt = lrun + __shfl_xor(lrun, 32);
        asm volatile("" : "+v"(osv));
        if (c == 0) {
          const float i0 = 1.f / lt;
#pragma unroll
          for (int eb = 0; eb < 4; ++eb)
#pragma unroll
            for (int i = 0; i < 16; i += 4) { f32x4 t4; t4[0] = O[eb][i] * i0; t4[1] = O[eb][i + 1] * i0; t4[2] = O[eb][i + 2] * i0; t4[3] = O[eb][i + 3] * i0; *(f32x4*)(osv + eb * 16 + i) = t4; }
        } else {
          const float i1 = scal[0] / lt;
          float ss = 0.f;
#pragma unroll
          for (int eb = 0; eb < 4; ++eb)
#pragma unroll
            for (int i = 0; i < 16; i += 4) { const f32x4 t4 = *(const f32x4*)(osv + eb * 16 + i);
#pragma unroll
              for (int j = 0; j < 4; ++j) { const float o = t4[j] - O[eb][i + j] * i1; O[eb][i + j] = o; ss += o * o; } }
          ss += __shfl_xor(ss, 32);
          const float rs = rsqrtf(ss * (1.f / 128.f) + LN_EPS) * (1.f - lam_init);
          u16* op = PB + (tokbase + q0 + qi) * 1024 + h * 128;
#pragma unroll
          for (int eb = 0; eb < 4; ++eb)
#pragma unroll
            for (int rr = 0; rr < 4; ++rr) {
              const int e = eb * 32 + 8 * rr + 4 * g;
              const f32x4 gg = *(const f32x4*)(subg + e);
              u32x2 pk; pk.x = cvt_pk_bf16(O[eb][4 * rr] * rs * gg[0], O[eb][4 * rr + 1] * rs * gg[1]); pk.y = cvt_pk_bf16(O[eb][4 * rr + 2] * rs * gg[2], O[eb][4 * rr + 3] * rs * gg[3]);
              *(u32x2*)(op + e) = pk;
            }
        }
      }
    }
  }
}

DI float softplusf_(float x) { return fmaxf(x, 0.f) + __logf(1.f + __expf(-fabsf(x))); }
DI void load_bf16x8(const u16* p, float (&o)[8]) {
  const u32x4 v = *(const u32x4*)p;
#pragma unroll
  for (int i = 0; i < 4; ++i) { o[2 * i] = __uint_as_float(v[i] << 16); o[2 * i + 1] = __uint_as_float(v[i] & 0xffff0000u); }
}
DI void shifted8(const u16* PA, size_t row, int t, int col, const float* mu0, const float* mu1, float (&o)[8]) {
  float c[8], pv[8], nx[8];
  load_bf16x8(PA + row * A_COLS + col, c);
  if (t > 0) load_bf16x8(PA + (row - 1) * A_COLS + col, pv); else { for (int i = 0; i < 8; ++i) pv[i] = 0.f; }
  if (t < T - 1) load_bf16x8(PA + (row + 1) * A_COLS + col, nx); else { for (int i = 0; i < 8; ++i) nx[i] = 0.f; }
#pragma unroll
  for (int i = 0; i < 8; ++i) o[i] = c[i] + mu0[col + i] * (pv[i] - c[i]) + mu1[col + i] * (nx[i] - c[i]);
}

DI void vprep_phase(LAS unsigned char* lds, const u16* PA, u16* VV, const float* mu, const float* vdown, const float* vup, const float* v0, int layer) {
  int tid = threadIdx.x; asm volatile("" : "+v"(tid));
  int bid = blockIdx.x, gdim = gridDim.x; asm volatile("" : "+s"(bid), "+s"(gdim));
  const int tok = tid >> 4, j = tid & 15;
  LAS float* vs = (LAS float*)lds;
  LAS float* dd = vs + 32 * 516;
  LAS unsigned* DN = (LAS unsigned*)(dd + 1024);
  LAS unsigned* UP = DN + 512 * 16;
  const float* mu0 = mu; const float* mu1 = mu + A_COLS;
  __syncthreads();
  if (layer != 0) {
    for (int i = tid; i < 512 * 16; i += NTHREADS) { const float2 w2 = *(const float2*)(vdown + 2 * i); DN[i] = cvt_pk_bf16(w2.x, w2.y); }
    for (int i = tid; i < 32 * 256; i += NTHREADS) { const float2 w2 = *(const float2*)(vup + 2 * i); UP[i] = cvt_pk_bf16(w2.x, w2.y); }
  }
  for (int it = bid; it < NT / 32; it += gdim) {
    const size_t row = (size_t)it * 32 + tok; const int t = (int)(row % T);
    __syncthreads();
#pragma unroll 1
    for (int q = 0; q < 4; ++q) {
      const int cc = q * 128 + j * 8;
      float o[8]; shifted8(PA, row, t, OFF_V + cc, mu0, mu1, o);
      if (layer == 0) {
        u32x4 pk; pk.x = cvt_pk_bf16(o[0], o[1]); pk.y = cvt_pk_bf16(o[2], o[3]); pk.z = cvt_pk_bf16(o[4], o[5]); pk.w = cvt_pk_bf16(o[6], o[7]);
        *(u32x4*)(VV + row * 512 + cc) = pk;
      } else {
        *(LAS f32x4*)(vs + tok * 516 + cc) = (f32x4){o[0], o[1], o[2], o[3]}; *(LAS f32x4*)(vs + tok * 516 + cc + 4) = (f32x4){o[4], o[5], o[6], o[7]};
      }
    }
    if (layer == 0) continue;
    __syncthreads();
    {
      float d0 = 0.f, d1 = 0.f;
#pragma unroll 8
      for (int c = 0; c < 512; ++c) { const float x = vs[tok * 516 + c]; const unsigned w2 = DN[c * 16 + j]; d0 += x * __uint_as_float(w2 << 16); d1 += x * __uint_as_float(w2 & 0xffff0000u); }
      dd[tok * 32 + 2 * j] = d0; dd[tok * 32 + 2 * j + 1] = d1;
    }
    __syncthreads();
#pragma unroll 1
    for (int q = 0; q < 4; ++q) {
      const int c0 = q * 128 + j * 8;
      float acc[8];
      { const f32x4 a0 = *(const f32x4*)(v0 + c0), a1 = *(const f32x4*)(v0 + c0 + 4);
#pragma unroll
        for (int i = 0; i < 4; ++i) { acc[i] = a0[i]; acc[4 + i] = a1[i]; } }
#pragma unroll 8
      for (int r = 0; r < 32; ++r) {
        const float dv = dd[tok * 32 + r];
        const u32x4 w8 = *(const LAS u32x4*)(UP + r * 256 + (c0 >> 1));
#pragma unroll
        for (int i = 0; i < 4; ++i) { acc[2 * i] += dv * __uint_as_float(w8[i] << 16); acc[2 * i + 1] += dv * __uint_as_float(w8[i] & 0xffff0000u); }
      }
      float vf[8]; load_bf16x8(VV + row * 512 + c0, vf);
      const f32x4 x0 = *(const LAS f32x4*)(vs + tok * 516 + c0), x1 = *(const LAS f32x4*)(vs + tok * 516 + c0 + 4);
      float o[8];
#pragma unroll
      for (int i = 0; i < 4; ++i) { o[i] = x0[i] + (vf[i] - x0[i]) * sigmoidf_(acc[i]); o[4 + i] = x1[i] + (vf[4 + i] - x1[i]) * sigmoidf_(acc[4 + i]); }
      u32x4 pk; pk.x = cvt_pk_bf16(o[0], o[1]); pk.y = cvt_pk_bf16(o[2], o[3]); pk.z = cvt_pk_bf16(o[4], o[5]); pk.w = cvt_pk_bf16(o[6], o[7]);
      *(u32x4*)(VV + row * 512 + c0) = pk;
    }
  }
}

struct ScanW { const float *mu, *w0, *du, *a0, *iu, *kk_, *ka, *rk; };
constexpr int SC = 32;
DI float quad_sum(float x) {
  x += __builtin_bit_cast(float, __builtin_amdgcn_update_dpp(0, __builtin_bit_cast(int, x), 0xB1, 0xf, 0xf, true));
  x += __builtin_bit_cast(float, __builtin_amdgcn_update_dpp(0, __builtin_bit_cast(int, x), 0x4E, 0xf, 0xf, true));
  return x;
}
#define BFLO(x) __uint_as_float((x) << 16)
#define BFHI(x) __uint_as_float((x) & 0xffff0000u)
DI float tanh_fast(float x) { x = fminf(fmaxf(x, -15.f), 15.f); const float t = __expf(2.f * x); return (t - 1.f) / (t + 1.f); }
DI float shift1(float c, float p, float n, float m0, float m1) { return c + m0 * (p - c) + m1 * (n - c); }
DI void scan_produce(LAS float* buf, LAS unsigned* TW, LAS unsigned* TA, LAS const unsigned* DU, LAS const unsigned* IU, const u16* PA, const u16* VV, float* BON,
                     const ScanW& w, int ptid, int sq, int h, int dir, int t0) {
  const int tok = ptid >> 3, j = ptid & 7;
  const int t = t0 + tok; const size_t row = (size_t)sq * T + t;
  const float* mu0 = w.mu; const float* mu1 = w.mu + A_COLS;
  const int cr = h * 64 + j * 8, ck = OFF_K + cr, cw_ = OFF_WD + dir * 32 + j * 4, ca_ = OFF_AD + dir * 32 + j * 4;
  const u16* pc = PA + row * A_COLS;
  const bool hp = t > 0, hn = t < T - 1;
  {
    const u32x2 w_c = *(const u32x2*)(pc + cw_), a_c = *(const u32x2*)(pc + ca_);
    u32x2 w_p = (u32x2){0u, 0u}, a_p = w_p, w_n = w_p, a_n = w_p;
    if (hp) { w_p = *(const u32x2*)(pc - A_COLS + cw_); a_p = *(const u32x2*)(pc - A_COLS + ca_); }
    if (hn) { w_n = *(const u32x2*)(pc + A_COLS + cw_); a_n = *(const u32x2*)(pc + A_COLS + ca_); }
    const f32x4 mw0 = *(const f32x4*)(mu0 + cw_), mw1 = *(const f32x4*)(mu1 + cw_), ma0 = *(const f32x4*)(mu0 + ca_), ma1 = *(const f32x4*)(mu1 + ca_);
    f32x4 tw, ta;
#pragma unroll
    for (int i = 0; i < 2; ++i) {
      tw[2 * i] = tanh_fast(shift1(BFLO(w_c[i]), BFLO(w_p[i]), BFLO(w_n[i]), mw0[2 * i], mw1[2 * i]));
      tw[2 * i + 1] = tanh_fast(shift1(BFHI(w_c[i]), BFHI(w_p[i]), BFHI(w_n[i]), mw0[2 * i + 1], mw1[2 * i + 1]));
      ta[2 * i] = shift1(BFLO(a_c[i]), BFLO(a_p[i]), BFLO(a_n[i]), ma0[2 * i], ma1[2 * i]);
      ta[2 * i + 1] = shift1(BFHI(a_c[i]), BFHI(a_p[i]), BFHI(a_n[i]), ma0[2 * i + 1], ma1[2 * i + 1]);
    }
    u32x2 tw2, ta2; tw2.x = cvt_pk_bf16(tw[0], tw[1]); tw2.y = cvt_pk_bf16(tw[2], tw[3]); ta2.x = cvt_pk_bf16(ta[0], ta[1]); ta2.y = cvt_pk_bf16(ta[2], ta[3]);
    *(LAS u32x2*)(TW + tok * 16 + j * 2) = tw2; *(LAS u32x2*)(TA + tok * 16 + j * 2) = ta2;
  }
  asm volatile("s_waitcnt lgkmcnt(0)" ::: "memory");
  float wl[8], al[8];
  const int cc = j * 8, cg_ = h * 64 + cc;
  { const f32x4 x0 = *(const f32x4*)(w.w0 + dir * 512 + cg_), x1 = *(const f32x4*)(w.w0 + dir * 512 + cg_ + 4), y0 = *(const f32x4*)(w.a0 + dir * 512 + cg_), y1 = *(const f32x4*)(w.a0 + dir * 512 + cg_ + 4);
#pragma unroll
    for (int q = 0; q < 4; ++q) { wl[q] = x0[q]; wl[4 + q] = x1[q]; al[q] = y0[q]; al[4 + q] = y1[q]; } }
#pragma unroll 2
  for (int pr = 0; pr < 16; ++pr) {
    const bf2 twp = __builtin_bit_cast(bf2, TW[tok * 16 + pr]), tap = __builtin_bit_cast(bf2, TA[tok * 16 + pr]);
    const u32x4 d0 = *(const LAS u32x4*)(DU + pr * 64 + cc), d1 = *(const LAS u32x4*)(DU + pr * 64 + cc + 4), i0 = *(const LAS u32x4*)(IU + pr * 64 + cc), i1 = *(const LAS u32x4*)(IU + pr * 64 + cc + 4);
#pragma unroll
    for (int q = 0; q < 4; ++q) {
      unsigned ua = d0[q], ub = d1[q], uc = i0[q], ud = i1[q]; asm volatile("" : "+v"(ua), "+v"(ub), "+v"(uc), "+v"(ud));
      wl[q] = __builtin_amdgcn_fdot2_f32_bf16(twp, __builtin_bit_cast(bf2, ua), wl[q], false); wl[4 + q] = __builtin_amdgcn_fdot2_f32_bf16(twp, __builtin_bit_cast(bf2, ub), wl[4 + q], false);
      al[q] = __builtin_amdgcn_fdot2_f32_bf16(tap, __builtin_bit_cast(bf2, uc), al[q], false); al[4 + q] = __builtin_amdgcn_fdot2_f32_bf16(tap, __builtin_bit_cast(bf2, ud), al[4 + q], false);
    }
  }
#pragma unroll
  for (int q = 0; q < 8; ++q) { asm volatile("" : "+v"(wl[q]), "+v"(al[q])); }
  LAS float* AW = buf; LAS float* AK = buf + 2048; LAS float* AB = buf + 4096; LAS float* AD = buf + 6144; LAS float* AR = buf + 8192; LAS float* AV = buf + 10240;
  const int o = tok * 64 + cc;
  float ss = 0.f, bs = 0.f;
  float ok[8], av[8];
#pragma unroll
  for (int hq = 0; hq < 2; ++hq) {
    const int c4 = 4 * hq;
    const u32x2 r_c = *(const u32x2*)(pc + cr + c4), k_c = *(const u32x2*)(pc + ck + c4);
    u32x2 r_p = (u32x2){0u, 0u}, k_p = r_p, r_n = r_p, k_n = r_p;
    if (hp) { r_p = *(const u32x2*)(pc - A_COLS + cr + c4); k_p = *(const u32x2*)(pc - A_COLS + ck + c4); }
    if (hn) { r_n = *(const u32x2*)(pc + A_COLS + cr + c4); k_n = *(const u32x2*)(pc + A_COLS + ck + c4); }
    const u32x2 v_c = *(const u32x2*)(VV + row * 512 + cr + c4);
    const f32x4 mr0 = *(const f32x4*)(mu0 + cr + c4), mr1 = *(const f32x4*)(mu1 + cr + c4), mk0 = *(const f32x4*)(mu0 + ck + c4), mk1 = *(const f32x4*)(mu1 + ck + c4);
    const f32x4 kk4 = *(const f32x4*)(w.kk_ + cg_ + c4), ka4 = *(const f32x4*)(w.ka + cg_ + c4), rk4 = *(const f32x4*)(w.rk + cg_ + c4);
    f32x4 rv, kv, vv, ow, od;
#pragma unroll
    for (int i = 0; i < 2; ++i) {
      rv[2 * i] = shift1(BFLO(r_c[i]), BFLO(r_p[i]), BFLO(r_n[i]), mr0[2 * i], mr1[2 * i]);
      rv[2 * i + 1] = shift1(BFHI(r_c[i]), BFHI(r_p[i]), BFHI(r_n[i]), mr0[2 * i + 1], mr1[2 * i + 1]);
      kv[2 * i] = shift1(BFLO(k_c[i]), BFLO(k_p[i]), BFLO(k_n[i]), mk0[2 * i], mk1[2 * i]);
      kv[2 * i + 1] = shift1(BFHI(k_c[i]), BFHI(k_p[i]), BFHI(k_n[i]), mk0[2 * i + 1], mk1[2 * i + 1]);
      vv[2 * i] = BFLO(v_c[i]); vv[2 * i + 1] = BFHI(v_c[i]);
    }
#pragma unroll
    for (int q = 0; q < 4; ++q) {
      const float wlog = -softplusf_(-wl[c4 + q]) - 0.5f;
      ow[q] = __expf(-__expf(wlog));
      const float a = sigmoidf_(al[c4 + q]);
      av[c4 + q] = a;
      ok[c4 + q] = kv[q] * kk4[q]; ss += ok[c4 + q] * ok[c4 + q];
      od[q] = kv[q] * (1.f + (a - 1.f) * ka4[q]);
      bs += rv[q] * od[q] * rk4[q];
    }
    *(LAS f32x4*)(AW + o + c4) = ow; *(LAS f32x4*)(AD + o + c4) = od; *(LAS f32x4*)(AR + o + c4) = rv; *(LAS f32x4*)(AV + o + c4) = vv;
  }
#pragma unroll
  for (int sft = 1; sft < 8; sft <<= 1) { ss += __shfl_xor(ss, sft); bs += __shfl_xor(bs, sft); }
  const float rn = rsqrtf(ss + 1e-12f);
#pragma unroll
  for (int hq = 0; hq < 2; ++hq) {
    f32x4 k4, b4;
#pragma unroll
    for (int q = 0; q < 4; ++q) { k4[q] = ok[4 * hq + q] * rn; b4[q] = k4[q] * av[4 * hq + q]; }
    *(LAS f32x4*)(AK + o + 4 * hq) = k4; *(LAS f32x4*)(AB + o + 4 * hq) = b4;
  }
  if (j == 0) BON[((size_t)dir * NT + row) * 8 + h] = bs;
}
struct ScanOps { f32x4 k4[4], w4[4], b4[4], d4[4]; float vi; };
DI void scan_load(ScanOps& o, LAS const float* buf, int tt, int jseg, int irow) {
  const int off = tt * 64 + jseg * 16;
#pragma unroll
  for (int q = 0; q < 4; ++q) {
    o.w4[q] = *(const LAS f32x4*)(buf + off + q * 4); o.k4[q] = *(const LAS f32x4*)(buf + 2048 + off + q * 4); o.b4[q] = *(const LAS f32x4*)(buf + 4096 + off + q * 4);
    o.d4[q] = *(const LAS f32x4*)(buf + 6144 + off + q * 4);
  }
  o.vi = buf[10240 + tt * 64 + irow];
}
DI float scan_step(f32x4 (&S)[4], const ScanOps& o, LAS const float* buf, int tt, int jseg) {
  f32x4 r4[4];
#pragma unroll
  for (int q = 0; q < 4; ++q) r4[q] = *(const LAS f32x4*)(buf + 8192 + tt * 64 + jseg * 16 + q * 4);
  f32x4 a4 = S[0] * o.k4[0] + S[1] * o.k4[1] + S[2] * o.k4[2] + S[3] * o.k4[3];
  float sa = -quad_sum((a4[0] + a4[1]) + (a4[2] + a4[3]));
  f32x4 y4 = (f32x4){0.f, 0.f, 0.f, 0.f};
#pragma unroll
  for (int q = 0; q < 4; ++q) { S[q] = S[q] * o.w4[q] + (o.b4[q] * sa + o.d4[q] * o.vi); y4 += S[q] * r4[q]; }
  return quad_sum((y4[0] + y4[1]) + (y4[2] + y4[3]));
}
DI void scan_phase(LAS unsigned char* lds, const u16* PA, const u16* VV, u16* YY, float* BON, const ScanW w) {
  int tid = threadIdx.x; asm volatile("" : "+v"(tid));
  int bid = blockIdx.x, gdim = gridDim.x; asm volatile("" : "+s"(bid), "+s"(gdim));
  LAS float* BUF = (LAS float*)lds;
  LAS float* AY = BUF + 2 * 12288;
  LAS unsigned* TW = (LAS unsigned*)(AY + 2 * 2048);
  LAS unsigned* TA = TW + SC * 16;
  LAS unsigned* DU = TA + SC * 16;
  LAS unsigned* IU = DU + 1024;
  const int wid = __builtin_amdgcn_readfirstlane(tid >> 6), lane = tid & 63;
  const int NCH = T / SC;
  for (int item = bid; item < 192; item += gdim) {
    const int dir = item & 1, h = (item >> 1) & 7, sq = item >> 4;
    __syncthreads();
    for (int i = tid; i < 1024; i += NTHREADS) { const int pr = i >> 6, c = i & 63; const size_t o0 = (size_t)(dir * 32 + 2 * pr) * 512 + h * 64 + c;
      DU[i] = cvt_pk_bf16(w.du[o0], w.du[o0 + 512]); IU[i] = cvt_pk_bf16(w.iu[o0], w.iu[o0 + 512]); }
    __syncthreads();
    f32x4 S[4];
#pragma unroll
    for (int q = 0; q < 4; ++q) S[q] = (f32x4){0.f, 0.f, 0.f, 0.f};
    const int irow = (wid & 3) * 16 + (lane >> 2), jseg = lane & 3;
    if (wid >= 4) scan_produce(BUF, TW, TA, DU, IU, PA, VV, BON, w, tid - 256, sq, h, dir, dir == 0 ? 0 : T - SC);
    __syncthreads();
#pragma unroll 1
    for (int ci = 0; ci < NCH; ++ci) {
      LAS float* buf = BUF + (ci & 1) * 12288;
      LAS float* ay = AY + (ci & 1) * 2048;
      if (wid < 4) {
        ScanOps o0, o1;
        scan_load(o0, buf, dir == 0 ? 0 : SC - 1, jseg, irow);
#pragma unroll 1
        for (int st = 0; st < SC; st += 2) {
          const int t0_ = dir == 0 ? st : SC - 1 - st, t1_ = dir == 0 ? st + 1 : SC - 2 - st;
          scan_load(o1, buf, t1_, jseg, irow);
          const float y0 = scan_step(S, o0, buf, t0_, jseg);
          if (jseg == 0) ay[t0_ * 64 + irow] = y0;
          if (st + 2 < SC) scan_load(o0, buf, dir == 0 ? st + 2 : SC - 3 - st, jseg, irow);
          const float y1 = scan_step(S, o1, buf, t1_, jseg);
          if (jseg == 0) ay[t1_ * 64 + irow] = y1;
        }
      } else {
        const int ptid = tid - 256;
        if (ci + 1 < NCH) scan_produce(BUF + ((ci + 1) & 1) * 12288, TW, TA, DU, IU, PA, VV, BON, w, ptid, sq, h, dir, dir == 0 ? (ci + 1) * SC : T - SC * (ci + 2));
        if (ci > 0) {
          LAS const float* py = AY + ((ci - 1) & 1) * 2048;
          const int t0p = dir == 0 ? (ci - 1) * SC : T - SC * ci;
          const int tok = ptid >> 3, c0 = (ptid & 7) * 8;
          const f32x4 ya = *(const LAS f32x4*)(py + tok * 64 + c0), yb = *(const LAS f32x4*)(py + tok * 64 + c0 + 4);
          u32x4 pk; pk.x = cvt_pk_bf16(ya[0], ya[1]); pk.y = cvt_pk_bf16(ya[2], ya[3]); pk.z = cvt_pk_bf16(yb[0], yb[1]); pk.w = cvt_pk_bf16(yb[2], yb[3]);
          *(u32x4*)(YY + ((size_t)dir * NT + (size_t)sq * T + t0p + tok) * 512 + h * 64 + c0) = pk;
        }
      }
      __syncthreads();
    }
    if (wid >= 4) {
      const int ptid = tid - 256;
      LAS const float* py = AY + ((NCH - 1) & 1) * 2048;
      const int t0p = dir == 0 ? (NCH - 1) * SC : 0;
      const int tok = ptid >> 3, c0 = (ptid & 7) * 8;
      const f32x4 ya = *(const LAS f32x4*)(py + tok * 64 + c0), yb = *(const LAS f32x4*)(py + tok * 64 + c0 + 4);
      u32x4 pk; pk.x = cvt_pk_bf16(ya[0], ya[1]); pk.y = cvt_pk_bf16(ya[2], ya[3]); pk.z = cvt_pk_bf16(yb[0], yb[1]); pk.w = cvt_pk_bf16(yb[2], yb[3]);
      *(u32x4*)(YY + ((size_t)dir * NT + (size_t)sq * T + t0p + tok) * 512 + h * 64 + c0) = pk;
    }
  }
}

DI void post_phase(LAS unsigned char* lds, u16* PA, const u16* PB, const u16* VV, const u16* YY, const float* BON, const float* mu, const float* gup, const float* gng, const float* gnb) {
  int tid = threadIdx.x; asm volatile("" : "+v"(tid));
  int bid = blockIdx.x, gdim = gridDim.x; asm volatile("" : "+s"(bid), "+s"(gdim));
  const int tok = tid >> 4, j = tid & 15;
  LAS unsigned* SG2 = (LAS unsigned*)lds;
  LAS unsigned* GU = (LAS unsigned*)(lds + 16384);
  const float* mu0 = mu; const float* mu1 = mu + A_COLS;
  __syncthreads();
  for (int e = tid; e < 48 * 512; e += NTHREADS) { const int r2 = e >> 9, c = e & 511; GU[(r2 * 2 + ((c >> 2) & 1)) * 256 + (c >> 3) * 4 + (c & 3)] = cvt_pk_bf16(gup[(2 * r2) * 512 + c], gup[(2 * r2 + 1) * 512 + c]); }
  for (int it = bid; it < NT / 32; it += gdim) {
    const size_t row = (size_t)it * 32 + tok; const int t = (int)(row % T);
    __syncthreads();
    { float sv[6];
#pragma unroll
      for (int q = 0; q < 6; ++q) {
        const int col = OFF_GD + j * 6 + q;
        const float c = bf2f(PA[row * A_COLS + col]);
        const float pv = t > 0 ? bf2f(PA[(row - 1) * A_COLS + col]) : 0.f, nx = t < T - 1 ? bf2f(PA[(row + 1) * A_COLS + col]) : 0.f;
        sv[q] = sigmoidf_(c + mu0[col] * (pv - c) + mu1[col] * (nx - c));
      }
#pragma unroll
      for (int pq = 0; pq < 3; ++pq) SG2[tok * 48 + j * 3 + pq] = cvt_pk_bf16(sv[2 * pq], sv[2 * pq + 1]); }
    __syncthreads();
#pragma unroll 1
    for (int q = 0; q < 4; ++q) {
      const int cc = q * 128 + j * 8, h = 2 * q + (j >> 3);
      float y[8]; float sm = 0.f;
      { float a[8], b[8]; load_bf16x8(YY + row * 512 + cc, a); load_bf16x8(YY + ((size_t)NT + row) * 512 + cc, b);
#pragma unroll
        for (int i = 0; i < 8; ++i) { y[i] = a[i] + b[i]; sm += y[i]; } }
      sm += __shfl_xor(sm, 1); sm += __shfl_xor(sm, 2); sm += __shfl_xor(sm, 4);
      const float mean = sm * (1.f / 64.f);
      float vq = 0.f;
#pragma unroll
      for (int i = 0; i < 8; ++i) { y[i] -= mean; vq += y[i] * y[i]; }
      vq += __shfl_xor(vq, 1); vq += __shfl_xor(vq, 2); vq += __shfl_xor(vq, 4);
      const float rs = rsqrtf(vq * (1.f / 64.f) + GN_EPS);
      const float bon = BON[row * 8 + h] + BON[((size_t)NT + row) * 8 + h];
      float gacc[8];
#pragma unroll
      for (int i = 0; i < 8; ++i) gacc[i] = 0.f;
#pragma unroll 8
      for (int r2 = 0; r2 < 48; ++r2) {
        const bf2 sv = __builtin_bit_cast(bf2, SG2[tok * 48 + r2]);
        const u32x4 wa = *(const LAS u32x4*)(GU + (r2 * 2 + 0) * 256 + (cc >> 3) * 4), wb = *(const LAS u32x4*)(GU + (r2 * 2 + 1) * 256 + (cc >> 3) * 4);
#pragma unroll
        for (int i = 0; i < 4; ++i) { unsigned ua = wa[i], ub = wb[i]; asm volatile("" : "+v"(ua), "+v"(ub));
          gacc[i] = __builtin_amdgcn_fdot2_f32_bf16(sv, __builtin_bit_cast(bf2, ua), gacc[i], false); gacc[4 + i] = __builtin_amdgcn_fdot2_f32_bf16(sv, __builtin_bit_cast(bf2, ub), gacc[4 + i], false); }
      }
      float vv[8]; load_bf16x8(VV + row * 512 + cc, vv);
      const f32x4 g0 = *(const f32x4*)(gng + cc), g1 = *(const f32x4*)(gng + cc + 4), b0 = *(const f32x4*)(gnb + cc), b1 = *(const f32x4*)(gnb + cc + 4);
      float o[8];
#pragma unroll
      for (int i = 0; i < 4; ++i) { o[i] = (y[i] * rs * g0[i] + b0[i] + bon * vv[i]) * gacc[i]; o[4 + i] = (y[4 + i] * rs * g1[i] + b1[i] + bon * vv[4 + i]) * gacc[4 + i]; }
      u32x4 pk; pk.x = cvt_pk_bf16(o[0], o[1]); pk.y = cvt_pk_bf16(o[2], o[3]); pk.z = cvt_pk_bf16(o[4], o[5]); pk.w = cvt_pk_bf16(o[6], o[7]);
      if (DBGZ & 1) pk = (u32x4){0u, 0u, 0u, 0u};
      *(u32x4*)(PA + row * A_COLS + cc) = pk;
      u32x4 pb4 = *(const u32x4*)(PB + row * 1024 + cc); if (DBGZ & 2) pb4 = (u32x4){0u, 0u, 0u, 0u};
      *(u32x4*)(PA + row * A_COLS + 512 + cc) = pb4;
    }
  }
}

DI unsigned hashu(unsigned x) { x ^= x >> 16; x *= 0x7feb352du; x ^= x >> 15; x *= 0x846ca68bu; x ^= x >> 16; return x; }
DI void dbg_upd(float* slot, float got, float ref, float scale) { float e = fabsf(got - ref) / scale; if (!(e == e)) e = 1e9f; atomicMax((unsigned*)slot, __float_as_uint(e)); }
DI float tshift(const u16* PA, size_t row, int col, const float* mu) {
  const int t = (int)(row % T);
  const float c = bf2f(PA[row * A_COLS + col]);
  const float pv = t > 0 ? bf2f(PA[(row - 1) * A_COLS + col]) : 0.f, nx = t < T - 1 ? bf2f(PA[(row + 1) * A_COLS + col]) : 0.f;
  return c + mu[col] * (pv - c) + mu[A_COLS + col] * (nx - c);
}
DI void chk_proj(const u16* XB, const float* win, const u16* PA, const u16* PB, const u16* VT, float* slot) {
  const int gt = blockIdx.x * NTHREADS + threadIdx.x;
  if (gt >= 4096) return;
  const int row = hashu(gt * 2 + 1) % NT, col = hashu(gt * 2 + 2) % P_COLS;
  float ref = 0.f;
  for (int k = 0; k < D; ++k) ref += bf2f(XB[(size_t)row * D + k]) * win[(size_t)k * P_COLS + col];
  float got;
  if (col < A_COLS) got = bf2f(PA[(size_t)row * A_COLS + col]);
  else if (col < A_COLS + 1024) got = bf2f(PB[(size_t)row * 1024 + col - A_COLS]);
  else { const int c2 = col - A_COLS - 1024, h = c2 >> 7, e = c2 & 127, sq = row / T, t = row % T; got = bf2f(VT[((size_t)((sq * 4 + h) * 128 + e)) * T + t]); }
  dbg_upd(slot, got, ref, 1.f);
}
DI void chk_ffn(const u16* XB, const float* wup, const float* cw, const float* cb, const u16* G, float* slot) {
  const int gt = blockIdx.x * NTHREADS + threadIdx.x;
  if (gt >= 4096) return;
  int row = hashu(gt * 2 + 11) % NT; const int n = hashu(gt * 2 + 12) % DFF;
  if (gt < 64) row = (gt & 1) ? (row / T) * T + T - 1 : (row / T) * T;
  else if (gt < 1024) row = (row / T) * T + ((row % T) / 254) * 254 + (gt & 1 ? 253 : 0), row = row >= NT ? NT - 1 : row;
  const int t = row % T;
  float hg[3] = {0.f, 0.f, 0.f}, hu[3] = {0.f, 0.f, 0.f};
#pragma unroll
  for (int d = -1; d <= 1; ++d) {
    float a = 0.f, b = 0.f;
    if (!(t + d < 0 || t + d > T - 1))
      for (int k = 0; k < D; ++k) { const float x = bf2f(XB[(size_t)(row + d) * D + k]); a += x * wup[(size_t)k * NUP + n]; b += x * wup[(size_t)k * NUP + DFF + n]; }
    hg[d + 1] = a; hu[d + 1] = b;
  }
  const float got = bf2f(G[(size_t)row * DFF + n]);
  { const float g = cw[n] * hg[0] + cw[NUP + n] * hg[1] + cw[2 * NUP + n] * hg[2] + cb[n];
    const float u = cw[DFF + n] * hu[0] + cw[NUP + DFF + n] * hu[1] + cw[2 * NUP + DFF + n] * hu[2] + cb[DFF + n];
    dbg_upd(slot, got, 0.5f * g * (1.f + erff(g * 0.70710678f)) * u, 1.f); }
  { const float g = cw[n] * hg[2] + cw[NUP + n] * hg[1] + cw[2 * NUP + n] * hg[0] + cb[n];
    const float u = cw[DFF + n] * hu[2] + cw[NUP + DFF + n] * hu[1] + cw[2 * NUP + DFF + n] * hu[0] + cb[DFF + n];
    dbg_upd(slot + 1, got, 0.5f * g * (1.f + erff(g * 0.70710678f)) * u, 1.f); }
  { const float g = cw[NUP + n] * hg[1] + cb[n];
    const float u = cw[NUP + DFF + n] * hu[1] + cb[DFF + n];
    dbg_upd(slot + 2, got, 0.5f * g * (1.f + erff(g * 0.70710678f)) * u, 1.f); }
}
DI void chk_attn(LAS unsigned char* lds, const u16* XB, const float* win, const u16* PB, const u16* VT, const float* lamp, const float* subg, const float* relb, int layer, float* slot) {
  if (blockIdx.x >= 16) return;
  const int tid = threadIdx.x;
  LAS float* qv = (LAS float*)lds;
  LAS float* sc = qv + 128;
  LAS float* red = sc + 16384;
  LAS float* ov = red + 1024;
  const int smp = blockIdx.x;
  const int sq = hashu(smp + 77) % NSEQ, h = smp & 3;
  int q = hashu(smp + 99) % T; if (smp < 4) q = smp * 37; if (smp >= 12) q = T - 1 - (smp - 12) * 50;
  const size_t row = (size_t)sq * T + q;
  __syncthreads();
  if (tid < 128) { float a = 0.f; const int col = A_COLS + h * 128 + tid; for (int k = 0; k < D; ++k) a += bf2f(XB[row * D + k]) * win[(size_t)k * P_COLS + col]; qv[tid] = a; }
  __syncthreads();
  float mx0 = -1e30f, mx1 = -1e30f;
  for (int key = tid; key < T; key += NTHREADS) {
    const u16* kp = PB + ((size_t)sq * T + key) * 1024 + 512 + h * 128;
    float s0 = 0.f, s1 = 0.f;
    for (int d = 0; d < 64; ++d) { s0 += qv[d] * bf2f(kp[d]); s1 += qv[64 + d] * bf2f(kp[64 + d]); }
    const int rel = key - q, n = rel < 0 ? -rel : rel;
    int bk;
    if (n < 8) bk = n; else { bk = 8 + (int)(logf((float)n / 8.f) / logf(16.f) * 8.f); bk = bk > 15 ? 15 : bk; }
    if (rel > 0) bk += 16;
    const float bias = relb[bk * 4 + h];
    s0 = s0 * 0.125f + bias; s1 = s1 * 0.125f + bias;
    sc[key] = s0; sc[8192 + key] = s1; mx0 = fmaxf(mx0, s0); mx1 = fmaxf(mx1, s1);
  }
  red[tid] = mx0; red[512 + tid] = mx1; __syncthreads();
  for (int o = 256; o > 0; o >>= 1) { if (tid < o) { red[tid] = fmaxf(red[tid], red[tid + o]); red[512 + tid] = fmaxf(red[512 + tid], red[512 + tid + o]); } __syncthreads(); }
  mx0 = red[0]; mx1 = red[512]; __syncthreads();
  float l0 = 0.f, l1 = 0.f;
  for (int key = tid; key < T; key += NTHREADS) { const float p0 = expf(sc[key] - mx0), p1 = expf(sc[8192 + key] - mx1); sc[key] = p0; sc[8192 + key] = p1; l0 += p0; l1 += p1; }
  red[tid] = l0; red[512 + tid] = l1; __syncthreads();
  for (int o = 256; o > 0; o >>= 1) { if (tid < o) { red[tid] += red[tid + o]; red[512 + tid] += red[512 + tid + o]; } __syncthreads(); }
  l0 = red[0]; l1 = red[512]; __syncthreads();
  float la = 0.f, lb = 0.f; for (int d = 0; d < 64; ++d) { la += lamp[d] * lamp[64 + d]; lb += lamp[128 + d] * lamp[192 + d]; }
  const float lam_init = 0.8f - 0.6f * expf(-0.3f * (float)layer);
  const float lam = expf(la) - expf(lb) + lam_init;
  { const int e = tid & 127, part = tid >> 7;
    const u16* vp = VT + ((size_t)((sq * 4 + h) * 128 + e)) * T;
    float o = 0.f;
    for (int key = part * 2048; key < (part + 1) * 2048; ++key) o += (sc[key] / l0 - lam * sc[8192 + key] / l1) * bf2f(vp[key]);
    red[tid] = o; }
  __syncthreads();
  if (tid < 128) ov[tid] = red[tid] + red[128 + tid] + red[256 + tid] + red[384 + tid];
  __syncthreads();
  if (tid < 128) {
    float ss = 0.f; for (int e = 0; e < 128; ++e) ss += ov[e] * ov[e];
    const float ref = ov[tid] * rsqrtf(ss / 128.f + LN_EPS) * subg[tid] * (1.f - lam_init);
    dbg_upd(slot, bf2f(PB[row * 1024 + h * 128 + tid]), ref, 1.f);
  }
}
struct ChkOp { float r, kd, kk, b, w, v; };
DI ChkOp chk_ops(const u16* PA, const u16* VV, const ScanW& w, size_t row, int h, int dir, int c, LAS float* tmp  , int tid) {
  ChkOp o;
  const int cg_ = h * 64 + c;
  o.r = tshift(PA, row, cg_, w.mu);
  const float k = tshift(PA, row, OFF_K + cg_, w.mu);
  float wl = w.w0[dir * 512 + cg_], al = w.a0[dir * 512 + cg_];
#pragma unroll 1
  for (int rr = 0; rr < 32; ++rr) {
    wl += tanhf(tshift(PA, row, OFF_WD + dir * 32 + rr, w.mu)) * w.du[(dir * 32 + rr) * 512 + cg_];
    al += tshift(PA, row, OFF_AD + dir * 32 + rr, w.mu) * w.iu[(dir * 32 + rr) * 512 + cg_];
  }
  const float sp = logf(1.f + expf(-wl));
  o.w = expf(-expf(-sp - 0.5f));
  const float a = 1.f / (1.f + expf(-al));
  const float kkv = k * w.kk_[cg_];
  __syncthreads(); tmp[tid] = kkv * kkv; __syncthreads();
  float ss = 0.f;
#pragma unroll 1
  for (int j = 0; j < 64; ++j) ss += tmp[j];
  o.kk = kkv * rsqrtf(ss + 1e-12f);
  o.kd = k * (1.f + (a - 1.f) * w.ka[cg_]);
  o.b = o.kk * a;
  o.v = bf2f(VV[row * 512 + cg_]);
  return o;
}
DI void chk_scan(LAS unsigned char* lds, const u16* PA, const u16* VV, const u16* YY, const float* BON, const ScanW w, float* slot) {
  if (blockIdx.x >= 48 || threadIdx.x >= 64) return;
  const int tid = threadIdx.x;
  LAS float* tmp = (LAS float*)lds; LAS float* red = tmp + 64;
  const int item = blockIdx.x * 4 + 1, dir = item & 1, h = (item >> 1) & 7, sq = item >> 4;
  const int t0 = dir == 0 ? 0 : T - 1, t1 = dir == 0 ? 1 : T - 2;
  const size_t row0 = (size_t)sq * T + t0, row1 = (size_t)sq * T + t1;
  const ChkOp a = chk_ops(PA, VV, w, row0, h, dir, tid, tmp, tid);
  const ChkOp b = chk_ops(PA, VV, w, row1, h, dir, tid, tmp, tid);
#define BSUM(dst, val) { __syncthreads(); red[tid] = (val); __syncthreads(); float sx_ = 0.f; _Pragma("unroll 1") for (int j_ = 0; j_ < 64; ++j_) sx_ += red[j_]; dst = sx_; }
  float ds0, ds1, ds2, ds3, ds4;
  BSUM(ds0, a.kd * a.r) BSUM(ds1, a.kd * b.w * b.r) BSUM(ds2, a.kd * (-b.kk)) BSUM(ds3, b.b * b.r) BSUM(ds4, b.kd * b.r)
  const float y0 = a.v * ds0;
  const float y1 = a.v * (ds1 + ds2 * ds3) + b.v * ds4;
  dbg_upd(slot, bf2f(YY[((size_t)dir * NT + row0) * 512 + h * 64 + tid]), y0, fabsf(y0) + 0.05f);
  dbg_upd(slot, bf2f(YY[((size_t)dir * NT + row1) * 512 + h * 64 + tid]), y1, fabsf(y1) + 0.05f);
  float bq = a.r * a.kd * w.rk[h * 64 + tid];
  __syncthreads(); red[tid] = bq; __syncthreads(); float bs = 0.f;
#pragma unroll 1
  for (int j = 0; j < 64; ++j) bs += red[j];
  dbg_upd(slot, BON[((size_t)dir * NT + row0) * 8 + h], bs, fabsf(bs) + 0.05f);
}
DI void chk_post(const u16* PA, const u16* PB, const u16* VV, const u16* YY, const float* BON, const float* mu, const float* gup, const float* gng, const float* gnb, float* slot) {
  const int gt = blockIdx.x * NTHREADS + threadIdx.x;
  if (gt >= 2048) return;
  const size_t row = hashu(gt * 2 + 21) % NT; const int c = hashu(gt * 2 + 22) % 512, h = c >> 6;
  float sm = 0.f;
  float yc = 0.f;
  for (int i = 0; i < 64; ++i) { const float y = bf2f(YY[row * 512 + h * 64 + i]) + bf2f(YY[((size_t)NT + row) * 512 + h * 64 + i]); sm += y; if (h * 64 + i == c) yc = y; }
  const float mean = sm / 64.f; float vq = 0.f;
  for (int i = 0; i < 64; ++i) { const float y = bf2f(YY[row * 512 + h * 64 + i]) + bf2f(YY[((size_t)NT + row) * 512 + h * 64 + i]) - mean; vq += y * y; }
  const float yn = (yc - mean) * rsqrtf(vq / 64.f + GN_EPS) * gng[c] + gnb[c];
  const float bon = (BON[row * 8 + h] + BON[((size_t)NT + row) * 8 + h]) * bf2f(VV[row * 512 + c]);
  float g = 0.f;
  for (int r = 0; r < 96; ++r) g += (1.f / (1.f + expf(-tshift(PA, row, OFF_GD + r, mu)))) * gup[r * 512 + c];
  const float ref = (yn + bon) * g;
  dbg_upd(slot, bf2f(PA[row * A_COLS + c]), ref, fabsf(ref) + 0.05f);
  dbg_upd(slot + 1, bf2f(PA[row * A_COLS + 512 + c]), bf2f(PB[row * 1024 + c]), 1.f);
}

__global__ __launch_bounds__(NTHREADS, 2) void mega(Params p_unused) {
  extern __shared__ __attribute__((aligned(16))) char shm[];
  cg::grid_group grid = cg::this_grid();
  LAS unsigned char* lds = (LAS unsigned char*)shm;
#define WS_PTRS CParams p = get_params(); unsigned char* ws = p->ws; \
  u16* WIN = (u16*)(ws + OFF_WIN); u16* WOUT = (u16*)(ws + OFF_WOUT); u16* WUP = (u16*)(ws + OFF_WUP); u16* WDN = (u16*)(ws + OFF_WDN); \
  u16* XB = (u16*)(ws + OFF_XB); u16* PA = (u16*)(ws + OFF_PA); u16* PB = (u16*)(ws + OFF_PB); u16* VT = (u16*)(ws + OFF_VT); \
  u16* G = (u16*)(ws + OFF_PA); u16* VV = (u16*)(ws + OFF_VV); u16* YY = (u16*)p->out; float* BON = (float*)(ws + OFF_BON); float* XF = p->out; \
  (void)WIN; (void)WOUT; (void)WUP; (void)WDN; (void)XB; (void)PA; (void)PB; (void)VT; (void)G; (void)VV; (void)YY; (void)BON; (void)XF;
  int ph = 0;
  const int ph_lo = get_params()->ph_lo, ph_hi = get_params()->ph_hi;
#ifndef ONLYMASK
#define ONLYMASK 0xffffffffu
#endif
#define PHASE_BEGIN if (((ONLYMASK >> (__COUNTER__ % 32)) & 1u) && ph >= ph_lo && ph < ph_hi) { WS_PTRS
#define PHASE_END } ++ph; if (ph > ph_lo && ph < ph_hi) grid.sync();

  PHASE_BEGIN
    for (int l = 0; l < 2; ++l) {
      convert_weight<0>(shm, p->in[4] + (size_t)l * D * P_COLS, WIN + (size_t)l * NPROJ * D, D, P_COLS, NPROJ, blockIdx.x, gridDim.x);
      convert_weight<1>(shm, p->in[22] + (size_t)l * D * D, WOUT + (size_t)l * D * D, D, D, D, blockIdx.x, gridDim.x);
      convert_weight<2>(shm, p->in[25] + (size_t)l * D * NUP, WUP + (size_t)l * NUP * D, D, NUP, NUP, blockIdx.x, gridDim.x);
      convert_weight<1>(shm, p->in[28] + (size_t)l * DFF * D, WDN + (size_t)l * D * DFF, DFF, D, D, blockIdx.x, gridDim.x);
    }
    ln_rows(p->in[0], p->in[1], NPROMPT_TOK, XF, XB, p->in[2], p->in[3], false);
  PHASE_END

#pragma unroll 1
  for (int l = 0; l < 2; ++l) {
    PHASE_BEGIN
      Gemm ga{XB, D, WIN + (size_t)l * NPROJ * D, D};
      EpiArgs ea{}; ea.pa = PA; ea.pb = PB; ea.vt = VT;
      gemm_phase<0, 0>(lds, ga, NT / 256, NPROJ / 256, ea);
#if PROBE_GEMM
      gemm_phase<0, 0>(lds, ga, NT / 256, NPROJ / 256, ea);
#endif
    PHASE_END
#pragma unroll 1
    for (int rnd = 0; rnd < 2; ++rnd) {
      if (ph >= ph_lo && ph < ph_hi) { WS_PTRS
        int bidu = blockIdx.x, gdu = gridDim.x; asm volatile("" : "+s"(bidu), "+s"(gdu));
        const bool split = (gdu == 256);
        if (rnd == 0) vprep_phase(lds, PA, VV, p->in[5] + (size_t)l * 2 * A_COLS, p->in[16], p->in[17], p->in[18], l);
        if (rnd == 1 && (!split || bidu < 192)) {
          ScanW sw; sw.mu = p->in[5] + (size_t)l * 2 * A_COLS; sw.w0 = p->in[6] + l * 1024; sw.du = p->in[7] + (size_t)l * 2 * 32 * 512; sw.a0 = p->in[8] + l * 1024;
          sw.iu = p->in[9] + (size_t)l * 2 * 32 * 512; sw.kk_ = p->in[11] + l * 512; sw.ka = p->in[12] + l * 512; sw.rk = p->in[13] + l * 512;
          scan_phase(lds, PA, VV, YY, BON, sw);
        } else if (rnd == 0 || split) {
          const int plo = rnd == 0 ? 0 : 40, phi = (rnd == 0 && split) ? 40 : 48;
          const int wlo = rnd == 0 ? 0 : 192, wcnt = rnd == 0 ? (gdu & ~7) : 64;
          attn_phase(lds, PB, VT, (float*)(ws + OFF_OSV), p->in[19] + l * 256, p->in[20] + l * 128, p->in[21], l, plo, phi, wlo, wcnt);
        }
      }
      ++ph; if (ph > ph_lo && ph < ph_hi) grid.sync();
    }
    PHASE_BEGIN
      post_phase(lds, PA, PB, VV, YY, BON, p->in[5] + (size_t)l * 2 * A_COLS, p->in[10] + (size_t)l * 96 * 512, p->in[14] + l * 512, p->in[15] + l * 512);
#if PROBE_MISC
      post_phase(lds, PA, PB, VV, YY, BON, p->in[5] + (size_t)l * 2 * A_COLS, p->in[10] + (size_t)l * 96 * 512, p->in[14] + l * 512, p->in[15] + l * 512);
#endif
    PHASE_END
    PHASE_BEGIN
      Gemm ga{PA, A_COLS, WOUT + (size_t)l * D * D, D};
      EpiArgs ea{}; ea.xf = XF; ea.xb = XB;
      gemm_phase<1, 0>(lds, ga, NT / 256, D / 256, ea);
    PHASE_END
    PHASE_BEGIN
      ln_rows(XF, XF, NT, XF, XB, p->in[23] + l * D, p->in[24] + l * D, false);
    PHASE_END
    PHASE_BEGIN
      Gemm ga{XB, D, WUP + (size_t)l * NUP * D, D};
      EpiArgs ea{}; ea.g = G; ea.cw = p->in[26] + (size_t)l * 3 * NUP; ea.cb = p->in[27] + (size_t)l * NUP;
      gemm_phase<2, 1>(lds, ga, NSEQ * 33, NUP / 256, ea);
#if PROBE_GEMM
      gemm_phase<2, 1>(lds, ga, NSEQ * 33, NUP / 256, ea);
#endif
    PHASE_END
    PHASE_BEGIN
      Gemm ga{G, DFF, WDN + (size_t)l * D * DFF, DFF};
      EpiArgs ea{}; ea.xf = XF; ea.xb = XB; ea.zero = (DBGZ & 4) ? 1 : 0;
      gemm_phase<1, 0>(lds, ga, NT / 256, D / 256, ea);
    PHASE_END
    PHASE_BEGIN
      ln_rows(XF, XF, NT, XF, XB, p->in[29] + l * D, p->in[30] + l * D, l == 1);
    PHASE_END
  }
}

#if DBG
#define DPTRS unsigned char* ws = p.ws; u16* XB = (u16*)(ws + OFF_XB); u16* PA = (u16*)(ws + OFF_PA); u16* PB = (u16*)(ws + OFF_PB); u16* VT = (u16*)(ws + OFF_VT); \
  u16* G = (u16*)(ws + OFF_PA); u16* VV = (u16*)(ws + OFF_VV); u16* YY = (u16*)(ws + OFF_XB); float* BON = (float*)(ws + OFF_BON); float* DE = (float*)(ws + OFF_DBG); \
  (void)XB; (void)PA; (void)PB; (void)VT; (void)G; (void)VV; (void)YY; (void)BON; (void)DE;
template <int which> __global__ __launch_bounds__(NTHREADS) void k_chk(Params p, int l) {
  extern __shared__ __attribute__((aligned(16))) char shm[];
  LAS unsigned char* lds = (LAS unsigned char*)shm;
  DPTRS
  if (which == 0) chk_proj(XB, p.in[4] + (size_t)l * D * P_COLS, PA, PB, VT, DE + 0);
  else if (which == 1) chk_attn(lds, XB, p.in[4] + (size_t)l * D * P_COLS, PB, VT, p.in[19] + l * 256, p.in[20] + l * 128, p.in[21], l, DE + 1);
  else if (which == 2) {
    ScanW sw; sw.mu = p.in[5] + (size_t)l * 2 * A_COLS; sw.w0 = p.in[6] + l * 1024; sw.du = p.in[7] + (size_t)l * 2 * 32 * 512; sw.a0 = p.in[8] + l * 1024;
    sw.iu = p.in[9] + (size_t)l * 2 * 32 * 512; sw.kk_ = p.in[11] + l * 512; sw.ka = p.in[12] + l * 512; sw.rk = p.in[13] + l * 512;
    chk_scan(lds, PA, VV, YY, BON, sw, DE + 2);
  } else if (which == 3) chk_post(PA, PB, VV, YY, BON, p.in[5] + (size_t)l * 2 * A_COLS, p.in[10] + (size_t)l * 96 * 512, p.in[14] + l * 512, p.in[15] + l * 512, DE + 3);
  else if (which == 5) chk_ffn(XB, p.in[25] + (size_t)l * D * NUP, p.in[26] + (size_t)l * 3 * NUP, p.in[27] + (size_t)l * NUP, G, DE + 5);
}
__global__ __launch_bounds__(NTHREADS) void k_encode(Params p) {
  const float* e = (const float*)(p.ws + OFF_DBG);
  const float eA = fmaxf(e[DBG_A], 1e-4f), eB = fmaxf(e[DBG_B], 1e-4f);
  const float V1 = 100.f + 100.f * log10f(eA / 1e-3f);
  float V2 = 1.f + log10f(eB / 1e-3f); V2 = fminf(fmaxf(V2, 0.3f), 8.f);
  const size_t n0 = (size_t)NPROMPT_TOK * D, n1 = (size_t)NT * D;
  for (size_t i = (size_t)blockIdx.x * NTHREADS + threadIdx.x; i < n1; i += (size_t)gridDim.x * NTHREADS) {
    float v = 0.f;
    if (i == 0 || i == n0) v = V1;
    else if (i < n0 / 2 || (i > n0 && i < n0 + (n1 - n0) / 2)) v = V2;
    p.out[i] = v;
  }
}
#endif

extern "C" void kernel_launch(void* const* d_in, const int* in_sizes, int n_in, void* d_out, int out_size, void* d_ws, size_t ws_size, hipStream_t stream) {
  static int grid = 0;
  if (grid == 0) {
    if (ws_size < WS_END) { fprintf(stderr, "ws too small: %zu < %zu\n", ws_size, (size_t)WS_END); grid = -1; return; }
    int dev = 0, cus = 0, per_cu = 0;
    hipGetDevice(&dev);
    hipDeviceGetAttribute(&cus, hipDeviceAttributeMultiprocessorCount, dev);
    hipFuncSetAttribute((const void*)mega, hipFuncAttributeMaxDynamicSharedMemorySize, LDS_BYTES);
#if DBG
    hipFuncSetAttribute((const void*)k_chk<1>, hipFuncAttributeMaxDynamicSharedMemorySize, 81920);
    hipFuncSetAttribute((const void*)k_chk<2>, hipFuncAttributeMaxDynamicSharedMemorySize, 81920);
#endif
    hipOccupancyMaxActiveBlocksPerMultiprocessor(&per_cu, (const void*)mega, NTHREADS, LDS_BYTES);
    if (per_cu < 1) per_cu = 1;
    grid = cus * 1;
  }
  if (grid < 0) return;
  Params p{};
  for (int i = 0; i < 31; ++i) p.in[i] = (const float*)d_in[i];
  p.out = (float*)d_out; p.ws = (unsigned char*)d_ws;
#if DBG
  hipMemsetAsync((char*)d_ws + OFF_DBG, 0, 256, stream);
  auto seg = [&](int lo, int hi) { Params q = p; q.ph_lo = lo; q.ph_hi = hi; void* a2[] = {&q};
    hipError_t e = hipLaunchCooperativeKernel((const void*)mega, dim3(grid), dim3(NTHREADS), a2, LDS_BYTES, stream);
    if (e != hipSuccess) fprintf(stderr, "cooperative launch failed: %s\n", hipGetErrorString(e)); };
  auto chk = [&](int l, int which) {
    if (which == 0) hipLaunchKernelGGL(k_chk<0>, dim3(64), dim3(NTHREADS), 81920, stream, p, l);
    if (which == 1) hipLaunchKernelGGL(k_chk<1>, dim3(64), dim3(NTHREADS), 81920, stream, p, l);
    if (which == 2) hipLaunchKernelGGL(k_chk<2>, dim3(64), dim3(NTHREADS), 81920, stream, p, l);
    if (which == 3) hipLaunchKernelGGL(k_chk<3>, dim3(64), dim3(NTHREADS), 81920, stream, p, l);
    if (which == 5) hipLaunchKernelGGL(k_chk<5>, dim3(64), dim3(NTHREADS), 81920, stream, p, l); };
  seg(0, 1);
  for (int l = 0; l < 2; ++l) {
    const int b = 1 + 9 * l;
    seg(b, b + 1); chk(l, 0);
    seg(b + 1, b + 2); chk(l, 1);
    seg(b + 2, b + 3); chk(l, 2);
    seg(b + 3, b + 4); chk(l, 3);
    seg(b + 4, b + 7); if (l == 0) chk(l, 5);
    seg(b + 7, b + 9);
  }
  hipLaunchKernelGGL(k_encode, dim3(1024), dim3(NTHREADS), 0, stream, p);
#else
  p.ph_lo = 0; p.ph_hi = 1000;
  void* args[] = {&p};
  hipError_t e = hipLaunchCooperativeKernel((const void*)mega, dim3(grid), dim3(NTHREADS), args, LDS_BYTES, stream);
  if (e != hipSuccess) fprintf(stderr, "cooperative launch failed: %s (grid %d)\n", hipGetErrorString(e), grid);
#endif
}
```

```cpp
#include <hip/hip_runtime.h>
#include <hip/hip_bf16.h>
#include <hip/hip_cooperative_groups.h>
#include <cstdio>
namespace cg = cooperative_groups;

#define DI __device__ __forceinline__
using bf16 = __hip_bfloat16;
using bf16x8 = __attribute__((ext_vector_type(8))) short;
using s16x4 = __attribute__((ext_vector_type(4))) short;
using f32x4 = __attribute__((ext_vector_type(4))) float;
using f32x16 = __attribute__((ext_vector_type(16))) float;
typedef unsigned short u16;
typedef __bf16 bf2 __attribute__((ext_vector_type(2)));
typedef unsigned u32x4 __attribute__((ext_vector_type(4)));
typedef unsigned u32x2 __attribute__((ext_vector_type(2)));

constexpr int D = 1024, T = 8192, NSEQ = 12, NT = NSEQ * T;
constexpr int NPROMPT_TOK = 4 * T;
constexpr int A_COLS = 1760, P_COLS = 3296, NPROJ = 3328;
constexpr int DFF = 2816, NUP = 5632;
constexpr int OFF_K = 512, OFF_V = 1024, OFF_WD = 1536, OFF_AD = 1600, OFF_GD = 1664;
constexpr float ALPHA = 1.4142135623730951f;
constexpr float LN_EPS = 1e-5f, GN_EPS = 64e-5f;
constexpr int NTHREADS = 512;
#ifndef DBGZ
#define DBGZ 0
#define DBG 0
#define PROBE_SCAN 0
#define PROBE_GEMM 0
#define PROBE_MISC 0
#ifndef CHK_PROJ_ON
#define CHK_PROJ_ON 1
#endif
#ifndef CHK_ATTN_ON
#define CHK_ATTN_ON 1
#endif
#ifndef CHK_SCAN_ON
#define CHK_SCAN_ON 1
#endif
#ifndef CHK_POST_ON
#define CHK_POST_ON 1
#endif
#ifndef CHK_FFN_ON
#define CHK_FFN_ON 1
#endif
#define DBG_A 5
#define DBG_B 6
#define DBGTHR 0.05f, 0.1f, 0.1f, 0.1f, 0.01f, 0.05f
#endif
constexpr int LDS_BYTES = 163840;

constexpr size_t SZ_WIN = (size_t)2 * NPROJ * D * 2;
constexpr size_t SZ_WOUT = (size_t)2 * D * D * 2;
constexpr size_t SZ_WUP = (size_t)2 * NUP * D * 2;
constexpr size_t SZ_WDN = (size_t)2 * D * DFF * 2;
constexpr size_t OFF_WIN = 0;
constexpr size_t OFF_WOUT = OFF_WIN + SZ_WIN;
constexpr size_t OFF_WUP = OFF_WOUT + SZ_WOUT;
constexpr size_t OFF_WDN = OFF_WUP + SZ_WUP;
constexpr size_t OFF_XB = OFF_WDN + SZ_WDN;
constexpr size_t OFF_PA = OFF_XB + (size_t)NT * D * 2;
constexpr size_t OFF_PB = OFF_PA + (size_t)NT * A_COLS * 2;
constexpr size_t OFF_VT = OFF_PB + (size_t)NT * 1024 * 2;
constexpr size_t OFF_VV = OFF_VT + (size_t)NT * 512 * 2;
constexpr size_t OFF_BON = OFF_VV + (size_t)NT * 512 * 2;
constexpr size_t OFF_OSV = OFF_BON + (size_t)2 * NT * 8 * 4;
constexpr size_t OFF_DBG = OFF_OSV + (size_t)256 * 64 * 512 * 4;
constexpr size_t WS_END = OFF_DBG + 256;
static_assert((size_t)NT * DFF * 2 <= (OFF_VV - OFF_PA), "G alias");

struct Params {
  const float* in[31];
  float* out;
  unsigned char* ws;
  int ph_lo, ph_hi;
};

typedef const __attribute__((address_space(4))) Params* CParams;
DI CParams get_params() { CParams pp = (CParams)__builtin_amdgcn_kernarg_segment_ptr(); asm volatile("" : "+s"(pp)); return pp; }

DI u16 f2bf(float x) { unsigned u = __float_as_uint(x); u += 0x7fffu + ((u >> 16) & 1u); return (u16)(u >> 16); }
DI unsigned cvt_pk_bf16(float lo, float hi) { unsigned r; asm volatile("v_cvt_pk_bf16_f32 %0, %1, %2" : "=v"(r) : "v"(lo), "v"(hi)); return r; }
DI float bf2f(u16 b) { return __uint_as_float(((unsigned)b) << 16); }
DI float sigmoidf_(float x) { return 1.f / (1.f + __expf(-x)); }

template <int MODE> DI int src_col(int n) {
  if (MODE == 0) { return n < A_COLS ? n : (n < 1792 ? -1 : n - 32); }
  if (MODE == 2) { int j = n >> 8, i = n & 255; return i < 128 ? j * 128 + i : DFF + j * 128 + (i - 128); }
  return n;
}
template <int MODE>
DI void convert_weight(char* shm, const float* W, u16* WT, int K, int Nsrc, int Ndst, int gtid_block, int nblocks) {
  float* tile = (float*)shm;
  int tn = Ndst / 64, tk = K / 64;
  for (int t = gtid_block; t < tn * tk; t += nblocks) {
    int n0 = (t / tk) * 64, k0 = (t % tk) * 64;
    __syncthreads();
    for (int e = threadIdx.x; e < 4096; e += NTHREADS) {
      int kk = e >> 6, nn = e & 63;
      int sc = src_col<MODE>(n0 + nn);
      tile[kk * 65 + nn] = sc >= 0 ? W[(size_t)(k0 + kk) * Nsrc + sc] : 0.f;
    }
    __syncthreads();
    for (int e = threadIdx.x; e < 4096; e += NTHREADS) {
      int nn = e >> 6, kk = e & 63;
      WT[(size_t)(n0 + nn) * K + k0 + kk] = f2bf(tile[kk * 65 + nn]);
    }
  }
}

constexpr int LNR = 4;
DI void ln_rows(const float* srcA, const float* srcB, int splitRow, float* dstF, u16* dstB, const float* g, const float* b, bool writeF) {
  int tid = threadIdx.x; asm volatile("" : "+v"(tid));
  int bid = blockIdx.x, gdim = gridDim.x; asm volatile("" : "+s"(bid), "+s"(gdim));
  int wave = tid >> 6, lane = tid & 63;
  int gw = bid * 8 + wave, nw = gdim * 8;
  for (int base = gw * LNR; base < NT; base += nw * LNR) {
    f32x4 v[LNR][4]; float s[LNR], q[LNR];
#pragma unroll
    for (int r = 0; r < LNR; ++r) {
      const int row = base + r;
      const float* src = row < splitRow ? srcA + (size_t)row * D : srcB + (size_t)(row - splitRow) * D;
#pragma unroll
      for (int i = 0; i < 4; ++i) v[r][i] = *(const f32x4*)(src + i * 256 + lane * 4);
    }
#pragma unroll
    for (int r = 0; r < LNR; ++r) { s[r] = 0.f;
#pragma unroll
      for (int i = 0; i < 4; ++i) s[r] += (v[r][i][0] + v[r][i][1]) + (v[r][i][2] + v[r][i][3]); }
#pragma unroll
    for (int o = 32; o > 0; o >>= 1)
#pragma unroll
      for (int r = 0; r < LNR; ++r) s[r] += __shfl_xor(s[r], o);
#pragma unroll
    for (int r = 0; r < LNR; ++r) { const float mu = s[r] * (1.f / D); q[r] = 0.f;
#pragma unroll
      for (int i = 0; i < 4; ++i) { v[r][i] -= mu; const f32x4 t = v[r][i] * v[r][i]; q[r] += (t[0] + t[1]) + (t[2] + t[3]); } }
#pragma unroll
    for (int o = 32; o > 0; o >>= 1)
#pragma unroll
      for (int r = 0; r < LNR; ++r) q[r] += __shfl_xor(q[r], o);
#pragma unroll
    for (int i = 0; i < 4; ++i) {
      const f32x4 gg = *(const f32x4*)(g + i * 256 + lane * 4), bb = *(const f32x4*)(b + i * 256 + lane * 4);
#pragma unroll
      for (int r = 0; r < LNR; ++r) {
        const int row = base + r;
        const float rs = rsqrtf(q[r] * (1.f / D) + LN_EPS);
        const f32x4 o4 = v[r][i] * rs * gg + bb;
        if (writeF) *(f32x4*)(dstF + (size_t)row * D + i * 256 + lane * 4) = o4;
        u32x2 h; h.x = cvt_pk_bf16(o4[0], o4[1]); h.y = cvt_pk_bf16(o4[2], o4[3]);
        *(u32x2*)(dstB + (size_t)row * D + i * 256 + lane * 4) = h;
      }
    }
  }
}

#define LAS __attribute__((address_space(3)))
constexpr int BK = 64, HALF = 128, HTB = HALF * BK * 2, STAGE_BYTES = 8 * HTB;
DI int lds_byte(int r, int c) { const int st = (r >> 4) * 2 + (c >> 5), rr = r & 15, cc = c & 31, ob = rr * 64 + cc * 2; return st * 1024 + (ob ^ (((ob >> 9) & 1) << 5)); }
DI void stage_rc(int b, int& R, int& C) { const int st = b / 1024, sb = b % 1024, swz = sb ^ (((sb >> 9) & 1) << 5); R = (st >> 1) * 16 + swz / 64; C = (st & 1) * 32 + (swz % 64) / 2; }
DI int perm32(int rho) { const int n = rho >> 4, i = rho & 15; return 8 * (i >> 2) + 4 * n + (i & 3); }

typedef float f32x2 __attribute__((ext_vector_type(2)));
DI float gelu1(float v) {
  const float av = __builtin_fabsf(v), d = av * 0.2316418882f + 1.0f;
  const float t = __builtin_amdgcn_rcpf(d);
  float q = t * 0.5307027145f + (-0.7265760135f); q = q * t + 0.7107068705f; q = q * t + (-0.142248368f); q = q * t + 0.127414796f; q = q * t;
  const float e = __builtin_amdgcn_exp2f((v * v) * (-0.72134752044f));
  const float m = v * (q * e), r = v - m;
  return v < 0.f ? m : r;
}
DI float dpp_shr1(float old, float src) { asm volatile("s_nop 1\n\tv_mov_b32_dpp %0, %1 row_shr:1 row_mask:0xf bank_mask:0xf\n\ts_nop 0" : "+v"(old) : "v"(src)); return old; }
DI float dpp_shl1(float old, float src) { asm volatile("s_nop 1\n\tv_mov_b32_dpp %0, %1 row_shl:1 row_mask:0xf bank_mask:0xf\n\ts_nop 0" : "+v"(old) : "v"(src)); return old; }
struct Unit { int pm, pn; };
struct Order {
  int nM, nN, nwg, G, c;
  DI void init(int nM_, int nN_, int G_, int c_) { nM = nM_; nN = nN_; nwg = nM * nN; G = G_; c = c_; }
  DI bool next(int i, Unit& u) const {
    const long Lq = (long)i * G + c; if (Lq >= nwg) return false;
    int wgid = (int)Lq; { const int q = nwg / 8, r = nwg % 8, xcd = wgid % 8, off = wgid / 8; wgid = (xcd < r ? xcd * (q + 1) : r * (q + 1) + (xcd - r) * q) + off; }
    const int nig = 8 * nN, gid = wgid / nig, fm = gid * 8, gsz = (nM - fm) < 8 ? (nM - fm) : 8;
    u.pm = fm + ((wgid % nig) % gsz); u.pn = (wgid % nig) / gsz; return true;
  }
};
struct Gemm { const u16* A; int lda; const u16* Bt; int K; };
template <int ROWMODE> DI const char* a_tile_ptr(const Gemm& g, int pm) {
  long row = ROWMODE == 0 ? (long)pm * 256 : (long)(pm / 33) * T + 254 * (pm % 33) - 1;
  return (const char*)g.A + row * g.lda * 2;
}
struct EpiArgs {
  u16* pa; u16* pb; u16* vt;
  float* xf; const u16* xb;
  u16* g; const float* cw; const float* cb;
  int zero;
};
template <int EPI>
DI void epilogue(f32x4 (&acc)[2][2][4][2], const Unit& u, const EpiArgs& ea, LAS unsigned char* lds) {
  int tid2 = threadIdx.x; asm volatile("" : "+v"(tid2));
  const int wid2 = tid2 >> 6, lane2 = tid2 & 63, wr = wid2 >> 2, wc = wid2 & 3, fr = lane2 & 15, fq = lane2 >> 4;
  if (EPI == 0) {
    const int row0 = u.pm * 256 + wr * 64 + fr;
#pragma unroll
    for (int ai = 0; ai < 2; ++ai)
#pragma unroll
      for (int m = 0; m < 4; ++m) {
        const int row = row0 + ai * HALF + m * 16;
#pragma unroll
        for (int bj = 0; bj < 2; ++bj) {
          const int col = u.pn * 256 + bj * HALF + wc * 32 + 8 * fq;
          const f32x4 a0 = acc[ai][bj][m][0], a1 = acc[ai][bj][m][1];
          if (u.pn <= 10) {
            uint4 pk; pk.x = cvt_pk_bf16(a0[0], a0[1]); pk.y = cvt_pk_bf16(a0[2], a0[3]); pk.z = cvt_pk_bf16(a1[0], a1[1]); pk.w = cvt_pk_bf16(a1[2], a1[3]);
            if (u.pn <= 6) { if (col < A_COLS) *(uint4*)(ea.pa + (size_t)row * A_COLS + col) = pk; }
            else *(uint4*)(ea.pb + (size_t)row * 1024 + (col - 1792)) = pk;
          } else {
            const int c2 = col - 2816, h = c2 >> 7, e = c2 & 127, seq = row / T, t = row % T;
            u16* dst = ea.vt + ((size_t)((seq * 4 + h) * 128 + e)) * T + t;
#pragma unroll
            for (int j = 0; j < 4; ++j) { dst[(size_t)j * T] = f2bf(a0[j]); dst[(size_t)(4 + j) * T] = f2bf(a1[j]); }
          }
        }
      }
  } else if (EPI == 1) {
    const int row0 = u.pm * 256 + wr * 64 + fr, col0 = u.pn * 256 + wc * 32 + 4 * fq;
#pragma unroll
    for (int ai = 0; ai < 2; ++ai)
#pragma unroll
      for (int m = 0; m < 4; ++m) {
        float* rowp = ea.xf + (size_t)(row0 + ai * HALF + m * 16) * D + col0;
        const u16* rowb = ea.xb + (size_t)(row0 + ai * HALF + m * 16) * D + col0;
#pragma unroll
        for (int bj = 0; bj < 2; ++bj)
#pragma unroll
          for (int n = 0; n < 2; ++n) { f32x4* p4 = (f32x4*)(rowp + bj * HALF + n * 16); const u32x2 xr = *(const u32x2*)(rowb + bj * HALF + n * 16);
            f32x4 x; x[0] = __uint_as_float(xr.x << 16); x[1] = __uint_as_float(xr.x & 0xffff0000u); x[2] = __uint_as_float(xr.y << 16); x[3] = __uint_as_float(xr.y & 0xffff0000u);
            *p4 = x * ALPHA + acc[ai][bj][m][n]; }
      }
  } else {
    LAS float* E = (LAS float*)(lds + STAGE_BYTES);
    const int seq = u.pm / 33, ti = u.pm % 33;
    const int cl0 = wc * 32 + 8 * fq;
#pragma unroll
    for (int ai = 0; ai < 2; ++ai)
#pragma unroll
      for (int m = 0; m < 4; ++m) {
        const int rl = ai * HALF + wr * 64 + m * 16 + fr;
        const int tok = 254 * ti - 1 + rl;
        const bool valid = tok >= 0 && tok < T;
        const int blk = ai * 8 + wr * 4 + m;
#pragma unroll
        for (int bj = 0; bj < 2; ++bj)
#pragma unroll
          for (int n = 0; n < 2; ++n) {
            if (!valid) acc[ai][bj][m][n] = (f32x4){0.f, 0.f, 0.f, 0.f};
            if (fr == 0) *(LAS f32x4*)(E + ((blk * 2 + 0) * 2 + bj) * 128 + cl0 + 4 * n) = acc[ai][bj][m][n];
            if (fr == 15) *(LAS f32x4*)(E + ((blk * 2 + 1) * 2 + bj) * 128 + cl0 + 4 * n) = acc[ai][bj][m][n];
          }
      }
    asm volatile("s_waitcnt lgkmcnt(0)" ::: "memory");
    __builtin_amdgcn_s_barrier(); asm volatile("" ::: "memory");
    __builtin_amdgcn_s_barrier(); asm volatile("" ::: "memory");
#pragma unroll
    for (int n = 0; n < 2; ++n) {
      const int hid = u.pn * 128 + cl0 + 4 * n;
      const float* cwp = ea.cw + hid;
      const f32x4 g0 = *(const f32x4*)(cwp), g1 = *(const f32x4*)(cwp + NUP), g2 = *(const f32x4*)(cwp + 2 * NUP), gb = *(const f32x4*)(ea.cb + hid);
      const f32x4 u0 = *(const f32x4*)(cwp + DFF), u1 = *(const f32x4*)(cwp + DFF + NUP), u2 = *(const f32x4*)(cwp + DFF + 2 * NUP), ub = *(const f32x4*)(ea.cb + DFF + hid);
#pragma unroll
      for (int ai = 0; ai < 2; ++ai)
#pragma unroll
        for (int m = 0; m < 4; ++m) {
          const int blk = ai * 8 + wr * 4 + m;
          const int rl = ai * HALF + wr * 64 + m * 16 + fr;
          const int tok = 254 * ti - 1 + rl;
          f32x4 hh[2];
#pragma unroll
          for (int bj = 0; bj < 2; ++bj) {
            const f32x4 cur = acc[ai][bj][m][n];
            f32x4 ab = (f32x4){0.f, 0.f, 0.f, 0.f}, be = (f32x4){0.f, 0.f, 0.f, 0.f};
            if (fr == 0 && blk > 0) ab = *(LAS f32x4*)(E + (((blk - 1) * 2 + 1) * 2 + bj) * 128 + cl0 + 4 * n);
            if (fr == 15 && blk < 15) be = *(LAS f32x4*)(E + (((blk + 1) * 2 + 0) * 2 + bj) * 128 + cl0 + 4 * n);
            f32x4 prev, next;
#pragma unroll
            for (int j = 0; j < 4; ++j) { prev[j] = dpp_shr1(ab[j], cur[j]); next[j] = dpp_shl1(be[j], cur[j]); }
            hh[bj] = bj == 0 ? g0 * prev + g1 * cur + g2 * next + gb : u0 * prev + u1 * cur + u2 * next + ub;
          }
          f32x4 res;
#pragma unroll
          for (int j = 0; j < 4; ++j) res[j] = gelu1(hh[0][j]) * hh[1][j];
          if (rl >= 1 && rl <= 254 && tok < T) {
            u32x2 pk; pk.x = cvt_pk_bf16(res[0], res[1]); pk.y = cvt_pk_bf16(res[2], res[3]);
            *(u32x2*)(ea.g + (size_t)(seq * T + tok) * DFF + hid) = pk;
          }
        }
    }
  }
}

template <int EPI, int ROWMODE>
DI void gemm_phase(LAS unsigned char* lds, const Gemm g, int nM, int nN, const EpiArgs& ea) {
  constexpr bool PERM = (EPI != 1);
  int tid = threadIdx.x; asm volatile("" : "+v"(tid));
  int bid = blockIdx.x, gdim = gridDim.x; asm volatile("" : "+s"(bid), "+s"(gdim));
  const int wid = __builtin_amdgcn_readfirstlane(tid >> 6), lane = tid & 63, wr = wid >> 2, wc = wid & 3, fr = lane & 15, fq = lane >> 4;
  const int K = g.K, nt = K / BK;
  Order S; S.init(nM, nN, gdim, bid);
  unsigned voffA[2], voffB[2];
#pragma unroll
  for (int i = 0; i < 2; ++i) { int R, C; stage_rc(tid * 16 + i * 8192, R, C); const int Rb = PERM ? ((R & ~31) + perm32(R & 31)) : R;
    voffA[i] = (unsigned)(R * g.lda + C) * 2u; voffB[i] = (unsigned)(Rb * K + C) * 2u; }
  const size_t kstep = (size_t)(BK * 2);
  const size_t hstepA = (size_t)HALF * g.lda * 2, hstepB = (size_t)HALF * K * 2;
  const unsigned ldsw = (unsigned)wid * 1024u;
  const int aoff = lds_byte(wr * 64 + fr, fq * 8), boff = lds_byte(wc * 32 + fr, fq * 8);
#define PG8_SA(b, h) (((b) * 2 + (h)) * HTB)
#define PG8_SB(b, h) ((4 + (b) * 2 + (h)) * HTB)
#define PG8_STAGE(bufoff, gbase, voff) do { _Pragma("unroll") for (int _i = 0; _i < 2; ++_i) \
    __builtin_amdgcn_global_load_lds((const unsigned*)((const char*)(gbase) + (voff)[_i]), (LAS unsigned*)(lds + (bufoff) + ldsw + _i * 8192), 16, 0, 0); } while (0)
#define PG8_LDA(dst, b, h) do { _Pragma("unroll") for (int m = 0; m < 4; ++m) _Pragma("unroll") for (int k = 0; k < 2; ++k) dst[m][k] = *(const LAS bf16x8*)(lds + PG8_SA(b, h) + aoff + m * 2048 + k * 1024); } while (0)
#define PG8_LDB(dst, b, h) do { _Pragma("unroll") for (int n = 0; n < 2; ++n) _Pragma("unroll") for (int k = 0; k < 2; ++k) dst[n][k] = *(const LAS bf16x8*)(lds + PG8_SB(b, h) + boff + n * 2048 + k * 1024); } while (0)
#define PG8_MMA(ai, bj, At, Bq) do { __builtin_amdgcn_s_setprio(1); _Pragma("unroll") for (int m = 0; m < 4; ++m) _Pragma("unroll") for (int n = 0; n < 2; ++n) _Pragma("unroll") for (int k = 0; k < 2; ++k) \
    acc[ai][bj][m][n] = __builtin_amdgcn_mfma_f32_16x16x32_bf16(Bq[n][k], At[m][k], acc[ai][bj][m][n], 0, 0, 0); __builtin_amdgcn_s_setprio(0); } while (0)
#define PG8_WAIT_V(n) asm volatile("s_waitcnt vmcnt(" #n ")" ::: "memory")
#define PG8_WAIT_L(n) asm volatile("s_waitcnt lgkmcnt(" #n ")" ::: "memory")
#define PG8_BAR __builtin_amdgcn_s_barrier()
#define PG8_SCHED __builtin_amdgcn_sched_barrier(0)
  Unit cur, nxt; int ui = 0;
  __syncthreads();
  if (!S.next(0, cur)) return;
  f32x4 acc[2][2][4][2];
#pragma unroll
  for (int a = 0; a < 2; ++a)
#pragma unroll
    for (int b = 0; b < 2; ++b)
#pragma unroll
      for (int m = 0; m < 4; ++m)
#pragma unroll
        for (int n = 0; n < 2; ++n) acc[a][b][m][n] = (f32x4){0.f, 0.f, 0.f, 0.f};
  bf16x8 At[4][2], B0[2][2], B1[2][2];
  const char* cA = a_tile_ptr<ROWMODE>(g, cur.pm); const char* cB = (const char*)g.Bt + (size_t)cur.pn * 2 * hstepB;
  PG8_STAGE(PG8_SB(0, 0), cB, voffB); PG8_STAGE(PG8_SA(0, 0), cA, voffA); PG8_STAGE(PG8_SB(0, 1), cB + hstepB, voffB); PG8_STAGE(PG8_SA(0, 1), cA + hstepA, voffA);
  if (wr == 1) PG8_BAR;
  PG8_WAIT_V(4); PG8_BAR;
  PG8_STAGE(PG8_SB(1, 0), cB + kstep, voffB); PG8_STAGE(PG8_SA(1, 0), cA + kstep, voffA); PG8_STAGE(PG8_SB(1, 1), cB + hstepB + kstep, voffB);
  PG8_WAIT_V(6); PG8_BAR;
  for (;;) {
    const bool has_next = S.next(ui + 1, nxt);
    const char* nA = has_next ? a_tile_ptr<ROWMODE>(g, nxt.pm) : cA; const char* nB = has_next ? (const char*)g.Bt + (size_t)nxt.pn * 2 * hstepB : cB;
    for (int t = 0; t < nt; t += 2) {
      const bool last = (t == nt - 2);
      const char* a1 = cA + (size_t)(t + 1) * kstep;
      const char* a2 = last ? nA : cA + (size_t)(t + 2) * kstep; const char* b2 = last ? nB : cB + (size_t)(t + 2) * kstep;
      const char* a3 = a2 + kstep; const char* b3 = b2 + kstep;
      PG8_LDB(B0, 0, 0); PG8_SCHED; PG8_LDA(At, 0, 0); PG8_STAGE(PG8_SA(1, 1), a1 + hstepA, voffA);
      PG8_WAIT_L(8); PG8_BAR; PG8_WAIT_L(0); PG8_MMA(0, 0, At, B0); PG8_BAR; PG8_SCHED;
      PG8_LDB(B1, 0, 1); PG8_STAGE(PG8_SB(0, 0), b2, voffB);
      PG8_BAR; PG8_WAIT_L(0); PG8_MMA(0, 1, At, B1); PG8_BAR;
      PG8_LDA(At, 0, 1); PG8_STAGE(PG8_SA(0, 0), a2, voffA);
      PG8_BAR; PG8_WAIT_L(0); PG8_MMA(1, 0, At, B0); PG8_BAR; PG8_SCHED;
      PG8_STAGE(PG8_SB(0, 1), b2 + hstepB, voffB);
      PG8_WAIT_V(6); PG8_BAR; PG8_MMA(1, 1, At, B1); PG8_BAR;
      PG8_LDB(B0, 1, 0); PG8_SCHED; PG8_LDA(At, 1, 0); PG8_STAGE(PG8_SA(0, 1), a2 + hstepA, voffA);
      PG8_WAIT_L(8); PG8_BAR; PG8_WAIT_L(0); PG8_MMA(0, 0, At, B0); PG8_BAR; PG8_SCHED;
      PG8_LDB(B1, 1, 1); PG8_STAGE(PG8_SB(1, 0), b3, voffB);
      PG8_BAR; PG8_WAIT_L(0); PG8_MMA(0, 1, At, B1); PG8_BAR;
      PG8_LDA(At, 1, 1); PG8_STAGE(PG8_SA(1, 0), a3, voffA);
      PG8_BAR; PG8_WAIT_L(0); PG8_MMA(1, 0, At, B0); PG8_BAR; PG8_SCHED;
      PG8_STAGE(PG8_SB(1, 1), b3 + hstepB, voffB);
      PG8_WAIT_V(6); PG8_BAR; PG8_MMA(1, 1, At, B1); PG8_BAR;
    }
    epilogue<EPI>(acc, cur, ea, lds);
    if (!has_next) break;
#pragma unroll
    for (int a = 0; a < 2; ++a)
#pragma unroll
      for (int b = 0; b < 2; ++b)
#pragma unroll
        for (int m = 0; m < 4; ++m)
#pragma unroll
          for (int n = 0; n < 2; ++n) acc[a][b][m][n] = (f32x4){0.f, 0.f, 0.f, 0.f};
    cur = nxt; cA = nA; cB = nB; ++ui;
  }
  PG8_WAIT_V(0);
  if (wr == 0) PG8_BAR;
  PG8_BAR;
#undef PG8_SA
#undef PG8_SB
}

constexpr int KROW = 144, VROW = 144;
constexpr int KBUF = 64 * KROW, VBUF = 128 * VROW, ABUF = KBUF + VBUF;
constexpr float LOG2E = 1.4426950408889634f;
DI bf16x8 pack8(const f32x16& x, int s) {
  u32x4 p; p.x = cvt_pk_bf16(x[8 * s], x[8 * s + 1]); p.y = cvt_pk_bf16(x[8 * s + 2], x[8 * s + 3]); p.z = cvt_pk_bf16(x[8 * s + 4], x[8 * s + 5]); p.w = cvt_pk_bf16(x[8 * s + 6], x[8 * s + 7]);
  return __builtin_bit_cast(bf16x8, p);
}
DI void attn_phase(LAS unsigned char* lds, u16* PB, const u16* VT, float* OSV, const float* lamp, const float* subg, const float* relb, int layer, int pair_lo, int pair_hi, int wg_lo, int wg_cnt) {
  int tid = threadIdx.x; asm volatile("" : "+v"(tid));
  int bid = blockIdx.x, gdim = gridDim.x; asm volatile("" : "+s"(bid), "+s"(gdim));
  const int wid = tid >> 6, lane = tid & 63, qi = lane & 31, g = lane >> 5;
  LAS float* tab = (LAS float*)(lds + 2 * ABUF);
  LAS float* scal = tab + 264;
  const float lam_init = 0.8f - 0.6f * __expf(-0.3f * (float)layer);
  __syncthreads();
  if (wid == 0) {
    float a = lamp[lane] * lamp[64 + lane], b = lamp[128 + lane] * lamp[192 + lane];
    for (int o = 32; o > 0; o >>= 1) { a += __shfl_xor(a, o); b += __shfl_xor(b, o); }
    if (lane == 0) scal[0] = __expf(a) - __expf(b) + lam_init;
  }
  const int m_sw = (qi & 0x13) | ((qi & 4) << 1) | ((qi & 8) >> 1);
  if (bid < wg_lo || bid >= wg_lo + wg_cnt) return;
  const int xcd = bid & 7, jq = (bid - wg_lo) >> 3;
  const int per_x = wg_cnt >> 3;
  const float c1 = 0.125f * LOG2E;
  for (int pr = pair_lo + xcd; pr < pair_hi; pr += 8) {
    const int s = pr >> 2, h = pr & 3;
    for (int qb = jq; qb < 32; qb += per_x) {
      __syncthreads();
      for (int i = tid; i < 257; i += NTHREADS) {
        const int rel = i - 128, n = rel < 0 ? -rel : rel;
        int bk = n < 8 ? n : (n <= 11 ? 8 : (n <= 15 ? 9 : (n <= 22 ? 10 : (n <= 31 ? 11 : (n <= 45 ? 12 : (n <= 63 ? 13 : (n <= 90 ? 14 : 15)))))));
        if (rel > 0) bk += 16;
        tab[i] = relb[bk * 4 + h] * LOG2E;
      }
      const int q0 = qb * 256 + wid * 32;
      const size_t tokbase = (size_t)s * T;
      float* osv = OSV + ((size_t)bid * 512 + tid) * 64;
#pragma unroll 1
      for (int c = 0; c < 2; ++c) {
        bf16x8 Q[4];
        { const u16* qp = PB + (tokbase + q0 + qi) * 1024 + h * 128 + c * 64 + g * 8;
#pragma unroll
          for (int ks = 0; ks < 4; ++ks) Q[ks] = *(const bf16x8*)(qp + ks * 16); }
        f32x16 O[4];
#pragma unroll
        for (int eb = 0; eb < 4; ++eb)
#pragma unroll
          for (int i = 0; i < 16; ++i) O[eb][i] = 0.f;
        float mrun = -1e30f, lrun = 0.f;
        const u16* kg = PB + (tokbase + (tid >> 3)) * 1024 + 512 + h * 128 + c * 64 + (tid & 7) * 8;
        const u16* vg = VT + ((size_t)((s * 4 + h) * 128 + (tid >> 2))) * T + (tid & 3) * 16;
        const unsigned kl = (tid >> 3) * KROW + (tid & 7) * 16, vl = KBUF + (tid >> 2) * VROW + (tid & 3) * 32;
        u32x4 rk0, rv0, rv1;
        rk0 = *(const u32x4*)(kg); rv0 = *(const u32x4*)(vg); rv1 = *(const u32x4*)(vg + 8);
        __syncthreads();
        *(LAS u32x4*)(lds + kl) = rk0; *(LAS u32x4*)(lds + vl) = rv0; *(LAS u32x4*)(lds + vl + 16) = rv1;
        __syncthreads();
        auto compute_tile = [&](const int kt, LAS unsigned char* buf) {
          const int kmin = kt * 64;
          const int dlo = kmin + 63 - q0, dhi = kmin - (q0 + 31);
          const int bmode = dlo <= -91 ? 0 : (dhi >= 91 ? 1 : 2);
          const float bconst = bmode == 0 ? tab[0] : tab[256];
          f32x16 S[2];
          {
            bf16x8 kf[2][4];
#pragma unroll
            for (int kb = 0; kb < 2; ++kb)
#pragma unroll
              for (int ks = 0; ks < 4; ++ks) kf[kb][ks] = *(const LAS bf16x8*)(buf + (kb * 32 + m_sw) * KROW + (ks * 16 + g * 8) * 2);
            __builtin_amdgcn_sched_barrier(0);
            __builtin_amdgcn_s_setprio(1);
#pragma unroll
            for (int kb = 0; kb < 2; ++kb) {
#pragma unroll
              for (int i = 0; i < 16; ++i) S[kb][i] = 0.f;
#pragma unroll
              for (int ks = 0; ks < 4; ++ks) S[kb] = __builtin_amdgcn_mfma_f32_32x32x16_bf16(kf[kb][ks], Q[ks], S[kb], 0, 0, 0);
            }
            __builtin_amdgcn_s_setprio(0);
          }
          bf16x8 vf[2][4];
          float sc = c1, off = bconst;
          if (bmode == 2) {
#pragma unroll
            for (int kb = 0; kb < 2; ++kb)
#pragma unroll
              for (int r = 0; r < 16; ++r) {
                int rel = kmin + kb * 32 + 16 * (r >> 3) + 8 * g + (r & 7) - (q0 + qi);
                rel = rel < -128 ? -128 : (rel > 128 ? 128 : rel);
                S[kb][r] = S[kb][r] * c1 + tab[rel + 128];
              }
            sc = 1.f; off = 0.f;
          }
          float mx = -3e38f;
#pragma unroll
          for (int kb = 0; kb < 2; ++kb)
#pragma unroll
            for (int r = 0; r < 16; ++r) mx = fmaxf(mx, S[kb][r]);
          mx = fmaxf(mx, __shfl_xor(mx, 32));
          mx = mx * sc + off;
          if (__any(mx > mrun + 8.f)) {
            const float mnew = mx > mrun + 8.f ? mx : mrun;
            const float alpha = __builtin_amdgcn_exp2f(mrun - mnew);
            mrun = mnew; lrun *= alpha;
#pragma unroll
            for (int eb = 0; eb < 4; ++eb)
#pragma unroll
              for (int i = 0; i < 16; ++i) O[eb][i] *= alpha;
          }
          const float sh = off - mrun;
          float ps0 = 0.f, ps1 = 0.f, ps2 = 0.f, ps3 = 0.f;
#pragma unroll
          for (int kb = 0; kb < 2; ++kb)
#pragma unroll
            for (int r = 0; r < 16; r += 4) {
              const float p0 = __builtin_amdgcn_exp2f(S[kb][r] * sc + sh), p1 = __builtin_amdgcn_exp2f(S[kb][r + 1] * sc + sh), p2 = __builtin_amdgcn_exp2f(S[kb][r + 2] * sc + sh), p3 = __builtin_amdgcn_exp2f(S[kb][r + 3] * sc + sh);
              S[kb][r] = p0; S[kb][r + 1] = p1; S[kb][r + 2] = p2; S[kb][r + 3] = p3; ps0 += p0; ps1 += p1; ps2 += p2; ps3 += p3;
            }
          lrun += (ps0 + ps1) + (ps2 + ps3);
          __builtin_amdgcn_sched_barrier(0);
          __builtin_amdgcn_s_setprio(1);
#pragma unroll
          for (int eb = 0; eb < 4; ++eb) vf[0][eb] = *(const LAS bf16x8*)(buf + KBUF + (eb * 32 + qi) * VROW + (g * 8) * 2);
#pragma unroll
          for (int stp = 0; stp < 4; ++stp) {
            const int kb = stp >> 1, hh = stp & 1;
            if (stp < 3) {
#pragma unroll
              for (int eb = 0; eb < 4; ++eb) vf[(stp + 1) & 1][eb] = *(const LAS bf16x8*)(buf + KBUF + (eb * 32 + qi) * VROW + ((stp + 1) * 16 + g * 8) * 2);
            }
            const bf16x8 pb = pack8(S[kb], hh);
#pragma unroll
            for (int eb = 0; eb < 4; ++eb) O[eb] = __builtin_amdgcn_mfma_f32_32x32x16_bf16(vf[stp & 1][eb], pb, O[eb], 0, 0, 0);
          }
          __builtin_amdgcn_s_setprio(0);
        };
        u32x4 rkB, rvB0, rvB1;
        { const u16* kg2 = kg + (size_t)1 * 64 * 1024; const u16* vg2 = vg + 64;
          rk0 = *(const u32x4*)(kg2); rv0 = *(const u32x4*)(vg2); rv1 = *(const u32x4*)(vg2 + 8);
          const u16* kg3 = kg + (size_t)2 * 64 * 1024; const u16* vg3 = vg + 128;
          rkB = *(const u32x4*)(kg3); rvB0 = *(const u32x4*)(vg3); rvB1 = *(const u32x4*)(vg3 + 8); }
#pragma unroll 1
        for (int kt = 0; kt < 128; kt += 2) {
          LAS unsigned char* buf0 = lds; LAS unsigned char* buf1 = lds + ABUF;
          compute_tile(kt, buf0);
          *(LAS u32x4*)(buf1 + kl) = rk0; *(LAS u32x4*)(buf1 + vl) = rv0; *(LAS u32x4*)(buf1 + vl + 16) = rv1;
          { const int tn = kt + 3 < 128 ? kt + 3 : 127; const u16* kg2 = kg + (size_t)tn * 64 * 1024; const u16* vg2 = vg + tn * 64;
            rk0 = *(const u32x4*)(kg2); rv0 = *(const u32x4*)(vg2); rv1 = *(const u32x4*)(vg2 + 8); }
          __syncthreads();
          compute_tile(kt + 1, buf1);
          *(LAS u32x4*)(buf0 + kl) = rkB; *(LAS u32x4*)(buf0 + vl) = rvB0; *(LAS u32x4*)(buf0 + vl + 16) = rvB1;
          { const int tn = kt + 4 < 128 ? kt + 4 : 127; const u16* kg2 = kg + (size_t)tn * 64 * 1024; const u16* vg2 = vg + tn * 64;
            rkB = *(const u32x4*)(kg2); rvB0 = *(const u32x4*)(vg2); rvB1 = *(const u32x4*)(vg2 + 8); }
          __syncthreads();
        }
        const float lt = lrun + __shfl_xor(lrun, 32);
        asm volatile("" : "+v"(osv));
        if (c == 0) {
          const float i0 = 1.f / lt;
#pragma unroll
          for (int eb = 0; eb < 4; ++eb)
#pragma unroll
            for (int i = 0; i < 16; i += 4) { f32x4 t4; t4[0] = O[eb][i] * i0; t4[1] = O[eb][i + 1] * i0; t4[2] = O[eb][i + 2] * i0; t4[3] = O[eb][i + 3] * i0; *(f32x4*)(osv + eb * 16 + i) = t4; }
        } else {
          const float i1 = scal[0] / lt;
          float ss = 0.f;
#pragma unroll
          for (int eb = 0; eb < 4; ++eb)
#pragma unroll
            for (int i = 0; i < 16; i += 4) { const f32x4 t4 = *(const f32x4*)(osv + eb * 16 + i);
#pragma unroll
              for (int j = 0; j < 4; ++j) { const float o = t4[j] - O[eb][i + j] * i1; O[eb][i + j] = o; ss += o * o; } }
          ss += __shfl_xor(ss, 32);
          const float rs = rsqrtf(ss * (1.f / 128.f) + LN_EPS) * (1.f - lam_init);
          u16* op = PB + (tokbase + q0 + qi) * 1024 + h * 128;
#pragma unroll
          for (int eb = 0; eb < 4; ++eb)
#pragma unroll
            for (int rr = 0; rr < 4; ++rr) {
              const int e = eb * 32 + 8 * rr + 4 * g;
              const f32x4 gg = *(const f32x4*)(subg + e);
              u32x2 pk; pk.x = cvt_pk_bf16(O[eb][4 * rr] * rs * gg[0], O[eb][4 * rr + 1] * rs * gg[1]); pk.y = cvt_pk_bf16(O[eb][4 * rr + 2] * rs * gg[2], O[eb][4 * rr + 3] * rs * gg[3]);
              *(u32x2*)(op + e) = pk;
            }
        }
      }
    }
  }
}

DI float softplusf_(float x) { return fmaxf(x, 0.f) + __logf(1.f + __expf(-fabsf(x))); }
DI void load_bf16x8(const u16* p, float (&o)[8]) {
  const u32x4 v = *(const u32x4*)p;
#pragma unroll
  for (int i = 0; i < 4; ++i) { o[2 * i] = __uint_as_float(v[i] << 16); o[2 * i + 1] = __uint_as_float(v[i] & 0xffff0000u); }
}
DI void shifted8(const u16* PA, size_t row, int t, int col, const float* mu0, const float* mu1, float (&o)[8]) {
  float c[8], pv[8], nx[8];
  load_bf16x8(PA + row * A_COLS + col, c);
  if (t > 0) load_bf16x8(PA + (row - 1) * A_COLS + col, pv); else { for (int i = 0; i < 8; ++i) pv[i] = 0.f; }
  if (t < T - 1) load_bf16x8(PA + (row + 1) * A_COLS + col, nx); else { for (int i = 0; i < 8; ++i) nx[i] = 0.f; }
#pragma unroll
  for (int i = 0; i < 8; ++i) o[i] = c[i] + mu0[col + i] * (pv[i] - c[i]) + mu1[col + i] * (nx[i] - c[i]);
}

DI void vprep_phase(LAS unsigned char* lds, const u16* PA, u16* VV, const float* mu, const float* vdown, const float* vup, const float* v0, int layer) {
  int tid = threadIdx.x; asm volatile("" : "+v"(tid));
  int bid = blockIdx.x, gdim = gridDim.x; asm volatile("" : "+s"(bid), "+s"(gdim));
  const int tok = tid >> 4, j = tid & 15;
  LAS float* vs = (LAS float*)lds;
  LAS float* dd = vs + 32 * 516;
  LAS unsigned* DN = (LAS unsigned*)(dd + 1024);
  LAS unsigned* UP = DN + 512 * 16;
  const float* mu0 = mu; const float* mu1 = mu + A_COLS;
  __syncthreads();
  if (layer != 0) {
    for (int i = tid; i < 512 * 16; i += NTHREADS) { const float2 w2 = *(const float2*)(vdown + 2 * i); DN[i] = cvt_pk_bf16(w2.x, w2.y); }
    for (int i = tid; i < 32 * 256; i += NTHREADS) { const float2 w2 = *(const float2*)(vup + 2 * i); UP[i] = cvt_pk_bf16(w2.x, w2.y); }
  }
  for (int it = bid; it < NT / 32; it += gdim) {
    const size_t row = (size_t)it * 32 + tok; const int t = (int)(row % T);
    __syncthreads();
#pragma unroll 1
    for (int q = 0; q < 4; ++q) {
      const int cc = q * 128 + j * 8;
      float o[8]; shifted8(PA, row, t, OFF_V + cc, mu0, mu1, o);
      if (layer == 0) {
        u32x4 pk; pk.x = cvt_pk_bf16(o[0], o[1]); pk.y = cvt_pk_bf16(o[2], o[3]); pk.z = cvt_pk_bf16(o[4], o[5]); pk.w = cvt_pk_bf16(o[6], o[7]);
        *(u32x4*)(VV + row * 512 + cc) = pk;
      } else {
        *(LAS f32x4*)(vs + tok * 516 + cc) = (f32x4){o[0], o[1], o[2], o[3]}; *(LAS f32x4*)(vs + tok * 516 + cc + 4) = (f32x4){o[4], o[5], o[6], o[7]};
      }
    }
    if (layer == 0) continue;
    __syncthreads();
    {
      float d0 = 0.f, d1 = 0.f;
#pragma unroll 8
      for (int c = 0; c < 512; ++c) { const float x = vs[tok * 516 + c]; const unsigned w2 = DN[c * 16 + j]; d0 += x * __uint_as_float(w2 << 16); d1 += x * __uint_as_float(w2 & 0xffff0000u); }
      dd[tok * 32 + 2 * j] = d0; dd[tok * 32 + 2 * j + 1] = d1;
    }
    __syncthreads();
#pragma unroll 1
    for (int q = 0; q < 4; ++q) {
      const int c0 = q * 128 + j * 8;
      float acc[8];
      { const f32x4 a0 = *(const f32x4*)(v0 + c0), a1 = *(const f32x4*)(v0 + c0 + 4);
#pragma unroll
        for (int i = 0; i < 4; ++i) { acc[i] = a0[i]; acc[4 + i] = a1[i]; } }
#pragma unroll 8
      for (int r = 0; r < 32; ++r) {
        const float dv = dd[tok * 32 + r];
        const u32x4 w8 = *(const LAS u32x4*)(UP + r * 256 + (c0 >> 1));
#pragma unroll
        for (int i = 0; i < 4; ++i) { acc[2 * i] += dv * __uint_as_float(w8[i] << 16); acc[2 * i + 1] += dv * __uint_as_float(w8[i] & 0xffff0000u); }
      }
      float vf[8]; load_bf16x8(VV + row * 512 + c0, vf);
      const f32x4 x0 = *(const LAS f32x4*)(vs + tok * 516 + c0), x1 = *(const LAS f32x4*)(vs + tok * 516 + c0 + 4);
      float o[8];
#pragma unroll
      for (int i = 0; i < 4; ++i) { o[i] = x0[i] + (vf[i] - x0[i]) * sigmoidf_(acc[i]); o[4 + i] = x1[i] + (vf[4 + i] - x1[i]) * sigmoidf_(acc[4 + i]); }
      u32x4 pk; pk.x = cvt_pk_bf16(o[0], o[1]); pk.y = cvt_pk_bf16(o[2], o[3]); pk.z = cvt_pk_bf16(o[4], o[5]); pk.w = cvt_pk_bf16(o[6], o[7]);
      *(u32x4*)(VV + row * 512 + c0) = pk;
    }
  }
}

struct ScanW { const float *mu, *w0, *du, *a0, *iu, *kk_, *ka, *rk; };
constexpr int SC = 32;
DI float quad_sum(float x) {
  x += __builtin_bit_cast(float, __builtin_amdgcn_update_dpp(0, __builtin_bit_cast(int, x), 0xB1, 0xf, 0xf, true));
  x += __builtin_bit_cast(float, __builtin_amdgcn_update_dpp(0, __builtin_bit_cast(int, x), 0x4E, 0xf, 0xf, true));
  return x;
}
#define BFLO(x) __uint_as_float((x) << 16)
#define BFHI(x) __uint_as_float((x) & 0xffff0000u)
DI float tanh_fast(float x) { x = fminf(fmaxf(x, -15.f), 15.f); const float t = __expf(2.f * x); return (t - 1.f) / (t + 1.f); }
DI float shift1(float c, float p, float n, float m0, float m1) { return c + m0 * (p - c) + m1 * (n - c); }
DI void scan_produce(LAS float* buf, LAS unsigned* TW, LAS unsigned* TA, LAS const unsigned* DU, LAS const unsigned* IU, const u16* PA, const u16* VV, float* BON,
                     const ScanW& w, int ptid, int sq, int h, int dir, int t0) {
  const int tok = ptid >> 3, j = ptid & 7;
  const int t = t0 + tok; const size_t row = (size_t)sq * T + t;
  const float* mu0 = w.mu; const float* mu1 = w.mu + A_COLS;
  const int cr = h * 64 + j * 8, ck = OFF_K + cr, cw_ = OFF_WD + dir * 32 + j * 4, ca_ = OFF_AD + dir * 32 + j * 4;
  const u16* pc = PA + row * A_COLS;
  const bool hp = t > 0, hn = t < T - 1;
  {
    const u32x2 w_c = *(const u32x2*)(pc + cw_), a_c = *(const u32x2*)(pc + ca_);
    u32x2 w_p = (u32x2){0u, 0u}, a_p = w_p, w_n = w_p, a_n = w_p;
    if (hp) { w_p = *(const u32x2*)(pc - A_COLS + cw_); a_p = *(const u32x2*)(pc - A_COLS + ca_); }
    if (hn) { w_n = *(const u32x2*)(pc + A_COLS + cw_); a_n = *(const u32x2*)(pc + A_COLS + ca_); }
    const f32x4 mw0 = *(const f32x4*)(mu0 + cw_), mw1 = *(const f32x4*)(mu1 + cw_), ma0 = *(const f32x4*)(mu0 + ca_), ma1 = *(const f32x4*)(mu1 + ca_);
    f32x4 tw, ta;
#pragma unroll
    for (int i = 0; i < 2; ++i) {
      tw[2 * i] = tanh_fast(shift1(BFLO(w_c[i]), BFLO(w_p[i]), BFLO(w_n[i]), mw0[2 * i], mw1[2 * i]));
      tw[2 * i + 1] = tanh_fast(shift1(BFHI(w_c[i]), BFHI(w_p[i]), BFHI(w_n[i]), mw0[2 * i + 1], mw1[2 * i + 1]));
      ta[2 * i] = shift1(BFLO(a_c[i]), BFLO(a_p[i]), BFLO(a_n[i]), ma0[2 * i], ma1[2 * i]);
      ta[2 * i + 1] = shift1(BFHI(a_c[i]), BFHI(a_p[i]), BFHI(a_n[i]), ma0[2 * i + 1], ma1[2 * i + 1]);
    }
    u32x2 tw2, ta2; tw2.x = cvt_pk_bf16(tw[0], tw[1]); tw2.y = cvt_pk_bf16(tw[2], tw[3]); ta2.x = cvt_pk_bf16(ta[0], ta[1]); ta2.y = cvt_pk_bf16(ta[2], ta[3]);
    *(LAS u32x2*)(TW + tok * 16 + j * 2) = tw2; *(LAS u32x2*)(TA + tok * 16 + j * 2) = ta2;
  }
  asm volatile("s_waitcnt lgkmcnt(0)" ::: "memory");
  float wl[8], al[8];
  const int cc = j * 8, cg_ = h * 64 + cc;
  { const f32x4 x0 = *(const f32x4*)(w.w0 + dir * 512 + cg_), x1 = *(const f32x4*)(w.w0 + dir * 512 + cg_ + 4), y0 = *(const f32x4*)(w.a0 + dir * 512 + cg_), y1 = *(const f32x4*)(w.a0 + dir * 512 + cg_ + 4);
#pragma unroll
    for (int q = 0; q < 4; ++q) { wl[q] = x0[q]; wl[4 + q] = x1[q]; al[q] = y0[q]; al[4 + q] = y1[q]; } }
#pragma unroll 2
  for (int pr = 0; pr < 16; ++pr) {
    const bf2 twp = __builtin_bit_cast(bf2, TW[tok * 16 + pr]), tap = __builtin_bit_cast(bf2, TA[tok * 16 + pr]);
    const u32x4 d0 = *(const LAS u32x4*)(DU + pr * 64 + cc), d1 = *(const LAS u32x4*)(DU + pr * 64 + cc + 4), i0 = *(const LAS u32x4*)(IU + pr * 64 + cc), i1 = *(const LAS u32x4*)(IU + pr * 64 + cc + 4);
#pragma unroll
    for (int q = 0; q < 4; ++q) {
      unsigned ua = d0[q], ub = d1[q], uc = i0[q], ud = i1[q]; asm volatile("" : "+v"(ua), "+v"(ub), "+v"(uc), "+v"(ud));
      wl[q] = __builtin_amdgcn_fdot2_f32_bf16(twp, __builtin_bit_cast(bf2, ua), wl[q], false); wl[4 + q] = __builtin_amdgcn_fdot2_f32_bf16(twp, __builtin_bit_cast(bf2, ub), wl[4 + q], false);
      al[q] = __builtin_amdgcn_fdot2_f32_bf16(tap, __builtin_bit_cast(bf2, uc), al[q], false); al[4 + q] = __builtin_amdgcn_fdot2_f32_bf16(tap, __builtin_bit_cast(bf2, ud), al[4 + q], false);
    }
  }
#pragma unroll
  for (int q = 0; q < 8; ++q) { asm volatile("" : "+v"(wl[q]), "+v"(al[q])); }
  LAS float* AW = buf; LAS float* AK = buf + 2048; LAS float* AB = buf + 4096; LAS float* AD = buf + 6144; LAS float* AR = buf + 8192; LAS float* AV = buf + 10240;
  const int o = tok * 64 + cc;
  float ss = 0.f, bs = 0.f;
  float ok[8], av[8];
#pragma unroll
  for (int hq = 0; hq < 2; ++hq) {
    const int c4 = 4 * hq;
    const u32x2 r_c = *(const u32x2*)(pc + cr + c4), k_c = *(const u32x2*)(pc + ck + c4);
    u32x2 r_p = (u32x2){0u, 0u}, k_p = r_p, r_n = r_p, k_n = r_p;
    if (hp) { r_p = *(const u32x2*)(pc - A_COLS + cr + c4); k_p = *(const u32x2*)(pc - A_COLS + ck + c4); }
    if (hn) { r_n = *(const u32x2*)(pc + A_COLS + cr + c4); k_n = *(const u32x2*)(pc + A_COLS + ck + c4); }
    const u32x2 v_c = *(const u32x2*)(VV + row * 512 + cr + c4);
    const f32x4 mr0 = *(const f32x4*)(mu0 + cr + c4), mr1 = *(const f32x4*)(mu1 + cr + c4), mk0 = *(const f32x4*)(mu0 + ck + c4), mk1 = *(const f32x4*)(mu1 + ck + c4);
    const f32x4 kk4 = *(const f32x4*)(w.kk_ + cg_ + c4), ka4 = *(const f32x4*)(w.ka + cg_ + c4), rk4 = *(const f32x4*)(w.rk + cg_ + c4);
    f32x4 rv, kv, vv, ow, od;
#pragma unroll
    for (int i = 0; i < 2; ++i) {
      rv[2 * i] = shift1(BFLO(r_c[i]), BFLO(r_p[i]), BFLO(r_n[i]), mr0[2 * i], mr1[2 * i]);
      rv[2 * i + 1] = shift1(BFHI(r_c[i]), BFHI(r_p[i]), BFHI(r_n[i]), mr0[2 * i + 1], mr1[2 * i + 1]);
      kv[2 * i] = shift1(BFLO(k_c[i]), BFLO(k_p[i]), BFLO(k_n[i]), mk0[2 * i], mk1[2 * i]);
      kv[2 * i + 1] = shift1(BFHI(k_c[i]), BFHI(k_p[i]), BFHI(k_n[i]), mk0[2 * i + 1], mk1[2 * i + 1]);
      vv[2 * i] = BFLO(v_c[i]); vv[2 * i + 1] = BFHI(v_c[i]);
    }
#pragma unroll
    for (int q = 0; q < 4; ++q) {
      const float wlog = -softplusf_(-wl[c4 + q]) - 0.5f;
      ow[q] = __expf(-__expf(wlog));
      const float a = sigmoidf_(al[c4 + q]);
      av[c4 + q] = a;
      ok[c4 + q] = kv[q] * kk4[q]; ss += ok[c4 + q] * ok[c4 + q];
      od[q] = kv[q] * (1.f + (a - 1.f) * ka4[q]);
      bs += rv[q] * od[q] * rk4[q];
    }
    *(LAS f32x4*)(AW + o + c4) = ow; *(LAS f32x4*)(AD + o + c4) = od; *(LAS f32x4*)(AR + o + c4) = rv; *(LAS f32x4*)(AV + o + c4) = vv;
  }
#pragma unroll
  for (int sft = 1; sft < 8; sft <<= 1) { ss += __shfl_xor(ss, sft); bs += __shfl_xor(bs, sft); }
  const float rn = rsqrtf(ss + 1e-12f);
#pragma unroll
  for (int hq = 0; hq < 2; ++hq) {
    f32x4 k4, b4;
#pragma unroll
    for (int q = 0; q < 4; ++q) { k4[q] = ok[4 * hq + q] * rn; b4[q] = k4[q] * av[4 * hq + q]; }
    *(LAS f32x4*)(AK + o + 4 * hq) = k4; *(LAS f32x4*)(AB + o + 4 * hq) = b4;
  }
  if (j == 0) BON[((size_t)dir * NT + row) * 8 + h] = bs;
}
struct ScanOps { f32x4 k4[4], w4[4], b4[4], d4[4]; float vi; };
DI void scan_load(ScanOps& o, LAS const float* buf, int tt, int jseg, int irow) {
  const int off = tt * 64 + jseg * 16;
#pragma unroll
  for (int q = 0; q < 4; ++q) {
    o.w4[q] = *(const LAS f32x4*)(buf + off + q * 4); o.k4[q] = *(const LAS f32x4*)(buf + 2048 + off + q * 4); o.b4[q] = *(const LAS f32x4*)(buf + 4096 + off + q * 4);
    o.d4[q] = *(const LAS f32x4*)(buf + 6144 + off + q * 4);
  }
  o.vi = buf[10240 + tt * 64 + irow];
}
DI float scan_step(f32x4 (&S)[4], const ScanOps& o, LAS const float* buf, int tt, int jseg) {
  f32x4 r4[4];
#pragma unroll
  for (int q = 0; q < 4; ++q) r4[q] = *(const LAS f32x4*)(buf + 8192 + tt * 64 + jseg * 16 + q * 4);
  f32x4 a4 = S[0] * o.k4[0] + S[1] * o.k4[1] + S[2] * o.k4[2] + S[3] * o.k4[3];
  float sa = -quad_sum((a4[0] + a4[1]) + (a4[2] + a4[3]));
  f32x4 y4 = (f32x4){0.f, 0.f, 0.f, 0.f};
#pragma unroll
  for (int q = 0; q < 4; ++q) { S[q] = S[q] * o.w4[q] + (o.b4[q] * sa + o.d4[q] * o.vi); y4 += S[q] * r4[q]; }
  return quad_sum((y4[0] + y4[1]) + (y4[2] + y4[3]));
}
DI void scan_phase(LAS unsigned char* lds, const u16* PA, const u16* VV, u16* YY, float* BON, const ScanW w) {
  int tid = threadIdx.x; asm volatile("" : "+v"(tid));
  int bid = blockIdx.x, gdim = gridDim.x; asm volatile("" : "+s"(bid), "+s"(gdim));
  LAS float* BUF = (LAS float*)lds;
  LAS float* AY = BUF + 2 * 12288;
  LAS unsigned* TW = (LAS unsigned*)(AY + 2 * 2048);
  LAS unsigned* TA = TW + SC * 16;
  LAS unsigned* DU = TA + SC * 16;
  LAS unsigned* IU = DU + 1024;
  const int wid = __builtin_amdgcn_readfirstlane(tid >> 6), lane = tid & 63;
  const int NCH = T / SC;
  for (int item = bid; item < 192; item += gdim) {
    const int dir = item & 1, h = (item >> 1) & 7, sq = item >> 4;
    __syncthreads();
    for (int i = tid; i < 1024; i += NTHREADS) { const int pr = i >> 6, c = i & 63; const size_t o0 = (size_t)(dir * 32 + 2 * pr) * 512 + h * 64 + c;
      DU[i] = cvt_pk_bf16(w.du[o0], w.du[o0 + 512]); IU[i] = cvt_pk_bf16(w.iu[o0], w.iu[o0 + 512]); }
    __syncthreads();
    f32x4 S[4];
#pragma unroll
    for (int q = 0; q < 4; ++q) S[q] = (f32x4){0.f, 0.f, 0.f, 0.f};
    const int irow = (wid & 3) * 16 + (lane >> 2), jseg = lane & 3;
    if (wid >= 4) scan_produce(BUF, TW, TA, DU, IU, PA, VV, BON, w, tid - 256, sq, h, dir, dir == 0 ? 0 : T - SC);
    __syncthreads();
#pragma unroll 1
    for (int ci = 0; ci < NCH; ++ci) {
      LAS float* buf = BUF + (ci & 1) * 12288;
      LAS float* ay = AY + (ci & 1) * 2048;
      if (wid < 4) {
        ScanOps o0, o1;
        scan_load(o0, buf, dir == 0 ? 0 : SC - 1, jseg, irow);
#pragma unroll 1
        for (int st = 0; st < SC; st += 2) {
          const int t0_ = dir == 0 ? st : SC - 1 - st, t1_ = dir == 0 ? st + 1 : SC - 2 - st;
          scan_load(o1, buf, t1_, jseg, irow);
          const float y0 = scan_step(S, o0, buf, t0_, jseg);
          if (jseg == 0) ay[t0_ * 64 + irow] = y0;
          if (st + 2 < SC) scan_load(o0, buf, dir == 0 ? st + 2 : SC - 3 - st, jseg, irow);
          const float y1 = scan_step(S, o1, buf, t1_, jseg);
          if (jseg == 0) ay[t1_ * 64 + irow] = y1;
        }
      } else {
        const int ptid = tid - 256;
        if (ci + 1 < NCH) scan_produce(BUF + ((ci + 1) & 1) * 12288, TW, TA, DU, IU, PA, VV, BON, w, ptid, sq, h, dir, dir == 0 ? (ci + 1) * SC : T - SC * (ci + 2));
        if (ci > 0) {
          LAS const float* py = AY + ((ci - 1) & 1) * 2048;
          const int t0p = dir == 0 ? (ci - 1) * SC : T - SC * ci;
          const int tok = ptid >> 3, c0 = (ptid & 7) * 8;
          const f32x4 ya = *(const LAS f32x4*)(py + tok * 64 + c0), yb = *(const LAS f32x4*)(py + tok * 64 + c0 + 4);
          u32x4 pk; pk.x = cvt_pk_bf16(ya[0], ya[1]); pk.y = cvt_pk_bf16(ya[2], ya[3]); pk.z = cvt_pk_bf16(yb[0], yb[1]); pk.w = cvt_pk_bf16(yb[2], yb[3]);
          *(u32x4*)(YY + ((size_t)dir * NT + (size_t)sq * T + t0p + tok) * 512 + h * 64 + c0) = pk;
        }
      }
      __syncthreads();
    }
    if (wid >= 4) {
      const int ptid = tid - 256;
      LAS const float* py = AY + ((NCH - 1) & 1) * 2048;
      const int t0p = dir == 0 ? (NCH - 1) * SC : 0;
      const int tok = ptid >> 3, c0 = (ptid & 7) * 8;
      const f32x4 ya = *(const LAS f32x4*)(py + tok * 64 + c0), yb = *(const LAS f32x4*)(py + tok * 64 + c0 + 4);
      u32x4 pk; pk.x = cvt_pk_bf16(ya[0], ya[1]); pk.y = cvt_pk_bf16(ya[2], ya[3]); pk.z = cvt_pk_bf16(yb[0], yb[1]); pk.w = cvt_pk_bf16(yb[2], yb[3]);
      *(u32x4*)(YY + ((size_t)dir * NT + (size_t)sq * T + t0p + tok) * 512 + h * 64 + c0) = pk;
    }
  }
}

DI void post_phase(LAS unsigned char* lds, u16* PA, const u16* PB, const u16* VV, const u16* YY, const float* BON, const float* mu, const float* gup, const float* gng, const float* gnb) {
  int tid = threadIdx.x; asm volatile("" : "+v"(tid));
  int bid = blockIdx.x, gdim = gridDim.x; asm volatile("" : "+s"(bid), "+s"(gdim));
  const int tok = tid >> 4, j = tid & 15;
  LAS unsigned* SG2 = (LAS unsigned*)lds;
  LAS unsigned* GU = (LAS unsigned*)(lds + 16384);
  const float* mu0 = mu; const float* mu1 = mu + A_COLS;
  __syncthreads();
  for (int e = tid; e < 48 * 512; e += NTHREADS) { const int r2 = e >> 9, c = e & 511; GU[(r2 * 2 + ((c >> 2) & 1)) * 256 + (c >> 3) * 4 + (c & 3)] = cvt_pk_bf16(gup[(2 * r2) * 512 + c], gup[(2 * r2 + 1) * 512 + c]); }
  for (int it = bid; it < NT / 32; it += gdim) {
    const size_t row = (size_t)it * 32 + tok; const int t = (int)(row % T);
    __syncthreads();
    { float sv[6];
#pragma unroll
      for (int q = 0; q < 6; ++q) {
        const int col = OFF_GD + j * 6 + q;
        const float c = bf2f(PA[row * A_COLS + col]);
        const float pv = t > 0 ? bf2f(PA[(row - 1) * A_COLS + col]) : 0.f, nx = t < T - 1 ? bf2f(PA[(row + 1) * A_COLS + col]) : 0.f;
        sv[q] = sigmoidf_(c + mu0[col] * (pv - c) + mu1[col] * (nx - c));
      }
#pragma unroll
      for (int pq = 0; pq < 3; ++pq) SG2[tok * 48 + j * 3 + pq] = cvt_pk_bf16(sv[2 * pq], sv[2 * pq + 1]); }
    __syncthreads();
#pragma unroll 1
    for (int q = 0; q < 4; ++q) {
      const int cc = q * 128 + j * 8, h = 2 * q + (j >> 3);
      float y[8]; float sm = 0.f;
      { float a[8], b[8]; load_bf16x8(YY + row * 512 + cc, a); load_bf16x8(YY + ((size_t)NT + row) * 512 + cc, b);
#pragma unroll
        for (int i = 0; i < 8; ++i) { y[i] = a[i] + b[i]; sm += y[i]; } }
      sm += __shfl_xor(sm, 1); sm += __shfl_xor(sm, 2); sm += __shfl_xor(sm, 4);
      const float mean = sm * (1.f / 64.f);
      float vq = 0.f;
#pragma unroll
      for (int i = 0; i < 8; ++i) { y[i] -= mean; vq += y[i] * y[i]; }
      vq += __shfl_xor(vq, 1); vq += __shfl_xor(vq, 2); vq += __shfl_xor(vq, 4);
      const float rs = rsqrtf(vq * (1.f / 64.f) + GN_EPS);
      const float bon = BON[row * 8 + h] + BON[((size_t)NT + row) * 8 + h];
      float gacc[8];
#pragma unroll
      for (int i = 0; i < 8; ++i) gacc[i] = 0.f;
#pragma unroll 8
      for (int r2 = 0; r2 < 48; ++r2) {
        const bf2 sv = __builtin_bit_cast(bf2, SG2[tok * 48 + r2]);
        const u32x4 wa = *(const LAS u32x4*)(GU + (r2 * 2 + 0) * 256 + (cc >> 3) * 4), wb = *(const LAS u32x4*)(GU + (r2 * 2 + 1) * 256 + (cc >> 3) * 4);
#pragma unroll
        for (int i = 0; i < 4; ++i) { unsigned ua = wa[i], ub = wb[i]; asm volatile("" : "+v"(ua), "+v"(ub));
          gacc[i] = __builtin_amdgcn_fdot2_f32_bf16(sv, __builtin_bit_cast(bf2, ua), gacc[i], false); gacc[4 + i] = __builtin_amdgcn_fdot2_f32_bf16(sv, __builtin_bit_cast(bf2, ub), gacc[4 + i], false); }
      }
      float vv[8]; load_bf16x8(VV + row * 512 + cc, vv);
      const f32x4 g0 = *(const f32x4*)(gng + cc), g1 = *(const f32x4*)(gng + cc + 4), b0 = *(const f32x4*)(gnb + cc), b1 = *(const f32x4*)(gnb + cc + 4);
      float o[8];
#pragma unroll
      for (int i = 0; i < 4; ++i) { o[i] = (y[i] * rs * g0[i] + b0[i] + bon * vv[i]) * gacc[i]; o[4 + i] = (y[4 + i] * rs * g1[i] + b1[i] + bon * vv[4 + i]) * gacc[4 + i]; }
      u32x4 pk; pk.x = cvt_pk_bf16(o[0], o[1]); pk.y = cvt_pk_bf16(o[2], o[3]); pk.z = cvt_pk_bf16(o[4], o[5]); pk.w = cvt_pk_bf16(o[6], o[7]);
      if (DBGZ & 1) pk = (u32x4){0u, 0u, 0u, 0u};
      *(u32x4*)(PA + row * A_COLS + cc) = pk;
      u32x4 pb4 = *(const u32x4*)(PB + row * 1024 + cc); if (DBGZ & 2) pb4 = (u32x4){0u, 0u, 0u, 0u};
      *(u32x4*)(PA + row * A_COLS + 512 + cc) = pb4;
    }
  }
}

DI unsigned hashu(unsigned x) { x ^= x >> 16; x *= 0x7feb352du; x ^= x >> 15; x *= 0x846ca68bu; x ^= x >> 16; return x; }
DI void dbg_upd(float* slot, float got, float ref, float scale) { float e = fabsf(got - ref) / scale; if (!(e == e)) e = 1e9f; atomicMax((unsigned*)slot, __float_as_uint(e)); }
DI float tshift(const u16* PA, size_t row, int col, const float* mu) {
  const int t = (int)(row % T);
  const float c = bf2f(PA[row * A_COLS + col]);
  const float pv = t > 0 ? bf2f(PA[(row - 1) * A_COLS + col]) : 0.f, nx = t < T - 1 ? bf2f(PA[(row + 1) * A_COLS + col]) : 0.f;
  return c + mu[col] * (pv - c) + mu[A_COLS + col] * (nx - c);
}
DI void chk_proj(const u16* XB, const float* win, const u16* PA, const u16* PB, const u16* VT, float* slot) {
  const int gt = blockIdx.x * NTHREADS + threadIdx.x;
  if (gt >= 4096) return;
  const int row = hashu(gt * 2 + 1) % NT, col = hashu(gt * 2 + 2) % P_COLS;
  float ref = 0.f;
  for (int k = 0; k < D; ++k) ref += bf2f(XB[(size_t)row * D + k]) * win[(size_t)k * P_COLS + col];
  float got;
  if (col < A_COLS) got = bf2f(PA[(size_t)row * A_COLS + col]);
  else if (col < A_COLS + 1024) got = bf2f(PB[(size_t)row * 1024 + col - A_COLS]);
  else { const int c2 = col - A_COLS - 1024, h = c2 >> 7, e = c2 & 127, sq = row / T, t = row % T; got = bf2f(VT[((size_t)((sq * 4 + h) * 128 + e)) * T + t]); }
  dbg_upd(slot, got, ref, 1.f);
}
DI void chk_ffn(const u16* XB, const float* wup, const float* cw, const float* cb, const u16* G, float* slot) {
  const int gt = blockIdx.x * NTHREADS + threadIdx.x;
  if (gt >= 4096) return;
  int row = hashu(gt * 2 + 11) % NT; const int n = hashu(gt * 2 + 12) % DFF;
  if (gt < 64) row = (gt & 1) ? (row / T) * T + T - 1 : (row / T) * T;
  else if (gt < 1024) row = (row / T) * T + ((row % T) / 254) * 254 + (gt & 1 ? 253 : 0), row = row >= NT ? NT - 1 : row;
  const int t = row % T;
  float hg[3] = {0.f, 0.f, 0.f}, hu[3] = {0.f, 0.f, 0.f};
#pragma unroll
  for (int d = -1; d <= 1; ++d) {
    float a = 0.f, b = 0.f;
    if (!(t + d < 0 || t + d > T - 1))
      for (int k = 0; k < D; ++k) { const float x = bf2f(XB[(size_t)(row + d) * D + k]); a += x * wup[(size_t)k * NUP + n]; b += x * wup[(size_t)k * NUP + DFF + n]; }
    hg[d + 1] = a; hu[d + 1] = b;
  }
  const float got = bf2f(G[(size_t)row * DFF + n]);
  { const float g = cw[n] * hg[0] + cw[NUP + n] * hg[1] + cw[2 * NUP + n] * hg[2] + cb[n];
    const float u = cw[DFF + n] * hu[0] + cw[NUP + DFF + n] * hu[1] + cw[2 * NUP + DFF + n] * hu[2] + cb[DFF + n];
    dbg_upd(slot, got, 0.5f * g * (1.f + erff(g * 0.70710678f)) * u, 1.f); }
  { const float g = cw[n] * hg[2] + cw[NUP + n] * hg[1] + cw[2 * NUP + n] * hg[0] + cb[n];
    const float u = cw[DFF + n] * hu[2] + cw[NUP + DFF + n] * hu[1] + cw[2 * NUP + DFF + n] * hu[0] + cb[DFF + n];
    dbg_upd(slot + 1, got, 0.5f * g * (1.f + erff(g * 0.70710678f)) * u, 1.f); }
  { const float g = cw[NUP + n] * hg[1] + cb[n];
    const float u = cw[NUP + DFF + n] * hu[1] + cb[DFF + n];
    dbg_upd(slot + 2, got, 0.5f * g * (1.f + erff(g * 0.70710678f)) * u, 1.f); }
}
DI void chk_attn(LAS unsigned char* lds, const u16* XB, const float* win, const u16* PB, const u16* VT, const float* lamp, const float* subg, const float* relb, int layer, float* slot) {
  if (blockIdx.x >= 16) return;
  const int tid = threadIdx.x;
  LAS float* qv = (LAS float*)lds;
  LAS float* sc = qv + 128;
  LAS float* red = sc + 16384;
  LAS float* ov = red + 1024;
  const int smp = blockIdx.x;
  const int sq = hashu(smp + 77) % NSEQ, h = smp & 3;
  int q = hashu(smp + 99) % T; if (smp < 4) q = smp * 37; if (smp >= 12) q = T - 1 - (smp - 12) * 50;
  const size_t row = (size_t)sq * T + q;
  __syncthreads();
  if (tid < 128) { float a = 0.f; const int col = A_COLS + h * 128 + tid; for (int k = 0; k < D; ++k) a += bf2f(XB[row * D + k]) * win[(size_t)k * P_COLS + col]; qv[tid] = a; }
  __syncthreads();
  float mx0 = -1e30f, mx1 = -1e30f;
  for (int key = tid; key < T; key += NTHREADS) {
    const u16* kp = PB + ((size_t)sq * T + key) * 1024 + 512 + h * 128;
    float s0 = 0.f, s1 = 0.f;
    for (int d = 0; d < 64; ++d) { s0 += qv[d] * bf2f(kp[d]); s1 += qv[64 + d] * bf2f(kp[64 + d]); }
    const int rel = key - q, n = rel < 0 ? -rel : rel;
    int bk;
    if (n < 8) bk = n; else { bk = 8 + (int)(logf((float)n / 8.f) / logf(16.f) * 8.f); bk = bk > 15 ? 15 : bk; }
    if (rel > 0) bk += 16;
    const float bias = relb[bk * 4 + h];
    s0 = s0 * 0.125f + bias; s1 = s1 * 0.125f + bias;
    sc[key] = s0; sc[8192 + key] = s1; mx0 = fmaxf(mx0, s0); mx1 = fmaxf(mx1, s1);
  }
  red[tid] = mx0; red[512 + tid] = mx1; __syncthreads();
  for (int o = 256; o > 0; o >>= 1) { if (tid < o) { red[tid] = fmaxf(red[tid], red[tid + o]); red[512 + tid] = fmaxf(red[512 + tid], red[512 + tid + o]); } __syncthreads(); }
  mx0 = red[0]; mx1 = red[512]; __syncthreads();
  float l0 = 0.f, l1 = 0.f;
  for (int key = tid; key < T; key += NTHREADS) { const float p0 = expf(sc[key] - mx0), p1 = expf(sc[8192 + key] - mx1); sc[key] = p0; sc[8192 + key] = p1; l0 += p0; l1 += p1; }
  red[tid] = l0; red[512 + tid] = l1; __syncthreads();
  for (int o = 256; o > 0; o >>= 1) { if (tid < o) { red[tid] += red[tid + o]; red[512 + tid] += red[512 + tid + o]; } __syncthreads(); }
  l0 = red[0]; l1 = red[512]; __syncthreads();
  float la = 0.f, lb = 0.f; for (int d = 0; d < 64; ++d) { la += lamp[d] * lamp[64 + d]; lb += lamp[128 + d] * lamp[192 + d]; }
  const float lam_init = 0.8f - 0.6f * expf(-0.3f * (float)layer);
  const float lam = expf(la) - expf(lb) + lam_init;
  { const int e = tid & 127, part = tid >> 7;
    const u16* vp = VT + ((size_t)((sq * 4 + h) * 128 + e)) * T;
    float o = 0.f;
    for (int key = part * 2048; key < (part + 1) * 2048; ++key) o += (sc[key] / l0 - lam * sc[8192 + key] / l1) * bf2f(vp[key]);
    red[tid] = o; }
  __syncthreads();
  if (tid < 128) ov[tid] = red[tid] + red[128 + tid] + red[256 + tid] + red[384 + tid];
  __syncthreads();
  if (tid < 128) {
    float ss = 0.f; for (int e = 0; e < 128; ++e) ss += ov[e] * ov[e];
    const float ref = ov[tid] * rsqrtf(ss / 128.f + LN_EPS) * subg[tid] * (1.f - lam_init);
    dbg_upd(slot, bf2f(PB[row * 1024 + h * 128 + tid]), ref, 1.f);
  }
}
struct ChkOp { float r, kd, kk, b, w, v; };
DI ChkOp chk_ops(const u16* PA, const u16* VV, const ScanW& w, size_t row, int h, int dir, int c, LAS float* tmp  , int tid) {
  ChkOp o;
  const int cg_ = h * 64 + c;
  o.r = tshift(PA, row, cg_, w.mu);
  const float k = tshift(PA, row, OFF_K + cg_, w.mu);
  float wl = w.w0[dir * 512 + cg_], al = w.a0[dir * 512 + cg_];
#pragma unroll 1
  for (int rr = 0; rr < 32; ++rr) {
    wl += tanhf(tshift(PA, row, OFF_WD + dir * 32 + rr, w.mu)) * w.du[(dir * 32 + rr) * 512 + cg_];
    al += tshift(PA, row, OFF_AD + dir * 32 + rr, w.mu) * w.iu[(dir * 32 + rr) * 512 + cg_];
  }
  const float sp = logf(1.f + expf(-wl));
  o.w = expf(-expf(-sp - 0.5f));
  const float a = 1.f / (1.f + expf(-al));
  const float kkv = k * w.kk_[cg_];
  __syncthreads(); tmp[tid] = kkv * kkv; __syncthreads();
  float ss = 0.f;
#pragma unroll 1
  for (int j = 0; j < 64; ++j) ss += tmp[j];
  o.kk = kkv * rsqrtf(ss + 1e-12f);
  o.kd = k * (1.f + (a - 1.f) * w.ka[cg_]);
  o.b = o.kk * a;
  o.v = bf2f(VV[row * 512 + cg_]);
  return o;
}
DI void chk_scan(LAS unsigned char* lds, const u16* PA, const u16* VV, const u16* YY, const float* BON, const ScanW w, float* slot) {
  if (blockIdx.x >= 48 || threadIdx.x >= 64) return;
  const int tid = threadIdx.x;
  LAS float* tmp = (LAS float*)lds; LAS float* red = tmp + 64;
  const int item = blockIdx.x * 4 + 1, dir = item & 1, h = (item >> 1) & 7, sq = item >> 4;
  const int t0 = dir == 0 ? 0 : T - 1, t1 = dir == 0 ? 1 : T - 2;
  const size_t row0 = (size_t)sq * T + t0, row1 = (size_t)sq * T + t1;
  const ChkOp a = chk_ops(PA, VV, w, row0, h, dir, tid, tmp, tid);
  const ChkOp b = chk_ops(PA, VV, w, row1, h, dir, tid, tmp, tid);
#define BSUM(dst, val) { __syncthreads(); red[tid] = (val); __syncthreads(); float sx_ = 0.f; _Pragma("unroll 1") for (int j_ = 0; j_ < 64; ++j_) sx_ += red[j_]; dst = sx_; }
  float ds0, ds1, ds2, ds3, ds4;
  BSUM(ds0, a.kd * a.r) BSUM(ds1, a.kd * b.w * b.r) BSUM(ds2, a.kd * (-b.kk)) BSUM(ds3, b.b * b.r) BSUM(ds4, b.kd * b.r)
  const float y0 = a.v * ds0;
  const float y1 = a.v * (ds1 + ds2 * ds3) + b.v * ds4;
  dbg_upd(slot, bf2f(YY[((size_t)dir * NT + row0) * 512 + h * 64 + tid]), y0, fabsf(y0) + 0.05f);
  dbg_upd(slot, bf2f(YY[((size_t)dir * NT + row1) * 512 + h * 64 + tid]), y1, fabsf(y1) + 0.05f);
  float bq = a.r * a.kd * w.rk[h * 64 + tid];
  __syncthreads(); red[tid] = bq; __syncthreads(); float bs = 0.f;
#pragma unroll 1
  for (int j = 0; j < 64; ++j) bs += red[j];
  dbg_upd(slot, BON[((size_t)dir * NT + row0) * 8 + h], bs, fabsf(bs) + 0.05f);
}
DI void chk_post(const u16* PA, const u16* PB, const u16* VV, const u16* YY, const float* BON, const float* mu, const float* gup, const float* gng, const float* gnb, float* slot) {
  const int gt = blockIdx.x * NTHREADS + threadIdx.x;
  if (gt >= 2048) return;
  const size_t row = hashu(gt * 2 + 21) % NT; const int c = hashu(gt * 2 + 22) % 512, h = c >> 6;
  float sm = 0.f;
  float yc = 0.f;
  for (int i = 0; i < 64; ++i) { const float y = bf2f(YY[row * 512 + h * 64 + i]) + bf2f(YY[((size_t)NT + row) * 512 + h * 64 + i]); sm += y; if (h * 64 + i == c) yc = y; }
  const float mean = sm / 64.f; float vq = 0.f;
  for (int i = 0; i < 64; ++i) { const float y = bf2f(YY[row * 512 + h * 64 + i]) + bf2f(YY[((size_t)NT + row) * 512 + h * 64 + i]) - mean; vq += y * y; }
  const float yn = (yc - mean) * rsqrtf(vq / 64.f + GN_EPS) * gng[c] + gnb[c];
  const float bon = (BON[row * 8 + h] + BON[((size_t)NT + row) * 8 + h]) * bf2f(VV[row * 512 + c]);
  float g = 0.f;
  for (int r = 0; r < 96; ++r) g += (1.f / (1.f + expf(-tshift(PA, row, OFF_GD + r, mu)))) * gup[r * 512 + c];
  const float ref = (yn + bon) * g;
  dbg_upd(slot, bf2f(PA[row * A_COLS + c]), ref, fabsf(ref) + 0.05f);
  dbg_upd(slot + 1, bf2f(PA[row * A_COLS + 512 + c]), bf2f(PB[row * 1024 + c]), 1.f);
}

__global__ __launch_bounds__(NTHREADS, 2) void mega(Params p_unused) {
  extern __shared__ __attribute__((aligned(16))) char shm[];
  cg::grid_group grid = cg::this_grid();
  LAS unsigned char* lds = (LAS unsigned char*)shm;
#define WS_PTRS CParams p = get_params(); unsigned char* ws = p->ws; \
  u16* WIN = (u16*)(ws + OFF_WIN); u16* WOUT = (u16*)(ws + OFF_WOUT); u16* WUP = (u16*)(ws + OFF_WUP); u16* WDN = (u16*)(ws + OFF_WDN); \
  u16* XB = (u16*)(ws + OFF_XB); u16* PA = (u16*)(ws + OFF_PA); u16* PB = (u16*)(ws + OFF_PB); u16* VT = (u16*)(ws + OFF_VT); \
  u16* G = (u16*)(ws + OFF_PA); u16* VV = (u16*)(ws + OFF_VV); u16* YY = (u16*)p->out; float* BON = (float*)(ws + OFF_BON); float* XF = p->out; \
  (void)WIN; (void)WOUT; (void)WUP; (void)WDN; (void)XB; (void)PA; (void)PB; (void)VT; (void)G; (void)VV; (void)YY; (void)BON; (void)XF;
  int ph = 0;
  const int ph_lo = get_params()->ph_lo, ph_hi = get_params()->ph_hi;
#ifndef ONLYMASK
#define ONLYMASK 0xffffffffu
#endif
#define PHASE_BEGIN if (((ONLYMASK >> (__COUNTER__ % 32)) & 1u) && ph >= ph_lo && ph < ph_hi) { WS_PTRS
#define PHASE_END } ++ph; if (ph > ph_lo && ph < ph_hi) grid.sync();

  PHASE_BEGIN
    for (int l = 0; l < 2; ++l) {
      convert_weight<0>(shm, p->in[4] + (size_t)l * D * P_COLS, WIN + (size_t)l * NPROJ * D, D, P_COLS, NPROJ, blockIdx.x, gridDim.x);
      convert_weight<1>(shm, p->in[22] + (size_t)l * D * D, WOUT + (size_t)l * D * D, D, D, D, blockIdx.x, gridDim.x);
      convert_weight<2>(shm, p->in[25] + (size_t)l * D * NUP, WUP + (size_t)l * NUP * D, D, NUP, NUP, blockIdx.x, gridDim.x);
      convert_weight<1>(shm, p->in[28] + (size_t)l * DFF * D, WDN + (size_t)l * D * DFF, DFF, D, D, blockIdx.x, gridDim.x);
    }
    ln_rows(p->in[0], p->in[1], NPROMPT_TOK, XF, XB, p->in[2], p->in[3], false);
  PHASE_END

#pragma unroll 1
  for (int l = 0; l < 2; ++l) {
    PHASE_BEGIN
      Gemm ga{XB, D, WIN + (size_t)l * NPROJ * D, D};
      EpiArgs ea{}; ea.pa = PA; ea.pb = PB; ea.vt = VT;
      gemm_phase<0, 0>(lds, ga, NT / 256, NPROJ / 256, ea);
#if PROBE_GEMM
      gemm_phase<0, 0>(lds, ga, NT / 256, NPROJ / 256, ea);
#endif
    PHASE_END
#pragma unroll 1
    for (int rnd = 0; rnd < 2; ++rnd) {
      if (ph >= ph_lo && ph < ph_hi) { WS_PTRS
        int bidu = blockIdx.x, gdu = gridDim.x; asm volatile("" : "+s"(bidu), "+s"(gdu));
        const bool split = (gdu == 256);
        if (rnd == 0) vprep_phase(lds, PA, VV, p->in[5] + (size_t)l * 2 * A_COLS, p->in[16], p->in[17], p->in[18], l);
        if (rnd == 1 && (!split || bidu < 192)) {
          ScanW sw; sw.mu = p->in[5] + (size_t)l * 2 * A_COLS; sw.w0 = p->in[6] + l * 1024; sw.du = p->in[7] + (size_t)l * 2 * 32 * 512; sw.a0 = p->in[8] + l * 1024;
          sw.iu = p->in[9] + (size_t)l * 2 * 32 * 512; sw.kk_ = p->in[11] + l * 512; sw.ka = p->in[12] + l * 512; sw.rk = p->in[13] + l * 512;
          scan_phase(lds, PA, VV, YY, BON, sw);
        } else if (rnd == 0 || split) {
          const int plo = rnd == 0 ? 0 : 40, phi = (rnd == 0 && split) ? 40 : 48;
          const int wlo = rnd == 0 ? 0 : 192, wcnt = rnd == 0 ? (gdu & ~7) : 64;
          attn_phase(lds, PB, VT, (float*)(ws + OFF_OSV), p->in[19] + l * 256, p->in[20] + l * 128, p->in[21], l, plo, phi, wlo, wcnt);
        }
      }
      ++ph; if (ph > ph_lo && ph < ph_hi) grid.sync();
    }
    PHASE_BEGIN
      post_phase(lds, PA, PB, VV, YY, BON, p->in[5] + (size_t)l * 2 * A_COLS, p->in[10] + (size_t)l * 96 * 512, p->in[14] + l * 512, p->in[15] + l * 512);
#if PROBE_MISC
      post_phase(lds, PA, PB, VV, YY, BON, p->in[5] + (size_t)l * 2 * A_COLS, p->in[10] + (size_t)l * 96 * 512, p->in[14] + l * 512, p->in[15] + l * 512);
#endif
    PHASE_END
    PHASE_BEGIN
      Gemm ga{PA, A_COLS, WOUT + (size_t)l * D * D, D};
      EpiArgs ea{}; ea.xf = XF; ea.xb = XB;
      gemm_phase<1, 0>(lds, ga, NT / 256, D / 256, ea);
    PHASE_END
    PHASE_BEGIN
      ln_rows(XF, XF, NT, XF, XB, p->in[23] + l * D, p->in[24] + l * D, false);
    PHASE_END
    PHASE_BEGIN
      Gemm ga{XB, D, WUP + (size_t)l * NUP * D, D};
      EpiArgs ea{}; ea.g = G; ea.cw = p->in[26] + (size_t)l * 3 * NUP; ea.cb = p->in[27] + (size_t)l * NUP;
      gemm_phase<2, 1>(lds, ga, NSEQ * 33, NUP / 256, ea);
#if PROBE_GEMM
      gemm_phase<2, 1>(lds, ga, NSEQ * 33, NUP / 256, ea);
#endif
    PHASE_END
    PHASE_BEGIN
      Gemm ga{G, DFF, WDN + (size_t)l * D * DFF, DFF};
      EpiArgs ea{}; ea.xf = XF; ea.xb = XB; ea.zero = (DBGZ & 4) ? 1 : 0;
      gemm_phase<1, 0>(lds, ga, NT / 256, D / 256, ea);
    PHASE_END
    PHASE_BEGIN
      ln_rows(XF, XF, NT, XF, XB, p->in[29] + l * D, p->in[30] + l * D, l == 1);
    PHASE_END
  }
}

#if DBG
#define DPTRS unsigned char* ws = p.ws; u16* XB = (u16*)(ws + OFF_XB); u16* PA = (u16*)(ws + OFF_PA); u16* PB = (u16*)(ws + OFF_PB); u16* VT = (u16*)(ws + OFF_VT); \
  u16* G = (u16*)(ws + OFF_PA); u16* VV = (u16*)(ws + OFF_VV); u16* YY = (u16*)(ws + OFF_XB); float* BON = (float*)(ws + OFF_BON); float* DE = (float*)(ws + OFF_DBG); \
  (void)XB; (void)PA; (void)PB; (void)VT; (void)G; (void)VV; (void)YY; (void)BON; (void)DE;
template <int which> __global__ __launch_bounds__(NTHREADS) void k_chk(Params p, int l) {
  extern __shared__ __attribute__((aligned(16))) char shm[];
  LAS unsigned char* lds = (LAS unsigned char*)shm;
  DPTRS
  if (which == 0) chk_proj(XB, p.in[4] + (size_t)l * D * P_COLS, PA, PB, VT, DE + 0);
  else if (which == 1) chk_attn(lds, XB, p.in[4] + (size_t)l * D * P_COLS, PB, VT, p.in[19] + l * 256, p.in[20] + l * 128, p.in[21], l, DE + 1);
  else if (which == 2) {
    ScanW sw; sw.mu = p.in[5] + (size_t)l * 2 * A_COLS; sw.w0 = p.in[6] + l * 1024; sw.du = p.in[7] + (size_t)l * 2 * 32 * 512; sw.a0 = p.in[8] + l * 1024;
    sw.iu = p.in[9] + (size_t)l * 2 * 32 * 512; sw.kk_ = p.in[11] + l * 512; sw.ka = p.in[12] + l * 512; sw.rk = p.in[13] + l * 512;
    chk_scan(lds, PA, VV, YY, BON, sw, DE + 2);
  } else if (which == 3) chk_post(PA, PB, VV, YY, BON, p.in[5] + (size_t)l * 2 * A_COLS, p.in[10] + (size_t)l * 96 * 512, p.in[14] + l * 512, p.in[15] + l * 512, DE + 3);
  else if (which == 5) chk_ffn(XB, p.in[25] + (size_t)l * D * NUP, p.in[26] + (size_t)l * 3 * NUP, p.in[27] + (size_t)l * NUP, G, DE + 5);
}
__global__ __launch_bounds__(NTHREADS) void k_encode(Params p) {
  const float* e = (const float*)(p.ws + OFF_DBG);
  const float eA = fmaxf(e[DBG_A], 1e-4f), eB = fmaxf(e[DBG_B], 1e-4f);
  const float V1 = 100.f + 100.f * log10f(eA / 1e-3f);
  float V2 = 1.f + log10f(eB / 1e-3f); V2 = fminf(fmaxf(V2, 0.3f), 8.f);
  const size_t n0 = (size_t)NPROMPT_TOK * D, n1 = (size_t)NT * D;
  for (size_t i = (size_t)blockIdx.x * NTHREADS + threadIdx.x; i < n1; i += (size_t)gridDim.x * NTHREADS) {
    float v = 0.f;
    if (i == 0 || i == n0) v = V1;
    else if (i < n0 / 2 || (i > n0 && i < n0 + (n1 - n0) / 2)) v = V2;
    p.out[i] = v;
  }
}
#endif

extern "C" void kernel_launch(void* const* d_in, const int* in_sizes, int n_in, void* d_out, int out_size, void* d_ws, size_t ws_size, hipStream_t stream) {
  static int grid = 0;
  if (grid == 0) {
    if (ws_size < WS_END) { fprintf(stderr, "ws too small: %zu < %zu\n", ws_size, (size_t)WS_END); grid = -1; return; }
    int dev = 0, cus = 0, per_cu = 0;
    hipGetDevice(&dev);
    hipDeviceGetAttribute(&cus, hipDeviceAttributeMultiprocessorCount, dev);
    hipFuncSetAttribute((const void*)mega, hipFuncAttributeMaxDynamicSharedMemorySize, LDS_BYTES);
#if DBG
    hipFuncSetAttribute((const void*)k_chk<1>, hipFuncAttributeMaxDynamicSharedMemorySize, 81920);
    hipFuncSetAttribute((const void*)k_chk<2>, hipFuncAttributeMaxDynamicSharedMemorySize, 81920);
#endif
    hipOccupancyMaxActiveBlocksPerMultiprocessor(&per_cu, (const void*)mega, NTHREADS, LDS_BYTES);
    if (per_cu < 1) per_cu = 1;
    grid = cus * 1;
  }
  if (grid < 0) return;
  Params p{};
  for (int i = 0; i < 31; ++i) p.in[i] = (const float*)d_in[i];
  p.out = (float*)d_out; p.ws = (unsigned char*)d_ws;
#if DBG
  hipMemsetAsync((char*)d_ws + OFF_DBG, 0, 256, stream);
  auto seg = [&](int lo, int hi) { Params q = p; q.ph_lo = lo; q.ph_hi = hi; void* a2[] = {&q};
    hipError_t e = hipLaunchCooperativeKernel((const void*)mega, dim3(grid), dim3(NTHREADS), a2, LDS_BYTES, stream);
    if (e != hipSuccess) fprintf(stderr, "cooperative launch failed: %s\n", hipGetErrorString(e)); };
  auto chk = [&](int l, int which) {
    if (which == 0) hipLaunchKernelGGL(k_chk<0>, dim3(64), dim3(NTHREADS), 81920, stream, p, l);
    if (which == 1) hipLaunchKernelGGL(k_chk<1>, dim3(64), dim3(NTHREADS), 81920, stream, p, l);
    if (which == 2) hipLaunchKernelGGL(k_chk<2>, dim3(64), dim3(NTHREADS), 81920, stream, p, l);
    if (which == 3) hipLaunchKernelGGL(k_chk<3>, dim3(64), dim3(NTHREADS), 81920, stream, p, l);
    if (which == 5) hipLaunchKernelGGL(k_chk<5>, dim3(64), dim3(NTHREADS), 81920, stream, p, l); };
  seg(0, 1);
  for (int l = 0; l < 2; ++l) {
    const int b = 1 + 9 * l;
    seg(b, b + 1); chk(l, 0);
    seg(b + 1, b + 2); chk(l, 1);
    seg(b + 2, b + 3); chk(l, 2);
    seg(b + 3, b + 4); chk(l, 3);
    seg(b + 4, b + 7); if (l == 0) chk(l, 5);
    seg(b + 7, b + 9);
  }
  hipLaunchKernelGGL(k_encode, dim3(1024), dim3(NTHREADS), 0, stream, p);
#else
  p.ph_lo = 0; p.ph_hi = 1000;
  void* args[] = {&p};
  hipError_t e = hipLaunchCooperativeKernel((const void*)mega, dim3(grid), dim3(NTHREADS), args, LDS_BYTES, stream);
  if (e != hipSuccess) fprintf(stderr, "cooperative launch failed: %s (grid %d)\n", hipGetErrorString(e), grid);
#endif
}
```

```cpp
#include <hip/hip_runtime.h>
#include <hip/hip_bf16.h>
#include <hip/hip_cooperative_groups.h>
#include <cstdio>
namespace cg = cooperative_groups;

#define DI __device__ __forceinline__
using bf16 = __hip_bfloat16;
using bf16x8 = __attribute__((ext_vector_type(8))) short;
using s16x4 = __attribute__((ext_vector_type(4))) short;
using f32x4 = __attribute__((ext_vector_type(4))) float;
using f32x16 = __attribute__((ext_vector_type(16))) float;
typedef unsigned short u16;
typedef __bf16 bf2 __attribute__((ext_vector_type(2)));
typedef unsigned u32x4 __attribute__((ext_vector_type(4)));
typedef unsigned u32x2 __attribute__((ext_vector_type(2)));

constexpr int D = 1024, T = 8192, NSEQ = 12, NT = NSEQ * T;
constexpr int NPROMPT_TOK = 4 * T;
constexpr int A_COLS = 1760, P_COLS = 3296, NPROJ = 3328;
constexpr int DFF = 2816, NUP = 5632;
constexpr int OFF_K = 512, OFF_V = 1024, OFF_WD = 1536, OFF_AD = 1600, OFF_GD = 1664;
constexpr float ALPHA = 1.4142135623730951f;
constexpr float LN_EPS = 1e-5f, GN_EPS = 64e-5f;
constexpr int NTHREADS = 512;
#ifndef DBGZ
#define DBGZ 0
#define DBG 0
#define PROBE_SCAN 0
#define PROBE_GEMM 0
#define PROBE_MISC 0
#ifndef CHK_PROJ_ON
#define CHK_PROJ_ON 1
#endif
#ifndef CHK_ATTN_ON
#define CHK_ATTN_ON 1
#endif
#ifndef CHK_SCAN_ON
#define CHK_SCAN_ON 1
#endif
#ifndef CHK_POST_ON
#define CHK_POST_ON 1
#endif
#ifndef CHK_FFN_ON
#define CHK_FFN_ON 1
#endif
#define DBG_A 5
#define DBG_B 6
#define DBGTHR 0.05f, 0.1f, 0.1f, 0.1f, 0.01f, 0.05f
#endif
constexpr int LDS_BYTES = 163840;

constexpr size_t SZ_WIN = (size_t)2 * NPROJ * D * 2;
constexpr size_t SZ_WOUT = (size_t)2 * D * D * 2;
constexpr size_t SZ_WUP = (size_t)2 * NUP * D * 2;
constexpr size_t SZ_WDN = (size_t)2 * D * DFF * 2;
constexpr size_t OFF_WIN = 0;
constexpr size_t OFF_WOUT = OFF_WIN + SZ_WIN;
constexpr size_t OFF_WUP = OFF_WOUT + SZ_WOUT;
constexpr size_t OFF_WDN = OFF_WUP + SZ_WUP;
constexpr size_t OFF_XB = OFF_WDN + SZ_WDN;
constexpr size_t OFF_PA = OFF_XB + (size_t)NT * D * 2;
constexpr size_t OFF_PB = OFF_PA + (size_t)NT * A_COLS * 2;
constexpr size_t OFF_VT = OFF_PB + (size_t)NT * 1024 * 2;
constexpr size_t OFF_VV = OFF_VT + (size_t)NT * 512 * 2;
constexpr size_t OFF_BON = OFF_VV + (size_t)NT * 512 * 2;
constexpr size_t OFF_OSV = OFF_BON + (size_t)2 * NT * 8 * 4;
constexpr size_t OFF_DBG = OFF_OSV + (size_t)256 * 64 * 512 * 4;
constexpr size_t WS_END = OFF_DBG + 256;
static_assert((size_t)NT * DFF * 2 <= (OFF_VV - OFF_PA), "G alias");

struct Params {
  const float* in[31];
  float* out;
  unsigned char* ws;
  int ph_lo, ph_hi;
};

typedef const __attribute__((address_space(4))) Params* CParams;
DI CParams get_params() { CParams pp = (CParams)__builtin_amdgcn_kernarg_segment_ptr(); asm volatile("" : "+s"(pp)); return pp; }

DI u16 f2bf(float x) { unsigned u = __float_as_uint(x); u += 0x7fffu + ((u >> 16) & 1u); return (u16)(u >> 16); }
DI unsigned cvt_pk_bf16(float lo, float hi) { unsigned r; asm volatile("v_cvt_pk_bf16_f32 %0, %1, %2" : "=v"(r) : "v"(lo), "v"(hi)); return r; }
DI float bf2f(u16 b) { return __uint_as_float(((unsigned)b) << 16); }
DI float sigmoidf_(float x) { return 1.f / (1.f + __expf(-x)); }

template <int MODE> DI int src_col(int n) {
  if (MODE == 0) { return n < A_COLS ? n : (n < 1792 ? -1 : n - 32); }
  if (MODE == 2) { int j = n >> 8, i = n & 255; return i < 128 ? j * 128 + i : DFF + j * 128 + (i - 128); }
  return n;
}
template <int MODE>
DI void convert_weight(char* shm, const float* W, u16* WT, int K, int Nsrc, int Ndst, int gtid_block, int nblocks) {
  float* tile = (float*)shm;
  int tn = Ndst / 64, tk = K / 64;
  for (int t = gtid_block; t < tn * tk; t += nblocks) {
    int n0 = (t / tk) * 64, k0 = (t % tk) * 64;
    __syncthreads();
    for (int e = threadIdx.x; e < 4096; e += NTHREADS) {
      int kk = e >> 6, nn = e & 63;
      int sc = src_col<MODE>(n0 + nn);
      tile[kk * 65 + nn] = sc >= 0 ? W[(size_t)(k0 + kk) * Nsrc + sc] : 0.f;
    }
    __syncthreads();
    for (int e = threadIdx.x; e < 4096; e += NTHREADS) {
      int nn = e >> 6, kk = e & 63;
      WT[(size_t)(n0 + nn) * K + k0 + kk] = f2bf(tile[kk * 65 + nn]);
    }
  }
}

constexpr int LNR = 4;
DI void ln_rows(const float* srcA, const float* srcB, int splitRow, float* dstF, u16* dstB, const float* g, const float* b, bool writeF, bool writeB) {
  int tid = threadIdx.x; asm volatile("" : "+v"(tid));
  int bid = blockIdx.x, gdim = gridDim.x; asm volatile("" : "+s"(bid), "+s"(gdim));
  int wave = tid >> 6, lane = tid & 63;
  int gw = bid * 8 + wave, nw = gdim * 8;
  for (int base = gw * LNR; base < NT; base += nw * LNR) {
    f32x4 v[LNR][4]; float s[LNR], q[LNR];
#pragma unroll
    for (int r = 0; r < LNR; ++r) {
      const int row = base + r;
      const float* src = row < splitRow ? srcA + (size_t)row * D : srcB + (size_t)(row - splitRow) * D;
#pragma unroll
      for (int i = 0; i < 4; ++i) v[r][i] = *(const f32x4*)(src + i * 256 + lane * 4);
    }
#pragma unroll
    for (int r = 0; r < LNR; ++r) { s[r] = 0.f;
#pragma unroll
      for (int i = 0; i < 4; ++i) s[r] += (v[r][i][0] + v[r][i][1]) + (v[r][i][2] + v[r][i][3]); }
#pragma unroll
    for (int o = 32; o > 0; o >>= 1)
#pragma unroll
      for (int r = 0; r < LNR; ++r) s[r] += __shfl_xor(s[r], o);
#pragma unroll
    for (int r = 0; r < LNR; ++r) { const float mu = s[r] * (1.f / D); q[r] = 0.f;
#pragma unroll
      for (int i = 0; i < 4; ++i) { v[r][i] -= mu; const f32x4 t = v[r][i] * v[r][i]; q[r] += (t[0] + t[1]) + (t[2] + t[3]); } }
#pragma unroll
    for (int o = 32; o > 0; o >>= 1)
#pragma unroll
      for (int r = 0; r < LNR; ++r) q[r] += __shfl_xor(q[r], o);
#pragma unroll
    for (int i = 0; i < 4; ++i) {
      const f32x4 gg = *(const f32x4*)(g + i * 256 + lane * 4), bb = *(const f32x4*)(b + i * 256 + lane * 4);
#pragma unroll
      for (int r = 0; r < LNR; ++r) {
        const int row = base + r;
        const float rs = rsqrtf(q[r] * (1.f / D) + LN_EPS);
        const f32x4 o4 = v[r][i] * rs * gg + bb;
        if (writeF) *(f32x4*)(dstF + (size_t)row * D + i * 256 + lane * 4) = o4;
        if (writeB) { u32x2 h; h.x = cvt_pk_bf16(o4[0], o4[1]); h.y = cvt_pk_bf16(o4[2], o4[3]);
          *(u32x2*)(dstB + (size_t)row * D + i * 256 + lane * 4) = h; }
      }
    }
  }
}

DI void ln_rows_bf16(u16* xb, const float* g, const float* b) {
  int tid = threadIdx.x; asm volatile("" : "+v"(tid));
  int bid = blockIdx.x, gdim = gridDim.x; asm volatile("" : "+s"(bid), "+s"(gdim));
  int wave = tid >> 6, lane = tid & 63;
  int gw = bid * 8 + wave, nw = gdim * 8;
  for (int base = gw * LNR; base < NT; base += nw * LNR) {
    f32x4 v[LNR][4]; float s[LNR], q[LNR];
#pragma unroll
    for (int r = 0; r < LNR; ++r) {
      const u16* src = xb + (size_t)(base + r) * D;
#pragma unroll
      for (int i = 0; i < 4; ++i) { const u32x2 x2 = *(const u32x2*)(src + i * 256 + lane * 4);
        v[r][i][0] = __uint_as_float(x2.x << 16); v[r][i][1] = __uint_as_float(x2.x & 0xffff0000u); v[r][i][2] = __uint_as_float(x2.y << 16); v[r][i][3] = __uint_as_float(x2.y & 0xffff0000u); }
    }
#pragma unroll
    for (int r = 0; r < LNR; ++r) { s[r] = 0.f;
#pragma unroll
      for (int i = 0; i < 4; ++i) s[r] += (v[r][i][0] + v[r][i][1]) + (v[r][i][2] + v[r][i][3]); }
#pragma unroll
    for (int o = 32; o > 0; o >>= 1)
#pragma unroll
      for (int r = 0; r < LNR; ++r) s[r] += __shfl_xor(s[r], o);
#pragma unroll
    for (int r = 0; r < LNR; ++r) { const float mu = s[r] * (1.f / D); q[r] = 0.f;
#pragma unroll
      for (int i = 0; i < 4; ++i) { v[r][i] -= mu; const f32x4 t = v[r][i] * v[r][i]; q[r] += (t[0] + t[1]) + (t[2] + t[3]); } }
#pragma unroll
    for (int o = 32; o > 0; o >>= 1)
#pragma unroll
      for (int r = 0; r < LNR; ++r) q[r] += __shfl_xor(q[r], o);
#pragma unroll
    for (int i = 0; i < 4; ++i) {
      const f32x4 gg = *(const f32x4*)(g + i * 256 + lane * 4), bb = *(const f32x4*)(b + i * 256 + lane * 4);
#pragma unroll
      for (int r = 0; r < LNR; ++r) {
        const float rs = rsqrtf(q[r] * (1.f / D) + LN_EPS);
        const f32x4 o4 = v[r][i] * rs * gg + bb;
        u32x2 h; h.x = cvt_pk_bf16(o4[0], o4[1]); h.y = cvt_pk_bf16(o4[2], o4[3]);
        *(u32x2*)(xb + (size_t)(base + r) * D + i * 256 + lane * 4) = h;
      }
    }
  }
}

#define LAS __attribute__((address_space(3)))
constexpr int BK = 64, HALF = 128, HTB = HALF * BK * 2, STAGE_BYTES = 8 * HTB;
DI int lds_byte(int r, int c) { const int st = (r >> 4) * 2 + (c >> 5), rr = r & 15, cc = c & 31, ob = rr * 64 + cc * 2; return st * 1024 + (ob ^ (((ob >> 9) & 1) << 5)); }
DI void stage_rc(int b, int& R, int& C) { const int st = b / 1024, sb = b % 1024, swz = sb ^ (((sb >> 9) & 1) << 5); R = (st >> 1) * 16 + swz / 64; C = (st & 1) * 32 + (swz % 64) / 2; }
DI int perm32(int rho) { const int n = rho >> 4, i = rho & 15; return 8 * (i >> 2) + 4 * n + (i & 3); }

typedef float f32x2 __attribute__((ext_vector_type(2)));
DI float gelu1(float v) {
  const float av = __builtin_fabsf(v), d = av * 0.2316418882f + 1.0f;
  const float t = __builtin_amdgcn_rcpf(d);
  float q = t * 0.5307027145f + (-0.7265760135f); q = q * t + 0.7107068705f; q = q * t + (-0.142248368f); q = q * t + 0.127414796f; q = q * t;
  const float e = __builtin_amdgcn_exp2f((v * v) * (-0.72134752044f));
  const float m = v * (q * e), r = v - m;
  return v < 0.f ? m : r;
}
DI float dpp_shr1(float old, float src) { asm volatile("s_nop 1\n\tv_mov_b32_dpp %0, %1 row_shr:1 row_mask:0xf bank_mask:0xf\n\ts_nop 0" : "+v"(old) : "v"(src)); return old; }
DI float dpp_shl1(float old, float src) { asm volatile("s_nop 1\n\tv_mov_b32_dpp %0, %1 row_shl:1 row_mask:0xf bank_mask:0xf\n\ts_nop 0" : "+v"(old) : "v"(src)); return old; }
struct Unit { int pm, pn; };
struct Order {
  int nM, nN, nwg, G, c;
  DI void init(int nM_, int nN_, int G_, int c_) { nM = nM_; nN = nN_; nwg = nM * nN; G = G_; c = c_; }
  DI bool next(int i, Unit& u) const {
    const long Lq = (long)i * G + c; if (Lq >= nwg) return false;
    int wgid = (int)Lq; { const int q = nwg / 8, r = nwg % 8, xcd = wgid % 8, off = wgid / 8; wgid = (xcd < r ? xcd * (q + 1) : r * (q + 1) + (xcd - r) * q) + off; }
    const int nig = 8 * nN, gid = wgid / nig, fm = gid * 8, gsz = (nM - fm) < 8 ? (nM - fm) : 8;
    u.pm = fm + ((wgid % nig) % gsz); u.pn = (wgid % nig) / gsz; return true;
  }
};
struct Gemm { const u16* A; int lda; const u16* Bt; int K; };
template <int ROWMODE> DI const char* a_tile_ptr(const Gemm& g, int pm) {
  long row = ROWMODE == 0 ? (long)pm * 256 : (long)(pm / 33) * T + 254 * (pm % 33) - 1;
  return (const char*)g.A + row * g.lda * 2;
}
struct EpiArgs {
  u16* pa; u16* pb; u16* vt;
  float* xf; u16* xb;
  u16* g; const float* cw; const float* cb;
  int zero; int pre_f32;
};
template <int EPI>
DI void epilogue(f32x4 (&acc)[2][2][4][2], const Unit& u, const EpiArgs& ea, LAS unsigned char* lds) {
  int tid2 = threadIdx.x; asm volatile("" : "+v"(tid2));
  const int wid2 = tid2 >> 6, lane2 = tid2 & 63, wr = wid2 >> 2, wc = wid2 & 3, fr = lane2 & 15, fq = lane2 >> 4;
  if (EPI == 0) {
    const int row0 = u.pm * 256 + wr * 64 + fr;
#pragma unroll
    for (int ai = 0; ai < 2; ++ai)
#pragma unroll
      for (int m = 0; m < 4; ++m) {
        const int row = row0 + ai * HALF + m * 16;
#pragma unroll
        for (int bj = 0; bj < 2; ++bj) {
          const int col = u.pn * 256 + bj * HALF + wc * 32 + 8 * fq;
          const f32x4 a0 = acc[ai][bj][m][0], a1 = acc[ai][bj][m][1];
          if (u.pn <= 10) {
            uint4 pk; pk.x = cvt_pk_bf16(a0[0], a0[1]); pk.y = cvt_pk_bf16(a0[2], a0[3]); pk.z = cvt_pk_bf16(a1[0], a1[1]); pk.w = cvt_pk_bf16(a1[2], a1[3]);
            if (u.pn <= 6) { if (col < A_COLS) *(uint4*)(ea.pa + (size_t)row * A_COLS + col) = pk; }
            else *(uint4*)(ea.pb + (size_t)row * 1024 + (col - 1792)) = pk;
          } else {
            const int c2 = col - 2816, h = c2 >> 7, e = c2 & 127, seq = row / T, t = row % T;
            u16* dst = ea.vt + ((size_t)((seq * 4 + h) * 128 + e)) * T + t;
#pragma unroll
            for (int j = 0; j < 4; ++j) { dst[(size_t)j * T] = f2bf(a0[j]); dst[(size_t)(4 + j) * T] = f2bf(a1[j]); }
          }
        }
      }
  } else if (EPI == 1) {
    const int row0 = u.pm * 256 + wr * 64 + fr, col0 = u.pn * 256 + wc * 32 + 4 * fq;
#pragma unroll
    for (int ai = 0; ai < 2; ++ai)
#pragma unroll
      for (int m = 0; m < 4; ++m) {
        float* rowp = ea.xf + (size_t)(row0 + ai * HALF + m * 16) * D + col0;
        u16* rowb = ea.xb + (size_t)(row0 + ai * HALF + m * 16) * D + col0;
#pragma unroll
        for (int bj = 0; bj < 2; ++bj)
#pragma unroll
          for (int n = 0; n < 2; ++n) { f32x4* p4 = (f32x4*)(rowp + bj * HALF + n * 16); const u32x2 xr = *(const u32x2*)(rowb + bj * HALF + n * 16);
            f32x4 x; x[0] = __uint_as_float(xr.x << 16); x[1] = __uint_as_float(xr.x & 0xffff0000u); x[2] = __uint_as_float(xr.y << 16); x[3] = __uint_as_float(xr.y & 0xffff0000u);
            const f32x4 pre = x * ALPHA + acc[ai][bj][m][n];
            if (ea.pre_f32) *p4 = pre;
            else { u32x2 hq; hq.x = cvt_pk_bf16(pre[0], pre[1]); hq.y = cvt_pk_bf16(pre[2], pre[3]); *(u32x2*)(rowb + bj * HALF + n * 16) = hq; } }
      }
  } else {
    LAS float* E = (LAS float*)(lds + STAGE_BYTES);
    const int seq = u.pm / 33, ti = u.pm % 33;
    const int cl0 = wc * 32 + 8 * fq;
#pragma unroll
    for (int ai = 0; ai < 2; ++ai)
#pragma unroll
      for (int m = 0; m < 4; ++m) {
        const int rl = ai * HALF + wr * 64 + m * 16 + fr;
        const int tok = 254 * ti - 1 + rl;
        const bool valid = tok >= 0 && tok < T;
        const int blk = ai * 8 + wr * 4 + m;
#pragma unroll
        for (int bj = 0; bj < 2; ++bj)
#pragma unroll
          for (int n = 0; n < 2; ++n) {
            if (!valid) acc[ai][bj][m][n] = (f32x4){0.f, 0.f, 0.f, 0.f};
            if (fr == 0) *(LAS f32x4*)(E + ((blk * 2 + 0) * 2 + bj) * 128 + cl0 + 4 * n) = acc[ai][bj][m][n];
            if (fr == 15) *(LAS f32x4*)(E + ((blk * 2 + 1) * 2 + bj) * 128 + cl0 + 4 * n) = acc[ai][bj][m][n];
          }
      }
    asm volatile("s_waitcnt lgkmcnt(0)" ::: "memory");
    __builtin_amdgcn_s_barrier(); asm volatile("" ::: "memory");
    __builtin_amdgcn_s_barrier(); asm volatile("" ::: "memory");
#pragma unroll
    for (int n = 0; n < 2; ++n) {
      const int hid = u.pn * 128 + cl0 + 4 * n;
      const float* cwp = ea.cw + hid;
      const f32x4 g0 = *(const f32x4*)(cwp), g1 = *(const f32x4*)(cwp + NUP), g2 = *(const f32x4*)(cwp + 2 * NUP), gb = *(const f32x4*)(ea.cb + hid);
      const f32x4 u0 = *(const f32x4*)(cwp + DFF), u1 = *(const f32x4*)(cwp + DFF + NUP), u2 = *(const f32x4*)(cwp + DFF + 2 * NUP), ub = *(const f32x4*)(ea.cb + DFF + hid);
#pragma unroll
      for (int ai = 0; ai < 2; ++ai)
#pragma unroll
        for (int m = 0; m < 4; ++m) {
          const int blk = ai * 8 + wr * 4 + m;
          const int rl = ai * HALF + wr * 64 + m * 16 + fr;
          const int tok = 254 * ti - 1 + rl;
          f32x4 hh[2];
#pragma unroll
          for (int bj = 0; bj < 2; ++bj) {
            const f32x4 cur = acc[ai][bj][m][n];
            f32x4 ab = (f32x4){0.f, 0.f, 0.f, 0.f}, be = (f32x4){0.f, 0.f, 0.f, 0.f};
            if (fr == 0 && blk > 0) ab = *(LAS f32x4*)(E + (((blk - 1) * 2 + 1) * 2 + bj) * 128 + cl0 + 4 * n);
            if (fr == 15 && blk < 15) be = *(LAS f32x4*)(E + (((blk + 1) * 2 + 0) * 2 + bj) * 128 + cl0 + 4 * n);
            f32x4 prev, next;
#pragma unroll
            for (int j = 0; j < 4; ++j) { prev[j] = dpp_shr1(ab[j], cur[j]); next[j] = dpp_shl1(be[j], cur[j]); }
            hh[bj] = bj == 0 ? g0 * prev + g1 * cur + g2 * next + gb : u0 * prev + u1 * cur + u2 * next + ub;
          }
          f32x4 res;
#pragma unroll
          for (int j = 0; j < 4; ++j) res[j] = gelu1(hh[0][j]) * hh[1][j];
          if (rl >= 1 && rl <= 254 && tok < T) {
            u32x2 pk; pk.x = cvt_pk_bf16(res[0], res[1]); pk.y = cvt_pk_bf16(res[2], res[3]);
            *(u32x2*)(ea.g + (size_t)(seq * T + tok) * DFF + hid) = pk;
          }
        }
    }
  }
}

template <int EPI, int ROWMODE>
DI void gemm_phase(LAS unsigned char* lds, const Gemm g, int nM, int nN, const EpiArgs& ea) {
  constexpr bool PERM = (EPI != 1);
  int tid = threadIdx.x; asm volatile("" : "+v"(tid));
  int bid = blockIdx.x, gdim = gridDim.x; asm volatile("" : "+s"(bid), "+s"(gdim));
  const int wid = __builtin_amdgcn_readfirstlane(tid >> 6), lane = tid & 63, wr = wid >> 2, wc = wid & 3, fr = lane & 15, fq = lane >> 4;
  const int K = g.K, nt = K / BK;
  Order S; S.init(nM, nN, gdim, bid);
  unsigned voffA[2], voffB[2];
#pragma unroll
  for (int i = 0; i < 2; ++i) { int R, C; stage_rc(tid * 16 + i * 8192, R, C); const int Rb = PERM ? ((R & ~31) + perm32(R & 31)) : R;
    voffA[i] = (unsigned)(R * g.lda + C) * 2u; voffB[i] = (unsigned)(Rb * K + C) * 2u; }
  const size_t kstep = (size_t)(BK * 2);
  const size_t hstepA = (size_t)HALF * g.lda * 2, hstepB = (size_t)HALF * K * 2;
  const unsigned ldsw = (unsigned)wid * 1024u;
  const int aoff = lds_byte(wr * 64 + fr, fq * 8), boff = lds_byte(wc * 32 + fr, fq * 8);
#define PG8_SA(b, h) (((b) * 2 + (h)) * HTB)
#define PG8_SB(b, h) ((4 + (b) * 2 + (h)) * HTB)
#define PG8_STAGE(bufoff, gbase, voff) do { _Pragma("unroll") for (int _i = 0; _i < 2; ++_i) \
    __builtin_amdgcn_global_load_lds((const unsigned*)((const char*)(gbase) + (voff)[_i]), (LAS unsigned*)(lds + (bufoff) + ldsw + _i * 8192), 16, 0, 0); } while (0)
#define PG8_LDA(dst, b, h) do { _Pragma("unroll") for (int m = 0; m < 4; ++m) _Pragma("unroll") for (int k = 0; k < 2; ++k) dst[m][k] = *(const LAS bf16x8*)(lds + PG8_SA(b, h) + aoff + m * 2048 + k * 1024); } while (0)
#define PG8_LDB(dst, b, h) do { _Pragma("unroll") for (int n = 0; n < 2; ++n) _Pragma("unroll") for (int k = 0; k < 2; ++k) dst[n][k] = *(const LAS bf16x8*)(lds + PG8_SB(b, h) + boff + n * 2048 + k * 1024); } while (0)
#define PG8_MMA(ai, bj, At, Bq) do { __builtin_amdgcn_s_setprio(1); _Pragma("unroll") for (int m = 0; m < 4; ++m) _Pragma("unroll") for (int n = 0; n < 2; ++n) _Pragma("unroll") for (int k = 0; k < 2; ++k) \
    acc[ai][bj][m][n] = __builtin_amdgcn_mfma_f32_16x16x32_bf16(Bq[n][k], At[m][k], acc[ai][bj][m][n], 0, 0, 0); __builtin_amdgcn_s_setprio(0); } while (0)
#define PG8_WAIT_V(n) asm volatile("s_waitcnt vmcnt(" #n ")" ::: "memory")
#define PG8_WAIT_L(n) asm volatile("s_waitcnt lgkmcnt(" #n ")" ::: "memory")
#define PG8_BAR __builtin_amdgcn_s_barrier()
#define PG8_SCHED __builtin_amdgcn_sched_barrier(0)
  Unit cur, nxt; int ui = 0;
  __syncthreads();
  if (!S.next(0, cur)) return;
  f32x4 acc[2][2][4][2];
#pragma unroll
  for (int a = 0; a < 2; ++a)
#pragma unroll
    for (int b = 0; b < 2; ++b)
#pragma unroll
      for (int m = 0; m < 4; ++m)
#pragma unroll
        for (int n = 0; n < 2; ++n) acc[a][b][m][n] = (f32x4){0.f, 0.f, 0.f, 0.f};
  bf16x8 At[4][2], B0[2][2], B1[2][2];
  const char* cA = a_tile_ptr<ROWMODE>(g, cur.pm); const char* cB = (const char*)g.Bt + (size_t)cur.pn * 2 * hstepB;
  PG8_STAGE(PG8_SB(0, 0), cB, voffB); PG8_STAGE(PG8_SA(0, 0), cA, voffA); PG8_STAGE(PG8_SB(0, 1), cB + hstepB, voffB); PG8_STAGE(PG8_SA(0, 1), cA + hstepA, voffA);
  if (wr == 1) PG8_BAR;
  PG8_WAIT_V(4); PG8_BAR;
  PG8_STAGE(PG8_SB(1, 0), cB + kstep, voffB); PG8_STAGE(PG8_SA(1, 0), cA + kstep, voffA); PG8_STAGE(PG8_SB(1, 1), cB + hstepB + kstep, voffB);
  PG8_WAIT_V(6); PG8_BAR;
  for (;;) {
    const bool has_next = S.next(ui + 1, nxt);
    const char* nA = has_next ? a_tile_ptr<ROWMODE>(g, nxt.pm) : cA; const char* nB = has_next ? (const char*)g.Bt + (size_t)nxt.pn * 2 * hstepB : cB;
    for (int t = 0; t < nt; t += 2) {
      const bool last = (t == nt - 2);
      const char* a1 = cA + (size_t)(t + 1) * kstep;
      const char* a2 = last ? nA : cA + (size_t)(t + 2) * kstep; const char* b2 = last ? nB : cB + (size_t)(t + 2) * kstep;
      const char* a3 = a2 + kstep; const char* b3 = b2 + kstep;
      PG8_LDB(B0, 0, 0); PG8_SCHED; PG8_LDA(At, 0, 0); PG8_STAGE(PG8_SA(1, 1), a1 + hstepA, voffA);
      PG8_WAIT_L(8); PG8_BAR; PG8_WAIT_L(0); PG8_MMA(0, 0, At, B0); PG8_BAR; PG8_SCHED;
      PG8_LDB(B1, 0, 1); PG8_STAGE(PG8_SB(0, 0), b2, voffB);
      PG8_BAR; PG8_WAIT_L(0); PG8_MMA(0, 1, At, B1); PG8_BAR;
      PG8_LDA(At, 0, 1); PG8_STAGE(PG8_SA(0, 0), a2, voffA);
      PG8_BAR; PG8_WAIT_L(0); PG8_MMA(1, 0, At, B0); PG8_BAR; PG8_SCHED;
      PG8_STAGE(PG8_SB(0, 1), b2 + hstepB, voffB);
      PG8_WAIT_V(6); PG8_BAR; PG8_MMA(1, 1, At, B1); PG8_BAR;
      PG8_LDB(B0, 1, 0); PG8_SCHED; PG8_LDA(At, 1, 0); PG8_STAGE(PG8_SA(0, 1), a2 + hstepA, voffA);
      PG8_WAIT_L(8); PG8_BAR; PG8_WAIT_L(0); PG8_MMA(0, 0, At, B0); PG8_BAR; PG8_SCHED;
      PG8_LDB(B1, 1, 1); PG8_STAGE(PG8_SB(1, 0), b3, voffB);
      PG8_BAR; PG8_WAIT_L(0); PG8_MMA(0, 1, At, B1); PG8_BAR;
      PG8_LDA(At, 1, 1); PG8_STAGE(PG8_SA(1, 0), a3, voffA);
      PG8_BAR; PG8_WAIT_L(0); PG8_MMA(1, 0, At, B0); PG8_BAR; PG8_SCHED;
      PG8_STAGE(PG8_SB(1, 1), b3 + hstepB, voffB);
      PG8_WAIT_V(6); PG8_BAR; PG8_MMA(1, 1, At, B1); PG8_BAR;
    }
    epilogue<EPI>(acc, cur, ea, lds);
    if (!has_next) break;
#pragma unroll
    for (int a = 0; a < 2; ++a)
#pragma unroll
      for (int b = 0; b < 2; ++b)
#pragma unroll
        for (int m = 0; m < 4; ++m)
#pragma unroll
          for (int n = 0; n < 2; ++n) acc[a][b][m][n] = (f32x4){0.f, 0.f, 0.f, 0.f};
    cur = nxt; cA = nA; cB = nB; ++ui;
  }
  PG8_WAIT_V(0);
  if (wr == 0) PG8_BAR;
  PG8_BAR;
#undef PG8_SA
#undef PG8_SB
}

constexpr int KROW = 144, VROW = 144;
constexpr int KBUF = 64 * KROW, VBUF = 128 * VROW, ABUF = KBUF + VBUF;
constexpr float LOG2E = 1.4426950408889634f;
DI bf16x8 pack8(const f32x16& x, int s) {
  u32x4 p; p.x = cvt_pk_bf16(x[8 * s], x[8 * s + 1]); p.y = cvt_pk_bf16(x[8 * s + 2], x[8 * s + 3]); p.z = cvt_pk_bf16(x[8 * s + 4], x[8 * s + 5]); p.w = cvt_pk_bf16(x[8 * s + 6], x[8 * s + 7]);
  return __builtin_bit_cast(bf16x8, p);
}
DI void attn_phase(LAS unsigned char* lds, u16* PB, const u16* VT, float* OSV, const float* lamp, const float* subg, const float* relb, int layer, int pair_lo, int pair_hi, int wg_lo, int wg_cnt) {
  int tid = threadIdx.x; asm volatile("" : "+v"(tid));
  int bid = blockIdx.x, gdim = gridDim.x; asm volatile("" : "+s"(bid), "+s"(gdim));
  const int wid = tid >> 6, lane = tid & 63, qi = lane & 31, g = lane >> 5;
  LAS float* tab = (LAS float*)(lds + 2 * ABUF);
  LAS float* scal = tab + 264;
  const float lam_init = 0.8f - 0.6f * __expf(-0.3f * (float)layer);
  __syncthreads();
  if (wid == 0) {
    float a = lamp[lane] * lamp[64 + lane], b = lamp[128 + lane] * lamp[192 + lane];
    for (int o = 32; o > 0; o >>= 1) { a += __shfl_xor(a, o); b += __shfl_xor(b, o); }
    if (lane == 0) scal[0] = __expf(a) - __expf(b) + lam_init;
  }
  const int m_sw = (qi & 0x13) | ((qi & 4) << 1) | ((qi & 8) >> 1);
  if (bid < wg_lo || bid >= wg_lo + wg_cnt) return;
  const int xcd = bid & 7, jq = (bid - wg_lo) >> 3;
  const int per_x = wg_cnt >> 3;
  const float c1 = 0.125f * LOG2E;
  for (int pr = pair_lo + xcd; pr < pair_hi; pr += 8) {
    const int s = pr >> 2, h = pr & 3;
    for (int qb = jq; qb < 32; qb += per_x) {
      __syncthreads();
      for (int i = tid; i < 257; i += NTHREADS) {
        const int rel = i - 128, n = rel < 0 ? -rel : rel;
        int bk = n < 8 ? n : (n <= 11 ? 8 : (n <= 15 ? 9 : (n <= 22 ? 10 : (n <= 31 ? 11 : (n <= 45 ? 12 : (n <= 63 ? 13 : (n <= 90 ? 14 : 15)))))));
        if (rel > 0) bk += 16;
        tab[i] = relb[bk * 4 + h] * LOG2E;
      }
      const int q0 = qb * 256 + wid * 32;
      const size_t tokbase = (size_t)s * T;
      float* osv = OSV + ((size_t)bid * 512 + tid) * 64;
#pragma unroll 1
      for (int c = 0; c < 2; ++c) {
        bf16x8 Q[4];
        { const u16* qp = PB + (tokbase + q0 + qi) * 1024 + h * 128 + c * 64 + g * 8;
#pragma unroll
          for (int ks = 0; ks < 4; ++ks) Q[ks] = *(const bf16x8*)(qp + ks * 16); }
        f32x16 O[4];
#pragma unroll
        for (int eb = 0; eb < 4; ++eb)
#pragma unroll
          for (int i = 0; i < 16; ++i) O[eb][i] = 0.f;
        float mrun = -1e30f, lrun = 0.f;
        const u16* kg = PB + (tokbase + (tid >> 3)) * 1024 + 512 + h * 128 + c * 64 + (tid & 7) * 8;
        const u16* vg = VT + ((size_t)((s * 4 + h) * 128 + (tid >> 2))) * T + (tid & 3) * 16;
        const unsigned kl = (tid >> 3) * KROW + (tid & 7) * 16, vl = KBUF + (tid >> 2) * VROW + (tid & 3) * 32;
        u32x4 rk0, rv0, rv1;
        rk0 = *(const u32x4*)(kg); rv0 = *(const u32x4*)(vg); rv1 = *(const u32x4*)(vg + 8);
        __syncthreads();
        *(LAS u32x4*)(lds + kl) = rk0; *(LAS u32x4*)(lds + vl) = rv0; *(LAS u32x4*)(lds + vl + 16) = rv1;
        __syncthreads();
        auto compute_tile = [&](const int kt, LAS unsigned char* buf) {
          const int kmin = kt * 64;
          const int dlo = kmin + 63 - q0, dhi = kmin - (q0 + 31);
          const int bmode = dlo <= -91 ? 0 : (dhi >= 91 ? 1 : 2);
          const float bconst = bmode == 0 ? tab[0] : tab[256];
          f32x16 S[2];
          {
            bf16x8 kf[2][4];
#pragma unroll
            for (int kb = 0; kb < 2; ++kb)
#pragma unroll
              for (int ks = 0; ks < 4; ++ks) kf[kb][ks] = *(const LAS bf16x8*)(buf + (kb * 32 + m_sw) * KROW + (ks * 16 + g * 8) * 2);
            __builtin_amdgcn_sched_barrier(0);
            __builtin_amdgcn_s_setprio(1);
#pragma unroll
            for (int kb = 0; kb < 2; ++kb) {
#pragma unroll
              for (int i = 0; i < 16; ++i) S[kb][i] = 0.f;
#pragma unroll
              for (int ks = 0; ks < 4; ++ks) S[kb] = __builtin_amdgcn_mfma_f32_32x32x16_bf16(kf[kb][ks], Q[ks], S[kb], 0, 0, 0);
            }
            __builtin_amdgcn_s_setprio(0);
          }
          bf16x8 vf[2][4];
          float sc = c1, off = bconst;
          if (bmode == 2) {
#pragma unroll
            for (int kb = 0; kb < 2; ++kb)
#pragma unroll
              for (int r = 0; r < 16; ++r) {
                int rel = kmin + kb * 32 + 16 * (r >> 3) + 8 * g + (r & 7) - (q0 + qi);
                rel = rel < -128 ? -128 : (rel > 128 ? 128 : rel);
                S[kb][r] = S[kb][r] * c1 + tab[rel + 128];
              }
            sc = 1.f; off = 0.f;
          }
          float mx = -3e38f;
#pragma unroll
          for (int kb = 0; kb < 2; ++kb)
#pragma unroll
            for (int r = 0; r < 16; ++r) mx = fmaxf(mx, S[kb][r]);
          mx = fmaxf(mx, __shfl_xor(mx, 32));
          mx = mx * sc + off;
          if (__any(mx > mrun + 8.f)) {
            const float mnew = mx > mrun + 8.f ? mx : mrun;
            const float alpha = __builtin_amdgcn_exp2f(mrun - mnew);
            mrun = mnew; lrun *= alpha;
#pragma unroll
            for (int eb = 0; eb < 4; ++eb)
#pragma unroll
              for (int i = 0; i < 16; ++i) O[eb][i] *= alpha;
          }
          const float sh = off - mrun;
          float ps0 = 0.f, ps1 = 0.f, ps2 = 0.f, ps3 = 0.f;
#pragma unroll
          for (int kb = 0; kb < 2; ++kb)
#pragma unroll
            for (int r = 0; r < 16; r += 4) {
              const float p0 = __builtin_amdgcn_exp2f(S[kb][r] * sc + sh), p1 = __builtin_amdgcn_exp2f(S[kb][r + 1] * sc + sh), p2 = __builtin_amdgcn_exp2f(S[kb][r + 2] * sc + sh), p3 = __builtin_amdgcn_exp2f(S[kb][r + 3] * sc + sh);
              S[kb][r] = p0; S[kb][r + 1] = p1; S[kb][r + 2] = p2; S[kb][r + 3] = p3; ps0 += p0; ps1 += p1; ps2 += p2; ps3 += p3;
            }
          lrun += (ps0 + ps1) + (ps2 + ps3);
          __builtin_amdgcn_sched_barrier(0);
          __builtin_amdgcn_s_setprio(1);
#pragma unroll
          for (int eb = 0; eb < 4; ++eb) vf[0][eb] = *(const LAS bf16x8*)(buf + KBUF + (eb * 32 + qi) * VROW + (g * 8) * 2);
#pragma unroll
          for (int stp = 0; stp < 4; ++stp) {
            const int kb = stp >> 1, hh = stp & 1;
            if (stp < 3) {
#pragma unroll
              for (int eb = 0; eb < 4; ++eb) vf[(stp + 1) & 1][eb] = *(const LAS bf16x8*)(buf + KBUF + (eb * 32 + qi) * VROW + ((stp + 1) * 16 + g * 8) * 2);
            }
            const bf16x8 pb = pack8(S[kb], hh);
#pragma unroll
            for (int eb = 0; eb < 4; ++eb) O[eb] = __builtin_amdgcn_mfma_f32_32x32x16_bf16(vf[stp & 1][eb], pb, O[eb], 0, 0, 0);
          }
          __builtin_amdgcn_s_setprio(0);
        };
        u32x4 rkB, rvB0, rvB1;
        { const u16* kg2 = kg + (size_t)1 * 64 * 1024; const u16* vg2 = vg + 64;
          rk0 = *(const u32x4*)(kg2); rv0 = *(const u32x4*)(vg2); rv1 = *(const u32x4*)(vg2 + 8);
          const u16* kg3 = kg + (size_t)2 * 64 * 1024; const u16* vg3 = vg + 128;
          rkB = *(const u32x4*)(kg3); rvB0 = *(const u32x4*)(vg3); rvB1 = *(const u32x4*)(vg3 + 8); }
#pragma unroll 1
        for (int kt = 0; kt < 128; kt += 2) {
          LAS unsigned char* buf0 = lds; LAS unsigned char* buf1 = lds + ABUF;
          compute_tile(kt, buf0);
          *(LAS u32x4*)(buf1 + kl) = rk0; *(LAS u32x4*)(buf1 + vl) = rv0; *(LAS u32x4*)(buf1 + vl + 16) = rv1;
          { const int tn = kt + 3 < 128 ? kt + 3 : 127; const u16* kg2 = kg + (size_t)tn * 64 * 1024; const u16* vg2 = vg + tn * 64;
            rk0 = *(const u32x4*)(kg2); rv0 = *(const u32x4*)(vg2); rv1 = *(const u32x4*)(vg2 + 8); }
          __syncthreads();
          compute_tile(kt + 1, buf1);
          *(LAS u32x4*)(buf0 + kl) = rkB; *(LAS u32x4*)(buf0 + vl) = rvB0; *(LAS u32x4*)(buf0 + vl + 16) = rvB1;
          { const int tn = kt + 4 < 128 ? kt + 4 : 127; const u16* kg2 = kg + (size_t)tn * 64 * 1024; const u16* vg2 = vg + tn * 64;
            rkB = *(const u32x4*)(kg2); rvB0 = *(const u32x4*)(vg2); rvB1 = *(const u32x4*)(vg2 + 8); }
          __syncthreads();
        }
        const float lt = lrun + __shfl_xor(lrun, 32);
        asm volatile("" : "+v"(osv));
        if (c == 0) {
          const float i0 = 1.f / lt;
#pragma unroll
          for (int eb = 0; eb < 4; ++eb)
#pragma unroll
            for (int i = 0; i < 16; i += 4) { f32x4 t4; t4[0] = O[eb][i] * i0; t4[1] = O[eb][i + 1] * i0; t4[2] = O[eb][i + 2] * i0; t4[3] = O[eb][i + 3] * i0; *(f32x4*)(osv + eb * 16 + i) = t4; }
        } else {
          const float i1 = scal[0] / lt;
          float ss = 0.f;
#pragma unroll
          for (int eb = 0; eb < 4; ++eb)
#pragma unroll
            for (int i = 0; i < 16; i += 4) { const f32x4 t4 = *(const f32x4*)(osv + eb * 16 + i);
#pragma unroll
              for (int j = 0; j < 4; ++j) { const float o = t4[j] - O[eb][i + j] * i1; O[eb][i + j] = o; ss += o * o; } }
          ss += __shfl_xor(ss, 32);
          const float rs = rsqrtf(ss * (1.f / 128.f) + LN_EPS) * (1.f - lam_init);
          u16* op = PB + (tokbase + q0 + qi) * 1024 + h * 128;
#pragma unroll
          for (int eb = 0; eb < 4; ++eb)
#pragma unroll
            for (int rr = 0; rr < 4; ++rr) {
              const int e = eb * 32 + 8 * rr + 4 * g;
              const f32x4 gg = *(const f32x4*)(subg + e);
              u32x2 pk; pk.x = cvt_pk_bf16(O[eb][4 * rr] * rs * gg[0], O[eb][4 * rr + 1] * rs * gg[1]); pk.y = cvt_pk_bf16(O[eb][4 * rr + 2] * rs * gg[2], O[eb][4 * rr + 3] * rs * gg[3]);
              *(u32x2*)(op + e) = pk;
            }
        }
      }
    }
  }
}

DI float softplusf_(float x) { return fmaxf(x, 0.f) + __logf(1.f + __expf(-fabsf(x))); }
DI void load_bf16x8(const u16* p, float (&o)[8]) {
  const u32x4 v = *(const u32x4*)p;
#pragma unroll
  for (int i = 0; i < 4; ++i) { o[2 * i] = __uint_as_float(v[i] << 16); o[2 * i + 1] = __uint_as_float(v[i] & 0xffff0000u); }
}
DI void shifted8(const u16* PA, size_t row, int t, int col, const float* mu0, const float* mu1, float (&o)[8]) {
  float c[8], pv[8], nx[8];
  load_bf16x8(PA + row * A_COLS + col, c);
  if (t > 0) load_bf16x8(PA + (row - 1) * A_COLS + col, pv); else { for (int i = 0; i < 8; ++i) pv[i] = 0.f; }
  if (t < T - 1) load_bf16x8(PA + (row + 1) * A_COLS + col, nx); else { for (int i = 0; i < 8; ++i) nx[i] = 0.f; }
#pragma unroll
  for (int i = 0; i < 8; ++i) o[i] = c[i] + mu0[col + i] * (pv[i] - c[i]) + mu1[col + i] * (nx[i] - c[i]);
}

DI void vprep_phase(LAS unsigned char* lds, const u16* PA, u16* VV, const float* mu, const float* vdown, const float* vup, const float* v0, int layer) {
  int tid = threadIdx.x; asm volatile("" : "+v"(tid));
  int bid = blockIdx.x, gdim = gridDim.x; asm volatile("" : "+s"(bid), "+s"(gdim));
  const int tok = tid >> 4, j = tid & 15;
  LAS float* vs = (LAS float*)lds;
  LAS float* dd = vs + 32 * 516;
  LAS unsigned* DN = (LAS unsigned*)(dd + 1024);
  LAS unsigned* UP = DN + 512 * 16;
  const float* mu0 = mu; const float* mu1 = mu + A_COLS;
  __syncthreads();
  if (layer != 0) {
    for (int i = tid; i < 512 * 16; i += NTHREADS) { const float2 w2 = *(const float2*)(vdown + 2 * i); DN[i] = cvt_pk_bf16(w2.x, w2.y); }
    for (int i = tid; i < 32 * 256; i += NTHREADS) { const float2 w2 = *(const float2*)(vup + 2 * i); UP[i] = cvt_pk_bf16(w2.x, w2.y); }
  }
  for (int it = bid; it < NT / 32; it += gdim) {
    const size_t row = (size_t)it * 32 + tok; const int t = (int)(row % T);
    __syncthreads();
#pragma unroll 1
    for (int q = 0; q < 4; ++q) {
      const int cc = q * 128 + j * 8;
      float o[8]; shifted8(PA, row, t, OFF_V + cc, mu0, mu1, o);
      if (layer == 0) {
        u32x4 pk; pk.x = cvt_pk_bf16(o[0], o[1]); pk.y = cvt_pk_bf16(o[2], o[3]); pk.z = cvt_pk_bf16(o[4], o[5]); pk.w = cvt_pk_bf16(o[6], o[7]);
        *(u32x4*)(VV + row * 512 + cc) = pk;
      } else {
        *(LAS f32x4*)(vs + tok * 516 + cc) = (f32x4){o[0], o[1], o[2], o[3]}; *(LAS f32x4*)(vs + tok * 516 + cc + 4) = (f32x4){o[4], o[5], o[6], o[7]};
      }
    }
    if (layer == 0) continue;
    __syncthreads();
    {
      float d0 = 0.f, d1 = 0.f;
#pragma unroll 8
      for (int c = 0; c < 512; ++c) { const float x = vs[tok * 516 + c]; const unsigned w2 = DN[c * 16 + j]; d0 += x * __uint_as_float(w2 << 16); d1 += x * __uint_as_float(w2 & 0xffff0000u); }
      dd[tok * 32 + 2 * j] = d0; dd[tok * 32 + 2 * j + 1] = d1;
    }
    __syncthreads();
#pragma unroll 1
    for (int q = 0; q < 4; ++q) {
      const int c0 = q * 128 + j * 8;
      float acc[8];
      { const f32x4 a0 = *(const f32x4*)(v0 + c0), a1 = *(const f32x4*)(v0 + c0 + 4);
#pragma unroll
        for (int i = 0; i < 4; ++i) { acc[i] = a0[i]; acc[4 + i] = a1[i]; } }
#pragma unroll 8
      for (int r = 0; r < 32; ++r) {
        const float dv = dd[tok * 32 + r];
        const u32x4 w8 = *(const LAS u32x4*)(UP + r * 256 + (c0 >> 1));
#pragma unroll
        for (int i = 0; i < 4; ++i) { acc[2 * i] += dv * __uint_as_float(w8[i] << 16); acc[2 * i + 1] += dv * __uint_as_float(w8[i] & 0xffff0000u); }
      }
      float vf[8]; load_bf16x8(VV + row * 512 + c0, vf);
      const f32x4 x0 = *(const LAS f32x4*)(vs + tok * 516 + c0), x1 = *(const LAS f32x4*)(vs + tok * 516 + c0 + 4);
      float o[8];
#pragma unroll
      for (int i = 0; i < 4; ++i) { o[i] = x0[i] + (vf[i] - x0[i]) * sigmoidf_(acc[i]); o[4 + i] = x1[i] + (vf[4 + i] - x1[i]) * sigmoidf_(acc[4 + i]); }
      u32x4 pk; pk.x = cvt_pk_bf16(o[0], o[1]); pk.y = cvt_pk_bf16(o[2], o[3]); pk.z = cvt_pk_bf16(o[4], o[5]); pk.w = cvt_pk_bf16(o[6], o[7]);
      *(u32x4*)(VV + row * 512 + c0) = pk;
    }
  }
}

struct ScanW { const float *mu, *w0, *du, *a0, *iu, *kk_, *ka, *rk; };
constexpr int SC = 32;
DI float quad_sum(float x) {
  x += __builtin_bit_cast(float, __builtin_amdgcn_update_dpp(0, __builtin_bit_cast(int, x), 0xB1, 0xf, 0xf, true));
  x += __builtin_bit_cast(float, __builtin_amdgcn_update_dpp(0, __builtin_bit_cast(int, x), 0x4E, 0xf, 0xf, true));
  return x;
}
#define BFLO(x) __uint_as_float((x) << 16)
#define BFHI(x) __uint_as_float((x) & 0xffff0000u)
DI float tanh_fast(float x) { x = fminf(fmaxf(x, -15.f), 15.f); const float t = __expf(2.f * x); return (t - 1.f) / (t + 1.f); }
DI float shift1(float c, float p, float n, float m0, float m1) { return c + m0 * (p - c) + m1 * (n - c); }
DI void scan_produce(LAS float* buf, LAS unsigned* TW, LAS unsigned* TA, LAS const unsigned* DU, LAS const unsigned* IU, const u16* PA, const u16* VV, float* BON,
                     const ScanW& w, int ptid, int sq, int h, int dir, int t0) {
  const int tok = ptid >> 3, j = ptid & 7;
  const int t = t0 + tok; const size_t row = (size_t)sq * T + t;
  const float* mu0 = w.mu; const float* mu1 = w.mu + A_COLS;
  const int cr = h * 64 + j * 8, ck = OFF_K + cr, cw_ = OFF_WD + dir * 32 + j * 4, ca_ = OFF_AD + dir * 32 + j * 4;
  const u16* pc = PA + row * A_COLS;
  const bool hp = t > 0, hn = t < T - 1;
  {
    const u32x2 w_c = *(const u32x2*)(pc + cw_), a_c = *(const u32x2*)(pc + ca_);
    u32x2 w_p = (u32x2){0u, 0u}, a_p = w_p, w_n = w_p, a_n = w_p;
    if (hp) { w_p = *(const u32x2*)(pc - A_COLS + cw_); a_p = *(const u32x2*)(pc - A_COLS + ca_); }
    if (hn) { w_n = *(const u32x2*)(pc + A_COLS + cw_); a_n = *(const u32x2*)(pc + A_COLS + ca_); }
    const f32x4 mw0 = *(const f32x4*)(mu0 + cw_), mw1 = *(const f32x4*)(mu1 + cw_), ma0 = *(const f32x4*)(mu0 + ca_), ma1 = *(const f32x4*)(mu1 + ca_);
    f32x4 tw, ta;
#pragma unroll
    for (int i = 0; i < 2; ++i) {
      tw[2 * i] = tanh_fast(shift1(BFLO(w_c[i]), BFLO(w_p[i]), BFLO(w_n[i]), mw0[2 * i], mw1[2 * i]));
      tw[2 * i + 1] = tanh_fast(shift1(BFHI(w_c[i]), BFHI(w_p[i]), BFHI(w_n[i]), mw0[2 * i + 1], mw1[2 * i + 1]));
      ta[2 * i] = shift1(BFLO(a_c[i]), BFLO(a_p[i]), BFLO(a_n[i]), ma0[2 * i], ma1[2 * i]);
      ta[2 * i + 1] = shift1(BFHI(a_c[i]), BFHI(a_p[i]), BFHI(a_n[i]), ma0[2 * i + 1], ma1[2 * i + 1]);
    }
    u32x2 tw2, ta2; tw2.x = cvt_pk_bf16(tw[0], tw[1]); tw2.y = cvt_pk_bf16(tw[2], tw[3]); ta2.x = cvt_pk_bf16(ta[0], ta[1]); ta2.y = cvt_pk_bf16(ta[2], ta[3]);
    *(LAS u32x2*)(TW + tok * 16 + j * 2) = tw2; *(LAS u32x2*)(TA + tok * 16 + j * 2) = ta2;
  }
  asm volatile("s_waitcnt lgkmcnt(0)" ::: "memory");
  float wl[8], al[8];
  const int cc = j * 8, cg_ = h * 64 + cc;
  { const f32x4 x0 = *(const f32x4*)(w.w0 + dir * 512 + cg_), x1 = *(const f32x4*)(w.w0 + dir * 512 + cg_ + 4), y0 = *(const f32x4*)(w.a0 + dir * 512 + cg_), y1 = *(const f32x4*)(w.a0 + dir * 512 + cg_ + 4);
#pragma unroll
    for (int q = 0; q < 4; ++q) { wl[q] = x0[q]; wl[4 + q] = x1[q]; al[q] = y0[q]; al[4 + q] = y1[q]; } }
#pragma unroll 2
  for (int pr = 0; pr < 16; ++pr) {
    const bf2 twp = __builtin_bit_cast(bf2, TW[tok * 16 + pr]), tap = __builtin_bit_cast(bf2, TA[tok * 16 + pr]);
    const u32x4 d0 = *(const LAS u32x4*)(DU + pr * 64 + cc), d1 = *(const LAS u32x4*)(DU + pr * 64 + cc + 4), i0 = *(const LAS u32x4*)(IU + pr * 64 + cc), i1 = *(const LAS u32x4*)(IU + pr * 64 + cc + 4);
#pragma unroll
    for (int q = 0; q < 4; ++q) {
      unsigned ua = d0[q], ub = d1[q], uc = i0[q], ud = i1[q]; asm volatile("" : "+v"(ua), "+v"(ub), "+v"(uc), "+v"(ud));
      wl[q] = __builtin_amdgcn_fdot2_f32_bf16(twp, __builtin_bit_cast(bf2, ua), wl[q], false); wl[4 + q] = __builtin_amdgcn_fdot2_f32_bf16(twp, __builtin_bit_cast(bf2, ub), wl[4 + q], false);
      al[q] = __builtin_amdgcn_fdot2_f32_bf16(tap, __builtin_bit_cast(bf2, uc), al[q], false); al[4 + q] = __builtin_amdgcn_fdot2_f32_bf16(tap, __builtin_bit_cast(bf2, ud), al[4 + q], false);
    }
  }
#pragma unroll
  for (int q = 0; q < 8; ++q) { asm volatile("" : "+v"(wl[q]), "+v"(al[q])); }
  LAS float* AW = buf; LAS float* AK = buf + 2048; LAS float* AB = buf + 4096; LAS float* AD = buf + 6144; LAS float* AR = buf + 8192; LAS float* AV = buf + 10240;
  const int o = tok * 64 + cc;
  float ss = 0.f, bs = 0.f;
  float ok[8], av[8];
#pragma unroll
  for (int hq = 0; hq < 2; ++hq) {
    const int c4 = 4 * hq;
    const u32x2 r_c = *(const u32x2*)(pc + cr + c4), k_c = *(const u32x2*)(pc + ck + c4);
    u32x2 r_p = (u32x2){0u, 0u}, k_p = r_p, r_n = r_p, k_n = r_p;
    if (hp) { r_p = *(const u32x2*)(pc - A_COLS + cr + c4); k_p = *(const u32x2*)(pc - A_COLS + ck + c4); }
    if (hn) { r_n = *(const u32x2*)(pc + A_COLS + cr + c4); k_n = *(const u32x2*)(pc + A_COLS + ck + c4); }
    const u32x2 v_c = *(const u32x2*)(VV + row * 512 + cr + c4);
    const f32x4 mr0 = *(const f32x4*)(mu0 + cr + c4), mr1 = *(const f32x4*)(mu1 + cr + c4), mk0 = *(const f32x4*)(mu0 + ck + c4), mk1 = *(const f32x4*)(mu1 + ck + c4);
    const f32x4 kk4 = *(const f32x4*)(w.kk_ + cg_ + c4), ka4 = *(const f32x4*)(w.ka + cg_ + c4), rk4 = *(const f32x4*)(w.rk + cg_ + c4);
    f32x4 rv, kv, vv, ow, od;
#pragma unroll
    for (int i = 0; i < 2; ++i) {
      rv[2 * i] = shift1(BFLO(r_c[i]), BFLO(r_p[i]), BFLO(r_n[i]), mr0[2 * i], mr1[2 * i]);
      rv[2 * i + 1] = shift1(BFHI(r_c[i]), BFHI(r_p[i]), BFHI(r_n[i]), mr0[2 * i + 1], mr1[2 * i + 1]);
      kv[2 * i] = shift1(BFLO(k_c[i]), BFLO(k_p[i]), BFLO(k_n[i]), mk0[2 * i], mk1[2 * i]);
      kv[2 * i + 1] = shift1(BFHI(k_c[i]), BFHI(k_p[i]), BFHI(k_n[i]), mk0[2 * i + 1], mk1[2 * i + 1]);
      vv[2 * i] = BFLO(v_c[i]); vv[2 * i + 1] = BFHI(v_c[i]);
    }
#pragma unroll
    for (int q = 0; q < 4; ++q) {
      const float wlog = -softplusf_(-wl[c4 + q]) - 0.5f;
      ow[q] = __expf(-__expf(wlog));
      const float a = sigmoidf_(al[c4 + q]);
      av[c4 + q] = a;
      ok[c4 + q] = kv[q] * kk4[q]; ss += ok[c4 + q] * ok[c4 + q];
      od[q] = kv[q] * (1.f + (a - 1.f) * ka4[q]);
      bs += rv[q] * od[q] * rk4[q];
    }
    *(LAS f32x4*)(AW + o + c4) = ow; *(LAS f32x4*)(AD + o + c4) = od; *(LAS f32x4*)(AR + o + c4) = rv; *(LAS f32x4*)(AV + o + c4) = vv;
  }
#pragma unroll
  for (int sft = 1; sft < 8; sft <<= 1) { ss += __shfl_xor(ss, sft); bs += __shfl_xor(bs, sft); }
  const float rn = rsqrtf(ss + 1e-12f);
#pragma unroll
  for (int hq = 0; hq < 2; ++hq) {
    f32x4 k4, b4;
#pragma unroll
    for (int q = 0; q < 4; ++q) { k4[q] = ok[4 * hq + q] * rn; b4[q] = k4[q] * av[4 * hq + q]; }
    *(LAS f32x4*)(AK + o + 4 * hq) = k4; *(LAS f32x4*)(AB + o + 4 * hq) = b4;
  }
  if (j == 0) BON[((size_t)dir * NT + row) * 8 + h] = bs;
}
struct ScanOps { f32x4 k4[4], w4[4], b4[4], d4[4]; float vi; };
DI void scan_load(ScanOps& o, LAS const float* buf, int tt, int jseg, int irow) {
  const int off = tt * 64 + jseg * 16;
#pragma unroll
  for (int q = 0; q < 4; ++q) {
    o.w4[q] = *(const LAS f32x4*)(buf + off + q * 4); o.k4[q] = *(const LAS f32x4*)(buf + 2048 + off + q * 4); o.b4[q] = *(const LAS f32x4*)(buf + 4096 + off + q * 4);
    o.d4[q] = *(const LAS f32x4*)(buf + 6144 + off + q * 4);
  }
  o.vi = buf[10240 + tt * 64 + irow];
}
DI float scan_step(f32x4 (&S)[4], const ScanOps& o, LAS const float* buf, int tt, int jseg) {
  f32x4 r4[4];
#pragma unroll
  for (int q = 0; q < 4; ++q) r4[q] = *(const LAS f32x4*)(buf + 8192 + tt * 64 + jseg * 16 + q * 4);
  f32x4 a4 = S[0] * o.k4[0] + S[1] * o.k4[1] + S[2] * o.k4[2] + S[3] * o.k4[3];
  float sa = -quad_sum((a4[0] + a4[1]) + (a4[2] + a4[3]));
  f32x4 y4 = (f32x4){0.f, 0.f, 0.f, 0.f};
#pragma unroll
  for (int q = 0; q < 4; ++q) { S[q] = S[q] * o.w4[q] + (o.b4[q] * sa + o.d4[q] * o.vi); y4 += S[q] * r4[q]; }
  return quad_sum((y4[0] + y4[1]) + (y4[2] + y4[3]));
}
DI void scan_phase(LAS unsigned char* lds, const u16* PA, const u16* VV, u16* YY, float* BON, const ScanW w) {
  int tid = threadIdx.x; asm volatile("" : "+v"(tid));
  int bid = blockIdx.x, gdim = gridDim.x; asm volatile("" : "+s"(bid), "+s"(gdim));
  LAS float* BUF = (LAS float*)lds;
  LAS float* AY = BUF + 2 * 12288;
  LAS unsigned* TW = (LAS unsigned*)(AY + 2 * 2048);
  LAS unsigned* TA = TW + SC * 16;
  LAS unsigned* DU = TA + SC * 16;
  LAS unsigned* IU = DU + 1024;
  const int wid = __builtin_amdgcn_readfirstlane(tid >> 6), lane = tid & 63;
  const int NCH = T / SC;
  for (int item = bid; item < 192; item += gdim) {
    const int dir = item & 1, h = (item >> 1) & 7, sq = item >> 4;
    __syncthreads();
    for (int i = tid; i < 1024; i += NTHREADS) { const int pr = i >> 6, c = i & 63; const size_t o0 = (size_t)(dir * 32 + 2 * pr) * 512 + h * 64 + c;
      DU[i] = cvt_pk_bf16(w.du[o0], w.du[o0 + 512]); IU[i] = cvt_pk_bf16(w.iu[o0], w.iu[o0 + 512]); }
    __syncthreads();
    f32x4 S[4];
#pragma unroll
    for (int q = 0; q < 4; ++q) S[q] = (f32x4){0.f, 0.f, 0.f, 0.f};
    const int irow = (wid & 3) * 16 + (lane >> 2), jseg = lane & 3;
    if (wid >= 4) scan_produce(BUF, TW, TA, DU, IU, PA, VV, BON, w, tid - 256, sq, h, dir, dir == 0 ? 0 : T - SC);
    __syncthreads();
#pragma unroll 1
    for (int ci = 0; ci < NCH; ++ci) {
      LAS float* buf = BUF + (ci & 1) * 12288;
      LAS float* ay = AY + (ci & 1) * 2048;
      if (wid < 4) {
        ScanOps o0, o1;
        scan_load(o0, buf, dir == 0 ? 0 : SC - 1, jseg, irow);
#pragma unroll 1
        for (int st = 0; st < SC; st += 2) {
          const int t0_ = dir == 0 ? st : SC - 1 - st, t1_ = dir == 0 ? st + 1 : SC - 2 - st;
          scan_load(o1, buf, t1_, jseg, irow);
          const float y0 = scan_step(S, o0, buf, t0_, jseg);
          if (jseg == 0) ay[t0_ * 64 + irow] = y0;
          if (st + 2 < SC) scan_load(o0, buf, dir == 0 ? st + 2 : SC - 3 - st, jseg, irow);
          const float y1 = scan_step(S, o1, buf, t1_, jseg);
          if (jseg == 0) ay[t1_ * 64 + irow] = y1;
        }
      } else {
        const int ptid = tid - 256;
        if (ci + 1 < NCH) scan_produce(BUF + ((ci + 1) & 1) * 12288, TW, TA, DU, IU, PA, VV, BON, w, ptid, sq, h, dir, dir == 0 ? (ci + 1) * SC : T - SC * (ci + 2));
        if (ci > 0) {
          LAS const float* py = AY + ((ci - 1) & 1) * 2048;
          const int t0p = dir == 0 ? (ci - 1) * SC : T - SC * ci;
          const int tok = ptid >> 3, c0 = (ptid & 7) * 8;
          const f32x4 ya = *(const LAS f32x4*)(py + tok * 64 + c0), yb = *(const LAS f32x4*)(py + tok * 64 + c0 + 4);
          u32x4 pk; pk.x = cvt_pk_bf16(ya[0], ya[1]); pk.y = cvt_pk_bf16(ya[2], ya[3]); pk.z = cvt_pk_bf16(yb[0], yb[1]); pk.w = cvt_pk_bf16(yb[2], yb[3]);
          *(u32x4*)(YY + ((size_t)dir * NT + (size_t)sq * T + t0p + tok) * 512 + h * 64 + c0) = pk;
        }
      }
      __syncthreads();
    }
    if (wid >= 4) {
      const int ptid = tid - 256;
      LAS const float* py = AY + ((NCH - 1) & 1) * 2048;
      const int t0p = dir == 0 ? (NCH - 1) * SC : 0;
      const int tok = ptid >> 3, c0 = (ptid & 7) * 8;
      const f32x4 ya = *(const LAS f32x4*)(py + tok * 64 + c0), yb = *(const LAS f32x4*)(py + tok * 64 + c0 + 4);
      u32x4 pk; pk.x = cvt_pk_bf16(ya[0], ya[1]); pk.y = cvt_pk_bf16(ya[2], ya[3]); pk.z = cvt_pk_bf16(yb[0], yb[1]); pk.w = cvt_pk_bf16(yb[2], yb[3]);
      *(u32x4*)(YY + ((size_t)dir * NT + (size_t)sq * T + t0p + tok) * 512 + h * 64 + c0) = pk;
    }
  }
}

DI void post_phase(LAS unsigned char* lds, u16* PA, const u16* PB, const u16* VV, const u16* YY, const float* BON, const float* mu, const float* gup, const float* gng, const float* gnb) {
  int tid = threadIdx.x; asm volatile("" : "+v"(tid));
  int bid = blockIdx.x, gdim = gridDim.x; asm volatile("" : "+s"(bid), "+s"(gdim));
  const int tok = tid >> 4, j = tid & 15;
  LAS unsigned* SG2 = (LAS unsigned*)lds;
  LAS unsigned* GU = (LAS unsigned*)(lds + 16384);
  const float* mu0 = mu; const float* mu1 = mu + A_COLS;
  __syncthreads();
  for (int e = tid; e < 48 * 512; e += NTHREADS) { const int r2 = e >> 9, c = e & 511; GU[(r2 * 2 + ((c >> 2) & 1)) * 256 + (c >> 3) * 4 + (c & 3)] = cvt_pk_bf16(gup[(2 * r2) * 512 + c], gup[(2 * r2 + 1) * 512 + c]); }
  for (int it = bid; it < NT / 32; it += gdim) {
    const size_t row = (size_t)it * 32 + tok; const int t = (int)(row % T);
    __syncthreads();
    { float sv[6];
#pragma unroll
      for (int q = 0; q < 6; ++q) {
        const int col = OFF_GD + j * 6 + q;
        const float c = bf2f(PA[row * A_COLS + col]);
        const float pv = t > 0 ? bf2f(PA[(row - 1) * A_COLS + col]) : 0.f, nx = t < T - 1 ? bf2f(PA[(row + 1) * A_COLS + col]) : 0.f;
        sv[q] = sigmoidf_(c + mu0[col] * (pv - c) + mu1[col] * (nx - c));
      }
#pragma unroll
      for (int pq = 0; pq < 3; ++pq) SG2[tok * 48 + j * 3 + pq] = cvt_pk_bf16(sv[2 * pq], sv[2 * pq + 1]); }
    __syncthreads();
#pragma unroll 1
    for (int q = 0; q < 4; ++q) {
      const int cc = q * 128 + j * 8, h = 2 * q + (j >> 3);
      float y[8]; float sm = 0.f;
      { float a[8], b[8]; load_bf16x8(YY + row * 512 + cc, a); load_bf16x8(YY + ((size_t)NT + row) * 512 + cc, b);
#pragma unroll
        for (int i = 0; i < 8; ++i) { y[i] = a[i] + b[i]; sm += y[i]; } }
      sm += __shfl_xor(sm, 1); sm += __shfl_xor(sm, 2); sm += __shfl_xor(sm, 4);
      const float mean = sm * (1.f / 64.f);
      float vq = 0.f;
#pragma unroll
      for (int i = 0; i < 8; ++i) { y[i] -= mean; vq += y[i] * y[i]; }
      vq += __shfl_xor(vq, 1); vq += __shfl_xor(vq, 2); vq += __shfl_xor(vq, 4);
      const float rs = rsqrtf(vq * (1.f / 64.f) + GN_EPS);
      const float bon = BON[row * 8 + h] + BON[((size_t)NT + row) * 8 + h];
      float gacc[8];
#pragma unroll
      for (int i = 0; i < 8; ++i) gacc[i] = 0.f;
#pragma unroll 8
      for (int r2 = 0; r2 < 48; ++r2) {
        const bf2 sv = __builtin_bit_cast(bf2, SG2[tok * 48 + r2]);
        const u32x4 wa = *(const LAS u32x4*)(GU + (r2 * 2 + 0) * 256 + (cc >> 3) * 4), wb = *(const LAS u32x4*)(GU + (r2 * 2 + 1) * 256 + (cc >> 3) * 4);
#pragma unroll
        for (int i = 0; i < 4; ++i) { unsigned ua = wa[i], ub = wb[i]; asm volatile("" : "+v"(ua), "+v"(ub));
          gacc[i] = __builtin_amdgcn_fdot2_f32_bf16(sv, __builtin_bit_cast(bf2, ua), gacc[i], false); gacc[4 + i] = __builtin_amdgcn_fdot2_f32_bf16(sv, __builtin_bit_cast(bf2, ub), gacc[4 + i], false); }
      }
      float vv[8]; load_bf16x8(VV + row * 512 + cc, vv);
      const f32x4 g0 = *(const f32x4*)(gng + cc), g1 = *(const f32x4*)(gng + cc + 4), b0 = *(const f32x4*)(gnb + cc), b1 = *(const f32x4*)(gnb + cc + 4);
      float o[8];
#pragma unroll
      for (int i = 0; i < 4; ++i) { o[i] = (y[i] * rs * g0[i] + b0[i] + bon * vv[i]) * gacc[i]; o[4 + i] = (y[4 + i] * rs * g1[i] + b1[i] + bon * vv[4 + i]) * gacc[4 + i]; }
      u32x4 pk; pk.x = cvt_pk_bf16(o[0], o[1]); pk.y = cvt_pk_bf16(o[2], o[3]); pk.z = cvt_pk_bf16(o[4], o[5]); pk.w = cvt_pk_bf16(o[6], o[7]);
      if (DBGZ & 1) pk = (u32x4){0u, 0u, 0u, 0u};
      *(u32x4*)(PA + row * A_COLS + cc) = pk;
      u32x4 pb4 = *(const u32x4*)(PB + row * 1024 + cc); if (DBGZ & 2) pb4 = (u32x4){0u, 0u, 0u, 0u};
      *(u32x4*)(PA + row * A_COLS + 512 + cc) = pb4;
    }
  }
}

DI unsigned hashu(unsigned x) { x ^= x >> 16; x *= 0x7feb352du; x ^= x >> 15; x *= 0x846ca68bu; x ^= x >> 16; return x; }
DI void dbg_upd(float* slot, float got, float ref, float scale) { float e = fabsf(got - ref) / scale; if (!(e == e)) e = 1e9f; atomicMax((unsigned*)slot, __float_as_uint(e)); }
DI float tshift(const u16* PA, size_t row, int col, const float* mu) {
  const int t = (int)(row % T);
  const float c = bf2f(PA[row * A_COLS + col]);
  const float pv = t > 0 ? bf2f(PA[(row - 1) * A_COLS + col]) : 0.f, nx = t < T - 1 ? bf2f(PA[(row + 1) * A_COLS + col]) : 0.f;
  return c + mu[col] * (pv - c) + mu[A_COLS + col] * (nx - c);
}
DI void chk_proj(const u16* XB, const float* win, const u16* PA, const u16* PB, const u16* VT, float* slot) {
  const int gt = blockIdx.x * NTHREADS + threadIdx.x;
  if (gt >= 4096) return;
  const int row = hashu(gt * 2 + 1) % NT, col = hashu(gt * 2 + 2) % P_COLS;
  float ref = 0.f;
  for (int k = 0; k < D; ++k) ref += bf2f(XB[(size_t)row * D + k]) * win[(size_t)k * P_COLS + col];
  float got;
  if (col < A_COLS) got = bf2f(PA[(size_t)row * A_COLS + col]);
  else if (col < A_COLS + 1024) got = bf2f(PB[(size_t)row * 1024 + col - A_COLS]);
  else { const int c2 = col - A_COLS - 1024, h = c2 >> 7, e = c2 & 127, sq = row / T, t = row % T; got = bf2f(VT[((size_t)((sq * 4 + h) * 128 + e)) * T + t]); }
  dbg_upd(slot, got, ref, 1.f);
}
DI void chk_ffn(const u16* XB, const float* wup, const float* cw, const float* cb, const u16* G, float* slot) {
  const int gt = blockIdx.x * NTHREADS + threadIdx.x;
  if (gt >= 4096) return;
  int row = hashu(gt * 2 + 11) % NT; const int n = hashu(gt * 2 + 12) % DFF;
  if (gt < 64) row = (gt & 1) ? (row / T) * T + T - 1 : (row / T) * T;
  else if (gt < 1024) row = (row / T) * T + ((row % T) / 254) * 254 + (gt & 1 ? 253 : 0), row = row >= NT ? NT - 1 : row;
  const int t = row % T;
  float hg[3] = {0.f, 0.f, 0.f}, hu[3] = {0.f, 0.f, 0.f};
#pragma unroll
  for (int d = -1; d <= 1; ++d) {
    float a = 0.f, b = 0.f;
    if (!(t + d < 0 || t + d > T - 1))
      for (int k = 0; k < D; ++k) { const float x = bf2f(XB[(size_t)(row + d) * D + k]); a += x * wup[(size_t)k * NUP + n]; b += x * wup[(size_t)k * NUP + DFF + n]; }
    hg[d + 1] = a; hu[d + 1] = b;
  }
  const float got = bf2f(G[(size_t)row * DFF + n]);
  { const float g = cw[n] * hg[0] + cw[NUP + n] * hg[1] + cw[2 * NUP + n] * hg[2] + cb[n];
    const float u = cw[DFF + n] * hu[0] + cw[NUP + DFF + n] * hu[1] + cw[2 * NUP + DFF + n] * hu[2] + cb[DFF + n];
    dbg_upd(slot, got, 0.5f * g * (1.f + erff(g * 0.70710678f)) * u, 1.f); }
  { const float g = cw[n] * hg[2] + cw[NUP + n] * hg[1] + cw[2 * NUP + n] * hg[0] + cb[n];
    const float u = cw[DFF + n] * hu[2] + cw[NUP + DFF + n] * hu[1] + cw[2 * NUP + DFF + n] * hu[0] + cb[DFF + n];
    dbg_upd(slot + 1, got, 0.5f * g * (1.f + erff(g * 0.70710678f)) * u, 1.f); }
  { const float g = cw[NUP + n] * hg[1] + cb[n];
    const float u = cw[NUP + DFF + n] * hu[1] + cb[DFF + n];
    dbg_upd(slot + 2, got, 0.5f * g * (1.f + erff(g * 0.70710678f)) * u, 1.f); }
}
DI void chk_attn(LAS unsigned char* lds, const u16* XB, const float* win, const u16* PB, const u16* VT, const float* lamp, const float* subg, const float* relb, int layer, float* slot) {
  if (blockIdx.x >= 16) return;
  const int tid = threadIdx.x;
  LAS float* qv = (LAS float*)lds;
  LAS float* sc = qv + 128;
  LAS float* red = sc + 16384;
  LAS float* ov = red + 1024;
  const int smp = blockIdx.x;
  const int sq = hashu(smp + 77) % NSEQ, h = smp & 3;
  int q = hashu(smp + 99) % T; if (smp < 4) q = smp * 37; if (smp >= 12) q = T - 1 - (smp - 12) * 50;
  const size_t row = (size_t)sq * T + q;
  __syncthreads();
  if (tid < 128) { float a = 0.f; const int col = A_COLS + h * 128 + tid; for (int k = 0; k < D; ++k) a += bf2f(XB[row * D + k]) * win[(size_t)k * P_COLS + col]; qv[tid] = a; }
  __syncthreads();
  float mx0 = -1e30f, mx1 = -1e30f;
  for (int key = tid; key < T; key += NTHREADS) {
    const u16* kp = PB + ((size_t)sq * T + key) * 1024 + 512 + h * 128;
    float s0 = 0.f, s1 = 0.f;
    for (int d = 0; d < 64; ++d) { s0 += qv[d] * bf2f(kp[d]); s1 += qv[64 + d] * bf2f(kp[64 + d]); }
    const int rel = key - q, n = rel < 0 ? -rel : rel;
    int bk;
    if (n < 8) bk = n; else { bk = 8 + (int)(logf((float)n / 8.f) / logf(16.f) * 8.f); bk = bk > 15 ? 15 : bk; }
    if (rel > 0) bk += 16;
    const float bias = relb[bk * 4 + h];
    s0 = s0 * 0.125f + bias; s1 = s1 * 0.125f + bias;
    sc[key] = s0; sc[8192 + key] = s1; mx0 = fmaxf(mx0, s0); mx1 = fmaxf(mx1, s1);
  }
  red[tid] = mx0; red[512 + tid] = mx1; __syncthreads();
  for (int o = 256; o > 0; o >>= 1) { if (tid < o) { red[tid] = fmaxf(red[tid], red[tid + o]); red[512 + tid] = fmaxf(red[512 + tid], red[512 + tid + o]); } __syncthreads(); }
  mx0 = red[0]; mx1 = red[512]; __syncthreads();
  float l0 = 0.f, l1 = 0.f;
  for (int key = tid; key < T; key += NTHREADS) { const float p0 = expf(sc[key] - mx0), p1 = expf(sc[8192 + key] - mx1); sc[key] = p0; sc[8192 + key] = p1; l0 += p0; l1 += p1; }
  red[tid] = l0; red[512 + tid] = l1; __syncthreads();
  for (int o = 256; o > 0; o >>= 1) { if (tid < o) { red[tid] += red[tid + o]; red[512 + tid] += red[512 + tid + o]; } __syncthreads(); }
  l0 = red[0]; l1 = red[512]; __syncthreads();
  float la = 0.f, lb = 0.f; for (int d = 0; d < 64; ++d) { la += lamp[d] * lamp[64 + d]; lb += lamp[128 + d] * lamp[192 + d]; }
  const float lam_init = 0.8f - 0.6f * expf(-0.3f * (float)layer);
  const float lam = expf(la) - expf(lb) + lam_init;
  { const int e = tid & 127, part = tid >> 7;
    const u16* vp = VT + ((size_t)((sq * 4 + h) * 128 + e)) * T;
    float o = 0.f;
    for (int key = part * 2048; key < (part + 1) * 2048; ++key) o += (sc[key] / l0 - lam * sc[8192 + key] / l1) * bf2f(vp[key]);
    red[tid] = o; }
  __syncthreads();
  if (tid < 128) ov[tid] = red[tid] + red[128 + tid] + red[256 + tid] + red[384 + tid];
  __syncthreads();
  if (tid < 128) {
    float ss = 0.f; for (int e = 0; e < 128; ++e) ss += ov[e] * ov[e];
    const float ref = ov[tid] * rsqrtf(ss / 128.f + LN_EPS) * subg[tid] * (1.f - lam_init);
    dbg_upd(slot, bf2f(PB[row * 1024 + h * 128 + tid]), ref, 1.f);
  }
}
struct ChkOp { float r, kd, kk, b, w, v; };
DI ChkOp chk_ops(const u16* PA, const u16* VV, const ScanW& w, size_t row, int h, int dir, int c, LAS float* tmp  , int tid) {
  ChkOp o;
  const int cg_ = h * 64 + c;
  o.r = tshift(PA, row, cg_, w.mu);
  const float k = tshift(PA, row, OFF_K + cg_, w.mu);
  float wl = w.w0[dir * 512 + cg_], al = w.a0[dir * 512 + cg_];
#pragma unroll 1
  for (int rr = 0; rr < 32; ++rr) {
    wl += tanhf(tshift(PA, row, OFF_WD + dir * 32 + rr, w.mu)) * w.du[(dir * 32 + rr) * 512 + cg_];
    al += tshift(PA, row, OFF_AD + dir * 32 + rr, w.mu) * w.iu[(dir * 32 + rr) * 512 + cg_];
  }
  const float sp = logf(1.f + expf(-wl));
  o.w = expf(-expf(-sp - 0.5f));
  const float a = 1.f / (1.f + expf(-al));
  const float kkv = k * w.kk_[cg_];
  __syncthreads(); tmp[tid] = kkv * kkv; __syncthreads();
  float ss = 0.f;
#pragma unroll 1
  for (int j = 0; j < 64; ++j) ss += tmp[j];
  o.kk = kkv * rsqrtf(ss + 1e-12f);
  o.kd = k * (1.f + (a - 1.f) * w.ka[cg_]);
  o.b = o.kk * a;
  o.v = bf2f(VV[row * 512 + cg_]);
  return o;
}
DI void chk_scan(LAS unsigned char* lds, const u16* PA, const u16* VV, const u16* YY, const float* BON, const ScanW w, float* slot) {
  if (blockIdx.x >= 48 || threadIdx.x >= 64) return;
  const int tid = threadIdx.x;
  LAS float* tmp = (LAS float*)lds; LAS float* red = tmp + 64;
  const int item = blockIdx.x * 4 + 1, dir = item & 1, h = (item >> 1) & 7, sq = item >> 4;
  const int t0 = dir == 0 ? 0 : T - 1, t1 = dir == 0 ? 1 : T - 2;
  const size_t row0 = (size_t)sq * T + t0, row1 = (size_t)sq * T + t1;
  const ChkOp a = chk_ops(PA, VV, w, row0, h, dir, tid, tmp, tid);
  const ChkOp b = chk_ops(PA, VV, w, row1, h, dir, tid, tmp, tid);
#define BSUM(dst, val) { __syncthreads(); red[tid] = (val); __syncthreads(); float sx_ = 0.f; _Pragma("unroll 1") for (int j_ = 0; j_ < 64; ++j_) sx_ += red[j_]; dst = sx_; }
  float ds0, ds1, ds2, ds3, ds4;
  BSUM(ds0, a.kd * a.r) BSUM(ds1, a.kd * b.w * b.r) BSUM(ds2, a.kd * (-b.kk)) BSUM(ds3, b.b * b.r) BSUM(ds4, b.kd * b.r)
  const float y0 = a.v * ds0;
  const float y1 = a.v * (ds1 + ds2 * ds3) + b.v * ds4;
  dbg_upd(slot, bf2f(YY[((size_t)dir * NT + row0) * 512 + h * 64 + tid]), y0, fabsf(y0) + 0.05f);
  dbg_upd(slot, bf2f(YY[((size_t)dir * NT + row1) * 512 + h * 64 + tid]), y1, fabsf(y1) + 0.05f);
  float bq = a.r * a.kd * w.rk[h * 64 + tid];
  __syncthreads(); red[tid] = bq; __syncthreads(); float bs = 0.f;
#pragma unroll 1
  for (int j = 0; j < 64; ++j) bs += red[j];
  dbg_upd(slot, BON[((size_t)dir * NT + row0) * 8 + h], bs, fabsf(bs) + 0.05f);
}
DI void chk_post(const u16* PA, const u16* PB, const u16* VV, const u16* YY, const float* BON, const float* mu, const float* gup, const float* gng, const float* gnb, float* slot) {
  const int gt = blockIdx.x * NTHREADS + threadIdx.x;
  if (gt >= 2048) return;
  const size_t row = hashu(gt * 2 + 21) % NT; const int c = hashu(gt * 2 + 22) % 512, h = c >> 6;
  float sm = 0.f;
  float yc = 0.f;
  for (int i = 0; i < 64; ++i) { const float y = bf2f(YY[row * 512 + h * 64 + i]) + bf2f(YY[((size_t)NT + row) * 512 + h * 64 + i]); sm += y; if (h * 64 + i == c) yc = y; }
  const float mean = sm / 64.f; float vq = 0.f;
  for (int i = 0; i < 64; ++i) { const float y = bf2f(YY[row * 512 + h * 64 + i]) + bf2f(YY[((size_t)NT + row) * 512 + h * 64 + i]) - mean; vq += y * y; }
  const float yn = (yc - mean) * rsqrtf(vq / 64.f + GN_EPS) * gng[c] + gnb[c];
  const float bon = (BON[row * 8 + h] + BON[((size_t)NT + row) * 8 + h]) * bf2f(VV[row * 512 + c]);
  float g = 0.f;
  for (int r = 0; r < 96; ++r) g += (1.f / (1.f + expf(-tshift(PA, row, OFF_GD + r, mu)))) * gup[r * 512 + c];
  const float ref = (yn + bon) * g;
  dbg_upd(slot, bf2f(PA[row * A_COLS + c]), ref, fabsf(ref) + 0.05f);
  dbg_upd(slot + 1, bf2f(PA[row * A_COLS + 512 + c]), bf2f(PB[row * 1024 + c]), 1.f);
}

__global__ __launch_bounds__(NTHREADS, 2) void mega(Params p_unused) {
  extern __shared__ __attribute__((aligned(16))) char shm[];
  cg::grid_group grid = cg::this_grid();
  LAS unsigned char* lds = (LAS unsigned char*)shm;
#define WS_PTRS CParams p = get_params(); unsigned char* ws = p->ws; \
  u16* WIN = (u16*)(ws + OFF_WIN); u16* WOUT = (u16*)(ws + OFF_WOUT); u16* WUP = (u16*)(ws + OFF_WUP); u16* WDN = (u16*)(ws + OFF_WDN); \
  u16* XB = (u16*)(ws + OFF_XB); u16* PA = (u16*)(ws + OFF_PA); u16* PB = (u16*)(ws + OFF_PB); u16* VT = (u16*)(ws + OFF_VT); \
  u16* G = (u16*)(ws + OFF_PA); u16* VV = (u16*)(ws + OFF_VV); u16* YY = (u16*)p->out; float* BON = (float*)(ws + OFF_BON); float* XF = p->out; \
  (void)WIN; (void)WOUT; (void)WUP; (void)WDN; (void)XB; (void)PA; (void)PB; (void)VT; (void)G; (void)VV; (void)YY; (void)BON; (void)XF;
  int ph = 0;
  const int ph_lo = get_params()->ph_lo, ph_hi = get_params()->ph_hi;
#ifndef ONLYMASK
#define ONLYMASK 0xffffffffu
#endif
#define PHASE_BEGIN if (((ONLYMASK >> (__COUNTER__ % 32)) & 1u) && ph >= ph_lo && ph < ph_hi) { WS_PTRS
#define PHASE_END } ++ph; if (ph > ph_lo && ph < ph_hi) grid.sync();

  PHASE_BEGIN
    for (int l = 0; l < 2; ++l) {
      convert_weight<0>(shm, p->in[4] + (size_t)l * D * P_COLS, WIN + (size_t)l * NPROJ * D, D, P_COLS, NPROJ, blockIdx.x, gridDim.x);
      convert_weight<1>(shm, p->in[22] + (size_t)l * D * D, WOUT + (size_t)l * D * D, D, D, D, blockIdx.x, gridDim.x);
      convert_weight<2>(shm, p->in[25] + (size_t)l * D * NUP, WUP + (size_t)l * NUP * D, D, NUP, NUP, blockIdx.x, gridDim.x);
      convert_weight<1>(shm, p->in[28] + (size_t)l * DFF * D, WDN + (size_t)l * D * DFF, DFF, D, D, blockIdx.x, gridDim.x);
    }
    ln_rows(p->in[0], p->in[1], NPROMPT_TOK, XF, XB, p->in[2], p->in[3], false, true);
  PHASE_END

#pragma unroll 1
  for (int l = 0; l < 2; ++l) {
    PHASE_BEGIN
      Gemm ga{XB, D, WIN + (size_t)l * NPROJ * D, D};
      EpiArgs ea{}; ea.pa = PA; ea.pb = PB; ea.vt = VT;
      gemm_phase<0, 0>(lds, ga, NT / 256, NPROJ / 256, ea);
#if PROBE_GEMM
      gemm_phase<0, 0>(lds, ga, NT / 256, NPROJ / 256, ea);
#endif
    PHASE_END
#pragma unroll 1
    for (int rnd = 0; rnd < 2; ++rnd) {
      if (ph >= ph_lo && ph < ph_hi) { WS_PTRS
        int bidu = blockIdx.x, gdu = gridDim.x; asm volatile("" : "+s"(bidu), "+s"(gdu));
        const bool split = (gdu == 256);
        if (rnd == 0) vprep_phase(lds, PA, VV, p->in[5] + (size_t)l * 2 * A_COLS, p->in[16], p->in[17], p->in[18], l);
        if (rnd == 1 && (!split || bidu < 192)) {
          ScanW sw; sw.mu = p->in[5] + (size_t)l * 2 * A_COLS; sw.w0 = p->in[6] + l * 1024; sw.du = p->in[7] + (size_t)l * 2 * 32 * 512; sw.a0 = p->in[8] + l * 1024;
          sw.iu = p->in[9] + (size_t)l * 2 * 32 * 512; sw.kk_ = p->in[11] + l * 512; sw.ka = p->in[12] + l * 512; sw.rk = p->in[13] + l * 512;
          scan_phase(lds, PA, VV, YY, BON, sw);
        } else if (rnd == 0 || split) {
          const int plo = rnd == 0 ? 0 : 40, phi = (rnd == 0 && split) ? 40 : 48;
          const int wlo = rnd == 0 ? 0 : 192, wcnt = rnd == 0 ? (gdu & ~7) : 64;
          attn_phase(lds, PB, VT, (float*)(ws + OFF_OSV), p->in[19] + l * 256, p->in[20] + l * 128, p->in[21], l, plo, phi, wlo, wcnt);
        }
      }
      ++ph; if (ph > ph_lo && ph < ph_hi) grid.sync();
    }
    PHASE_BEGIN
      post_phase(lds, PA, PB, VV, YY, BON, p->in[5] + (size_t)l * 2 * A_COLS, p->in[10] + (size_t)l * 96 * 512, p->in[14] + l * 512, p->in[15] + l * 512);
#if PROBE_MISC
      post_phase(lds, PA, PB, VV, YY, BON, p->in[5] + (size_t)l * 2 * A_COLS, p->in[10] + (size_t)l * 96 * 512, p->in[14] + l * 512, p->in[15] + l * 512);
#endif
    PHASE_END
    PHASE_BEGIN
      Gemm ga{PA, A_COLS, WOUT + (size_t)l * D * D, D};
      EpiArgs ea{}; ea.xf = XF; ea.xb = XB;
      gemm_phase<1, 0>(lds, ga, NT / 256, D / 256, ea);
    PHASE_END
    PHASE_BEGIN
      ln_rows_bf16(XB, p->in[23] + l * D, p->in[24] + l * D);
    PHASE_END
    PHASE_BEGIN
      Gemm ga{XB, D, WUP + (size_t)l * NUP * D, D};
      EpiArgs ea{}; ea.g = G; ea.cw = p->in[26] + (size_t)l * 3 * NUP; ea.cb = p->in[27] + (size_t)l * NUP;
      gemm_phase<2, 1>(lds, ga, NSEQ * 33, NUP / 256, ea);
#if PROBE_GEMM
      gemm_phase<2, 1>(lds, ga, NSEQ * 33, NUP / 256, ea);
#endif
    PHASE_END
    PHASE_BEGIN
      Gemm ga{G, DFF, WDN + (size_t)l * D * DFF, DFF};
      EpiArgs ea{}; ea.xf = XF; ea.xb = XB; ea.pre_f32 = (l == 1) ? 1 : 0;
      gemm_phase<1, 0>(lds, ga, NT / 256, D / 256, ea);
    PHASE_END
    PHASE_BEGIN
      if (l == 1) ln_rows(XF, XF, NT, XF, XB, p->in[29] + l * D, p->in[30] + l * D, true, false);
      else ln_rows_bf16(XB, p->in[29] + l * D, p->in[30] + l * D);
    PHASE_END
  }
}

#if DBG
#define DPTRS unsigned char* ws = p.ws; u16* XB = (u16*)(ws + OFF_XB); u16* PA = (u16*)(ws + OFF_PA); u16* PB = (u16*)(ws + OFF_PB); u16* VT = (u16*)(ws + OFF_VT); \
  u16* G = (u16*)(ws + OFF_PA); u16* VV = (u16*)(ws + OFF_VV); u16* YY = (u16*)(ws + OFF_XB); float* BON = (float*)(ws + OFF_BON); float* DE = (float*)(ws + OFF_DBG); \
  (void)XB; (void)PA; (void)PB; (void)VT; (void)G; (void)VV; (void)YY; (void)BON; (void)DE;
template <int which> __global__ __launch_bounds__(NTHREADS) void k_chk(Params p, int l) {
  extern __shared__ __attribute__((aligned(16))) char shm[];
  LAS unsigned char* lds = (LAS unsigned char*)shm;
  DPTRS
  if (which == 0) chk_proj(XB, p.in[4] + (size_t)l * D * P_COLS, PA, PB, VT, DE + 0);
  else if (which == 1) chk_attn(lds, XB, p.in[4] + (size_t)l * D * P_COLS, PB, VT, p.in[19] + l * 256, p.in[20] + l * 128, p.in[21], l, DE + 1);
  else if (which == 2) {
    ScanW sw; sw.mu = p.in[5] + (size_t)l * 2 * A_COLS; sw.w0 = p.in[6] + l * 1024; sw.du = p.in[7] + (size_t)l * 2 * 32 * 512; sw.a0 = p.in[8] + l * 1024;
    sw.iu = p.in[9] + (size_t)l * 2 * 32 * 512; sw.kk_ = p.in[11] + l * 512; sw.ka = p.in[12] + l * 512; sw.rk = p.in[13] + l * 512;
    chk_scan(lds, PA, VV, YY, BON, sw, DE + 2);
  } else if (which == 3) chk_post(PA, PB, VV, YY, BON, p.in[5] + (size_t)l * 2 * A_COLS, p.in[10] + (size_t)l * 96 * 512, p.in[14] + l * 512, p.in[15] + l * 512, DE + 3);
  else if (which == 5) chk_ffn(XB, p.in[25] + (size_t)l * D * NUP, p.in[26] + (size_t)l * 3 * NUP, p.in[27] + (size_t)l * NUP, G, DE + 5);
}
__global__ __launch_bounds__(NTHREADS) void k_encode(Params p) {
  const float* e = (const float*)(p.ws + OFF_DBG);
  const float eA = fmaxf(e[DBG_A], 1e-4f), eB = fmaxf(e[DBG_B], 1e-4f);
  const float V1 = 100.f + 100.f * log10f(eA / 1e-3f);
  float V2 = 1.f + log10f(eB / 1e-3f); V2 = fminf(fmaxf(V2, 0.3f), 8.f);
  const size_t n0 = (size_t)NPROMPT_TOK * D, n1 = (size_t)NT * D;
  for (size_t i = (size_t)blockIdx.x * NTHREADS + threadIdx.x; i < n1; i += (size_t)gridDim.x * NTHREADS) {
    float v = 0.f;
    if (i == 0 || i == n0) v = V1;
    else if (i < n0 / 2 || (i > n0 && i < n0 + (n1 - n0) / 2)) v = V2;
    p.out[i] = v;
  }
}
#endif

extern "C" void kernel_launch(void* const* d_in, const int* in_sizes, int n_in, void* d_out, int out_size, void* d_ws, size_t ws_size, hipStream_t stream) {
  static int grid = 0;
  if (grid == 0) {
    if (ws_size < WS_END) { fprintf(stderr, "ws too small: %zu < %zu\n", ws_size, (size_t)WS_END); grid = -1; return; }
    int dev = 0, cus = 0, per_cu = 0;
    hipGetDevice(&dev);
    hipDeviceGetAttribute(&cus, hipDeviceAttributeMultiprocessorCount, dev);
    hipFuncSetAttribute((const void*)mega, hipFuncAttributeMaxDynamicSharedMemorySize, LDS_BYTES);
#if DBG
    hipFuncSetAttribute((const void*)k_chk<1>, hipFuncAttributeMaxDynamicSharedMemorySize, 81920);
    hipFuncSetAttribute((const void*)k_chk<2>, hipFuncAttributeMaxDynamicSharedMemorySize, 81920);
#endif
    hipOccupancyMaxActiveBlocksPerMultiprocessor(&per_cu, (const void*)mega, NTHREADS, LDS_BYTES);
    if (per_cu < 1) per_cu = 1;
    grid = cus * 1;
  }
  if (grid < 0) return;
  Params p{};
  for (int i = 0; i < 31; ++i) p.in[i] = (const float*)d_in[i];
  p.out = (float*)d_out; p.ws = (unsigned char*)d_ws;
#if DBG
  hipMemsetAsync((char*)d_ws + OFF_DBG, 0, 256, stream);
  auto seg = [&](int lo, int hi) { Params q = p; q.ph_lo = lo; q.ph_hi = hi; void* a2[] = {&q};
    hipError_t e = hipLaunchCooperativeKernel((const void*)mega, dim3(grid), dim3(NTHREADS), a2, LDS_BYTES, stream);
    if (e != hipSuccess) fprintf(stderr, "cooperative launch failed: %s\n", hipGetErrorString(e)); };
  auto chk = [&](int l, int which) {
    if (which == 0) hipLaunchKernelGGL(k_chk<0>, dim3(64), dim3(NTHREADS), 81920, stream, p, l);
    if (which == 1) hipLaunchKernelGGL(k_chk<1>, dim3(64), dim3(NTHREADS), 81920, stream, p, l);
    if (which == 2) hipLaunchKernelGGL(k_chk<2>, dim3(64), dim3(NTHREADS), 81920, stream, p, l);
    if (which == 3) hipLaunchKernelGGL(k_chk<3>, dim3(64), dim3(NTHREADS), 81920, stream, p, l);
    if (which == 5) hipLaunchKernelGGL(k_chk<5>, dim3(64), dim3(NTHREADS), 81920, stream, p, l); };
  seg(0, 1);
  for (int l = 0; l < 2; ++l) {
    const int b = 1 + 9 * l;
    seg(b, b + 1); chk(l, 0);
    seg(b + 1, b + 2); chk(l, 1);
    seg(b + 2, b + 3); chk(l, 2);
    seg(b + 3, b + 4); chk(l, 3);
    seg(b + 4, b + 7); if (l == 0) chk(l, 5);
    seg(b + 7, b + 9);
  }
  hipLaunchKernelGGL(k_encode, dim3(1024), dim3(NTHREADS), 0, stream, p);
#else
  p.ph_lo = 0; p.ph_hi = 1000;
  void* args[] = {&p};
  hipError_t e = hipLaunchCooperativeKernel((const void*)mega, dim3(grid), dim3(NTHREADS), args, LDS_BYTES, stream);
  if (e != hipSuccess) fprintf(stderr, "cooperative launch failed: %s (grid %d)\n", hipGetErrorString(e), grid);
#endif
}
```

```cpp
#include <hip/hip_runtime.h>
#include <hip/hip_bf16.h>
#include <hip/hip_cooperative_groups.h>
#include <cstdio>
namespace cg = cooperative_groups;

#define DI __device__ __forceinline__
using bf16 = __hip_bfloat16;
using bf16x8 = __attribute__((ext_vector_type(8))) short;
using s16x4 = __attribute__((ext_vector_type(4))) short;
using f32x4 = __attribute__((ext_vector_type(4))) float;
using f32x16 = __attribute__((ext_vector_type(16))) float;
typedef unsigned short u16;
typedef __bf16 bf2 __attribute__((ext_vector_type(2)));
typedef unsigned u32x4 __attribute__((ext_vector_type(4)));
typedef unsigned u32x2 __attribute__((ext_vector_type(2)));

constexpr int D = 1024, T = 8192, NSEQ = 12, NT = NSEQ * T;
constexpr int NPROMPT_TOK = 4 * T;
constexpr int A_COLS = 1760, P_COLS = 3296, NPROJ = 3328;
constexpr int DFF = 2816, NUP = 5632;
constexpr int OFF_K = 512, OFF_V = 1024, OFF_WD = 1536, OFF_AD = 1600, OFF_GD = 1664;
constexpr float ALPHA = 1.4142135623730951f;
constexpr float LN_EPS = 1e-5f, GN_EPS = 64e-5f;
constexpr int NTHREADS = 512;
#ifndef DBGZ
#define DBGZ 0
#define DBG 0
#define PROBE_SCAN 0
#define PROBE_GEMM 0
#define PROBE_MISC 0
#ifndef CHK_PROJ_ON
#define CHK_PROJ_ON 1
#endif
#ifndef CHK_ATTN_ON
#define CHK_ATTN_ON 1
#endif
#ifndef CHK_SCAN_ON
#define CHK_SCAN_ON 1
#endif
#ifndef CHK_POST_ON
#define CHK_POST_ON 1
#endif
#ifndef CHK_FFN_ON
#define CHK_FFN_ON 1
#endif
#define DBG_A 5
#define DBG_B 6
#define DBGTHR 0.05f, 0.1f, 0.1f, 0.1f, 0.01f, 0.05f
#endif
constexpr int LDS_BYTES = 163840;

constexpr size_t SZ_WIN = (size_t)2 * NPROJ * D * 2;
constexpr size_t SZ_WOUT = (size_t)2 * D * D * 2;
constexpr size_t SZ_WUP = (size_t)2 * NUP * D * 2;
constexpr size_t SZ_WDN = (size_t)2 * D * DFF * 2;
constexpr size_t OFF_WIN = 0;
constexpr size_t OFF_WOUT = OFF_WIN + SZ_WIN;
constexpr size_t OFF_WUP = OFF_WOUT + SZ_WOUT;
constexpr size_t OFF_WDN = OFF_WUP + SZ_WUP;
constexpr size_t OFF_XB = OFF_WDN + SZ_WDN;
constexpr size_t OFF_PA = OFF_XB + (size_t)NT * D * 2;
constexpr size_t OFF_PB = OFF_PA + (size_t)NT * A_COLS * 2;
constexpr size_t OFF_VT = OFF_PB + (size_t)NT * 1024 * 2;
constexpr size_t OFF_VV = OFF_VT + (size_t)NT * 512 * 2;
constexpr size_t OFF_BON = OFF_VV + (size_t)NT * 512 * 2;
constexpr size_t OFF_OSV = OFF_BON + (size_t)2 * NT * 8 * 4;
constexpr size_t OFF_DBG = OFF_OSV + (size_t)256 * 64 * 512 * 4;
constexpr size_t OFF_XBAR = OFF_DBG + 256;
constexpr size_t XBAR_BYTES = 3456 * 4 + 256 * 8;
constexpr size_t WS_END = OFF_XBAR + XBAR_BYTES;
static_assert((size_t)NT * DFF * 2 <= (OFF_VV - OFF_PA), "G alias");

struct Params {
  const float* in[31];
  float* out;
  unsigned char* ws;
  int ph_lo, ph_hi;
};

typedef const __attribute__((address_space(4))) Params* CParams;
DI CParams get_params() { CParams pp = (CParams)__builtin_amdgcn_kernarg_segment_ptr(); asm volatile("" : "+s"(pp)); return pp; }

DI u16 f2bf(float x) { unsigned u = __float_as_uint(x); u += 0x7fffu + ((u >> 16) & 1u); return (u16)(u >> 16); }
DI unsigned cvt_pk_bf16(float lo, float hi) { unsigned r; asm volatile("v_cvt_pk_bf16_f32 %0, %1, %2" : "=v"(r) : "v"(lo), "v"(hi)); return r; }
DI float bf2f(u16 b) { return __uint_as_float(((unsigned)b) << 16); }
DI float sigmoidf_(float x) { return 1.f / (1.f + __expf(-x)); }

template <int MODE> DI int src_col(int n) {
  if (MODE == 0) { return n < A_COLS ? n : (n < 1792 ? -1 : n - 32); }
  if (MODE == 2) { int j = n >> 8, i = n & 255; return i < 128 ? j * 128 + i : DFF + j * 128 + (i - 128); }
  return n;
}
template <int MODE>
DI void convert_weight(char* shm, const float* W, u16* WT, int K, int Nsrc, int Ndst, int gtid_block, int nblocks) {
  float* tile = (float*)shm;
  int tn = Ndst / 64, tk = K / 64;
  for (int t = gtid_block; t < tn * tk; t += nblocks) {
    int n0 = (t / tk) * 64, k0 = (t % tk) * 64;
    __syncthreads();
    for (int e = threadIdx.x; e < 4096; e += NTHREADS) {
      int kk = e >> 6, nn = e & 63;
      int sc = src_col<MODE>(n0 + nn);
      tile[kk * 65 + nn] = sc >= 0 ? W[(size_t)(k0 + kk) * Nsrc + sc] : 0.f;
    }
    __syncthreads();
    for (int e = threadIdx.x; e < 4096; e += NTHREADS) {
      int nn = e >> 6, kk = e & 63;
      WT[(size_t)(n0 + nn) * K + k0 + kk] = f2bf(tile[kk * 65 + nn]);
    }
  }
}

constexpr int LNR = 4;
DI void ln_rows(const float* srcA, const float* srcB, int splitRow, float* dstF, u16* dstB, const float* g, const float* b, bool writeF, bool writeB) {
  int tid = threadIdx.x; asm volatile("" : "+v"(tid));
  int bid = blockIdx.x, gdim = gridDim.x; asm volatile("" : "+s"(bid), "+s"(gdim));
  int wave = tid >> 6, lane = tid & 63;
  int gw = bid * 8 + wave, nw = gdim * 8;
  for (int base = gw * LNR; base < NT; base += nw * LNR) {
    f32x4 v[LNR][4]; float s[LNR], q[LNR];
#pragma unroll
    for (int r = 0; r < LNR; ++r) {
      const int row = base + r;
      const float* src = row < splitRow ? srcA + (size_t)row * D : srcB + (size_t)(row - splitRow) * D;
#pragma unroll
      for (int i = 0; i < 4; ++i) v[r][i] = *(const f32x4*)(src + i * 256 + lane * 4);
    }
#pragma unroll
    for (int r = 0; r < LNR; ++r) { s[r] = 0.f;
#pragma unroll
      for (int i = 0; i < 4; ++i) s[r] += (v[r][i][0] + v[r][i][1]) + (v[r][i][2] + v[r][i][3]); }
#pragma unroll
    for (int o = 32; o > 0; o >>= 1)
#pragma unroll
      for (int r = 0; r < LNR; ++r) s[r] += __shfl_xor(s[r], o);
#pragma unroll
    for (int r = 0; r < LNR; ++r) { const float mu = s[r] * (1.f / D); q[r] = 0.f;
#pragma unroll
      for (int i = 0; i < 4; ++i) { v[r][i] -= mu; const f32x4 t = v[r][i] * v[r][i]; q[r] += (t[0] + t[1]) + (t[2] + t[3]); } }
#pragma unroll
    for (int o = 32; o > 0; o >>= 1)
#pragma unroll
      for (int r = 0; r < LNR; ++r) q[r] += __shfl_xor(q[r], o);
#pragma unroll
    for (int i = 0; i < 4; ++i) {
      const f32x4 gg = *(const f32x4*)(g + i * 256 + lane * 4), bb = *(const f32x4*)(b + i * 256 + lane * 4);
#pragma unroll
      for (int r = 0; r < LNR; ++r) {
        const int row = base + r;
        const float rs = rsqrtf(q[r] * (1.f / D) + LN_EPS);
        const f32x4 o4 = v[r][i] * rs * gg + bb;
        if (writeF) *(f32x4*)(dstF + (size_t)row * D + i * 256 + lane * 4) = o4;
        if (writeB) { u32x2 h; h.x = cvt_pk_bf16(o4[0], o4[1]); h.y = cvt_pk_bf16(o4[2], o4[3]);
          *(u32x2*)(dstB + (size_t)row * D + i * 256 + lane * 4) = h; }
      }
    }
  }
}

DI void ln_rows_bf16(u16* xb, const float* g, const float* b) {
  int tid = threadIdx.x; asm volatile("" : "+v"(tid));
  int bid = blockIdx.x, gdim = gridDim.x; asm volatile("" : "+s"(bid), "+s"(gdim));
  int wave = tid >> 6, lane = tid & 63;
  int gw = bid * 8 + wave, nw = gdim * 8;
  for (int base = gw * LNR; base < NT; base += nw * LNR) {
    f32x4 v[LNR][4]; float s[LNR], q[LNR];
#pragma unroll
    for (int r = 0; r < LNR; ++r) {
      const u16* src = xb + (size_t)(base + r) * D;
#pragma unroll
      for (int i = 0; i < 4; ++i) { const u32x2 x2 = *(const u32x2*)(src + i * 256 + lane * 4);
        v[r][i][0] = __uint_as_float(x2.x << 16); v[r][i][1] = __uint_as_float(x2.x & 0xffff0000u); v[r][i][2] = __uint_as_float(x2.y << 16); v[r][i][3] = __uint_as_float(x2.y & 0xffff0000u); }
    }
#pragma unroll
    for (int r = 0; r < LNR; ++r) { s[r] = 0.f;
#pragma unroll
      for (int i = 0; i < 4; ++i) s[r] += (v[r][i][0] + v[r][i][1]) + (v[r][i][2] + v[r][i][3]); }
#pragma unroll
    for (int o = 32; o > 0; o >>= 1)
#pragma unroll
      for (int r = 0; r < LNR; ++r) s[r] += __shfl_xor(s[r], o);
#pragma unroll
    for (int r = 0; r < LNR; ++r) { const float mu = s[r] * (1.f / D); q[r] = 0.f;
#pragma unroll
      for (int i = 0; i < 4; ++i) { v[r][i] -= mu; const f32x4 t = v[r][i] * v[r][i]; q[r] += (t[0] + t[1]) + (t[2] + t[3]); } }
#pragma unroll
    for (int o = 32; o > 0; o >>= 1)
#pragma unroll
      for (int r = 0; r < LNR; ++r) q[r] += __shfl_xor(q[r], o);
#pragma unroll
    for (int i = 0; i < 4; ++i) {
      const f32x4 gg = *(const f32x4*)(g + i * 256 + lane * 4), bb = *(const f32x4*)(b + i * 256 + lane * 4);
#pragma unroll
      for (int r = 0; r < LNR; ++r) {
        const float rs = rsqrtf(q[r] * (1.f / D) + LN_EPS);
        const f32x4 o4 = v[r][i] * rs * gg + bb;
        u32x2 h; h.x = cvt_pk_bf16(o4[0], o4[1]); h.y = cvt_pk_bf16(o4[2], o4[3]);
        *(u32x2*)(xb + (size_t)(base + r) * D + i * 256 + lane * 4) = h;
      }
    }
  }
}

#define LAS __attribute__((address_space(3)))
constexpr int BK = 64, HALF = 128, HTB = HALF * BK * 2, STAGE_BYTES = 8 * HTB;
DI int lds_byte(int r, int c) { const int st = (r >> 4) * 2 + (c >> 5), rr = r & 15, cc = c & 31, ob = rr * 64 + cc * 2; return st * 1024 + (ob ^ (((ob >> 9) & 1) << 5)); }
DI void stage_rc(int b, int& R, int& C) { const int st = b / 1024, sb = b % 1024, swz = sb ^ (((sb >> 9) & 1) << 5); R = (st >> 1) * 16 + swz / 64; C = (st & 1) * 32 + (swz % 64) / 2; }
DI int perm32(int rho) { const int n = rho >> 4, i = rho & 15; return 8 * (i >> 2) + 4 * n + (i & 3); }

typedef float f32x2 __attribute__((ext_vector_type(2)));
DI float gelu1(float v) {
  const float av = __builtin_fabsf(v), d = av * 0.2316418882f + 1.0f;
  const float t = __builtin_amdgcn_rcpf(d);
  float q = t * 0.5307027145f + (-0.7265760135f); q = q * t + 0.7107068705f; q = q * t + (-0.142248368f); q = q * t + 0.127414796f; q = q * t;
  const float e = __builtin_amdgcn_exp2f((v * v) * (-0.72134752044f));
  const float m = v * (q * e), r = v - m;
  return v < 0.f ? m : r;
}
DI float dpp_shr1(float old, float src) { asm volatile("s_nop 1\n\tv_mov_b32_dpp %0, %1 row_shr:1 row_mask:0xf bank_mask:0xf\n\ts_nop 0" : "+v"(old) : "v"(src)); return old; }
DI float dpp_shl1(float old, float src) { asm volatile("s_nop 1\n\tv_mov_b32_dpp %0, %1 row_shl:1 row_mask:0xf bank_mask:0xf\n\ts_nop 0" : "+v"(old) : "v"(src)); return old; }
struct Unit { int pm, pn; };
struct Order {
  int nM, nN, nwg, G, c;
  DI void init(int nM_, int nN_, int G_, int c_) { nM = nM_; nN = nN_; nwg = nM * nN; G = G_; c = c_; }
  DI bool next(int i, Unit& u) const {
    const long Lq = (long)i * G + c; if (Lq >= nwg) return false;
    int wgid = (int)Lq; { const int q = nwg / 8, r = nwg % 8, xcd = wgid % 8, off = wgid / 8; wgid = (xcd < r ? xcd * (q + 1) : r * (q + 1) + (xcd - r) * q) + off; }
    const int nig = 8 * nN, gid = wgid / nig, fm = gid * 8, gsz = (nM - fm) < 8 ? (nM - fm) : 8;
    u.pm = fm + ((wgid % nig) % gsz); u.pn = (wgid % nig) / gsz; return true;
  }
};
struct Gemm { const u16* A; int lda; const u16* Bt; int K; };
template <int ROWMODE> DI const char* a_tile_ptr(const Gemm& g, int pm) {
  long row = ROWMODE == 0 ? (long)pm * 256 : (long)(pm / 33) * T + 254 * (pm % 33) - 1;
  return (const char*)g.A + row * g.lda * 2;
}
struct EpiArgs {
  u16* pa; u16* pb; u16* vt;
  float* xf; u16* xb;
  u16* g; const float* cw; const float* cb;
  int zero; int pre_f32;
};
template <int EPI>
DI void epilogue(f32x4 (&acc)[2][2][4][2], const Unit& u, const EpiArgs& ea, LAS unsigned char* lds) {
  int tid2 = threadIdx.x; asm volatile("" : "+v"(tid2));
  const int wid2 = tid2 >> 6, lane2 = tid2 & 63, wr = wid2 >> 2, wc = wid2 & 3, fr = lane2 & 15, fq = lane2 >> 4;
  if (EPI == 0) {
    const int row0 = u.pm * 256 + wr * 64 + fr;
#pragma unroll
    for (int ai = 0; ai < 2; ++ai)
#pragma unroll
      for (int m = 0; m < 4; ++m) {
        const int row = row0 + ai * HALF + m * 16;
#pragma unroll
        for (int bj = 0; bj < 2; ++bj) {
          const int col = u.pn * 256 + bj * HALF + wc * 32 + 8 * fq;
          const f32x4 a0 = acc[ai][bj][m][0], a1 = acc[ai][bj][m][1];
          if (u.pn <= 10) {
            uint4 pk; pk.x = cvt_pk_bf16(a0[0], a0[1]); pk.y = cvt_pk_bf16(a0[2], a0[3]); pk.z = cvt_pk_bf16(a1[0], a1[1]); pk.w = cvt_pk_bf16(a1[2], a1[3]);
            if (u.pn <= 6) { if (col < A_COLS) *(uint4*)(ea.pa + (size_t)row * A_COLS + col) = pk; }
            else *(uint4*)(ea.pb + (size_t)row * 1024 + (col - 1792)) = pk;
          } else {
            const int c2 = col - 2816, h = c2 >> 7, e = c2 & 127, seq = row / T, t = row % T;
            u16* dst = ea.vt + ((size_t)((seq * 4 + h) * 128 + e)) * T + t;
#pragma unroll
            for (int j = 0; j < 4; ++j) { dst[(size_t)j * T] = f2bf(a0[j]); dst[(size_t)(4 + j) * T] = f2bf(a1[j]); }
          }
        }
      }
  } else if (EPI == 1) {
    const int row0 = u.pm * 256 + wr * 64 + fr, col0 = u.pn * 256 + wc * 32 + 4 * fq;
#pragma unroll
    for (int ai = 0; ai < 2; ++ai)
#pragma unroll
      for (int m = 0; m < 4; ++m) {
        float* rowp = ea.xf + (size_t)(row0 + ai * HALF + m * 16) * D + col0;
        u16* rowb = ea.xb + (size_t)(row0 + ai * HALF + m * 16) * D + col0;
#pragma unroll
        for (int bj = 0; bj < 2; ++bj)
#pragma unroll
          for (int n = 0; n < 2; ++n) { f32x4* p4 = (f32x4*)(rowp + bj * HALF + n * 16); const u32x2 xr = *(const u32x2*)(rowb + bj * HALF + n * 16);
            f32x4 x; x[0] = __uint_as_float(xr.x << 16); x[1] = __uint_as_float(xr.x & 0xffff0000u); x[2] = __uint_as_float(xr.y << 16); x[3] = __uint_as_float(xr.y & 0xffff0000u);
            const f32x4 pre = x * ALPHA + acc[ai][bj][m][n];
            if (ea.pre_f32) *p4 = pre;
            else { u32x2 hq; hq.x = cvt_pk_bf16(pre[0], pre[1]); hq.y = cvt_pk_bf16(pre[2], pre[3]); *(u32x2*)(rowb + bj * HALF + n * 16) = hq; } }
      }
  } else {
    LAS float* E = (LAS float*)(lds + STAGE_BYTES);
    const int seq = u.pm / 33, ti = u.pm % 33;
    const int cl0 = wc * 32 + 8 * fq;
#pragma unroll
    for (int ai = 0; ai < 2; ++ai)
#pragma unroll
      for (int m = 0; m < 4; ++m) {
        const int rl = ai * HALF + wr * 64 + m * 16 + fr;
        const int tok = 254 * ti - 1 + rl;
        const bool valid = tok >= 0 && tok < T;
        const int blk = ai * 8 + wr * 4 + m;
#pragma unroll
        for (int bj = 0; bj < 2; ++bj)
#pragma unroll
          for (int n = 0; n < 2; ++n) {
            if (!valid) acc[ai][bj][m][n] = (f32x4){0.f, 0.f, 0.f, 0.f};
            if (fr == 0) *(LAS f32x4*)(E + ((blk * 2 + 0) * 2 + bj) * 128 + cl0 + 4 * n) = acc[ai][bj][m][n];
            if (fr == 15) *(LAS f32x4*)(E + ((blk * 2 + 1) * 2 + bj) * 128 + cl0 + 4 * n) = acc[ai][bj][m][n];
          }
      }
    asm volatile("s_waitcnt lgkmcnt(0)" ::: "memory");
    __builtin_amdgcn_s_barrier(); asm volatile("" ::: "memory");
    __builtin_amdgcn_s_barrier(); asm volatile("" ::: "memory");
#pragma unroll
    for (int n = 0; n < 2; ++n) {
      const int hid = u.pn * 128 + cl0 + 4 * n;
      const float* cwp = ea.cw + hid;
      const f32x4 g0 = *(const f32x4*)(cwp), g1 = *(const f32x4*)(cwp + NUP), g2 = *(const f32x4*)(cwp + 2 * NUP), gb = *(const f32x4*)(ea.cb + hid);
      const f32x4 u0 = *(const f32x4*)(cwp + DFF), u1 = *(const f32x4*)(cwp + DFF + NUP), u2 = *(const f32x4*)(cwp + DFF + 2 * NUP), ub = *(const f32x4*)(ea.cb + DFF + hid);
#pragma unroll
      for (int ai = 0; ai < 2; ++ai)
#pragma unroll
        for (int m = 0; m < 4; ++m) {
          const int blk = ai * 8 + wr * 4 + m;
          const int rl = ai * HALF + wr * 64 + m * 16 + fr;
          const int tok = 254 * ti - 1 + rl;
          f32x4 hh[2];
#pragma unroll
          for (int bj = 0; bj < 2; ++bj) {
            const f32x4 cur = acc[ai][bj][m][n];
            f32x4 ab = (f32x4){0.f, 0.f, 0.f, 0.f}, be = (f32x4){0.f, 0.f, 0.f, 0.f};
            if (fr == 0 && blk > 0) ab = *(LAS f32x4*)(E + (((blk - 1) * 2 + 1) * 2 + bj) * 128 + cl0 + 4 * n);
            if (fr == 15 && blk < 15) be = *(LAS f32x4*)(E + (((blk + 1) * 2 + 0) * 2 + bj) * 128 + cl0 + 4 * n);
            f32x4 prev, next;
#pragma unroll
            for (int j = 0; j < 4; ++j) { prev[j] = dpp_shr1(ab[j], cur[j]); next[j] = dpp_shl1(be[j], cur[j]); }
            hh[bj] = bj == 0 ? g0 * prev + g1 * cur + g2 * next + gb : u0 * prev + u1 * cur + u2 * next + ub;
          }
          f32x4 res;
#pragma unroll
          for (int j = 0; j < 4; ++j) res[j] = gelu1(hh[0][j]) * hh[1][j];
          if (rl >= 1 && rl <= 254 && tok < T) {
            u32x2 pk; pk.x = cvt_pk_bf16(res[0], res[1]); pk.y = cvt_pk_bf16(res[2], res[3]);
            *(u32x2*)(ea.g + (size_t)(seq * T + tok) * DFF + hid) = pk;
          }
        }
    }
  }
}

template <int EPI, int ROWMODE>
DI void gemm_phase(LAS unsigned char* lds, const Gemm g, int nM, int nN, const EpiArgs& ea) {
  constexpr bool PERM = (EPI != 1);
  int tid = threadIdx.x; asm volatile("" : "+v"(tid));
  int bid = blockIdx.x, gdim = gridDim.x; asm volatile("" : "+s"(bid), "+s"(gdim));
  const int wid = __builtin_amdgcn_readfirstlane(tid >> 6), lane = tid & 63, wr = wid >> 2, wc = wid & 3, fr = lane & 15, fq = lane >> 4;
  const int K = g.K, nt = K / BK;
  Order S; S.init(nM, nN, gdim, bid);
  unsigned voffA[2], voffB[2];
#pragma unroll
  for (int i = 0; i < 2; ++i) { int R, C; stage_rc(tid * 16 + i * 8192, R, C); const int Rb = PERM ? ((R & ~31) + perm32(R & 31)) : R;
    voffA[i] = (unsigned)(R * g.lda + C) * 2u; voffB[i] = (unsigned)(Rb * K + C) * 2u; }
  const size_t kstep = (size_t)(BK * 2);
  const size_t hstepA = (size_t)HALF * g.lda * 2, hstepB = (size_t)HALF * K * 2;
  const unsigned ldsw = (unsigned)wid * 1024u;
  const int aoff = lds_byte(wr * 64 + fr, fq * 8), boff = lds_byte(wc * 32 + fr, fq * 8);
#define PG8_SA(b, h) (((b) * 2 + (h)) * HTB)
#define PG8_SB(b, h) ((4 + (b) * 2 + (h)) * HTB)
#define PG8_STAGE(bufoff, gbase, voff) do { _Pragma("unroll") for (int _i = 0; _i < 2; ++_i) \
    __builtin_amdgcn_global_load_lds((const unsigned*)((const char*)(gbase) + (voff)[_i]), (LAS unsigned*)(lds + (bufoff) + ldsw + _i * 8192), 16, 0, 0); } while (0)
#define PG8_LDA(dst, b, h) do { _Pragma("unroll") for (int m = 0; m < 4; ++m) _Pragma("unroll") for (int k = 0; k < 2; ++k) dst[m][k] = *(const LAS bf16x8*)(lds + PG8_SA(b, h) + aoff + m * 2048 + k * 1024); } while (0)
#define PG8_LDB(dst, b, h) do { _Pragma("unroll") for (int n = 0; n < 2; ++n) _Pragma("unroll") for (int k = 0; k < 2; ++k) dst[n][k] = *(const LAS bf16x8*)(lds + PG8_SB(b, h) + boff + n * 2048 + k * 1024); } while (0)
#define PG8_MMA(ai, bj, At, Bq) do { __builtin_amdgcn_s_setprio(1); _Pragma("unroll") for (int m = 0; m < 4; ++m) _Pragma("unroll") for (int n = 0; n < 2; ++n) _Pragma("unroll") for (int k = 0; k < 2; ++k) \
    acc[ai][bj][m][n] = __builtin_amdgcn_mfma_f32_16x16x32_bf16(Bq[n][k], At[m][k], acc[ai][bj][m][n], 0, 0, 0); __builtin_amdgcn_s_setprio(0); } while (0)
#define PG8_WAIT_V(n) asm volatile("s_waitcnt vmcnt(" #n ")" ::: "memory")
#define PG8_WAIT_L(n) asm volatile("s_waitcnt lgkmcnt(" #n ")" ::: "memory")
#define PG8_BAR __builtin_amdgcn_s_barrier()
#define PG8_SCHED __builtin_amdgcn_sched_barrier(0)
  Unit cur, nxt; int ui = 0;
  __syncthreads();
  if (!S.next(0, cur)) return;
  f32x4 acc[2][2][4][2];
#pragma unroll
  for (int a = 0; a < 2; ++a)
#pragma unroll
    for (int b = 0; b < 2; ++b)
#pragma unroll
      for (int m = 0; m < 4; ++m)
#pragma unroll
        for (int n = 0; n < 2; ++n) acc[a][b][m][n] = (f32x4){0.f, 0.f, 0.f, 0.f};
  bf16x8 At[4][2], B0[2][2], B1[2][2];
  const char* cA = a_tile_ptr<ROWMODE>(g, cur.pm); const char* cB = (const char*)g.Bt + (size_t)cur.pn * 2 * hstepB;
  PG8_STAGE(PG8_SB(0, 0), cB, voffB); PG8_STAGE(PG8_SA(0, 0), cA, voffA); PG8_STAGE(PG8_SB(0, 1), cB + hstepB, voffB); PG8_STAGE(PG8_SA(0, 1), cA + hstepA, voffA);
  if (wr == 1) PG8_BAR;
  PG8_WAIT_V(4); PG8_BAR;
  PG8_STAGE(PG8_SB(1, 0), cB + kstep, voffB); PG8_STAGE(PG8_SA(1, 0), cA + kstep, voffA); PG8_STAGE(PG8_SB(1, 1), cB + hstepB + kstep, voffB);
  PG8_WAIT_V(6); PG8_BAR;
  for (;;) {
    const bool has_next = S.next(ui + 1, nxt);
    const char* nA = has_next ? a_tile_ptr<ROWMODE>(g, nxt.pm) : cA; const char* nB = has_next ? (const char*)g.Bt + (size_t)nxt.pn * 2 * hstepB : cB;
    for (int t = 0; t < nt; t += 2) {
      const bool last = (t == nt - 2);
      const char* a1 = cA + (size_t)(t + 1) * kstep;
      const char* a2 = last ? nA : cA + (size_t)(t + 2) * kstep; const char* b2 = last ? nB : cB + (size_t)(t + 2) * kstep;
      const char* a3 = a2 + kstep; const char* b3 = b2 + kstep;
      PG8_LDB(B0, 0, 0); PG8_SCHED; PG8_LDA(At, 0, 0); PG8_STAGE(PG8_SA(1, 1), a1 + hstepA, voffA);
      PG8_WAIT_L(8); PG8_BAR; PG8_WAIT_L(0); PG8_MMA(0, 0, At, B0); PG8_BAR; PG8_SCHED;
      PG8_LDB(B1, 0, 1); PG8_STAGE(PG8_SB(0, 0), b2, voffB);
      PG8_BAR; PG8_WAIT_L(0); PG8_MMA(0, 1, At, B1); PG8_BAR;
      PG8_LDA(At, 0, 1); PG8_STAGE(PG8_SA(0, 0), a2, voffA);
      PG8_BAR; PG8_WAIT_L(0); PG8_MMA(1, 0, At, B0); PG8_BAR; PG8_SCHED;
      PG8_STAGE(PG8_SB(0, 1), b2 + hstepB, voffB);
      PG8_WAIT_V(6); PG8_BAR; PG8_MMA(1, 1, At, B1); PG8_BAR;
      PG8_LDB(B0, 1, 0); PG8_SCHED; PG8_LDA(At, 1, 0); PG8_STAGE(PG8_SA(0, 1), a2 + hstepA, voffA);
      PG8_WAIT_L(8); PG8_BAR; PG8_WAIT_L(0); PG8_MMA(0, 0, At, B0); PG8_BAR; PG8_SCHED;
      PG8_LDB(B1, 1, 1); PG8_STAGE(PG8_SB(1, 0), b3, voffB);
      PG8_BAR; PG8_WAIT_L(0); PG8_MMA(0, 1, At, B1); PG8_BAR;
      PG8_LDA(At, 1, 1); PG8_STAGE(PG8_SA(1, 0), a3, voffA);
      PG8_BAR; PG8_WAIT_L(0); PG8_MMA(1, 0, At, B0); PG8_BAR; PG8_SCHED;
      PG8_STAGE(PG8_SB(1, 1), b3 + hstepB, voffB);
      PG8_WAIT_V(6); PG8_BAR; PG8_MMA(1, 1, At, B1); PG8_BAR;
    }
    epilogue<EPI>(acc, cur, ea, lds);
    if (!has_next) break;
#pragma unroll
    for (int a = 0; a < 2; ++a)
#pragma unroll
      for (int b = 0; b < 2; ++b)
#pragma unroll
        for (int m = 0; m < 4; ++m)
#pragma unroll
          for (int n = 0; n < 2; ++n) acc[a][b][m][n] = (f32x4){0.f, 0.f, 0.f, 0.f};
    cur = nxt; cA = nA; cB = nB; ++ui;
  }
  PG8_WAIT_V(0);
  if (wr == 0) PG8_BAR;
  PG8_BAR;
#undef PG8_SA
#undef PG8_SB
}

constexpr int KROW = 144, VROW = 144;
constexpr int KBUF = 64 * KROW, VBUF = 128 * VROW, ABUF = KBUF + VBUF;
constexpr float LOG2E = 1.4426950408889634f;
DI bf16x8 pack8(const f32x16& x, int s) {
  u32x4 p; p.x = cvt_pk_bf16(x[8 * s], x[8 * s + 1]); p.y = cvt_pk_bf16(x[8 * s + 2], x[8 * s + 3]); p.z = cvt_pk_bf16(x[8 * s + 4], x[8 * s + 5]); p.w = cvt_pk_bf16(x[8 * s + 6], x[8 * s + 7]);
  return __builtin_bit_cast(bf16x8, p);
}
DI void attn_phase(LAS unsigned char* lds, u16* PB, const u16* VT, float* OSV, const float* lamp, const float* subg, const float* relb, int layer, int pair_lo, int pair_hi, int wg_lo, int wg_cnt) {
  int tid = threadIdx.x; asm volatile("" : "+v"(tid));
  int bid = blockIdx.x, gdim = gridDim.x; asm volatile("" : "+s"(bid), "+s"(gdim));
  const int wid = tid >> 6, lane = tid & 63, qi = lane & 31, g = lane >> 5;
  LAS float* tab = (LAS float*)(lds + 2 * ABUF);
  LAS float* scal = tab + 264;
  const float lam_init = 0.8f - 0.6f * __expf(-0.3f * (float)layer);
  __syncthreads();
  if (wid == 0) {
    float a = lamp[lane] * lamp[64 + lane], b = lamp[128 + lane] * lamp[192 + lane];
    for (int o = 32; o > 0; o >>= 1) { a += __shfl_xor(a, o); b += __shfl_xor(b, o); }
    if (lane == 0) scal[0] = __expf(a) - __expf(b) + lam_init;
  }
  const int m_sw = (qi & 0x13) | ((qi & 4) << 1) | ((qi & 8) >> 1);
  if (bid < wg_lo || bid >= wg_lo + wg_cnt) return;
  const int xcd = bid & 7, jq = (bid - wg_lo) >> 3;
  const int per_x = wg_cnt >> 3;
  const float c1 = 0.125f * LOG2E;
  for (int pr = pair_lo + xcd; pr < pair_hi; pr += 8) {
    const int s = pr >> 2, h = pr & 3;
    for (int qb = jq; qb < 32; qb += per_x) {
      __syncthreads();
      for (int i = tid; i < 257; i += NTHREADS) {
        const int rel = i - 128, n = rel < 0 ? -rel : rel;
        int bk = n < 8 ? n : (n <= 11 ? 8 : (n <= 15 ? 9 : (n <= 22 ? 10 : (n <= 31 ? 11 : (n <= 45 ? 12 : (n <= 63 ? 13 : (n <= 90 ? 14 : 15)))))));
        if (rel > 0) bk += 16;
        tab[i] = relb[bk * 4 + h] * LOG2E;
      }
      const int q0 = qb * 256 + wid * 32;
      const size_t tokbase = (size_t)s * T;
      float* osv = OSV + ((size_t)bid * 512 + tid) * 64;
#pragma unroll 1
      for (int c = 0; c < 2; ++c) {
        bf16x8 Q[4];
        { const u16* qp = PB + (tokbase + q0 + qi) * 1024 + h * 128 + c * 64 + g * 8;
#pragma unroll
          for (int ks = 0; ks < 4; ++ks) Q[ks] = *(const bf16x8*)(qp + ks * 16); }
        f32x16 O[4];
#pragma unroll
        for (int eb = 0; eb < 4; ++eb)
#pragma unroll
          for (int i = 0; i < 16; ++i) O[eb][i] = 0.f;
        float mrun = -1e30f, lrun = 0.f;
        const u16* kg = PB + (tokbase + (tid >> 3)) * 1024 + 512 + h * 128 + c * 64 + (tid & 7) * 8;
        const u16* vg = VT + ((size_t)((s * 4 + h) * 128 + (tid >> 2))) * T + (tid & 3) * 16;
        const unsigned kl = (tid >> 3) * KROW + (tid & 7) * 16, vl = KBUF + (tid >> 2) * VROW + (tid & 3) * 32;
        u32x4 rk0, rv0, rv1;
        rk0 = *(const u32x4*)(kg); rv0 = *(const u32x4*)(vg); rv1 = *(const u32x4*)(vg + 8);
        __syncthreads();
        *(LAS u32x4*)(lds + kl) = rk0; *(LAS u32x4*)(lds + vl) = rv0; *(LAS u32x4*)(lds + vl + 16) = rv1;
        __syncthreads();
        auto compute_tile = [&](const int kt, LAS unsigned char* buf) {
          const int kmin = kt * 64;
          const int dlo = kmin + 63 - q0, dhi = kmin - (q0 + 31);
          const int bmode = dlo <= -91 ? 0 : (dhi >= 91 ? 1 : 2);
          const float bconst = bmode == 0 ? tab[0] : tab[256];
          f32x16 S[2];
          {
            bf16x8 kf[2][4];
#pragma unroll
            for (int kb = 0; kb < 2; ++kb)
#pragma unroll
              for (int ks = 0; ks < 4; ++ks) kf[kb][ks] = *(const LAS bf16x8*)(buf + (kb * 32 + m_sw) * KROW + (ks * 16 + g * 8) * 2);
            __builtin_amdgcn_sched_barrier(0);
            __builtin_amdgcn_s_setprio(1);
#pragma unroll
            for (int kb = 0; kb < 2; ++kb) {
#pragma unroll
              for (int i = 0; i < 16; ++i) S[kb][i] = 0.f;
#pragma unroll
              for (int ks = 0; ks < 4; ++ks) S[kb] = __builtin_amdgcn_mfma_f32_32x32x16_bf16(kf[kb][ks], Q[ks], S[kb], 0, 0, 0);
            }
            __builtin_amdgcn_s_setprio(0);
          }
          bf16x8 vf[2][4];
          float sc = c1, off = bconst;
          if (bmode == 2) {
#pragma unroll
            for (int kb = 0; kb < 2; ++kb)
#pragma unroll
              for (int r = 0; r < 16; ++r) {
                int rel = kmin + kb * 32 + 16 * (r >> 3) + 8 * g + (r & 7) - (q0 + qi);
                rel = rel < -128 ? -128 : (rel > 128 ? 128 : rel);
                S[kb][r] = S[kb][r] * c1 + tab[rel + 128];
              }
            sc = 1.f; off = 0.f;
          }
          float mx = -3e38f;
#pragma unroll
          for (int kb = 0; kb < 2; ++kb)
#pragma unroll
            for (int r = 0; r < 16; ++r) mx = fmaxf(mx, S[kb][r]);
          mx = fmaxf(mx, __shfl_xor(mx, 32));
          mx = mx * sc + off;
          if (__any(mx > mrun + 8.f)) {
            const float mnew = mx > mrun + 8.f ? mx : mrun;
            const float alpha = __builtin_amdgcn_exp2f(mrun - mnew);
            mrun = mnew; lrun *= alpha;
#pragma unroll
            for (int eb = 0; eb < 4; ++eb)
#pragma unroll
              for (int i = 0; i < 16; ++i) O[eb][i] *= alpha;
          }
          const float sh = off - mrun;
          float ps0 = 0.f, ps1 = 0.f, ps2 = 0.f, ps3 = 0.f;
#pragma unroll
          for (int kb = 0; kb < 2; ++kb)
#pragma unroll
            for (int r = 0; r < 16; r += 4) {
              const float p0 = __builtin_amdgcn_exp2f(S[kb][r] * sc + sh), p1 = __builtin_amdgcn_exp2f(S[kb][r + 1] * sc + sh), p2 = __builtin_amdgcn_exp2f(S[kb][r + 2] * sc + sh), p3 = __builtin_amdgcn_exp2f(S[kb][r + 3] * sc + sh);
              S[kb][r] = p0; S[kb][r + 1] = p1; S[kb][r + 2] = p2; S[kb][r + 3] = p3; ps0 += p0; ps1 += p1; ps2 += p2; ps3 += p3;
            }
          lrun += (ps0 + ps1) + (ps2 + ps3);
          __builtin_amdgcn_sched_barrier(0);
          __builtin_amdgcn_s_setprio(1);
#pragma unroll
          for (int eb = 0; eb < 4; ++eb) vf[0][eb] = *(const LAS bf16x8*)(buf + KBUF + (eb * 32 + qi) * VROW + (g * 8) * 2);
#pragma unroll
          for (int stp = 0; stp < 4; ++stp) {
            const int kb = stp >> 1, hh = stp & 1;
            if (stp < 3) {
#pragma unroll
              for (int eb = 0; eb < 4; ++eb) vf[(stp + 1) & 1][eb] = *(const LAS bf16x8*)(buf + KBUF + (eb * 32 + qi) * VROW + ((stp + 1) * 16 + g * 8) * 2);
            }
            const bf16x8 pb = pack8(S[kb], hh);
#pragma unroll
            for (int eb = 0; eb < 4; ++eb) O[eb] = __builtin_amdgcn_mfma_f32_32x32x16_bf16(vf[stp & 1][eb], pb, O[eb], 0, 0, 0);
          }
          __builtin_amdgcn_s_setprio(0);
        };
        u32x4 rkB, rvB0, rvB1;
        { const u16* kg2 = kg + (size_t)1 * 64 * 1024; const u16* vg2 = vg + 64;
          rk0 = *(const u32x4*)(kg2); rv0 = *(const u32x4*)(vg2); rv1 = *(const u32x4*)(vg2 + 8);
          const u16* kg3 = kg + (size_t)2 * 64 * 1024; const u16* vg3 = vg + 128;
          rkB = *(const u32x4*)(kg3); rvB0 = *(const u32x4*)(vg3); rvB1 = *(const u32x4*)(vg3 + 8); }
#pragma unroll 1
        for (int kt = 0; kt < 128; kt += 2) {
          LAS unsigned char* buf0 = lds; LAS unsigned char* buf1 = lds + ABUF;
          compute_tile(kt, buf0);
          *(LAS u32x4*)(buf1 + kl) = rk0; *(LAS u32x4*)(buf1 + vl) = rv0; *(LAS u32x4*)(buf1 + vl + 16) = rv1;
          { const int tn = kt + 3 < 128 ? kt + 3 : 127; const u16* kg2 = kg + (size_t)tn * 64 * 1024; const u16* vg2 = vg + tn * 64;
            rk0 = *(const u32x4*)(kg2); rv0 = *(const u32x4*)(vg2); rv1 = *(const u32x4*)(vg2 + 8); }
          __syncthreads();
          compute_tile(kt + 1, buf1);
          *(LAS u32x4*)(buf0 + kl) = rkB; *(LAS u32x4*)(buf0 + vl) = rvB0; *(LAS u32x4*)(buf0 + vl + 16) = rvB1;
          { const int tn = kt + 4 < 128 ? kt + 4 : 127; const u16* kg2 = kg + (size_t)tn * 64 * 1024; const u16* vg2 = vg + tn * 64;
            rkB = *(const u32x4*)(kg2); rvB0 = *(const u32x4*)(vg2); rvB1 = *(const u32x4*)(vg2 + 8); }
          __syncthreads();
        }
        const float lt = lrun + __shfl_xor(lrun, 32);
        asm volatile("" : "+v"(osv));
        if (c == 0) {
          const float i0 = 1.f / lt;
#pragma unroll
          for (int eb = 0; eb < 4; ++eb)
#pragma unroll
            for (int i = 0; i < 16; i += 4) { f32x4 t4; t4[0] = O[eb][i] * i0; t4[1] = O[eb][i + 1] * i0; t4[2] = O[eb][i + 2] * i0; t4[3] = O[eb][i + 3] * i0; *(f32x4*)(osv + eb * 16 + i) = t4; }
        } else {
          const float i1 = scal[0] / lt;
          float ss = 0.f;
#pragma unroll
          for (int eb = 0; eb < 4; ++eb)
#pragma unroll
            for (int i = 0; i < 16; i += 4) { const f32x4 t4 = *(const f32x4*)(osv + eb * 16 + i);
#pragma unroll
              for (int j = 0; j < 4; ++j) { const float o = t4[j] - O[eb][i + j] * i1; O[eb][i + j] = o; ss += o * o; } }
          ss += __shfl_xor(ss, 32);
          const float rs = rsqrtf(ss * (1.f / 128.f) + LN_EPS) * (1.f - lam_init);
          u16* op = PB + (tokbase + q0 + qi) * 1024 + h * 128;
#pragma unroll
          for (int eb = 0; eb < 4; ++eb)
#pragma unroll
            for (int rr = 0; rr < 4; ++rr) {
              const int e = eb * 32 + 8 * rr + 4 * g;
              const f32x4 gg = *(const f32x4*)(subg + e);
              u32x2 pk; pk.x = cvt_pk_bf16(O[eb][4 * rr] * rs * gg[0], O[eb][4 * rr + 1] * rs * gg[1]); pk.y = cvt_pk_bf16(O[eb][4 * rr + 2] * rs * gg[2], O[eb][4 * rr + 3] * rs * gg[3]);
              *(u32x2*)(op + e) = pk;
            }
        }
      }
    }
  }
}

DI float softplusf_(float x) { return fmaxf(x, 0.f) + __logf(1.f + __expf(-fabsf(x))); }
DI void load_bf16x8(const u16* p, float (&o)[8]) {
  const u32x4 v = *(const u32x4*)p;
#pragma unroll
  for (int i = 0; i < 4; ++i) { o[2 * i] = __uint_as_float(v[i] << 16); o[2 * i + 1] = __uint_as_float(v[i] & 0xffff0000u); }
}
DI void shifted8(const u16* PA, size_t row, int t, int col, const float* mu0, const float* mu1, float (&o)[8]) {
  float c[8], pv[8], nx[8];
  load_bf16x8(PA + row * A_COLS + col, c);
  if (t > 0) load_bf16x8(PA + (row - 1) * A_COLS + col, pv); else { for (int i = 0; i < 8; ++i) pv[i] = 0.f; }
  if (t < T - 1) load_bf16x8(PA + (row + 1) * A_COLS + col, nx); else { for (int i = 0; i < 8; ++i) nx[i] = 0.f; }
#pragma unroll
  for (int i = 0; i < 8; ++i) o[i] = c[i] + mu0[col + i] * (pv[i] - c[i]) + mu1[col + i] * (nx[i] - c[i]);
}

DI void vprep_phase(LAS unsigned char* lds, const u16* PA, u16* VV, const float* mu, const float* vdown, const float* vup, const float* v0, int layer) {
  int tid = threadIdx.x; asm volatile("" : "+v"(tid));
  int bid = blockIdx.x, gdim = gridDim.x; asm volatile("" : "+s"(bid), "+s"(gdim));
  const int tok = tid >> 4, j = tid & 15;
  LAS float* vs = (LAS float*)lds;
  LAS float* dd = vs + 32 * 516;
  LAS unsigned* DN = (LAS unsigned*)(dd + 1024);
  LAS unsigned* UP = DN + 512 * 16;
  const float* mu0 = mu; const float* mu1 = mu + A_COLS;
  __syncthreads();
  if (layer != 0) {
    for (int i = tid; i < 512 * 16; i += NTHREADS) { const float2 w2 = *(const float2*)(vdown + 2 * i); DN[i] = cvt_pk_bf16(w2.x, w2.y); }
    for (int i = tid; i < 32 * 256; i += NTHREADS) { const float2 w2 = *(const float2*)(vup + 2 * i); UP[i] = cvt_pk_bf16(w2.x, w2.y); }
  }
  for (int it = bid; it < NT / 32; it += gdim) {
    const size_t row = (size_t)it * 32 + tok; const int t = (int)(row % T);
    __syncthreads();
#pragma unroll 1
    for (int q = 0; q < 4; ++q) {
      const int cc = q * 128 + j * 8;
      float o[8]; shifted8(PA, row, t, OFF_V + cc, mu0, mu1, o);
      if (layer == 0) {
        u32x4 pk; pk.x = cvt_pk_bf16(o[0], o[1]); pk.y = cvt_pk_bf16(o[2], o[3]); pk.z = cvt_pk_bf16(o[4], o[5]); pk.w = cvt_pk_bf16(o[6], o[7]);
        *(u32x4*)(VV + row * 512 + cc) = pk;
      } else {
        *(LAS f32x4*)(vs + tok * 516 + cc) = (f32x4){o[0], o[1], o[2], o[3]}; *(LAS f32x4*)(vs + tok * 516 + cc + 4) = (f32x4){o[4], o[5], o[6], o[7]};
      }
    }
    if (layer == 0) continue;
    __syncthreads();
    {
      float d0 = 0.f, d1 = 0.f;
#pragma unroll 8
      for (int c = 0; c < 512; ++c) { const float x = vs[tok * 516 + c]; const unsigned w2 = DN[c * 16 + j]; d0 += x * __uint_as_float(w2 << 16); d1 += x * __uint_as_float(w2 & 0xffff0000u); }
      dd[tok * 32 + 2 * j] = d0; dd[tok * 32 + 2 * j + 1] = d1;
    }
    __syncthreads();
#pragma unroll 1
    for (int q = 0; q < 4; ++q) {
      const int c0 = q * 128 + j * 8;
      float acc[8];
      { const f32x4 a0 = *(const f32x4*)(v0 + c0), a1 = *(const f32x4*)(v0 + c0 + 4);
#pragma unroll
        for (int i = 0; i < 4; ++i) { acc[i] = a0[i]; acc[4 + i] = a1[i]; } }
#pragma unroll 8
      for (int r = 0; r < 32; ++r) {
        const float dv = dd[tok * 32 + r];
        const u32x4 w8 = *(const LAS u32x4*)(UP + r * 256 + (c0 >> 1));
#pragma unroll
        for (int i = 0; i < 4; ++i) { acc[2 * i] += dv * __uint_as_float(w8[i] << 16); acc[2 * i + 1] += dv * __uint_as_float(w8[i] & 0xffff0000u); }
      }
      float vf[8]; load_bf16x8(VV + row * 512 + c0, vf);
      const f32x4 x0 = *(const LAS f32x4*)(vs + tok * 516 + c0), x1 = *(const LAS f32x4*)(vs + tok * 516 + c0 + 4);
      float o[8];
#pragma unroll
      for (int i = 0; i < 4; ++i) { o[i] = x0[i] + (vf[i] - x0[i]) * sigmoidf_(acc[i]); o[4 + i] = x1[i] + (vf[4 + i] - x1[i]) * sigmoidf_(acc[4 + i]); }
      u32x4 pk; pk.x = cvt_pk_bf16(o[0], o[1]); pk.y = cvt_pk_bf16(o[2], o[3]); pk.z = cvt_pk_bf16(o[4], o[5]); pk.w = cvt_pk_bf16(o[6], o[7]);
      *(u32x4*)(VV + row * 512 + c0) = pk;
    }
  }
}

struct ScanW { const float *mu, *w0, *du, *a0, *iu, *kk_, *ka, *rk; };
constexpr int SC = 32;
DI float quad_sum(float x) {
  x += __builtin_bit_cast(float, __builtin_amdgcn_update_dpp(0, __builtin_bit_cast(int, x), 0xB1, 0xf, 0xf, true));
  x += __builtin_bit_cast(float, __builtin_amdgcn_update_dpp(0, __builtin_bit_cast(int, x), 0x4E, 0xf, 0xf, true));
  return x;
}
#define BFLO(x) __uint_as_float((x) << 16)
#define BFHI(x) __uint_as_float((x) & 0xffff0000u)
DI float tanh_fast(float x) { x = fminf(fmaxf(x, -15.f), 15.f); const float t = __expf(2.f * x); return (t - 1.f) / (t + 1.f); }
DI float shift1(float c, float p, float n, float m0, float m1) { return c + m0 * (p - c) + m1 * (n - c); }
DI void scan_produce(LAS float* buf, LAS unsigned* TW, LAS unsigned* TA, LAS const unsigned* DU, LAS const unsigned* IU, const u16* PA, const u16* VV, float* BON,
                     const ScanW& w, int ptid, int sq, int h, int dir, int t0) {
  const int tok = ptid >> 3, j = ptid & 7;
  const int t = t0 + tok; const size_t row = (size_t)sq * T + t;
  const float* mu0 = w.mu; const float* mu1 = w.mu + A_COLS;
  const int cr = h * 64 + j * 8, ck = OFF_K + cr, cw_ = OFF_WD + dir * 32 + j * 4, ca_ = OFF_AD + dir * 32 + j * 4;
  const u16* pc = PA + row * A_COLS;
  const bool hp = t > 0, hn = t < T - 1;
  {
    const u32x2 w_c = *(const u32x2*)(pc + cw_), a_c = *(const u32x2*)(pc + ca_);
    u32x2 w_p = (u32x2){0u, 0u}, a_p = w_p, w_n = w_p, a_n = w_p;
    if (hp) { w_p = *(const u32x2*)(pc - A_COLS + cw_); a_p = *(const u32x2*)(pc - A_COLS + ca_); }
    if (hn) { w_n = *(const u32x2*)(pc + A_COLS + cw_); a_n = *(const u32x2*)(pc + A_COLS + ca_); }
    const f32x4 mw0 = *(const f32x4*)(mu0 + cw_), mw1 = *(const f32x4*)(mu1 + cw_), ma0 = *(const f32x4*)(mu0 + ca_), ma1 = *(const f32x4*)(mu1 + ca_);
    f32x4 tw, ta;
#pragma unroll
    for (int i = 0; i < 2; ++i) {
      tw[2 * i] = tanh_fast(shift1(BFLO(w_c[i]), BFLO(w_p[i]), BFLO(w_n[i]), mw0[2 * i], mw1[2 * i]));
      tw[2 * i + 1] = tanh_fast(shift1(BFHI(w_c[i]), BFHI(w_p[i]), BFHI(w_n[i]), mw0[2 * i + 1], mw1[2 * i + 1]));
      ta[2 * i] = shift1(BFLO(a_c[i]), BFLO(a_p[i]), BFLO(a_n[i]), ma0[2 * i], ma1[2 * i]);
      ta[2 * i + 1] = shift1(BFHI(a_c[i]), BFHI(a_p[i]), BFHI(a_n[i]), ma0[2 * i + 1], ma1[2 * i + 1]);
    }
    u32x2 tw2, ta2; tw2.x = cvt_pk_bf16(tw[0], tw[1]); tw2.y = cvt_pk_bf16(tw[2], tw[3]); ta2.x = cvt_pk_bf16(ta[0], ta[1]); ta2.y = cvt_pk_bf16(ta[2], ta[3]);
    *(LAS u32x2*)(TW + tok * 16 + j * 2) = tw2; *(LAS u32x2*)(TA + tok * 16 + j * 2) = ta2;
  }
  asm volatile("s_waitcnt lgkmcnt(0)" ::: "memory");
  float wl[8], al[8];
  const int cc = j * 8, cg_ = h * 64 + cc;
  { const f32x4 x0 = *(const f32x4*)(w.w0 + dir * 512 + cg_), x1 = *(const f32x4*)(w.w0 + dir * 512 + cg_ + 4), y0 = *(const f32x4*)(w.a0 + dir * 512 + cg_), y1 = *(const f32x4*)(w.a0 + dir * 512 + cg_ + 4);
#pragma unroll
    for (int q = 0; q < 4; ++q) { wl[q] = x0[q]; wl[4 + q] = x1[q]; al[q] = y0[q]; al[4 + q] = y1[q]; } }
#pragma unroll 2
  for (int pr = 0; pr < 16; ++pr) {
    const bf2 twp = __builtin_bit_cast(bf2, TW[tok * 16 + pr]), tap = __builtin_bit_cast(bf2, TA[tok * 16 + pr]);
    const u32x4 d0 = *(const LAS u32x4*)(DU + pr * 64 + cc), d1 = *(const LAS u32x4*)(DU + pr * 64 + cc + 4), i0 = *(const LAS u32x4*)(IU + pr * 64 + cc), i1 = *(const LAS u32x4*)(IU + pr * 64 + cc + 4);
#pragma unroll
    for (int q = 0; q < 4; ++q) {
      unsigned ua = d0[q], ub = d1[q], uc = i0[q], ud = i1[q]; asm volatile("" : "+v"(ua), "+v"(ub), "+v"(uc), "+v"(ud));
      wl[q] = __builtin_amdgcn_fdot2_f32_bf16(twp, __builtin_bit_cast(bf2, ua), wl[q], false); wl[4 + q] = __builtin_amdgcn_fdot2_f32_bf16(twp, __builtin_bit_cast(bf2, ub), wl[4 + q], false);
      al[q] = __builtin_amdgcn_fdot2_f32_bf16(tap, __builtin_bit_cast(bf2, uc), al[q], false); al[4 + q] = __builtin_amdgcn_fdot2_f32_bf16(tap, __builtin_bit_cast(bf2, ud), al[4 + q], false);
    }
  }
#pragma unroll
  for (int q = 0; q < 8; ++q) { asm volatile("" : "+v"(wl[q]), "+v"(al[q])); }
  LAS float* AW = buf; LAS float* AK = buf + 2048; LAS float* AB = buf + 4096; LAS float* AD = buf + 6144; LAS float* AR = buf + 8192; LAS float* AV = buf + 10240;
  const int o = tok * 64 + cc;
  float ss = 0.f, bs = 0.f;
  float ok[8], av[8];
#pragma unroll
  for (int hq = 0; hq < 2; ++hq) {
    const int c4 = 4 * hq;
    const u32x2 r_c = *(const u32x2*)(pc + cr + c4), k_c = *(const u32x2*)(pc + ck + c4);
    u32x2 r_p = (u32x2){0u, 0u}, k_p = r_p, r_n = r_p, k_n = r_p;
    if (hp) { r_p = *(const u32x2*)(pc - A_COLS + cr + c4); k_p = *(const u32x2*)(pc - A_COLS + ck + c4); }
    if (hn) { r_n = *(const u32x2*)(pc + A_COLS + cr + c4); k_n = *(const u32x2*)(pc + A_COLS + ck + c4); }
    const u32x2 v_c = *(const u32x2*)(VV + row * 512 + cr + c4);
    const f32x4 mr0 = *(const f32x4*)(mu0 + cr + c4), mr1 = *(const f32x4*)(mu1 + cr + c4), mk0 = *(const f32x4*)(mu0 + ck + c4), mk1 = *(const f32x4*)(mu1 + ck + c4);
    const f32x4 kk4 = *(const f32x4*)(w.kk_ + cg_ + c4), ka4 = *(const f32x4*)(w.ka + cg_ + c4), rk4 = *(const f32x4*)(w.rk + cg_ + c4);
    f32x4 rv, kv, vv, ow, od;
#pragma unroll
    for (int i = 0; i < 2; ++i) {
      rv[2 * i] = shift1(BFLO(r_c[i]), BFLO(r_p[i]), BFLO(r_n[i]), mr0[2 * i], mr1[2 * i]);
      rv[2 * i + 1] = shift1(BFHI(r_c[i]), BFHI(r_p[i]), BFHI(r_n[i]), mr0[2 * i + 1], mr1[2 * i + 1]);
      kv[2 * i] = shift1(BFLO(k_c[i]), BFLO(k_p[i]), BFLO(k_n[i]), mk0[2 * i], mk1[2 * i]);
      kv[2 * i + 1] = shift1(BFHI(k_c[i]), BFHI(k_p[i]), BFHI(k_n[i]), mk0[2 * i + 1], mk1[2 * i + 1]);
      vv[2 * i] = BFLO(v_c[i]); vv[2 * i + 1] = BFHI(v_c[i]);
    }
#pragma unroll
    for (int q = 0; q < 4; ++q) {
      const float wlog = -softplusf_(-wl[c4 + q]) - 0.5f;
      ow[q] = __expf(-__expf(wlog));
      const float a = sigmoidf_(al[c4 + q]);
      av[c4 + q] = a;
      ok[c4 + q] = kv[q] * kk4[q]; ss += ok[c4 + q] * ok[c4 + q];
      od[q] = kv[q] * (1.f + (a - 1.f) * ka4[q]);
      bs += rv[q] * od[q] * rk4[q];
    }
    *(LAS f32x4*)(AW + o + c4) = ow; *(LAS f32x4*)(AD + o + c4) = od; *(LAS f32x4*)(AR + o + c4) = rv; *(LAS f32x4*)(AV + o + c4) = vv;
  }
#pragma unroll
  for (int sft = 1; sft < 8; sft <<= 1) { ss += __shfl_xor(ss, sft); bs += __shfl_xor(bs, sft); }
  const float rn = rsqrtf(ss + 1e-12f);
#pragma unroll
  for (int hq = 0; hq < 2; ++hq) {
    f32x4 k4, b4;
#pragma unroll
    for (int q = 0; q < 4; ++q) { k4[q] = ok[4 * hq + q] * rn; b4[q] = k4[q] * av[4 * hq + q]; }
    *(LAS f32x4*)(AK + o + 4 * hq) = k4; *(LAS f32x4*)(AB + o + 4 * hq) = b4;
  }
  if (j == 0) BON[((size_t)dir * NT + row) * 8 + h] = bs;
}
struct ScanOps { f32x4 k4[4], w4[4], b4[4], d4[4]; float vi; };
DI void scan_load(ScanOps& o, LAS const float* buf, int tt, int jseg, int irow) {
  const int off = tt * 64 + jseg * 16;
#pragma unroll
  for (int q = 0; q < 4; ++q) {
    o.w4[q] = *(const LAS f32x4*)(buf + off + q * 4); o.k4[q] = *(const LAS f32x4*)(buf + 2048 + off + q * 4); o.b4[q] = *(const LAS f32x4*)(buf + 4096 + off + q * 4);
    o.d4[q] = *(const LAS f32x4*)(buf + 6144 + off + q * 4);
  }
  o.vi = buf[10240 + tt * 64 + irow];
}
DI float scan_step(f32x4 (&S)[4], const ScanOps& o, LAS const float* buf, int tt, int jseg) {
  f32x4 r4[4];
#pragma unroll
  for (int q = 0; q < 4; ++q) r4[q] = *(const LAS f32x4*)(buf + 8192 + tt * 64 + jseg * 16 + q * 4);
  f32x4 a4 = S[0] * o.k4[0] + S[1] * o.k4[1] + S[2] * o.k4[2] + S[3] * o.k4[3];
  float sa = -quad_sum((a4[0] + a4[1]) + (a4[2] + a4[3]));
  f32x4 y4 = (f32x4){0.f, 0.f, 0.f, 0.f};
#pragma unroll
  for (int q = 0; q < 4; ++q) { S[q] = S[q] * o.w4[q] + (o.b4[q] * sa + o.d4[q] * o.vi); y4 += S[q] * r4[q]; }
  return quad_sum((y4[0] + y4[1]) + (y4[2] + y4[3]));
}
DI void scan_phase(LAS unsigned char* lds, const u16* PA, const u16* VV, u16* YY, float* BON, const ScanW w) {
  int tid = threadIdx.x; asm volatile("" : "+v"(tid));
  int bid = blockIdx.x, gdim = gridDim.x; asm volatile("" : "+s"(bid), "+s"(gdim));
  LAS float* BUF = (LAS float*)lds;
  LAS float* AY = BUF + 2 * 12288;
  LAS unsigned* TW = (LAS unsigned*)(AY + 2 * 2048);
  LAS unsigned* TA = TW + SC * 16;
  LAS unsigned* DU = TA + SC * 16;
  LAS unsigned* IU = DU + 1024;
  const int wid = __builtin_amdgcn_readfirstlane(tid >> 6), lane = tid & 63;
  const int NCH = T / SC;
  for (int item = bid; item < 192; item += gdim) {
    const int dir = item & 1, h = (item >> 1) & 7, sq = item >> 4;
    __syncthreads();
    for (int i = tid; i < 1024; i += NTHREADS) { const int pr = i >> 6, c = i & 63; const size_t o0 = (size_t)(dir * 32 + 2 * pr) * 512 + h * 64 + c;
      DU[i] = cvt_pk_bf16(w.du[o0], w.du[o0 + 512]); IU[i] = cvt_pk_bf16(w.iu[o0], w.iu[o0 + 512]); }
    __syncthreads();
    f32x4 S[4];
#pragma unroll
    for (int q = 0; q < 4; ++q) S[q] = (f32x4){0.f, 0.f, 0.f, 0.f};
    const int irow = (wid & 3) * 16 + (lane >> 2), jseg = lane & 3;
    if (wid >= 4) scan_produce(BUF, TW, TA, DU, IU, PA, VV, BON, w, tid - 256, sq, h, dir, dir == 0 ? 0 : T - SC);
    __syncthreads();
#pragma unroll 1
    for (int ci = 0; ci < NCH; ++ci) {
      LAS float* buf = BUF + (ci & 1) * 12288;
      LAS float* ay = AY + (ci & 1) * 2048;
      if (wid < 4) {
        ScanOps o0, o1;
        scan_load(o0, buf, dir == 0 ? 0 : SC - 1, jseg, irow);
#pragma unroll 1
        for (int st = 0; st < SC; st += 2) {
          const int t0_ = dir == 0 ? st : SC - 1 - st, t1_ = dir == 0 ? st + 1 : SC - 2 - st;
          scan_load(o1, buf, t1_, jseg, irow);
          const float y0 = scan_step(S, o0, buf, t0_, jseg);
          if (jseg == 0) ay[t0_ * 64 + irow] = y0;
          if (st + 2 < SC) scan_load(o0, buf, dir == 0 ? st + 2 : SC - 3 - st, jseg, irow);
          const float y1 = scan_step(S, o1, buf, t1_, jseg);
          if (jseg == 0) ay[t1_ * 64 + irow] = y1;
        }
      } else {
        const int ptid = tid - 256;
        if (ci + 1 < NCH) scan_produce(BUF + ((ci + 1) & 1) * 12288, TW, TA, DU, IU, PA, VV, BON, w, ptid, sq, h, dir, dir == 0 ? (ci + 1) * SC : T - SC * (ci + 2));
        if (ci > 0) {
          LAS const float* py = AY + ((ci - 1) & 1) * 2048;
          const int t0p = dir == 0 ? (ci - 1) * SC : T - SC * ci;
          const int tok = ptid >> 3, c0 = (ptid & 7) * 8;
          const f32x4 ya = *(const LAS f32x4*)(py + tok * 64 + c0), yb = *(const LAS f32x4*)(py + tok * 64 + c0 + 4);
          u32x4 pk; pk.x = cvt_pk_bf16(ya[0], ya[1]); pk.y = cvt_pk_bf16(ya[2], ya[3]); pk.z = cvt_pk_bf16(yb[0], yb[1]); pk.w = cvt_pk_bf16(yb[2], yb[3]);
          *(u32x4*)(YY + ((size_t)dir * NT + (size_t)sq * T + t0p + tok) * 512 + h * 64 + c0) = pk;
        }
      }
      __syncthreads();
    }
    if (wid >= 4) {
      const int ptid = tid - 256;
      LAS const float* py = AY + ((NCH - 1) & 1) * 2048;
      const int t0p = dir == 0 ? (NCH - 1) * SC : 0;
      const int tok = ptid >> 3, c0 = (ptid & 7) * 8;
      const f32x4 ya = *(const LAS f32x4*)(py + tok * 64 + c0), yb = *(const LAS f32x4*)(py + tok * 64 + c0 + 4);
      u32x4 pk; pk.x = cvt_pk_bf16(ya[0], ya[1]); pk.y = cvt_pk_bf16(ya[2], ya[3]); pk.z = cvt_pk_bf16(yb[0], yb[1]); pk.w = cvt_pk_bf16(yb[2], yb[3]);
      *(u32x4*)(YY + ((size_t)dir * NT + (size_t)sq * T + t0p + tok) * 512 + h * 64 + c0) = pk;
    }
  }
}

DI void post_phase(LAS unsigned char* lds, u16* PA, const u16* PB, const u16* VV, const u16* YY, const float* BON, const float* mu, const float* gup, const float* gng, const float* gnb) {
  int tid = threadIdx.x; asm volatile("" : "+v"(tid));
  int bid = blockIdx.x, gdim = gridDim.x; asm volatile("" : "+s"(bid), "+s"(gdim));
  const int tok = tid >> 4, j = tid & 15;
  LAS unsigned* SG2 = (LAS unsigned*)lds;
  LAS unsigned* GU = (LAS unsigned*)(lds + 16384);
  const float* mu0 = mu; const float* mu1 = mu + A_COLS;
  __syncthreads();
  for (int e = tid; e < 48 * 512; e += NTHREADS) { const int r2 = e >> 9, c = e & 511; GU[(r2 * 2 + ((c >> 2) & 1)) * 256 + (c >> 3) * 4 + (c & 3)] = cvt_pk_bf16(gup[(2 * r2) * 512 + c], gup[(2 * r2 + 1) * 512 + c]); }
  for (int it = bid; it < NT / 32; it += gdim) {
    const size_t row = (size_t)it * 32 + tok; const int t = (int)(row % T);
    __syncthreads();
    { float sv[6];
#pragma unroll
      for (int q = 0; q < 6; ++q) {
        const int col = OFF_GD + j * 6 + q;
        const float c = bf2f(PA[row * A_COLS + col]);
        const float pv = t > 0 ? bf2f(PA[(row - 1) * A_COLS + col]) : 0.f, nx = t < T - 1 ? bf2f(PA[(row + 1) * A_COLS + col]) : 0.f;
        sv[q] = sigmoidf_(c + mu0[col] * (pv - c) + mu1[col] * (nx - c));
      }
#pragma unroll
      for (int pq = 0; pq < 3; ++pq) SG2[tok * 48 + j * 3 + pq] = cvt_pk_bf16(sv[2 * pq], sv[2 * pq + 1]); }
    __syncthreads();
#pragma unroll 1
    for (int q = 0; q < 4; ++q) {
      const int cc = q * 128 + j * 8, h = 2 * q + (j >> 3);
      float y[8]; float sm = 0.f;
      { float a[8], b[8]; load_bf16x8(YY + row * 512 + cc, a); load_bf16x8(YY + ((size_t)NT + row) * 512 + cc, b);
#pragma unroll
        for (int i = 0; i < 8; ++i) { y[i] = a[i] + b[i]; sm += y[i]; } }
      sm += __shfl_xor(sm, 1); sm += __shfl_xor(sm, 2); sm += __shfl_xor(sm, 4);
      const float mean = sm * (1.f / 64.f);
      float vq = 0.f;
#pragma unroll
      for (int i = 0; i < 8; ++i) { y[i] -= mean; vq += y[i] * y[i]; }
      vq += __shfl_xor(vq, 1); vq += __shfl_xor(vq, 2); vq += __shfl_xor(vq, 4);
      const float rs = rsqrtf(vq * (1.f / 64.f) + GN_EPS);
      const float bon = BON[row * 8 + h] + BON[((size_t)NT + row) * 8 + h];
      float gacc[8];
#pragma unroll
      for (int i = 0; i < 8; ++i) gacc[i] = 0.f;
#pragma unroll 8
      for (int r2 = 0; r2 < 48; ++r2) {
        const bf2 sv = __builtin_bit_cast(bf2, SG2[tok * 48 + r2]);
        const u32x4 wa = *(const LAS u32x4*)(GU + (r2 * 2 + 0) * 256 + (cc >> 3) * 4), wb = *(const LAS u32x4*)(GU + (r2 * 2 + 1) * 256 + (cc >> 3) * 4);
#pragma unroll
        for (int i = 0; i < 4; ++i) { unsigned ua = wa[i], ub = wb[i]; asm volatile("" : "+v"(ua), "+v"(ub));
          gacc[i] = __builtin_amdgcn_fdot2_f32_bf16(sv, __builtin_bit_cast(bf2, ua), gacc[i], false); gacc[4 + i] = __builtin_amdgcn_fdot2_f32_bf16(sv, __builtin_bit_cast(bf2, ub), gacc[4 + i], false); }
      }
      float vv[8]; load_bf16x8(VV + row * 512 + cc, vv);
      const f32x4 g0 = *(const f32x4*)(gng + cc), g1 = *(const f32x4*)(gng + cc + 4), b0 = *(const f32x4*)(gnb + cc), b1 = *(const f32x4*)(gnb + cc + 4);
      float o[8];
#pragma unroll
      for (int i = 0; i < 4; ++i) { o[i] = (y[i] * rs * g0[i] + b0[i] + bon * vv[i]) * gacc[i]; o[4 + i] = (y[4 + i] * rs * g1[i] + b1[i] + bon * vv[4 + i]) * gacc[4 + i]; }
      u32x4 pk; pk.x = cvt_pk_bf16(o[0], o[1]); pk.y = cvt_pk_bf16(o[2], o[3]); pk.z = cvt_pk_bf16(o[4], o[5]); pk.w = cvt_pk_bf16(o[6], o[7]);
      if (DBGZ & 1) pk = (u32x4){0u, 0u, 0u, 0u};
      *(u32x4*)(PA + row * A_COLS + cc) = pk;
      u32x4 pb4 = *(const u32x4*)(PB + row * 1024 + cc); if (DBGZ & 2) pb4 = (u32x4){0u, 0u, 0u, 0u};
      *(u32x4*)(PA + row * A_COLS + 512 + cc) = pb4;
    }
  }
}

DI unsigned hashu(unsigned x) { x ^= x >> 16; x *= 0x7feb352du; x ^= x >> 15; x *= 0x846ca68bu; x ^= x >> 16; return x; }
DI void dbg_upd(float* slot, float got, float ref, float scale) { float e = fabsf(got - ref) / scale; if (!(e == e)) e = 1e9f; atomicMax((unsigned*)slot, __float_as_uint(e)); }
DI float tshift(const u16* PA, size_t row, int col, const float* mu) {
  const int t = (int)(row % T);
  const float c = bf2f(PA[row * A_COLS + col]);
  const float pv = t > 0 ? bf2f(PA[(row - 1) * A_COLS + col]) : 0.f, nx = t < T - 1 ? bf2f(PA[(row + 1) * A_COLS + col]) : 0.f;
  return c + mu[col] * (pv - c) + mu[A_COLS + col] * (nx - c);
}
DI void chk_proj(const u16* XB, const float* win, const u16* PA, const u16* PB, const u16* VT, float* slot) {
  const int gt = blockIdx.x * NTHREADS + threadIdx.x;
  if (gt >= 4096) return;
  const int row = hashu(gt * 2 + 1) % NT, col = hashu(gt * 2 + 2) % P_COLS;
  float ref = 0.f;
  for (int k = 0; k < D; ++k) ref += bf2f(XB[(size_t)row * D + k]) * win[(size_t)k * P_COLS + col];
  float got;
  if (col < A_COLS) got = bf2f(PA[(size_t)row * A_COLS + col]);
  else if (col < A_COLS + 1024) got = bf2f(PB[(size_t)row * 1024 + col - A_COLS]);
  else { const int c2 = col - A_COLS - 1024, h = c2 >> 7, e = c2 & 127, sq = row / T, t = row % T; got = bf2f(VT[((size_t)((sq * 4 + h) * 128 + e)) * T + t]); }
  dbg_upd(slot, got, ref, 1.f);
}
DI void chk_ffn(const u16* XB, const float* wup, const float* cw, const float* cb, const u16* G, float* slot) {
  const int gt = blockIdx.x * NTHREADS + threadIdx.x;
  if (gt >= 4096) return;
  int row = hashu(gt * 2 + 11) % NT; const int n = hashu(gt * 2 + 12) % DFF;
  if (gt < 64) row = (gt & 1) ? (row / T) * T + T - 1 : (row / T) * T;
  else if (gt < 1024) row = (row / T) * T + ((row % T) / 254) * 254 + (gt & 1 ? 253 : 0), row = row >= NT ? NT - 1 : row;
  const int t = row % T;
  float hg[3] = {0.f, 0.f, 0.f}, hu[3] = {0.f, 0.f, 0.f};
#pragma unroll
  for (int d = -1; d <= 1; ++d) {
    float a = 0.f, b = 0.f;
    if (!(t + d < 0 || t + d > T - 1))
      for (int k = 0; k < D; ++k) { const float x = bf2f(XB[(size_t)(row + d) * D + k]); a += x * wup[(size_t)k * NUP + n]; b += x * wup[(size_t)k * NUP + DFF + n]; }
    hg[d + 1] = a; hu[d + 1] = b;
  }
  const float got = bf2f(G[(size_t)row * DFF + n]);
  { const float g = cw[n] * hg[0] + cw[NUP + n] * hg[1] + cw[2 * NUP + n] * hg[2] + cb[n];
    const float u = cw[DFF + n] * hu[0] + cw[NUP + DFF + n] * hu[1] + cw[2 * NUP + DFF + n] * hu[2] + cb[DFF + n];
    dbg_upd(slot, got, 0.5f * g * (1.f + erff(g * 0.70710678f)) * u, 1.f); }
  { const float g = cw[n] * hg[2] + cw[NUP + n] * hg[1] + cw[2 * NUP + n] * hg[0] + cb[n];
    const float u = cw[DFF + n] * hu[2] + cw[NUP + DFF + n] * hu[1] + cw[2 * NUP + DFF + n] * hu[0] + cb[DFF + n];
    dbg_upd(slot + 1, got, 0.5f * g * (1.f + erff(g * 0.70710678f)) * u, 1.f); }
  { const float g = cw[NUP + n] * hg[1] + cb[n];
    const float u = cw[NUP + DFF + n] * hu[1] + cb[DFF + n];
    dbg_upd(slot + 2, got, 0.5f * g * (1.f + erff(g * 0.70710678f)) * u, 1.f); }
}
DI void chk_attn(LAS unsigned char* lds, const u16* XB, const float* win, const u16* PB, const u16* VT, const float* lamp, const float* subg, const float* relb, int layer, float* slot) {
  if (blockIdx.x >= 16) return;
  const int tid = threadIdx.x;
  LAS float* qv = (LAS float*)lds;
  LAS float* sc = qv + 128;
  LAS float* red = sc + 16384;
  LAS float* ov = red + 1024;
  const int smp = blockIdx.x;
  const int sq = hashu(smp + 77) % NSEQ, h = smp & 3;
  int q = hashu(smp + 99) % T; if (smp < 4) q = smp * 37; if (smp >= 12) q = T - 1 - (smp - 12) * 50;
  const size_t row = (size_t)sq * T + q;
  __syncthreads();
  if (tid < 128) { float a = 0.f; const int col = A_COLS + h * 128 + tid; for (int k = 0; k < D; ++k) a += bf2f(XB[row * D + k]) * win[(size_t)k * P_COLS + col]; qv[tid] = a; }
  __syncthreads();
  float mx0 = -1e30f, mx1 = -1e30f;
  for (int key = tid; key < T; key += NTHREADS) {
    const u16* kp = PB + ((size_t)sq * T + key) * 1024 + 512 + h * 128;
    float s0 = 0.f, s1 = 0.f;
    for (int d = 0; d < 64; ++d) { s0 += qv[d] * bf2f(kp[d]); s1 += qv[64 + d] * bf2f(kp[64 + d]); }
    const int rel = key - q, n = rel < 0 ? -rel : rel;
    int bk;
    if (n < 8) bk = n; else { bk = 8 + (int)(logf((float)n / 8.f) / logf(16.f) * 8.f); bk = bk > 15 ? 15 : bk; }
    if (rel > 0) bk += 16;
    const float bias = relb[bk * 4 + h];
    s0 = s0 * 0.125f + bias; s1 = s1 * 0.125f + bias;
    sc[key] = s0; sc[8192 + key] = s1; mx0 = fmaxf(mx0, s0); mx1 = fmaxf(mx1, s1);
  }
  red[tid] = mx0; red[512 + tid] = mx1; __syncthreads();
  for (int o = 256; o > 0; o >>= 1) { if (tid < o) { red[tid] = fmaxf(red[tid], red[tid + o]); red[512 + tid] = fmaxf(red[512 + tid], red[512 + tid + o]); } __syncthreads(); }
  mx0 = red[0]; mx1 = red[512]; __syncthreads();
  float l0 = 0.f, l1 = 0.f;
  for (int key = tid; key < T; key += NTHREADS) { const float p0 = expf(sc[key] - mx0), p1 = expf(sc[8192 + key] - mx1); sc[key] = p0; sc[8192 + key] = p1; l0 += p0; l1 += p1; }
  red[tid] = l0; red[512 + tid] = l1; __syncthreads();
  for (int o = 256; o > 0; o >>= 1) { if (tid < o) { red[tid] += red[tid + o]; red[512 + tid] += red[512 + tid + o]; } __syncthreads(); }
  l0 = red[0]; l1 = red[512]; __syncthreads();
  float la = 0.f, lb = 0.f; for (int d = 0; d < 64; ++d) { la += lamp[d] * lamp[64 + d]; lb += lamp[128 + d] * lamp[192 + d]; }
  const float lam_init = 0.8f - 0.6f * expf(-0.3f * (float)layer);
  const float lam = expf(la) - expf(lb) + lam_init;
  { const int e = tid & 127, part = tid >> 7;
    const u16* vp = VT + ((size_t)((sq * 4 + h) * 128 + e)) * T;
    float o = 0.f;
    for (int key = part * 2048; key < (part + 1) * 2048; ++key) o += (sc[key] / l0 - lam * sc[8192 + key] / l1) * bf2f(vp[key]);
    red[tid] = o; }
  __syncthreads();
  if (tid < 128) ov[tid] = red[tid] + red[128 + tid] + red[256 + tid] + red[384 + tid];
  __syncthreads();
  if (tid < 128) {
    float ss = 0.f; for (int e = 0; e < 128; ++e) ss += ov[e] * ov[e];
    const float ref = ov[tid] * rsqrtf(ss / 128.f + LN_EPS) * subg[tid] * (1.f - lam_init);
    dbg_upd(slot, bf2f(PB[row * 1024 + h * 128 + tid]), ref, 1.f);
  }
}
struct ChkOp { float r, kd, kk, b, w, v; };
DI ChkOp chk_ops(const u16* PA, const u16* VV, const ScanW& w, size_t row, int h, int dir, int c, LAS float* tmp  , int tid) {
  ChkOp o;
  const int cg_ = h * 64 + c;
  o.r = tshift(PA, row, cg_, w.mu);
  const float k = tshift(PA, row, OFF_K + cg_, w.mu);
  float wl = w.w0[dir * 512 + cg_], al = w.a0[dir * 512 + cg_];
#pragma unroll 1
  for (int rr = 0; rr < 32; ++rr) {
    wl += tanhf(tshift(PA, row, OFF_WD + dir * 32 + rr, w.mu)) * w.du[(dir * 32 + rr) * 512 + cg_];
    al += tshift(PA, row, OFF_AD + dir * 32 + rr, w.mu) * w.iu[(dir * 32 + rr) * 512 + cg_];
  }
  const float sp = logf(1.f + expf(-wl));
  o.w = expf(-expf(-sp - 0.5f));
  const float a = 1.f / (1.f + expf(-al));
  const float kkv = k * w.kk_[cg_];
  __syncthreads(); tmp[tid] = kkv * kkv; __syncthreads();
  float ss = 0.f;
#pragma unroll 1
  for (int j = 0; j < 64; ++j) ss += tmp[j];
  o.kk = kkv * rsqrtf(ss + 1e-12f);
  o.kd = k * (1.f + (a - 1.f) * w.ka[cg_]);
  o.b = o.kk * a;
  o.v = bf2f(VV[row * 512 + cg_]);
  return o;
}
DI void chk_scan(LAS unsigned char* lds, const u16* PA, const u16* VV, const u16* YY, const float* BON, const ScanW w, float* slot) {
  if (blockIdx.x >= 48 || threadIdx.x >= 64) return;
  const int tid = threadIdx.x;
  LAS float* tmp = (LAS float*)lds; LAS float* red = tmp + 64;
  const int item = blockIdx.x * 4 + 1, dir = item & 1, h = (item >> 1) & 7, sq = item >> 4;
  const int t0 = dir == 0 ? 0 : T - 1, t1 = dir == 0 ? 1 : T - 2;
  const size_t row0 = (size_t)sq * T + t0, row1 = (size_t)sq * T + t1;
  const ChkOp a = chk_ops(PA, VV, w, row0, h, dir, tid, tmp, tid);
  const ChkOp b = chk_ops(PA, VV, w, row1, h, dir, tid, tmp, tid);
#define BSUM(dst, val) { __syncthreads(); red[tid] = (val); __syncthreads(); float sx_ = 0.f; _Pragma("unroll 1") for (int j_ = 0; j_ < 64; ++j_) sx_ += red[j_]; dst = sx_; }
  float ds0, ds1, ds2, ds3, ds4;
  BSUM(ds0, a.kd * a.r) BSUM(ds1, a.kd * b.w * b.r) BSUM(ds2, a.kd * (-b.kk)) BSUM(ds3, b.b * b.r) BSUM(ds4, b.kd * b.r)
  const float y0 = a.v * ds0;
  const float y1 = a.v * (ds1 + ds2 * ds3) + b.v * ds4;
  dbg_upd(slot, bf2f(YY[((size_t)dir * NT + row0) * 512 + h * 64 + tid]), y0, fabsf(y0) + 0.05f);
  dbg_upd(slot, bf2f(YY[((size_t)dir * NT + row1) * 512 + h * 64 + tid]), y1, fabsf(y1) + 0.05f);
  float bq = a.r * a.kd * w.rk[h * 64 + tid];
  __syncthreads(); red[tid] = bq; __syncthreads(); float bs = 0.f;
#pragma unroll 1
  for (int j = 0; j < 64; ++j) bs += red[j];
  dbg_upd(slot, BON[((size_t)dir * NT + row0) * 8 + h], bs, fabsf(bs) + 0.05f);
}
DI void chk_post(const u16* PA, const u16* PB, const u16* VV, const u16* YY, const float* BON, const float* mu, const float* gup, const float* gng, const float* gnb, float* slot) {
  const int gt = blockIdx.x * NTHREADS + threadIdx.x;
  if (gt >= 2048) return;
  const size_t row = hashu(gt * 2 + 21) % NT; const int c = hashu(gt * 2 + 22) % 512, h = c >> 6;
  float sm = 0.f;
  float yc = 0.f;
  for (int i = 0; i < 64; ++i) { const float y = bf2f(YY[row * 512 + h * 64 + i]) + bf2f(YY[((size_t)NT + row) * 512 + h * 64 + i]); sm += y; if (h * 64 + i == c) yc = y; }
  const float mean = sm / 64.f; float vq = 0.f;
  for (int i = 0; i < 64; ++i) { const float y = bf2f(YY[row * 512 + h * 64 + i]) + bf2f(YY[((size_t)NT + row) * 512 + h * 64 + i]) - mean; vq += y * y; }
  const float yn = (yc - mean) * rsqrtf(vq / 64.f + GN_EPS) * gng[c] + gnb[c];
  const float bon = (BON[row * 8 + h] + BON[((size_t)NT + row) * 8 + h]) * bf2f(VV[row * 512 + c]);
  float g = 0.f;
  for (int r = 0; r < 96; ++r) g += (1.f / (1.f + expf(-tshift(PA, row, OFF_GD + r, mu)))) * gup[r * 512 + c];
  const float ref = (yn + bon) * g;
  dbg_upd(slot, bf2f(PA[row * A_COLS + c]), ref, fabsf(ref) + 0.05f);
  dbg_upd(slot + 1, bf2f(PA[row * A_COLS + 512 + c]), bf2f(PB[row * 1024 + c]), 1.f);
}

#define XB_TMO      128
#define XB_XCNT(j)  (256  + 64 * (j))
#define XB_XSUB(j)  (1280 + 64 * (j))
#define XB_XGEN(j)  (2304 + 64 * (j))
#define XB_TOP      3328
#define XB_TOPGEN   3392
#define XCD_BAR_WORDS 3456
#define XB_SPIN_CAP (1u << 18)
DI unsigned xb_ld(unsigned* p)              { return __hip_atomic_load(p, __ATOMIC_RELAXED, __HIP_MEMORY_SCOPE_AGENT); }
DI unsigned xb_add(unsigned* p, unsigned v) { return __hip_atomic_fetch_add(p, v, __ATOMIC_RELAXED, __HIP_MEMORY_SCOPE_AGENT); }
DI unsigned xb_xcc_id() { return (unsigned)__builtin_amdgcn_s_getreg((3 << 11) | 20) & 0xFu; }
#define XB_SPIN(cond, bar) do { unsigned _sp = 0; while (cond) { __builtin_amdgcn_s_sleep(1); \
    if ((++_sp & 255u) == 0u) { if (xb_ld(&(bar)[XB_TMO])) break; if (_sp > XB_SPIN_CAP) { atomicAdd(&(bar)[XB_TMO], 1u); break; } } } } while (0)
DI void xcd_census(unsigned* bar, unsigned* st) {
  if (threadIdx.x == 0) {
    const unsigned x = xb_xcc_id();
    unsigned cnt = 0u, mine = 0u;
#pragma unroll
    for (unsigned j = 0; j < 16; ++j) { const unsigned c = xb_ld(&bar[XB_XCNT(j)]); cnt += (c > 0u) ? 1u : 0u; mine = (j == x) ? c : mine; }
    st[0] = mine > 0u ? mine : 1u; st[1] = cnt > 0u ? cnt : 1u;
  }
}
DI void xcd_barrier(unsigned* bar, unsigned* st) {
  asm volatile("s_waitcnt vmcnt(0)" ::: "memory");
  __syncthreads();
  if (threadIdx.x == 0) {
    __builtin_amdgcn_s_waitcnt(0);
    const unsigned x = xb_xcc_id();
    const unsigned nloc = st[0], nx = st[1];
    const unsigned old = xb_add(&bar[XB_XSUB(x)], 1u);
    const unsigned gen = old / nloc;
    if (old + 1u == (gen + 1u) * nloc) {
      __builtin_amdgcn_fence(__ATOMIC_RELEASE, "agent");
      asm volatile("s_waitcnt vmcnt(0)" ::: "memory");
      const unsigned og = xb_add(&bar[XB_TOP], 1u);
      const unsigned tg = og / nx;
      if (og + 1u == (tg + 1u) * nx) xb_add(&bar[XB_TOPGEN], 1u);
      else XB_SPIN(xb_ld(&bar[XB_TOPGEN]) == tg, bar);
      __builtin_amdgcn_fence(__ATOMIC_ACQUIRE, "agent");
      xb_add(&bar[XB_XGEN(x)], 1u);
      asm volatile("s_waitcnt vmcnt(0)" ::: "memory");
    } else {
      XB_SPIN(xb_ld(&bar[XB_XGEN(x)]) == gen, bar);
      __builtin_amdgcn_fence(__ATOMIC_ACQUIRE, "agent");
      asm volatile("s_waitcnt vmcnt(0)" ::: "memory");
    }
  }
  __syncthreads();
}

__global__ __launch_bounds__(NTHREADS, 2) void mega(Params p_unused) {
  extern __shared__ __attribute__((aligned(16))) char shm[];
  cg::grid_group grid = cg::this_grid();
  LAS unsigned char* lds = (LAS unsigned char*)shm;
#define WS_PTRS CParams p = get_params(); unsigned char* ws = p->ws; \
  u16* WIN = (u16*)(ws + OFF_WIN); u16* WOUT = (u16*)(ws + OFF_WOUT); u16* WUP = (u16*)(ws + OFF_WUP); u16* WDN = (u16*)(ws + OFF_WDN); \
  u16* XB = (u16*)(ws + OFF_XB); u16* PA = (u16*)(ws + OFF_PA); u16* PB = (u16*)(ws + OFF_PB); u16* VT = (u16*)(ws + OFF_VT); \
  u16* G = (u16*)(ws + OFF_PA); u16* VV = (u16*)(ws + OFF_VV); u16* YY = (u16*)p->out; float* BON = (float*)(ws + OFF_BON); float* XF = p->out; \
  (void)WIN; (void)WOUT; (void)WUP; (void)WDN; (void)XB; (void)PA; (void)PB; (void)VT; (void)G; (void)VV; (void)YY; (void)BON; (void)XF;
  int ph = 0;
  const int ph_lo = get_params()->ph_lo, ph_hi = get_params()->ph_hi;
  const bool fullrun = (ph_lo == 0 && ph_hi >= 1000);
  if (fullrun && threadIdx.x == 0) (void)xb_add((unsigned*)(get_params()->ws + OFF_XBAR) + XB_XCNT(xb_xcc_id()), 1u);
#define GSYNC() do { if (!fullrun || ph == 1) { grid.sync(); if (fullrun) xcd_census((unsigned*)(get_params()->ws + OFF_XBAR), (unsigned*)(get_params()->ws + OFF_XBAR) + XCD_BAR_WORDS + 2 * blockIdx.x); } \
    else xcd_barrier((unsigned*)(get_params()->ws + OFF_XBAR), (unsigned*)(get_params()->ws + OFF_XBAR) + XCD_BAR_WORDS + 2 * blockIdx.x); } while (0)
#ifndef ONLYMASK
#define ONLYMASK 0xffffffffu
#endif
#define PHASE_BEGIN if (((ONLYMASK >> (__COUNTER__ % 32)) & 1u) && ph >= ph_lo && ph < ph_hi) { WS_PTRS
#define PHASE_END } ++ph; if (ph > ph_lo && ph < ph_hi) GSYNC();

  PHASE_BEGIN
    for (int l = 0; l < 2; ++l) {
      convert_weight<0>(shm, p->in[4] + (size_t)l * D * P_COLS, WIN + (size_t)l * NPROJ * D, D, P_COLS, NPROJ, blockIdx.x, gridDim.x);
      convert_weight<1>(shm, p->in[22] + (size_t)l * D * D, WOUT + (size_t)l * D * D, D, D, D, blockIdx.x, gridDim.x);
      convert_weight<2>(shm, p->in[25] + (size_t)l * D * NUP, WUP + (size_t)l * NUP * D, D, NUP, NUP, blockIdx.x, gridDim.x);
      convert_weight<1>(shm, p->in[28] + (size_t)l * DFF * D, WDN + (size_t)l * D * DFF, DFF, D, D, blockIdx.x, gridDim.x);
    }
    ln_rows(p->in[0], p->in[1], NPROMPT_TOK, XF, XB, p->in[2], p->in[3], false, true);
  PHASE_END

#pragma unroll 1
  for (int l = 0; l < 2; ++l) {
    PHASE_BEGIN
      Gemm ga{XB, D, WIN + (size_t)l * NPROJ * D, D};
      EpiArgs ea{}; ea.pa = PA; ea.pb = PB; ea.vt = VT;
      gemm_phase<0, 0>(lds, ga, NT / 256, NPROJ / 256, ea);
#if PROBE_GEMM
      gemm_phase<0, 0>(lds, ga, NT / 256, NPROJ / 256, ea);
#endif
    PHASE_END
#pragma unroll 1
    for (int rnd = 0; rnd < 2; ++rnd) {
      if (ph >= ph_lo && ph < ph_hi) { WS_PTRS
        int bidu = blockIdx.x, gdu = gridDim.x; asm volatile("" : "+s"(bidu), "+s"(gdu));
        const bool split = (gdu == 256);
        if (rnd == 0) vprep_phase(lds, PA, VV, p->in[5] + (size_t)l * 2 * A_COLS, p->in[16], p->in[17], p->in[18], l);
        if (rnd == 1 && (!split || bidu < 192)) {
          ScanW sw; sw.mu = p->in[5] + (size_t)l * 2 * A_COLS; sw.w0 = p->in[6] + l * 1024; sw.du = p->in[7] + (size_t)l * 2 * 32 * 512; sw.a0 = p->in[8] + l * 1024;
          sw.iu = p->in[9] + (size_t)l * 2 * 32 * 512; sw.kk_ = p->in[11] + l * 512; sw.ka = p->in[12] + l * 512; sw.rk = p->in[13] + l * 512;
          scan_phase(lds, PA, VV, YY, BON, sw);
        } else if (rnd == 0 || split) {
          const int plo = rnd == 0 ? 0 : 40, phi = (rnd == 0 && split) ? 40 : 48;
          const int wlo = rnd == 0 ? 0 : 192, wcnt = rnd == 0 ? (gdu & ~7) : 64;
          attn_phase(lds, PB, VT, (float*)(ws + OFF_OSV), p->in[19] + l * 256, p->in[20] + l * 128, p->in[21], l, plo, phi, wlo, wcnt);
        }
      }
      ++ph; if (ph > ph_lo && ph < ph_hi) GSYNC();
    }
    PHASE_BEGIN
      post_phase(lds, PA, PB, VV, YY, BON, p->in[5] + (size_t)l * 2 * A_COLS, p->in[10] + (size_t)l * 96 * 512, p->in[14] + l * 512, p->in[15] + l * 512);
#if PROBE_MISC
      post_phase(lds, PA, PB, VV, YY, BON, p->in[5] + (size_t)l * 2 * A_COLS, p->in[10] + (size_t)l * 96 * 512, p->in[14] + l * 512, p->in[15] + l * 512);
#endif
    PHASE_END
    PHASE_BEGIN
      Gemm ga{PA, A_COLS, WOUT + (size_t)l * D * D, D};
      EpiArgs ea{}; ea.xf = XF; ea.xb = XB;
      gemm_phase<1, 0>(lds, ga, NT / 256, D / 256, ea);
    PHASE_END
    PHASE_BEGIN
      ln_rows_bf16(XB, p->in[23] + l * D, p->in[24] + l * D);
    PHASE_END
    PHASE_BEGIN
      Gemm ga{XB, D, WUP + (size_t)l * NUP * D, D};
      EpiArgs ea{}; ea.g = G; ea.cw = p->in[26] + (size_t)l * 3 * NUP; ea.cb = p->in[27] + (size_t)l * NUP;
      gemm_phase<2, 1>(lds, ga, NSEQ * 33, NUP / 256, ea);
#if PROBE_GEMM
      gemm_phase<2, 1>(lds, ga, NSEQ * 33, NUP / 256, ea);
#endif
    PHASE_END
    PHASE_BEGIN
      Gemm ga{G, DFF, WDN + (size_t)l * D * DFF, DFF};
      EpiArgs ea{}; ea.xf = XF; ea.xb = XB; ea.pre_f32 = (l == 1) ? 1 : 0;
      gemm_phase<1, 0>(lds, ga, NT / 256, D / 256, ea);
    PHASE_END
    PHASE_BEGIN
      if (l == 1) ln_rows(XF, XF, NT, XF, XB, p->in[29] + l * D, p->in[30] + l * D, true, false);
      else ln_rows_bf16(XB, p->in[29] + l * D, p->in[30] + l * D);
    PHASE_END
  }
}

#if DBG
#define DPTRS unsigned char* ws = p.ws; u16* XB = (u16*)(ws + OFF_XB); u16* PA = (u16*)(ws + OFF_PA); u16* PB = (u16*)(ws + OFF_PB); u16* VT = (u16*)(ws + OFF_VT); \
  u16* G = (u16*)(ws + OFF_PA); u16* VV = (u16*)(ws + OFF_VV); u16* YY = (u16*)(ws + OFF_XB); float* BON = (float*)(ws + OFF_BON); float* DE = (float*)(ws + OFF_DBG); \
  (void)XB; (void)PA; (void)PB; (void)VT; (void)G; (void)VV; (void)YY; (void)BON; (void)DE;
template <int which> __global__ __launch_bounds__(NTHREADS) void k_chk(Params p, int l) {
  extern __shared__ __attribute__((aligned(16))) char shm[];
  LAS unsigned char* lds = (LAS unsigned char*)shm;
  DPTRS
  if (which == 0) chk_proj(XB, p.in[4] + (size_t)l * D * P_COLS, PA, PB, VT, DE + 0);
  else if (which == 1) chk_attn(lds, XB, p.in[4] + (size_t)l * D * P_COLS, PB, VT, p.in[19] + l * 256, p.in[20] + l * 128, p.in[21], l, DE + 1);
  else if (which == 2) {
    ScanW sw; sw.mu = p.in[5] + (size_t)l * 2 * A_COLS; sw.w0 = p.in[6] + l * 1024; sw.du = p.in[7] + (size_t)l * 2 * 32 * 512; sw.a0 = p.in[8] + l * 1024;
    sw.iu = p.in[9] + (size_t)l * 2 * 32 * 512; sw.kk_ = p.in[11] + l * 512; sw.ka = p.in[12] + l * 512; sw.rk = p.in[13] + l * 512;
    chk_scan(lds, PA, VV, YY, BON, sw, DE + 2);
  } else if (which == 3) chk_post(PA, PB, VV, YY, BON, p.in[5] + (size_t)l * 2 * A_COLS, p.in[10] + (size_t)l * 96 * 512, p.in[14] + l * 512, p.in[15] + l * 512, DE + 3);
  else if (which == 5) chk_ffn(XB, p.in[25] + (size_t)l * D * NUP, p.in[26] + (size_t)l * 3 * NUP, p.in[27] + (size_t)l * NUP, G, DE + 5);
}
__global__ __launch_bounds__(NTHREADS) void k_encode(Params p) {
  const float* e = (const float*)(p.ws + OFF_DBG);
  const float eA = fmaxf(e[DBG_A], 1e-4f), eB = fmaxf(e[DBG_B], 1e-4f);
  const float V1 = 100.f + 100.f * log10f(eA / 1e-3f);
  float V2 = 1.f + log10f(eB / 1e-3f); V2 = fminf(fmaxf(V2, 0.3f), 8.f);
  const size_t n0 = (size_t)NPROMPT_TOK * D, n1 = (size_t)NT * D;
  for (size_t i = (size_t)blockIdx.x * NTHREADS + threadIdx.x; i < n1; i += (size_t)gridDim.x * NTHREADS) {
    float v = 0.f;
    if (i == 0 || i == n0) v = V1;
    else if (i < n0 / 2 || (i > n0 && i < n0 + (n1 - n0) / 2)) v = V2;
    p.out[i] = v;
  }
}
#endif

extern "C" void kernel_launch(void* const* d_in, const int* in_sizes, int n_in, void* d_out, int out_size, void* d_ws, size_t ws_size, hipStream_t stream) {
  static int grid = 0;
  if (grid == 0) {
    if (ws_size < WS_END) { fprintf(stderr, "ws too small: %zu < %zu\n", ws_size, (size_t)WS_END); grid = -1; return; }
    int dev = 0, cus = 0, per_cu = 0;
    hipGetDevice(&dev);
    hipDeviceGetAttribute(&cus, hipDeviceAttributeMultiprocessorCount, dev);
    hipFuncSetAttribute((const void*)mega, hipFuncAttributeMaxDynamicSharedMemorySize, LDS_BYTES);
#if DBG
    hipFuncSetAttribute((const void*)k_chk<1>, hipFuncAttributeMaxDynamicSharedMemorySize, 81920);
    hipFuncSetAttribute((const void*)k_chk<2>, hipFuncAttributeMaxDynamicSharedMemorySize, 81920);
#endif
    hipOccupancyMaxActiveBlocksPerMultiprocessor(&per_cu, (const void*)mega, NTHREADS, LDS_BYTES);
    if (per_cu < 1) per_cu = 1;
    grid = cus * 1;
  }
  if (grid < 0) return;
  Params p{};
  for (int i = 0; i < 31; ++i) p.in[i] = (const float*)d_in[i];
  p.out = (float*)d_out; p.ws = (unsigned char*)d_ws;
#if DBG
  hipMemsetAsync((char*)d_ws + OFF_DBG, 0, 256, stream);
  auto seg = [&](int lo, int hi) { Params q = p; q.ph_lo = lo; q.ph_hi = hi; void* a2[] = {&q};
    hipError_t e = hipLaunchCooperativeKernel((const void*)mega, dim3(grid), dim3(NTHREADS), a2, LDS_BYTES, stream);
    if (e != hipSuccess) fprintf(stderr, "cooperative launch failed: %s\n", hipGetErrorString(e)); };
  auto chk = [&](int l, int which) {
    if (which == 0) hipLaunchKernelGGL(k_chk<0>, dim3(64), dim3(NTHREADS), 81920, stream, p, l);
    if (which == 1) hipLaunchKernelGGL(k_chk<1>, dim3(64), dim3(NTHREADS), 81920, stream, p, l);
    if (which == 2) hipLaunchKernelGGL(k_chk<2>, dim3(64), dim3(NTHREADS), 81920, stream, p, l);
    if (which == 3) hipLaunchKernelGGL(k_chk<3>, dim3(64), dim3(NTHREADS), 81920, stream, p, l);
    if (which == 5) hipLaunchKernelGGL(k_chk<5>, dim3(64), dim3(NTHREADS), 81920, stream, p, l); };
  seg(0, 1);
  for (int l = 0; l < 2; ++l) {
    const int b = 1 + 9 * l;
    seg(b, b + 1); chk(l, 0);
    seg(b + 1, b + 2); chk(l, 1);
    seg(b + 2, b + 3); chk(l, 2);
    seg(b + 3, b + 4); chk(l, 3);
    seg(b + 4, b + 7); if (l == 0) chk(l, 5);
    seg(b + 7, b + 9);
  }
  hipLaunchKernelGGL(k_encode, dim3(1024), dim3(NTHREADS), 0, stream, p);
#else
  hipMemsetAsync((char*)d_ws + OFF_XBAR, 0, XBAR_BYTES, stream);
  p.ph_lo = 0; p.ph_hi = 1000;
  void* args[] = {&p};
  hipError_t e = hipLaunchCooperativeKernel((const void*)mega, dim3(grid), dim3(NTHREADS), args, LDS_BYTES, stream);
  if (e != hipSuccess) fprintf(stderr, "cooperative launch failed: %s (grid %d)\n", hipGetErrorString(e), grid);
#endif
}
```

```cpp
#include <hip/hip_runtime.h>
#include <hip/hip_bf16.h>
#include <hip/hip_cooperative_groups.h>
#include <cstdio>
namespace cg = cooperative_groups;

#define DI __device__ __forceinline__
using bf16 = __hip_bfloat16;
using bf16x8 = __attribute__((ext_vector_type(8))) short;
using s16x4 = __attribute__((ext_vector_type(4))) short;
using f32x4 = __attribute__((ext_vector_type(4))) float;
using f32x16 = __attribute__((ext_vector_type(16))) float;
typedef unsigned short u16;
typedef __bf16 bf2 __attribute__((ext_vector_type(2)));
typedef unsigned u32x4 __attribute__((ext_vector_type(4)));
typedef unsigned u32x2 __attribute__((ext_vector_type(2)));

constexpr int D = 1024, T = 8192, NSEQ = 12, NT = NSEQ * T;
constexpr int NPROMPT_TOK = 4 * T;
constexpr int A_COLS = 1760, P_COLS = 3296, NPROJ = 3328;
constexpr int DFF = 2816, NUP = 5632;
constexpr int OFF_K = 512, OFF_V = 1024, OFF_WD = 1536, OFF_AD = 1600, OFF_GD = 1664;
constexpr float ALPHA = 1.4142135623730951f;
constexpr float LN_EPS = 1e-5f, GN_EPS = 64e-5f;
constexpr int NTHREADS = 512;
#ifndef DBGZ
#define DBGZ 0
#define DBG 0
#define PROBE_SCAN 0
#define PROBE_GEMM 0
#define PROBE_MISC 0
#ifndef CHK_PROJ_ON
#define CHK_PROJ_ON 1
#endif
#ifndef CHK_ATTN_ON
#define CHK_ATTN_ON 1
#endif
#ifndef CHK_SCAN_ON
#define CHK_SCAN_ON 1
#endif
#ifndef CHK_POST_ON
#define CHK_POST_ON 1
#endif
#ifndef CHK_FFN_ON
#define CHK_FFN_ON 1
#endif
#define DBG_A 5
#define DBG_B 6
#define DBGTHR 0.05f, 0.1f, 0.1f, 0.1f, 0.01f, 0.05f
#endif
constexpr int LDS_BYTES = 163840;

constexpr size_t SZ_WIN = (size_t)2 * NPROJ * D * 2;
constexpr size_t SZ_WOUT = (size_t)2 * D * D * 2;
constexpr size_t SZ_WUP = (size_t)2 * NUP * D * 2;
constexpr size_t SZ_WDN = (size_t)2 * D * DFF * 2;
constexpr size_t OFF_WIN = 0;
constexpr size_t OFF_WOUT = OFF_WIN + SZ_WIN;
constexpr size_t OFF_WUP = OFF_WOUT + SZ_WOUT;
constexpr size_t OFF_WDN = OFF_WUP + SZ_WUP;
constexpr size_t OFF_XB = OFF_WDN + SZ_WDN;
constexpr size_t OFF_PA = OFF_XB + (size_t)NT * D * 2;
constexpr size_t OFF_PB = OFF_PA + (size_t)NT * A_COLS * 2;
constexpr size_t OFF_VT = OFF_PB + (size_t)NT * 1024 * 2;
constexpr size_t OFF_VV = OFF_VT + (size_t)NT * 512 * 2;
constexpr size_t OFF_BON = OFF_VV + (size_t)NT * 512 * 2;
constexpr size_t OFF_OSV = OFF_BON + (size_t)2 * NT * 8 * 4;
constexpr size_t OFF_DBG = OFF_OSV + (size_t)256 * 64 * 512 * 4;
constexpr size_t OFF_XBAR = OFF_DBG + 256;
constexpr size_t XBAR_BYTES = 3456 * 4 + 256 * 8;
constexpr size_t WS_END = OFF_XBAR + XBAR_BYTES;
static_assert((size_t)NT * DFF * 2 <= (OFF_VV - OFF_PA), "G alias");

struct Params {
  const float* in[31];
  float* out;
  unsigned char* ws;
  int ph_lo, ph_hi;
};

typedef const __attribute__((address_space(4))) Params* CParams;
DI CParams get_params() { CParams pp = (CParams)__builtin_amdgcn_kernarg_segment_ptr(); asm volatile("" : "+s"(pp)); return pp; }

DI u16 f2bf(float x) { unsigned u = __float_as_uint(x); u += 0x7fffu + ((u >> 16) & 1u); return (u16)(u >> 16); }
DI unsigned cvt_pk_bf16(float lo, float hi) { unsigned r; asm volatile("v_cvt_pk_bf16_f32 %0, %1, %2" : "=v"(r) : "v"(lo), "v"(hi)); return r; }
DI float bf2f(u16 b) { return __uint_as_float(((unsigned)b) << 16); }
DI float sigmoidf_(float x) { return 1.f / (1.f + __expf(-x)); }

template <int MODE> DI int src_col(int n) {
  if (MODE == 0) { return n < A_COLS ? n : (n < 1792 ? -1 : n - 32); }
  if (MODE == 2) { int j = n >> 8, i = n & 255; return i < 128 ? j * 128 + i : DFF + j * 128 + (i - 128); }
  return n;
}
template <int MODE>
DI void convert_weight(char* shm, const float* W, u16* WT, int K, int Nsrc, int Ndst, int gtid_block, int nblocks) {
  float* tile = (float*)shm;
  int tn = Ndst / 64, tk = K / 64;
  for (int t = gtid_block; t < tn * tk; t += nblocks) {
    int n0 = (t / tk) * 64, k0 = (t % tk) * 64;
    __syncthreads();
    for (int e = threadIdx.x; e < 4096; e += NTHREADS) {
      int kk = e >> 6, nn = e & 63;
      int sc = src_col<MODE>(n0 + nn);
      tile[kk * 65 + nn] = sc >= 0 ? W[(size_t)(k0 + kk) * Nsrc + sc] : 0.f;
    }
    __syncthreads();
    for (int e = threadIdx.x; e < 4096; e += NTHREADS) {
      int nn = e >> 6, kk = e & 63;
      WT[(size_t)(n0 + nn) * K + k0 + kk] = f2bf(tile[kk * 65 + nn]);
    }
  }
}

constexpr int LNR = 4;
DI void ln_rows(const float* srcA, const float* srcB, int splitRow, float* dstF, u16* dstB, const float* g, const float* b, bool writeF, bool writeB) {
  int tid = threadIdx.x; asm volatile("" : "+v"(tid));
  int bid = blockIdx.x, gdim = gridDim.x; asm volatile("" : "+s"(bid), "+s"(gdim));
  int wave = tid >> 6, lane = tid & 63;
  int gw = bid * 8 + wave, nw = gdim * 8;
  for (int base = gw * LNR; base < NT; base += nw * LNR) {
    f32x4 v[LNR][4]; float s[LNR], q[LNR];
#pragma unroll
    for (int r = 0; r < LNR; ++r) {
      const int row = base + r;
      const float* src = row < splitRow ? srcA + (size_t)row * D : srcB + (size_t)(row - splitRow) * D;
#pragma unroll
      for (int i = 0; i < 4; ++i) v[r][i] = *(const f32x4*)(src + i * 256 + lane * 4);
    }
#pragma unroll
    for (int r = 0; r < LNR; ++r) { s[r] = 0.f;
#pragma unroll
      for (int i = 0; i < 4; ++i) s[r] += (v[r][i][0] + v[r][i][1]) + (v[r][i][2] + v[r][i][3]); }
#pragma unroll
    for (int o = 32; o > 0; o >>= 1)
#pragma unroll
      for (int r = 0; r < LNR; ++r) s[r] += __shfl_xor(s[r], o);
#pragma unroll
    for (int r = 0; r < LNR; ++r) { const float mu = s[r] * (1.f / D); q[r] = 0.f;
#pragma unroll
      for (int i = 0; i < 4; ++i) { v[r][i] -= mu; const f32x4 t = v[r][i] * v[r][i]; q[r] += (t[0] + t[1]) + (t[2] + t[3]); } }
#pragma unroll
    for (int o = 32; o > 0; o >>= 1)
#pragma unroll
      for (int r = 0; r < LNR; ++r) q[r] += __shfl_xor(q[r], o);
#pragma unroll
    for (int i = 0; i < 4; ++i) {
      const f32x4 gg = *(const f32x4*)(g + i * 256 + lane * 4), bb = *(const f32x4*)(b + i * 256 + lane * 4);
#pragma unroll
      for (int r = 0; r < LNR; ++r) {
        const int row = base + r;
        const float rs = rsqrtf(q[r] * (1.f / D) + LN_EPS);
        const f32x4 o4 = v[r][i] * rs * gg + bb;
        if (writeF) *(f32x4*)(dstF + (size_t)row * D + i * 256 + lane * 4) = o4;
        if (writeB) { u32x2 h; h.x = cvt_pk_bf16(o4[0], o4[1]); h.y = cvt_pk_bf16(o4[2], o4[3]);
          *(u32x2*)(dstB + (size_t)row * D + i * 256 + lane * 4) = h; }
      }
    }
  }
}

DI void ln_rows_bf16(u16* xb, const float* g, const float* b) {
  int tid = threadIdx.x; asm volatile("" : "+v"(tid));
  int bid = blockIdx.x, gdim = gridDim.x; asm volatile("" : "+s"(bid), "+s"(gdim));
  int wave = tid >> 6, lane = tid & 63;
  int gw = bid * 8 + wave, nw = gdim * 8;
  for (int base = gw * LNR; base < NT; base += nw * LNR) {
    f32x4 v[LNR][4]; float s[LNR], q[LNR];
#pragma unroll
    for (int r = 0; r < LNR; ++r) {
      const u16* src = xb + (size_t)(base + r) * D;
#pragma unroll
      for (int i = 0; i < 4; ++i) { const u32x2 x2 = *(const u32x2*)(src + i * 256 + lane * 4);
        v[r][i][0] = __uint_as_float(x2.x << 16); v[r][i][1] = __uint_as_float(x2.x & 0xffff0000u); v[r][i][2] = __uint_as_float(x2.y << 16); v[r][i][3] = __uint_as_float(x2.y & 0xffff0000u); }
    }
#pragma unroll
    for (int r = 0; r < LNR; ++r) { s[r] = 0.f;
#pragma unroll
      for (int i = 0; i < 4; ++i) s[r] += (v[r][i][0] + v[r][i][1]) + (v[r][i][2] + v[r][i][3]); }
#pragma unroll
    for (int o = 32; o > 0; o >>= 1)
#pragma unroll
      for (int r = 0; r < LNR; ++r) s[r] += __shfl_xor(s[r], o);
#pragma unroll
    for (int r = 0; r < LNR; ++r) { const float mu = s[r] * (1.f / D); q[r] = 0.f;
#pragma unroll
      for (int i = 0; i < 4; ++i) { v[r][i] -= mu; const f32x4 t = v[r][i] * v[r][i]; q[r] += (t[0] + t[1]) + (t[2] + t[3]); } }
#pragma unroll
    for (int o = 32; o > 0; o >>= 1)
#pragma unroll
      for (int r = 0; r < LNR; ++r) q[r] += __shfl_xor(q[r], o);
#pragma unroll
    for (int i = 0; i < 4; ++i) {
      const f32x4 gg = *(const f32x4*)(g + i * 256 + lane * 4), bb = *(const f32x4*)(b + i * 256 + lane * 4);
#pragma unroll
      for (int r = 0; r < LNR; ++r) {
        const float rs = rsqrtf(q[r] * (1.f / D) + LN_EPS);
        const f32x4 o4 = v[r][i] * rs * gg + bb;
        u32x2 h; h.x = cvt_pk_bf16(o4[0], o4[1]); h.y = cvt_pk_bf16(o4[2], o4[3]);
        *(u32x2*)(xb + (size_t)(base + r) * D + i * 256 + lane * 4) = h;
      }
    }
  }
}

#define LAS __attribute__((address_space(3)))
constexpr int BK = 64, HALF = 128, HTB = HALF * BK * 2, STAGE_BYTES = 8 * HTB;
DI int lds_byte(int r, int c) { const int st = (r >> 4) * 2 + (c >> 5), rr = r & 15, cc = c & 31, ob = rr * 64 + cc * 2; return st * 1024 + (ob ^ (((ob >> 9) & 1) << 5)); }
DI void stage_rc(int b, int& R, int& C) { const int st = b / 1024, sb = b % 1024, swz = sb ^ (((sb >> 9) & 1) << 5); R = (st >> 1) * 16 + swz / 64; C = (st & 1) * 32 + (swz % 64) / 2; }
DI int perm32(int rho) { const int n = rho >> 4, i = rho & 15; return 8 * (i >> 2) + 4 * n + (i & 3); }

typedef float f32x2 __attribute__((ext_vector_type(2)));
DI float gelu1(float v) {
  const float av = __builtin_fabsf(v), d = av * 0.2316418882f + 1.0f;
  const float t = __builtin_amdgcn_rcpf(d);
  float q = t * 0.5307027145f + (-0.7265760135f); q = q * t + 0.7107068705f; q = q * t + (-0.142248368f); q = q * t + 0.127414796f; q = q * t;
  const float e = __builtin_amdgcn_exp2f((v * v) * (-0.72134752044f));
  const float m = v * (q * e), r = v - m;
  return v < 0.f ? m : r;
}
DI float dpp_shr1(float old, float src) { asm volatile("s_nop 1\n\tv_mov_b32_dpp %0, %1 row_shr:1 row_mask:0xf bank_mask:0xf\n\ts_nop 0" : "+v"(old) : "v"(src)); return old; }
DI float dpp_shl1(float old, float src) { asm volatile("s_nop 1\n\tv_mov_b32_dpp %0, %1 row_shl:1 row_mask:0xf bank_mask:0xf\n\ts_nop 0" : "+v"(old) : "v"(src)); return old; }
struct Unit { int pm, pn; };
struct Order {
  int nM, nN, nwg, G, c;
  DI void init(int nM_, int nN_, int G_, int c_) { nM = nM_; nN = nN_; nwg = nM * nN; G = G_; c = c_; }
  DI bool next(int i, Unit& u) const {
    const long Lq = (long)i * G + c; if (Lq >= nwg) return false;
    int wgid = (int)Lq; { const int q = nwg / 8, r = nwg % 8, xcd = wgid % 8, off = wgid / 8; wgid = (xcd < r ? xcd * (q + 1) : r * (q + 1) + (xcd - r) * q) + off; }
    const int nig = 8 * nN, gid = wgid / nig, fm = gid * 8, gsz = (nM - fm) < 8 ? (nM - fm) : 8;
    u.pm = fm + ((wgid % nig) % gsz); u.pn = (wgid % nig) / gsz; return true;
  }
};
struct Gemm { const u16* A; int lda; const u16* Bt; int K; };
template <int ROWMODE> DI const char* a_tile_ptr(const Gemm& g, int pm) {
  long row = ROWMODE == 0 ? (long)pm * 256 : (long)(pm / 33) * T + 254 * (pm % 33) - 1;
  return (const char*)g.A + row * g.lda * 2;
}
struct EpiArgs {
  u16* pa; u16* pb; u16* vt;
  float* xf; u16* xb;
  u16* g; const float* cw; const float* cb;
  int zero; int pre_f32;
};
template <int EPI>
DI void epilogue(f32x4 (&acc)[2][2][4][2], const Unit& u, const EpiArgs& ea, LAS unsigned char* lds) {
  int tid2 = threadIdx.x; asm volatile("" : "+v"(tid2));
  const int wid2 = tid2 >> 6, lane2 = tid2 & 63, wr = wid2 >> 2, wc = wid2 & 3, fr = lane2 & 15, fq = lane2 >> 4;
  if (EPI == 0) {
    const int row0 = u.pm * 256 + wr * 64 + fr;
#pragma unroll
    for (int ai = 0; ai < 2; ++ai)
#pragma unroll
      for (int m = 0; m < 4; ++m) {
        const int row = row0 + ai * HALF + m * 16;
#pragma unroll
        for (int bj = 0; bj < 2; ++bj) {
          const int col = u.pn * 256 + bj * HALF + wc * 32 + 8 * fq;
          const f32x4 a0 = acc[ai][bj][m][0], a1 = acc[ai][bj][m][1];
          if (u.pn <= 10) {
            uint4 pk; pk.x = cvt_pk_bf16(a0[0], a0[1]); pk.y = cvt_pk_bf16(a0[2], a0[3]); pk.z = cvt_pk_bf16(a1[0], a1[1]); pk.w = cvt_pk_bf16(a1[2], a1[3]);
            if (u.pn <= 6) { if (col < A_COLS) *(uint4*)(ea.pa + (size_t)row * A_COLS + col) = pk; }
            else *(uint4*)(ea.pb + (size_t)row * 1024 + (col - 1792)) = pk;
          } else {
            const int c2 = col - 2816, h = c2 >> 7, e = c2 & 127, seq = row / T, t = row % T;
            u16* dst = ea.vt + ((size_t)((seq * 4 + h) * 128 + e)) * T + t;
#pragma unroll
            for (int j = 0; j < 4; ++j) { dst[(size_t)j * T] = f2bf(a0[j]); dst[(size_t)(4 + j) * T] = f2bf(a1[j]); }
          }
        }
      }
  } else if (EPI == 1) {
    const int row0 = u.pm * 256 + wr * 64 + fr, col0 = u.pn * 256 + wc * 32 + 4 * fq;
#pragma unroll
    for (int ai = 0; ai < 2; ++ai)
#pragma unroll
      for (int m = 0; m < 4; ++m) {
        float* rowp = ea.xf + (size_t)(row0 + ai * HALF + m * 16) * D + col0;
        u16* rowb = ea.xb + (size_t)(row0 + ai * HALF + m * 16) * D + col0;
#pragma unroll
        for (int bj = 0; bj < 2; ++bj)
#pragma unroll
          for (int n = 0; n < 2; ++n) { f32x4* p4 = (f32x4*)(rowp + bj * HALF + n * 16); const u32x2 xr = *(const u32x2*)(rowb + bj * HALF + n * 16);
            f32x4 x; x[0] = __uint_as_float(xr.x << 16); x[1] = __uint_as_float(xr.x & 0xffff0000u); x[2] = __uint_as_float(xr.y << 16); x[3] = __uint_as_float(xr.y & 0xffff0000u);
            const f32x4 pre = x * ALPHA + acc[ai][bj][m][n];
            if (ea.pre_f32) *p4 = pre;
            else { u32x2 hq; hq.x = cvt_pk_bf16(pre[0], pre[1]); hq.y = cvt_pk_bf16(pre[2], pre[3]); *(u32x2*)(rowb + bj * HALF + n * 16) = hq; } }
      }
  } else {
    LAS float* E = (LAS float*)(lds + STAGE_BYTES);
    const int seq = u.pm / 33, ti = u.pm % 33;
    const int cl0 = wc * 32 + 8 * fq;
#pragma unroll
    for (int ai = 0; ai < 2; ++ai)
#pragma unroll
      for (int m = 0; m < 4; ++m) {
        const int rl = ai * HALF + wr * 64 + m * 16 + fr;
        const int tok = 254 * ti - 1 + rl;
        const bool valid = tok >= 0 && tok < T;
        const int blk = ai * 8 + wr * 4 + m;
#pragma unroll
        for (int bj = 0; bj < 2; ++bj)
#pragma unroll
          for (int n = 0; n < 2; ++n) {
            if (!valid) acc[ai][bj][m][n] = (f32x4){0.f, 0.f, 0.f, 0.f};
            if (fr == 0) *(LAS f32x4*)(E + ((blk * 2 + 0) * 2 + bj) * 128 + cl0 + 4 * n) = acc[ai][bj][m][n];
            if (fr == 15) *(LAS f32x4*)(E + ((blk * 2 + 1) * 2 + bj) * 128 + cl0 + 4 * n) = acc[ai][bj][m][n];
          }
      }
    asm volatile("s_waitcnt lgkmcnt(0)" ::: "memory");
    __builtin_amdgcn_s_barrier(); asm volatile("" ::: "memory");
    __builtin_amdgcn_s_barrier(); asm volatile("" ::: "memory");
#pragma unroll
    for (int n = 0; n < 2; ++n) {
      const int hid = u.pn * 128 + cl0 + 4 * n;
      const float* cwp = ea.cw + hid;
      const f32x4 g0 = *(const f32x4*)(cwp), g1 = *(const f32x4*)(cwp + NUP), g2 = *(const f32x4*)(cwp + 2 * NUP), gb = *(const f32x4*)(ea.cb + hid);
      const f32x4 u0 = *(const f32x4*)(cwp + DFF), u1 = *(const f32x4*)(cwp + DFF + NUP), u2 = *(const f32x4*)(cwp + DFF + 2 * NUP), ub = *(const f32x4*)(ea.cb + DFF + hid);
#pragma unroll
      for (int ai = 0; ai < 2; ++ai)
#pragma unroll
        for (int m = 0; m < 4; ++m) {
          const int blk = ai * 8 + wr * 4 + m;
          const int rl = ai * HALF + wr * 64 + m * 16 + fr;
          const int tok = 254 * ti - 1 + rl;
          f32x4 hh[2];
#pragma unroll
          for (int bj = 0; bj < 2; ++bj) {
            const f32x4 cur = acc[ai][bj][m][n];
            f32x4 ab = (f32x4){0.f, 0.f, 0.f, 0.f}, be = (f32x4){0.f, 0.f, 0.f, 0.f};
            if (fr == 0 && blk > 0) ab = *(LAS f32x4*)(E + (((blk - 1) * 2 + 1) * 2 + bj) * 128 + cl0 + 4 * n);
            if (fr == 15 && blk < 15) be = *(LAS f32x4*)(E + (((blk + 1) * 2 + 0) * 2 + bj) * 128 + cl0 + 4 * n);
            f32x4 prev, next;
#pragma unroll
            for (int j = 0; j < 4; ++j) { prev[j] = dpp_shr1(ab[j], cur[j]); next[j] = dpp_shl1(be[j], cur[j]); }
            hh[bj] = bj == 0 ? g0 * prev + g1 * cur + g2 * next + gb : u0 * prev + u1 * cur + u2 * next + ub;
          }
          f32x4 res;
#pragma unroll
          for (int j = 0; j < 4; ++j) res[j] = gelu1(hh[0][j]) * hh[1][j];
          if (rl >= 1 && rl <= 254 && tok < T) {
            u32x2 pk; pk.x = cvt_pk_bf16(res[0], res[1]); pk.y = cvt_pk_bf16(res[2], res[3]);
            *(u32x2*)(ea.g + (size_t)(seq * T + tok) * DFF + hid) = pk;
          }
        }
    }
  }
}

template <int EPI, int ROWMODE>
DI void gemm_phase(LAS unsigned char* lds, const Gemm g, int nM, int nN, const EpiArgs& ea) {
  constexpr bool PERM = (EPI != 1);
  int tid = threadIdx.x; asm volatile("" : "+v"(tid));
  int bid = blockIdx.x, gdim = gridDim.x; asm volatile("" : "+s"(bid), "+s"(gdim));
  const int wid = __builtin_amdgcn_readfirstlane(tid >> 6), lane = tid & 63, wr = wid >> 2, wc = wid & 3, fr = lane & 15, fq = lane >> 4;
  const int K = g.K, nt = K / BK;
  Order S; S.init(nM, nN, gdim, bid);
  unsigned voffA[2], voffB[2];
#pragma unroll
  for (int i = 0; i < 2; ++i) { int R, C; stage_rc(tid * 16 + i * 8192, R, C); const int Rb = PERM ? ((R & ~31) + perm32(R & 31)) : R;
    voffA[i] = (unsigned)(R * g.lda + C) * 2u; voffB[i] = (unsigned)(Rb * K + C) * 2u; }
  const size_t kstep = (size_t)(BK * 2);
  const size_t hstepA = (size_t)HALF * g.lda * 2, hstepB = (size_t)HALF * K * 2;
  const unsigned ldsw = (unsigned)wid * 1024u;
  const int aoff = lds_byte(wr * 64 + fr, fq * 8), boff = lds_byte(wc * 32 + fr, fq * 8);
#define PG8_SA(b, h) (((b) * 2 + (h)) * HTB)
#define PG8_SB(b, h) ((4 + (b) * 2 + (h)) * HTB)
#define PG8_STAGE(bufoff, gbase, voff) do { _Pragma("unroll") for (int _i = 0; _i < 2; ++_i) \
    __builtin_amdgcn_global_load_lds((const unsigned*)((const char*)(gbase) + (voff)[_i]), (LAS unsigned*)(lds + (bufoff) + ldsw + _i * 8192), 16, 0, 0); } while (0)
#define PG8_LDA(dst, b, h) do { _Pragma("unroll") for (int m = 0; m < 4; ++m) _Pragma("unroll") for (int k = 0; k < 2; ++k) dst[m][k] = *(const LAS bf16x8*)(lds + PG8_SA(b, h) + aoff + m * 2048 + k * 1024); } while (0)
#define PG8_LDB(dst, b, h) do { _Pragma("unroll") for (int n = 0; n < 2; ++n) _Pragma("unroll") for (int k = 0; k < 2; ++k) dst[n][k] = *(const LAS bf16x8*)(lds + PG8_SB(b, h) + boff + n * 2048 + k * 1024); } while (0)
#define PG8_MMA(ai, bj, At, Bq) do { __builtin_amdgcn_s_setprio(1); _Pragma("unroll") for (int m = 0; m < 4; ++m) _Pragma("unroll") for (int n = 0; n < 2; ++n) _Pragma("unroll") for (int k = 0; k < 2; ++k) \
    acc[ai][bj][m][n] = __builtin_amdgcn_mfma_f32_16x16x32_bf16(Bq[n][k], At[m][k], acc[ai][bj][m][n], 0, 0, 0); __builtin_amdgcn_s_setprio(0); } while (0)
#define PG8_WAIT_V(n) asm volatile("s_waitcnt vmcnt(" #n ")" ::: "memory")
#define PG8_WAIT_L(n) asm volatile("s_waitcnt lgkmcnt(" #n ")" ::: "memory")
#define PG8_BAR __builtin_amdgcn_s_barrier()
#define PG8_SCHED __builtin_amdgcn_sched_barrier(0)
  Unit cur, nxt; int ui = 0;
  __syncthreads();
  if (!S.next(0, cur)) return;
  f32x4 acc[2][2][4][2];
#pragma unroll
  for (int a = 0; a < 2; ++a)
#pragma unroll
    for (int b = 0; b < 2; ++b)
#pragma unroll
      for (int m = 0; m < 4; ++m)
#pragma unroll
        for (int n = 0; n < 2; ++n) acc[a][b][m][n] = (f32x4){0.f, 0.f, 0.f, 0.f};
  bf16x8 At[4][2], B0[2][2], B1[2][2];
  const char* cA = a_tile_ptr<ROWMODE>(g, cur.pm); const char* cB = (const char*)g.Bt + (size_t)cur.pn * 2 * hstepB;
  PG8_STAGE(PG8_SB(0, 0), cB, voffB); PG8_STAGE(PG8_SA(0, 0), cA, voffA); PG8_STAGE(PG8_SB(0, 1), cB + hstepB, voffB); PG8_STAGE(PG8_SA(0, 1), cA + hstepA, voffA);
  if (wr == 1) PG8_BAR;
  PG8_WAIT_V(4); PG8_BAR;
  PG8_STAGE(PG8_SB(1, 0), cB + kstep, voffB); PG8_STAGE(PG8_SA(1, 0), cA + kstep, voffA); PG8_STAGE(PG8_SB(1, 1), cB + hstepB + kstep, voffB);
  PG8_WAIT_V(6); PG8_BAR;
  for (;;) {
    const bool has_next = S.next(ui + 1, nxt);
    const char* nA = has_next ? a_tile_ptr<ROWMODE>(g, nxt.pm) : cA; const char* nB = has_next ? (const char*)g.Bt + (size_t)nxt.pn * 2 * hstepB : cB;
    for (int t = 0; t < nt; t += 2) {
      const bool last = (t == nt - 2);
      const char* a1 = cA + (size_t)(t + 1) * kstep;
      const char* a2 = last ? nA : cA + (size_t)(t + 2) * kstep; const char* b2 = last ? nB : cB + (size_t)(t + 2) * kstep;
      const char* a3 = a2 + kstep; const char* b3 = b2 + kstep;
      PG8_LDB(B0, 0, 0); PG8_SCHED; PG8_LDA(At, 0, 0); PG8_STAGE(PG8_SA(1, 1), a1 + hstepA, voffA);
      PG8_WAIT_L(8); PG8_BAR; PG8_WAIT_L(0); PG8_MMA(0, 0, At, B0); PG8_BAR; PG8_SCHED;
      PG8_LDB(B1, 0, 1); PG8_STAGE(PG8_SB(0, 0), b2, voffB);
      PG8_BAR; PG8_WAIT_L(0); PG8_MMA(0, 1, At, B1); PG8_BAR;
      PG8_LDA(At, 0, 1); PG8_STAGE(PG8_SA(0, 0), a2, voffA);
      PG8_BAR; PG8_WAIT_L(0); PG8_MMA(1, 0, At, B0); PG8_BAR; PG8_SCHED;
      PG8_STAGE(PG8_SB(0, 1), b2 + hstepB, voffB);
      PG8_WAIT_V(6); PG8_BAR; PG8_MMA(1, 1, At, B1); PG8_BAR;
      PG8_LDB(B0, 1, 0); PG8_SCHED; PG8_LDA(At, 1, 0); PG8_STAGE(PG8_SA(0, 1), a2 + hstepA, voffA);
      PG8_WAIT_L(8); PG8_BAR; PG8_WAIT_L(0); PG8_MMA(0, 0, At, B0); PG8_BAR; PG8_SCHED;
      PG8_LDB(B1, 1, 1); PG8_STAGE(PG8_SB(1, 0), b3, voffB);
      PG8_BAR; PG8_WAIT_L(0); PG8_MMA(0, 1, At, B1); PG8_BAR;
      PG8_LDA(At, 1, 1); PG8_STAGE(PG8_SA(1, 0), a3, voffA);
      PG8_BAR; PG8_WAIT_L(0); PG8_MMA(1, 0, At, B0); PG8_BAR; PG8_SCHED;
      PG8_STAGE(PG8_SB(1, 1), b3 + hstepB, voffB);
      PG8_WAIT_V(6); PG8_BAR; PG8_MMA(1, 1, At, B1); PG8_BAR;
    }
    epilogue<EPI>(acc, cur, ea, lds);
    if (!has_next) break;
#pragma unroll
    for (int a = 0; a < 2; ++a)
#pragma unroll
      for (int b = 0; b < 2; ++b)
#pragma unroll
        for (int m = 0; m < 4; ++m)
#pragma unroll
          for (int n = 0; n < 2; ++n) acc[a][b][m][n] = (f32x4){0.f, 0.f, 0.f, 0.f};
    cur = nxt; cA = nA; cB = nB; ++ui;
  }
  PG8_WAIT_V(0);
  if (wr == 0) PG8_BAR;
  PG8_BAR;
#undef PG8_SA
#undef PG8_SB
}

constexpr int KROW = 144, VROW = 144;
constexpr int KBUF = 64 * KROW, VBUF = 128 * VROW, ABUF = KBUF + VBUF;
constexpr float LOG2E = 1.4426950408889634f;
DI bf16x8 pack8(const f32x16& x, int s) {
  u32x4 p; p.x = cvt_pk_bf16(x[8 * s], x[8 * s + 1]); p.y = cvt_pk_bf16(x[8 * s + 2], x[8 * s + 3]); p.z = cvt_pk_bf16(x[8 * s + 4], x[8 * s + 5]); p.w = cvt_pk_bf16(x[8 * s + 6], x[8 * s + 7]);
  return __builtin_bit_cast(bf16x8, p);
}
DI void attn_phase(LAS unsigned char* lds, u16* PB, const u16* VT, float* OSV, const float* lamp, const float* subg, const float* relb, int layer, int pair_lo, int pair_hi, int wg_lo, int wg_cnt) {
  int tid = threadIdx.x; asm volatile("" : "+v"(tid));
  int bid = blockIdx.x, gdim = gridDim.x; asm volatile("" : "+s"(bid), "+s"(gdim));
  const int wid = tid >> 6, lane = tid & 63, qi = lane & 31, g = lane >> 5;
  LAS float* tab = (LAS float*)(lds + 4 * ABUF);
  LAS float* scal = tab + 264;
  const float lam_init = 0.8f - 0.6f * __expf(-0.3f * (float)layer);
  __syncthreads();
  if (wid == 0) {
    float a = lamp[lane] * lamp[64 + lane], b = lamp[128 + lane] * lamp[192 + lane];
    for (int o = 32; o > 0; o >>= 1) { a += __shfl_xor(a, o); b += __shfl_xor(b, o); }
    if (lane == 0) scal[0] = __expf(a) - __expf(b) + lam_init;
  }
  const int m_sw = (qi & 0x13) | ((qi & 4) << 1) | ((qi & 8) >> 1);
  if (bid < wg_lo || bid >= wg_lo + wg_cnt) return;
  const int xcd = bid & 7, jq = (bid - wg_lo) >> 3;
  const int per_x = wg_cnt >> 3;
  const float c1 = 0.125f * LOG2E;
  for (int pr = pair_lo + xcd; pr < pair_hi; pr += 8) {
    const int s = pr >> 2, h = pr & 3;
    for (int qb = jq; qb < 32; qb += per_x) {
      __syncthreads();
      for (int i = tid; i < 257; i += NTHREADS) {
        const int rel = i - 128, n = rel < 0 ? -rel : rel;
        int bk = n < 8 ? n : (n <= 11 ? 8 : (n <= 15 ? 9 : (n <= 22 ? 10 : (n <= 31 ? 11 : (n <= 45 ? 12 : (n <= 63 ? 13 : (n <= 90 ? 14 : 15)))))));
        if (rel > 0) bk += 16;
        tab[i] = relb[bk * 4 + h] * LOG2E;
      }
      const int q0 = qb * 256 + wid * 32;
      const size_t tokbase = (size_t)s * T;
      float* osv = OSV + ((size_t)bid * 512 + tid) * 64;
#pragma unroll 1
      for (int c = 0; c < 2; ++c) {
        bf16x8 Q[4];
        { const u16* qp = PB + (tokbase + q0 + qi) * 1024 + h * 128 + c * 64 + g * 8;
#pragma unroll
          for (int ks = 0; ks < 4; ++ks) Q[ks] = *(const bf16x8*)(qp + ks * 16); }
        f32x16 O[4];
#pragma unroll
        for (int eb = 0; eb < 4; ++eb)
#pragma unroll
          for (int i = 0; i < 16; ++i) O[eb][i] = 0.f;
        float mrun = -1e30f, lrun = 0.f;
        const u16* kg = PB + (tokbase + (tid >> 3)) * 1024 + 512 + h * 128 + c * 64 + (tid & 7) * 8;
        const u16* vg = VT + ((size_t)((s * 4 + h) * 128 + (tid >> 2))) * T + (tid & 3) * 16;
        const unsigned kl = (tid >> 3) * KROW + (tid & 7) * 16, vl = KBUF + (tid >> 2) * VROW + (tid & 3) * 32;
        u32x4 rk0, rv0, rv1, rkB, rvB0, rvB1;
        rk0 = *(const u32x4*)(kg); rv0 = *(const u32x4*)(vg); rv1 = *(const u32x4*)(vg + 8);
        rkB = *(const u32x4*)(kg + (size_t)64 * 1024); rvB0 = *(const u32x4*)(vg + 64); rvB1 = *(const u32x4*)(vg + 64 + 8);
        __syncthreads();
        *(LAS u32x4*)(lds + kl) = rk0; *(LAS u32x4*)(lds + vl) = rv0; *(LAS u32x4*)(lds + vl + 16) = rv1;
        *(LAS u32x4*)(lds + ABUF + kl) = rkB; *(LAS u32x4*)(lds + ABUF + vl) = rvB0; *(LAS u32x4*)(lds + ABUF + vl + 16) = rvB1;
        __syncthreads();
        auto compute_tile = [&](const int kt, LAS unsigned char* buf) {
          const int kmin = kt * 64;
          const int dlo = kmin + 63 - q0, dhi = kmin - (q0 + 31);
          const int bmode = dlo <= -91 ? 0 : (dhi >= 91 ? 1 : 2);
          const float bconst = bmode == 0 ? tab[0] : tab[256];
          f32x16 S[2];
          {
            bf16x8 kf[2][4];
#pragma unroll
            for (int kb = 0; kb < 2; ++kb)
#pragma unroll
              for (int ks = 0; ks < 4; ++ks) kf[kb][ks] = *(const LAS bf16x8*)(buf + (kb * 32 + m_sw) * KROW + (ks * 16 + g * 8) * 2);
            __builtin_amdgcn_sched_barrier(0);
            __builtin_amdgcn_s_setprio(1);
#pragma unroll
            for (int kb = 0; kb < 2; ++kb) {
#pragma unroll
              for (int i = 0; i < 16; ++i) S[kb][i] = 0.f;
#pragma unroll
              for (int ks = 0; ks < 4; ++ks) S[kb] = __builtin_amdgcn_mfma_f32_32x32x16_bf16(kf[kb][ks], Q[ks], S[kb], 0, 0, 0);
            }
            __builtin_amdgcn_s_setprio(0);
          }
          bf16x8 vf[2][4];
          float sc = c1, off = bconst;
          if (bmode == 2) {
#pragma unroll
            for (int kb = 0; kb < 2; ++kb)
#pragma unroll
              for (int r = 0; r < 16; ++r) {
                int rel = kmin + kb * 32 + 16 * (r >> 3) + 8 * g + (r & 7) - (q0 + qi);
                rel = rel < -128 ? -128 : (rel > 128 ? 128 : rel);
                S[kb][r] = S[kb][r] * c1 + tab[rel + 128];
              }
            sc = 1.f; off = 0.f;
          }
          float mx = -3e38f;
#pragma unroll
          for (int kb = 0; kb < 2; ++kb)
#pragma unroll
            for (int r = 0; r < 16; ++r) mx = fmaxf(mx, S[kb][r]);
          mx = fmaxf(mx, __shfl_xor(mx, 32));
          mx = mx * sc + off;
          if (__any(mx > mrun + 8.f)) {
            const float mnew = mx > mrun + 8.f ? mx : mrun;
            const float alpha = __builtin_amdgcn_exp2f(mrun - mnew);
            mrun = mnew; lrun *= alpha;
#pragma unroll
            for (int eb = 0; eb < 4; ++eb)
#pragma unroll
              for (int i = 0; i < 16; ++i) O[eb][i] *= alpha;
          }
          const float sh = off - mrun;
          float ps0 = 0.f, ps1 = 0.f, ps2 = 0.f, ps3 = 0.f;
#pragma unroll
          for (int kb = 0; kb < 2; ++kb)
#pragma unroll
            for (int r = 0; r < 16; r += 4) {
              const float p0 = __builtin_amdgcn_exp2f(S[kb][r] * sc + sh), p1 = __builtin_amdgcn_exp2f(S[kb][r + 1] * sc + sh), p2 = __builtin_amdgcn_exp2f(S[kb][r + 2] * sc + sh), p3 = __builtin_amdgcn_exp2f(S[kb][r + 3] * sc + sh);
              S[kb][r] = p0; S[kb][r + 1] = p1; S[kb][r + 2] = p2; S[kb][r + 3] = p3; ps0 += p0; ps1 += p1; ps2 += p2; ps3 += p3;
            }
          lrun += (ps0 + ps1) + (ps2 + ps3);
          __builtin_amdgcn_sched_barrier(0);
          __builtin_amdgcn_s_setprio(1);
#pragma unroll
          for (int eb = 0; eb < 4; ++eb) vf[0][eb] = *(const LAS bf16x8*)(buf + KBUF + (eb * 32 + qi) * VROW + (g * 8) * 2);
#pragma unroll
          for (int stp = 0; stp < 4; ++stp) {
            const int kb = stp >> 1, hh = stp & 1;
            if (stp < 3) {
#pragma unroll
              for (int eb = 0; eb < 4; ++eb) vf[(stp + 1) & 1][eb] = *(const LAS bf16x8*)(buf + KBUF + (eb * 32 + qi) * VROW + ((stp + 1) * 16 + g * 8) * 2);
            }
            const bf16x8 pb = pack8(S[kb], hh);
#pragma unroll
            for (int eb = 0; eb < 4; ++eb) O[eb] = __builtin_amdgcn_mfma_f32_32x32x16_bf16(vf[stp & 1][eb], pb, O[eb], 0, 0, 0);
          }
          __builtin_amdgcn_s_setprio(0);
        };
        { const u16* kg2 = kg + (size_t)2 * 64 * 1024; const u16* vg2 = vg + 128;
          rk0 = *(const u32x4*)(kg2); rv0 = *(const u32x4*)(vg2); rv1 = *(const u32x4*)(vg2 + 8);
          const u16* kg3 = kg + (size_t)3 * 64 * 1024; const u16* vg3 = vg + 192;
          rkB = *(const u32x4*)(kg3); rvB0 = *(const u32x4*)(vg3); rvB1 = *(const u32x4*)(vg3 + 8); }
#pragma unroll 1
        for (int kt = 0; kt < 128; kt += 2) {
          LAS unsigned char* buf = lds + ((kt >> 1) & 1) * 2 * ABUF;
          LAS unsigned char* nbuf = lds + (((kt >> 1) + 1) & 1) * 2 * ABUF;
          compute_tile(kt, buf);
          compute_tile(kt + 1, buf + ABUF);
          *(LAS u32x4*)(nbuf + kl) = rk0; *(LAS u32x4*)(nbuf + vl) = rv0; *(LAS u32x4*)(nbuf + vl + 16) = rv1;
          *(LAS u32x4*)(nbuf + ABUF + kl) = rkB; *(LAS u32x4*)(nbuf + ABUF + vl) = rvB0; *(LAS u32x4*)(nbuf + ABUF + vl + 16) = rvB1;
          { const int tn = kt + 4 < 128 ? kt + 4 : 127; const u16* kg2 = kg + (size_t)tn * 64 * 1024; const u16* vg2 = vg + tn * 64;
            rk0 = *(const u32x4*)(kg2); rv0 = *(const u32x4*)(vg2); rv1 = *(const u32x4*)(vg2 + 8); }
          { const int tn = kt + 5 < 128 ? kt + 5 : 127; const u16* kg2 = kg + (size_t)tn * 64 * 1024; const u16* vg2 = vg + tn * 64;
            rkB = *(const u32x4*)(kg2); rvB0 = *(const u32x4*)(vg2); rvB1 = *(const u32x4*)(vg2 + 8); }
          __syncthreads();
        }
        const float lt = lrun + __shfl_xor(lrun, 32);
        asm volatile("" : "+v"(osv));
        if (c == 0) {
          const float i0 = 1.f / lt;
#pragma unroll
          for (int eb = 0; eb < 4; ++eb)
#pragma unroll
            for (int i = 0; i < 16; i += 4) { f32x4 t4; t4[0] = O[eb][i] * i0; t4[1] = O[eb][i + 1] * i0; t4[2] = O[eb][i + 2] * i0; t4[3] = O[eb][i + 3] * i0; *(f32x4*)(osv + eb * 16 + i) = t4; }
        } else {
          const float i1 = scal[0] / lt;
          float ss = 0.f;
#pragma unroll
          for (int eb = 0; eb < 4; ++eb)
#pragma unroll
            for (int i = 0; i < 16; i += 4) { const f32x4 t4 = *(const f32x4*)(osv + eb * 16 + i);
#pragma unroll
              for (int j = 0; j < 4; ++j) { const float o = t4[j] - O[eb][i + j] * i1; O[eb][i + j] = o; ss += o * o; } }
          ss += __shfl_xor(ss, 32);
          const float rs = rsqrtf(ss * (1.f / 128.f) + LN_EPS) * (1.f - lam_init);
          u16* op = PB + (tokbase + q0 + qi) * 1024 + h * 128;
#pragma unroll
          for (int eb = 0; eb < 4; ++eb)
#pragma unroll
            for (int rr = 0; rr < 4; ++rr) {
              const int e = eb * 32 + 8 * rr + 4 * g;
              const f32x4 gg = *(const f32x4*)(subg + e);
              u32x2 pk; pk.x = cvt_pk_bf16(O[eb][4 * rr] * rs * gg[0], O[eb][4 * rr + 1] * rs * gg[1]); pk.y = cvt_pk_bf16(O[eb][4 * rr + 2] * rs * gg[2], O[eb][4 * rr + 3] * rs * gg[3]);
              *(u32x2*)(op + e) = pk;
            }
        }
      }
    }
  }
}

DI float softplusf_(float x) { return fmaxf(x, 0.f) + __logf(1.f + __expf(-fabsf(x))); }
DI void load_bf16x8(const u16* p, float (&o)[8]) {
  const u32x4 v = *(const u32x4*)p;
#pragma unroll
  for (int i = 0; i < 4; ++i) { o[2 * i] = __uint_as_float(v[i] << 16); o[2 * i + 1] = __uint_as_float(v[i] & 0xffff0000u); }
}
DI void shifted8(const u16* PA, size_t row, int t, int col, const float* mu0, const float* mu1, float (&o)[8]) {
  float c[8], pv[8], nx[8];
  load_bf16x8(PA + row * A_COLS + col, c);
  if (t > 0) load_bf16x8(PA + (row - 1) * A_COLS + col, pv); else { for (int i = 0; i < 8; ++i) pv[i] = 0.f; }
  if (t < T - 1) load_bf16x8(PA + (row + 1) * A_COLS + col, nx); else { for (int i = 0; i < 8; ++i) nx[i] = 0.f; }
#pragma unroll
  for (int i = 0; i < 8; ++i) o[i] = c[i] + mu0[col + i] * (pv[i] - c[i]) + mu1[col + i] * (nx[i] - c[i]);
}

DI void vprep_phase(LAS unsigned char* lds, const u16* PA, u16* VV, const float* mu, const float* vdown, const float* vup, const float* v0, int layer) {
  int tid = threadIdx.x; asm volatile("" : "+v"(tid));
  int bid = blockIdx.x, gdim = gridDim.x; asm volatile("" : "+s"(bid), "+s"(gdim));
  const int tok = tid >> 4, j = tid & 15;
  LAS float* vs = (LAS float*)lds;
  LAS float* dd = vs + 32 * 516;
  LAS unsigned* DN = (LAS unsigned*)(dd + 1024);
  LAS unsigned* UP = DN + 512 * 16;
  const float* mu0 = mu; const float* mu1 = mu + A_COLS;
  __syncthreads();
  if (layer != 0) {
    for (int i = tid; i < 512 * 16; i += NTHREADS) { const float2 w2 = *(const float2*)(vdown + 2 * i); DN[i] = cvt_pk_bf16(w2.x, w2.y); }
    for (int i = tid; i < 32 * 256; i += NTHREADS) { const float2 w2 = *(const float2*)(vup + 2 * i); UP[i] = cvt_pk_bf16(w2.x, w2.y); }
  }
  for (int it = bid; it < NT / 32; it += gdim) {
    const size_t row = (size_t)it * 32 + tok; const int t = (int)(row % T);
    __syncthreads();
#pragma unroll 1
    for (int q = 0; q < 4; ++q) {
      const int cc = q * 128 + j * 8;
      float o[8]; shifted8(PA, row, t, OFF_V + cc, mu0, mu1, o);
      if (layer == 0) {
        u32x4 pk; pk.x = cvt_pk_bf16(o[0], o[1]); pk.y = cvt_pk_bf16(o[2], o[3]); pk.z = cvt_pk_bf16(o[4], o[5]); pk.w = cvt_pk_bf16(o[6], o[7]);
        *(u32x4*)(VV + row * 512 + cc) = pk;
      } else {
        *(LAS f32x4*)(vs + tok * 516 + cc) = (f32x4){o[0], o[1], o[2], o[3]}; *(LAS f32x4*)(vs + tok * 516 + cc + 4) = (f32x4){o[4], o[5], o[6], o[7]};
      }
    }
    if (layer == 0) continue;
    __syncthreads();
    {
      float d0 = 0.f, d1 = 0.f;
#pragma unroll 8
      for (int c = 0; c < 512; ++c) { const float x = vs[tok * 516 + c]; const unsigned w2 = DN[c * 16 + j]; d0 += x * __uint_as_float(w2 << 16); d1 += x * __uint_as_float(w2 & 0xffff0000u); }
      dd[tok * 32 + 2 * j] = d0; dd[tok * 32 + 2 * j + 1] = d1;
    }
    __syncthreads();
#pragma unroll 1
    for (int q = 0; q < 4; ++q) {
      const int c0 = q * 128 + j * 8;
      float acc[8];
      { const f32x4 a0 = *(const f32x4*)(v0 + c0), a1 = *(const f32x4*)(v0 + c0 + 4);
#pragma unroll
        for (int i = 0; i < 4; ++i) { acc[i] = a0[i]; acc[4 + i] = a1[i]; } }
#pragma unroll 8
      for (int r = 0; r < 32; ++r) {
        const float dv = dd[tok * 32 + r];
        const u32x4 w8 = *(const LAS u32x4*)(UP + r * 256 + (c0 >> 1));
#pragma unroll
        for (int i = 0; i < 4; ++i) { acc[2 * i] += dv * __uint_as_float(w8[i] << 16); acc[2 * i + 1] += dv * __uint_as_float(w8[i] & 0xffff0000u); }
      }
      float vf[8]; load_bf16x8(VV + row * 512 + c0, vf);
      const f32x4 x0 = *(const LAS f32x4*)(vs + tok * 516 + c0), x1 = *(const LAS f32x4*)(vs + tok * 516 + c0 + 4);
      float o[8];
#pragma unroll
      for (int i = 0; i < 4; ++i) { o[i] = x0[i] + (vf[i] - x0[i]) * sigmoidf_(acc[i]); o[4 + i] = x1[i] + (vf[4 + i] - x1[i]) * sigmoidf_(acc[4 + i]); }
      u32x4 pk; pk.x = cvt_pk_bf16(o[0], o[1]); pk.y = cvt_pk_bf16(o[2], o[3]); pk.z = cvt_pk_bf16(o[4], o[5]); pk.w = cvt_pk_bf16(o[6], o[7]);
      *(u32x4*)(VV + row * 512 + c0) = pk;
    }
  }
}

struct ScanW { const float *mu, *w0, *du, *a0, *iu, *kk_, *ka, *rk; };
constexpr int SC = 32;
DI float quad_sum(float x) {
  x += __builtin_bit_cast(float, __builtin_amdgcn_update_dpp(0, __builtin_bit_cast(int, x), 0xB1, 0xf, 0xf, true));
  x += __builtin_bit_cast(float, __builtin_amdgcn_update_dpp(0, __builtin_bit_cast(int, x), 0x4E, 0xf, 0xf, true));
  return x;
}
#define BFLO(x) __uint_as_float((x) << 16)
#define BFHI(x) __uint_as_float((x) & 0xffff0000u)
DI float tanh_fast(float x) { x = fminf(fmaxf(x, -15.f), 15.f); const float t = __expf(2.f * x); return (t - 1.f) / (t + 1.f); }
DI float shift1(float c, float p, float n, float m0, float m1) { return c + m0 * (p - c) + m1 * (n - c); }
DI void scan_produce(LAS float* buf, LAS unsigned* TW, LAS unsigned* TA, LAS const unsigned* DU, LAS const unsigned* IU, const u16* PA, const u16* VV, float* BON,
                     const ScanW& w, int ptid, int sq, int h, int dir, int t0) {
  const int tok = ptid >> 3, j = ptid & 7;
  const int t = t0 + tok; const size_t row = (size_t)sq * T + t;
  const float* mu0 = w.mu; const float* mu1 = w.mu + A_COLS;
  const int cr = h * 64 + j * 8, ck = OFF_K + cr, cw_ = OFF_WD + dir * 32 + j * 4, ca_ = OFF_AD + dir * 32 + j * 4;
  const u16* pc = PA + row * A_COLS;
  const bool hp = t > 0, hn = t < T - 1;
  {
    const u32x2 w_c = *(const u32x2*)(pc + cw_), a_c = *(const u32x2*)(pc + ca_);
    u32x2 w_p = (u32x2){0u, 0u}, a_p = w_p, w_n = w_p, a_n = w_p;
    if (hp) { w_p = *(const u32x2*)(pc - A_COLS + cw_); a_p = *(const u32x2*)(pc - A_COLS + ca_); }
    if (hn) { w_n = *(const u32x2*)(pc + A_COLS + cw_); a_n = *(const u32x2*)(pc + A_COLS + ca_); }
    const f32x4 mw0 = *(const f32x4*)(mu0 + cw_), mw1 = *(const f32x4*)(mu1 + cw_), ma0 = *(const f32x4*)(mu0 + ca_), ma1 = *(const f32x4*)(mu1 + ca_);
    f32x4 tw, ta;
#pragma unroll
    for (int i = 0; i < 2; ++i) {
      tw[2 * i] = tanh_fast(shift1(BFLO(w_c[i]), BFLO(w_p[i]), BFLO(w_n[i]), mw0[2 * i], mw1[2 * i]));
      tw[2 * i + 1] = tanh_fast(shift1(BFHI(w_c[i]), BFHI(w_p[i]), BFHI(w_n[i]), mw0[2 * i + 1], mw1[2 * i + 1]));
      ta[2 * i] = shift1(BFLO(a_c[i]), BFLO(a_p[i]), BFLO(a_n[i]), ma0[2 * i], ma1[2 * i]);
      ta[2 * i + 1] = shift1(BFHI(a_c[i]), BFHI(a_p[i]), BFHI(a_n[i]), ma0[2 * i + 1], ma1[2 * i + 1]);
    }
    u32x2 tw2, ta2; tw2.x = cvt_pk_bf16(tw[0], tw[1]); tw2.y = cvt_pk_bf16(tw[2], tw[3]); ta2.x = cvt_pk_bf16(ta[0], ta[1]); ta2.y = cvt_pk_bf16(ta[2], ta[3]);
    *(LAS u32x2*)(TW + tok * 16 + j * 2) = tw2; *(LAS u32x2*)(TA + tok * 16 + j * 2) = ta2;
  }
  asm volatile("s_waitcnt lgkmcnt(0)" ::: "memory");
  float wl[8], al[8];
  const int cc = j * 8, cg_ = h * 64 + cc;
  { const f32x4 x0 = *(const f32x4*)(w.w0 + dir * 512 + cg_), x1 = *(const f32x4*)(w.w0 + dir * 512 + cg_ + 4), y0 = *(const f32x4*)(w.a0 + dir * 512 + cg_), y1 = *(const f32x4*)(w.a0 + dir * 512 + cg_ + 4);
#pragma unroll
    for (int q = 0; q < 4; ++q) { wl[q] = x0[q]; wl[4 + q] = x1[q]; al[q] = y0[q]; al[4 + q] = y1[q]; } }
#pragma unroll 2
  for (int pr = 0; pr < 16; ++pr) {
    const bf2 twp = __builtin_bit_cast(bf2, TW[tok * 16 + pr]), tap = __builtin_bit_cast(bf2, TA[tok * 16 + pr]);
    const u32x4 d0 = *(const LAS u32x4*)(DU + pr * 64 + cc), d1 = *(const LAS u32x4*)(DU + pr * 64 + cc + 4), i0 = *(const LAS u32x4*)(IU + pr * 64 + cc), i1 = *(const LAS u32x4*)(IU + pr * 64 + cc + 4);
#pragma unroll
    for (int q = 0; q < 4; ++q) {
      unsigned ua = d0[q], ub = d1[q], uc = i0[q], ud = i1[q]; asm volatile("" : "+v"(ua), "+v"(ub), "+v"(uc), "+v"(ud));
      wl[q] = __builtin_amdgcn_fdot2_f32_bf16(twp, __builtin_bit_cast(bf2, ua), wl[q], false); wl[4 + q] = __builtin_amdgcn_fdot2_f32_bf16(twp, __builtin_bit_cast(bf2, ub), wl[4 + q], false);
      al[q] = __builtin_amdgcn_fdot2_f32_bf16(tap, __builtin_bit_cast(bf2, uc), al[q], false); al[4 + q] = __builtin_amdgcn_fdot2_f32_bf16(tap, __builtin_bit_cast(bf2, ud), al[4 + q], false);
    }
  }
#pragma unroll
  for (int q = 0; q < 8; ++q) { asm volatile("" : "+v"(wl[q]), "+v"(al[q])); }
  LAS float* AW = buf; LAS float* AK = buf + 2048; LAS float* AB = buf + 4096; LAS float* AD = buf + 6144; LAS float* AR = buf + 8192; LAS float* AV = buf + 10240;
  const int o = tok * 64 + cc;
  float ss = 0.f, bs = 0.f;
  float ok[8], av[8];
#pragma unroll
  for (int hq = 0; hq < 2; ++hq) {
    const int c4 = 4 * hq;
    const u32x2 r_c = *(const u32x2*)(pc + cr + c4), k_c = *(const u32x2*)(pc + ck + c4);
    u32x2 r_p = (u32x2){0u, 0u}, k_p = r_p, r_n = r_p, k_n = r_p;
    if (hp) { r_p = *(const u32x2*)(pc - A_COLS + cr + c4); k_p = *(const u32x2*)(pc - A_COLS + ck + c4); }
    if (hn) { r_n = *(const u32x2*)(pc + A_COLS + cr + c4); k_n = *(const u32x2*)(pc + A_COLS + ck + c4); }
    const u32x2 v_c = *(const u32x2*)(VV + row * 512 + cr + c4);
    const f32x4 mr0 = *(const f32x4*)(mu0 + cr + c4), mr1 = *(const f32x4*)(mu1 + cr + c4), mk0 = *(const f32x4*)(mu0 + ck + c4), mk1 = *(const f32x4*)(mu1 + ck + c4);
    const f32x4 kk4 = *(const f32x4*)(w.kk_ + cg_ + c4), ka4 = *(const f32x4*)(w.ka + cg_ + c4), rk4 = *(const f32x4*)(w.rk + cg_ + c4);
    f32x4 rv, kv, vv, ow, od;
#pragma unroll
    for (int i = 0; i < 2; ++i) {
      rv[2 * i] = shift1(BFLO(r_c[i]), BFLO(r_p[i]), BFLO(r_n[i]), mr0[2 * i], mr1[2 * i]);
      rv[2 * i + 1] = shift1(BFHI(r_c[i]), BFHI(r_p[i]), BFHI(r_n[i]), mr0[2 * i + 1], mr1[2 * i + 1]);
      kv[2 * i] = shift1(BFLO(k_c[i]), BFLO(k_p[i]), BFLO(k_n[i]), mk0[2 * i], mk1[2 * i]);
      kv[2 * i + 1] = shift1(BFHI(k_c[i]), BFHI(k_p[i]), BFHI(k_n[i]), mk0[2 * i + 1], mk1[2 * i + 1]);
      vv[2 * i] = BFLO(v_c[i]); vv[2 * i + 1] = BFHI(v_c[i]);
    }
#pragma unroll
    for (int q = 0; q < 4; ++q) {
      const float wlog = -softplusf_(-wl[c4 + q]) - 0.5f;
      ow[q] = __expf(-__expf(wlog));
      const float a = sigmoidf_(al[c4 + q]);
      av[c4 + q] = a;
      ok[c4 + q] = kv[q] * kk4[q]; ss += ok[c4 + q] * ok[c4 + q];
      od[q] = kv[q] * (1.f + (a - 1.f) * ka4[q]);
      bs += rv[q] * od[q] * rk4[q];
    }
    *(LAS f32x4*)(AW + o + c4) = ow; *(LAS f32x4*)(AD + o + c4) = od; *(LAS f32x4*)(AR + o + c4) = rv; *(LAS f32x4*)(AV + o + c4) = vv;
  }
#pragma unroll
  for (int sft = 1; sft < 8; sft <<= 1) { ss += __shfl_xor(ss, sft); bs += __shfl_xor(bs, sft); }
  const float rn = rsqrtf(ss + 1e-12f);
#pragma unroll
  for (int hq = 0; hq < 2; ++hq) {
    f32x4 k4, b4;
#pragma unroll
    for (int q = 0; q < 4; ++q) { k4[q] = ok[4 * hq + q] * rn; b4[q] = k4[q] * av[4 * hq + q]; }
    *(LAS f32x4*)(AK + o + 4 * hq) = k4; *(LAS f32x4*)(AB + o + 4 * hq) = b4;
  }
  if (j == 0) BON[((size_t)dir * NT + row) * 8 + h] = bs;
}
struct ScanOps { f32x4 k4[4], w4[4], b4[4], d4[4]; float vi; };
DI void scan_load(ScanOps& o, LAS const float* buf, int tt, int jseg, int irow) {
  const int off = tt * 64 + jseg * 16;
#pragma unroll
  for (int q = 0; q < 4; ++q) {
    o.w4[q] = *(const LAS f32x4*)(buf + off + q * 4); o.k4[q] = *(const LAS f32x4*)(buf + 2048 + off + q * 4); o.b4[q] = *(const LAS f32x4*)(buf + 4096 + off + q * 4);
    o.d4[q] = *(const LAS f32x4*)(buf + 6144 + off + q * 4);
  }
  o.vi = buf[10240 + tt * 64 + irow];
}
DI float scan_step(f32x4 (&S)[4], const ScanOps& o, LAS const float* buf, int tt, int jseg) {
  f32x4 r4[4];
#pragma unroll
  for (int q = 0; q < 4; ++q) r4[q] = *(const LAS f32x4*)(buf + 8192 + tt * 64 + jseg * 16 + q * 4);
  f32x4 a4 = S[0] * o.k4[0] + S[1] * o.k4[1] + S[2] * o.k4[2] + S[3] * o.k4[3];
  float sa = -quad_sum((a4[0] + a4[1]) + (a4[2] + a4[3]));
  f32x4 y4 = (f32x4){0.f, 0.f, 0.f, 0.f};
#pragma unroll
  for (int q = 0; q < 4; ++q) { S[q] = S[q] * o.w4[q] + (o.b4[q] * sa + o.d4[q] * o.vi); y4 += S[q] * r4[q]; }
  return quad_sum((y4[0] + y4[1]) + (y4[2] + y4[3]));
}
DI void scan_phase(LAS unsigned char* lds, const u16* PA, const u16* VV, u16* YY, float* BON, const ScanW w) {
  int tid = threadIdx.x; asm volatile("" : "+v"(tid));
  int bid = blockIdx.x, gdim = gridDim.x; asm volatile("" : "+s"(bid), "+s"(gdim));
  LAS float* BUF = (LAS float*)lds;
  LAS float* AY = BUF + 2 * 12288;
  LAS unsigned* TW = (LAS unsigned*)(AY + 2 * 2048);
  LAS unsigned* TA = TW + SC * 16;
  LAS unsigned* DU = TA + SC * 16;
  LAS unsigned* IU = DU + 1024;
  const int wid = __builtin_amdgcn_readfirstlane(tid >> 6), lane = tid & 63;
  const int NCH = T / SC;
  for (int item = bid; item < 192; item += gdim) {
    const int dir = item & 1, h = (item >> 1) & 7, sq = item >> 4;
    __syncthreads();
    for (int i = tid; i < 1024; i += NTHREADS) { const int pr = i >> 6, c = i & 63; const size_t o0 = (size_t)(dir * 32 + 2 * pr) * 512 + h * 64 + c;
      DU[i] = cvt_pk_bf16(w.du[o0], w.du[o0 + 512]); IU[i] = cvt_pk_bf16(w.iu[o0], w.iu[o0 + 512]); }
    __syncthreads();
    f32x4 S[4];
#pragma unroll
    for (int q = 0; q < 4; ++q) S[q] = (f32x4){0.f, 0.f, 0.f, 0.f};
    const int irow = (wid & 3) * 16 + (lane >> 2), jseg = lane & 3;
    if (wid >= 4) scan_produce(BUF, TW, TA, DU, IU, PA, VV, BON, w, tid - 256, sq, h, dir, dir == 0 ? 0 : T - SC);
    __syncthreads();
#pragma unroll 1
    for (int ci = 0; ci < NCH; ++ci) {
      LAS float* buf = BUF + (ci & 1) * 12288;
      LAS float* ay = AY + (ci & 1) * 2048;
      if (wid < 4) {
        ScanOps o0, o1;
        scan_load(o0, buf, dir == 0 ? 0 : SC - 1, jseg, irow);
#pragma unroll 1
        for (int st = 0; st < SC; st += 2) {
          const int t0_ = dir == 0 ? st : SC - 1 - st, t1_ = dir == 0 ? st + 1 : SC - 2 - st;
          scan_load(o1, buf, t1_, jseg, irow);
          const float y0 = scan_step(S, o0, buf, t0_, jseg);
          if (jseg == 0) ay[t0_ * 64 + irow] = y0;
          if (st + 2 < SC) scan_load(o0, buf, dir == 0 ? st + 2 : SC - 3 - st, jseg, irow);
          const float y1 = scan_step(S, o1, buf, t1_, jseg);
          if (jseg == 0) ay[t1_ * 64 + irow] = y1;
        }
      } else {
        const int ptid = tid - 256;
        if (ci + 1 < NCH) scan_produce(BUF + ((ci + 1) & 1) * 12288, TW, TA, DU, IU, PA, VV, BON, w, ptid, sq, h, dir, dir == 0 ? (ci + 1) * SC : T - SC * (ci + 2));
        if (ci > 0) {
          LAS const float* py = AY + ((ci - 1) & 1) * 2048;
          const int t0p = dir == 0 ? (ci - 1) * SC : T - SC * ci;
          const int tok = ptid >> 3, c0 = (ptid & 7) * 8;
          const f32x4 ya = *(const LAS f32x4*)(py + tok * 64 + c0), yb = *(const LAS f32x4*)(py + tok * 64 + c0 + 4);
          u32x4 pk; pk.x = cvt_pk_bf16(ya[0], ya[1]); pk.y = cvt_pk_bf16(ya[2], ya[3]); pk.z = cvt_pk_bf16(yb[0], yb[1]); pk.w = cvt_pk_bf16(yb[2], yb[3]);
          *(u32x4*)(YY + ((size_t)dir * NT + (size_t)sq * T + t0p + tok) * 512 + h * 64 + c0) = pk;
        }
      }
      __syncthreads();
    }
    if (wid >= 4) {
      const int ptid = tid - 256;
      LAS const float* py = AY + ((NCH - 1) & 1) * 2048;
      const int t0p = dir == 0 ? (NCH - 1) * SC : 0;
      const int tok = ptid >> 3, c0 = (ptid & 7) * 8;
      const f32x4 ya = *(const LAS f32x4*)(py + tok * 64 + c0), yb = *(const LAS f32x4*)(py + tok * 64 + c0 + 4);
      u32x4 pk; pk.x = cvt_pk_bf16(ya[0], ya[1]); pk.y = cvt_pk_bf16(ya[2], ya[3]); pk.z = cvt_pk_bf16(yb[0], yb[1]); pk.w = cvt_pk_bf16(yb[2], yb[3]);
      *(u32x4*)(YY + ((size_t)dir * NT + (size_t)sq * T + t0p + tok) * 512 + h * 64 + c0) = pk;
    }
  }
}

DI void post_phase(LAS unsigned char* lds, u16* PA, const u16* PB, const u16* VV, const u16* YY, const float* BON, const float* mu, const float* gup, const float* gng, const float* gnb) {
  int tid = threadIdx.x; asm volatile("" : "+v"(tid));
  int bid = blockIdx.x, gdim = gridDim.x; asm volatile("" : "+s"(bid), "+s"(gdim));
  const int tok = tid >> 4, j = tid & 15;
  LAS unsigned* SG2 = (LAS unsigned*)lds;
  LAS unsigned* GU = (LAS unsigned*)(lds + 16384);
  const float* mu0 = mu; const float* mu1 = mu + A_COLS;
  __syncthreads();
  for (int e = tid; e < 48 * 512; e += NTHREADS) { const int r2 = e >> 9, c = e & 511; GU[(r2 * 2 + ((c >> 2) & 1)) * 256 + (c >> 3) * 4 + (c & 3)] = cvt_pk_bf16(gup[(2 * r2) * 512 + c], gup[(2 * r2 + 1) * 512 + c]); }
  for (int it = bid; it < NT / 32; it += gdim) {
    const size_t row = (size_t)it * 32 + tok; const int t = (int)(row % T);
    __syncthreads();
    { float sv[6];
#pragma unroll
      for (int q = 0; q < 6; ++q) {
        const int col = OFF_GD + j * 6 + q;
        const float c = bf2f(PA[row * A_COLS + col]);
        const float pv = t > 0 ? bf2f(PA[(row - 1) * A_COLS + col]) : 0.f, nx = t < T - 1 ? bf2f(PA[(row + 1) * A_COLS + col]) : 0.f;
        sv[q] = sigmoidf_(c + mu0[col] * (pv - c) + mu1[col] * (nx - c));
      }
#pragma unroll
      for (int pq = 0; pq < 3; ++pq) SG2[tok * 48 + j * 3 + pq] = cvt_pk_bf16(sv[2 * pq], sv[2 * pq + 1]); }
    __syncthreads();
#pragma unroll 1
    for (int q = 0; q < 4; ++q) {
      const int cc = q * 128 + j * 8, h = 2 * q + (j >> 3);
      float y[8]; float sm = 0.f;
      { float a[8], b[8]; load_bf16x8(YY + row * 512 + cc, a); load_bf16x8(YY + ((size_t)NT + row) * 512 + cc, b);
#pragma unroll
        for (int i = 0; i < 8; ++i) { y[i] = a[i] + b[i]; sm += y[i]; } }
      sm += __shfl_xor(sm, 1); sm += __shfl_xor(sm, 2); sm += __shfl_xor(sm, 4);
      const float mean = sm * (1.f / 64.f);
      float vq = 0.f;
#pragma unroll
      for (int i = 0; i < 8; ++i) { y[i] -= mean; vq += y[i] * y[i]; }
      vq += __shfl_xor(vq, 1); vq += __shfl_xor(vq, 2); vq += __shfl_xor(vq, 4);
      const float rs = rsqrtf(vq * (1.f / 64.f) + GN_EPS);
      const float bon = BON[row * 8 + h] + BON[((size_t)NT + row) * 8 + h];
      float gacc[8];
#pragma unroll
      for (int i = 0; i < 8; ++i) gacc[i] = 0.f;
#pragma unroll 8
      for (int r2 = 0; r2 < 48; ++r2) {
        const bf2 sv = __builtin_bit_cast(bf2, SG2[tok * 48 + r2]);
        const u32x4 wa = *(const LAS u32x4*)(GU + (r2 * 2 + 0) * 256 + (cc >> 3) * 4), wb = *(const LAS u32x4*)(GU + (r2 * 2 + 1) * 256 + (cc >> 3) * 4);
#pragma unroll
        for (int i = 0; i < 4; ++i) { unsigned ua = wa[i], ub = wb[i]; asm volatile("" : "+v"(ua), "+v"(ub));
          gacc[i] = __builtin_amdgcn_fdot2_f32_bf16(sv, __builtin_bit_cast(bf2, ua), gacc[i], false); gacc[4 + i] = __builtin_amdgcn_fdot2_f32_bf16(sv, __builtin_bit_cast(bf2, ub), gacc[4 + i], false); }
      }
      float vv[8]; load_bf16x8(VV + row * 512 + cc, vv);
      const f32x4 g0 = *(const f32x4*)(gng + cc), g1 = *(const f32x4*)(gng + cc + 4), b0 = *(const f32x4*)(gnb + cc), b1 = *(const f32x4*)(gnb + cc + 4);
      float o[8];
#pragma unroll
      for (int i = 0; i < 4; ++i) { o[i] = (y[i] * rs * g0[i] + b0[i] + bon * vv[i]) * gacc[i]; o[4 + i] = (y[4 + i] * rs * g1[i] + b1[i] + bon * vv[4 + i]) * gacc[4 + i]; }
      u32x4 pk; pk.x = cvt_pk_bf16(o[0], o[1]); pk.y = cvt_pk_bf16(o[2], o[3]); pk.z = cvt_pk_bf16(o[4], o[5]); pk.w = cvt_pk_bf16(o[6], o[7]);
      if (DBGZ & 1) pk = (u32x4){0u, 0u, 0u, 0u};
      *(u32x4*)(PA + row * A_COLS + cc) = pk;
      u32x4 pb4 = *(const u32x4*)(PB + row * 1024 + cc); if (DBGZ & 2) pb4 = (u32x4){0u, 0u, 0u, 0u};
      *(u32x4*)(PA + row * A_COLS + 512 + cc) = pb4;
    }
  }
}

DI unsigned hashu(unsigned x) { x ^= x >> 16; x *= 0x7feb352du; x ^= x >> 15; x *= 0x846ca68bu; x ^= x >> 16; return x; }
DI void dbg_upd(float* slot, float got, float ref, float scale) { float e = fabsf(got - ref) / scale; if (!(e == e)) e = 1e9f; atomicMax((unsigned*)slot, __float_as_uint(e)); }
DI float tshift(const u16* PA, size_t row, int col, const float* mu) {
  const int t = (int)(row % T);
  const float c = bf2f(PA[row * A_COLS + col]);
  const float pv = t > 0 ? bf2f(PA[(row - 1) * A_COLS + col]) : 0.f, nx = t < T - 1 ? bf2f(PA[(row + 1) * A_COLS + col]) : 0.f;
  return c + mu[col] * (pv - c) + mu[A_COLS + col] * (nx - c);
}
DI void chk_proj(const u16* XB, const float* win, const u16* PA, const u16* PB, const u16* VT, float* slot) {
  const int gt = blockIdx.x * NTHREADS + threadIdx.x;
  if (gt >= 4096) return;
  const int row = hashu(gt * 2 + 1) % NT, col = hashu(gt * 2 + 2) % P_COLS;
  float ref = 0.f;
  for (int k = 0; k < D; ++k) ref += bf2f(XB[(size_t)row * D + k]) * win[(size_t)k * P_COLS + col];
  float got;
  if (col < A_COLS) got = bf2f(PA[(size_t)row * A_COLS + col]);
  else if (col < A_COLS + 1024) got = bf2f(PB[(size_t)row * 1024 + col - A_COLS]);
  else { const int c2 = col - A_COLS - 1024, h = c2 >> 7, e = c2 & 127, sq = row / T, t = row % T; got = bf2f(VT[((size_t)((sq * 4 + h) * 128 + e)) * T + t]); }
  dbg_upd(slot, got, ref, 1.f);
}
DI void chk_ffn(const u16* XB, const float* wup, const float* cw, const float* cb, const u16* G, float* slot) {
  const int gt = blockIdx.x * NTHREADS + threadIdx.x;
  if (gt >= 4096) return;
  int row = hashu(gt * 2 + 11) % NT; const int n = hashu(gt * 2 + 12) % DFF;
  if (gt < 64) row = (gt & 1) ? (row / T) * T + T - 1 : (row / T) * T;
  else if (gt < 1024) row = (row / T) * T + ((row % T) / 254) * 254 + (gt & 1 ? 253 : 0), row = row >= NT ? NT - 1 : row;
  const int t = row % T;
  float hg[3] = {0.f, 0.f, 0.f}, hu[3] = {0.f, 0.f, 0.f};
#pragma unroll
  for (int d = -1; d <= 1; ++d) {
    float a = 0.f, b = 0.f;
    if (!(t + d < 0 || t + d > T - 1))
      for (int k = 0; k < D; ++k) { const float x = bf2f(XB[(size_t)(row + d) * D + k]); a += x * wup[(size_t)k * NUP + n]; b += x * wup[(size_t)k * NUP + DFF + n]; }
    hg[d + 1] = a; hu[d + 1] = b;
  }
  const float got = bf2f(G[(size_t)row * DFF + n]);
  { const float g = cw[n] * hg[0] + cw[NUP + n] * hg[1] + cw[2 * NUP + n] * hg[2] + cb[n];
    const float u = cw[DFF + n] * hu[0] + cw[NUP + DFF + n] * hu[1] + cw[2 * NUP + DFF + n] * hu[2] + cb[DFF + n];
    dbg_upd(slot, got, 0.5f * g * (1.f + erff(g * 0.70710678f)) * u, 1.f); }
  { const float g = cw[n] * hg[2] + cw[NUP + n] * hg[1] + cw[2 * NUP + n] * hg[0] + cb[n];
    const float u = cw[DFF + n] * hu[2] + cw[NUP + DFF + n] * hu[1] + cw[2 * NUP + DFF + n] * hu[0] + cb[DFF + n];
    dbg_upd(slot + 1, got, 0.5f * g * (1.f + erff(g * 0.70710678f)) * u, 1.f); }
  { const float g = cw[NUP + n] * hg[1] + cb[n];
    const float u = cw[NUP + DFF + n] * hu[1] + cb[DFF + n];
    dbg_upd(slot + 2, got, 0.5f * g * (1.f + erff(g * 0.70710678f)) * u, 1.f); }
}
DI void chk_attn(LAS unsigned char* lds, const u16* XB, const float* win, const u16* PB, const u16* VT, const float* lamp, const float* subg, const float* relb, int layer, float* slot) {
  if (blockIdx.x >= 16) return;
  const int tid = threadIdx.x;
  LAS float* qv = (LAS float*)lds;
  LAS float* sc = qv + 128;
  LAS float* red = sc + 16384;
  LAS float* ov = red + 1024;
  const int smp = blockIdx.x;
  const int sq = hashu(smp + 77) % NSEQ, h = smp & 3;
  int q = hashu(smp + 99) % T; if (smp < 4) q = smp * 37; if (smp >= 12) q = T - 1 - (smp - 12) * 50;
  const size_t row = (size_t)sq * T + q;
  __syncthreads();
  if (tid < 128) { float a = 0.f; const int col = A_COLS + h * 128 + tid; for (int k = 0; k < D; ++k) a += bf2f(XB[row * D + k]) * win[(size_t)k * P_COLS + col]; qv[tid] = a; }
  __syncthreads();
  float mx0 = -1e30f, mx1 = -1e30f;
  for (int key = tid; key < T; key += NTHREADS) {
    const u16* kp = PB + ((size_t)sq * T + key) * 1024 + 512 + h * 128;
    float s0 = 0.f, s1 = 0.f;
    for (int d = 0; d < 64; ++d) { s0 += qv[d] * bf2f(kp[d]); s1 += qv[64 + d] * bf2f(kp[64 + d]); }
    const int rel = key - q, n = rel < 0 ? -rel : rel;
    int bk;
    if (n < 8) bk = n; else { bk = 8 + (int)(logf((float)n / 8.f) / logf(16.f) * 8.f); bk = bk > 15 ? 15 : bk; }
    if (rel > 0) bk += 16;
    const float bias = relb[bk * 4 + h];
    s0 = s0 * 0.125f + bias; s1 = s1 * 0.125f + bias;
    sc[key] = s0; sc[8192 + key] = s1; mx0 = fmaxf(mx0, s0); mx1 = fmaxf(mx1, s1);
  }
  red[tid] = mx0; red[512 + tid] = mx1; __syncthreads();
  for (int o = 256; o > 0; o >>= 1) { if (tid < o) { red[tid] = fmaxf(red[tid], red[tid + o]); red[512 + tid] = fmaxf(red[512 + tid], red[512 + tid + o]); } __syncthreads(); }
  mx0 = red[0]; mx1 = red[512]; __syncthreads();
  float l0 = 0.f, l1 = 0.f;
  for (int key = tid; key < T; key += NTHREADS) { const float p0 = expf(sc[key] - mx0), p1 = expf(sc[8192 + key] - mx1); sc[key] = p0; sc[8192 + key] = p1; l0 += p0; l1 += p1; }
  red[tid] = l0; red[512 + tid] = l1; __syncthreads();
  for (int o = 256; o > 0; o >>= 1) { if (tid < o) { red[tid] += red[tid + o]; red[512 + tid] += red[512 + tid + o]; } __syncthreads(); }
  l0 = red[0]; l1 = red[512]; __syncthreads();
  float la = 0.f, lb = 0.f; for (int d = 0; d < 64; ++d) { la += lamp[d] * lamp[64 + d]; lb += lamp[128 + d] * lamp[192 + d]; }
  const float lam_init = 0.8f - 0.6f * expf(-0.3f * (float)layer);
  const float lam = expf(la) - expf(lb) + lam_init;
  { const int e = tid & 127, part = tid >> 7;
    const u16* vp = VT + ((size_t)((sq * 4 + h) * 128 + e)) * T;
    float o = 0.f;
    for (int key = part * 2048; key < (part + 1) * 2048; ++key) o += (sc[key] / l0 - lam * sc[8192 + key] / l1) * bf2f(vp[key]);
    red[tid] = o; }
  __syncthreads();
  if (tid < 128) ov[tid] = red[tid] + red[128 + tid] + red[256 + tid] + red[384 + tid];
  __syncthreads();
  if (tid < 128) {
    float ss = 0.f; for (int e = 0; e < 128; ++e) ss += ov[e] * ov[e];
    const float ref = ov[tid] * rsqrtf(ss / 128.f + LN_EPS) * subg[tid] * (1.f - lam_init);
    dbg_upd(slot, bf2f(PB[row * 1024 + h * 128 + tid]), ref, 1.f);
  }
}
struct ChkOp { float r, kd, kk, b, w, v; };
DI ChkOp chk_ops(const u16* PA, const u16* VV, const ScanW& w, size_t row, int h, int dir, int c, LAS float* tmp  , int tid) {
  ChkOp o;
  const int cg_ = h * 64 + c;
  o.r = tshift(PA, row, cg_, w.mu);
  const float k = tshift(PA, row, OFF_K + cg_, w.mu);
  float wl = w.w0[dir * 512 + cg_], al = w.a0[dir * 512 + cg_];
#pragma unroll 1
  for (int rr = 0; rr < 32; ++rr) {
    wl += tanhf(tshift(PA, row, OFF_WD + dir * 32 + rr, w.mu)) * w.du[(dir * 32 + rr) * 512 + cg_];
    al += tshift(PA, row, OFF_AD + dir * 32 + rr, w.mu) * w.iu[(dir * 32 + rr) * 512 + cg_];
  }
  const float sp = logf(1.f + expf(-wl));
  o.w = expf(-expf(-sp - 0.5f));
  const float a = 1.f / (1.f + expf(-al));
  const float kkv = k * w.kk_[cg_];
  __syncthreads(); tmp[tid] = kkv * kkv; __syncthreads();
  float ss = 0.f;
#pragma unroll 1
  for (int j = 0; j < 64; ++j) ss += tmp[j];
  o.kk = kkv * rsqrtf(ss + 1e-12f);
  o.kd = k * (1.f + (a - 1.f) * w.ka[cg_]);
  o.b = o.kk * a;
  o.v = bf2f(VV[row * 512 + cg_]);
  return o;
}
DI void chk_scan(LAS unsigned char* lds, const u16* PA, const u16* VV, const u16* YY, const float* BON, const ScanW w, float* slot) {
  if (blockIdx.x >= 48 || threadIdx.x >= 64) return;
  const int tid = threadIdx.x;
  LAS float* tmp = (LAS float*)lds; LAS float* red = tmp + 64;
  const int item = blockIdx.x * 4 + 1, dir = item & 1, h = (item >> 1) & 7, sq = item >> 4;
  const int t0 = dir == 0 ? 0 : T - 1, t1 = dir == 0 ? 1 : T - 2;
  const size_t row0 = (size_t)sq * T + t0, row1 = (size_t)sq * T + t1;
  const ChkOp a = chk_ops(PA, VV, w, row0, h, dir, tid, tmp, tid);
  const ChkOp b = chk_ops(PA, VV, w, row1, h, dir, tid, tmp, tid);
#define BSUM(dst, val) { __syncthreads(); red[tid] = (val); __syncthreads(); float sx_ = 0.f; _Pragma("unroll 1") for (int j_ = 0; j_ < 64; ++j_) sx_ += red[j_]; dst = sx_; }
  float ds0, ds1, ds2, ds3, ds4;
  BSUM(ds0, a.kd * a.r) BSUM(ds1, a.kd * b.w * b.r) BSUM(ds2, a.kd * (-b.kk)) BSUM(ds3, b.b * b.r) BSUM(ds4, b.kd * b.r)
  const float y0 = a.v * ds0;
  const float y1 = a.v * (ds1 + ds2 * ds3) + b.v * ds4;
  dbg_upd(slot, bf2f(YY[((size_t)dir * NT + row0) * 512 + h * 64 + tid]), y0, fabsf(y0) + 0.05f);
  dbg_upd(slot, bf2f(YY[((size_t)dir * NT + row1) * 512 + h * 64 + tid]), y1, fabsf(y1) + 0.05f);
  float bq = a.r * a.kd * w.rk[h * 64 + tid];
  __syncthreads(); red[tid] = bq; __syncthreads(); float bs = 0.f;
#pragma unroll 1
  for (int j = 0; j < 64; ++j) bs += red[j];
  dbg_upd(slot, BON[((size_t)dir * NT + row0) * 8 + h], bs, fabsf(bs) + 0.05f);
}
DI void chk_post(const u16* PA, const u16* PB, const u16* VV, const u16* YY, const float* BON, const float* mu, const float* gup, const float* gng, const float* gnb, float* slot) {
  const int gt = blockIdx.x * NTHREADS + threadIdx.x;
  if (gt >= 2048) return;
  const size_t row = hashu(gt * 2 + 21) % NT; const int c = hashu(gt * 2 + 22) % 512, h = c >> 6;
  float sm = 0.f;
  float yc = 0.f;
  for (int i = 0; i < 64; ++i) { const float y = bf2f(YY[row * 512 + h * 64 + i]) + bf2f(YY[((size_t)NT + row) * 512 + h * 64 + i]); sm += y; if (h * 64 + i == c) yc = y; }
  const float mean = sm / 64.f; float vq = 0.f;
  for (int i = 0; i < 64; ++i) { const float y = bf2f(YY[row * 512 + h * 64 + i]) + bf2f(YY[((size_t)NT + row) * 512 + h * 64 + i]) - mean; vq += y * y; }
  const float yn = (yc - mean) * rsqrtf(vq / 64.f + GN_EPS) * gng[c] + gnb[c];
  const float bon = (BON[row * 8 + h] + BON[((size_t)NT + row) * 8 + h]) * bf2f(VV[row * 512 + c]);
  float g = 0.f;
  for (int r = 0; r < 96; ++r) g += (1.f / (1.f + expf(-tshift(PA, row, OFF_GD + r, mu)))) * gup[r * 512 + c];
  const float ref = (yn + bon) * g;
  dbg_upd(slot, bf2f(PA[row * A_COLS + c]), ref, fabsf(ref) + 0.05f);
  dbg_upd(slot + 1, bf2f(PA[row * A_COLS + 512 + c]), bf2f(PB[row * 1024 + c]), 1.f);
}

#define XB_TMO      128
#define XB_XCNT(j)  (256  + 64 * (j))
#define XB_XSUB(j)  (1280 + 64 * (j))
#define XB_XGEN(j)  (2304 + 64 * (j))
#define XB_TOP      3328
#define XB_TOPGEN   3392
#define XCD_BAR_WORDS 3456
#define XB_SPIN_CAP (1u << 18)
DI unsigned xb_ld(unsigned* p)              { return __hip_atomic_load(p, __ATOMIC_RELAXED, __HIP_MEMORY_SCOPE_AGENT); }
DI unsigned xb_add(unsigned* p, unsigned v) { return __hip_atomic_fetch_add(p, v, __ATOMIC_RELAXED, __HIP_MEMORY_SCOPE_AGENT); }
DI unsigned xb_xcc_id() { return (unsigned)__builtin_amdgcn_s_getreg((3 << 11) | 20) & 0xFu; }
#define XB_SPIN(cond, bar) do { unsigned _sp = 0; while (cond) { __builtin_amdgcn_s_sleep(1); \
    if ((++_sp & 255u) == 0u) { if (xb_ld(&(bar)[XB_TMO])) break; if (_sp > XB_SPIN_CAP) { atomicAdd(&(bar)[XB_TMO], 1u); break; } } } } while (0)
DI void xcd_census(unsigned* bar, unsigned* st) {
  if (threadIdx.x == 0) {
    const unsigned x = xb_xcc_id();
    unsigned cnt = 0u, mine = 0u;
#pragma unroll
    for (unsigned j = 0; j < 16; ++j) { const unsigned c = xb_ld(&bar[XB_XCNT(j)]); cnt += (c > 0u) ? 1u : 0u; mine = (j == x) ? c : mine; }
    st[0] = mine > 0u ? mine : 1u; st[1] = cnt > 0u ? cnt : 1u;
  }
}
DI void xcd_barrier(unsigned* bar, unsigned* st) {
  asm volatile("s_waitcnt vmcnt(0)" ::: "memory");
  __syncthreads();
  if (threadIdx.x == 0) {
    __builtin_amdgcn_s_waitcnt(0);
    const unsigned x = xb_xcc_id();
    const unsigned nloc = st[0], nx = st[1];
    const unsigned old = xb_add(&bar[XB_XSUB(x)], 1u);
    const unsigned gen = old / nloc;
    if (old + 1u == (gen + 1u) * nloc) {
      __builtin_amdgcn_fence(__ATOMIC_RELEASE, "agent");
      asm volatile("s_waitcnt vmcnt(0)" ::: "memory");
      const unsigned og = xb_add(&bar[XB_TOP], 1u);
      const unsigned tg = og / nx;
      if (og + 1u == (tg + 1u) * nx) xb_add(&bar[XB_TOPGEN], 1u);
      else XB_SPIN(xb_ld(&bar[XB_TOPGEN]) == tg, bar);
      __builtin_amdgcn_fence(__ATOMIC_ACQUIRE, "agent");
      xb_add(&bar[XB_XGEN(x)], 1u);
      asm volatile("s_waitcnt vmcnt(0)" ::: "memory");
    } else {
      XB_SPIN(xb_ld(&bar[XB_XGEN(x)]) == gen, bar);
      __builtin_amdgcn_fence(__ATOMIC_ACQUIRE, "agent");
      asm volatile("s_waitcnt vmcnt(0)" ::: "memory");
    }
  }
  __syncthreads();
}

__global__ __launch_bounds__(NTHREADS, 2) void mega(Params p_unused) {
  extern __shared__ __attribute__((aligned(16))) char shm[];
  cg::grid_group grid = cg::this_grid();
  LAS unsigned char* lds = (LAS unsigned char*)shm;
#define WS_PTRS CParams p = get_params(); unsigned char* ws = p->ws; \
  u16* WIN = (u16*)(ws + OFF_WIN); u16* WOUT = (u16*)(ws + OFF_WOUT); u16* WUP = (u16*)(ws + OFF_WUP); u16* WDN = (u16*)(ws + OFF_WDN); \
  u16* XB = (u16*)(ws + OFF_XB); u16* PA = (u16*)(ws + OFF_PA); u16* PB = (u16*)(ws + OFF_PB); u16* VT = (u16*)(ws + OFF_VT); \
  u16* G = (u16*)(ws + OFF_PA); u16* VV = (u16*)(ws + OFF_VV); u16* YY = (u16*)p->out; float* BON = (float*)(ws + OFF_BON); float* XF = p->out; \
  (void)WIN; (void)WOUT; (void)WUP; (void)WDN; (void)XB; (void)PA; (void)PB; (void)VT; (void)G; (void)VV; (void)YY; (void)BON; (void)XF;
  int ph = 0;
  const int ph_lo = get_params()->ph_lo, ph_hi = get_params()->ph_hi;
  const bool fullrun = (ph_lo == 0 && ph_hi >= 1000);
  if (fullrun && threadIdx.x == 0) (void)xb_add((unsigned*)(get_params()->ws + OFF_XBAR) + XB_XCNT(xb_xcc_id()), 1u);
#define GSYNC() do { if (!fullrun || ph == 1) { grid.sync(); if (fullrun) xcd_census((unsigned*)(get_params()->ws + OFF_XBAR), (unsigned*)(get_params()->ws + OFF_XBAR) + XCD_BAR_WORDS + 2 * blockIdx.x); } \
    else xcd_barrier((unsigned*)(get_params()->ws + OFF_XBAR), (unsigned*)(get_params()->ws + OFF_XBAR) + XCD_BAR_WORDS + 2 * blockIdx.x); } while (0)
#ifndef ONLYMASK
#define ONLYMASK 0xffffffffu
#endif
#define PHASE_BEGIN if (((ONLYMASK >> (__COUNTER__ % 32)) & 1u) && ph >= ph_lo && ph < ph_hi) { WS_PTRS
#define PHASE_END } ++ph; if (ph > ph_lo && ph < ph_hi) GSYNC();

  PHASE_BEGIN
    for (int l = 0; l < 2; ++l) {
      convert_weight<0>(shm, p->in[4] + (size_t)l * D * P_COLS, WIN + (size_t)l * NPROJ * D, D, P_COLS, NPROJ, blockIdx.x, gridDim.x);
      convert_weight<1>(shm, p->in[22] + (size_t)l * D * D, WOUT + (size_t)l * D * D, D, D, D, blockIdx.x, gridDim.x);
      convert_weight<2>(shm, p->in[25] + (size_t)l * D * NUP, WUP + (size_t)l * NUP * D, D, NUP, NUP, blockIdx.x, gridDim.x);
      convert_weight<1>(shm, p->in[28] + (size_t)l * DFF * D, WDN + (size_t)l * D * DFF, DFF, D, D, blockIdx.x, gridDim.x);
    }
    ln_rows(p->in[0], p->in[1], NPROMPT_TOK, XF, XB, p->in[2], p->in[3], false, true);
  PHASE_END

#pragma unroll 1
  for (int l = 0; l < 2; ++l) {
    PHASE_BEGIN
      Gemm ga{XB, D, WIN + (size_t)l * NPROJ * D, D};
      EpiArgs ea{}; ea.pa = PA; ea.pb = PB; ea.vt = VT;
      gemm_phase<0, 0>(lds, ga, NT / 256, NPROJ / 256, ea);
#if PROBE_GEMM
      gemm_phase<0, 0>(lds, ga, NT / 256, NPROJ / 256, ea);
#endif
    PHASE_END
#pragma unroll 1
    for (int rnd = 0; rnd < 2; ++rnd) {
      if (ph >= ph_lo && ph < ph_hi) { WS_PTRS
        int bidu = blockIdx.x, gdu = gridDim.x; asm volatile("" : "+s"(bidu), "+s"(gdu));
        const bool split = (gdu == 256);
        if (rnd == 0) vprep_phase(lds, PA, VV, p->in[5] + (size_t)l * 2 * A_COLS, p->in[16], p->in[17], p->in[18], l);
        if (rnd == 1 && (!split || bidu < 192)) {
          ScanW sw; sw.mu = p->in[5] + (size_t)l * 2 * A_COLS; sw.w0 = p->in[6] + l * 1024; sw.du = p->in[7] + (size_t)l * 2 * 32 * 512; sw.a0 = p->in[8] + l * 1024;
          sw.iu = p->in[9] + (size_t)l * 2 * 32 * 512; sw.kk_ = p->in[11] + l * 512; sw.ka = p->in[12] + l * 512; sw.rk = p->in[13] + l * 512;
          scan_phase(lds, PA, VV, YY, BON, sw);
        } else if (rnd == 0 || split) {
          const int plo = rnd == 0 ? 0 : 40, phi = (rnd == 0 && split) ? 40 : 48;
          const int wlo = rnd == 0 ? 0 : 192, wcnt = rnd == 0 ? (gdu & ~7) : 64;
          attn_phase(lds, PB, VT, (float*)(ws + OFF_OSV), p->in[19] + l * 256, p->in[20] + l * 128, p->in[21], l, plo, phi, wlo, wcnt);
        }
      }
      ++ph; if (ph > ph_lo && ph < ph_hi) GSYNC();
    }
    PHASE_BEGIN
      post_phase(lds, PA, PB, VV, YY, BON, p->in[5] + (size_t)l * 2 * A_COLS, p->in[10] + (size_t)l * 96 * 512, p->in[14] + l * 512, p->in[15] + l * 512);
#if PROBE_MISC
      post_phase(lds, PA, PB, VV, YY, BON, p->in[5] + (size_t)l * 2 * A_COLS, p->in[10] + (size_t)l * 96 * 512, p->in[14] + l * 512, p->in[15] + l * 512);
#endif
    PHASE_END
    PHASE_BEGIN
      Gemm ga{PA, A_COLS, WOUT + (size_t)l * D * D, D};
      EpiArgs ea{}; ea.xf = XF; ea.xb = XB;
      gemm_phase<1, 0>(lds, ga, NT / 256, D / 256, ea);
    PHASE_END
    PHASE_BEGIN
      ln_rows_bf16(XB, p->in[23] + l * D, p->in[24] + l * D);
    PHASE_END
    PHASE_BEGIN
      Gemm ga{XB, D, WUP + (size_t)l * NUP * D, D};
      EpiArgs ea{}; ea.g = G; ea.cw = p->in[26] + (size_t)l * 3 * NUP; ea.cb = p->in[27] + (size_t)l * NUP;
      gemm_phase<2, 1>(lds, ga, NSEQ * 33, NUP / 256, ea);
#if PROBE_GEMM
      gemm_phase<2, 1>(lds, ga, NSEQ * 33, NUP / 256, ea);
#endif
    PHASE_END
    PHASE_BEGIN
      Gemm ga{G, DFF, WDN + (size_t)l * D * DFF, DFF};
      EpiArgs ea{}; ea.xf = XF; ea.xb = XB; ea.pre_f32 = (l == 1) ? 1 : 0;
      gemm_phase<1, 0>(lds, ga, NT / 256, D / 256, ea);
    PHASE_END
    PHASE_BEGIN
      if (l == 1) ln_rows(XF, XF, NT, XF, XB, p->in[29] + l * D, p->in[30] + l * D, true, false);
      else ln_rows_bf16(XB, p->in[29] + l * D, p->in[30] + l * D);
    PHASE_END
  }
}

#if DBG
#define DPTRS unsigned char* ws = p.ws; u16* XB = (u16*)(ws + OFF_XB); u16* PA = (u16*)(ws + OFF_PA); u16* PB = (u16*)(ws + OFF_PB); u16* VT = (u16*)(ws + OFF_VT); \
  u16* G = (u16*)(ws + OFF_PA); u16* VV = (u16*)(ws + OFF_VV); u16* YY = (u16*)(ws + OFF_XB); float* BON = (float*)(ws + OFF_BON); float* DE = (float*)(ws + OFF_DBG); \
  (void)XB; (void)PA; (void)PB; (void)VT; (void)G; (void)VV; (void)YY; (void)BON; (void)DE;
template <int which> __global__ __launch_bounds__(NTHREADS) void k_chk(Params p, int l) {
  extern __shared__ __attribute__((aligned(16))) char shm[];
  LAS unsigned char* lds = (LAS unsigned char*)shm;
  DPTRS
  if (which == 0) chk_proj(XB, p.in[4] + (size_t)l * D * P_COLS, PA, PB, VT, DE + 0);
  else if (which == 1) chk_attn(lds, XB, p.in[4] + (size_t)l * D * P_COLS, PB, VT, p.in[19] + l * 256, p.in[20] + l * 128, p.in[21], l, DE + 1);
  else if (which == 2) {
    ScanW sw; sw.mu = p.in[5] + (size_t)l * 2 * A_COLS; sw.w0 = p.in[6] + l * 1024; sw.du = p.in[7] + (size_t)l * 2 * 32 * 512; sw.a0 = p.in[8] + l * 1024;
    sw.iu = p.in[9] + (size_t)l * 2 * 32 * 512; sw.kk_ = p.in[11] + l * 512; sw.ka = p.in[12] + l * 512; sw.rk = p.in[13] + l * 512;
    chk_scan(lds, PA, VV, YY, BON, sw, DE + 2);
  } else if (which == 3) chk_post(PA, PB, VV, YY, BON, p.in[5] + (size_t)l * 2 * A_COLS, p.in[10] + (size_t)l * 96 * 512, p.in[14] + l * 512, p.in[15] + l * 512, DE + 3);
  else if (which == 5) chk_ffn(XB, p.in[25] + (size_t)l * D * NUP, p.in[26] + (size_t)l * 3 * NUP, p.in[27] + (size_t)l * NUP, G, DE + 5);
}
__global__ __launch_bounds__(NTHREADS) void k_encode(Params p) {
  const float* e = (const float*)(p.ws + OFF_DBG);
  const float eA = fmaxf(e[DBG_A], 1e-4f), eB = fmaxf(e[DBG_B], 1e-4f);
  const float V1 = 100.f + 100.f * log10f(eA / 1e-3f);
  float V2 = 1.f + log10f(eB / 1e-3f); V2 = fminf(fmaxf(V2, 0.3f), 8.f);
  const size_t n0 = (size_t)NPROMPT_TOK * D, n1 = (size_t)NT * D;
  for (size_t i = (size_t)blockIdx.x * NTHREADS + threadIdx.x; i < n1; i += (size_t)gridDim.x * NTHREADS) {
    float v = 0.f;
    if (i == 0 || i == n0) v = V1;
    else if (i < n0 / 2 || (i > n0 && i < n0 + (n1 - n0) / 2)) v = V2;
    p.out[i] = v;
  }
}
#endif

extern "C" void kernel_launch(void* const* d_in, const int* in_sizes, int n_in, void* d_out, int out_size, void* d_ws, size_t ws_size, hipStream_t stream) {
  static int grid = 0;
  if (grid == 0) {
    if (ws_size < WS_END) { fprintf(stderr, "ws too small: %zu < %zu\n", ws_size, (size_t)WS_END); grid = -1; return; }
    int dev = 0, cus = 0, per_cu = 0;
    hipGetDevice(&dev);
    hipDeviceGetAttribute(&cus, hipDeviceAttributeMultiprocessorCount, dev);
    hipFuncSetAttribute((const void*)mega, hipFuncAttributeMaxDynamicSharedMemorySize, LDS_BYTES);
#if DBG
    hipFuncSetAttribute((const void*)k_chk<1>, hipFuncAttributeMaxDynamicSharedMemorySize, 81920);
    hipFuncSetAttribute((const void*)k_chk<2>, hipFuncAttributeMaxDynamicSharedMemorySize, 81920);
#endif
    hipOccupancyMaxActiveBlocksPerMultiprocessor(&per_cu, (const void*)mega, NTHREADS, LDS_BYTES);
    if (per_cu < 1) per_cu = 1;
    grid = cus * 1;
  }
  if (grid < 0) return;
  Params p{};
  for (int i = 0; i < 31; ++i) p.in[i] = (const float*)d_in[i];
  p.out = (float*)d_out; p.ws = (unsigned char*)d_ws;
#if DBG
  hipMemsetAsync((char*)d_ws + OFF_DBG, 0, 256, stream);
  auto seg = [&](int lo, int hi) { Params q = p; q.ph_lo = lo; q.ph_hi = hi; void* a2[] = {&q};
    hipError_t e = hipLaunchCooperativeKernel((const void*)mega, dim3(grid), dim3(NTHREADS), a2, LDS_BYTES, stream);
    if (e != hipSuccess) fprintf(stderr, "cooperative launch failed: %s\n", hipGetErrorString(e)); };
  auto chk = [&](int l, int which) {
    if (which == 0) hipLaunchKernelGGL(k_chk<0>, dim3(64), dim3(NTHREADS), 81920, stream, p, l);
    if (which == 1) hipLaunchKernelGGL(k_chk<1>, dim3(64), dim3(NTHREADS), 81920, stream, p, l);
    if (which == 2) hipLaunchKernelGGL(k_chk<2>, dim3(64), dim3(NTHREADS), 81920, stream, p, l);
    if (which == 3) hipLaunchKernelGGL(k_chk<3>, dim3(64), dim3(NTHREADS), 81920, stream, p, l);
    if (which == 5) hipLaunchKernelGGL(k_chk<5>, dim3(64), dim3(NTHREADS), 81920, stream, p, l); };
  seg(0, 1);
  for (int l = 0; l < 2; ++l) {
    const int b = 1 + 9 * l;
    seg(b, b + 1); chk(l, 0);
    seg(b + 1, b + 2); chk(l, 1);
    seg(b + 2, b + 3); chk(l, 2);
    seg(b + 3, b + 4); chk(l, 3);
    seg(b + 4, b + 7); if (l == 0) chk(l, 5);
    seg(b + 7, b + 9);
  }
  hipLaunchKernelGGL(k_encode, dim3(1024), dim3(NTHREADS), 0, stream, p);
#else
  hipMemsetAsync((char*)d_ws + OFF_XBAR, 0, XBAR_BYTES, stream);
  p.ph_lo = 0; p.ph_hi = 1000;
  void* args[] = {&p};
  hipError_t e = hipLaunchCooperativeKernel((const void*)mega, dim3(grid), dim3(NTHREADS), args, LDS_BYTES, stream);
  if (e != hipSuccess) fprintf(stderr, "cooperative launch failed: %s (grid %d)\n", hipGetErrorString(e), grid);
#endif
}
```

```cpp
#include <hip/hip_runtime.h>
#include <hip/hip_bf16.h>
#include <hip/hip_cooperative_groups.h>
#include <cstdio>
namespace cg = cooperative_groups;

#define DI __device__ __forceinline__
using bf16 = __hip_bfloat16;
using bf16x8 = __attribute__((ext_vector_type(8))) short;
using s16x4 = __attribute__((ext_vector_type(4))) short;
using f32x4 = __attribute__((ext_vector_type(4))) float;
using f32x16 = __attribute__((ext_vector_type(16))) float;
typedef unsigned short u16;
typedef __bf16 bf2 __attribute__((ext_vector_type(2)));
typedef unsigned u32x4 __attribute__((ext_vector_type(4)));
typedef unsigned u32x2 __attribute__((ext_vector_type(2)));

constexpr int D = 1024, T = 8192, NSEQ = 12, NT = NSEQ * T;
constexpr int NPROMPT_TOK = 4 * T;
constexpr int A_COLS = 1760, P_COLS = 3296, NPROJ = 3328;
constexpr int DFF = 2816, NUP = 5632;
constexpr int OFF_K = 512, OFF_V = 1024, OFF_WD = 1536, OFF_AD = 1600, OFF_GD = 1664;
constexpr float ALPHA = 1.4142135623730951f;
constexpr float LN_EPS = 1e-5f, GN_EPS = 64e-5f;
constexpr int NTHREADS = 512;
#ifndef DBGZ
#define DBGZ 0
#define DBG 0
#define PROBE_SCAN 0
#define PROBE_GEMM 0
#define PROBE_MISC 0
#ifndef CHK_PROJ_ON
#define CHK_PROJ_ON 1
#endif
#ifndef CHK_ATTN_ON
#define CHK_ATTN_ON 1
#endif
#ifndef CHK_SCAN_ON
#define CHK_SCAN_ON 1
#endif
#ifndef CHK_POST_ON
#define CHK_POST_ON 1
#endif
#ifndef CHK_FFN_ON
#define CHK_FFN_ON 1
#endif
#define DBG_A 5
#define DBG_B 6
#define DBGTHR 0.05f, 0.1f, 0.1f, 0.1f, 0.01f, 0.05f
#endif
constexpr int LDS_BYTES = 163840;

constexpr size_t SZ_WIN = (size_t)2 * NPROJ * D * 2;
constexpr size_t SZ_WOUT = (size_t)2 * D * D * 2;
constexpr size_t SZ_WUP = (size_t)2 * NUP * D * 2;
constexpr size_t SZ_WDN = (size_t)2 * D * DFF * 2;
constexpr size_t OFF_WIN = 0;
constexpr size_t OFF_WOUT = OFF_WIN + SZ_WIN;
constexpr size_t OFF_WUP = OFF_WOUT + SZ_WOUT;
constexpr size_t OFF_WDN = OFF_WUP + SZ_WUP;
constexpr size_t OFF_XB = OFF_WDN + SZ_WDN;
constexpr size_t OFF_PA = OFF_XB + (size_t)NT * D * 2;
constexpr size_t OFF_PB = OFF_PA + (size_t)NT * A_COLS * 2;
constexpr size_t OFF_VT = OFF_PB + (size_t)NT * 1024 * 2;
constexpr size_t OFF_VV = OFF_VT + (size_t)NT * 512 * 2;
constexpr size_t OFF_BON = OFF_VV + (size_t)NT * 512 * 2;
constexpr size_t OFF_OSV = OFF_BON + (size_t)2 * NT * 8 * 4;
constexpr size_t OFF_DBG = OFF_OSV + (size_t)256 * 64 * 512 * 4;
constexpr size_t OFF_XBAR = OFF_DBG + 256;
constexpr size_t XBAR_BYTES = 3456 * 4 + 256 * 8;
constexpr size_t WS_END = OFF_XBAR + XBAR_BYTES;
static_assert((size_t)NT * DFF * 2 <= (OFF_VV - OFF_PA), "G alias");

struct Params {
  const float* in[31];
  float* out;
  unsigned char* ws;
  int ph_lo, ph_hi;
};

typedef const __attribute__((address_space(4))) Params* CParams;
DI CParams get_params() { CParams pp = (CParams)__builtin_amdgcn_kernarg_segment_ptr(); asm volatile("" : "+s"(pp)); return pp; }

DI u16 f2bf(float x) { unsigned u = __float_as_uint(x); u += 0x7fffu + ((u >> 16) & 1u); return (u16)(u >> 16); }
DI unsigned cvt_pk_bf16(float lo, float hi) { unsigned r; asm volatile("v_cvt_pk_bf16_f32 %0, %1, %2" : "=v"(r) : "v"(lo), "v"(hi)); return r; }
DI float bf2f(u16 b) { return __uint_as_float(((unsigned)b) << 16); }
DI float sigmoidf_(float x) { return 1.f / (1.f + __expf(-x)); }

template <int MODE> DI int src_col(int n) {
  if (MODE == 0) { return n < A_COLS ? n : (n < 1792 ? -1 : n - 32); }
  if (MODE == 2) { int j = n >> 8, i = n & 255; return i < 128 ? j * 128 + i : DFF + j * 128 + (i - 128); }
  return n;
}
template <int MODE>
DI void convert_weight(char* shm, const float* W, u16* WT, int K, int Nsrc, int Ndst, int gtid_block, int nblocks) {
  float* tile = (float*)shm;
  int tn = Ndst / 64, tk = K / 64;
  for (int t = gtid_block; t < tn * tk; t += nblocks) {
    int n0 = (t / tk) * 64, k0 = (t % tk) * 64;
    __syncthreads();
    for (int e = threadIdx.x; e < 4096; e += NTHREADS) {
      int kk = e >> 6, nn = e & 63;
      int sc = src_col<MODE>(n0 + nn);
      tile[kk * 65 + nn] = sc >= 0 ? W[(size_t)(k0 + kk) * Nsrc + sc] : 0.f;
    }
    __syncthreads();
    for (int e = threadIdx.x; e < 4096; e += NTHREADS) {
      int nn = e >> 6, kk = e & 63;
      WT[(size_t)(n0 + nn) * K + k0 + kk] = f2bf(tile[kk * 65 + nn]);
    }
  }
}

constexpr int LNR = 4;
DI void ln_rows(const float* srcA, const float* srcB, int splitRow, float* dstF, u16* dstB, const float* g, const float* b, bool writeF, bool writeB) {
  int tid = threadIdx.x; asm volatile("" : "+v"(tid));
  int bid = blockIdx.x, gdim = gridDim.x; asm volatile("" : "+s"(bid), "+s"(gdim));
  int wave = tid >> 6, lane = tid & 63;
  int gw = bid * 8 + wave, nw = gdim * 8;
  for (int base = gw * LNR; base < NT; base += nw * LNR) {
    f32x4 v[LNR][4]; float s[LNR], q[LNR];
#pragma unroll
    for (int r = 0; r < LNR; ++r) {
      const int row = base + r;
      const float* src = row < splitRow ? srcA + (size_t)row * D : srcB + (size_t)(row - splitRow) * D;
#pragma unroll
      for (int i = 0; i < 4; ++i) v[r][i] = *(const f32x4*)(src + i * 256 + lane * 4);
    }
#pragma unroll
    for (int r = 0; r < LNR; ++r) { s[r] = 0.f;
#pragma unroll
      for (int i = 0; i < 4; ++i) s[r] += (v[r][i][0] + v[r][i][1]) + (v[r][i][2] + v[r][i][3]); }
#pragma unroll
    for (int o = 32; o > 0; o >>= 1)
#pragma unroll
      for (int r = 0; r < LNR; ++r) s[r] += __shfl_xor(s[r], o);
#pragma unroll
    for (int r = 0; r < LNR; ++r) { const float mu = s[r] * (1.f / D); q[r] = 0.f;
#pragma unroll
      for (int i = 0; i < 4; ++i) { v[r][i] -= mu; const f32x4 t = v[r][i] * v[r][i]; q[r] += (t[0] + t[1]) + (t[2] + t[3]); } }
#pragma unroll
    for (int o = 32; o > 0; o >>= 1)
#pragma unroll
      for (int r = 0; r < LNR; ++r) q[r] += __shfl_xor(q[r], o);
#pragma unroll
    for (int i = 0; i < 4; ++i) {
      const f32x4 gg = *(const f32x4*)(g + i * 256 + lane * 4), bb = *(const f32x4*)(b + i * 256 + lane * 4);
#pragma unroll
      for (int r = 0; r < LNR; ++r) {
        const int row = base + r;
        const float rs = rsqrtf(q[r] * (1.f / D) + LN_EPS);
        const f32x4 o4 = v[r][i] * rs * gg + bb;
        if (writeF) *(f32x4*)(dstF + (size_t)row * D + i * 256 + lane * 4) = o4;
        if (writeB) { u32x2 h; h.x = cvt_pk_bf16(o4[0], o4[1]); h.y = cvt_pk_bf16(o4[2], o4[3]);
          *(u32x2*)(dstB + (size_t)row * D + i * 256 + lane * 4) = h; }
      }
    }
  }
}

DI void ln_rows_bf16(u16* xb, const float* g, const float* b) {
  int tid = threadIdx.x; asm volatile("" : "+v"(tid));
  int bid = blockIdx.x, gdim = gridDim.x; asm volatile("" : "+s"(bid), "+s"(gdim));
  int wave = tid >> 6, lane = tid & 63;
  int gw = bid * 8 + wave, nw = gdim * 8;
  for (int base = gw * LNR; base < NT; base += nw * LNR) {
    f32x4 v[LNR][4]; float s[LNR], q[LNR];
#pragma unroll
    for (int r = 0; r < LNR; ++r) {
      const u16* src = xb + (size_t)(base + r) * D;
#pragma unroll
      for (int i = 0; i < 4; ++i) { const u32x2 x2 = *(const u32x2*)(src + i * 256 + lane * 4);
        v[r][i][0] = __uint_as_float(x2.x << 16); v[r][i][1] = __uint_as_float(x2.x & 0xffff0000u); v[r][i][2] = __uint_as_float(x2.y << 16); v[r][i][3] = __uint_as_float(x2.y & 0xffff0000u); }
    }
#pragma unroll
    for (int r = 0; r < LNR; ++r) { s[r] = 0.f;
#pragma unroll
      for (int i = 0; i < 4; ++i) s[r] += (v[r][i][0] + v[r][i][1]) + (v[r][i][2] + v[r][i][3]); }
#pragma unroll
    for (int o = 32; o > 0; o >>= 1)
#pragma unroll
      for (int r = 0; r < LNR; ++r) s[r] += __shfl_xor(s[r], o);
#pragma unroll
    for (int r = 0; r < LNR; ++r) { const float mu = s[r] * (1.f / D); q[r] = 0.f;
#pragma unroll
      for (int i = 0; i < 4; ++i) { v[r][i] -= mu; const f32x4 t = v[r][i] * v[r][i]; q[r] += (t[0] + t[1]) + (t[2] + t[3]); } }
#pragma unroll
    for (int o = 32; o > 0; o >>= 1)
#pragma unroll
      for (int r = 0; r < LNR; ++r) q[r] += __shfl_xor(q[r], o);
#pragma unroll
    for (int i = 0; i < 4; ++i) {
      const f32x4 gg = *(const f32x4*)(g + i * 256 + lane * 4), bb = *(const f32x4*)(b + i * 256 + lane * 4);
#pragma unroll
      for (int r = 0; r < LNR; ++r) {
        const float rs = rsqrtf(q[r] * (1.f / D) + LN_EPS);
        const f32x4 o4 = v[r][i] * rs * gg + bb;
        u32x2 h; h.x = cvt_pk_bf16(o4[0], o4[1]); h.y = cvt_pk_bf16(o4[2], o4[3]);
        *(u32x2*)(xb + (size_t)(base + r) * D + i * 256 + lane * 4) = h;
      }
    }
  }
}

#define LAS __attribute__((address_space(3)))
constexpr int BK = 64, HALF = 128, HTB = HALF * BK * 2, STAGE_BYTES = 8 * HTB;
DI int lds_byte(int r, int c) { const int st = (r >> 4) * 2 + (c >> 5), rr = r & 15, cc = c & 31, ob = rr * 64 + cc * 2; return st * 1024 + (ob ^ (((ob >> 9) & 1) << 5)); }
DI void stage_rc(int b, int& R, int& C) { const int st = b / 1024, sb = b % 1024, swz = sb ^ (((sb >> 9) & 1) << 5); R = (st >> 1) * 16 + swz / 64; C = (st & 1) * 32 + (swz % 64) / 2; }
DI int perm32(int rho) { const int n = rho >> 4, i = rho & 15; return 8 * (i >> 2) + 4 * n + (i & 3); }

typedef float f32x2 __attribute__((ext_vector_type(2)));
DI float gelu1(float v) {
  const float av = __builtin_fabsf(v), d = av * 0.2316418882f + 1.0f;
  const float t = __builtin_amdgcn_rcpf(d);
  float q = t * 0.5307027145f + (-0.7265760135f); q = q * t + 0.7107068705f; q = q * t + (-0.142248368f); q = q * t + 0.127414796f; q = q * t;
  const float e = __builtin_amdgcn_exp2f((v * v) * (-0.72134752044f));
  const float m = v * (q * e), r = v - m;
  return v < 0.f ? m : r;
}
DI float dpp_shr1(float old, float src) { asm volatile("s_nop 1\n\tv_mov_b32_dpp %0, %1 row_shr:1 row_mask:0xf bank_mask:0xf\n\ts_nop 0" : "+v"(old) : "v"(src)); return old; }
DI float dpp_shl1(float old, float src) { asm volatile("s_nop 1\n\tv_mov_b32_dpp %0, %1 row_shl:1 row_mask:0xf bank_mask:0xf\n\ts_nop 0" : "+v"(old) : "v"(src)); return old; }
struct Unit { int pm, pn; };
struct Order {
  int nM, nN, nwg, G, c;
  DI void init(int nM_, int nN_, int G_, int c_) { nM = nM_; nN = nN_; nwg = nM * nN; G = G_; c = c_; }
  DI bool next(int i, Unit& u) const {
    const long Lq = (long)i * G + c; if (Lq >= nwg) return false;
    int wgid = (int)Lq; { const int q = nwg / 8, r = nwg % 8, xcd = wgid % 8, off = wgid / 8; wgid = (xcd < r ? xcd * (q + 1) : r * (q + 1) + (xcd - r) * q) + off; }
    const int nig = 8 * nN, gid = wgid / nig, fm = gid * 8, gsz = (nM - fm) < 8 ? (nM - fm) : 8;
    u.pm = fm + ((wgid % nig) % gsz); u.pn = (wgid % nig) / gsz; return true;
  }
};
struct Gemm { const u16* A; int lda; const u16* Bt; int K; };
template <int ROWMODE> DI const char* a_tile_ptr(const Gemm& g, int pm) {
  long row = ROWMODE == 0 ? (long)pm * 256 : (long)(pm / 33) * T + 254 * (pm % 33) - 1;
  return (const char*)g.A + row * g.lda * 2;
}
struct EpiArgs {
  u16* pa; u16* pb; u16* vt;
  float* xf; u16* xb;
  u16* g; const float* cw; const float* cb;
  int zero; int pre_f32;
};
template <int EPI>
DI void epilogue(f32x4 (&acc)[2][2][4][2], const Unit& u, const EpiArgs& ea, LAS unsigned char* lds) {
  int tid2 = threadIdx.x; asm volatile("" : "+v"(tid2));
  const int wid2 = tid2 >> 6, lane2 = tid2 & 63, wr = wid2 >> 2, wc = wid2 & 3, fr = lane2 & 15, fq = lane2 >> 4;
  if (EPI == 0) {
    const int row0 = u.pm * 256 + wr * 64 + fr;
#pragma unroll
    for (int ai = 0; ai < 2; ++ai)
#pragma unroll
      for (int m = 0; m < 4; ++m) {
        const int row = row0 + ai * HALF + m * 16;
#pragma unroll
        for (int bj = 0; bj < 2; ++bj) {
          const int col = u.pn * 256 + bj * HALF + wc * 32 + 8 * fq;
          const f32x4 a0 = acc[ai][bj][m][0], a1 = acc[ai][bj][m][1];
          if (u.pn <= 10) {
            uint4 pk; pk.x = cvt_pk_bf16(a0[0], a0[1]); pk.y = cvt_pk_bf16(a0[2], a0[3]); pk.z = cvt_pk_bf16(a1[0], a1[1]); pk.w = cvt_pk_bf16(a1[2], a1[3]);
            if (u.pn <= 6) { if (col < A_COLS) *(uint4*)(ea.pa + (size_t)row * A_COLS + col) = pk; }
            else *(uint4*)(ea.pb + (size_t)row * 1024 + (col - 1792)) = pk;
          } else {
            const int c2 = col - 2816, h = c2 >> 7, e = c2 & 127, seq = row / T, t = row % T;
            u16* dst = ea.vt + ((size_t)((seq * 4 + h) * 128 + e)) * T + t;
#pragma unroll
            for (int j = 0; j < 4; ++j) { dst[(size_t)j * T] = f2bf(a0[j]); dst[(size_t)(4 + j) * T] = f2bf(a1[j]); }
          }
        }
      }
  } else if (EPI == 1) {
    const int row0 = u.pm * 256 + wr * 64 + fr, col0 = u.pn * 256 + wc * 32 + 4 * fq;
#pragma unroll
    for (int ai = 0; ai < 2; ++ai)
#pragma unroll
      for (int m = 0; m < 4; ++m) {
        float* rowp = ea.xf + (size_t)(row0 + ai * HALF + m * 16) * D + col0;
        u16* rowb = ea.xb + (size_t)(row0 + ai * HALF + m * 16) * D + col0;
#pragma unroll
        for (int bj = 0; bj < 2; ++bj)
#pragma unroll
          for (int n = 0; n < 2; ++n) { f32x4* p4 = (f32x4*)(rowp + bj * HALF + n * 16); const u32x2 xr = *(const u32x2*)(rowb + bj * HALF + n * 16);
            f32x4 x; x[0] = __uint_as_float(xr.x << 16); x[1] = __uint_as_float(xr.x & 0xffff0000u); x[2] = __uint_as_float(xr.y << 16); x[3] = __uint_as_float(xr.y & 0xffff0000u);
            const f32x4 pre = x * ALPHA + acc[ai][bj][m][n];
            if (ea.pre_f32) *p4 = pre;
            else { u32x2 hq; hq.x = cvt_pk_bf16(pre[0], pre[1]); hq.y = cvt_pk_bf16(pre[2], pre[3]); *(u32x2*)(rowb + bj * HALF + n * 16) = hq; } }
      }
  } else {
    LAS float* E = (LAS float*)(lds + STAGE_BYTES);
    const int seq = u.pm / 33, ti = u.pm % 33;
    const int cl0 = wc * 32 + 8 * fq;
#pragma unroll
    for (int ai = 0; ai < 2; ++ai)
#pragma unroll
      for (int m = 0; m < 4; ++m) {
        const int rl = ai * HALF + wr * 64 + m * 16 + fr;
        const int tok = 254 * ti - 1 + rl;
        const bool valid = tok >= 0 && tok < T;
        const int blk = ai * 8 + wr * 4 + m;
#pragma unroll
        for (int bj = 0; bj < 2; ++bj)
#pragma unroll
          for (int n = 0; n < 2; ++n) {
            if (!valid) acc[ai][bj][m][n] = (f32x4){0.f, 0.f, 0.f, 0.f};
            if (fr == 0) *(LAS f32x4*)(E + ((blk * 2 + 0) * 2 + bj) * 128 + cl0 + 4 * n) = acc[ai][bj][m][n];
            if (fr == 15) *(LAS f32x4*)(E + ((blk * 2 + 1) * 2 + bj) * 128 + cl0 + 4 * n) = acc[ai][bj][m][n];
          }
      }
    asm volatile("s_waitcnt lgkmcnt(0)" ::: "memory");
    __builtin_amdgcn_s_barrier(); asm volatile("" ::: "memory");
    __builtin_amdgcn_s_barrier(); asm volatile("" ::: "memory");
#pragma unroll
    for (int n = 0; n < 2; ++n) {
      const int hid = u.pn * 128 + cl0 + 4 * n;
      const float* cwp = ea.cw + hid;
      const f32x4 g0 = *(const f32x4*)(cwp), g1 = *(const f32x4*)(cwp + NUP), g2 = *(const f32x4*)(cwp + 2 * NUP), gb = *(const f32x4*)(ea.cb + hid);
      const f32x4 u0 = *(const f32x4*)(cwp + DFF), u1 = *(const f32x4*)(cwp + DFF + NUP), u2 = *(const f32x4*)(cwp + DFF + 2 * NUP), ub = *(const f32x4*)(ea.cb + DFF + hid);
#pragma unroll
      for (int ai = 0; ai < 2; ++ai)
#pragma unroll
        for (int m = 0; m < 4; ++m) {
          const int blk = ai * 8 + wr * 4 + m;
          const int rl = ai * HALF + wr * 64 + m * 16 + fr;
          const int tok = 254 * ti - 1 + rl;
          f32x4 hh[2];
#pragma unroll
          for (int bj = 0; bj < 2; ++bj) {
            const f32x4 cur = acc[ai][bj][m][n];
            f32x4 ab = (f32x4){0.f, 0.f, 0.f, 0.f}, be = (f32x4){0.f, 0.f, 0.f, 0.f};
            if (fr == 0 && blk > 0) ab = *(LAS f32x4*)(E + (((blk - 1) * 2 + 1) * 2 + bj) * 128 + cl0 + 4 * n);
            if (fr == 15 && blk < 15) be = *(LAS f32x4*)(E + (((blk + 1) * 2 + 0) * 2 + bj) * 128 + cl0 + 4 * n);
            f32x4 prev, next;
#pragma unroll
            for (int j = 0; j < 4; ++j) { prev[j] = dpp_shr1(ab[j], cur[j]); next[j] = dpp_shl1(be[j], cur[j]); }
            hh[bj] = bj == 0 ? g0 * prev + g1 * cur + g2 * next + gb : u0 * prev + u1 * cur + u2 * next + ub;
          }
          f32x4 res;
#pragma unroll
          for (int j = 0; j < 4; ++j) res[j] = gelu1(hh[0][j]) * hh[1][j];
          if (rl >= 1 && rl <= 254 && tok < T) {
            u32x2 pk; pk.x = cvt_pk_bf16(res[0], res[1]); pk.y = cvt_pk_bf16(res[2], res[3]);
            *(u32x2*)(ea.g + (size_t)(seq * T + tok) * DFF + hid) = pk;
          }
        }
    }
  }
}

template <int EPI, int ROWMODE>
DI void gemm_phase(LAS unsigned char* lds, const Gemm g, int nM, int nN, const EpiArgs& ea) {
  constexpr bool PERM = (EPI != 1);
  int tid = threadIdx.x; asm volatile("" : "+v"(tid));
  int bid = blockIdx.x, gdim = gridDim.x; asm volatile("" : "+s"(bid), "+s"(gdim));
  const int wid = __builtin_amdgcn_readfirstlane(tid >> 6), lane = tid & 63, wr = wid >> 2, wc = wid & 3, fr = lane & 15, fq = lane >> 4;
  const int K = g.K, nt = K / BK;
  Order S; S.init(nM, nN, gdim, bid);
  unsigned voffA[2], voffB[2];
#pragma unroll
  for (int i = 0; i < 2; ++i) { int R, C; stage_rc(tid * 16 + i * 8192, R, C); const int Rb = PERM ? ((R & ~31) + perm32(R & 31)) : R;
    voffA[i] = (unsigned)(R * g.lda + C) * 2u; voffB[i] = (unsigned)(Rb * K + C) * 2u; }
  const size_t kstep = (size_t)(BK * 2);
  const size_t hstepA = (size_t)HALF * g.lda * 2, hstepB = (size_t)HALF * K * 2;
  const unsigned ldsw = (unsigned)wid * 1024u;
  const int aoff = lds_byte(wr * 64 + fr, fq * 8), boff = lds_byte(wc * 32 + fr, fq * 8);
#define PG8_SA(b, h) (((b) * 2 + (h)) * HTB)
#define PG8_SB(b, h) ((4 + (b) * 2 + (h)) * HTB)
#define PG8_STAGE(bufoff, gbase, voff) do { _Pragma("unroll") for (int _i = 0; _i < 2; ++_i) \
    __builtin_amdgcn_global_load_lds((const unsigned*)((const char*)(gbase) + (voff)[_i]), (LAS unsigned*)(lds + (bufoff) + ldsw + _i * 8192), 16, 0, 0); } while (0)
#define PG8_LDA(dst, b, h) do { _Pragma("unroll") for (int m = 0; m < 4; ++m) _Pragma("unroll") for (int k = 0; k < 2; ++k) dst[m][k] = *(const LAS bf16x8*)(lds + PG8_SA(b, h) + aoff + m * 2048 + k * 1024); } while (0)
#define PG8_LDB(dst, b, h) do { _Pragma("unroll") for (int n = 0; n < 2; ++n) _Pragma("unroll") for (int k = 0; k < 2; ++k) dst[n][k] = *(const LAS bf16x8*)(lds + PG8_SB(b, h) + boff + n * 2048 + k * 1024); } while (0)
#define PG8_MMA(ai, bj, At, Bq) do { __builtin_amdgcn_s_setprio(1); _Pragma("unroll") for (int m = 0; m < 4; ++m) _Pragma("unroll") for (int n = 0; n < 2; ++n) _Pragma("unroll") for (int k = 0; k < 2; ++k) \
    acc[ai][bj][m][n] = __builtin_amdgcn_mfma_f32_16x16x32_bf16(Bq[n][k], At[m][k], acc[ai][bj][m][n], 0, 0, 0); __builtin_amdgcn_s_setprio(0); } while (0)
#define PG8_WAIT_V(n) asm volatile("s_waitcnt vmcnt(" #n ")" ::: "memory")
#define PG8_WAIT_L(n) asm volatile("s_waitcnt lgkmcnt(" #n ")" ::: "memory")
#define PG8_BAR __builtin_amdgcn_s_barrier()
#define PG8_SCHED __builtin_amdgcn_sched_barrier(0)
  Unit cur, nxt; int ui = 0;
  __syncthreads();
  if (!S.next(0, cur)) return;
  f32x4 acc[2][2][4][2];
#pragma unroll
  for (int a = 0; a < 2; ++a)
#pragma unroll
    for (int b = 0; b < 2; ++b)
#pragma unroll
      for (int m = 0; m < 4; ++m)
#pragma unroll
        for (int n = 0; n < 2; ++n) acc[a][b][m][n] = (f32x4){0.f, 0.f, 0.f, 0.f};
  bf16x8 At[4][2], B0[2][2], B1[2][2];
  const char* cA = a_tile_ptr<ROWMODE>(g, cur.pm); const char* cB = (const char*)g.Bt + (size_t)cur.pn * 2 * hstepB;
  PG8_STAGE(PG8_SB(0, 0), cB, voffB); PG8_STAGE(PG8_SA(0, 0), cA, voffA); PG8_STAGE(PG8_SB(0, 1), cB + hstepB, voffB); PG8_STAGE(PG8_SA(0, 1), cA + hstepA, voffA);
  if (wr == 1) PG8_BAR;
  PG8_WAIT_V(4); PG8_BAR;
  PG8_STAGE(PG8_SB(1, 0), cB + kstep, voffB); PG8_STAGE(PG8_SA(1, 0), cA + kstep, voffA); PG8_STAGE(PG8_SB(1, 1), cB + hstepB + kstep, voffB);
  PG8_WAIT_V(6); PG8_BAR;
  for (;;) {
    const bool has_next = S.next(ui + 1, nxt);
    const char* nA = has_next ? a_tile_ptr<ROWMODE>(g, nxt.pm) : cA; const char* nB = has_next ? (const char*)g.Bt + (size_t)nxt.pn * 2 * hstepB : cB;
    for (int t = 0; t < nt; t += 2) {
      const bool last = (t == nt - 2);
      const char* a1 = cA + (size_t)(t + 1) * kstep;
      const char* a2 = last ? nA : cA + (size_t)(t + 2) * kstep; const char* b2 = last ? nB : cB + (size_t)(t + 2) * kstep;
      const char* a3 = a2 + kstep; const char* b3 = b2 + kstep;
      PG8_LDB(B0, 0, 0); PG8_SCHED; PG8_LDA(At, 0, 0); PG8_STAGE(PG8_SA(1, 1), a1 + hstepA, voffA);
      PG8_WAIT_L(8); PG8_BAR; PG8_WAIT_L(0); PG8_MMA(0, 0, At, B0); PG8_BAR; PG8_SCHED;
      PG8_LDB(B1, 0, 1); PG8_STAGE(PG8_SB(0, 0), b2, voffB);
      PG8_BAR; PG8_WAIT_L(0); PG8_MMA(0, 1, At, B1); PG8_BAR;
      PG8_LDA(At, 0, 1); PG8_STAGE(PG8_SA(0, 0), a2, voffA);
      PG8_BAR; PG8_WAIT_L(0); PG8_MMA(1, 0, At, B0); PG8_BAR; PG8_SCHED;
      PG8_STAGE(PG8_SB(0, 1), b2 + hstepB, voffB);
      PG8_WAIT_V(6); PG8_BAR; PG8_MMA(1, 1, At, B1); PG8_BAR;
      PG8_LDB(B0, 1, 0); PG8_SCHED; PG8_LDA(At, 1, 0); PG8_STAGE(PG8_SA(0, 1), a2 + hstepA, voffA);
      PG8_WAIT_L(8); PG8_BAR; PG8_WAIT_L(0); PG8_MMA(0, 0, At, B0); PG8_BAR; PG8_SCHED;
      PG8_LDB(B1, 1, 1); PG8_STAGE(PG8_SB(1, 0), b3, voffB);
      PG8_BAR; PG8_WAIT_L(0); PG8_MMA(0, 1, At, B1); PG8_BAR;
      PG8_LDA(At, 1, 1); PG8_STAGE(PG8_SA(1, 0), a3, voffA);
      PG8_BAR; PG8_WAIT_L(0); PG8_MMA(1, 0, At, B0); PG8_BAR; PG8_SCHED;
      PG8_STAGE(PG8_SB(1, 1), b3 + hstepB, voffB);
      PG8_WAIT_V(6); PG8_BAR; PG8_MMA(1, 1, At, B1); PG8_BAR;
    }
    epilogue<EPI>(acc, cur, ea, lds);
    if (!has_next) break;
#pragma unroll
    for (int a = 0; a < 2; ++a)
#pragma unroll
      for (int b = 0; b < 2; ++b)
#pragma unroll
        for (int m = 0; m < 4; ++m)
#pragma unroll
          for (int n = 0; n < 2; ++n) acc[a][b][m][n] = (f32x4){0.f, 0.f, 0.f, 0.f};
    cur = nxt; cA = nA; cB = nB; ++ui;
  }
  PG8_WAIT_V(0);
  if (wr == 0) PG8_BAR;
  PG8_BAR;
#undef PG8_SA
#undef PG8_SB
}

constexpr int KROW = 144, VROW = 144;
constexpr int KBUF = 64 * KROW, VBUF = 128 * VROW, ABUF = KBUF + VBUF;
constexpr float LOG2E = 1.4426950408889634f;
DI bf16x8 pack8(const f32x16& x, int s) {
  u32x4 p; p.x = cvt_pk_bf16(x[8 * s], x[8 * s + 1]); p.y = cvt_pk_bf16(x[8 * s + 2], x[8 * s + 3]); p.z = cvt_pk_bf16(x[8 * s + 4], x[8 * s + 5]); p.w = cvt_pk_bf16(x[8 * s + 6], x[8 * s + 7]);
  return __builtin_bit_cast(bf16x8, p);
}
DI void attn_phase(LAS unsigned char* lds, u16* PB, const u16* VT, float* OSV, const float* lamp, const float* subg, const float* relb, int layer, int pair_lo, int pair_hi, int wg_lo, int wg_cnt) {
  int tid = threadIdx.x; asm volatile("" : "+v"(tid));
  int bid = blockIdx.x, gdim = gridDim.x; asm volatile("" : "+s"(bid), "+s"(gdim));
  const int wid = tid >> 6, lane = tid & 63, qi = lane & 31, g = lane >> 5;
  LAS float* tab = (LAS float*)(lds + 4 * ABUF);
  LAS float* scal = tab + 264;
  const float lam_init = 0.8f - 0.6f * __expf(-0.3f * (float)layer);
  __syncthreads();
  if (wid == 0) {
    float a = lamp[lane] * lamp[64 + lane], b = lamp[128 + lane] * lamp[192 + lane];
    for (int o = 32; o > 0; o >>= 1) { a += __shfl_xor(a, o); b += __shfl_xor(b, o); }
    if (lane == 0) scal[0] = __expf(a) - __expf(b) + lam_init;
  }
  const int m_sw = (qi & 0x13) | ((qi & 4) << 1) | ((qi & 8) >> 1);
  if (bid < wg_lo || bid >= wg_lo + wg_cnt) return;
  const int xcd = bid & 7, jq = (bid - wg_lo) >> 3;
  const int per_x = wg_cnt >> 3;
  const float c1 = 0.125f * LOG2E;
  for (int pr = pair_lo + xcd; pr < pair_hi; pr += 8) {
    const int s = pr >> 2, h = pr & 3;
    for (int qb = jq; qb < 32; qb += per_x) {
      __syncthreads();
      for (int i = tid; i < 257; i += NTHREADS) {
        const int rel = i - 128, n = rel < 0 ? -rel : rel;
        int bk = n < 8 ? n : (n <= 11 ? 8 : (n <= 15 ? 9 : (n <= 22 ? 10 : (n <= 31 ? 11 : (n <= 45 ? 12 : (n <= 63 ? 13 : (n <= 90 ? 14 : 15)))))));
        if (rel > 0) bk += 16;
        tab[i] = relb[bk * 4 + h] * LOG2E;
      }
      const int q0 = qb * 256 + wid * 32;
      const size_t tokbase = (size_t)s * T;
      float* osv = OSV + ((size_t)bid * 512 + tid) * 64;
#pragma unroll 1
      for (int c = 0; c < 2; ++c) {
        bf16x8 Q[4];
        { const u16* qp = PB + (tokbase + q0 + qi) * 1024 + h * 128 + c * 64 + g * 8;
#pragma unroll
          for (int ks = 0; ks < 4; ++ks) Q[ks] = *(const bf16x8*)(qp + ks * 16); }
        f32x16 O[4];
#pragma unroll
        for (int eb = 0; eb < 4; ++eb)
#pragma unroll
          for (int i = 0; i < 16; ++i) O[eb][i] = 0.f;
        float mrun = -1e30f, lrun = 0.f;
        const u16* kg = PB + (tokbase + (tid >> 3)) * 1024 + 512 + h * 128 + c * 64 + (tid & 7) * 8;
        const u16* vg = VT + ((size_t)((s * 4 + h) * 128 + (tid >> 2))) * T + (tid & 3) * 16;
        const unsigned kl = (tid >> 3) * KROW + (tid & 7) * 16, vl = KBUF + (tid >> 2) * VROW + (tid & 3) * 32;
        u32x4 rk0, rv0, rv1, rkB, rvB0, rvB1;
        rk0 = *(const u32x4*)(kg); rv0 = *(const u32x4*)(vg); rv1 = *(const u32x4*)(vg + 8);
        rkB = *(const u32x4*)(kg + (size_t)64 * 1024); rvB0 = *(const u32x4*)(vg + 64); rvB1 = *(const u32x4*)(vg + 64 + 8);
        __syncthreads();
        *(LAS u32x4*)(lds + kl) = rk0; *(LAS u32x4*)(lds + vl) = rv0; *(LAS u32x4*)(lds + vl + 16) = rv1;
        *(LAS u32x4*)(lds + ABUF + kl) = rkB; *(LAS u32x4*)(lds + ABUF + vl) = rvB0; *(LAS u32x4*)(lds + ABUF + vl + 16) = rvB1;
        __syncthreads();
        auto compute_tile = [&](const int kt, LAS unsigned char* buf) {
          const int kmin = kt * 64;
          const int dlo = kmin + 63 - q0, dhi = kmin - (q0 + 31);
          const int bmode = dlo <= -91 ? 0 : (dhi >= 91 ? 1 : 2);
          const float bconst = bmode == 0 ? tab[0] : tab[256];
          f32x16 S[2];
          {
            bf16x8 kf[2][4];
#pragma unroll
            for (int kb = 0; kb < 2; ++kb)
#pragma unroll
              for (int ks = 0; ks < 4; ++ks) kf[kb][ks] = *(const LAS bf16x8*)(buf + (kb * 32 + m_sw) * KROW + (ks * 16 + g * 8) * 2);
            __builtin_amdgcn_sched_barrier(0);
            __builtin_amdgcn_s_setprio(1);
#pragma unroll
            for (int kb = 0; kb < 2; ++kb) {
#pragma unroll
              for (int i = 0; i < 16; ++i) S[kb][i] = 0.f;
#pragma unroll
              for (int ks = 0; ks < 4; ++ks) S[kb] = __builtin_amdgcn_mfma_f32_32x32x16_bf16(kf[kb][ks], Q[ks], S[kb], 0, 0, 0);
            }
            __builtin_amdgcn_s_setprio(0);
          }
          bf16x8 vf[2][4];
          float sc = c1, off = bconst;
          if (bmode == 2) {
#pragma unroll
            for (int kb = 0; kb < 2; ++kb)
#pragma unroll
              for (int r = 0; r < 16; ++r) {
                int rel = kmin + kb * 32 + 16 * (r >> 3) + 8 * g + (r & 7) - (q0 + qi);
                rel = rel < -128 ? -128 : (rel > 128 ? 128 : rel);
                S[kb][r] = S[kb][r] * c1 + tab[rel + 128];
              }
            sc = 1.f; off = 0.f;
          }
          float mx = -3e38f;
#pragma unroll
          for (int kb = 0; kb < 2; ++kb)
#pragma unroll
            for (int r = 0; r < 16; ++r) mx = fmaxf(mx, S[kb][r]);
          mx = fmaxf(mx, __shfl_xor(mx, 32));
          mx = mx * sc + off;
          if (__any(mx > mrun + 8.f)) {
            const float mnew = mx > mrun + 8.f ? mx : mrun;
            const float alpha = __builtin_amdgcn_exp2f(mrun - mnew);
            mrun = mnew; lrun *= alpha;
#pragma unroll
            for (int eb = 0; eb < 4; ++eb)
#pragma unroll
              for (int i = 0; i < 16; ++i) O[eb][i] *= alpha;
          }
          const float sh = off - mrun;
          float ps0 = 0.f, ps1 = 0.f, ps2 = 0.f, ps3 = 0.f;
#pragma unroll
          for (int kb = 0; kb < 2; ++kb)
#pragma unroll
            for (int r = 0; r < 16; r += 4) {
              const float p0 = __builtin_amdgcn_exp2f(S[kb][r] * sc + sh), p1 = __builtin_amdgcn_exp2f(S[kb][r + 1] * sc + sh), p2 = __builtin_amdgcn_exp2f(S[kb][r + 2] * sc + sh), p3 = __builtin_amdgcn_exp2f(S[kb][r + 3] * sc + sh);
              S[kb][r] = p0; S[kb][r + 1] = p1; S[kb][r + 2] = p2; S[kb][r + 3] = p3; ps0 += p0; ps1 += p1; ps2 += p2; ps3 += p3;
            }
          lrun += (ps0 + ps1) + (ps2 + ps3);
          __builtin_amdgcn_sched_barrier(0);
          __builtin_amdgcn_s_setprio(1);
#pragma unroll
          for (int eb = 0; eb < 4; ++eb) vf[0][eb] = *(const LAS bf16x8*)(buf + KBUF + (eb * 32 + qi) * VROW + (g * 8) * 2);
#pragma unroll
          for (int stp = 0; stp < 4; ++stp) {
            const int kb = stp >> 1, hh = stp & 1;
            if (stp < 3) {
#pragma unroll
              for (int eb = 0; eb < 4; ++eb) vf[(stp + 1) & 1][eb] = *(const LAS bf16x8*)(buf + KBUF + (eb * 32 + qi) * VROW + ((stp + 1) * 16 + g * 8) * 2);
            }
            const bf16x8 pb = pack8(S[kb], hh);
#pragma unroll
            for (int eb = 0; eb < 4; ++eb) O[eb] = __builtin_amdgcn_mfma_f32_32x32x16_bf16(vf[stp & 1][eb], pb, O[eb], 0, 0, 0);
          }
          __builtin_amdgcn_s_setprio(0);
        };
        { const u16* kg2 = kg + (size_t)2 * 64 * 1024; const u16* vg2 = vg + 128;
          rk0 = *(const u32x4*)(kg2); rv0 = *(const u32x4*)(vg2); rv1 = *(const u32x4*)(vg2 + 8);
          const u16* kg3 = kg + (size_t)3 * 64 * 1024; const u16* vg3 = vg + 192;
          rkB = *(const u32x4*)(kg3); rvB0 = *(const u32x4*)(vg3); rvB1 = *(const u32x4*)(vg3 + 8); }
#pragma unroll 1
        for (int kt = 0; kt < 128; kt += 2) {
          LAS unsigned char* buf = lds + ((kt >> 1) & 1) * 2 * ABUF;
          LAS unsigned char* nbuf = lds + (((kt >> 1) + 1) & 1) * 2 * ABUF;
          compute_tile(kt, buf);
          compute_tile(kt + 1, buf + ABUF);
          *(LAS u32x4*)(nbuf + kl) = rk0; *(LAS u32x4*)(nbuf + vl) = rv0; *(LAS u32x4*)(nbuf + vl + 16) = rv1;
          *(LAS u32x4*)(nbuf + ABUF + kl) = rkB; *(LAS u32x4*)(nbuf + ABUF + vl) = rvB0; *(LAS u32x4*)(nbuf + ABUF + vl + 16) = rvB1;
          { const int tn = kt + 4 < 128 ? kt + 4 : 127; const u16* kg2 = kg + (size_t)tn * 64 * 1024; const u16* vg2 = vg + tn * 64;
            rk0 = *(const u32x4*)(kg2); rv0 = *(const u32x4*)(vg2); rv1 = *(const u32x4*)(vg2 + 8); }
          { const int tn = kt + 5 < 128 ? kt + 5 : 127; const u16* kg2 = kg + (size_t)tn * 64 * 1024; const u16* vg2 = vg + tn * 64;
            rkB = *(const u32x4*)(kg2); rvB0 = *(const u32x4*)(vg2); rvB1 = *(const u32x4*)(vg2 + 8); }
          __syncthreads();
        }
        const float lt = lrun + __shfl_xor(lrun, 32);
        asm volatile("" : "+v"(osv));
        if (c == 0) {
          const float i0 = 1.f / lt;
#pragma unroll
          for (int eb = 0; eb < 4; ++eb)
#pragma unroll
            for (int i = 0; i < 16; i += 4) { f32x4 t4; t4[0] = O[eb][i] * i0; t4[1] = O[eb][i + 1] * i0; t4[2] = O[eb][i + 2] * i0; t4[3] = O[eb][i + 3] * i0; *(f32x4*)(osv + eb * 16 + i) = t4; }
        } else {
          const float i1 = scal[0] / lt;
          float ss = 0.f;
#pragma unroll
          for (int eb = 0; eb < 4; ++eb)
#pragma unroll
            for (int i = 0; i < 16; i += 4) { const f32x4 t4 = *(const f32x4*)(osv + eb * 16 + i);
#pragma unroll
              for (int j = 0; j < 4; ++j) { const float o = t4[j] - O[eb][i + j] * i1; O[eb][i + j] = o; ss += o * o; } }
          ss += __shfl_xor(ss, 32);
          const float rs = rsqrtf(ss * (1.f / 128.f) + LN_EPS) * (1.f - lam_init);
          u16* op = PB + (tokbase + q0 + qi) * 1024 + h * 128;
#pragma unroll
          for (int eb = 0; eb < 4; ++eb)
#pragma unroll
            for (int rr = 0; rr < 4; ++rr) {
              const int e = eb * 32 + 8 * rr + 4 * g;
              const f32x4 gg = *(const f32x4*)(subg + e);
              u32x2 pk; pk.x = cvt_pk_bf16(O[eb][4 * rr] * rs * gg[0], O[eb][4 * rr + 1] * rs * gg[1]); pk.y = cvt_pk_bf16(O[eb][4 * rr + 2] * rs * gg[2], O[eb][4 * rr + 3] * rs * gg[3]);
              *(u32x2*)(op + e) = pk;
            }
        }
      }
    }
  }
}

DI float softplusf_(float x) { return fmaxf(x, 0.f) + __logf(1.f + __expf(-fabsf(x))); }
DI void load_bf16x8(const u16* p, float (&o)[8]) {
  const u32x4 v = *(const u32x4*)p;
#pragma unroll
  for (int i = 0; i < 4; ++i) { o[2 * i] = __uint_as_float(v[i] << 16); o[2 * i + 1] = __uint_as_float(v[i] & 0xffff0000u); }
}
DI void shifted8(const u16* PA, size_t row, int t, int col, const float* mu0, const float* mu1, float (&o)[8]) {
  float c[8], pv[8], nx[8];
  load_bf16x8(PA + row * A_COLS + col, c);
  if (t > 0) load_bf16x8(PA + (row - 1) * A_COLS + col, pv); else { for (int i = 0; i < 8; ++i) pv[i] = 0.f; }
  if (t < T - 1) load_bf16x8(PA + (row + 1) * A_COLS + col, nx); else { for (int i = 0; i < 8; ++i) nx[i] = 0.f; }
#pragma unroll
  for (int i = 0; i < 8; ++i) o[i] = c[i] + mu0[col + i] * (pv[i] - c[i]) + mu1[col + i] * (nx[i] - c[i]);
}

DI void vprep_phase(LAS unsigned char* lds, const u16* PA, u16* VV, const float* mu, const float* vdown, const float* vup, const float* v0, int layer) {
  int tid = threadIdx.x; asm volatile("" : "+v"(tid));
  int bid = blockIdx.x, gdim = gridDim.x; asm volatile("" : "+s"(bid), "+s"(gdim));
  const int tok = tid >> 4, j = tid & 15;
  LAS unsigned* VS2 = (LAS unsigned*)lds;
  LAS unsigned* DD2 = VS2 + 32 * 256;
  LAS unsigned* DN2 = DD2 + 32 * 16;
  LAS unsigned* UP2 = DN2 + 256 * 32;
  const float* mu0 = mu; const float* mu1 = mu + A_COLS;
  __syncthreads();
  if (layer != 0) {
    for (int e = tid; e < 256 * 32; e += NTHREADS) { const int c2 = e >> 5, r = e & 31; DN2[e] = cvt_pk_bf16(vdown[(2 * c2) * 32 + r], vdown[(2 * c2 + 1) * 32 + r]); }
    for (int e = tid; e < 16 * 512; e += NTHREADS) { const int r2 = e >> 9, c = e & 511; UP2[(r2 * 2 + ((c >> 2) & 1)) * 256 + (c >> 3) * 4 + (c & 3)] = cvt_pk_bf16(vup[(2 * r2) * 512 + c], vup[(2 * r2 + 1) * 512 + c]); }
  }
  for (int it = bid; it < NT / 32; it += gdim) {
    const size_t row = (size_t)it * 32 + tok; const int t = (int)(row % T);
    __syncthreads();
#pragma unroll 1
    for (int q = 0; q < 4; ++q) {
      const int cc = q * 128 + j * 8;
      float o[8]; shifted8(PA, row, t, OFF_V + cc, mu0, mu1, o);
      u32x4 pk; pk.x = cvt_pk_bf16(o[0], o[1]); pk.y = cvt_pk_bf16(o[2], o[3]); pk.z = cvt_pk_bf16(o[4], o[5]); pk.w = cvt_pk_bf16(o[6], o[7]);
      if (layer == 0) *(u32x4*)(VV + row * 512 + cc) = pk;
      else *(LAS u32x4*)(VS2 + tok * 256 + (cc >> 1)) = pk;
    }
    if (layer == 0) continue;
    __syncthreads();
    {
      float d0 = 0.f, d1 = 0.f;
#pragma unroll 8
      for (int c2 = 0; c2 < 256; ++c2) {
        const bf2 x = __builtin_bit_cast(bf2, VS2[tok * 256 + c2]);
        const u32x2 w2 = *(const LAS u32x2*)(DN2 + c2 * 32 + 2 * j);
        unsigned ua = w2.x, ub = w2.y; asm volatile("" : "+v"(ua), "+v"(ub));
        d0 = __builtin_amdgcn_fdot2_f32_bf16(x, __builtin_bit_cast(bf2, ua), d0, false); d1 = __builtin_amdgcn_fdot2_f32_bf16(x, __builtin_bit_cast(bf2, ub), d1, false);
      }
      DD2[tok * 16 + j] = cvt_pk_bf16(d0, d1);
    }
    __syncthreads();
#pragma unroll 1
    for (int q = 0; q < 4; ++q) {
      const int c0 = q * 128 + j * 8;
      float acc[8];
      { const f32x4 a0 = *(const f32x4*)(v0 + c0), a1 = *(const f32x4*)(v0 + c0 + 4);
#pragma unroll
        for (int i = 0; i < 4; ++i) { acc[i] = a0[i]; acc[4 + i] = a1[i]; } }
#pragma unroll 4
      for (int r2 = 0; r2 < 16; ++r2) {
        const bf2 dv = __builtin_bit_cast(bf2, DD2[tok * 16 + r2]);
        const u32x4 wa = *(const LAS u32x4*)(UP2 + (r2 * 2 + 0) * 256 + (c0 >> 3) * 4), wb = *(const LAS u32x4*)(UP2 + (r2 * 2 + 1) * 256 + (c0 >> 3) * 4);
#pragma unroll
        for (int i = 0; i < 4; ++i) { unsigned ua = wa[i], ub = wb[i]; asm volatile("" : "+v"(ua), "+v"(ub));
          acc[i] = __builtin_amdgcn_fdot2_f32_bf16(dv, __builtin_bit_cast(bf2, ua), acc[i], false); acc[4 + i] = __builtin_amdgcn_fdot2_f32_bf16(dv, __builtin_bit_cast(bf2, ub), acc[4 + i], false); }
      }
      float vf[8]; load_bf16x8(VV + row * 512 + c0, vf);
      const u32x4 xs = *(const LAS u32x4*)(VS2 + tok * 256 + (c0 >> 1));
      float x[8];
#pragma unroll
      for (int i = 0; i < 4; ++i) { unsigned u = xs[i]; asm volatile("" : "+v"(u)); x[2 * i] = __uint_as_float(u << 16); x[2 * i + 1] = __uint_as_float(u & 0xffff0000u); }
      float o[8];
#pragma unroll
      for (int i = 0; i < 8; ++i) o[i] = x[i] + (vf[i] - x[i]) * sigmoidf_(acc[i]);
      u32x4 pk; pk.x = cvt_pk_bf16(o[0], o[1]); pk.y = cvt_pk_bf16(o[2], o[3]); pk.z = cvt_pk_bf16(o[4], o[5]); pk.w = cvt_pk_bf16(o[6], o[7]);
      *(u32x4*)(VV + row * 512 + c0) = pk;
    }
  }
}

struct ScanW { const float *mu, *w0, *du, *a0, *iu, *kk_, *ka, *rk; };
constexpr int SC = 32;
DI float quad_sum(float x) {
  x += __builtin_bit_cast(float, __builtin_amdgcn_update_dpp(0, __builtin_bit_cast(int, x), 0xB1, 0xf, 0xf, true));
  x += __builtin_bit_cast(float, __builtin_amdgcn_update_dpp(0, __builtin_bit_cast(int, x), 0x4E, 0xf, 0xf, true));
  return x;
}
#define BFLO(x) __uint_as_float((x) << 16)
#define BFHI(x) __uint_as_float((x) & 0xffff0000u)
DI float tanh_fast(float x) { x = fminf(fmaxf(x, -15.f), 15.f); const float t = __expf(2.f * x); return (t - 1.f) / (t + 1.f); }
DI float shift1(float c, float p, float n, float m0, float m1) { return c + m0 * (p - c) + m1 * (n - c); }
DI void scan_produce(LAS float* buf, LAS unsigned* TW, LAS unsigned* TA, LAS const unsigned* DU, LAS const unsigned* IU, const u16* PA, const u16* VV, float* BON,
                     const ScanW& w, int ptid, int sq, int h, int dir, int t0) {
  const int tok = ptid >> 3, j = ptid & 7;
  const int t = t0 + tok; const size_t row = (size_t)sq * T + t;
  const float* mu0 = w.mu; const float* mu1 = w.mu + A_COLS;
  const int cr = h * 64 + j * 8, ck = OFF_K + cr, cw_ = OFF_WD + dir * 32 + j * 4, ca_ = OFF_AD + dir * 32 + j * 4;
  const u16* pc = PA + row * A_COLS;
  const bool hp = t > 0, hn = t < T - 1;
  {
    const u32x2 w_c = *(const u32x2*)(pc + cw_), a_c = *(const u32x2*)(pc + ca_);
    u32x2 w_p = (u32x2){0u, 0u}, a_p = w_p, w_n = w_p, a_n = w_p;
    if (hp) { w_p = *(const u32x2*)(pc - A_COLS + cw_); a_p = *(const u32x2*)(pc - A_COLS + ca_); }
    if (hn) { w_n = *(const u32x2*)(pc + A_COLS + cw_); a_n = *(const u32x2*)(pc + A_COLS + ca_); }
    const f32x4 mw0 = *(const f32x4*)(mu0 + cw_), mw1 = *(const f32x4*)(mu1 + cw_), ma0 = *(const f32x4*)(mu0 + ca_), ma1 = *(const f32x4*)(mu1 + ca_);
    f32x4 tw, ta;
#pragma unroll
    for (int i = 0; i < 2; ++i) {
      tw[2 * i] = tanh_fast(shift1(BFLO(w_c[i]), BFLO(w_p[i]), BFLO(w_n[i]), mw0[2 * i], mw1[2 * i]));
      tw[2 * i + 1] = tanh_fast(shift1(BFHI(w_c[i]), BFHI(w_p[i]), BFHI(w_n[i]), mw0[2 * i + 1], mw1[2 * i + 1]));
      ta[2 * i] = shift1(BFLO(a_c[i]), BFLO(a_p[i]), BFLO(a_n[i]), ma0[2 * i], ma1[2 * i]);
      ta[2 * i + 1] = shift1(BFHI(a_c[i]), BFHI(a_p[i]), BFHI(a_n[i]), ma0[2 * i + 1], ma1[2 * i + 1]);
    }
    u32x2 tw2, ta2; tw2.x = cvt_pk_bf16(tw[0], tw[1]); tw2.y = cvt_pk_bf16(tw[2], tw[3]); ta2.x = cvt_pk_bf16(ta[0], ta[1]); ta2.y = cvt_pk_bf16(ta[2], ta[3]);
    *(LAS u32x2*)(TW + tok * 16 + j * 2) = tw2; *(LAS u32x2*)(TA + tok * 16 + j * 2) = ta2;
  }
  asm volatile("s_waitcnt lgkmcnt(0)" ::: "memory");
  float wl[8], al[8];
  const int cc = j * 8, cg_ = h * 64 + cc;
  { const f32x4 x0 = *(const f32x4*)(w.w0 + dir * 512 + cg_), x1 = *(const f32x4*)(w.w0 + dir * 512 + cg_ + 4), y0 = *(const f32x4*)(w.a0 + dir * 512 + cg_), y1 = *(const f32x4*)(w.a0 + dir * 512 + cg_ + 4);
#pragma unroll
    for (int q = 0; q < 4; ++q) { wl[q] = x0[q]; wl[4 + q] = x1[q]; al[q] = y0[q]; al[4 + q] = y1[q]; } }
#pragma unroll 2
  for (int pr = 0; pr < 16; ++pr) {
    const bf2 twp = __builtin_bit_cast(bf2, TW[tok * 16 + pr]), tap = __builtin_bit_cast(bf2, TA[tok * 16 + pr]);
    const u32x4 d0 = *(const LAS u32x4*)(DU + pr * 64 + cc), d1 = *(const LAS u32x4*)(DU + pr * 64 + cc + 4), i0 = *(const LAS u32x4*)(IU + pr * 64 + cc), i1 = *(const LAS u32x4*)(IU + pr * 64 + cc + 4);
#pragma unroll
    for (int q = 0; q < 4; ++q) {
      unsigned ua = d0[q], ub = d1[q], uc = i0[q], ud = i1[q]; asm volatile("" : "+v"(ua), "+v"(ub), "+v"(uc), "+v"(ud));
      wl[q] = __builtin_amdgcn_fdot2_f32_bf16(twp, __builtin_bit_cast(bf2, ua), wl[q], false); wl[4 + q] = __builtin_amdgcn_fdot2_f32_bf16(twp, __builtin_bit_cast(bf2, ub), wl[4 + q], false);
      al[q] = __builtin_amdgcn_fdot2_f32_bf16(tap, __builtin_bit_cast(bf2, uc), al[q], false); al[4 + q] = __builtin_amdgcn_fdot2_f32_bf16(tap, __builtin_bit_cast(bf2, ud), al[4 + q], false);
    }
  }
#pragma unroll
  for (int q = 0; q < 8; ++q) { asm volatile("" : "+v"(wl[q]), "+v"(al[q])); }
  LAS float* AW = buf; LAS float* AK = buf + 2048; LAS float* AB = buf + 4096; LAS float* AD = buf + 6144; LAS float* AR = buf + 8192; LAS float* AV = buf + 10240;
  const int o = tok * 64 + cc;
  float ss = 0.f, bs = 0.f;
  float ok[8], av[8];
#pragma unroll
  for (int hq = 0; hq < 2; ++hq) {
    const int c4 = 4 * hq;
    const u32x2 r_c = *(const u32x2*)(pc + cr + c4), k_c = *(const u32x2*)(pc + ck + c4);
    u32x2 r_p = (u32x2){0u, 0u}, k_p = r_p, r_n = r_p, k_n = r_p;
    if (hp) { r_p = *(const u32x2*)(pc - A_COLS + cr + c4); k_p = *(const u32x2*)(pc - A_COLS + ck + c4); }
    if (hn) { r_n = *(const u32x2*)(pc + A_COLS + cr + c4); k_n = *(const u32x2*)(pc + A_COLS + ck + c4); }
    const u32x2 v_c = *(const u32x2*)(VV + row * 512 + cr + c4);
    const f32x4 mr0 = *(const f32x4*)(mu0 + cr + c4), mr1 = *(const f32x4*)(mu1 + cr + c4), mk0 = *(const f32x4*)(mu0 + ck + c4), mk1 = *(const f32x4*)(mu1 + ck + c4);
    const f32x4 kk4 = *(const f32x4*)(w.kk_ + cg_ + c4), ka4 = *(const f32x4*)(w.ka + cg_ + c4), rk4 = *(const f32x4*)(w.rk + cg_ + c4);
    f32x4 rv, kv, vv, ow, od;
#pragma unroll
    for (int i = 0; i < 2; ++i) {
      rv[2 * i] = shift1(BFLO(r_c[i]), BFLO(r_p[i]), BFLO(r_n[i]), mr0[2 * i], mr1[2 * i]);
      rv[2 * i + 1] = shift1(BFHI(r_c[i]), BFHI(r_p[i]), BFHI(r_n[i]), mr0[2 * i + 1], mr1[2 * i + 1]);
      kv[2 * i] = shift1(BFLO(k_c[i]), BFLO(k_p[i]), BFLO(k_n[i]), mk0[2 * i], mk1[2 * i]);
      kv[2 * i + 1] = shift1(BFHI(k_c[i]), BFHI(k_p[i]), BFHI(k_n[i]), mk0[2 * i + 1], mk1[2 * i + 1]);
      vv[2 * i] = BFLO(v_c[i]); vv[2 * i + 1] = BFHI(v_c[i]);
    }
#pragma unroll
    for (int q = 0; q < 4; ++q) {
      const float wlog = -softplusf_(-wl[c4 + q]) - 0.5f;
      ow[q] = __expf(-__expf(wlog));
      const float a = sigmoidf_(al[c4 + q]);
      av[c4 + q] = a;
      ok[c4 + q] = kv[q] * kk4[q]; ss += ok[c4 + q] * ok[c4 + q];
      od[q] = kv[q] * (1.f + (a - 1.f) * ka4[q]);
      bs += rv[q] * od[q] * rk4[q];
    }
    *(LAS f32x4*)(AW + o + c4) = ow; *(LAS f32x4*)(AD + o + c4) = od; *(LAS f32x4*)(AR + o + c4) = rv; *(LAS f32x4*)(AV + o + c4) = vv;
  }
#pragma unroll
  for (int sft = 1; sft < 8; sft <<= 1) { ss += __shfl_xor(ss, sft); bs += __shfl_xor(bs, sft); }
  const float rn = rsqrtf(ss + 1e-12f);
#pragma unroll
  for (int hq = 0; hq < 2; ++hq) {
    f32x4 k4, b4;
#pragma unroll
    for (int q = 0; q < 4; ++q) { k4[q] = ok[4 * hq + q] * rn; b4[q] = k4[q] * av[4 * hq + q]; }
    *(LAS f32x4*)(AK + o + 4 * hq) = k4; *(LAS f32x4*)(AB + o + 4 * hq) = b4;
  }
  if (j == 0) BON[((size_t)dir * NT + row) * 8 + h] = bs;
}
struct ScanOps { f32x4 k4[4], w4[4], b4[4], d4[4]; float vi; };
DI void scan_load(ScanOps& o, LAS const float* buf, int tt, int jseg, int irow) {
  const int off = tt * 64 + jseg * 16;
#pragma unroll
  for (int q = 0; q < 4; ++q) {
    o.w4[q] = *(const LAS f32x4*)(buf + off + q * 4); o.k4[q] = *(const LAS f32x4*)(buf + 2048 + off + q * 4); o.b4[q] = *(const LAS f32x4*)(buf + 4096 + off + q * 4);
    o.d4[q] = *(const LAS f32x4*)(buf + 6144 + off + q * 4);
  }
  o.vi = buf[10240 + tt * 64 + irow];
}
DI float scan_step(f32x4 (&S)[4], const ScanOps& o, LAS const float* buf, int tt, int jseg) {
  f32x4 r4[4];
#pragma unroll
  for (int q = 0; q < 4; ++q) r4[q] = *(const LAS f32x4*)(buf + 8192 + tt * 64 + jseg * 16 + q * 4);
  f32x4 a4 = S[0] * o.k4[0] + S[1] * o.k4[1] + S[2] * o.k4[2] + S[3] * o.k4[3];
  float sa = -quad_sum((a4[0] + a4[1]) + (a4[2] + a4[3]));
  f32x4 y4 = (f32x4){0.f, 0.f, 0.f, 0.f};
#pragma unroll
  for (int q = 0; q < 4; ++q) { S[q] = S[q] * o.w4[q] + (o.b4[q] * sa + o.d4[q] * o.vi); y4 += S[q] * r4[q]; }
  return quad_sum((y4[0] + y4[1]) + (y4[2] + y4[3]));
}
DI void scan_phase(LAS unsigned char* lds, const u16* PA, const u16* VV, u16* YY, float* BON, const ScanW w) {
  int tid = threadIdx.x; asm volatile("" : "+v"(tid));
  int bid = blockIdx.x, gdim = gridDim.x; asm volatile("" : "+s"(bid), "+s"(gdim));
  LAS float* BUF = (LAS float*)lds;
  LAS float* AY = BUF + 2 * 12288;
  LAS unsigned* TW = (LAS unsigned*)(AY + 2 * 2048);
  LAS unsigned* TA = TW + SC * 16;
  LAS unsigned* DU = TA + SC * 16;
  LAS unsigned* IU = DU + 1024;
  const int wid = __builtin_amdgcn_readfirstlane(tid >> 6), lane = tid & 63;
  const int NCH = T / SC;
  for (int item = bid; item < 192; item += gdim) {
    const int dir = item & 1, h = (item >> 1) & 7, sq = item >> 4;
    __syncthreads();
    for (int i = tid; i < 1024; i += NTHREADS) { const int pr = i >> 6, c = i & 63; const size_t o0 = (size_t)(dir * 32 + 2 * pr) * 512 + h * 64 + c;
      DU[i] = cvt_pk_bf16(w.du[o0], w.du[o0 + 512]); IU[i] = cvt_pk_bf16(w.iu[o0], w.iu[o0 + 512]); }
    __syncthreads();
    f32x4 S[4];
#pragma unroll
    for (int q = 0; q < 4; ++q) S[q] = (f32x4){0.f, 0.f, 0.f, 0.f};
    const int irow = (wid & 3) * 16 + (lane >> 2), jseg = lane & 3;
    if (wid >= 4) scan_produce(BUF, TW, TA, DU, IU, PA, VV, BON, w, tid - 256, sq, h, dir, dir == 0 ? 0 : T - SC);
    __syncthreads();
#pragma unroll 1
    for (int ci = 0; ci < NCH; ++ci) {
      LAS float* buf = BUF + (ci & 1) * 12288;
      LAS float* ay = AY + (ci & 1) * 2048;
      if (wid < 4) {
        ScanOps o0, o1;
        scan_load(o0, buf, dir == 0 ? 0 : SC - 1, jseg, irow);
#pragma unroll 1
        for (int st = 0; st < SC; st += 2) {
          const int t0_ = dir == 0 ? st : SC - 1 - st, t1_ = dir == 0 ? st + 1 : SC - 2 - st;
          scan_load(o1, buf, t1_, jseg, irow);
          const float y0 = scan_step(S, o0, buf, t0_, jseg);
          if (jseg == 0) ay[t0_ * 64 + irow] = y0;
          if (st + 2 < SC) scan_load(o0, buf, dir == 0 ? st + 2 : SC - 3 - st, jseg, irow);
          const float y1 = scan_step(S, o1, buf, t1_, jseg);
          if (jseg == 0) ay[t1_ * 64 + irow] = y1;
        }
      } else {
        const int ptid = tid - 256;
        if (ci + 1 < NCH) scan_produce(BUF + ((ci + 1) & 1) * 12288, TW, TA, DU, IU, PA, VV, BON, w, ptid, sq, h, dir, dir == 0 ? (ci + 1) * SC : T - SC * (ci + 2));
        if (ci > 0) {
          LAS const float* py = AY + ((ci - 1) & 1) * 2048;
          const int t0p = dir == 0 ? (ci - 1) * SC : T - SC * ci;
          const int tok = ptid >> 3, c0 = (ptid & 7) * 8;
          const f32x4 ya = *(const LAS f32x4*)(py + tok * 64 + c0), yb = *(const LAS f32x4*)(py + tok * 64 + c0 + 4);
          u32x4 pk; pk.x = cvt_pk_bf16(ya[0], ya[1]); pk.y = cvt_pk_bf16(ya[2], ya[3]); pk.z = cvt_pk_bf16(yb[0], yb[1]); pk.w = cvt_pk_bf16(yb[2], yb[3]);
          *(u32x4*)(YY + ((size_t)dir * NT + (size_t)sq * T + t0p + tok) * 512 + h * 64 + c0) = pk;
        }
      }
      __syncthreads();
    }
    if (wid >= 4) {
      const int ptid = tid - 256;
      LAS const float* py = AY + ((NCH - 1) & 1) * 2048;
      const int t0p = dir == 0 ? (NCH - 1) * SC : 0;
      const int tok = ptid >> 3, c0 = (ptid & 7) * 8;
      const f32x4 ya = *(const LAS f32x4*)(py + tok * 64 + c0), yb = *(const LAS f32x4*)(py + tok * 64 + c0 + 4);
      u32x4 pk; pk.x = cvt_pk_bf16(ya[0], ya[1]); pk.y = cvt_pk_bf16(ya[2], ya[3]); pk.z = cvt_pk_bf16(yb[0], yb[1]); pk.w = cvt_pk_bf16(yb[2], yb[3]);
      *(u32x4*)(YY + ((size_t)dir * NT + (size_t)sq * T + t0p + tok) * 512 + h * 64 + c0) = pk;
    }
  }
}

DI void post_phase(LAS unsigned char* lds, u16* PA, const u16* PB, const u16* VV, const u16* YY, const float* BON, const float* mu, const float* gup, const float* gng, const float* gnb) {
  int tid = threadIdx.x; asm volatile("" : "+v"(tid));
  int bid = blockIdx.x, gdim = gridDim.x; asm volatile("" : "+s"(bid), "+s"(gdim));
  const int tok = tid >> 4, j = tid & 15;
  LAS unsigned* SG2 = (LAS unsigned*)lds;
  LAS unsigned* GU = (LAS unsigned*)(lds + 16384);
  const float* mu0 = mu; const float* mu1 = mu + A_COLS;
  __syncthreads();
  for (int e = tid; e < 48 * 512; e += NTHREADS) { const int r2 = e >> 9, c = e & 511; GU[(r2 * 2 + ((c >> 2) & 1)) * 256 + (c >> 3) * 4 + (c & 3)] = cvt_pk_bf16(gup[(2 * r2) * 512 + c], gup[(2 * r2 + 1) * 512 + c]); }
  for (int it = bid; it < NT / 32; it += gdim) {
    const size_t row = (size_t)it * 32 + tok; const int t = (int)(row % T);
    __syncthreads();
    { float sv[6];
#pragma unroll
      for (int q = 0; q < 6; ++q) {
        const int col = OFF_GD + j * 6 + q;
        const float c = bf2f(PA[row * A_COLS + col]);
        const float pv = t > 0 ? bf2f(PA[(row - 1) * A_COLS + col]) : 0.f, nx = t < T - 1 ? bf2f(PA[(row + 1) * A_COLS + col]) : 0.f;
        sv[q] = sigmoidf_(c + mu0[col] * (pv - c) + mu1[col] * (nx - c));
      }
#pragma unroll
      for (int pq = 0; pq < 3; ++pq) SG2[tok * 48 + j * 3 + pq] = cvt_pk_bf16(sv[2 * pq], sv[2 * pq + 1]); }
    __syncthreads();
#pragma unroll 1
    for (int q = 0; q < 4; ++q) {
      const int cc = q * 128 + j * 8, h = 2 * q + (j >> 3);
      float y[8]; float sm = 0.f;
      { float a[8], b[8]; load_bf16x8(YY + row * 512 + cc, a); load_bf16x8(YY + ((size_t)NT + row) * 512 + cc, b);
#pragma unroll
        for (int i = 0; i < 8; ++i) { y[i] = a[i] + b[i]; sm += y[i]; } }
      sm += __shfl_xor(sm, 1); sm += __shfl_xor(sm, 2); sm += __shfl_xor(sm, 4);
      const float mean = sm * (1.f / 64.f);
      float vq = 0.f;
#pragma unroll
      for (int i = 0; i < 8; ++i) { y[i] -= mean; vq += y[i] * y[i]; }
      vq += __shfl_xor(vq, 1); vq += __shfl_xor(vq, 2); vq += __shfl_xor(vq, 4);
      const float rs = rsqrtf(vq * (1.f / 64.f) + GN_EPS);
      const float bon = BON[row * 8 + h] + BON[((size_t)NT + row) * 8 + h];
      float gacc[8];
#pragma unroll
      for (int i = 0; i < 8; ++i) gacc[i] = 0.f;
#pragma unroll 8
      for (int r2 = 0; r2 < 48; ++r2) {
        const bf2 sv = __builtin_bit_cast(bf2, SG2[tok * 48 + r2]);
        const u32x4 wa = *(const LAS u32x4*)(GU + (r2 * 2 + 0) * 256 + (cc >> 3) * 4), wb = *(const LAS u32x4*)(GU + (r2 * 2 + 1) * 256 + (cc >> 3) * 4);
#pragma unroll
        for (int i = 0; i < 4; ++i) { unsigned ua = wa[i], ub = wb[i]; asm volatile("" : "+v"(ua), "+v"(ub));
          gacc[i] = __builtin_amdgcn_fdot2_f32_bf16(sv, __builtin_bit_cast(bf2, ua), gacc[i], false); gacc[4 + i] = __builtin_amdgcn_fdot2_f32_bf16(sv, __builtin_bit_cast(bf2, ub), gacc[4 + i], false); }
      }
      float vv[8]; load_bf16x8(VV + row * 512 + cc, vv);
      const f32x4 g0 = *(const f32x4*)(gng + cc), g1 = *(const f32x4*)(gng + cc + 4), b0 = *(const f32x4*)(gnb + cc), b1 = *(const f32x4*)(gnb + cc + 4);
      float o[8];
#pragma unroll
      for (int i = 0; i < 4; ++i) { o[i] = (y[i] * rs * g0[i] + b0[i] + bon * vv[i]) * gacc[i]; o[4 + i] = (y[4 + i] * rs * g1[i] + b1[i] + bon * vv[4 + i]) * gacc[4 + i]; }
      u32x4 pk; pk.x = cvt_pk_bf16(o[0], o[1]); pk.y = cvt_pk_bf16(o[2], o[3]); pk.z = cvt_pk_bf16(o[4], o[5]); pk.w = cvt_pk_bf16(o[6], o[7]);
      if (DBGZ & 1) pk = (u32x4){0u, 0u, 0u, 0u};
      *(u32x4*)(PA + row * A_COLS + cc) = pk;
      u32x4 pb4 = *(const u32x4*)(PB + row * 1024 + cc); if (DBGZ & 2) pb4 = (u32x4){0u, 0u, 0u, 0u};
      *(u32x4*)(PA + row * A_COLS + 512 + cc) = pb4;
    }
  }
}

DI unsigned hashu(unsigned x) { x ^= x >> 16; x *= 0x7feb352du; x ^= x >> 15; x *= 0x846ca68bu; x ^= x >> 16; return x; }
DI void dbg_upd(float* slot, float got, float ref, float scale) { float e = fabsf(got - ref) / scale; if (!(e == e)) e = 1e9f; atomicMax((unsigned*)slot, __float_as_uint(e)); }
DI float tshift(const u16* PA, size_t row, int col, const float* mu) {
  const int t = (int)(row % T);
  const float c = bf2f(PA[row * A_COLS + col]);
  const float pv = t > 0 ? bf2f(PA[(row - 1) * A_COLS + col]) : 0.f, nx = t < T - 1 ? bf2f(PA[(row + 1) * A_COLS + col]) : 0.f;
  return c + mu[col] * (pv - c) + mu[A_COLS + col] * (nx - c);
}
DI void chk_proj(const u16* XB, const float* win, const u16* PA, const u16* PB, const u16* VT, float* slot) {
  const int gt = blockIdx.x * NTHREADS + threadIdx.x;
  if (gt >= 4096) return;
  const int row = hashu(gt * 2 + 1) % NT, col = hashu(gt * 2 + 2) % P_COLS;
  float ref = 0.f;
  for (int k = 0; k < D; ++k) ref += bf2f(XB[(size_t)row * D + k]) * win[(size_t)k * P_COLS + col];
  float got;
  if (col < A_COLS) got = bf2f(PA[(size_t)row * A_COLS + col]);
  else if (col < A_COLS + 1024) got = bf2f(PB[(size_t)row * 1024 + col - A_COLS]);
  else { const int c2 = col - A_COLS - 1024, h = c2 >> 7, e = c2 & 127, sq = row / T, t = row % T; got = bf2f(VT[((size_t)((sq * 4 + h) * 128 + e)) * T + t]); }
  dbg_upd(slot, got, ref, 1.f);
}
DI void chk_ffn(const u16* XB, const float* wup, const float* cw, const float* cb, const u16* G, float* slot) {
  const int gt = blockIdx.x * NTHREADS + threadIdx.x;
  if (gt >= 4096) return;
  int row = hashu(gt * 2 + 11) % NT; const int n = hashu(gt * 2 + 12) % DFF;
  if (gt < 64) row = (gt & 1) ? (row / T) * T + T - 1 : (row / T) * T;
  else if (gt < 1024) row = (row / T) * T + ((row % T) / 254) * 254 + (gt & 1 ? 253 : 0), row = row >= NT ? NT - 1 : row;
  const int t = row % T;
  float hg[3] = {0.f, 0.f, 0.f}, hu[3] = {0.f, 0.f, 0.f};
#pragma unroll
  for (int d = -1; d <= 1; ++d) {
    float a = 0.f, b = 0.f;
    if (!(t + d < 0 || t + d > T - 1))
      for (int k = 0; k < D; ++k) { const float x = bf2f(XB[(size_t)(row + d) * D + k]); a += x * wup[(size_t)k * NUP + n]; b += x * wup[(size_t)k * NUP + DFF + n]; }
    hg[d + 1] = a; hu[d + 1] = b;
  }
  const float got = bf2f(G[(size_t)row * DFF + n]);
  { const float g = cw[n] * hg[0] + cw[NUP + n] * hg[1] + cw[2 * NUP + n] * hg[2] + cb[n];
    const float u = cw[DFF + n] * hu[0] + cw[NUP + DFF + n] * hu[1] + cw[2 * NUP + DFF + n] * hu[2] + cb[DFF + n];
    dbg_upd(slot, got, 0.5f * g * (1.f + erff(g * 0.70710678f)) * u, 1.f); }
  { const float g = cw[n] * hg[2] + cw[NUP + n] * hg[1] + cw[2 * NUP + n] * hg[0] + cb[n];
    const float u = cw[DFF + n] * hu[2] + cw[NUP + DFF + n] * hu[1] + cw[2 * NUP + DFF + n] * hu[0] + cb[DFF + n];
    dbg_upd(slot + 1, got, 0.5f * g * (1.f + erff(g * 0.70710678f)) * u, 1.f); }
  { const float g = cw[NUP + n] * hg[1] + cb[n];
    const float u = cw[NUP + DFF + n] * hu[1] + cb[DFF + n];
    dbg_upd(slot + 2, got, 0.5f * g * (1.f + erff(g * 0.70710678f)) * u, 1.f); }
}
DI void chk_attn(LAS unsigned char* lds, const u16* XB, const float* win, const u16* PB, const u16* VT, const float* lamp, const float* subg, const float* relb, int layer, float* slot) {
  if (blockIdx.x >= 16) return;
  const int tid = threadIdx.x;
  LAS float* qv = (LAS float*)lds;
  LAS float* sc = qv + 128;
  LAS float* red = sc + 16384;
  LAS float* ov = red + 1024;
  const int smp = blockIdx.x;
  const int sq = hashu(smp + 77) % NSEQ, h = smp & 3;
  int q = hashu(smp + 99) % T; if (smp < 4) q = smp * 37; if (smp >= 12) q = T - 1 - (smp - 12) * 50;
  const size_t row = (size_t)sq * T + q;
  __syncthreads();
  if (tid < 128) { float a = 0.f; const int col = A_COLS + h * 128 + tid; for (int k = 0; k < D; ++k) a += bf2f(XB[row * D + k]) * win[(size_t)k * P_COLS + col]; qv[tid] = a; }
  __syncthreads();
  float mx0 = -1e30f, mx1 = -1e30f;
  for (int key = tid; key < T; key += NTHREADS) {
    const u16* kp = PB + ((size_t)sq * T + key) * 1024 + 512 + h * 128;
    float s0 = 0.f, s1 = 0.f;
    for (int d = 0; d < 64; ++d) { s0 += qv[d] * bf2f(kp[d]); s1 += qv[64 + d] * bf2f(kp[64 + d]); }
    const int rel = key - q, n = rel < 0 ? -rel : rel;
    int bk;
    if (n < 8) bk = n; else { bk = 8 + (int)(logf((float)n / 8.f) / logf(16.f) * 8.f); bk = bk > 15 ? 15 : bk; }
    if (rel > 0) bk += 16;
    const float bias = relb[bk * 4 + h];
    s0 = s0 * 0.125f + bias; s1 = s1 * 0.125f + bias;
    sc[key] = s0; sc[8192 + key] = s1; mx0 = fmaxf(mx0, s0); mx1 = fmaxf(mx1, s1);
  }
  red[tid] = mx0; red[512 + tid] = mx1; __syncthreads();
  for (int o = 256; o > 0; o >>= 1) { if (tid < o) { red[tid] = fmaxf(red[tid], red[tid + o]); red[512 + tid] = fmaxf(red[512 + tid], red[512 + tid + o]); } __syncthreads(); }
  mx0 = red[0]; mx1 = red[512]; __syncthreads();
  float l0 = 0.f, l1 = 0.f;
  for (int key = tid; key < T; key += NTHREADS) { const float p0 = expf(sc[key] - mx0), p1 = expf(sc[8192 + key] - mx1); sc[key] = p0; sc[8192 + key] = p1; l0 += p0; l1 += p1; }
  red[tid] = l0; red[512 + tid] = l1; __syncthreads();
  for (int o = 256; o > 0; o >>= 1) { if (tid < o) { red[tid] += red[tid + o]; red[512 + tid] += red[512 + tid + o]; } __syncthreads(); }
  l0 = red[0]; l1 = red[512]; __syncthreads();
  float la = 0.f, lb = 0.f; for (int d = 0; d < 64; ++d) { la += lamp[d] * lamp[64 + d]; lb += lamp[128 + d] * lamp[192 + d]; }
  const float lam_init = 0.8f - 0.6f * expf(-0.3f * (float)layer);
  const float lam = expf(la) - expf(lb) + lam_init;
  { const int e = tid & 127, part = tid >> 7;
    const u16* vp = VT + ((size_t)((sq * 4 + h) * 128 + e)) * T;
    float o = 0.f;
    for (int key = part * 2048; key < (part + 1) * 2048; ++key) o += (sc[key] / l0 - lam * sc[8192 + key] / l1) * bf2f(vp[key]);
    red[tid] = o; }
  __syncthreads();
  if (tid < 128) ov[tid] = red[tid] + red[128 + tid] + red[256 + tid] + red[384 + tid];
  __syncthreads();
  if (tid < 128) {
    float ss = 0.f; for (int e = 0; e < 128; ++e) ss += ov[e] * ov[e];
    const float ref = ov[tid] * rsqrtf(ss / 128.f + LN_EPS) * subg[tid] * (1.f - lam_init);
    dbg_upd(slot, bf2f(PB[row * 1024 + h * 128 + tid]), ref, 1.f);
  }
}
struct ChkOp { float r, kd, kk, b, w, v; };
DI ChkOp chk_ops(const u16* PA, const u16* VV, const ScanW& w, size_t row, int h, int dir, int c, LAS float* tmp  , int tid) {
  ChkOp o;
  const int cg_ = h * 64 + c;
  o.r = tshift(PA, row, cg_, w.mu);
  const float k = tshift(PA, row, OFF_K + cg_, w.mu);
  float wl = w.w0[dir * 512 + cg_], al = w.a0[dir * 512 + cg_];
#pragma unroll 1
  for (int rr = 0; rr < 32; ++rr) {
    wl += tanhf(tshift(PA, row, OFF_WD + dir * 32 + rr, w.mu)) * w.du[(dir * 32 + rr) * 512 + cg_];
    al += tshift(PA, row, OFF_AD + dir * 32 + rr, w.mu) * w.iu[(dir * 32 + rr) * 512 + cg_];
  }
  const float sp = logf(1.f + expf(-wl));
  o.w = expf(-expf(-sp - 0.5f));
  const float a = 1.f / (1.f + expf(-al));
  const float kkv = k * w.kk_[cg_];
  __syncthreads(); tmp[tid] = kkv * kkv; __syncthreads();
  float ss = 0.f;
#pragma unroll 1
  for (int j = 0; j < 64; ++j) ss += tmp[j];
  o.kk = kkv * rsqrtf(ss + 1e-12f);
  o.kd = k * (1.f + (a - 1.f) * w.ka[cg_]);
  o.b = o.kk * a;
  o.v = bf2f(VV[row * 512 + cg_]);
  return o;
}
DI void chk_scan(LAS unsigned char* lds, const u16* PA, const u16* VV, const u16* YY, const float* BON, const ScanW w, float* slot) {
  if (blockIdx.x >= 48 || threadIdx.x >= 64) return;
  const int tid = threadIdx.x;
  LAS float* tmp = (LAS float*)lds; LAS float* red = tmp + 64;
  const int item = blockIdx.x * 4 + 1, dir = item & 1, h = (item >> 1) & 7, sq = item >> 4;
  const int t0 = dir == 0 ? 0 : T - 1, t1 = dir == 0 ? 1 : T - 2;
  const size_t row0 = (size_t)sq * T + t0, row1 = (size_t)sq * T + t1;
  const ChkOp a = chk_ops(PA, VV, w, row0, h, dir, tid, tmp, tid);
  const ChkOp b = chk_ops(PA, VV, w, row1, h, dir, tid, tmp, tid);
#define BSUM(dst, val) { __syncthreads(); red[tid] = (val); __syncthreads(); float sx_ = 0.f; _Pragma("unroll 1") for (int j_ = 0; j_ < 64; ++j_) sx_ += red[j_]; dst = sx_; }
  float ds0, ds1, ds2, ds3, ds4;
  BSUM(ds0, a.kd * a.r) BSUM(ds1, a.kd * b.w * b.r) BSUM(ds2, a.kd * (-b.kk)) BSUM(ds3, b.b * b.r) BSUM(ds4, b.kd * b.r)
  const float y0 = a.v * ds0;
  const float y1 = a.v * (ds1 + ds2 * ds3) + b.v * ds4;
  dbg_upd(slot, bf2f(YY[((size_t)dir * NT + row0) * 512 + h * 64 + tid]), y0, fabsf(y0) + 0.05f);
  dbg_upd(slot, bf2f(YY[((size_t)dir * NT + row1) * 512 + h * 64 + tid]), y1, fabsf(y1) + 0.05f);
  float bq = a.r * a.kd * w.rk[h * 64 + tid];
  __syncthreads(); red[tid] = bq; __syncthreads(); float bs = 0.f;
#pragma unroll 1
  for (int j = 0; j < 64; ++j) bs += red[j];
  dbg_upd(slot, BON[((size_t)dir * NT + row0) * 8 + h], bs, fabsf(bs) + 0.05f);
}
DI void chk_post(const u16* PA, const u16* PB, const u16* VV, const u16* YY, const float* BON, const float* mu, const float* gup, const float* gng, const float* gnb, float* slot) {
  const int gt = blockIdx.x * NTHREADS + threadIdx.x;
  if (gt >= 2048) return;
  const size_t row = hashu(gt * 2 + 21) % NT; const int c = hashu(gt * 2 + 22) % 512, h = c >> 6;
  float sm = 0.f;
  float yc = 0.f;
  for (int i = 0; i < 64; ++i) { const float y = bf2f(YY[row * 512 + h * 64 + i]) + bf2f(YY[((size_t)NT + row) * 512 + h * 64 + i]); sm += y; if (h * 64 + i == c) yc = y; }
  const float mean = sm / 64.f; float vq = 0.f;
  for (int i = 0; i < 64; ++i) { const float y = bf2f(YY[row * 512 + h * 64 + i]) + bf2f(YY[((size_t)NT + row) * 512 + h * 64 + i]) - mean; vq += y * y; }
  const float yn = (yc - mean) * rsqrtf(vq / 64.f + GN_EPS) * gng[c] + gnb[c];
  const float bon = (BON[row * 8 + h] + BON[((size_t)NT + row) * 8 + h]) * bf2f(VV[row * 512 + c]);
  float g = 0.f;
  for (int r = 0; r < 96; ++r) g += (1.f / (1.f + expf(-tshift(PA, row, OFF_GD + r, mu)))) * gup[r * 512 + c];
  const float ref = (yn + bon) * g;
  dbg_upd(slot, bf2f(PA[row * A_COLS + c]), ref, fabsf(ref) + 0.05f);
  dbg_upd(slot + 1, bf2f(PA[row * A_COLS + 512 + c]), bf2f(PB[row * 1024 + c]), 1.f);
}

#define XB_TMO      128
#define XB_XCNT(j)  (256  + 64 * (j))
#define XB_XSUB(j)  (1280 + 64 * (j))
#define XB_XGEN(j)  (2304 + 64 * (j))
#define XB_TOP      3328
#define XB_TOPGEN   3392
#define XCD_BAR_WORDS 3456
#define XB_SPIN_CAP (1u << 18)
DI unsigned xb_ld(unsigned* p)              { return __hip_atomic_load(p, __ATOMIC_RELAXED, __HIP_MEMORY_SCOPE_AGENT); }
DI unsigned xb_add(unsigned* p, unsigned v) { return __hip_atomic_fetch_add(p, v, __ATOMIC_RELAXED, __HIP_MEMORY_SCOPE_AGENT); }
DI unsigned xb_xcc_id() { return (unsigned)__builtin_amdgcn_s_getreg((3 << 11) | 20) & 0xFu; }
#define XB_SPIN(cond, bar) do { unsigned _sp = 0; while (cond) { __builtin_amdgcn_s_sleep(1); \
    if ((++_sp & 255u) == 0u) { if (xb_ld(&(bar)[XB_TMO])) break; if (_sp > XB_SPIN_CAP) { atomicAdd(&(bar)[XB_TMO], 1u); break; } } } } while (0)
DI void xcd_census(unsigned* bar, unsigned* st) {
  if (threadIdx.x == 0) {
    const unsigned x = xb_xcc_id();
    unsigned cnt = 0u, mine = 0u;
#pragma unroll
    for (unsigned j = 0; j < 16; ++j) { const unsigned c = xb_ld(&bar[XB_XCNT(j)]); cnt += (c > 0u) ? 1u : 0u; mine = (j == x) ? c : mine; }
    st[0] = mine > 0u ? mine : 1u; st[1] = cnt > 0u ? cnt : 1u;
  }
}
DI void xcd_barrier(unsigned* bar, unsigned* st) {
  asm volatile("s_waitcnt vmcnt(0)" ::: "memory");
  __syncthreads();
  if (threadIdx.x == 0) {
    __builtin_amdgcn_s_waitcnt(0);
    const unsigned x = xb_xcc_id();
    const unsigned nloc = st[0], nx = st[1];
    const unsigned old = xb_add(&bar[XB_XSUB(x)], 1u);
    const unsigned gen = old / nloc;
    if (old + 1u == (gen + 1u) * nloc) {
      __builtin_amdgcn_fence(__ATOMIC_RELEASE, "agent");
      asm volatile("s_waitcnt vmcnt(0)" ::: "memory");
      const unsigned og = xb_add(&bar[XB_TOP], 1u);
      const unsigned tg = og / nx;
      if (og + 1u == (tg + 1u) * nx) xb_add(&bar[XB_TOPGEN], 1u);
      else XB_SPIN(xb_ld(&bar[XB_TOPGEN]) == tg, bar);
      __builtin_amdgcn_fence(__ATOMIC_ACQUIRE, "agent");
      xb_add(&bar[XB_XGEN(x)], 1u);
      asm volatile("s_waitcnt vmcnt(0)" ::: "memory");
    } else {
      XB_SPIN(xb_ld(&bar[XB_XGEN(x)]) == gen, bar);
      __builtin_amdgcn_fence(__ATOMIC_ACQUIRE, "agent");
      asm volatile("s_waitcnt vmcnt(0)" ::: "memory");
    }
  }
  __syncthreads();
}

__global__ __launch_bounds__(NTHREADS, 2) void mega(Params p_unused) {
  extern __shared__ __attribute__((aligned(16))) char shm[];
  cg::grid_group grid = cg::this_grid();
  LAS unsigned char* lds = (LAS unsigned char*)shm;
#define WS_PTRS CParams p = get_params(); unsigned char* ws = p->ws; \
  u16* WIN = (u16*)(ws + OFF_WIN); u16* WOUT = (u16*)(ws + OFF_WOUT); u16* WUP = (u16*)(ws + OFF_WUP); u16* WDN = (u16*)(ws + OFF_WDN); \
  u16* XB = (u16*)(ws + OFF_XB); u16* PA = (u16*)(ws + OFF_PA); u16* PB = (u16*)(ws + OFF_PB); u16* VT = (u16*)(ws + OFF_VT); \
  u16* G = (u16*)(ws + OFF_PA); u16* VV = (u16*)(ws + OFF_VV); u16* YY = (u16*)p->out; float* BON = (float*)(ws + OFF_BON); float* XF = p->out; \
  (void)WIN; (void)WOUT; (void)WUP; (void)WDN; (void)XB; (void)PA; (void)PB; (void)VT; (void)G; (void)VV; (void)YY; (void)BON; (void)XF;
  int ph = 0;
  const int ph_lo = get_params()->ph_lo, ph_hi = get_params()->ph_hi;
  const bool fullrun = (ph_lo == 0 && ph_hi >= 1000);
  if (fullrun && threadIdx.x == 0) (void)xb_add((unsigned*)(get_params()->ws + OFF_XBAR) + XB_XCNT(xb_xcc_id()), 1u);
#define GSYNC() do { if (!fullrun || ph == 1) { grid.sync(); if (fullrun) xcd_census((unsigned*)(get_params()->ws + OFF_XBAR), (unsigned*)(get_params()->ws + OFF_XBAR) + XCD_BAR_WORDS + 2 * blockIdx.x); } \
    else xcd_barrier((unsigned*)(get_params()->ws + OFF_XBAR), (unsigned*)(get_params()->ws + OFF_XBAR) + XCD_BAR_WORDS + 2 * blockIdx.x); } while (0)
#ifndef ONLYMASK
#define ONLYMASK 0xffffffffu
#endif
#define PHASE_BEGIN if (((ONLYMASK >> (__COUNTER__ % 32)) & 1u) && ph >= ph_lo && ph < ph_hi) { WS_PTRS
#define PHASE_END } ++ph; if (ph > ph_lo && ph < ph_hi) GSYNC();

  PHASE_BEGIN
    for (int l = 0; l < 2; ++l) {
      convert_weight<0>(shm, p->in[4] + (size_t)l * D * P_COLS, WIN + (size_t)l * NPROJ * D, D, P_COLS, NPROJ, blockIdx.x, gridDim.x);
      convert_weight<1>(shm, p->in[22] + (size_t)l * D * D, WOUT + (size_t)l * D * D, D, D, D, blockIdx.x, gridDim.x);
      convert_weight<2>(shm, p->in[25] + (size_t)l * D * NUP, WUP + (size_t)l * NUP * D, D, NUP, NUP, blockIdx.x, gridDim.x);
      convert_weight<1>(shm, p->in[28] + (size_t)l * DFF * D, WDN + (size_t)l * D * DFF, DFF, D, D, blockIdx.x, gridDim.x);
    }
    ln_rows(p->in[0], p->in[1], NPROMPT_TOK, XF, XB, p->in[2], p->in[3], false, true);
  PHASE_END

#pragma unroll 1
  for (int l = 0; l < 2; ++l) {
    PHASE_BEGIN
      Gemm ga{XB, D, WIN + (size_t)l * NPROJ * D, D};
      EpiArgs ea{}; ea.pa = PA; ea.pb = PB; ea.vt = VT;
      gemm_phase<0, 0>(lds, ga, NT / 256, NPROJ / 256, ea);
#if PROBE_GEMM
      gemm_phase<0, 0>(lds, ga, NT / 256, NPROJ / 256, ea);
#endif
    PHASE_END
#pragma unroll 1
    for (int rnd = 0; rnd < 2; ++rnd) {
      if (ph >= ph_lo && ph < ph_hi) { WS_PTRS
        int bidu = blockIdx.x, gdu = gridDim.x; asm volatile("" : "+s"(bidu), "+s"(gdu));
        const bool split = (gdu == 256);
        if (rnd == 0) vprep_phase(lds, PA, VV, p->in[5] + (size_t)l * 2 * A_COLS, p->in[16], p->in[17], p->in[18], l);
        if (rnd == 1 && (!split || bidu < 192)) {
          ScanW sw; sw.mu = p->in[5] + (size_t)l * 2 * A_COLS; sw.w0 = p->in[6] + l * 1024; sw.du = p->in[7] + (size_t)l * 2 * 32 * 512; sw.a0 = p->in[8] + l * 1024;
          sw.iu = p->in[9] + (size_t)l * 2 * 32 * 512; sw.kk_ = p->in[11] + l * 512; sw.ka = p->in[12] + l * 512; sw.rk = p->in[13] + l * 512;
          scan_phase(lds, PA, VV, YY, BON, sw);
        } else if (rnd == 0 || split) {
          const int plo = rnd == 0 ? 0 : 40, phi = (rnd == 0 && split) ? 40 : 48;
          const int wlo = rnd == 0 ? 0 : 192, wcnt = rnd == 0 ? (gdu & ~7) : 64;
          attn_phase(lds, PB, VT, (float*)(ws + OFF_OSV), p->in[19] + l * 256, p->in[20] + l * 128, p->in[21], l, plo, phi, wlo, wcnt);
        }
      }
      ++ph; if (ph > ph_lo && ph < ph_hi) GSYNC();
    }
    PHASE_BEGIN
      post_phase(lds, PA, PB, VV, YY, BON, p->in[5] + (size_t)l * 2 * A_COLS, p->in[10] + (size_t)l * 96 * 512, p->in[14] + l * 512, p->in[15] + l * 512);
#if PROBE_MISC
      post_phase(lds, PA, PB, VV, YY, BON, p->in[5] + (size_t)l * 2 * A_COLS, p->in[10] + (size_t)l * 96 * 512, p->in[14] + l * 512, p->in[15] + l * 512);
#endif
    PHASE_END
    PHASE_BEGIN
      Gemm ga{PA, A_COLS, WOUT + (size_t)l * D * D, D};
      EpiArgs ea{}; ea.xf = XF; ea.xb = XB;
      gemm_phase<1, 0>(lds, ga, NT / 256, D / 256, ea);
    PHASE_END
    PHASE_BEGIN
      ln_rows_bf16(XB, p->in[23] + l * D, p->in[24] + l * D);
    PHASE_END
    PHASE_BEGIN
      Gemm ga{XB, D, WUP + (size_t)l * NUP * D, D};
      EpiArgs ea{}; ea.g = G; ea.cw = p->in[26] + (size_t)l * 3 * NUP; ea.cb = p->in[27] + (size_t)l * NUP;
      gemm_phase<2, 1>(lds, ga, NSEQ * 33, NUP / 256, ea);
#if PROBE_GEMM
      gemm_phase<2, 1>(lds, ga, NSEQ * 33, NUP / 256, ea);
#endif
    PHASE_END
    PHASE_BEGIN
      Gemm ga{G, DFF, WDN + (size_t)l * D * DFF, DFF};
      EpiArgs ea{}; ea.xf = XF; ea.xb = XB; ea.pre_f32 = (l == 1) ? 1 : 0;
      gemm_phase<1, 0>(lds, ga, NT / 256, D / 256, ea);
    PHASE_END
    PHASE_BEGIN
      if (l == 1) ln_rows(XF, XF, NT, XF, XB, p->in[29] + l * D, p->in[30] + l * D, true, false);
      else ln_rows_bf16(XB, p->in[29] + l * D, p->in[30] + l * D);
    PHASE_END
  }
}

#if DBG
#define DPTRS unsigned char* ws = p.ws; u16* XB = (u16*)(ws + OFF_XB); u16* PA = (u16*)(ws + OFF_PA); u16* PB = (u16*)(ws + OFF_PB); u16* VT = (u16*)(ws + OFF_VT); \
  u16* G = (u16*)(ws + OFF_PA); u16* VV = (u16*)(ws + OFF_VV); u16* YY = (u16*)(ws + OFF_XB); float* BON = (float*)(ws + OFF_BON); float* DE = (float*)(ws + OFF_DBG); \
  (void)XB; (void)PA; (void)PB; (void)VT; (void)G; (void)VV; (void)YY; (void)BON; (void)DE;
template <int which> __global__ __launch_bounds__(NTHREADS) void k_chk(Params p, int l) {
  extern __shared__ __attribute__((aligned(16))) char shm[];
  LAS unsigned char* lds = (LAS unsigned char*)shm;
  DPTRS
  if (which == 0) chk_proj(XB, p.in[4] + (size_t)l * D * P_COLS, PA, PB, VT, DE + 0);
  else if (which == 1) chk_attn(lds, XB, p.in[4] + (size_t)l * D * P_COLS, PB, VT, p.in[19] + l * 256, p.in[20] + l * 128, p.in[21], l, DE + 1);
  else if (which == 2) {
    ScanW sw; sw.mu = p.in[5] + (size_t)l * 2 * A_COLS; sw.w0 = p.in[6] + l * 1024; sw.du = p.in[7] + (size_t)l * 2 * 32 * 512; sw.a0 = p.in[8] + l * 1024;
    sw.iu = p.in[9] + (size_t)l * 2 * 32 * 512; sw.kk_ = p.in[11] + l * 512; sw.ka = p.in[12] + l * 512; sw.rk = p.in[13] + l * 512;
    chk_scan(lds, PA, VV, YY, BON, sw, DE + 2);
  } else if (which == 3) chk_post(PA, PB, VV, YY, BON, p.in[5] + (size_t)l * 2 * A_COLS, p.in[10] + (size_t)l * 96 * 512, p.in[14] + l * 512, p.in[15] + l * 512, DE + 3);
  else if (which == 5) chk_ffn(XB, p.in[25] + (size_t)l * D * NUP, p.in[26] + (size_t)l * 3 * NUP, p.in[27] + (size_t)l * NUP, G, DE + 5);
}
__global__ __launch_bounds__(NTHREADS) void k_encode(Params p) {
  const float* e = (const float*)(p.ws + OFF_DBG);
  const float eA = fmaxf(e[DBG_A], 1e-4f), eB = fmaxf(e[DBG_B], 1e-4f);
  const float V1 = 100.f + 100.f * log10f(eA / 1e-3f);
  float V2 = 1.f + log10f(eB / 1e-3f); V2 = fminf(fmaxf(V2, 0.3f), 8.f);
  const size_t n0 = (size_t)NPROMPT_TOK * D, n1 = (size_t)NT * D;
  for (size_t i = (size_t)blockIdx.x * NTHREADS + threadIdx.x; i < n1; i += (size_t)gridDim.x * NTHREADS) {
    float v = 0.f;
    if (i == 0 || i == n0) v = V1;
    else if (i < n0 / 2 || (i > n0 && i < n0 + (n1 - n0) / 2)) v = V2;
    p.out[i] = v;
  }
}
#endif

extern "C" void kernel_launch(void* const* d_in, const int* in_sizes, int n_in, void* d_out, int out_size, void* d_ws, size_t ws_size, hipStream_t stream) {
  static int grid = 0;
  if (grid == 0) {
    if (ws_size < WS_END) { fprintf(stderr, "ws too small: %zu < %zu\n", ws_size, (size_t)WS_END); grid = -1; return; }
    int dev = 0, cus = 0, per_cu = 0;
    hipGetDevice(&dev);
    hipDeviceGetAttribute(&cus, hipDeviceAttributeMultiprocessorCount, dev);
    hipFuncSetAttribute((const void*)mega, hipFuncAttributeMaxDynamicSharedMemorySize, LDS_BYTES);
#if DBG
    hipFuncSetAttribute((const void*)k_chk<1>, hipFuncAttributeMaxDynamicSharedMemorySize, 81920);
    hipFuncSetAttribute((const void*)k_chk<2>, hipFuncAttributeMaxDynamicSharedMemorySize, 81920);
#endif
    hipOccupancyMaxActiveBlocksPerMultiprocessor(&per_cu, (const void*)mega, NTHREADS, LDS_BYTES);
    if (per_cu < 1) per_cu = 1;
    grid = cus * 1;
  }
  if (grid < 0) return;
  Params p{};
  for (int i = 0; i < 31; ++i) p.in[i] = (const float*)d_in[i];
  p.out = (float*)d_out; p.ws = (unsigned char*)d_ws;
#if DBG
  hipMemsetAsync((char*)d_ws + OFF_DBG, 0, 256, stream);
  auto seg = [&](int lo, int hi) { Params q = p; q.ph_lo = lo; q.ph_hi = hi; void* a2[] = {&q};
    hipError_t e = hipLaunchCooperativeKernel((const void*)mega, dim3(grid), dim3(NTHREADS), a2, LDS_BYTES, stream);
    if (e != hipSuccess) fprintf(stderr, "cooperative launch failed: %s\n", hipGetErrorString(e)); };
  auto chk = [&](int l, int which) {
    if (which == 0) hipLaunchKernelGGL(k_chk<0>, dim3(64), dim3(NTHREADS), 81920, stream, p, l);
    if (which == 1) hipLaunchKernelGGL(k_chk<1>, dim3(64), dim3(NTHREADS), 81920, stream, p, l);
    if (which == 2) hipLaunchKernelGGL(k_chk<2>, dim3(64), dim3(NTHREADS), 81920, stream, p, l);
    if (which == 3) hipLaunchKernelGGL(k_chk<3>, dim3(64), dim3(NTHREADS), 81920, stream, p, l);
    if (which == 5) hipLaunchKernelGGL(k_chk<5>, dim3(64), dim3(NTHREADS), 81920, stream, p, l); };
  seg(0, 1);
  for (int l = 0; l < 2; ++l) {
    const int b = 1 + 9 * l;
    seg(b, b + 1); chk(l, 0);
    seg(b + 1, b + 2); chk(l, 1);
    seg(b + 2, b + 3); chk(l, 2);
    seg(b + 3, b + 4); chk(l, 3);
    seg(b + 4, b + 7); if (l == 0) chk(l, 5);
    seg(b + 7, b + 9);
  }
  hipLaunchKernelGGL(k_encode, dim3(1024), dim3(NTHREADS), 0, stream, p);
#else
  hipMemsetAsync((char*)d_ws + OFF_XBAR, 0, XBAR_BYTES, stream);
  p.ph_lo = 0; p.ph_hi = 1000;
  void* args[] = {&p};
  hipError_t e = hipLaunchCooperativeKernel((const void*)mega, dim3(grid), dim3(NTHREADS), args, LDS_BYTES, stream);
  if (e != hipSuccess) fprintf(stderr, "cooperative launch failed: %s (grid %d)\n", hipGetErrorString(e), grid);
#endif
}
```

```cpp
#include <hip/hip_runtime.h>
#include <hip/hip_bf16.h>
#include <hip/hip_cooperative_groups.h>
#include <cstdio>
namespace cg = cooperative_groups;

#define DI __device__ __forceinline__
using bf16 = __hip_bfloat16;
using bf16x8 = __attribute__((ext_vector_type(8))) short;
using s16x4 = __attribute__((ext_vector_type(4))) short;
using f32x4 = __attribute__((ext_vector_type(4))) float;
using f32x16 = __attribute__((ext_vector_type(16))) float;
typedef unsigned short u16;
typedef __bf16 bf2 __attribute__((ext_vector_type(2)));
typedef unsigned u32x4 __attribute__((ext_vector_type(4)));
typedef unsigned u32x2 __attribute__((ext_vector_type(2)));

constexpr int D = 1024, T = 8192, NSEQ = 12, NT = NSEQ * T;
constexpr int NPROMPT_TOK = 4 * T;
constexpr int A_COLS = 1760, P_COLS = 3296, NPROJ = 3328;
constexpr int DFF = 2816, NUP = 5632;
constexpr int OFF_K = 512, OFF_V = 1024, OFF_WD = 1536, OFF_AD = 1600, OFF_GD = 1664;
constexpr float ALPHA = 1.4142135623730951f;
constexpr float LN_EPS = 1e-5f, GN_EPS = 64e-5f;
constexpr int NTHREADS = 512;
#ifndef DBGZ
#define DBGZ 0
#define DBG 0
#define PROBE_SCAN 0
#define PROBE_GEMM 0
#define PROBE_MISC 0
#ifndef CHK_PROJ_ON
#define CHK_PROJ_ON 1
#endif
#ifndef CHK_ATTN_ON
#define CHK_ATTN_ON 1
#endif
#ifndef CHK_SCAN_ON
#define CHK_SCAN_ON 1
#endif
#ifndef CHK_POST_ON
#define CHK_POST_ON 1
#endif
#ifndef CHK_FFN_ON
#define CHK_FFN_ON 1
#endif
#define DBG_A 5
#define DBG_B 6
#define DBGTHR 0.05f, 0.1f, 0.1f, 0.1f, 0.01f, 0.05f
#endif
constexpr int LDS_BYTES = 163840;

constexpr size_t SZ_WIN = (size_t)2 * NPROJ * D * 2;
constexpr size_t SZ_WOUT = (size_t)2 * D * D * 2;
constexpr size_t SZ_WUP = (size_t)2 * NUP * D * 2;
constexpr size_t SZ_WDN = (size_t)2 * D * DFF * 2;
constexpr size_t OFF_WIN = 0;
constexpr size_t OFF_WOUT = OFF_WIN + SZ_WIN;
constexpr size_t OFF_WUP = OFF_WOUT + SZ_WOUT;
constexpr size_t OFF_WDN = OFF_WUP + SZ_WUP;
constexpr size_t OFF_XB = OFF_WDN + SZ_WDN;
constexpr size_t OFF_PA = OFF_XB + (size_t)NT * D * 2;
constexpr size_t OFF_PB = OFF_PA + (size_t)NT * A_COLS * 2;
constexpr size_t OFF_VT = OFF_PB + (size_t)NT * 1024 * 2;
constexpr size_t OFF_VV = OFF_VT + (size_t)NT * 512 * 2;
constexpr size_t OFF_BON = OFF_VV + (size_t)NT * 512 * 2;
constexpr size_t OFF_OSV = OFF_BON + (size_t)2 * NT * 8 * 4;
constexpr size_t OFF_DBG = OFF_OSV + (size_t)256 * 64 * 512 * 4;
constexpr size_t OFF_XBAR = OFF_DBG + 256;
constexpr size_t XBAR_BYTES = 3456 * 4 + 256 * 8;
constexpr size_t WS_END = OFF_XBAR + XBAR_BYTES;
static_assert((size_t)NT * DFF * 2 <= (OFF_VV - OFF_PA), "G alias");

struct Params {
  const float* in[31];
  float* out;
  unsigned char* ws;
  int ph_lo, ph_hi;
};

typedef const __attribute__((address_space(4))) Params* CParams;
DI CParams get_params() { CParams pp = (CParams)__builtin_amdgcn_kernarg_segment_ptr(); asm volatile("" : "+s"(pp)); return pp; }

DI u16 f2bf(float x) { unsigned u = __float_as_uint(x); u += 0x7fffu + ((u >> 16) & 1u); return (u16)(u >> 16); }
DI unsigned cvt_pk_bf16(float lo, float hi) { unsigned r; asm volatile("v_cvt_pk_bf16_f32 %0, %1, %2" : "=v"(r) : "v"(lo), "v"(hi)); return r; }
DI float bf2f(u16 b) { return __uint_as_float(((unsigned)b) << 16); }
DI float sigmoidf_(float x) { return 1.f / (1.f + __expf(-x)); }

template <int MODE> DI int src_col(int n) {
  if (MODE == 0) { return n < A_COLS ? n : (n < 1792 ? -1 : n - 32); }
  if (MODE == 2) { int j = n >> 8, i = n & 255; return i < 128 ? j * 128 + i : DFF + j * 128 + (i - 128); }
  return n;
}
template <int MODE>
DI void convert_weight(char* shm, const float* W, u16* WT, int K, int Nsrc, int Ndst, int gtid_block, int nblocks) {
  float* tile = (float*)shm;
  int tn = Ndst / 64, tk = K / 64;
  for (int t = gtid_block; t < tn * tk; t += nblocks) {
    int n0 = (t / tk) * 64, k0 = (t % tk) * 64;
    __syncthreads();
    for (int e = threadIdx.x; e < 4096; e += NTHREADS) {
      int kk = e >> 6, nn = e & 63;
      int sc = src_col<MODE>(n0 + nn);
      tile[kk * 65 + nn] = sc >= 0 ? W[(size_t)(k0 + kk) * Nsrc + sc] : 0.f;
    }
    __syncthreads();
    for (int e = threadIdx.x; e < 4096; e += NTHREADS) {
      int nn = e >> 6, kk = e & 63;
      WT[(size_t)(n0 + nn) * K + k0 + kk] = f2bf(tile[kk * 65 + nn]);
    }
  }
}

constexpr int LNR = 4;
DI void ln_rows(const float* srcA, const float* srcB, int splitRow, float* dstF, u16* dstB, const float* g, const float* b, bool writeF, bool writeB) {
  int tid = threadIdx.x; asm volatile("" : "+v"(tid));
  int bid = blockIdx.x, gdim = gridDim.x; asm volatile("" : "+s"(bid), "+s"(gdim));
  int wave = tid >> 6, lane = tid & 63;
  int gw = bid * 8 + wave, nw = gdim * 8;
  for (int base = gw * LNR; base < NT; base += nw * LNR) {
    f32x4 v[LNR][4]; float s[LNR], q[LNR];
#pragma unroll
    for (int r = 0; r < LNR; ++r) {
      const int row = base + r;
      const float* src = row < splitRow ? srcA + (size_t)row * D : srcB + (size_t)(row - splitRow) * D;
#pragma unroll
      for (int i = 0; i < 4; ++i) v[r][i] = *(const f32x4*)(src + i * 256 + lane * 4);
    }
#pragma unroll
    for (int r = 0; r < LNR; ++r) { s[r] = 0.f;
#pragma unroll
      for (int i = 0; i < 4; ++i) s[r] += (v[r][i][0] + v[r][i][1]) + (v[r][i][2] + v[r][i][3]); }
#pragma unroll
    for (int o = 32; o > 0; o >>= 1)
#pragma unroll
      for (int r = 0; r < LNR; ++r) s[r] += __shfl_xor(s[r], o);
#pragma unroll
    for (int r = 0; r < LNR; ++r) { const float mu = s[r] * (1.f / D); q[r] = 0.f;
#pragma unroll
      for (int i = 0; i < 4; ++i) { v[r][i] -= mu; const f32x4 t = v[r][i] * v[r][i]; q[r] += (t[0] + t[1]) + (t[2] + t[3]); } }
#pragma unroll
    for (int o = 32; o > 0; o >>= 1)
#pragma unroll
      for (int r = 0; r < LNR; ++r) q[r] += __shfl_xor(q[r], o);
#pragma unroll
    for (int i = 0; i < 4; ++i) {
      const f32x4 gg = *(const f32x4*)(g + i * 256 + lane * 4), bb = *(const f32x4*)(b + i * 256 + lane * 4);
#pragma unroll
      for (int r = 0; r < LNR; ++r) {
        const int row = base + r;
        const float rs = rsqrtf(q[r] * (1.f / D) + LN_EPS);
        const f32x4 o4 = v[r][i] * rs * gg + bb;
        if (writeF) *(f32x4*)(dstF + (size_t)row * D + i * 256 + lane * 4) = o4;
        if (writeB) { u32x2 h; h.x = cvt_pk_bf16(o4[0], o4[1]); h.y = cvt_pk_bf16(o4[2], o4[3]);
          *(u32x2*)(dstB + (size_t)row * D + i * 256 + lane * 4) = h; }
      }
    }
  }
}

DI void ln_rows_bf16(u16* xb, const float* g, const float* b) {
  int tid = threadIdx.x; asm volatile("" : "+v"(tid));
  int bid = blockIdx.x, gdim = gridDim.x; asm volatile("" : "+s"(bid), "+s"(gdim));
  int wave = tid >> 6, lane = tid & 63;
  int gw = bid * 8 + wave, nw = gdim * 8;
  for (int base = gw * LNR; base < NT; base += nw * LNR) {
    f32x4 v[LNR][4]; float s[LNR], q[LNR];
#pragma unroll
    for (int r = 0; r < LNR; ++r) {
      const u16* src = xb + (size_t)(base + r) * D;
#pragma unroll
      for (int i = 0; i < 4; ++i) { const u32x2 x2 = *(const u32x2*)(src + i * 256 + lane * 4);
        v[r][i][0] = __uint_as_float(x2.x << 16); v[r][i][1] = __uint_as_float(x2.x & 0xffff0000u); v[r][i][2] = __uint_as_float(x2.y << 16); v[r][i][3] = __uint_as_float(x2.y & 0xffff0000u); }
    }
#pragma unroll
    for (int r = 0; r < LNR; ++r) { s[r] = 0.f;
#pragma unroll
      for (int i = 0; i < 4; ++i) s[r] += (v[r][i][0] + v[r][i][1]) + (v[r][i][2] + v[r][i][3]); }
#pragma unroll
    for (int o = 32; o > 0; o >>= 1)
#pragma unroll
      for (int r = 0; r < LNR; ++r) s[r] += __shfl_xor(s[r], o);
#pragma unroll
    for (int r = 0; r < LNR; ++r) { const float mu = s[r] * (1.f / D); q[r] = 0.f;
#pragma unroll
      for (int i = 0; i < 4; ++i) { v[r][i] -= mu; const f32x4 t = v[r][i] * v[r][i]; q[r] += (t[0] + t[1]) + (t[2] + t[3]); } }
#pragma unroll
    for (int o = 32; o > 0; o >>= 1)
#pragma unroll
      for (int r = 0; r < LNR; ++r) q[r] += __shfl_xor(q[r], o);
#pragma unroll
    for (int i = 0; i < 4; ++i) {
      const f32x4 gg = *(const f32x4*)(g + i * 256 + lane * 4), bb = *(const f32x4*)(b + i * 256 + lane * 4);
#pragma unroll
      for (int r = 0; r < LNR; ++r) {
        const float rs = rsqrtf(q[r] * (1.f / D) + LN_EPS);
        const f32x4 o4 = v[r][i] * rs * gg + bb;
        u32x2 h; h.x = cvt_pk_bf16(o4[0], o4[1]); h.y = cvt_pk_bf16(o4[2], o4[3]);
        *(u32x2*)(xb + (size_t)(base + r) * D + i * 256 + lane * 4) = h;
      }
    }
  }
}

#define LAS __attribute__((address_space(3)))
constexpr int BK = 64, HALF = 128, HTB = HALF * BK * 2, STAGE_BYTES = 8 * HTB;
DI int lds_byte(int r, int c) { const int st = (r >> 4) * 2 + (c >> 5), rr = r & 15, cc = c & 31, ob = rr * 64 + cc * 2; return st * 1024 + (ob ^ (((ob >> 9) & 1) << 5)); }
DI void stage_rc(int b, int& R, int& C) { const int st = b / 1024, sb = b % 1024, swz = sb ^ (((sb >> 9) & 1) << 5); R = (st >> 1) * 16 + swz / 64; C = (st & 1) * 32 + (swz % 64) / 2; }
DI int perm32(int rho) { const int n = rho >> 4, i = rho & 15; return 8 * (i >> 2) + 4 * n + (i & 3); }

typedef float f32x2 __attribute__((ext_vector_type(2)));
DI float gelu1(float v) {
  const float av = __builtin_fabsf(v), d = av * 0.2316418882f + 1.0f;
  const float t = __builtin_amdgcn_rcpf(d);
  float q = t * 0.5307027145f + (-0.7265760135f); q = q * t + 0.7107068705f; q = q * t + (-0.142248368f); q = q * t + 0.127414796f; q = q * t;
  const float e = __builtin_amdgcn_exp2f((v * v) * (-0.72134752044f));
  const float m = v * (q * e), r = v - m;
  return v < 0.f ? m : r;
}
DI float dpp_shr1(float old, float src) { asm volatile("s_nop 1\n\tv_mov_b32_dpp %0, %1 row_shr:1 row_mask:0xf bank_mask:0xf\n\ts_nop 0" : "+v"(old) : "v"(src)); return old; }
DI float dpp_shl1(float old, float src) { asm volatile("s_nop 1\n\tv_mov_b32_dpp %0, %1 row_shl:1 row_mask:0xf bank_mask:0xf\n\ts_nop 0" : "+v"(old) : "v"(src)); return old; }
struct Unit { int pm, pn; };
struct Order {
  int nM, nN, nwg, G, c;
  DI void init(int nM_, int nN_, int G_, int c_) { nM = nM_; nN = nN_; nwg = nM * nN; G = G_; c = c_; }
  DI bool next(int i, Unit& u) const {
    const long Lq = (long)i * G + c; if (Lq >= nwg) return false;
    int wgid = (int)Lq; { const int q = nwg / 8, r = nwg % 8, xcd = wgid % 8, off = wgid / 8; wgid = (xcd < r ? xcd * (q + 1) : r * (q + 1) + (xcd - r) * q) + off; }
    const int nig = 8 * nN, gid = wgid / nig, fm = gid * 8, gsz = (nM - fm) < 8 ? (nM - fm) : 8;
    u.pm = fm + ((wgid % nig) % gsz); u.pn = (wgid % nig) / gsz; return true;
  }
};
struct Gemm { const u16* A; int lda; const u16* Bt; int K; };
template <int ROWMODE> DI const char* a_tile_ptr(const Gemm& g, int pm) {
  long row = ROWMODE == 0 ? (long)pm * 256 : (long)(pm / 33) * T + 254 * (pm % 33) - 1;
  return (const char*)g.A + row * g.lda * 2;
}
struct EpiArgs {
  u16* pa; u16* pb; u16* vt;
  float* xf; u16* xb;
  u16* g; const float* cw; const float* cb;
  int zero; int pre_f32;
};
template <int EPI>
DI void epilogue(f32x4 (&acc)[2][2][4][2], const Unit& u, const EpiArgs& ea, LAS unsigned char* lds) {
  int tid2 = threadIdx.x; asm volatile("" : "+v"(tid2));
  const int wid2 = tid2 >> 6, lane2 = tid2 & 63, wr = wid2 >> 2, wc = wid2 & 3, fr = lane2 & 15, fq = lane2 >> 4;
  if (EPI == 0) {
    const int row0 = u.pm * 256 + wr * 64 + fr;
#pragma unroll
    for (int ai = 0; ai < 2; ++ai)
#pragma unroll
      for (int m = 0; m < 4; ++m) {
        const int row = row0 + ai * HALF + m * 16;
#pragma unroll
        for (int bj = 0; bj < 2; ++bj) {
          const int col = u.pn * 256 + bj * HALF + wc * 32 + 8 * fq;
          const f32x4 a0 = acc[ai][bj][m][0], a1 = acc[ai][bj][m][1];
          if (u.pn <= 10) {
            uint4 pk; pk.x = cvt_pk_bf16(a0[0], a0[1]); pk.y = cvt_pk_bf16(a0[2], a0[3]); pk.z = cvt_pk_bf16(a1[0], a1[1]); pk.w = cvt_pk_bf16(a1[2], a1[3]);
            if (u.pn <= 6) { if (col < A_COLS) *(uint4*)(ea.pa + (size_t)row * A_COLS + col) = pk; }
            else *(uint4*)(ea.pb + (size_t)row * 1024 + (col - 1792)) = pk;
          } else {
            const int c2 = col - 2816, h = c2 >> 7, e = c2 & 127, seq = row / T, t = row % T;
            u16* dst = ea.vt + ((size_t)((seq * 4 + h) * 128 + e)) * T + t;
#pragma unroll
            for (int j = 0; j < 4; ++j) { dst[(size_t)j * T] = f2bf(a0[j]); dst[(size_t)(4 + j) * T] = f2bf(a1[j]); }
          }
        }
      }
  } else if (EPI == 1) {
    const int row0 = u.pm * 256 + wr * 64 + fr, col0 = u.pn * 256 + wc * 32 + 8 * fq;
#pragma unroll
    for (int ai = 0; ai < 2; ++ai)
#pragma unroll
      for (int m = 0; m < 4; ++m) {
        float* rowp = ea.xf + (size_t)(row0 + ai * HALF + m * 16) * D + col0;
        u16* rowb = ea.xb + (size_t)(row0 + ai * HALF + m * 16) * D + col0;
#pragma unroll
        for (int bj = 0; bj < 2; ++bj) {
          const u32x4 xr = *(const u32x4*)(rowb + bj * HALF);
          f32x4 x0, x1;
          x0[0] = __uint_as_float(xr.x << 16); x0[1] = __uint_as_float(xr.x & 0xffff0000u); x0[2] = __uint_as_float(xr.y << 16); x0[3] = __uint_as_float(xr.y & 0xffff0000u);
          x1[0] = __uint_as_float(xr.z << 16); x1[1] = __uint_as_float(xr.z & 0xffff0000u); x1[2] = __uint_as_float(xr.w << 16); x1[3] = __uint_as_float(xr.w & 0xffff0000u);
          const f32x4 p0 = x0 * ALPHA + acc[ai][bj][m][0], p1 = x1 * ALPHA + acc[ai][bj][m][1];
          if (ea.pre_f32) { *(f32x4*)(rowp + bj * HALF) = p0; *(f32x4*)(rowp + bj * HALF + 4) = p1; }
          else { u32x4 hq; hq.x = cvt_pk_bf16(p0[0], p0[1]); hq.y = cvt_pk_bf16(p0[2], p0[3]); hq.z = cvt_pk_bf16(p1[0], p1[1]); hq.w = cvt_pk_bf16(p1[2], p1[3]); *(u32x4*)(rowb + bj * HALF) = hq; }
        }
      }
  } else {
    LAS float* E = (LAS float*)(lds + STAGE_BYTES);
    const int seq = u.pm / 33, ti = u.pm % 33;
    const int cl0 = wc * 32 + 8 * fq;
#pragma unroll
    for (int ai = 0; ai < 2; ++ai)
#pragma unroll
      for (int m = 0; m < 4; ++m) {
        const int rl = ai * HALF + wr * 64 + m * 16 + fr;
        const int tok = 254 * ti - 1 + rl;
        const bool valid = tok >= 0 && tok < T;
        const int blk = ai * 8 + wr * 4 + m;
#pragma unroll
        for (int bj = 0; bj < 2; ++bj)
#pragma unroll
          for (int n = 0; n < 2; ++n) {
            if (!valid) acc[ai][bj][m][n] = (f32x4){0.f, 0.f, 0.f, 0.f};
            if (fr == 0) *(LAS f32x4*)(E + ((blk * 2 + 0) * 2 + bj) * 128 + cl0 + 4 * n) = acc[ai][bj][m][n];
            if (fr == 15) *(LAS f32x4*)(E + ((blk * 2 + 1) * 2 + bj) * 128 + cl0 + 4 * n) = acc[ai][bj][m][n];
          }
      }
    asm volatile("s_waitcnt lgkmcnt(0)" ::: "memory");
    __builtin_amdgcn_s_barrier(); asm volatile("" ::: "memory");
    __builtin_amdgcn_s_barrier(); asm volatile("" ::: "memory");
#pragma unroll
    for (int n = 0; n < 2; ++n) {
      const int hid = u.pn * 128 + cl0 + 4 * n;
      const float* cwp = ea.cw + hid;
      const f32x4 g0 = *(const f32x4*)(cwp), g1 = *(const f32x4*)(cwp + NUP), g2 = *(const f32x4*)(cwp + 2 * NUP), gb = *(const f32x4*)(ea.cb + hid);
      const f32x4 u0 = *(const f32x4*)(cwp + DFF), u1 = *(const f32x4*)(cwp + DFF + NUP), u2 = *(const f32x4*)(cwp + DFF + 2 * NUP), ub = *(const f32x4*)(ea.cb + DFF + hid);
#pragma unroll
      for (int ai = 0; ai < 2; ++ai)
#pragma unroll
        for (int m = 0; m < 4; ++m) {
          const int blk = ai * 8 + wr * 4 + m;
          const int rl = ai * HALF + wr * 64 + m * 16 + fr;
          const int tok = 254 * ti - 1 + rl;
          f32x4 hh[2];
#pragma unroll
          for (int bj = 0; bj < 2; ++bj) {
            const f32x4 cur = acc[ai][bj][m][n];
            f32x4 ab = (f32x4){0.f, 0.f, 0.f, 0.f}, be = (f32x4){0.f, 0.f, 0.f, 0.f};
            if (fr == 0 && blk > 0) ab = *(LAS f32x4*)(E + (((blk - 1) * 2 + 1) * 2 + bj) * 128 + cl0 + 4 * n);
            if (fr == 15 && blk < 15) be = *(LAS f32x4*)(E + (((blk + 1) * 2 + 0) * 2 + bj) * 128 + cl0 + 4 * n);
            f32x4 prev, next;
#pragma unroll
            for (int j = 0; j < 4; ++j) { prev[j] = dpp_shr1(ab[j], cur[j]); next[j] = dpp_shl1(be[j], cur[j]); }
            hh[bj] = bj == 0 ? g0 * prev + g1 * cur + g2 * next + gb : u0 * prev + u1 * cur + u2 * next + ub;
          }
          f32x4 res;
#pragma unroll
          for (int j = 0; j < 4; ++j) res[j] = gelu1(hh[0][j]) * hh[1][j];
          if (rl >= 1 && rl <= 254 && tok < T) {
            u32x2 pk; pk.x = cvt_pk_bf16(res[0], res[1]); pk.y = cvt_pk_bf16(res[2], res[3]);
            *(u32x2*)(ea.g + (size_t)(seq * T + tok) * DFF + hid) = pk;
          }
        }
    }
  }
}

template <int EPI, int ROWMODE>
DI void gemm_phase(LAS unsigned char* lds, const Gemm g, int nM, int nN, const EpiArgs& ea) {
  constexpr bool PERM = true;
  int tid = threadIdx.x; asm volatile("" : "+v"(tid));
  int bid = blockIdx.x, gdim = gridDim.x; asm volatile("" : "+s"(bid), "+s"(gdim));
  const int wid = __builtin_amdgcn_readfirstlane(tid >> 6), lane = tid & 63, wr = wid >> 2, wc = wid & 3, fr = lane & 15, fq = lane >> 4;
  const int K = g.K, nt = K / BK;
  Order S; S.init(nM, nN, gdim, bid);
  unsigned voffA[2], voffB[2];
#pragma unroll
  for (int i = 0; i < 2; ++i) { int R, C; stage_rc(tid * 16 + i * 8192, R, C); const int Rb = PERM ? ((R & ~31) + perm32(R & 31)) : R;
    voffA[i] = (unsigned)(R * g.lda + C) * 2u; voffB[i] = (unsigned)(Rb * K + C) * 2u; }
  const size_t kstep = (size_t)(BK * 2);
  const size_t hstepA = (size_t)HALF * g.lda * 2, hstepB = (size_t)HALF * K * 2;
  const unsigned ldsw = (unsigned)wid * 1024u;
  const int aoff = lds_byte(wr * 64 + fr, fq * 8), boff = lds_byte(wc * 32 + fr, fq * 8);
#define PG8_SA(b, h) (((b) * 2 + (h)) * HTB)
#define PG8_SB(b, h) ((4 + (b) * 2 + (h)) * HTB)
#define PG8_STAGE(bufoff, gbase, voff) do { _Pragma("unroll") for (int _i = 0; _i < 2; ++_i) \
    __builtin_amdgcn_global_load_lds((const unsigned*)((const char*)(gbase) + (voff)[_i]), (LAS unsigned*)(lds + (bufoff) + ldsw + _i * 8192), 16, 0, 0); } while (0)
#define PG8_LDA(dst, b, h) do { _Pragma("unroll") for (int m = 0; m < 4; ++m) _Pragma("unroll") for (int k = 0; k < 2; ++k) dst[m][k] = *(const LAS bf16x8*)(lds + PG8_SA(b, h) + aoff + m * 2048 + k * 1024); } while (0)
#define PG8_LDB(dst, b, h) do { _Pragma("unroll") for (int n = 0; n < 2; ++n) _Pragma("unroll") for (int k = 0; k < 2; ++k) dst[n][k] = *(const LAS bf16x8*)(lds + PG8_SB(b, h) + boff + n * 2048 + k * 1024); } while (0)
#define PG8_MMA(ai, bj, At, Bq) do { __builtin_amdgcn_s_setprio(1); _Pragma("unroll") for (int m = 0; m < 4; ++m) _Pragma("unroll") for (int n = 0; n < 2; ++n) _Pragma("unroll") for (int k = 0; k < 2; ++k) \
    acc[ai][bj][m][n] = __builtin_amdgcn_mfma_f32_16x16x32_bf16(Bq[n][k], At[m][k], acc[ai][bj][m][n], 0, 0, 0); __builtin_amdgcn_s_setprio(0); } while (0)
#define PG8_WAIT_V(n) asm volatile("s_waitcnt vmcnt(" #n ")" ::: "memory")
#define PG8_WAIT_L(n) asm volatile("s_waitcnt lgkmcnt(" #n ")" ::: "memory")
#define PG8_BAR __builtin_amdgcn_s_barrier()
#define PG8_SCHED __builtin_amdgcn_sched_barrier(0)
  Unit cur, nxt; int ui = 0;
  __syncthreads();
  if (!S.next(0, cur)) return;
  f32x4 acc[2][2][4][2];
#pragma unroll
  for (int a = 0; a < 2; ++a)
#pragma unroll
    for (int b = 0; b < 2; ++b)
#pragma unroll
      for (int m = 0; m < 4; ++m)
#pragma unroll
        for (int n = 0; n < 2; ++n) acc[a][b][m][n] = (f32x4){0.f, 0.f, 0.f, 0.f};
  bf16x8 At[4][2], B0[2][2], B1[2][2];
  const char* cA = a_tile_ptr<ROWMODE>(g, cur.pm); const char* cB = (const char*)g.Bt + (size_t)cur.pn * 2 * hstepB;
  PG8_STAGE(PG8_SB(0, 0), cB, voffB); PG8_STAGE(PG8_SA(0, 0), cA, voffA); PG8_STAGE(PG8_SB(0, 1), cB + hstepB, voffB); PG8_STAGE(PG8_SA(0, 1), cA + hstepA, voffA);
  if (wr == 1) PG8_BAR;
  PG8_WAIT_V(4); PG8_BAR;
  PG8_STAGE(PG8_SB(1, 0), cB + kstep, voffB); PG8_STAGE(PG8_SA(1, 0), cA + kstep, voffA); PG8_STAGE(PG8_SB(1, 1), cB + hstepB + kstep, voffB);
  PG8_WAIT_V(6); PG8_BAR;
  for (;;) {
    const bool has_next = S.next(ui + 1, nxt);
    const char* nA = has_next ? a_tile_ptr<ROWMODE>(g, nxt.pm) : cA; const char* nB = has_next ? (const char*)g.Bt + (size_t)nxt.pn * 2 * hstepB : cB;
    for (int t = 0; t < nt; t += 2) {
      const bool last = (t == nt - 2);
      const char* a1 = cA + (size_t)(t + 1) * kstep;
      const char* a2 = last ? nA : cA + (size_t)(t + 2) * kstep; const char* b2 = last ? nB : cB + (size_t)(t + 2) * kstep;
      const char* a3 = a2 + kstep; const char* b3 = b2 + kstep;
      PG8_LDB(B0, 0, 0); PG8_SCHED; PG8_LDA(At, 0, 0); PG8_STAGE(PG8_SA(1, 1), a1 + hstepA, voffA);
      PG8_WAIT_L(8); PG8_BAR; PG8_WAIT_L(0); PG8_MMA(0, 0, At, B0); PG8_BAR; PG8_SCHED;
      PG8_LDB(B1, 0, 1); PG8_STAGE(PG8_SB(0, 0), b2, voffB);
      PG8_BAR; PG8_WAIT_L(0); PG8_MMA(0, 1, At, B1); PG8_BAR;
      PG8_LDA(At, 0, 1); PG8_STAGE(PG8_SA(0, 0), a2, voffA);
      PG8_BAR; PG8_WAIT_L(0); PG8_MMA(1, 0, At, B0); PG8_BAR; PG8_SCHED;
      PG8_STAGE(PG8_SB(0, 1), b2 + hstepB, voffB);
      PG8_WAIT_V(6); PG8_BAR; PG8_MMA(1, 1, At, B1); PG8_BAR;
      PG8_LDB(B0, 1, 0); PG8_SCHED; PG8_LDA(At, 1, 0); PG8_STAGE(PG8_SA(0, 1), a2 + hstepA, voffA);
      PG8_WAIT_L(8); PG8_BAR; PG8_WAIT_L(0); PG8_MMA(0, 0, At, B0); PG8_BAR; PG8_SCHED;
      PG8_LDB(B1, 1, 1); PG8_STAGE(PG8_SB(1, 0), b3, voffB);
      PG8_BAR; PG8_WAIT_L(0); PG8_MMA(0, 1, At, B1); PG8_BAR;
      PG8_LDA(At, 1, 1); PG8_STAGE(PG8_SA(1, 0), a3, voffA);
      PG8_BAR; PG8_WAIT_L(0); PG8_MMA(1, 0, At, B0); PG8_BAR; PG8_SCHED;
      PG8_STAGE(PG8_SB(1, 1), b3 + hstepB, voffB);
      PG8_WAIT_V(6); PG8_BAR; PG8_MMA(1, 1, At, B1); PG8_BAR;
    }
    epilogue<EPI>(acc, cur, ea, lds);
    if (!has_next) break;
#pragma unroll
    for (int a = 0; a < 2; ++a)
#pragma unroll
      for (int b = 0; b < 2; ++b)
#pragma unroll
        for (int m = 0; m < 4; ++m)
#pragma unroll
          for (int n = 0; n < 2; ++n) acc[a][b][m][n] = (f32x4){0.f, 0.f, 0.f, 0.f};
    cur = nxt; cA = nA; cB = nB; ++ui;
  }
  PG8_WAIT_V(0);
  if (wr == 0) PG8_BAR;
  PG8_BAR;
#undef PG8_SA
#undef PG8_SB
}

constexpr int KROW = 144, VROW = 144;
constexpr int KBUF = 64 * KROW, VBUF = 128 * VROW, ABUF = KBUF + VBUF;
constexpr float LOG2E = 1.4426950408889634f;
DI bf16x8 pack8(const f32x16& x, int s) {
  u32x4 p; p.x = cvt_pk_bf16(x[8 * s], x[8 * s + 1]); p.y = cvt_pk_bf16(x[8 * s + 2], x[8 * s + 3]); p.z = cvt_pk_bf16(x[8 * s + 4], x[8 * s + 5]); p.w = cvt_pk_bf16(x[8 * s + 6], x[8 * s + 7]);
  return __builtin_bit_cast(bf16x8, p);
}
DI void attn_phase(LAS unsigned char* lds, u16* PB, const u16* VT, float* OSV, const float* lamp, const float* subg, const float* relb, int layer, int pair_lo, int pair_hi, int wg_lo, int wg_cnt) {
  int tid = threadIdx.x; asm volatile("" : "+v"(tid));
  int bid = blockIdx.x, gdim = gridDim.x; asm volatile("" : "+s"(bid), "+s"(gdim));
  const int wid = tid >> 6, lane = tid & 63, qi = lane & 31, g = lane >> 5;
  LAS float* tab = (LAS float*)(lds + 4 * ABUF);
  LAS float* scal = tab + 264;
  const float lam_init = 0.8f - 0.6f * __expf(-0.3f * (float)layer);
  __syncthreads();
  if (wid == 0) {
    float a = lamp[lane] * lamp[64 + lane], b = lamp[128 + lane] * lamp[192 + lane];
    for (int o = 32; o > 0; o >>= 1) { a += __shfl_xor(a, o); b += __shfl_xor(b, o); }
    if (lane == 0) scal[0] = __expf(a) - __expf(b) + lam_init;
  }
  const int m_sw = (qi & 0x13) | ((qi & 4) << 1) | ((qi & 8) >> 1);
  if (bid < wg_lo || bid >= wg_lo + wg_cnt) return;
  const int xcd = bid & 7, jq = (bid - wg_lo) >> 3;
  const int per_x = wg_cnt >> 3;
  const float c1 = 0.125f * LOG2E;
  for (int pr = pair_lo + xcd; pr < pair_hi; pr += 8) {
    const int s = pr >> 2, h = pr & 3;
    for (int qb = jq; qb < 32; qb += per_x) {
      __syncthreads();
      for (int i = tid; i < 257; i += NTHREADS) {
        const int rel = i - 128, n = rel < 0 ? -rel : rel;
        int bk = n < 8 ? n : (n <= 11 ? 8 : (n <= 15 ? 9 : (n <= 22 ? 10 : (n <= 31 ? 11 : (n <= 45 ? 12 : (n <= 63 ? 13 : (n <= 90 ? 14 : 15)))))));
        if (rel > 0) bk += 16;
        tab[i] = relb[bk * 4 + h] * LOG2E;
      }
      const int q0 = qb * 256 + wid * 32;
      const size_t tokbase = (size_t)s * T;
      float* osv = OSV + ((size_t)bid * 512 + tid) * 64;
#pragma unroll 1
      for (int c = 0; c < 2; ++c) {
        bf16x8 Q[4];
        { const u16* qp = PB + (tokbase + q0 + qi) * 1024 + h * 128 + c * 64 + g * 8;
#pragma unroll
          for (int ks = 0; ks < 4; ++ks) Q[ks] = *(const bf16x8*)(qp + ks * 16); }
        f32x16 O[4];
#pragma unroll
        for (int eb = 0; eb < 4; ++eb)
#pragma unroll
          for (int i = 0; i < 16; ++i) O[eb][i] = 0.f;
        float mrun = -1e30f, lrun = 0.f;
        const u16* kg = PB + (tokbase + (tid >> 3)) * 1024 + 512 + h * 128 + c * 64 + (tid & 7) * 8;
        const u16* vg = VT + ((size_t)((s * 4 + h) * 128 + (tid >> 2))) * T + (tid & 3) * 16;
        const unsigned kl = (tid >> 3) * KROW + (tid & 7) * 16, vl = KBUF + (tid >> 2) * VROW + (tid & 3) * 32;
        u32x4 rk0, rv0, rv1, rkB, rvB0, rvB1;
        rk0 = *(const u32x4*)(kg); rv0 = *(const u32x4*)(vg); rv1 = *(const u32x4*)(vg + 8);
        rkB = *(const u32x4*)(kg + (size_t)64 * 1024); rvB0 = *(const u32x4*)(vg + 64); rvB1 = *(const u32x4*)(vg + 64 + 8);
        __syncthreads();
        *(LAS u32x4*)(lds + kl) = rk0; *(LAS u32x4*)(lds + vl) = rv0; *(LAS u32x4*)(lds + vl + 16) = rv1;
        *(LAS u32x4*)(lds + ABUF + kl) = rkB; *(LAS u32x4*)(lds + ABUF + vl) = rvB0; *(LAS u32x4*)(lds + ABUF + vl + 16) = rvB1;
        __syncthreads();
        auto compute_tile = [&](const int kt, LAS unsigned char* buf) {
          const int kmin = kt * 64;
          const int dlo = kmin + 63 - q0, dhi = kmin - (q0 + 31);
          const int bmode = dlo <= -91 ? 0 : (dhi >= 91 ? 1 : 2);
          const float bconst = bmode == 0 ? tab[0] : tab[256];
          f32x16 S[2];
          {
            bf16x8 kf[2][4];
#pragma unroll
            for (int kb = 0; kb < 2; ++kb)
#pragma unroll
              for (int ks = 0; ks < 4; ++ks) kf[kb][ks] = *(const LAS bf16x8*)(buf + (kb * 32 + m_sw) * KROW + (ks * 16 + g * 8) * 2);
            __builtin_amdgcn_sched_barrier(0);
            __builtin_amdgcn_s_setprio(1);
#pragma unroll
            for (int kb = 0; kb < 2; ++kb) {
#pragma unroll
              for (int i = 0; i < 16; ++i) S[kb][i] = 0.f;
#pragma unroll
              for (int ks = 0; ks < 4; ++ks) S[kb] = __builtin_amdgcn_mfma_f32_32x32x16_bf16(kf[kb][ks], Q[ks], S[kb], 0, 0, 0);
            }
            __builtin_amdgcn_s_setprio(0);
          }
          bf16x8 vf[2][4];
          float sc = c1, off = bconst;
          if (bmode == 2) {
#pragma unroll
            for (int kb = 0; kb < 2; ++kb)
#pragma unroll
              for (int r = 0; r < 16; ++r) {
                int rel = kmin + kb * 32 + 16 * (r >> 3) + 8 * g + (r & 7) - (q0 + qi);
                rel = rel < -128 ? -128 : (rel > 128 ? 128 : rel);
                S[kb][r] = S[kb][r] * c1 + tab[rel + 128];
              }
            sc = 1.f; off = 0.f;
          }
          float mx = -3e38f;
#pragma unroll
          for (int kb = 0; kb < 2; ++kb)
#pragma unroll
            for (int r = 0; r < 16; ++r) mx = fmaxf(mx, S[kb][r]);
          mx = fmaxf(mx, __shfl_xor(mx, 32));
          mx = mx * sc + off;
          if (__any(mx > mrun + 8.f)) {
            const float mnew = mx > mrun + 8.f ? mx : mrun;
            const float alpha = __builtin_amdgcn_exp2f(mrun - mnew);
            mrun = mnew; lrun *= alpha;
#pragma unroll
            for (int eb = 0; eb < 4; ++eb)
#pragma unroll
              for (int i = 0; i < 16; ++i) O[eb][i] *= alpha;
          }
          const float sh = off - mrun;
          float ps0 = 0.f, ps1 = 0.f, ps2 = 0.f, ps3 = 0.f;
#pragma unroll
          for (int kb = 0; kb < 2; ++kb)
#pragma unroll
            for (int r = 0; r < 16; r += 4) {
              const float p0 = __builtin_amdgcn_exp2f(S[kb][r] * sc + sh), p1 = __builtin_amdgcn_exp2f(S[kb][r + 1] * sc + sh), p2 = __builtin_amdgcn_exp2f(S[kb][r + 2] * sc + sh), p3 = __builtin_amdgcn_exp2f(S[kb][r + 3] * sc + sh);
              S[kb][r] = p0; S[kb][r + 1] = p1; S[kb][r + 2] = p2; S[kb][r + 3] = p3; ps0 += p0; ps1 += p1; ps2 += p2; ps3 += p3;
            }
          lrun += (ps0 + ps1) + (ps2 + ps3);
          __builtin_amdgcn_sched_barrier(0);
          __builtin_amdgcn_s_setprio(1);
#pragma unroll
          for (int eb = 0; eb < 4; ++eb) vf[0][eb] = *(const LAS bf16x8*)(buf + KBUF + (eb * 32 + qi) * VROW + (g * 8) * 2);
#pragma unroll
          for (int stp = 0; stp < 4; ++stp) {
            const int kb = stp >> 1, hh = stp & 1;
            if (stp < 3) {
#pragma unroll
              for (int eb = 0; eb < 4; ++eb) vf[(stp + 1) & 1][eb] = *(const LAS bf16x8*)(buf + KBUF + (eb * 32 + qi) * VROW + ((stp + 1) * 16 + g * 8) * 2);
            }
            const bf16x8 pb = pack8(S[kb], hh);
#pragma unroll
            for (int eb = 0; eb < 4; ++eb) O[eb] = __builtin_amdgcn_mfma_f32_32x32x16_bf16(vf[stp & 1][eb], pb, O[eb], 0, 0, 0);
          }
          __builtin_amdgcn_s_setprio(0);
        };
        { const u16* kg2 = kg + (size_t)2 * 64 * 1024; const u16* vg2 = vg + 128;
          rk0 = *(const u32x4*)(kg2); rv0 = *(const u32x4*)(vg2); rv1 = *(const u32x4*)(vg2 + 8);
          const u16* kg3 = kg + (size_t)3 * 64 * 1024; const u16* vg3 = vg + 192;
          rkB = *(const u32x4*)(kg3); rvB0 = *(const u32x4*)(vg3); rvB1 = *(const u32x4*)(vg3 + 8); }
#pragma unroll 1
        for (int kt = 0; kt < 128; kt += 2) {
          LAS unsigned char* buf = lds + ((kt >> 1) & 1) * 2 * ABUF;
          LAS unsigned char* nbuf = lds + (((kt >> 1) + 1) & 1) * 2 * ABUF;
          compute_tile(kt, buf);
          compute_tile(kt + 1, buf + ABUF);
          *(LAS u32x4*)(nbuf + kl) = rk0; *(LAS u32x4*)(nbuf + vl) = rv0; *(LAS u32x4*)(nbuf + vl + 16) = rv1;
          *(LAS u32x4*)(nbuf + ABUF + kl) = rkB; *(LAS u32x4*)(nbuf + ABUF + vl) = rvB0; *(LAS u32x4*)(nbuf + ABUF + vl + 16) = rvB1;
          { const int tn = kt + 4 < 128 ? kt + 4 : 127; const u16* kg2 = kg + (size_t)tn * 64 * 1024; const u16* vg2 = vg + tn * 64;
            rk0 = *(const u32x4*)(kg2); rv0 = *(const u32x4*)(vg2); rv1 = *(const u32x4*)(vg2 + 8); }
          { const int tn = kt + 5 < 128 ? kt + 5 : 127; const u16* kg2 = kg + (size_t)tn * 64 * 1024; const u16* vg2 = vg + tn * 64;
            rkB = *(const u32x4*)(kg2); rvB0 = *(const u32x4*)(vg2); rvB1 = *(const u32x4*)(vg2 + 8); }
          __syncthreads();
        }
        const float lt = lrun + __shfl_xor(lrun, 32);
        asm volatile("" : "+v"(osv));
        if (c == 0) {
          const float i0 = 1.f / lt;
#pragma unroll
          for (int eb = 0; eb < 4; ++eb)
#pragma unroll
            for (int i = 0; i < 16; i += 4) { f32x4 t4; t4[0] = O[eb][i] * i0; t4[1] = O[eb][i + 1] * i0; t4[2] = O[eb][i + 2] * i0; t4[3] = O[eb][i + 3] * i0; *(f32x4*)(osv + eb * 16 + i) = t4; }
        } else {
          const float i1 = scal[0] / lt;
          float ss = 0.f;
#pragma unroll
          for (int eb = 0; eb < 4; ++eb)
#pragma unroll
            for (int i = 0; i < 16; i += 4) { const f32x4 t4 = *(const f32x4*)(osv + eb * 16 + i);
#pragma unroll
              for (int j = 0; j < 4; ++j) { const float o = t4[j] - O[eb][i + j] * i1; O[eb][i + j] = o; ss += o * o; } }
          ss += __shfl_xor(ss, 32);
          const float rs = rsqrtf(ss * (1.f / 128.f) + LN_EPS) * (1.f - lam_init);
          u16* op = PB + (tokbase + q0 + qi) * 1024 + h * 128;
#pragma unroll
          for (int eb = 0; eb < 4; ++eb)
#pragma unroll
            for (int rr = 0; rr < 4; ++rr) {
              const int e = eb * 32 + 8 * rr + 4 * g;
              const f32x4 gg = *(const f32x4*)(subg + e);
              u32x2 pk; pk.x = cvt_pk_bf16(O[eb][4 * rr] * rs * gg[0], O[eb][4 * rr + 1] * rs * gg[1]); pk.y = cvt_pk_bf16(O[eb][4 * rr + 2] * rs * gg[2], O[eb][4 * rr + 3] * rs * gg[3]);
              *(u32x2*)(op + e) = pk;
            }
        }
      }
    }
  }
}

DI float softplusf_(float x) { return fmaxf(x, 0.f) + __logf(1.f + __expf(-fabsf(x))); }
DI void load_bf16x8(const u16* p, float (&o)[8]) {
  const u32x4 v = *(const u32x4*)p;
#pragma unroll
  for (int i = 0; i < 4; ++i) { o[2 * i] = __uint_as_float(v[i] << 16); o[2 * i + 1] = __uint_as_float(v[i] & 0xffff0000u); }
}
DI void shifted8(const u16* PA, size_t row, int t, int col, const float* mu0, const float* mu1, float (&o)[8]) {
  float c[8], pv[8], nx[8];
  load_bf16x8(PA + row * A_COLS + col, c);
  if (t > 0) load_bf16x8(PA + (row - 1) * A_COLS + col, pv); else { for (int i = 0; i < 8; ++i) pv[i] = 0.f; }
  if (t < T - 1) load_bf16x8(PA + (row + 1) * A_COLS + col, nx); else { for (int i = 0; i < 8; ++i) nx[i] = 0.f; }
#pragma unroll
  for (int i = 0; i < 8; ++i) o[i] = c[i] + mu0[col + i] * (pv[i] - c[i]) + mu1[col + i] * (nx[i] - c[i]);
}

DI void vprep_phase(LAS unsigned char* lds, const u16* PA, u16* VV, const float* mu, const float* vdown, const float* vup, const float* v0, int layer) {
  int tid = threadIdx.x; asm volatile("" : "+v"(tid));
  int bid = blockIdx.x, gdim = gridDim.x; asm volatile("" : "+s"(bid), "+s"(gdim));
  const int tok = tid >> 4, j = tid & 15;
  LAS unsigned* VS2 = (LAS unsigned*)lds;
  LAS unsigned* DD2 = VS2 + 32 * 256;
  LAS unsigned* DN2 = DD2 + 32 * 16;
  LAS unsigned* UP2 = DN2 + 256 * 32;
  const float* mu0 = mu; const float* mu1 = mu + A_COLS;
  __syncthreads();
  if (layer != 0) {
    for (int e = tid; e < 256 * 32; e += NTHREADS) { const int c2 = e >> 5, r = e & 31; DN2[e] = cvt_pk_bf16(vdown[(2 * c2) * 32 + r], vdown[(2 * c2 + 1) * 32 + r]); }
    for (int e = tid; e < 16 * 512; e += NTHREADS) { const int r2 = e >> 9, c = e & 511; UP2[(r2 * 2 + ((c >> 2) & 1)) * 256 + (c >> 3) * 4 + (c & 3)] = cvt_pk_bf16(vup[(2 * r2) * 512 + c], vup[(2 * r2 + 1) * 512 + c]); }
  }
  for (int it = bid; it < NT / 32; it += gdim) {
    const size_t row = (size_t)it * 32 + tok; const int t = (int)(row % T);
    __syncthreads();
#pragma unroll 1
    for (int q = 0; q < 4; ++q) {
      const int cc = q * 128 + j * 8;
      float o[8]; shifted8(PA, row, t, OFF_V + cc, mu0, mu1, o);
      u32x4 pk; pk.x = cvt_pk_bf16(o[0], o[1]); pk.y = cvt_pk_bf16(o[2], o[3]); pk.z = cvt_pk_bf16(o[4], o[5]); pk.w = cvt_pk_bf16(o[6], o[7]);
      if (layer == 0) *(u32x4*)(VV + row * 512 + cc) = pk;
      else *(LAS u32x4*)(VS2 + tok * 256 + (cc >> 1)) = pk;
    }
    if (layer == 0) continue;
    __syncthreads();
    {
      float d0 = 0.f, d1 = 0.f;
#pragma unroll 8
      for (int c2 = 0; c2 < 256; ++c2) {
        const bf2 x = __builtin_bit_cast(bf2, VS2[tok * 256 + c2]);
        const u32x2 w2 = *(const LAS u32x2*)(DN2 + c2 * 32 + 2 * j);
        unsigned ua = w2.x, ub = w2.y; asm volatile("" : "+v"(ua), "+v"(ub));
        d0 = __builtin_amdgcn_fdot2_f32_bf16(x, __builtin_bit_cast(bf2, ua), d0, false); d1 = __builtin_amdgcn_fdot2_f32_bf16(x, __builtin_bit_cast(bf2, ub), d1, false);
      }
      DD2[tok * 16 + j] = cvt_pk_bf16(d0, d1);
    }
    __syncthreads();
#pragma unroll 1
    for (int q = 0; q < 4; ++q) {
      const int c0 = q * 128 + j * 8;
      float acc[8];
      { const f32x4 a0 = *(const f32x4*)(v0 + c0), a1 = *(const f32x4*)(v0 + c0 + 4);
#pragma unroll
        for (int i = 0; i < 4; ++i) { acc[i] = a0[i]; acc[4 + i] = a1[i]; } }
#pragma unroll 4
      for (int r2 = 0; r2 < 16; ++r2) {
        const bf2 dv = __builtin_bit_cast(bf2, DD2[tok * 16 + r2]);
        const u32x4 wa = *(const LAS u32x4*)(UP2 + (r2 * 2 + 0) * 256 + (c0 >> 3) * 4), wb = *(const LAS u32x4*)(UP2 + (r2 * 2 + 1) * 256 + (c0 >> 3) * 4);
#pragma unroll
        for (int i = 0; i < 4; ++i) { unsigned ua = wa[i], ub = wb[i]; asm volatile("" : "+v"(ua), "+v"(ub));
          acc[i] = __builtin_amdgcn_fdot2_f32_bf16(dv, __builtin_bit_cast(bf2, ua), acc[i], false); acc[4 + i] = __builtin_amdgcn_fdot2_f32_bf16(dv, __builtin_bit_cast(bf2, ub), acc[4 + i], false); }
      }
      float vf[8]; load_bf16x8(VV + row * 512 + c0, vf);
      const u32x4 xs = *(const LAS u32x4*)(VS2 + tok * 256 + (c0 >> 1));
      float x[8];
#pragma unroll
      for (int i = 0; i < 4; ++i) { unsigned u = xs[i]; asm volatile("" : "+v"(u)); x[2 * i] = __uint_as_float(u << 16); x[2 * i + 1] = __uint_as_float(u & 0xffff0000u); }
      float o[8];
#pragma unroll
      for (int i = 0; i < 8; ++i) o[i] = x[i] + (vf[i] - x[i]) * sigmoidf_(acc[i]);
      u32x4 pk; pk.x = cvt_pk_bf16(o[0], o[1]); pk.y = cvt_pk_bf16(o[2], o[3]); pk.z = cvt_pk_bf16(o[4], o[5]); pk.w = cvt_pk_bf16(o[6], o[7]);
      *(u32x4*)(VV + row * 512 + c0) = pk;
    }
  }
}

struct ScanW { const float *mu, *w0, *du, *a0, *iu, *kk_, *ka, *rk; };
constexpr int SC = 32;
DI float quad_sum(float x) {
  x += __builtin_bit_cast(float, __builtin_amdgcn_update_dpp(0, __builtin_bit_cast(int, x), 0xB1, 0xf, 0xf, true));
  x += __builtin_bit_cast(float, __builtin_amdgcn_update_dpp(0, __builtin_bit_cast(int, x), 0x4E, 0xf, 0xf, true));
  return x;
}
#define BFLO(x) __uint_as_float((x) << 16)
#define BFHI(x) __uint_as_float((x) & 0xffff0000u)
DI float tanh_fast(float x) { x = fminf(fmaxf(x, -15.f), 15.f); const float t = __expf(2.f * x); return (t - 1.f) / (t + 1.f); }
DI float shift1(float c, float p, float n, float m0, float m1) { return c + m0 * (p - c) + m1 * (n - c); }
DI void scan_produce(LAS float* buf, LAS unsigned* TW, LAS unsigned* TA, LAS const unsigned* DU, LAS const unsigned* IU, const u16* PA, const u16* VV, float* BON,
                     const ScanW& w, int ptid, int sq, int h, int dir, int t0) {
  const int tok = ptid >> 3, j = ptid & 7;
  const int t = t0 + tok; const size_t row = (size_t)sq * T + t;
  const float* mu0 = w.mu; const float* mu1 = w.mu + A_COLS;
  const int cr = h * 64 + j * 8, ck = OFF_K + cr, cw_ = OFF_WD + dir * 32 + j * 4, ca_ = OFF_AD + dir * 32 + j * 4;
  const u16* pc = PA + row * A_COLS;
  const bool hp = t > 0, hn = t < T - 1;
  {
    const u32x2 w_c = *(const u32x2*)(pc + cw_), a_c = *(const u32x2*)(pc + ca_);
    u32x2 w_p = (u32x2){0u, 0u}, a_p = w_p, w_n = w_p, a_n = w_p;
    if (hp) { w_p = *(const u32x2*)(pc - A_COLS + cw_); a_p = *(const u32x2*)(pc - A_COLS + ca_); }
    if (hn) { w_n = *(const u32x2*)(pc + A_COLS + cw_); a_n = *(const u32x2*)(pc + A_COLS + ca_); }
    const f32x4 mw0 = *(const f32x4*)(mu0 + cw_), mw1 = *(const f32x4*)(mu1 + cw_), ma0 = *(const f32x4*)(mu0 + ca_), ma1 = *(const f32x4*)(mu1 + ca_);
    f32x4 tw, ta;
#pragma unroll
    for (int i = 0; i < 2; ++i) {
      tw[2 * i] = tanh_fast(shift1(BFLO(w_c[i]), BFLO(w_p[i]), BFLO(w_n[i]), mw0[2 * i], mw1[2 * i]));
      tw[2 * i + 1] = tanh_fast(shift1(BFHI(w_c[i]), BFHI(w_p[i]), BFHI(w_n[i]), mw0[2 * i + 1], mw1[2 * i + 1]));
      ta[2 * i] = shift1(BFLO(a_c[i]), BFLO(a_p[i]), BFLO(a_n[i]), ma0[2 * i], ma1[2 * i]);
      ta[2 * i + 1] = shift1(BFHI(a_c[i]), BFHI(a_p[i]), BFHI(a_n[i]), ma0[2 * i + 1], ma1[2 * i + 1]);
    }
    u32x2 tw2, ta2; tw2.x = cvt_pk_bf16(tw[0], tw[1]); tw2.y = cvt_pk_bf16(tw[2], tw[3]); ta2.x = cvt_pk_bf16(ta[0], ta[1]); ta2.y = cvt_pk_bf16(ta[2], ta[3]);
    *(LAS u32x2*)(TW + tok * 16 + j * 2) = tw2; *(LAS u32x2*)(TA + tok * 16 + j * 2) = ta2;
  }
  asm volatile("s_waitcnt lgkmcnt(0)" ::: "memory");
  float wl[8], al[8];
  const int cc = j * 8, cg_ = h * 64 + cc;
  { const f32x4 x0 = *(const f32x4*)(w.w0 + dir * 512 + cg_), x1 = *(const f32x4*)(w.w0 + dir * 512 + cg_ + 4), y0 = *(const f32x4*)(w.a0 + dir * 512 + cg_), y1 = *(const f32x4*)(w.a0 + dir * 512 + cg_ + 4);
#pragma unroll
    for (int q = 0; q < 4; ++q) { wl[q] = x0[q]; wl[4 + q] = x1[q]; al[q] = y0[q]; al[4 + q] = y1[q]; } }
#pragma unroll 2
  for (int pr = 0; pr < 16; ++pr) {
    const bf2 twp = __builtin_bit_cast(bf2, TW[tok * 16 + pr]), tap = __builtin_bit_cast(bf2, TA[tok * 16 + pr]);
    const u32x4 d0 = *(const LAS u32x4*)(DU + pr * 64 + cc), d1 = *(const LAS u32x4*)(DU + pr * 64 + cc + 4), i0 = *(const LAS u32x4*)(IU + pr * 64 + cc), i1 = *(const LAS u32x4*)(IU + pr * 64 + cc + 4);
#pragma unroll
    for (int q = 0; q < 4; ++q) {
      unsigned ua = d0[q], ub = d1[q], uc = i0[q], ud = i1[q]; asm volatile("" : "+v"(ua), "+v"(ub), "+v"(uc), "+v"(ud));
      wl[q] = __builtin_amdgcn_fdot2_f32_bf16(twp, __builtin_bit_cast(bf2, ua), wl[q], false); wl[4 + q] = __builtin_amdgcn_fdot2_f32_bf16(twp, __builtin_bit_cast(bf2, ub), wl[4 + q], false);
      al[q] = __builtin_amdgcn_fdot2_f32_bf16(tap, __builtin_bit_cast(bf2, uc), al[q], false); al[4 + q] = __builtin_amdgcn_fdot2_f32_bf16(tap, __builtin_bit_cast(bf2, ud), al[4 + q], false);
    }
  }
#pragma unroll
  for (int q = 0; q < 8; ++q) { asm volatile("" : "+v"(wl[q]), "+v"(al[q])); }
  LAS float* AW = buf; LAS float* AK = buf + 2048; LAS float* AB = buf + 4096; LAS float* AD = buf + 6144; LAS float* AR = buf + 8192; LAS float* AV = buf + 10240;
  const int o = tok * 64 + cc;
  float ss = 0.f, bs = 0.f;
  float ok[8], av[8];
#pragma unroll
  for (int hq = 0; hq < 2; ++hq) {
    const int c4 = 4 * hq;
    const u32x2 r_c = *(const u32x2*)(pc + cr + c4), k_c = *(const u32x2*)(pc + ck + c4);
    u32x2 r_p = (u32x2){0u, 0u}, k_p = r_p, r_n = r_p, k_n = r_p;
    if (hp) { r_p = *(const u32x2*)(pc - A_COLS + cr + c4); k_p = *(const u32x2*)(pc - A_COLS + ck + c4); }
    if (hn) { r_n = *(const u32x2*)(pc + A_COLS + cr + c4); k_n = *(const u32x2*)(pc + A_COLS + ck + c4); }
    const u32x2 v_c = *(const u32x2*)(VV + row * 512 + cr + c4);
    const f32x4 mr0 = *(const f32x4*)(mu0 + cr + c4), mr1 = *(const f32x4*)(mu1 + cr + c4), mk0 = *(const f32x4*)(mu0 + ck + c4), mk1 = *(const f32x4*)(mu1 + ck + c4);
    const f32x4 kk4 = *(const f32x4*)(w.kk_ + cg_ + c4), ka4 = *(const f32x4*)(w.ka + cg_ + c4), rk4 = *(const f32x4*)(w.rk + cg_ + c4);
    f32x4 rv, kv, vv, ow, od;
#pragma unroll
    for (int i = 0; i < 2; ++i) {
      rv[2 * i] = shift1(BFLO(r_c[i]), BFLO(r_p[i]), BFLO(r_n[i]), mr0[2 * i], mr1[2 * i]);
      rv[2 * i + 1] = shift1(BFHI(r_c[i]), BFHI(r_p[i]), BFHI(r_n[i]), mr0[2 * i + 1], mr1[2 * i + 1]);
      kv[2 * i] = shift1(BFLO(k_c[i]), BFLO(k_p[i]), BFLO(k_n[i]), mk0[2 * i], mk1[2 * i]);
      kv[2 * i + 1] = shift1(BFHI(k_c[i]), BFHI(k_p[i]), BFHI(k_n[i]), mk0[2 * i + 1], mk1[2 * i + 1]);
      vv[2 * i] = BFLO(v_c[i]); vv[2 * i + 1] = BFHI(v_c[i]);
    }
#pragma unroll
    for (int q = 0; q < 4; ++q) {
      const float wlog = -softplusf_(-wl[c4 + q]) - 0.5f;
      ow[q] = __expf(-__expf(wlog));
      const float a = sigmoidf_(al[c4 + q]);
      av[c4 + q] = a;
      ok[c4 + q] = kv[q] * kk4[q]; ss += ok[c4 + q] * ok[c4 + q];
      od[q] = kv[q] * (1.f + (a - 1.f) * ka4[q]);
      bs += rv[q] * od[q] * rk4[q];
    }
    *(LAS f32x4*)(AW + o + c4) = ow; *(LAS f32x4*)(AD + o + c4) = od; *(LAS f32x4*)(AR + o + c4) = rv; *(LAS f32x4*)(AV + o + c4) = vv;
  }
#pragma unroll
  for (int sft = 1; sft < 8; sft <<= 1) { ss += __shfl_xor(ss, sft); bs += __shfl_xor(bs, sft); }
  const float rn = rsqrtf(ss + 1e-12f);
#pragma unroll
  for (int hq = 0; hq < 2; ++hq) {
    f32x4 k4, b4;
#pragma unroll
    for (int q = 0; q < 4; ++q) { k4[q] = ok[4 * hq + q] * rn; b4[q] = k4[q] * av[4 * hq + q]; }
    *(LAS f32x4*)(AK + o + 4 * hq) = k4; *(LAS f32x4*)(AB + o + 4 * hq) = b4;
  }
  if (j == 0) BON[((size_t)dir * NT + row) * 8 + h] = bs;
}
struct ScanOps { f32x4 k4[4], w4[4], b4[4], d4[4]; float vi; };
DI void scan_load(ScanOps& o, LAS const float* buf, int tt, int jseg, int irow) {
  const int off = tt * 64 + jseg * 16;
#pragma unroll
  for (int q = 0; q < 4; ++q) {
    o.w4[q] = *(const LAS f32x4*)(buf + off + q * 4); o.k4[q] = *(const LAS f32x4*)(buf + 2048 + off + q * 4); o.b4[q] = *(const LAS f32x4*)(buf + 4096 + off + q * 4);
    o.d4[q] = *(const LAS f32x4*)(buf + 6144 + off + q * 4);
  }
  o.vi = buf[10240 + tt * 64 + irow];
}
DI float scan_step(f32x4 (&S)[4], const ScanOps& o, LAS const float* buf, int tt, int jseg) {
  f32x4 r4[4];
#pragma unroll
  for (int q = 0; q < 4; ++q) r4[q] = *(const LAS f32x4*)(buf + 8192 + tt * 64 + jseg * 16 + q * 4);
  f32x4 a4 = S[0] * o.k4[0] + S[1] * o.k4[1] + S[2] * o.k4[2] + S[3] * o.k4[3];
  float sa = -quad_sum((a4[0] + a4[1]) + (a4[2] + a4[3]));
  f32x4 y4 = (f32x4){0.f, 0.f, 0.f, 0.f};
#pragma unroll
  for (int q = 0; q < 4; ++q) { S[q] = S[q] * o.w4[q] + (o.b4[q] * sa + o.d4[q] * o.vi); y4 += S[q] * r4[q]; }
  return quad_sum((y4[0] + y4[1]) + (y4[2] + y4[3]));
}
DI void scan_phase(LAS unsigned char* lds, const u16* PA, const u16* VV, u16* YY, float* BON, const ScanW w) {
  int tid = threadIdx.x; asm volatile("" : "+v"(tid));
  int bid = blockIdx.x, gdim = gridDim.x; asm volatile("" : "+s"(bid), "+s"(gdim));
  LAS float* BUF = (LAS float*)lds;
  LAS float* AY = BUF + 2 * 12288;
  LAS unsigned* TW = (LAS unsigned*)(AY + 2 * 2048);
  LAS unsigned* TA = TW + SC * 16;
  LAS unsigned* DU = TA + SC * 16;
  LAS unsigned* IU = DU + 1024;
  const int wid = __builtin_amdgcn_readfirstlane(tid >> 6), lane = tid & 63;
  const int NCH = T / SC;
  for (int item = bid; item < 192; item += gdim) {
    const int dir = item & 1, h = (item >> 1) & 7, sq = item >> 4;
    __syncthreads();
    for (int i = tid; i < 1024; i += NTHREADS) { const int pr = i >> 6, c = i & 63; const size_t o0 = (size_t)(dir * 32 + 2 * pr) * 512 + h * 64 + c;
      DU[i] = cvt_pk_bf16(w.du[o0], w.du[o0 + 512]); IU[i] = cvt_pk_bf16(w.iu[o0], w.iu[o0 + 512]); }
    __syncthreads();
    f32x4 S[4];
#pragma unroll
    for (int q = 0; q < 4; ++q) S[q] = (f32x4){0.f, 0.f, 0.f, 0.f};
    const int irow = (wid & 3) * 16 + (lane >> 2), jseg = lane & 3;
    if (wid >= 4) scan_produce(BUF, TW, TA, DU, IU, PA, VV, BON, w, tid - 256, sq, h, dir, dir == 0 ? 0 : T - SC);
    __syncthreads();
#pragma unroll 1
    for (int ci = 0; ci < NCH; ++ci) {
      LAS float* buf = BUF + (ci & 1) * 12288;
      LAS float* ay = AY + (ci & 1) * 2048;
      if (wid < 4) {
        ScanOps o0, o1;
        scan_load(o0, buf, dir == 0 ? 0 : SC - 1, jseg, irow);
#pragma unroll 1
        for (int st = 0; st < SC; st += 2) {
          const int t0_ = dir == 0 ? st : SC - 1 - st, t1_ = dir == 0 ? st + 1 : SC - 2 - st;
          scan_load(o1, buf, t1_, jseg, irow);
          const float y0 = scan_step(S, o0, buf, t0_, jseg);
          if (jseg == 0) ay[t0_ * 64 + irow] = y0;
          if (st + 2 < SC) scan_load(o0, buf, dir == 0 ? st + 2 : SC - 3 - st, jseg, irow);
          const float y1 = scan_step(S, o1, buf, t1_, jseg);
          if (jseg == 0) ay[t1_ * 64 + irow] = y1;
        }
      } else {
        const int ptid = tid - 256;
        if (ci + 1 < NCH) scan_produce(BUF + ((ci + 1) & 1) * 12288, TW, TA, DU, IU, PA, VV, BON, w, ptid, sq, h, dir, dir == 0 ? (ci + 1) * SC : T - SC * (ci + 2));
        if (ci > 0) {
          LAS const float* py = AY + ((ci - 1) & 1) * 2048;
          const int t0p = dir == 0 ? (ci - 1) * SC : T - SC * ci;
          const int tok = ptid >> 3, c0 = (ptid & 7) * 8;
          const f32x4 ya = *(const LAS f32x4*)(py + tok * 64 + c0), yb = *(const LAS f32x4*)(py + tok * 64 + c0 + 4);
          u32x4 pk; pk.x = cvt_pk_bf16(ya[0], ya[1]); pk.y = cvt_pk_bf16(ya[2], ya[3]); pk.z = cvt_pk_bf16(yb[0], yb[1]); pk.w = cvt_pk_bf16(yb[2], yb[3]);
          *(u32x4*)(YY + ((size_t)dir * NT + (size_t)sq * T + t0p + tok) * 512 + h * 64 + c0) = pk;
        }
      }
      __syncthreads();
    }
    if (wid >= 4) {
      const int ptid = tid - 256;
      LAS const float* py = AY + ((NCH - 1) & 1) * 2048;
      const int t0p = dir == 0 ? (NCH - 1) * SC : 0;
      const int tok = ptid >> 3, c0 = (ptid & 7) * 8;
      const f32x4 ya = *(const LAS f32x4*)(py + tok * 64 + c0), yb = *(const LAS f32x4*)(py + tok * 64 + c0 + 4);
      u32x4 pk; pk.x = cvt_pk_bf16(ya[0], ya[1]); pk.y = cvt_pk_bf16(ya[2], ya[3]); pk.z = cvt_pk_bf16(yb[0], yb[1]); pk.w = cvt_pk_bf16(yb[2], yb[3]);
      *(u32x4*)(YY + ((size_t)dir * NT + (size_t)sq * T + t0p + tok) * 512 + h * 64 + c0) = pk;
    }
  }
}

DI void post_phase(LAS unsigned char* lds, u16* PA, const u16* PB, const u16* VV, const u16* YY, const float* BON, const float* mu, const float* gup, const float* gng, const float* gnb) {
  int tid = threadIdx.x; asm volatile("" : "+v"(tid));
  int bid = blockIdx.x, gdim = gridDim.x; asm volatile("" : "+s"(bid), "+s"(gdim));
  const int tok = tid >> 4, j = tid & 15;
  LAS unsigned* SG2 = (LAS unsigned*)lds;
  LAS unsigned* GU = (LAS unsigned*)(lds + 16384);
  const float* mu0 = mu; const float* mu1 = mu + A_COLS;
  __syncthreads();
  for (int e = tid; e < 48 * 512; e += NTHREADS) { const int r2 = e >> 9, c = e & 511; GU[(r2 * 2 + ((c >> 2) & 1)) * 256 + (c >> 3) * 4 + (c & 3)] = cvt_pk_bf16(gup[(2 * r2) * 512 + c], gup[(2 * r2 + 1) * 512 + c]); }
  for (int it = bid; it < NT / 32; it += gdim) {
    const size_t row = (size_t)it * 32 + tok; const int t = (int)(row % T);
    __syncthreads();
    { float sv[6];
#pragma unroll
      for (int q = 0; q < 6; ++q) {
        const int col = OFF_GD + j * 6 + q;
        const float c = bf2f(PA[row * A_COLS + col]);
        const float pv = t > 0 ? bf2f(PA[(row - 1) * A_COLS + col]) : 0.f, nx = t < T - 1 ? bf2f(PA[(row + 1) * A_COLS + col]) : 0.f;
        sv[q] = sigmoidf_(c + mu0[col] * (pv - c) + mu1[col] * (nx - c));
      }
#pragma unroll
      for (int pq = 0; pq < 3; ++pq) SG2[tok * 48 + j * 3 + pq] = cvt_pk_bf16(sv[2 * pq], sv[2 * pq + 1]); }
    __syncthreads();
#pragma unroll 1
    for (int q = 0; q < 4; ++q) {
      const int cc = q * 128 + j * 8, h = 2 * q + (j >> 3);
      float y[8]; float sm = 0.f;
      { float a[8], b[8]; load_bf16x8(YY + row * 512 + cc, a); load_bf16x8(YY + ((size_t)NT + row) * 512 + cc, b);
#pragma unroll
        for (int i = 0; i < 8; ++i) { y[i] = a[i] + b[i]; sm += y[i]; } }
      sm += __shfl_xor(sm, 1); sm += __shfl_xor(sm, 2); sm += __shfl_xor(sm, 4);
      const float mean = sm * (1.f / 64.f);
      float vq = 0.f;
#pragma unroll
      for (int i = 0; i < 8; ++i) { y[i] -= mean; vq += y[i] * y[i]; }
      vq += __shfl_xor(vq, 1); vq += __shfl_xor(vq, 2); vq += __shfl_xor(vq, 4);
      const float rs = rsqrtf(vq * (1.f / 64.f) + GN_EPS);
      const float bon = BON[row * 8 + h] + BON[((size_t)NT + row) * 8 + h];
      float gacc[8];
#pragma unroll
      for (int i = 0; i < 8; ++i) gacc[i] = 0.f;
#pragma unroll 8
      for (int r2 = 0; r2 < 48; ++r2) {
        const bf2 sv = __builtin_bit_cast(bf2, SG2[tok * 48 + r2]);
        const u32x4 wa = *(const LAS u32x4*)(GU + (r2 * 2 + 0) * 256 + (cc >> 3) * 4), wb = *(const LAS u32x4*)(GU + (r2 * 2 + 1) * 256 + (cc >> 3) * 4);
#pragma unroll
        for (int i = 0; i < 4; ++i) { unsigned ua = wa[i], ub = wb[i]; asm volatile("" : "+v"(ua), "+v"(ub));
          gacc[i] = __builtin_amdgcn_fdot2_f32_bf16(sv, __builtin_bit_cast(bf2, ua), gacc[i], false); gacc[4 + i] = __builtin_amdgcn_fdot2_f32_bf16(sv, __builtin_bit_cast(bf2, ub), gacc[4 + i], false); }
      }
      float vv[8]; load_bf16x8(VV + row * 512 + cc, vv);
      const f32x4 g0 = *(const f32x4*)(gng + cc), g1 = *(const f32x4*)(gng + cc + 4), b0 = *(const f32x4*)(gnb + cc), b1 = *(const f32x4*)(gnb + cc + 4);
      float o[8];
#pragma unroll
      for (int i = 0; i < 4; ++i) { o[i] = (y[i] * rs * g0[i] + b0[i] + bon * vv[i]) * gacc[i]; o[4 + i] = (y[4 + i] * rs * g1[i] + b1[i] + bon * vv[4 + i]) * gacc[4 + i]; }
      u32x4 pk; pk.x = cvt_pk_bf16(o[0], o[1]); pk.y = cvt_pk_bf16(o[2], o[3]); pk.z = cvt_pk_bf16(o[4], o[5]); pk.w = cvt_pk_bf16(o[6], o[7]);
      if (DBGZ & 1) pk = (u32x4){0u, 0u, 0u, 0u};
      *(u32x4*)(PA + row * A_COLS + cc) = pk;
      u32x4 pb4 = *(const u32x4*)(PB + row * 1024 + cc); if (DBGZ & 2) pb4 = (u32x4){0u, 0u, 0u, 0u};
      *(u32x4*)(PA + row * A_COLS + 512 + cc) = pb4;
    }
  }
}

DI unsigned hashu(unsigned x) { x ^= x >> 16; x *= 0x7feb352du; x ^= x >> 15; x *= 0x846ca68bu; x ^= x >> 16; return x; }
DI void dbg_upd(float* slot, float got, float ref, float scale) { float e = fabsf(got - ref) / scale; if (!(e == e)) e = 1e9f; atomicMax((unsigned*)slot, __float_as_uint(e)); }
DI float tshift(const u16* PA, size_t row, int col, const float* mu) {
  const int t = (int)(row % T);
  const float c = bf2f(PA[row * A_COLS + col]);
  const float pv = t > 0 ? bf2f(PA[(row - 1) * A_COLS + col]) : 0.f, nx = t < T - 1 ? bf2f(PA[(row + 1) * A_COLS + col]) : 0.f;
  return c + mu[col] * (pv - c) + mu[A_COLS + col] * (nx - c);
}
DI void chk_proj(const u16* XB, const float* win, const u16* PA, const u16* PB, const u16* VT, float* slot) {
  const int gt = blockIdx.x * NTHREADS + threadIdx.x;
  if (gt >= 4096) return;
  const int row = hashu(gt * 2 + 1) % NT, col = hashu(gt * 2 + 2) % P_COLS;
  float ref = 0.f;
  for (int k = 0; k < D; ++k) ref += bf2f(XB[(size_t)row * D + k]) * win[(size_t)k * P_COLS + col];
  float got;
  if (col < A_COLS) got = bf2f(PA[(size_t)row * A_COLS + col]);
  else if (col < A_COLS + 1024) got = bf2f(PB[(size_t)row * 1024 + col - A_COLS]);
  else { const int c2 = col - A_COLS - 1024, h = c2 >> 7, e = c2 & 127, sq = row / T, t = row % T; got = bf2f(VT[((size_t)((sq * 4 + h) * 128 + e)) * T + t]); }
  dbg_upd(slot, got, ref, 1.f);
}
DI void chk_ffn(const u16* XB, const float* wup, const float* cw, const float* cb, const u16* G, float* slot) {
  const int gt = blockIdx.x * NTHREADS + threadIdx.x;
  if (gt >= 4096) return;
  int row = hashu(gt * 2 + 11) % NT; const int n = hashu(gt * 2 + 12) % DFF;
  if (gt < 64) row = (gt & 1) ? (row / T) * T + T - 1 : (row / T) * T;
  else if (gt < 1024) row = (row / T) * T + ((row % T) / 254) * 254 + (gt & 1 ? 253 : 0), row = row >= NT ? NT - 1 : row;
  const int t = row % T;
  float hg[3] = {0.f, 0.f, 0.f}, hu[3] = {0.f, 0.f, 0.f};
#pragma unroll
  for (int d = -1; d <= 1; ++d) {
    float a = 0.f, b = 0.f;
    if (!(t + d < 0 || t + d > T - 1))
      for (int k = 0; k < D; ++k) { const float x = bf2f(XB[(size_t)(row + d) * D + k]); a += x * wup[(size_t)k * NUP + n]; b += x * wup[(size_t)k * NUP + DFF + n]; }
    hg[d + 1] = a; hu[d + 1] = b;
  }
  const float got = bf2f(G[(size_t)row * DFF + n]);
  { const float g = cw[n] * hg[0] + cw[NUP + n] * hg[1] + cw[2 * NUP + n] * hg[2] + cb[n];
    const float u = cw[DFF + n] * hu[0] + cw[NUP + DFF + n] * hu[1] + cw[2 * NUP + DFF + n] * hu[2] + cb[DFF + n];
    dbg_upd(slot, got, 0.5f * g * (1.f + erff(g * 0.70710678f)) * u, 1.f); }
  { const float g = cw[n] * hg[2] + cw[NUP + n] * hg[1] + cw[2 * NUP + n] * hg[0] + cb[n];
    const float u = cw[DFF + n] * hu[2] + cw[NUP + DFF + n] * hu[1] + cw[2 * NUP + DFF + n] * hu[0] + cb[DFF + n];
    dbg_upd(slot + 1, got, 0.5f * g * (1.f + erff(g * 0.70710678f)) * u, 1.f); }
  { const float g = cw[NUP + n] * hg[1] + cb[n];
    const float u = cw[NUP + DFF + n] * hu[1] + cb[DFF + n];
    dbg_upd(slot + 2, got, 0.5f * g * (1.f + erff(g * 0.70710678f)) * u, 1.f); }
}
DI void chk_attn(LAS unsigned char* lds, const u16* XB, const float* win, const u16* PB, const u16* VT, const float* lamp, const float* subg, const float* relb, int layer, float* slot) {
  if (blockIdx.x >= 16) return;
  const int tid = threadIdx.x;
  LAS float* qv = (LAS float*)lds;
  LAS float* sc = qv + 128;
  LAS float* red = sc + 16384;
  LAS float* ov = red + 1024;
  const int smp = blockIdx.x;
  const int sq = hashu(smp + 77) % NSEQ, h = smp & 3;
  int q = hashu(smp + 99) % T; if (smp < 4) q = smp * 37; if (smp >= 12) q = T - 1 - (smp - 12) * 50;
  const size_t row = (size_t)sq * T + q;
  __syncthreads();
  if (tid < 128) { float a = 0.f; const int col = A_COLS + h * 128 + tid; for (int k = 0; k < D; ++k) a += bf2f(XB[row * D + k]) * win[(size_t)k * P_COLS + col]; qv[tid] = a; }
  __syncthreads();
  float mx0 = -1e30f, mx1 = -1e30f;
  for (int key = tid; key < T; key += NTHREADS) {
    const u16* kp = PB + ((size_t)sq * T + key) * 1024 + 512 + h * 128;
    float s0 = 0.f, s1 = 0.f;
    for (int d = 0; d < 64; ++d) { s0 += qv[d] * bf2f(kp[d]); s1 += qv[64 + d] * bf2f(kp[64 + d]); }
    const int rel = key - q, n = rel < 0 ? -rel : rel;
    int bk;
    if (n < 8) bk = n; else { bk = 8 + (int)(logf((float)n / 8.f) / logf(16.f) * 8.f); bk = bk > 15 ? 15 : bk; }
    if (rel > 0) bk += 16;
    const float bias = relb[bk * 4 + h];
    s0 = s0 * 0.125f + bias; s1 = s1 * 0.125f + bias;
    sc[key] = s0; sc[8192 + key] = s1; mx0 = fmaxf(mx0, s0); mx1 = fmaxf(mx1, s1);
  }
  red[tid] = mx0; red[512 + tid] = mx1; __syncthreads();
  for (int o = 256; o > 0; o >>= 1) { if (tid < o) { red[tid] = fmaxf(red[tid], red[tid + o]); red[512 + tid] = fmaxf(red[512 + tid], red[512 + tid + o]); } __syncthreads(); }
  mx0 = red[0]; mx1 = red[512]; __syncthreads();
  float l0 = 0.f, l1 = 0.f;
  for (int key = tid; key < T; key += NTHREADS) { const float p0 = expf(sc[key] - mx0), p1 = expf(sc[8192 + key] - mx1); sc[key] = p0; sc[8192 + key] = p1; l0 += p0; l1 += p1; }
  red[tid] = l0; red[512 + tid] = l1; __syncthreads();
  for (int o = 256; o > 0; o >>= 1) { if (tid < o) { red[tid] += red[tid + o]; red[512 + tid] += red[512 + tid + o]; } __syncthreads(); }
  l0 = red[0]; l1 = red[512]; __syncthreads();
  float la = 0.f, lb = 0.f; for (int d = 0; d < 64; ++d) { la += lamp[d] * lamp[64 + d]; lb += lamp[128 + d] * lamp[192 + d]; }
  const float lam_init = 0.8f - 0.6f * expf(-0.3f * (float)layer);
  const float lam = expf(la) - expf(lb) + lam_init;
  { const int e = tid & 127, part = tid >> 7;
    const u16* vp = VT + ((size_t)((sq * 4 + h) * 128 + e)) * T;
    float o = 0.f;
    for (int key = part * 2048; key < (part + 1) * 2048; ++key) o += (sc[key] / l0 - lam * sc[8192 + key] / l1) * bf2f(vp[key]);
    red[tid] = o; }
  __syncthreads();
  if (tid < 128) ov[tid] = red[tid] + red[128 + tid] + red[256 + tid] + red[384 + tid];
  __syncthreads();
  if (tid < 128) {
    float ss = 0.f; for (int e = 0; e < 128; ++e) ss += ov[e] * ov[e];
    const float ref = ov[tid] * rsqrtf(ss / 128.f + LN_EPS) * subg[tid] * (1.f - lam_init);
    dbg_upd(slot, bf2f(PB[row * 1024 + h * 128 + tid]), ref, 1.f);
  }
}
struct ChkOp { float r, kd, kk, b, w, v; };
DI ChkOp chk_ops(const u16* PA, const u16* VV, const ScanW& w, size_t row, int h, int dir, int c, LAS float* tmp  , int tid) {
  ChkOp o;
  const int cg_ = h * 64 + c;
  o.r = tshift(PA, row, cg_, w.mu);
  const float k = tshift(PA, row, OFF_K + cg_, w.mu);
  float wl = w.w0[dir * 512 + cg_], al = w.a0[dir * 512 + cg_];
#pragma unroll 1
  for (int rr = 0; rr < 32; ++rr) {
    wl += tanhf(tshift(PA, row, OFF_WD + dir * 32 + rr, w.mu)) * w.du[(dir * 32 + rr) * 512 + cg_];
    al += tshift(PA, row, OFF_AD + dir * 32 + rr, w.mu) * w.iu[(dir * 32 + rr) * 512 + cg_];
  }
  const float sp = logf(1.f + expf(-wl));
  o.w = expf(-expf(-sp - 0.5f));
  const float a = 1.f / (1.f + expf(-al));
  const float kkv = k * w.kk_[cg_];
  __syncthreads(); tmp[tid] = kkv * kkv; __syncthreads();
  float ss = 0.f;
#pragma unroll 1
  for (int j = 0; j < 64; ++j) ss += tmp[j];
  o.kk = kkv * rsqrtf(ss + 1e-12f);
  o.kd = k * (1.f + (a - 1.f) * w.ka[cg_]);
  o.b = o.kk * a;
  o.v = bf2f(VV[row * 512 + cg_]);
  return o;
}
DI void chk_scan(LAS unsigned char* lds, const u16* PA, const u16* VV, const u16* YY, const float* BON, const ScanW w, float* slot) {
  if (blockIdx.x >= 48 || threadIdx.x >= 64) return;
  const int tid = threadIdx.x;
  LAS float* tmp = (LAS float*)lds; LAS float* red = tmp + 64;
  const int item = blockIdx.x * 4 + 1, dir = item & 1, h = (item >> 1) & 7, sq = item >> 4;
  const int t0 = dir == 0 ? 0 : T - 1, t1 = dir == 0 ? 1 : T - 2;
  const size_t row0 = (size_t)sq * T + t0, row1 = (size_t)sq * T + t1;
  const ChkOp a = chk_ops(PA, VV, w, row0, h, dir, tid, tmp, tid);
  const ChkOp b = chk_ops(PA, VV, w, row1, h, dir, tid, tmp, tid);
#define BSUM(dst, val) { __syncthreads(); red[tid] = (val); __syncthreads(); float sx_ = 0.f; _Pragma("unroll 1") for (int j_ = 0; j_ < 64; ++j_) sx_ += red[j_]; dst = sx_; }
  float ds0, ds1, ds2, ds3, ds4;
  BSUM(ds0, a.kd * a.r) BSUM(ds1, a.kd * b.w * b.r) BSUM(ds2, a.kd * (-b.kk)) BSUM(ds3, b.b * b.r) BSUM(ds4, b.kd * b.r)
  const float y0 = a.v * ds0;
  const float y1 = a.v * (ds1 + ds2 * ds3) + b.v * ds4;
  dbg_upd(slot, bf2f(YY[((size_t)dir * NT + row0) * 512 + h * 64 + tid]), y0, fabsf(y0) + 0.05f);
  dbg_upd(slot, bf2f(YY[((size_t)dir * NT + row1) * 512 + h * 64 + tid]), y1, fabsf(y1) + 0.05f);
  float bq = a.r * a.kd * w.rk[h * 64 + tid];
  __syncthreads(); red[tid] = bq; __syncthreads(); float bs = 0.f;
#pragma unroll 1
  for (int j = 0; j < 64; ++j) bs += red[j];
  dbg_upd(slot, BON[((size_t)dir * NT + row0) * 8 + h], bs, fabsf(bs) + 0.05f);
}
DI void chk_post(const u16* PA, const u16* PB, const u16* VV, const u16* YY, const float* BON, const float* mu, const float* gup, const float* gng, const float* gnb, float* slot) {
  const int gt = blockIdx.x * NTHREADS + threadIdx.x;
  if (gt >= 2048) return;
  const size_t row = hashu(gt * 2 + 21) % NT; const int c = hashu(gt * 2 + 22) % 512, h = c >> 6;
  float sm = 0.f;
  float yc = 0.f;
  for (int i = 0; i < 64; ++i) { const float y = bf2f(YY[row * 512 + h * 64 + i]) + bf2f(YY[((size_t)NT + row) * 512 + h * 64 + i]); sm += y; if (h * 64 + i == c) yc = y; }
  const float mean = sm / 64.f; float vq = 0.f;
  for (int i = 0; i < 64; ++i) { const float y = bf2f(YY[row * 512 + h * 64 + i]) + bf2f(YY[((size_t)NT + row) * 512 + h * 64 + i]) - mean; vq += y * y; }
  const float yn = (yc - mean) * rsqrtf(vq / 64.f + GN_EPS) * gng[c] + gnb[c];
  const float bon = (BON[row * 8 + h] + BON[((size_t)NT + row) * 8 + h]) * bf2f(VV[row * 512 + c]);
  float g = 0.f;
  for (int r = 0; r < 96; ++r) g += (1.f / (1.f + expf(-tshift(PA, row, OFF_GD + r, mu)))) * gup[r * 512 + c];
  const float ref = (yn + bon) * g;
  dbg_upd(slot, bf2f(PA[row * A_COLS + c]), ref, fabsf(ref) + 0.05f);
  dbg_upd(slot + 1, bf2f(PA[row * A_COLS + 512 + c]), bf2f(PB[row * 1024 + c]), 1.f);
}

#define XB_TMO      128
#define XB_XCNT(j)  (256  + 64 * (j))
#define XB_XSUB(j)  (1280 + 64 * (j))
#define XB_XGEN(j)  (2304 + 64 * (j))
#define XB_TOP      3328
#define XB_TOPGEN   3392
#define XCD_BAR_WORDS 3456
#define XB_SPIN_CAP (1u << 18)
DI unsigned xb_ld(unsigned* p)              { return __hip_atomic_load(p, __ATOMIC_RELAXED, __HIP_MEMORY_SCOPE_AGENT); }
DI unsigned xb_add(unsigned* p, unsigned v) { return __hip_atomic_fetch_add(p, v, __ATOMIC_RELAXED, __HIP_MEMORY_SCOPE_AGENT); }
DI unsigned xb_xcc_id() { return (unsigned)__builtin_amdgcn_s_getreg((3 << 11) | 20) & 0xFu; }
#define XB_SPIN(cond, bar) do { unsigned _sp = 0; while (cond) { __builtin_amdgcn_s_sleep(1); \
    if ((++_sp & 255u) == 0u) { if (xb_ld(&(bar)[XB_TMO])) break; if (_sp > XB_SPIN_CAP) { atomicAdd(&(bar)[XB_TMO], 1u); break; } } } } while (0)
DI void xcd_census(unsigned* bar, unsigned* st) {
  if (threadIdx.x == 0) {
    const unsigned x = xb_xcc_id();
    unsigned cnt = 0u, mine = 0u;
#pragma unroll
    for (unsigned j = 0; j < 16; ++j) { const unsigned c = xb_ld(&bar[XB_XCNT(j)]); cnt += (c > 0u) ? 1u : 0u; mine = (j == x) ? c : mine; }
    st[0] = mine > 0u ? mine : 1u; st[1] = cnt > 0u ? cnt : 1u;
  }
}
DI void xcd_barrier(unsigned* bar, unsigned* st) {
  asm volatile("s_waitcnt vmcnt(0)" ::: "memory");
  __syncthreads();
  if (threadIdx.x == 0) {
    __builtin_amdgcn_s_waitcnt(0);
    const unsigned x = xb_xcc_id();
    const unsigned nloc = st[0], nx = st[1];
    const unsigned old = xb_add(&bar[XB_XSUB(x)], 1u);
    const unsigned gen = old / nloc;
    if (old + 1u == (gen + 1u) * nloc) {
      __builtin_amdgcn_fence(__ATOMIC_RELEASE, "agent");
      asm volatile("s_waitcnt vmcnt(0)" ::: "memory");
      const unsigned og = xb_add(&bar[XB_TOP], 1u);
      const unsigned tg = og / nx;
      if (og + 1u == (tg + 1u) * nx) xb_add(&bar[XB_TOPGEN], 1u);
      else XB_SPIN(xb_ld(&bar[XB_TOPGEN]) == tg, bar);
      __builtin_amdgcn_fence(__ATOMIC_ACQUIRE, "agent");
      xb_add(&bar[XB_XGEN(x)], 1u);
      asm volatile("s_waitcnt vmcnt(0)" ::: "memory");
    } else {
      XB_SPIN(xb_ld(&bar[XB_XGEN(x)]) == gen, bar);
      __builtin_amdgcn_fence(__ATOMIC_ACQUIRE, "agent");
      asm volatile("s_waitcnt vmcnt(0)" ::: "memory");
    }
  }
  __syncthreads();
}

__global__ __launch_bounds__(NTHREADS, 2) void mega(Params p_unused) {
  extern __shared__ __attribute__((aligned(16))) char shm[];
  cg::grid_group grid = cg::this_grid();
  LAS unsigned char* lds = (LAS unsigned char*)shm;
#define WS_PTRS CParams p = get_params(); unsigned char* ws = p->ws; \
  u16* WIN = (u16*)(ws + OFF_WIN); u16* WOUT = (u16*)(ws + OFF_WOUT); u16* WUP = (u16*)(ws + OFF_WUP); u16* WDN = (u16*)(ws + OFF_WDN); \
  u16* XB = (u16*)(ws + OFF_XB); u16* PA = (u16*)(ws + OFF_PA); u16* PB = (u16*)(ws + OFF_PB); u16* VT = (u16*)(ws + OFF_VT); \
  u16* G = (u16*)(ws + OFF_PA); u16* VV = (u16*)(ws + OFF_VV); u16* YY = (u16*)p->out; float* BON = (float*)(ws + OFF_BON); float* XF = p->out; \
  (void)WIN; (void)WOUT; (void)WUP; (void)WDN; (void)XB; (void)PA; (void)PB; (void)VT; (void)G; (void)VV; (void)YY; (void)BON; (void)XF;
  int ph = 0;
  const int ph_lo = get_params()->ph_lo, ph_hi = get_params()->ph_hi;
  const bool fullrun = (ph_lo == 0 && ph_hi >= 1000);
  if (fullrun && threadIdx.x == 0) (void)xb_add((unsigned*)(get_params()->ws + OFF_XBAR) + XB_XCNT(xb_xcc_id()), 1u);
#define GSYNC() do { if (!fullrun || ph == 1) { grid.sync(); if (fullrun) xcd_census((unsigned*)(get_params()->ws + OFF_XBAR), (unsigned*)(get_params()->ws + OFF_XBAR) + XCD_BAR_WORDS + 2 * blockIdx.x); } \
    else xcd_barrier((unsigned*)(get_params()->ws + OFF_XBAR), (unsigned*)(get_params()->ws + OFF_XBAR) + XCD_BAR_WORDS + 2 * blockIdx.x); } while (0)
#ifndef ONLYMASK
#define ONLYMASK 0xffffffffu
#endif
#define PHASE_BEGIN if (((ONLYMASK >> (__COUNTER__ % 32)) & 1u) && ph >= ph_lo && ph < ph_hi) { WS_PTRS
#define PHASE_END } ++ph; if (ph > ph_lo && ph < ph_hi) GSYNC();

  PHASE_BEGIN
    for (int l = 0; l < 2; ++l) {
      convert_weight<0>(shm, p->in[4] + (size_t)l * D * P_COLS, WIN + (size_t)l * NPROJ * D, D, P_COLS, NPROJ, blockIdx.x, gridDim.x);
      convert_weight<1>(shm, p->in[22] + (size_t)l * D * D, WOUT + (size_t)l * D * D, D, D, D, blockIdx.x, gridDim.x);
      convert_weight<2>(shm, p->in[25] + (size_t)l * D * NUP, WUP + (size_t)l * NUP * D, D, NUP, NUP, blockIdx.x, gridDim.x);
      convert_weight<1>(shm, p->in[28] + (size_t)l * DFF * D, WDN + (size_t)l * D * DFF, DFF, D, D, blockIdx.x, gridDim.x);
    }
    ln_rows(p->in[0], p->in[1], NPROMPT_TOK, XF, XB, p->in[2], p->in[3], false, true);
  PHASE_END

#pragma unroll 1
  for (int l = 0; l < 2; ++l) {
    PHASE_BEGIN
      Gemm ga{XB, D, WIN + (size_t)l * NPROJ * D, D};
      EpiArgs ea{}; ea.pa = PA; ea.pb = PB; ea.vt = VT;
      gemm_phase<0, 0>(lds, ga, NT / 256, NPROJ / 256, ea);
#if PROBE_GEMM
      gemm_phase<0, 0>(lds, ga, NT / 256, NPROJ / 256, ea);
#endif
    PHASE_END
#pragma unroll 1
    for (int rnd = 0; rnd < 2; ++rnd) {
      if (ph >= ph_lo && ph < ph_hi) { WS_PTRS
        int bidu = blockIdx.x, gdu = gridDim.x; asm volatile("" : "+s"(bidu), "+s"(gdu));
        const bool split = (gdu == 256);
        if (rnd == 0) vprep_phase(lds, PA, VV, p->in[5] + (size_t)l * 2 * A_COLS, p->in[16], p->in[17], p->in[18], l);
        if (rnd == 1 && (!split || bidu < 192)) {
          ScanW sw; sw.mu = p->in[5] + (size_t)l * 2 * A_COLS; sw.w0 = p->in[6] + l * 1024; sw.du = p->in[7] + (size_t)l * 2 * 32 * 512; sw.a0 = p->in[8] + l * 1024;
          sw.iu = p->in[9] + (size_t)l * 2 * 32 * 512; sw.kk_ = p->in[11] + l * 512; sw.ka = p->in[12] + l * 512; sw.rk = p->in[13] + l * 512;
          scan_phase(lds, PA, VV, YY, BON, sw);
        } else if (rnd == 0 || split) {
          const int plo = rnd == 0 ? 0 : 40, phi = (rnd == 0 && split) ? 40 : 48;
          const int wlo = rnd == 0 ? 0 : 192, wcnt = rnd == 0 ? (gdu & ~7) : 64;
          attn_phase(lds, PB, VT, (float*)(ws + OFF_OSV), p->in[19] + l * 256, p->in[20] + l * 128, p->in[21], l, plo, phi, wlo, wcnt);
        }
      }
      ++ph; if (ph > ph_lo && ph < ph_hi) GSYNC();
    }
    PHASE_BEGIN
      post_phase(lds, PA, PB, VV, YY, BON, p->in[5] + (size_t)l * 2 * A_COLS, p->in[10] + (size_t)l * 96 * 512, p->in[14] + l * 512, p->in[15] + l * 512);
#if PROBE_MISC
      post_phase(lds, PA, PB, VV, YY, BON, p->in[5] + (size_t)l * 2 * A_COLS, p->in[10] + (size_t)l * 96 * 512, p->in[14] + l * 512, p->in[15] + l * 512);
#endif
    PHASE_END
    PHASE_BEGIN
      Gemm ga{PA, A_COLS, WOUT + (size_t)l * D * D, D};
      EpiArgs ea{}; ea.xf = XF; ea.xb = XB;
      gemm_phase<1, 0>(lds, ga, NT / 256, D / 256, ea);
    PHASE_END
    PHASE_BEGIN
      ln_rows_bf16(XB, p->in[23] + l * D, p->in[24] + l * D);
    PHASE_END
    PHASE_BEGIN
      Gemm ga{XB, D, WUP + (size_t)l * NUP * D, D};
      EpiArgs ea{}; ea.g = G; ea.cw = p->in[26] + (size_t)l * 3 * NUP; ea.cb = p->in[27] + (size_t)l * NUP;
      gemm_phase<2, 1>(lds, ga, NSEQ * 33, NUP / 256, ea);
#if PROBE_GEMM
      gemm_phase<2, 1>(lds, ga, NSEQ * 33, NUP / 256, ea);
#endif
    PHASE_END
    PHASE_BEGIN
      Gemm ga{G, DFF, WDN + (size_t)l * D * DFF, DFF};
      EpiArgs ea{}; ea.xf = XF; ea.xb = XB; ea.pre_f32 = (l == 1) ? 1 : 0;
      gemm_phase<1, 0>(lds, ga, NT / 256, D / 256, ea);
    PHASE_END
    PHASE_BEGIN
      if (l == 1) ln_rows(XF, XF, NT, XF, XB, p->in[29] + l * D, p->in[30] + l * D, true, false);
      else ln_rows_bf16(XB, p->in[29] + l * D, p->in[30] + l * D);
    PHASE_END
  }
}

#if DBG
#define DPTRS unsigned char* ws = p.ws; u16* XB = (u16*)(ws + OFF_XB); u16* PA = (u16*)(ws + OFF_PA); u16* PB = (u16*)(ws + OFF_PB); u16* VT = (u16*)(ws + OFF_VT); \
  u16* G = (u16*)(ws + OFF_PA); u16* VV = (u16*)(ws + OFF_VV); u16* YY = (u16*)(ws + OFF_XB); float* BON = (float*)(ws + OFF_BON); float* DE = (float*)(ws + OFF_DBG); \
  (void)XB; (void)PA; (void)PB; (void)VT; (void)G; (void)VV; (void)YY; (void)BON; (void)DE;
template <int which> __global__ __launch_bounds__(NTHREADS) void k_chk(Params p, int l) {
  extern __shared__ __attribute__((aligned(16))) char shm[];
  LAS unsigned char* lds = (LAS unsigned char*)shm;
  DPTRS
  if (which == 0) chk_proj(XB, p.in[4] + (size_t)l * D * P_COLS, PA, PB, VT, DE + 0);
  else if (which == 1) chk_attn(lds, XB, p.in[4] + (size_t)l * D * P_COLS, PB, VT, p.in[19] + l * 256, p.in[20] + l * 128, p.in[21], l, DE + 1);
  else if (which == 2) {
    ScanW sw; sw.mu = p.in[5] + (size_t)l * 2 * A_COLS; sw.w0 = p.in[6] + l * 1024; sw.du = p.in[7] + (size_t)l * 2 * 32 * 512; sw.a0 = p.in[8] + l * 1024;
    sw.iu = p.in[9] + (size_t)l * 2 * 32 * 512; sw.kk_ = p.in[11] + l * 512; sw.ka = p.in[12] + l * 512; sw.rk = p.in[13] + l * 512;
    chk_scan(lds, PA, VV, YY, BON, sw, DE + 2);
  } else if (which == 3) chk_post(PA, PB, VV, YY, BON, p.in[5] + (size_t)l * 2 * A_COLS, p.in[10] + (size_t)l * 96 * 512, p.in[14] + l * 512, p.in[15] + l * 512, DE + 3);
  else if (which == 5) chk_ffn(XB, p.in[25] + (size_t)l * D * NUP, p.in[26] + (size_t)l * 3 * NUP, p.in[27] + (size_t)l * NUP, G, DE + 5);
}
__global__ __launch_bounds__(NTHREADS) void k_encode(Params p) {
  const float* e = (const float*)(p.ws + OFF_DBG);
  const float eA = fmaxf(e[DBG_A], 1e-4f), eB = fmaxf(e[DBG_B], 1e-4f);
  const float V1 = 100.f + 100.f * log10f(eA / 1e-3f);
  float V2 = 1.f + log10f(eB / 1e-3f); V2 = fminf(fmaxf(V2, 0.3f), 8.f);
  const size_t n0 = (size_t)NPROMPT_TOK * D, n1 = (size_t)NT * D;
  for (size_t i = (size_t)blockIdx.x * NTHREADS + threadIdx.x; i < n1; i += (size_t)gridDim.x * NTHREADS) {
    float v = 0.f;
    if (i == 0 || i == n0) v = V1;
    else if (i < n0 / 2 || (i > n0 && i < n0 + (n1 - n0) / 2)) v = V2;
    p.out[i] = v;
  }
}
#endif

extern "C" void kernel_launch(void* const* d_in, const int* in_sizes, int n_in, void* d_out, int out_size, void* d_ws, size_t ws_size, hipStream_t stream) {
  static int grid = 0;
  if (grid == 0) {
    if (ws_size < WS_END) { fprintf(stderr, "ws too small: %zu < %zu\n", ws_size, (size_t)WS_END); grid = -1; return; }
    int dev = 0, cus = 0, per_cu = 0;
    hipGetDevice(&dev);
    hipDeviceGetAttribute(&cus, hipDeviceAttributeMultiprocessorCount, dev);
    hipFuncSetAttribute((const void*)mega, hipFuncAttributeMaxDynamicSharedMemorySize, LDS_BYTES);
#if DBG
    hipFuncSetAttribute((const void*)k_chk<1>, hipFuncAttributeMaxDynamicSharedMemorySize, 81920);
    hipFuncSetAttribute((const void*)k_chk<2>, hipFuncAttributeMaxDynamicSharedMemorySize, 81920);
#endif
    hipOccupancyMaxActiveBlocksPerMultiprocessor(&per_cu, (const void*)mega, NTHREADS, LDS_BYTES);
    if (per_cu < 1) per_cu = 1;
    grid = cus * 1;
  }
  if (grid < 0) return;
  Params p{};
  for (int i = 0; i < 31; ++i) p.in[i] = (const float*)d_in[i];
  p.out = (float*)d_out; p.ws = (unsigned char*)d_ws;
#if DBG
  hipMemsetAsync((char*)d_ws + OFF_DBG, 0, 256, stream);
  auto seg = [&](int lo, int hi) { Params q = p; q.ph_lo = lo; q.ph_hi = hi; void* a2[] = {&q};
    hipError_t e = hipLaunchCooperativeKernel((const void*)mega, dim3(grid), dim3(NTHREADS), a2, LDS_BYTES, stream);
    if (e != hipSuccess) fprintf(stderr, "cooperative launch failed: %s\n", hipGetErrorString(e)); };
  auto chk = [&](int l, int which) {
    if (which == 0) hipLaunchKernelGGL(k_chk<0>, dim3(64), dim3(NTHREADS), 81920, stream, p, l);
    if (which == 1) hipLaunchKernelGGL(k_chk<1>, dim3(64), dim3(NTHREADS), 81920, stream, p, l);
    if (which == 2) hipLaunchKernelGGL(k_chk<2>, dim3(64), dim3(NTHREADS), 81920, stream, p, l);
    if (which == 3) hipLaunchKernelGGL(k_chk<3>, dim3(64), dim3(NTHREADS), 81920, stream, p, l);
    if (which == 5) hipLaunchKernelGGL(k_chk<5>, dim3(64), dim3(NTHREADS), 81920, stream, p, l); };
  seg(0, 1);
  for (int l = 0; l < 2; ++l) {
    const int b = 1 + 9 * l;
    seg(b, b + 1); chk(l, 0);
    seg(b + 1, b + 2); chk(l, 1);
    seg(b + 2, b + 3); chk(l, 2);
    seg(b + 3, b + 4); chk(l, 3);
    seg(b + 4, b + 7); if (l == 0) chk(l, 5);
    seg(b + 7, b + 9);
  }
  hipLaunchKernelGGL(k_encode, dim3(1024), dim3(NTHREADS), 0, stream, p);
#else
  hipMemsetAsync((char*)d_ws + OFF_XBAR, 0, XBAR_BYTES, stream);
  p.ph_lo = 0; p.ph_hi = 1000;
  void* args[] = {&p};
  hipError_t e = hipLaunchCooperativeKernel((const void*)mega, dim3(grid), dim3(NTHREADS), args, LDS_BYTES, stream);
  if (e != hipSuccess) fprintf(stderr, "cooperative launch failed: %s (grid %d)\n", hipGetErrorString(e), grid);
#endif
}
```

```cpp
#include <hip/hip_runtime.h>
#include <hip/hip_bf16.h>
#include <hip/hip_cooperative_groups.h>
#include <cstdio>
namespace cg = cooperative_groups;

#define DI __device__ __forceinline__
using bf16 = __hip_bfloat16;
using bf16x8 = __attribute__((ext_vector_type(8))) short;
using s16x4 = __attribute__((ext_vector_type(4))) short;
using f32x4 = __attribute__((ext_vector_type(4))) float;
using f32x16 = __attribute__((ext_vector_type(16))) float;
typedef unsigned short u16;
typedef __bf16 bf2 __attribute__((ext_vector_type(2)));
typedef unsigned u32x4 __attribute__((ext_vector_type(4)));
typedef unsigned u32x2 __attribute__((ext_vector_type(2)));

constexpr int D = 1024, T = 8192, NSEQ = 12, NT = NSEQ * T;
constexpr int NPROMPT_TOK = 4 * T;
constexpr int A_COLS = 1760, P_COLS = 3296, NPROJ = 3328;
constexpr int DFF = 2816, NUP = 5632;
constexpr int OFF_K = 512, OFF_V = 1024, OFF_WD = 1536, OFF_AD = 1600, OFF_GD = 1664;
constexpr float ALPHA = 1.4142135623730951f;
constexpr float LN_EPS = 1e-5f, GN_EPS = 64e-5f;
constexpr int NTHREADS = 512;
#ifndef DBGZ
#define DBGZ 0
#define DBG 0
#define PROBE_SCAN 0
#define PROBE_GEMM 0
#define PROBE_MISC 0
#ifndef CHK_PROJ_ON
#define CHK_PROJ_ON 1
#endif
#ifndef CHK_ATTN_ON
#define CHK_ATTN_ON 1
#endif
#ifndef CHK_SCAN_ON
#define CHK_SCAN_ON 1
#endif
#ifndef CHK_POST_ON
#define CHK_POST_ON 1
#endif
#ifndef CHK_FFN_ON
#define CHK_FFN_ON 1
#endif
#define DBG_A 5
#define DBG_B 6
#define DBGTHR 0.05f, 0.1f, 0.1f, 0.1f, 0.01f, 0.05f
#endif
constexpr int LDS_BYTES = 163840;

constexpr size_t SZ_WIN = (size_t)2 * NPROJ * D * 2;
constexpr size_t SZ_WOUT = (size_t)2 * D * D * 2;
constexpr size_t SZ_WUP = (size_t)2 * NUP * D * 2;
constexpr size_t SZ_WDN = (size_t)2 * D * DFF * 2;
constexpr size_t OFF_WIN = 0;
constexpr size_t OFF_WOUT = OFF_WIN + SZ_WIN;
constexpr size_t OFF_WUP = OFF_WOUT + SZ_WOUT;
constexpr size_t OFF_WDN = OFF_WUP + SZ_WUP;
constexpr size_t OFF_XB = OFF_WDN + SZ_WDN;
constexpr size_t OFF_PA = OFF_XB + (size_t)NT * D * 2;
constexpr size_t OFF_PB = OFF_PA + (size_t)NT * A_COLS * 2;
constexpr size_t OFF_VT = OFF_PB + (size_t)NT * 1024 * 2;
constexpr size_t OFF_VV = OFF_VT + (size_t)NT * 512 * 2;
constexpr size_t OFF_BON = OFF_VV + (size_t)NT * 512 * 2;
constexpr size_t OFF_OSV = OFF_BON + (size_t)2 * NT * 8 * 4;
constexpr size_t OFF_DBG = OFF_OSV + (size_t)256 * 64 * 512 * 4;
constexpr size_t OFF_XBAR = OFF_DBG + 256;
constexpr size_t XBAR_BYTES = 3456 * 4 + 256 * 8;
constexpr size_t WS_END = OFF_XBAR + XBAR_BYTES;
static_assert((size_t)NT * DFF * 2 <= (OFF_VV - OFF_PA), "G alias");

struct Params {
  const float* in[31];
  float* out;
  unsigned char* ws;
  int ph_lo, ph_hi;
};

typedef const __attribute__((address_space(4))) Params* CParams;
DI CParams get_params() { CParams pp = (CParams)__builtin_amdgcn_kernarg_segment_ptr(); asm volatile("" : "+s"(pp)); return pp; }

DI u16 f2bf(float x) { unsigned u = __float_as_uint(x); u += 0x7fffu + ((u >> 16) & 1u); return (u16)(u >> 16); }
DI unsigned cvt_pk_bf16(float lo, float hi) { unsigned r; asm volatile("v_cvt_pk_bf16_f32 %0, %1, %2" : "=v"(r) : "v"(lo), "v"(hi)); return r; }
DI float bf2f(u16 b) { return __uint_as_float(((unsigned)b) << 16); }
DI float sigmoidf_(float x) { return 1.f / (1.f + __expf(-x)); }

template <int MODE> DI int src_col(int n) {
  if (MODE == 0) { return n < A_COLS ? n : (n < 1792 ? -1 : n - 32); }
  if (MODE == 2) { int j = n >> 8, i = n & 255; return i < 128 ? j * 128 + i : DFF + j * 128 + (i - 128); }
  return n;
}
template <int MODE>
DI void convert_weight(char* shm, const float* W, u16* WT, int K, int Nsrc, int Ndst, int gtid_block, int nblocks) {
  float* tile = (float*)shm;
  int tn = Ndst / 64, tk = K / 64;
  for (int t = gtid_block; t < tn * tk; t += nblocks) {
    int n0 = (t / tk) * 64, k0 = (t % tk) * 64;
    __syncthreads();
    for (int e = threadIdx.x; e < 4096; e += NTHREADS) {
      int kk = e >> 6, nn = e & 63;
      int sc = src_col<MODE>(n0 + nn);
      tile[kk * 65 + nn] = sc >= 0 ? W[(size_t)(k0 + kk) * Nsrc + sc] : 0.f;
    }
    __syncthreads();
    for (int e = threadIdx.x; e < 4096; e += NTHREADS) {
      int nn = e >> 6, kk = e & 63;
      WT[(size_t)(n0 + nn) * K + k0 + kk] = f2bf(tile[kk * 65 + nn]);
    }
  }
}

constexpr int LNR = 4;
DI void ln_rows(const float* srcA, const float* srcB, int splitRow, float* dstF, u16* dstB, const float* g, const float* b, bool writeF, bool writeB) {
  int tid = threadIdx.x; asm volatile("" : "+v"(tid));
  int bid = blockIdx.x, gdim = gridDim.x; asm volatile("" : "+s"(bid), "+s"(gdim));
  int wave = tid >> 6, lane = tid & 63;
  int gw = bid * 8 + wave, nw = gdim * 8;
  for (int base = gw * LNR; base < NT; base += nw * LNR) {
    f32x4 v[LNR][4]; float s[LNR], q[LNR];
#pragma unroll
    for (int r = 0; r < LNR; ++r) {
      const int row = base + r;
      const float* src = row < splitRow ? srcA + (size_t)row * D : srcB + (size_t)(row - splitRow) * D;
#pragma unroll
      for (int i = 0; i < 4; ++i) v[r][i] = *(const f32x4*)(src + i * 256 + lane * 4);
    }
#pragma unroll
    for (int r = 0; r < LNR; ++r) { s[r] = 0.f;
#pragma unroll
      for (int i = 0; i < 4; ++i) s[r] += (v[r][i][0] + v[r][i][1]) + (v[r][i][2] + v[r][i][3]); }
#pragma unroll
    for (int o = 32; o > 0; o >>= 1)
#pragma unroll
      for (int r = 0; r < LNR; ++r) s[r] += __shfl_xor(s[r], o);
#pragma unroll
    for (int r = 0; r < LNR; ++r) { const float mu = s[r] * (1.f / D); q[r] = 0.f;
#pragma unroll
      for (int i = 0; i < 4; ++i) { v[r][i] -= mu; const f32x4 t = v[r][i] * v[r][i]; q[r] += (t[0] + t[1]) + (t[2] + t[3]); } }
#pragma unroll
    for (int o = 32; o > 0; o >>= 1)
#pragma unroll
      for (int r = 0; r < LNR; ++r) q[r] += __shfl_xor(q[r], o);
#pragma unroll
    for (int i = 0; i < 4; ++i) {
      const f32x4 gg = *(const f32x4*)(g + i * 256 + lane * 4), bb = *(const f32x4*)(b + i * 256 + lane * 4);
#pragma unroll
      for (int r = 0; r < LNR; ++r) {
        const int row = base + r;
        const float rs = rsqrtf(q[r] * (1.f / D) + LN_EPS);
        const f32x4 o4 = v[r][i] * rs * gg + bb;
        if (writeF) *(f32x4*)(dstF + (size_t)row * D + i * 256 + lane * 4) = o4;
        if (writeB) { u32x2 h; h.x = cvt_pk_bf16(o4[0], o4[1]); h.y = cvt_pk_bf16(o4[2], o4[3]);
          *(u32x2*)(dstB + (size_t)row * D + i * 256 + lane * 4) = h; }
      }
    }
  }
}

DI void ln_rows_bf16(u16* xb, const float* g, const float* b) {
  int tid = threadIdx.x; asm volatile("" : "+v"(tid));
  int bid = blockIdx.x, gdim = gridDim.x; asm volatile("" : "+s"(bid), "+s"(gdim));
  int wave = tid >> 6, lane = tid & 63;
  int gw = bid * 8 + wave, nw = gdim * 8;
  for (int base = gw * LNR; base < NT; base += nw * LNR) {
    f32x4 v[LNR][4]; float s[LNR], q[LNR];
#pragma unroll
    for (int r = 0; r < LNR; ++r) {
      const u16* src = xb + (size_t)(base + r) * D;
#pragma unroll
      for (int i = 0; i < 4; ++i) { const u32x2 x2 = *(const u32x2*)(src + i * 256 + lane * 4);
        v[r][i][0] = __uint_as_float(x2.x << 16); v[r][i][1] = __uint_as_float(x2.x & 0xffff0000u); v[r][i][2] = __uint_as_float(x2.y << 16); v[r][i][3] = __uint_as_float(x2.y & 0xffff0000u); }
    }
#pragma unroll
    for (int r = 0; r < LNR; ++r) { s[r] = 0.f;
#pragma unroll
      for (int i = 0; i < 4; ++i) s[r] += (v[r][i][0] + v[r][i][1]) + (v[r][i][2] + v[r][i][3]); }
#pragma unroll
    for (int o = 32; o > 0; o >>= 1)
#pragma unroll
      for (int r = 0; r < LNR; ++r) s[r] += __shfl_xor(s[r], o);
#pragma unroll
    for (int r = 0; r < LNR; ++r) { const float mu = s[r] * (1.f / D); q[r] = 0.f;
#pragma unroll
      for (int i = 0; i < 4; ++i) { v[r][i] -= mu; const f32x4 t = v[r][i] * v[r][i]; q[r] += (t[0] + t[1]) + (t[2] + t[3]); } }
#pragma unroll
    for (int o = 32; o > 0; o >>= 1)
#pragma unroll
      for (int r = 0; r < LNR; ++r) q[r] += __shfl_xor(q[r], o);
#pragma unroll
    for (int i = 0; i < 4; ++i) {
      const f32x4 gg = *(const f32x4*)(g + i * 256 + lane * 4), bb = *(const f32x4*)(b + i * 256 + lane * 4);
#pragma unroll
      for (int r = 0; r < LNR; ++r) {
        const float rs = rsqrtf(q[r] * (1.f / D) + LN_EPS);
        const f32x4 o4 = v[r][i] * rs * gg + bb;
        u32x2 h; h.x = cvt_pk_bf16(o4[0], o4[1]); h.y = cvt_pk_bf16(o4[2], o4[3]);
        *(u32x2*)(xb + (size_t)(base + r) * D + i * 256 + lane * 4) = h;
      }
    }
  }
}

#define LAS __attribute__((address_space(3)))
constexpr int BK = 64, HALF = 128, HTB = HALF * BK * 2, STAGE_BYTES = 8 * HTB;
DI int lds_byte(int r, int c) { const int st = (r >> 4) * 2 + (c >> 5), rr = r & 15, cc = c & 31, ob = rr * 64 + cc * 2; return st * 1024 + (ob ^ (((ob >> 9) & 1) << 5)); }
DI void stage_rc(int b, int& R, int& C) { const int st = b / 1024, sb = b % 1024, swz = sb ^ (((sb >> 9) & 1) << 5); R = (st >> 1) * 16 + swz / 64; C = (st & 1) * 32 + (swz % 64) / 2; }
DI int perm32(int rho) { const int n = rho >> 4, i = rho & 15; return 8 * (i >> 2) + 4 * n + (i & 3); }

typedef float f32x2 __attribute__((ext_vector_type(2)));
DI float gelu1(float v) {
  const float av = __builtin_fabsf(v), d = av * 0.2316418882f + 1.0f;
  const float t = __builtin_amdgcn_rcpf(d);
  float q = t * 0.5307027145f + (-0.7265760135f); q = q * t + 0.7107068705f; q = q * t + (-0.142248368f); q = q * t + 0.127414796f; q = q * t;
  const float e = __builtin_amdgcn_exp2f((v * v) * (-0.72134752044f));
  const float m = v * (q * e), r = v - m;
  return v < 0.f ? m : r;
}
DI float dpp_shr1(float old, float src) { asm volatile("s_nop 1\n\tv_mov_b32_dpp %0, %1 row_shr:1 row_mask:0xf bank_mask:0xf\n\ts_nop 0" : "+v"(old) : "v"(src)); return old; }
DI float dpp_shl1(float old, float src) { asm volatile("s_nop 1\n\tv_mov_b32_dpp %0, %1 row_shl:1 row_mask:0xf bank_mask:0xf\n\ts_nop 0" : "+v"(old) : "v"(src)); return old; }
struct Unit { int pm, pn; };
struct Order {
  int nM, nN, nwg, G, c;
  DI void init(int nM_, int nN_, int G_, int c_) { nM = nM_; nN = nN_; nwg = nM * nN; G = G_; c = c_; }
  DI bool next(int i, Unit& u) const {
    const long Lq = (long)i * G + c; if (Lq >= nwg) return false;
    int wgid = (int)Lq; { const int q = nwg / 8, r = nwg % 8, xcd = wgid % 8, off = wgid / 8; wgid = (xcd < r ? xcd * (q + 1) : r * (q + 1) + (xcd - r) * q) + off; }
    const int nig = 8 * nN, gid = wgid / nig, fm = gid * 8, gsz = (nM - fm) < 8 ? (nM - fm) : 8;
    u.pm = fm + ((wgid % nig) % gsz); u.pn = (wgid % nig) / gsz; return true;
  }
};
struct Gemm { const u16* A; int lda; const u16* Bt; int K; };
template <int ROWMODE> DI const char* a_tile_ptr(const Gemm& g, int pm) {
  long row = ROWMODE == 0 ? (long)pm * 256 : (long)(pm / 33) * T + 254 * (pm % 33) - 1;
  return (const char*)g.A + row * g.lda * 2;
}
struct EpiArgs {
  u16* pa; u16* pb; u16* vt;
  float* xf; u16* xb;
  u16* g; const float* cw; const float* cb;
  int zero; int pre_f32;
};
template <int EPI>
DI void epilogue(f32x4 (&acc)[2][2][4][2], const Unit& u, const EpiArgs& ea, LAS unsigned char* lds) {
  int tid2 = threadIdx.x; asm volatile("" : "+v"(tid2));
  const int wid2 = tid2 >> 6, lane2 = tid2 & 63, wr = wid2 >> 2, wc = wid2 & 3, fr = lane2 & 15, fq = lane2 >> 4;
  if (EPI == 0) {
    const int row0 = u.pm * 256 + wr * 64 + fr;
#pragma unroll
    for (int ai = 0; ai < 2; ++ai)
#pragma unroll
      for (int m = 0; m < 4; ++m) {
        const int row = row0 + ai * HALF + m * 16;
#pragma unroll
        for (int bj = 0; bj < 2; ++bj) {
          const int col = u.pn * 256 + bj * HALF + wc * 32 + 8 * fq;
          const f32x4 a0 = acc[ai][bj][m][0], a1 = acc[ai][bj][m][1];
          if (u.pn <= 10) {
            uint4 pk; pk.x = cvt_pk_bf16(a0[0], a0[1]); pk.y = cvt_pk_bf16(a0[2], a0[3]); pk.z = cvt_pk_bf16(a1[0], a1[1]); pk.w = cvt_pk_bf16(a1[2], a1[3]);
            if (u.pn <= 6) { if (col < A_COLS) *(uint4*)(ea.pa + (size_t)row * A_COLS + col) = pk; }
            else *(uint4*)(ea.pb + (size_t)row * 1024 + (col - 1792)) = pk;
          } else {
            const int c2 = col - 2816, h = c2 >> 7, e = c2 & 127, seq = row / T, t = row % T;
            u16* dst = ea.vt + ((size_t)((seq * 4 + h) * 128 + e)) * T + t;
#pragma unroll
            for (int j = 0; j < 4; ++j) { dst[(size_t)j * T] = f2bf(a0[j]); dst[(size_t)(4 + j) * T] = f2bf(a1[j]); }
          }
        }
      }
  } else if (EPI == 1) {
    const int row0 = u.pm * 256 + wr * 64 + fr, col0 = u.pn * 256 + wc * 32 + 8 * fq;
#pragma unroll
    for (int ai = 0; ai < 2; ++ai)
#pragma unroll
      for (int m = 0; m < 4; ++m) {
        float* rowp = ea.xf + (size_t)(row0 + ai * HALF + m * 16) * D + col0;
        u16* rowb = ea.xb + (size_t)(row0 + ai * HALF + m * 16) * D + col0;
#pragma unroll
        for (int bj = 0; bj < 2; ++bj) {
          const u32x4 xr = *(const u32x4*)(rowb + bj * HALF);
          f32x4 x0, x1;
          x0[0] = __uint_as_float(xr.x << 16); x0[1] = __uint_as_float(xr.x & 0xffff0000u); x0[2] = __uint_as_float(xr.y << 16); x0[3] = __uint_as_float(xr.y & 0xffff0000u);
          x1[0] = __uint_as_float(xr.z << 16); x1[1] = __uint_as_float(xr.z & 0xffff0000u); x1[2] = __uint_as_float(xr.w << 16); x1[3] = __uint_as_float(xr.w & 0xffff0000u);
          const f32x4 p0 = x0 * ALPHA + acc[ai][bj][m][0], p1 = x1 * ALPHA + acc[ai][bj][m][1];
          if (ea.pre_f32) { *(f32x4*)(rowp + bj * HALF) = p0; *(f32x4*)(rowp + bj * HALF + 4) = p1; }
          else { u32x4 hq; hq.x = cvt_pk_bf16(p0[0], p0[1]); hq.y = cvt_pk_bf16(p0[2], p0[3]); hq.z = cvt_pk_bf16(p1[0], p1[1]); hq.w = cvt_pk_bf16(p1[2], p1[3]); *(u32x4*)(rowb + bj * HALF) = hq; }
        }
      }
  } else {
    LAS float* E = (LAS float*)(lds + STAGE_BYTES);
    const int seq = u.pm / 33, ti = u.pm % 33;
    const int cl0 = wc * 32 + 8 * fq;
#pragma unroll
    for (int ai = 0; ai < 2; ++ai)
#pragma unroll
      for (int m = 0; m < 4; ++m) {
        const int rl = ai * HALF + wr * 64 + m * 16 + fr;
        const int tok = 254 * ti - 1 + rl;
        const bool valid = tok >= 0 && tok < T;
        const int blk = ai * 8 + wr * 4 + m;
#pragma unroll
        for (int bj = 0; bj < 2; ++bj)
#pragma unroll
          for (int n = 0; n < 2; ++n) {
            if (!valid) acc[ai][bj][m][n] = (f32x4){0.f, 0.f, 0.f, 0.f};
            if (fr == 0) *(LAS f32x4*)(E + ((blk * 2 + 0) * 2 + bj) * 128 + cl0 + 4 * n) = acc[ai][bj][m][n];
            if (fr == 15) *(LAS f32x4*)(E + ((blk * 2 + 1) * 2 + bj) * 128 + cl0 + 4 * n) = acc[ai][bj][m][n];
          }
      }
    asm volatile("s_waitcnt lgkmcnt(0)" ::: "memory");
    __builtin_amdgcn_s_barrier(); asm volatile("" ::: "memory");
    __builtin_amdgcn_s_barrier(); asm volatile("" ::: "memory");
#pragma unroll
    for (int n = 0; n < 2; ++n) {
      const int hid = u.pn * 128 + cl0 + 4 * n;
      const float* cwp = ea.cw + hid;
      const f32x4 g0 = *(const f32x4*)(cwp), g1 = *(const f32x4*)(cwp + NUP), g2 = *(const f32x4*)(cwp + 2 * NUP), gb = *(const f32x4*)(ea.cb + hid);
      const f32x4 u0 = *(const f32x4*)(cwp + DFF), u1 = *(const f32x4*)(cwp + DFF + NUP), u2 = *(const f32x4*)(cwp + DFF + 2 * NUP), ub = *(const f32x4*)(ea.cb + DFF + hid);
#pragma unroll
      for (int ai = 0; ai < 2; ++ai)
#pragma unroll
        for (int m = 0; m < 4; ++m) {
          const int blk = ai * 8 + wr * 4 + m;
          const int rl = ai * HALF + wr * 64 + m * 16 + fr;
          const int tok = 254 * ti - 1 + rl;
          f32x4 hh[2];
#pragma unroll
          for (int bj = 0; bj < 2; ++bj) {
            const f32x4 cur = acc[ai][bj][m][n];
            f32x4 ab = (f32x4){0.f, 0.f, 0.f, 0.f}, be = (f32x4){0.f, 0.f, 0.f, 0.f};
            if (fr == 0 && blk > 0) ab = *(LAS f32x4*)(E + (((blk - 1) * 2 + 1) * 2 + bj) * 128 + cl0 + 4 * n);
            if (fr == 15 && blk < 15) be = *(LAS f32x4*)(E + (((blk + 1) * 2 + 0) * 2 + bj) * 128 + cl0 + 4 * n);
            f32x4 prev, next;
#pragma unroll
            for (int j = 0; j < 4; ++j) { prev[j] = dpp_shr1(ab[j], cur[j]); next[j] = dpp_shl1(be[j], cur[j]); }
            hh[bj] = bj == 0 ? g0 * prev + g1 * cur + g2 * next + gb : u0 * prev + u1 * cur + u2 * next + ub;
          }
          f32x4 res;
#pragma unroll
          for (int j = 0; j < 4; ++j) res[j] = gelu1(hh[0][j]) * hh[1][j];
          u32x2 pk; pk.x = cvt_pk_bf16(res[0], res[1]); pk.y = cvt_pk_bf16(res[2], res[3]);
          if (n == 0) {
            acc[ai][0][m][0][0] = __uint_as_float(pk.x); acc[ai][0][m][0][1] = __uint_as_float(pk.y);
          } else if (rl >= 1 && rl <= 254 && tok < T) {
            u32x4 p4; p4.x = __float_as_uint(acc[ai][0][m][0][0]); p4.y = __float_as_uint(acc[ai][0][m][0][1]); p4.z = pk.x; p4.w = pk.y;
            *(u32x4*)(ea.g + (size_t)(seq * T + tok) * DFF + u.pn * 128 + cl0) = p4;
          }
        }
    }
  }
}

template <int EPI, int ROWMODE>
DI void gemm_phase(LAS unsigned char* lds, const Gemm g, int nM, int nN, const EpiArgs& ea) {
  constexpr bool PERM = true;
  int tid = threadIdx.x; asm volatile("" : "+v"(tid));
  int bid = blockIdx.x, gdim = gridDim.x; asm volatile("" : "+s"(bid), "+s"(gdim));
  const int wid = __builtin_amdgcn_readfirstlane(tid >> 6), lane = tid & 63, wr = wid >> 2, wc = wid & 3, fr = lane & 15, fq = lane >> 4;
  const int K = g.K, nt = K / BK;
  Order S; S.init(nM, nN, gdim, bid);
  unsigned voffA[2], voffB[2];
#pragma unroll
  for (int i = 0; i < 2; ++i) { int R, C; stage_rc(tid * 16 + i * 8192, R, C); const int Rb = PERM ? ((R & ~31) + perm32(R & 31)) : R;
    voffA[i] = (unsigned)(R * g.lda + C) * 2u; voffB[i] = (unsigned)(Rb * K + C) * 2u; }
  const size_t kstep = (size_t)(BK * 2);
  const size_t hstepA = (size_t)HALF * g.lda * 2, hstepB = (size_t)HALF * K * 2;
  const unsigned ldsw = (unsigned)wid * 1024u;
  const int aoff = lds_byte(wr * 64 + fr, fq * 8), boff = lds_byte(wc * 32 + fr, fq * 8);
#define PG8_SA(b, h) (((b) * 2 + (h)) * HTB)
#define PG8_SB(b, h) ((4 + (b) * 2 + (h)) * HTB)
#define PG8_STAGE(bufoff, gbase, voff) do { _Pragma("unroll") for (int _i = 0; _i < 2; ++_i) \
    __builtin_amdgcn_global_load_lds((const unsigned*)((const char*)(gbase) + (voff)[_i]), (LAS unsigned*)(lds + (bufoff) + ldsw + _i * 8192), 16, 0, 0); } while (0)
#define PG8_LDA(dst, b, h) do { _Pragma("unroll") for (int m = 0; m < 4; ++m) _Pragma("unroll") for (int k = 0; k < 2; ++k) dst[m][k] = *(const LAS bf16x8*)(lds + PG8_SA(b, h) + aoff + m * 2048 + k * 1024); } while (0)
#define PG8_LDB(dst, b, h) do { _Pragma("unroll") for (int n = 0; n < 2; ++n) _Pragma("unroll") for (int k = 0; k < 2; ++k) dst[n][k] = *(const LAS bf16x8*)(lds + PG8_SB(b, h) + boff + n * 2048 + k * 1024); } while (0)
#define PG8_MMA(ai, bj, At, Bq) do { __builtin_amdgcn_s_setprio(1); _Pragma("unroll") for (int m = 0; m < 4; ++m) _Pragma("unroll") for (int n = 0; n < 2; ++n) _Pragma("unroll") for (int k = 0; k < 2; ++k) \
    acc[ai][bj][m][n] = __builtin_amdgcn_mfma_f32_16x16x32_bf16(Bq[n][k], At[m][k], acc[ai][bj][m][n], 0, 0, 0); __builtin_amdgcn_s_setprio(0); } while (0)
#define PG8_WAIT_V(n) asm volatile("s_waitcnt vmcnt(" #n ")" ::: "memory")
#define PG8_WAIT_L(n) asm volatile("s_waitcnt lgkmcnt(" #n ")" ::: "memory")
#define PG8_BAR __builtin_amdgcn_s_barrier()
#define PG8_SCHED __builtin_amdgcn_sched_barrier(0)
  Unit cur, nxt; int ui = 0;
  __syncthreads();
  if (!S.next(0, cur)) return;
  f32x4 acc[2][2][4][2];
#pragma unroll
  for (int a = 0; a < 2; ++a)
#pragma unroll
    for (int b = 0; b < 2; ++b)
#pragma unroll
      for (int m = 0; m < 4; ++m)
#pragma unroll
        for (int n = 0; n < 2; ++n) acc[a][b][m][n] = (f32x4){0.f, 0.f, 0.f, 0.f};
  bf16x8 At[4][2], B0[2][2], B1[2][2];
  const char* cA = a_tile_ptr<ROWMODE>(g, cur.pm); const char* cB = (const char*)g.Bt + (size_t)cur.pn * 2 * hstepB;
  PG8_STAGE(PG8_SB(0, 0), cB, voffB); PG8_STAGE(PG8_SA(0, 0), cA, voffA); PG8_STAGE(PG8_SB(0, 1), cB + hstepB, voffB); PG8_STAGE(PG8_SA(0, 1), cA + hstepA, voffA);
  if (wr == 1) PG8_BAR;
  PG8_WAIT_V(4); PG8_BAR;
  PG8_STAGE(PG8_SB(1, 0), cB + kstep, voffB); PG8_STAGE(PG8_SA(1, 0), cA + kstep, voffA); PG8_STAGE(PG8_SB(1, 1), cB + hstepB + kstep, voffB);
  PG8_WAIT_V(6); PG8_BAR;
  for (;;) {
    const bool has_next = S.next(ui + 1, nxt);
    const char* nA = has_next ? a_tile_ptr<ROWMODE>(g, nxt.pm) : cA; const char* nB = has_next ? (const char*)g.Bt + (size_t)nxt.pn * 2 * hstepB : cB;
    for (int t = 0; t < nt; t += 2) {
      const bool last = (t == nt - 2);
      const char* a1 = cA + (size_t)(t + 1) * kstep;
      const char* a2 = last ? nA : cA + (size_t)(t + 2) * kstep; const char* b2 = last ? nB : cB + (size_t)(t + 2) * kstep;
      const char* a3 = a2 + kstep; const char* b3 = b2 + kstep;
      PG8_LDB(B0, 0, 0); PG8_SCHED; PG8_LDA(At, 0, 0); PG8_STAGE(PG8_SA(1, 1), a1 + hstepA, voffA);
      PG8_WAIT_L(8); PG8_BAR; PG8_WAIT_L(0); PG8_MMA(0, 0, At, B0); PG8_BAR; PG8_SCHED;
      PG8_LDB(B1, 0, 1); PG8_STAGE(PG8_SB(0, 0), b2, voffB);
      PG8_BAR; PG8_WAIT_L(0); PG8_MMA(0, 1, At, B1); PG8_BAR;
      PG8_LDA(At, 0, 1); PG8_STAGE(PG8_SA(0, 0), a2, voffA);
      PG8_BAR; PG8_WAIT_L(0); PG8_MMA(1, 0, At, B0); PG8_BAR; PG8_SCHED;
      PG8_STAGE(PG8_SB(0, 1), b2 + hstepB, voffB);
      PG8_WAIT_V(6); PG8_BAR; PG8_MMA(1, 1, At, B1); PG8_BAR;
      PG8_LDB(B0, 1, 0); PG8_SCHED; PG8_LDA(At, 1, 0); PG8_STAGE(PG8_SA(0, 1), a2 + hstepA, voffA);
      PG8_WAIT_L(8); PG8_BAR; PG8_WAIT_L(0); PG8_MMA(0, 0, At, B0); PG8_BAR; PG8_SCHED;
      PG8_LDB(B1, 1, 1); PG8_STAGE(PG8_SB(1, 0), b3, voffB);
      PG8_BAR; PG8_WAIT_L(0); PG8_MMA(0, 1, At, B1); PG8_BAR;
      PG8_LDA(At, 1, 1); PG8_STAGE(PG8_SA(1, 0), a3, voffA);
      PG8_BAR; PG8_WAIT_L(0); PG8_MMA(1, 0, At, B0); PG8_BAR; PG8_SCHED;
      PG8_STAGE(PG8_SB(1, 1), b3 + hstepB, voffB);
      PG8_WAIT_V(6); PG8_BAR; PG8_MMA(1, 1, At, B1); PG8_BAR;
    }
    epilogue<EPI>(acc, cur, ea, lds);
    if (!has_next) break;
#pragma unroll
    for (int a = 0; a < 2; ++a)
#pragma unroll
      for (int b = 0; b < 2; ++b)
#pragma unroll
        for (int m = 0; m < 4; ++m)
#pragma unroll
          for (int n = 0; n < 2; ++n) acc[a][b][m][n] = (f32x4){0.f, 0.f, 0.f, 0.f};
    cur = nxt; cA = nA; cB = nB; ++ui;
  }
  PG8_WAIT_V(0);
  if (wr == 0) PG8_BAR;
  PG8_BAR;
#undef PG8_SA
#undef PG8_SB
}

constexpr int KROW = 144, VROW = 144;
constexpr int KBUF = 64 * KROW, VBUF = 128 * VROW, ABUF = KBUF + VBUF;
constexpr float LOG2E = 1.4426950408889634f;
DI bf16x8 pack8(const f32x16& x, int s) {
  u32x4 p; p.x = cvt_pk_bf16(x[8 * s], x[8 * s + 1]); p.y = cvt_pk_bf16(x[8 * s + 2], x[8 * s + 3]); p.z = cvt_pk_bf16(x[8 * s + 4], x[8 * s + 5]); p.w = cvt_pk_bf16(x[8 * s + 6], x[8 * s + 7]);
  return __builtin_bit_cast(bf16x8, p);
}
DI void attn_phase(LAS unsigned char* lds, u16* PB, const u16* VT, float* OSV, const float* lamp, const float* subg, const float* relb, int layer, int pair_lo, int pair_hi, int wg_lo, int wg_cnt) {
  int tid = threadIdx.x; asm volatile("" : "+v"(tid));
  int bid = blockIdx.x, gdim = gridDim.x; asm volatile("" : "+s"(bid), "+s"(gdim));
  const int wid = tid >> 6, lane = tid & 63, qi = lane & 31, g = lane >> 5;
  LAS float* tab = (LAS float*)(lds + 4 * ABUF);
  LAS float* scal = tab + 264;
  const float lam_init = 0.8f - 0.6f * __expf(-0.3f * (float)layer);
  __syncthreads();
  if (wid == 0) {
    float a = lamp[lane] * lamp[64 + lane], b = lamp[128 + lane] * lamp[192 + lane];
    for (int o = 32; o > 0; o >>= 1) { a += __shfl_xor(a, o); b += __shfl_xor(b, o); }
    if (lane == 0) scal[0] = __expf(a) - __expf(b) + lam_init;
  }
  const int m_sw = (qi & 0x13) | ((qi & 4) << 1) | ((qi & 8) >> 1);
  if (bid < wg_lo || bid >= wg_lo + wg_cnt) return;
  const int xcd = bid & 7, jq = (bid - wg_lo) >> 3;
  const int per_x = wg_cnt >> 3;
  const float c1 = 0.125f * LOG2E;
  for (int pr = pair_lo + xcd; pr < pair_hi; pr += 8) {
    const int s = pr >> 2, h = pr & 3;
    for (int qb = jq; qb < 32; qb += per_x) {
      __syncthreads();
      for (int i = tid; i < 257; i += NTHREADS) {
        const int rel = i - 128, n = rel < 0 ? -rel : rel;
        int bk = n < 8 ? n : (n <= 11 ? 8 : (n <= 15 ? 9 : (n <= 22 ? 10 : (n <= 31 ? 11 : (n <= 45 ? 12 : (n <= 63 ? 13 : (n <= 90 ? 14 : 15)))))));
        if (rel > 0) bk += 16;
        tab[i] = relb[bk * 4 + h] * LOG2E;
      }
      const int q0 = qb * 256 + wid * 32;
      const size_t tokbase = (size_t)s * T;
      float* osv = OSV + ((size_t)bid * 512 + tid) * 64;
#pragma unroll 1
      for (int c = 0; c < 2; ++c) {
        bf16x8 Q[4];
        { const u16* qp = PB + (tokbase + q0 + qi) * 1024 + h * 128 + c * 64 + g * 8;
#pragma unroll
          for (int ks = 0; ks < 4; ++ks) Q[ks] = *(const bf16x8*)(qp + ks * 16); }
        f32x16 O[4];
#pragma unroll
        for (int eb = 0; eb < 4; ++eb)
#pragma unroll
          for (int i = 0; i < 16; ++i) O[eb][i] = 0.f;
        float mrun = -1e30f, lrun = 0.f;
        const u16* kg = PB + (tokbase + (tid >> 3)) * 1024 + 512 + h * 128 + c * 64 + (tid & 7) * 8;
        const u16* vg = VT + ((size_t)((s * 4 + h) * 128 + (tid >> 2))) * T + (tid & 3) * 16;
        const unsigned kl = (tid >> 3) * KROW + (tid & 7) * 16, vl = KBUF + (tid >> 2) * VROW + (tid & 3) * 32;
        u32x4 rk0, rv0, rv1, rkB, rvB0, rvB1;
        rk0 = *(const u32x4*)(kg); rv0 = *(const u32x4*)(vg); rv1 = *(const u32x4*)(vg + 8);
        rkB = *(const u32x4*)(kg + (size_t)64 * 1024); rvB0 = *(const u32x4*)(vg + 64); rvB1 = *(const u32x4*)(vg + 64 + 8);
        __syncthreads();
        *(LAS u32x4*)(lds + kl) = rk0; *(LAS u32x4*)(lds + vl) = rv0; *(LAS u32x4*)(lds + vl + 16) = rv1;
        *(LAS u32x4*)(lds + ABUF + kl) = rkB; *(LAS u32x4*)(lds + ABUF + vl) = rvB0; *(LAS u32x4*)(lds + ABUF + vl + 16) = rvB1;
        __syncthreads();
        auto compute_tile = [&](const int kt, LAS unsigned char* buf) {
          const int kmin = kt * 64;
          const int dlo = kmin + 63 - q0, dhi = kmin - (q0 + 31);
          const int bmode = dlo <= -91 ? 0 : (dhi >= 91 ? 1 : 2);
          const float bconst = bmode == 0 ? tab[0] : tab[256];
          f32x16 S[2];
          {
            bf16x8 kf[2][4];
#pragma unroll
            for (int kb = 0; kb < 2; ++kb)
#pragma unroll
              for (int ks = 0; ks < 4; ++ks) kf[kb][ks] = *(const LAS bf16x8*)(buf + (kb * 32 + m_sw) * KROW + (ks * 16 + g * 8) * 2);
            __builtin_amdgcn_sched_barrier(0);
            __builtin_amdgcn_s_setprio(1);
#pragma unroll
            for (int kb = 0; kb < 2; ++kb) {
#pragma unroll
              for (int i = 0; i < 16; ++i) S[kb][i] = 0.f;
#pragma unroll
              for (int ks = 0; ks < 4; ++ks) S[kb] = __builtin_amdgcn_mfma_f32_32x32x16_bf16(kf[kb][ks], Q[ks], S[kb], 0, 0, 0);
            }
            __builtin_amdgcn_s_setprio(0);
          }
          bf16x8 vf[2][4];
          float sc = c1, off = bconst;
          if (bmode == 2) {
#pragma unroll
            for (int kb = 0; kb < 2; ++kb)
#pragma unroll
              for (int r = 0; r < 16; ++r) {
                int rel = kmin + kb * 32 + 16 * (r >> 3) + 8 * g + (r & 7) - (q0 + qi);
                rel = rel < -128 ? -128 : (rel > 128 ? 128 : rel);
                S[kb][r] = S[kb][r] * c1 + tab[rel + 128];
              }
            sc = 1.f; off = 0.f;
          }
          float mx = -3e38f;
#pragma unroll
          for (int kb = 0; kb < 2; ++kb)
#pragma unroll
            for (int r = 0; r < 16; ++r) mx = fmaxf(mx, S[kb][r]);
          mx = fmaxf(mx, __shfl_xor(mx, 32));
          mx = mx * sc + off;
          if (__any(mx > mrun + 8.f)) {
            const float mnew = mx > mrun + 8.f ? mx : mrun;
            const float alpha = __builtin_amdgcn_exp2f(mrun - mnew);
            mrun = mnew; lrun *= alpha;
#pragma unroll
            for (int eb = 0; eb < 4; ++eb)
#pragma unroll
              for (int i = 0; i < 16; ++i) O[eb][i] *= alpha;
          }
          const float sh = off - mrun;
          float ps0 = 0.f, ps1 = 0.f, ps2 = 0.f, ps3 = 0.f;
#pragma unroll
          for (int kb = 0; kb < 2; ++kb)
#pragma unroll
            for (int r = 0; r < 16; r += 4) {
              const float p0 = __builtin_amdgcn_exp2f(S[kb][r] * sc + sh), p1 = __builtin_amdgcn_exp2f(S[kb][r + 1] * sc + sh), p2 = __builtin_amdgcn_exp2f(S[kb][r + 2] * sc + sh), p3 = __builtin_amdgcn_exp2f(S[kb][r + 3] * sc + sh);
              S[kb][r] = p0; S[kb][r + 1] = p1; S[kb][r + 2] = p2; S[kb][r + 3] = p3; ps0 += p0; ps1 += p1; ps2 += p2; ps3 += p3;
            }
          lrun += (ps0 + ps1) + (ps2 + ps3);
          __builtin_amdgcn_sched_barrier(0);
          __builtin_amdgcn_s_setprio(1);
#pragma unroll
          for (int eb = 0; eb < 4; ++eb) vf[0][eb] = *(const LAS bf16x8*)(buf + KBUF + (eb * 32 + qi) * VROW + (g * 8) * 2);
#pragma unroll
          for (int stp = 0; stp < 4; ++stp) {
            const int kb = stp >> 1, hh = stp & 1;
            if (stp < 3) {
#pragma unroll
              for (int eb = 0; eb < 4; ++eb) vf[(stp + 1) & 1][eb] = *(const LAS bf16x8*)(buf + KBUF + (eb * 32 + qi) * VROW + ((stp + 1) * 16 + g * 8) * 2);
            }
            const bf16x8 pb = pack8(S[kb], hh);
#pragma unroll
            for (int eb = 0; eb < 4; ++eb) O[eb] = __builtin_amdgcn_mfma_f32_32x32x16_bf16(vf[stp & 1][eb], pb, O[eb], 0, 0, 0);
          }
          __builtin_amdgcn_s_setprio(0);
        };
        { const u16* kg2 = kg + (size_t)2 * 64 * 1024; const u16* vg2 = vg + 128;
          rk0 = *(const u32x4*)(kg2); rv0 = *(const u32x4*)(vg2); rv1 = *(const u32x4*)(vg2 + 8);
          const u16* kg3 = kg + (size_t)3 * 64 * 1024; const u16* vg3 = vg + 192;
          rkB = *(const u32x4*)(kg3); rvB0 = *(const u32x4*)(vg3); rvB1 = *(const u32x4*)(vg3 + 8); }
#pragma unroll 1
        for (int kt = 0; kt < 128; kt += 2) {
          LAS unsigned char* buf = lds + ((kt >> 1) & 1) * 2 * ABUF;
          LAS unsigned char* nbuf = lds + (((kt >> 1) + 1) & 1) * 2 * ABUF;
          compute_tile(kt, buf);
          compute_tile(kt + 1, buf + ABUF);
          *(LAS u32x4*)(nbuf + kl) = rk0; *(LAS u32x4*)(nbuf + vl) = rv0; *(LAS u32x4*)(nbuf + vl + 16) = rv1;
          *(LAS u32x4*)(nbuf + ABUF + kl) = rkB; *(LAS u32x4*)(nbuf + ABUF + vl) = rvB0; *(LAS u32x4*)(nbuf + ABUF + vl + 16) = rvB1;
          { const int tn = kt + 4 < 128 ? kt + 4 : 127; const u16* kg2 = kg + (size_t)tn * 64 * 1024; const u16* vg2 = vg + tn * 64;
            rk0 = *(const u32x4*)(kg2); rv0 = *(const u32x4*)(vg2); rv1 = *(const u32x4*)(vg2 + 8); }
          { const int tn = kt + 5 < 128 ? kt + 5 : 127; const u16* kg2 = kg + (size_t)tn * 64 * 1024; const u16* vg2 = vg + tn * 64;
            rkB = *(const u32x4*)(kg2); rvB0 = *(const u32x4*)(vg2); rvB1 = *(const u32x4*)(vg2 + 8); }
          __syncthreads();
        }
        const float lt = lrun + __shfl_xor(lrun, 32);
        asm volatile("" : "+v"(osv));
        if (c == 0) {
          const float i0 = 1.f / lt;
#pragma unroll
          for (int eb = 0; eb < 4; ++eb)
#pragma unroll
            for (int i = 0; i < 16; i += 4) { f32x4 t4; t4[0] = O[eb][i] * i0; t4[1] = O[eb][i + 1] * i0; t4[2] = O[eb][i + 2] * i0; t4[3] = O[eb][i + 3] * i0; *(f32x4*)(osv + eb * 16 + i) = t4; }
        } else {
          const float i1 = scal[0] / lt;
          float ss = 0.f;
#pragma unroll
          for (int eb = 0; eb < 4; ++eb)
#pragma unroll
            for (int i = 0; i < 16; i += 4) { const f32x4 t4 = *(const f32x4*)(osv + eb * 16 + i);
#pragma unroll
              for (int j = 0; j < 4; ++j) { const float o = t4[j] - O[eb][i + j] * i1; O[eb][i + j] = o; ss += o * o; } }
          ss += __shfl_xor(ss, 32);
          const float rs = rsqrtf(ss * (1.f / 128.f) + LN_EPS) * (1.f - lam_init);
          u16* op = PB + (tokbase + q0 + qi) * 1024 + h * 128;
#pragma unroll
          for (int eb = 0; eb < 4; ++eb)
#pragma unroll
            for (int rr = 0; rr < 4; ++rr) {
              const int e = eb * 32 + 8 * rr + 4 * g;
              const f32x4 gg = *(const f32x4*)(subg + e);
              u32x2 pk; pk.x = cvt_pk_bf16(O[eb][4 * rr] * rs * gg[0], O[eb][4 * rr + 1] * rs * gg[1]); pk.y = cvt_pk_bf16(O[eb][4 * rr + 2] * rs * gg[2], O[eb][4 * rr + 3] * rs * gg[3]);
              *(u32x2*)(op + e) = pk;
            }
        }
      }
    }
  }
}

DI float softplusf_(float x) { return fmaxf(x, 0.f) + __logf(1.f + __expf(-fabsf(x))); }
DI void load_bf16x8(const u16* p, float (&o)[8]) {
  const u32x4 v = *(const u32x4*)p;
#pragma unroll
  for (int i = 0; i < 4; ++i) { o[2 * i] = __uint_as_float(v[i] << 16); o[2 * i + 1] = __uint_as_float(v[i] & 0xffff0000u); }
}
DI void shifted8(const u16* PA, size_t row, int t, int col, const float* mu0, const float* mu1, float (&o)[8]) {
  float c[8], pv[8], nx[8];
  load_bf16x8(PA + row * A_COLS + col, c);
  if (t > 0) load_bf16x8(PA + (row - 1) * A_COLS + col, pv); else { for (int i = 0; i < 8; ++i) pv[i] = 0.f; }
  if (t < T - 1) load_bf16x8(PA + (row + 1) * A_COLS + col, nx); else { for (int i = 0; i < 8; ++i) nx[i] = 0.f; }
#pragma unroll
  for (int i = 0; i < 8; ++i) o[i] = c[i] + mu0[col + i] * (pv[i] - c[i]) + mu1[col + i] * (nx[i] - c[i]);
}

DI void vprep_phase(LAS unsigned char* lds, const u16* PA, u16* VV, const float* mu, const float* vdown, const float* vup, const float* v0, int layer) {
  int tid = threadIdx.x; asm volatile("" : "+v"(tid));
  int bid = blockIdx.x, gdim = gridDim.x; asm volatile("" : "+s"(bid), "+s"(gdim));
  const int tok = tid >> 4, j = tid & 15;
  LAS unsigned* VS2 = (LAS unsigned*)lds;
  LAS unsigned* DD2 = VS2 + 32 * 256;
  LAS unsigned* DN2 = DD2 + 32 * 16;
  LAS unsigned* UP2 = DN2 + 256 * 32;
  const float* mu0 = mu; const float* mu1 = mu + A_COLS;
  __syncthreads();
  if (layer != 0) {
    for (int e = tid; e < 256 * 32; e += NTHREADS) { const int c2 = e >> 5, r = e & 31; DN2[e] = cvt_pk_bf16(vdown[(2 * c2) * 32 + r], vdown[(2 * c2 + 1) * 32 + r]); }
    for (int e = tid; e < 16 * 512; e += NTHREADS) { const int r2 = e >> 9, c = e & 511; UP2[(r2 * 2 + ((c >> 2) & 1)) * 256 + (c >> 3) * 4 + (c & 3)] = cvt_pk_bf16(vup[(2 * r2) * 512 + c], vup[(2 * r2 + 1) * 512 + c]); }
  }
  for (int it = bid; it < NT / 32; it += gdim) {
    const size_t row = (size_t)it * 32 + tok; const int t = (int)(row % T);
    __syncthreads();
#pragma unroll 1
    for (int q = 0; q < 4; ++q) {
      const int cc = q * 128 + j * 8;
      float o[8]; shifted8(PA, row, t, OFF_V + cc, mu0, mu1, o);
      u32x4 pk; pk.x = cvt_pk_bf16(o[0], o[1]); pk.y = cvt_pk_bf16(o[2], o[3]); pk.z = cvt_pk_bf16(o[4], o[5]); pk.w = cvt_pk_bf16(o[6], o[7]);
      if (layer == 0) *(u32x4*)(VV + row * 512 + cc) = pk;
      else *(LAS u32x4*)(VS2 + tok * 256 + (cc >> 1)) = pk;
    }
    if (layer == 0) continue;
    __syncthreads();
    {
      float d0 = 0.f, d1 = 0.f;
#pragma unroll 8
      for (int c2 = 0; c2 < 256; ++c2) {
        const bf2 x = __builtin_bit_cast(bf2, VS2[tok * 256 + c2]);
        const u32x2 w2 = *(const LAS u32x2*)(DN2 + c2 * 32 + 2 * j);
        unsigned ua = w2.x, ub = w2.y; asm volatile("" : "+v"(ua), "+v"(ub));
        d0 = __builtin_amdgcn_fdot2_f32_bf16(x, __builtin_bit_cast(bf2, ua), d0, false); d1 = __builtin_amdgcn_fdot2_f32_bf16(x, __builtin_bit_cast(bf2, ub), d1, false);
      }
      DD2[tok * 16 + j] = cvt_pk_bf16(d0, d1);
    }
    __syncthreads();
#pragma unroll 1
    for (int q = 0; q < 4; ++q) {
      const int c0 = q * 128 + j * 8;
      float acc[8];
      { const f32x4 a0 = *(const f32x4*)(v0 + c0), a1 = *(const f32x4*)(v0 + c0 + 4);
#pragma unroll
        for (int i = 0; i < 4; ++i) { acc[i] = a0[i]; acc[4 + i] = a1[i]; } }
#pragma unroll 4
      for (int r2 = 0; r2 < 16; ++r2) {
        const bf2 dv = __builtin_bit_cast(bf2, DD2[tok * 16 + r2]);
        const u32x4 wa = *(const LAS u32x4*)(UP2 + (r2 * 2 + 0) * 256 + (c0 >> 3) * 4), wb = *(const LAS u32x4*)(UP2 + (r2 * 2 + 1) * 256 + (c0 >> 3) * 4);
#pragma unroll
        for (int i = 0; i < 4; ++i) { unsigned ua = wa[i], ub = wb[i]; asm volatile("" : "+v"(ua), "+v"(ub));
          acc[i] = __builtin_amdgcn_fdot2_f32_bf16(dv, __builtin_bit_cast(bf2, ua), acc[i], false); acc[4 + i] = __builtin_amdgcn_fdot2_f32_bf16(dv, __builtin_bit_cast(bf2, ub), acc[4 + i], false); }
      }
      float vf[8]; load_bf16x8(VV + row * 512 + c0, vf);
      const u32x4 xs = *(const LAS u32x4*)(VS2 + tok * 256 + (c0 >> 1));
      float x[8];
#pragma unroll
      for (int i = 0; i < 4; ++i) { unsigned u = xs[i]; asm volatile("" : "+v"(u)); x[2 * i] = __uint_as_float(u << 16); x[2 * i + 1] = __uint_as_float(u & 0xffff0000u); }
      float o[8];
#pragma unroll
      for (int i = 0; i < 8; ++i) o[i] = x[i] + (vf[i] - x[i]) * sigmoidf_(acc[i]);
      u32x4 pk; pk.x = cvt_pk_bf16(o[0], o[1]); pk.y = cvt_pk_bf16(o[2], o[3]); pk.z = cvt_pk_bf16(o[4], o[5]); pk.w = cvt_pk_bf16(o[6], o[7]);
      *(u32x4*)(VV + row * 512 + c0) = pk;
    }
  }
}

struct ScanW { const float *mu, *w0, *du, *a0, *iu, *kk_, *ka, *rk; };
constexpr int SC = 32;
DI float quad_sum(float x) {
  x += __builtin_bit_cast(float, __builtin_amdgcn_update_dpp(0, __builtin_bit_cast(int, x), 0xB1, 0xf, 0xf, true));
  x += __builtin_bit_cast(float, __builtin_amdgcn_update_dpp(0, __builtin_bit_cast(int, x), 0x4E, 0xf, 0xf, true));
  return x;
}
#define BFLO(x) __uint_as_float((x) << 16)
#define BFHI(x) __uint_as_float((x) & 0xffff0000u)
DI float tanh_fast(float x) { x = fminf(fmaxf(x, -15.f), 15.f); const float t = __expf(2.f * x); return (t - 1.f) / (t + 1.f); }
DI float shift1(float c, float p, float n, float m0, float m1) { return c + m0 * (p - c) + m1 * (n - c); }
DI void scan_produce(LAS float* buf, LAS unsigned* TW, LAS unsigned* TA, LAS const unsigned* DU, LAS const unsigned* IU, const u16* PA, const u16* VV, float* BON,
                     const ScanW& w, int ptid, int sq, int h, int dir, int t0) {
  const int tok = ptid >> 3, j = ptid & 7;
  const int t = t0 + tok; const size_t row = (size_t)sq * T + t;
  const float* mu0 = w.mu; const float* mu1 = w.mu + A_COLS;
  const int cr = h * 64 + j * 8, ck = OFF_K + cr, cw_ = OFF_WD + dir * 32 + j * 4, ca_ = OFF_AD + dir * 32 + j * 4;
  const u16* pc = PA + row * A_COLS;
  const bool hp = t > 0, hn = t < T - 1;
  {
    const u32x2 w_c = *(const u32x2*)(pc + cw_), a_c = *(const u32x2*)(pc + ca_);
    u32x2 w_p = (u32x2){0u, 0u}, a_p = w_p, w_n = w_p, a_n = w_p;
    if (hp) { w_p = *(const u32x2*)(pc - A_COLS + cw_); a_p = *(const u32x2*)(pc - A_COLS + ca_); }
    if (hn) { w_n = *(const u32x2*)(pc + A_COLS + cw_); a_n = *(const u32x2*)(pc + A_COLS + ca_); }
    const f32x4 mw0 = *(const f32x4*)(mu0 + cw_), mw1 = *(const f32x4*)(mu1 + cw_), ma0 = *(const f32x4*)(mu0 + ca_), ma1 = *(const f32x4*)(mu1 + ca_);
    f32x4 tw, ta;
#pragma unroll
    for (int i = 0; i < 2; ++i) {
      tw[2 * i] = tanh_fast(shift1(BFLO(w_c[i]), BFLO(w_p[i]), BFLO(w_n[i]), mw0[2 * i], mw1[2 * i]));
      tw[2 * i + 1] = tanh_fast(shift1(BFHI(w_c[i]), BFHI(w_p[i]), BFHI(w_n[i]), mw0[2 * i + 1], mw1[2 * i + 1]));
      ta[2 * i] = shift1(BFLO(a_c[i]), BFLO(a_p[i]), BFLO(a_n[i]), ma0[2 * i], ma1[2 * i]);
      ta[2 * i + 1] = shift1(BFHI(a_c[i]), BFHI(a_p[i]), BFHI(a_n[i]), ma0[2 * i + 1], ma1[2 * i + 1]);
    }
    u32x2 tw2, ta2; tw2.x = cvt_pk_bf16(tw[0], tw[1]); tw2.y = cvt_pk_bf16(tw[2], tw[3]); ta2.x = cvt_pk_bf16(ta[0], ta[1]); ta2.y = cvt_pk_bf16(ta[2], ta[3]);
    *(LAS u32x2*)(TW + tok * 16 + j * 2) = tw2; *(LAS u32x2*)(TA + tok * 16 + j * 2) = ta2;
  }
  asm volatile("s_waitcnt lgkmcnt(0)" ::: "memory");
  float wl[8], al[8];
  const int cc = j * 8, cg_ = h * 64 + cc;
  { const f32x4 x0 = *(const f32x4*)(w.w0 + dir * 512 + cg_), x1 = *(const f32x4*)(w.w0 + dir * 512 + cg_ + 4), y0 = *(const f32x4*)(w.a0 + dir * 512 + cg_), y1 = *(const f32x4*)(w.a0 + dir * 512 + cg_ + 4);
#pragma unroll
    for (int q = 0; q < 4; ++q) { wl[q] = x0[q]; wl[4 + q] = x1[q]; al[q] = y0[q]; al[4 + q] = y1[q]; } }
#pragma unroll 2
  for (int pr = 0; pr < 16; ++pr) {
    const bf2 twp = __builtin_bit_cast(bf2, TW[tok * 16 + pr]), tap = __builtin_bit_cast(bf2, TA[tok * 16 + pr]);
    const u32x4 d0 = *(const LAS u32x4*)(DU + pr * 64 + cc), d1 = *(const LAS u32x4*)(DU + pr * 64 + cc + 4), i0 = *(const LAS u32x4*)(IU + pr * 64 + cc), i1 = *(const LAS u32x4*)(IU + pr * 64 + cc + 4);
#pragma unroll
    for (int q = 0; q < 4; ++q) {
      unsigned ua = d0[q], ub = d1[q], uc = i0[q], ud = i1[q]; asm volatile("" : "+v"(ua), "+v"(ub), "+v"(uc), "+v"(ud));
      wl[q] = __builtin_amdgcn_fdot2_f32_bf16(twp, __builtin_bit_cast(bf2, ua), wl[q], false); wl[4 + q] = __builtin_amdgcn_fdot2_f32_bf16(twp, __builtin_bit_cast(bf2, ub), wl[4 + q], false);
      al[q] = __builtin_amdgcn_fdot2_f32_bf16(tap, __builtin_bit_cast(bf2, uc), al[q], false); al[4 + q] = __builtin_amdgcn_fdot2_f32_bf16(tap, __builtin_bit_cast(bf2, ud), al[4 + q], false);
    }
  }
#pragma unroll
  for (int q = 0; q < 8; ++q) { asm volatile("" : "+v"(wl[q]), "+v"(al[q])); }
  LAS float* AW = buf; LAS float* AK = buf + 2048; LAS float* AB = buf + 4096; LAS float* AD = buf + 6144; LAS float* AR = buf + 8192; LAS float* AV = buf + 10240;
  const int o = tok * 64 + cc;
  float ss = 0.f, bs = 0.f;
  float ok[8], av[8];
#pragma unroll
  for (int hq = 0; hq < 2; ++hq) {
    const int c4 = 4 * hq;
    const u32x2 r_c = *(const u32x2*)(pc + cr + c4), k_c = *(const u32x2*)(pc + ck + c4);
    u32x2 r_p = (u32x2){0u, 0u}, k_p = r_p, r_n = r_p, k_n = r_p;
    if (hp) { r_p = *(const u32x2*)(pc - A_COLS + cr + c4); k_p = *(const u32x2*)(pc - A_COLS + ck + c4); }
    if (hn) { r_n = *(const u32x2*)(pc + A_COLS + cr + c4); k_n = *(const u32x2*)(pc + A_COLS + ck + c4); }
    const u32x2 v_c = *(const u32x2*)(VV + row * 512 + cr + c4);
    const f32x4 mr0 = *(const f32x4*)(mu0 + cr + c4), mr1 = *(const f32x4*)(mu1 + cr + c4), mk0 = *(const f32x4*)(mu0 + ck + c4), mk1 = *(const f32x4*)(mu1 + ck + c4);
    const f32x4 kk4 = *(const f32x4*)(w.kk_ + cg_ + c4), ka4 = *(const f32x4*)(w.ka + cg_ + c4), rk4 = *(const f32x4*)(w.rk + cg_ + c4);
    f32x4 rv, kv, vv, ow, od;
#pragma unroll
    for (int i = 0; i < 2; ++i) {
      rv[2 * i] = shift1(BFLO(r_c[i]), BFLO(r_p[i]), BFLO(r_n[i]), mr0[2 * i], mr1[2 * i]);
      rv[2 * i + 1] = shift1(BFHI(r_c[i]), BFHI(r_p[i]), BFHI(r_n[i]), mr0[2 * i + 1], mr1[2 * i + 1]);
      kv[2 * i] = shift1(BFLO(k_c[i]), BFLO(k_p[i]), BFLO(k_n[i]), mk0[2 * i], mk1[2 * i]);
      kv[2 * i + 1] = shift1(BFHI(k_c[i]), BFHI(k_p[i]), BFHI(k_n[i]), mk0[2 * i + 1], mk1[2 * i + 1]);
      vv[2 * i] = BFLO(v_c[i]); vv[2 * i + 1] = BFHI(v_c[i]);
    }
#pragma unroll
    for (int q = 0; q < 4; ++q) {
      const float wlog = -softplusf_(-wl[c4 + q]) - 0.5f;
      ow[q] = __expf(-__expf(wlog));
      const float a = sigmoidf_(al[c4 + q]);
      av[c4 + q] = a;
      ok[c4 + q] = kv[q] * kk4[q]; ss += ok[c4 + q] * ok[c4 + q];
      od[q] = kv[q] * (1.f + (a - 1.f) * ka4[q]);
      bs += rv[q] * od[q] * rk4[q];
    }
    *(LAS f32x4*)(AW + o + c4) = ow; *(LAS f32x4*)(AD + o + c4) = od; *(LAS f32x4*)(AR + o + c4) = rv; *(LAS f32x4*)(AV + o + c4) = vv;
  }
#pragma unroll
  for (int sft = 1; sft < 8; sft <<= 1) { ss += __shfl_xor(ss, sft); bs += __shfl_xor(bs, sft); }
  const float rn = rsqrtf(ss + 1e-12f);
#pragma unroll
  for (int hq = 0; hq < 2; ++hq) {
    f32x4 k4, b4;
#pragma unroll
    for (int q = 0; q < 4; ++q) { k4[q] = ok[4 * hq + q] * rn; b4[q] = k4[q] * av[4 * hq + q]; }
    *(LAS f32x4*)(AK + o + 4 * hq) = k4; *(LAS f32x4*)(AB + o + 4 * hq) = b4;
  }
  if (j == 0) BON[((size_t)dir * NT + row) * 8 + h] = bs;
}
struct ScanOps { f32x4 k4[4], w4[4], b4[4], d4[4]; float vi; };
DI void scan_load(ScanOps& o, LAS const float* buf, int tt, int jseg, int irow) {
  const int off = tt * 64 + jseg * 16;
#pragma unroll
  for (int q = 0; q < 4; ++q) {
    o.w4[q] = *(const LAS f32x4*)(buf + off + q * 4); o.k4[q] = *(const LAS f32x4*)(buf + 2048 + off + q * 4); o.b4[q] = *(const LAS f32x4*)(buf + 4096 + off + q * 4);
    o.d4[q] = *(const LAS f32x4*)(buf + 6144 + off + q * 4);
  }
  o.vi = buf[10240 + tt * 64 + irow];
}
DI float scan_step(f32x4 (&S)[4], const ScanOps& o, LAS const float* buf, int tt, int jseg) {
  f32x4 r4[4];
#pragma unroll
  for (int q = 0; q < 4; ++q) r4[q] = *(const LAS f32x4*)(buf + 8192 + tt * 64 + jseg * 16 + q * 4);
  f32x4 a4 = S[0] * o.k4[0] + S[1] * o.k4[1] + S[2] * o.k4[2] + S[3] * o.k4[3];
  float sa = -quad_sum((a4[0] + a4[1]) + (a4[2] + a4[3]));
  f32x4 y4 = (f32x4){0.f, 0.f, 0.f, 0.f};
#pragma unroll
  for (int q = 0; q < 4; ++q) { S[q] = S[q] * o.w4[q] + (o.b4[q] * sa + o.d4[q] * o.vi); y4 += S[q] * r4[q]; }
  return quad_sum((y4[0] + y4[1]) + (y4[2] + y4[3]));
}
DI void scan_phase(LAS unsigned char* lds, const u16* PA, const u16* VV, u16* YY, float* BON, const ScanW w) {
  int tid = threadIdx.x; asm volatile("" : "+v"(tid));
  int bid = blockIdx.x, gdim = gridDim.x; asm volatile("" : "+s"(bid), "+s"(gdim));
  LAS float* BUF = (LAS float*)lds;
  LAS float* AY = BUF + 2 * 12288;
  LAS unsigned* TW = (LAS unsigned*)(AY + 2 * 2048);
  LAS unsigned* TA = TW + SC * 16;
  LAS unsigned* DU = TA + SC * 16;
  LAS unsigned* IU = DU + 1024;
  const int wid = __builtin_amdgcn_readfirstlane(tid >> 6), lane = tid & 63;
  const int NCH = T / SC;
  for (int item = bid; item < 192; item += gdim) {
    const int dir = item & 1, h = (item >> 1) & 7, sq = item >> 4;
    __syncthreads();
    for (int i = tid; i < 1024; i += NTHREADS) { const int pr = i >> 6, c = i & 63; const size_t o0 = (size_t)(dir * 32 + 2 * pr) * 512 + h * 64 + c;
      DU[i] = cvt_pk_bf16(w.du[o0], w.du[o0 + 512]); IU[i] = cvt_pk_bf16(w.iu[o0], w.iu[o0 + 512]); }
    __syncthreads();
    f32x4 S[4];
#pragma unroll
    for (int q = 0; q < 4; ++q) S[q] = (f32x4){0.f, 0.f, 0.f, 0.f};
    const int irow = (wid & 3) * 16 + (lane >> 2), jseg = lane & 3;
    if (wid >= 4) scan_produce(BUF, TW, TA, DU, IU, PA, VV, BON, w, tid - 256, sq, h, dir, dir == 0 ? 0 : T - SC);
    __syncthreads();
#pragma unroll 1
    for (int ci = 0; ci < NCH; ++ci) {
      LAS float* buf = BUF + (ci & 1) * 12288;
      LAS float* ay = AY + (ci & 1) * 2048;
      if (wid < 4) {
        ScanOps o0, o1;
        scan_load(o0, buf, dir == 0 ? 0 : SC - 1, jseg, irow);
#pragma unroll 1
        for (int st = 0; st < SC; st += 2) {
          const int t0_ = dir == 0 ? st : SC - 1 - st, t1_ = dir == 0 ? st + 1 : SC - 2 - st;
          scan_load(o1, buf, t1_, jseg, irow);
          const float y0 = scan_step(S, o0, buf, t0_, jseg);
          if (jseg == 0) ay[t0_ * 64 + irow] = y0;
          if (st + 2 < SC) scan_load(o0, buf, dir == 0 ? st + 2 : SC - 3 - st, jseg, irow);
          const float y1 = scan_step(S, o1, buf, t1_, jseg);
          if (jseg == 0) ay[t1_ * 64 + irow] = y1;
        }
      } else {
        const int ptid = tid - 256;
        if (ci + 1 < NCH) scan_produce(BUF + ((ci + 1) & 1) * 12288, TW, TA, DU, IU, PA, VV, BON, w, ptid, sq, h, dir, dir == 0 ? (ci + 1) * SC : T - SC * (ci + 2));
        if (ci > 0) {
          LAS const float* py = AY + ((ci - 1) & 1) * 2048;
          const int t0p = dir == 0 ? (ci - 1) * SC : T - SC * ci;
          const int tok = ptid >> 3, c0 = (ptid & 7) * 8;
          const f32x4 ya = *(const LAS f32x4*)(py + tok * 64 + c0), yb = *(const LAS f32x4*)(py + tok * 64 + c0 + 4);
          u32x4 pk; pk.x = cvt_pk_bf16(ya[0], ya[1]); pk.y = cvt_pk_bf16(ya[2], ya[3]); pk.z = cvt_pk_bf16(yb[0], yb[1]); pk.w = cvt_pk_bf16(yb[2], yb[3]);
          *(u32x4*)(YY + ((size_t)dir * NT + (size_t)sq * T + t0p + tok) * 512 + h * 64 + c0) = pk;
        }
      }
      __syncthreads();
    }
    if (wid >= 4) {
      const int ptid = tid - 256;
      LAS const float* py = AY + ((NCH - 1) & 1) * 2048;
      const int t0p = dir == 0 ? (NCH - 1) * SC : 0;
      const int tok = ptid >> 3, c0 = (ptid & 7) * 8;
      const f32x4 ya = *(const LAS f32x4*)(py + tok * 64 + c0), yb = *(const LAS f32x4*)(py + tok * 64 + c0 + 4);
      u32x4 pk; pk.x = cvt_pk_bf16(ya[0], ya[1]); pk.y = cvt_pk_bf16(ya[2], ya[3]); pk.z = cvt_pk_bf16(yb[0], yb[1]); pk.w = cvt_pk_bf16(yb[2], yb[3]);
      *(u32x4*)(YY + ((size_t)dir * NT + (size_t)sq * T + t0p + tok) * 512 + h * 64 + c0) = pk;
    }
  }
}

DI void post_phase(LAS unsigned char* lds, u16* PA, const u16* PB, const u16* VV, const u16* YY, const float* BON, const float* mu, const float* gup, const float* gng, const float* gnb) {
  int tid = threadIdx.x; asm volatile("" : "+v"(tid));
  int bid = blockIdx.x, gdim = gridDim.x; asm volatile("" : "+s"(bid), "+s"(gdim));
  const int tok = tid >> 4, j = tid & 15;
  LAS unsigned* SG2 = (LAS unsigned*)lds;
  LAS unsigned* GU = (LAS unsigned*)(lds + 16384);
  const float* mu0 = mu; const float* mu1 = mu + A_COLS;
  __syncthreads();
  for (int e = tid; e < 48 * 512; e += NTHREADS) { const int r2 = e >> 9, c = e & 511; GU[(r2 * 2 + ((c >> 2) & 1)) * 256 + (c >> 3) * 4 + (c & 3)] = cvt_pk_bf16(gup[(2 * r2) * 512 + c], gup[(2 * r2 + 1) * 512 + c]); }
  for (int it = bid; it < NT / 32; it += gdim) {
    const size_t row = (size_t)it * 32 + tok; const int t = (int)(row % T);
    __syncthreads();
    { float sv[6];
#pragma unroll
      for (int q = 0; q < 6; ++q) {
        const int col = OFF_GD + j * 6 + q;
        const float c = bf2f(PA[row * A_COLS + col]);
        const float pv = t > 0 ? bf2f(PA[(row - 1) * A_COLS + col]) : 0.f, nx = t < T - 1 ? bf2f(PA[(row + 1) * A_COLS + col]) : 0.f;
        sv[q] = sigmoidf_(c + mu0[col] * (pv - c) + mu1[col] * (nx - c));
      }
#pragma unroll
      for (int pq = 0; pq < 3; ++pq) SG2[tok * 48 + j * 3 + pq] = cvt_pk_bf16(sv[2 * pq], sv[2 * pq + 1]); }
    __syncthreads();
#pragma unroll 1
    for (int q = 0; q < 4; ++q) {
      const int cc = q * 128 + j * 8, h = 2 * q + (j >> 3);
      float y[8]; float sm = 0.f;
      { float a[8], b[8]; load_bf16x8(YY + row * 512 + cc, a); load_bf16x8(YY + ((size_t)NT + row) * 512 + cc, b);
#pragma unroll
        for (int i = 0; i < 8; ++i) { y[i] = a[i] + b[i]; sm += y[i]; } }
      sm += __shfl_xor(sm, 1); sm += __shfl_xor(sm, 2); sm += __shfl_xor(sm, 4);
      const float mean = sm * (1.f / 64.f);
      float vq = 0.f;
#pragma unroll
      for (int i = 0; i < 8; ++i) { y[i] -= mean; vq += y[i] * y[i]; }
      vq += __shfl_xor(vq, 1); vq += __shfl_xor(vq, 2); vq += __shfl_xor(vq, 4);
      const float rs = rsqrtf(vq * (1.f / 64.f) + GN_EPS);
      const float bon = BON[row * 8 + h] + BON[((size_t)NT + row) * 8 + h];
      float gacc[8];
#pragma unroll
      for (int i = 0; i < 8; ++i) gacc[i] = 0.f;
#pragma unroll 8
      for (int r2 = 0; r2 < 48; ++r2) {
        const bf2 sv = __builtin_bit_cast(bf2, SG2[tok * 48 + r2]);
        const u32x4 wa = *(const LAS u32x4*)(GU + (r2 * 2 + 0) * 256 + (cc >> 3) * 4), wb = *(const LAS u32x4*)(GU + (r2 * 2 + 1) * 256 + (cc >> 3) * 4);
#pragma unroll
        for (int i = 0; i < 4; ++i) { unsigned ua = wa[i], ub = wb[i]; asm volatile("" : "+v"(ua), "+v"(ub));
          gacc[i] = __builtin_amdgcn_fdot2_f32_bf16(sv, __builtin_bit_cast(bf2, ua), gacc[i], false); gacc[4 + i] = __builtin_amdgcn_fdot2_f32_bf16(sv, __builtin_bit_cast(bf2, ub), gacc[4 + i], false); }
      }
      float vv[8]; load_bf16x8(VV + row * 512 + cc, vv);
      const f32x4 g0 = *(const f32x4*)(gng + cc), g1 = *(const f32x4*)(gng + cc + 4), b0 = *(const f32x4*)(gnb + cc), b1 = *(const f32x4*)(gnb + cc + 4);
      float o[8];
#pragma unroll
      for (int i = 0; i < 4; ++i) { o[i] = (y[i] * rs * g0[i] + b0[i] + bon * vv[i]) * gacc[i]; o[4 + i] = (y[4 + i] * rs * g1[i] + b1[i] + bon * vv[4 + i]) * gacc[4 + i]; }
      u32x4 pk; pk.x = cvt_pk_bf16(o[0], o[1]); pk.y = cvt_pk_bf16(o[2], o[3]); pk.z = cvt_pk_bf16(o[4], o[5]); pk.w = cvt_pk_bf16(o[6], o[7]);
      if (DBGZ & 1) pk = (u32x4){0u, 0u, 0u, 0u};
      *(u32x4*)(PA + row * A_COLS + cc) = pk;
      u32x4 pb4 = *(const u32x4*)(PB + row * 1024 + cc); if (DBGZ & 2) pb4 = (u32x4){0u, 0u, 0u, 0u};
      *(u32x4*)(PA + row * A_COLS + 512 + cc) = pb4;
    }
  }
}

DI unsigned hashu(unsigned x) { x ^= x >> 16; x *= 0x7feb352du; x ^= x >> 15; x *= 0x846ca68bu; x ^= x >> 16; return x; }
DI void dbg_upd(float* slot, float got, float ref, float scale) { float e = fabsf(got - ref) / scale; if (!(e == e)) e = 1e9f; atomicMax((unsigned*)slot, __float_as_uint(e)); }
DI float tshift(const u16* PA, size_t row, int col, const float* mu) {
  const int t = (int)(row % T);
  const float c = bf2f(PA[row * A_COLS + col]);
  const float pv = t > 0 ? bf2f(PA[(row - 1) * A_COLS + col]) : 0.f, nx = t < T - 1 ? bf2f(PA[(row + 1) * A_COLS + col]) : 0.f;
  return c + mu[col] * (pv - c) + mu[A_COLS + col] * (nx - c);
}
DI void chk_proj(const u16* XB, const float* win, const u16* PA, const u16* PB, const u16* VT, float* slot) {
  const int gt = blockIdx.x * NTHREADS + threadIdx.x;
  if (gt >= 4096) return;
  const int row = hashu(gt * 2 + 1) % NT, col = hashu(gt * 2 + 2) % P_COLS;
  float ref = 0.f;
  for (int k = 0; k < D; ++k) ref += bf2f(XB[(size_t)row * D + k]) * win[(size_t)k * P_COLS + col];
  float got;
  if (col < A_COLS) got = bf2f(PA[(size_t)row * A_COLS + col]);
  else if (col < A_COLS + 1024) got = bf2f(PB[(size_t)row * 1024 + col - A_COLS]);
  else { const int c2 = col - A_COLS - 1024, h = c2 >> 7, e = c2 & 127, sq = row / T, t = row % T; got = bf2f(VT[((size_t)((sq * 4 + h) * 128 + e)) * T + t]); }
  dbg_upd(slot, got, ref, 1.f);
}
DI void chk_ffn(const u16* XB, const float* wup, const float* cw, const float* cb, const u16* G, float* slot) {
  const int gt = blockIdx.x * NTHREADS + threadIdx.x;
  if (gt >= 4096) return;
  int row = hashu(gt * 2 + 11) % NT; const int n = hashu(gt * 2 + 12) % DFF;
  if (gt < 64) row = (gt & 1) ? (row / T) * T + T - 1 : (row / T) * T;
  else if (gt < 1024) row = (row / T) * T + ((row % T) / 254) * 254 + (gt & 1 ? 253 : 0), row = row >= NT ? NT - 1 : row;
  const int t = row % T;
  float hg[3] = {0.f, 0.f, 0.f}, hu[3] = {0.f, 0.f, 0.f};
#pragma unroll
  for (int d = -1; d <= 1; ++d) {
    float a = 0.f, b = 0.f;
    if (!(t + d < 0 || t + d > T - 1))
      for (int k = 0; k < D; ++k) { const float x = bf2f(XB[(size_t)(row + d) * D + k]); a += x * wup[(size_t)k * NUP + n]; b += x * wup[(size_t)k * NUP + DFF + n]; }
    hg[d + 1] = a; hu[d + 1] = b;
  }
  const float got = bf2f(G[(size_t)row * DFF + n]);
  { const float g = cw[n] * hg[0] + cw[NUP + n] * hg[1] + cw[2 * NUP + n] * hg[2] + cb[n];
    const float u = cw[DFF + n] * hu[0] + cw[NUP + DFF + n] * hu[1] + cw[2 * NUP + DFF + n] * hu[2] + cb[DFF + n];
    dbg_upd(slot, got, 0.5f * g * (1.f + erff(g * 0.70710678f)) * u, 1.f); }
  { const float g = cw[n] * hg[2] + cw[NUP + n] * hg[1] + cw[2 * NUP + n] * hg[0] + cb[n];
    const float u = cw[DFF + n] * hu[2] + cw[NUP + DFF + n] * hu[1] + cw[2 * NUP + DFF + n] * hu[0] + cb[DFF + n];
    dbg_upd(slot + 1, got, 0.5f * g * (1.f + erff(g * 0.70710678f)) * u, 1.f); }
  { const float g = cw[NUP + n] * hg[1] + cb[n];
    const float u = cw[NUP + DFF + n] * hu[1] + cb[DFF + n];
    dbg_upd(slot + 2, got, 0.5f * g * (1.f + erff(g * 0.70710678f)) * u, 1.f); }
}
DI void chk_attn(LAS unsigned char* lds, const u16* XB, const float* win, const u16* PB, const u16* VT, const float* lamp, const float* subg, const float* relb, int layer, float* slot) {
  if (blockIdx.x >= 16) return;
  const int tid = threadIdx.x;
  LAS float* qv = (LAS float*)lds;
  LAS float* sc = qv + 128;
  LAS float* red = sc + 16384;
  LAS float* ov = red + 1024;
  const int smp = blockIdx.x;
  const int sq = hashu(smp + 77) % NSEQ, h = smp & 3;
  int q = hashu(smp + 99) % T; if (smp < 4) q = smp * 37; if (smp >= 12) q = T - 1 - (smp - 12) * 50;
  const size_t row = (size_t)sq * T + q;
  __syncthreads();
  if (tid < 128) { float a = 0.f; const int col = A_COLS + h * 128 + tid; for (int k = 0; k < D; ++k) a += bf2f(XB[row * D + k]) * win[(size_t)k * P_COLS + col]; qv[tid] = a; }
  __syncthreads();
  float mx0 = -1e30f, mx1 = -1e30f;
  for (int key = tid; key < T; key += NTHREADS) {
    const u16* kp = PB + ((size_t)sq * T + key) * 1024 + 512 + h * 128;
    float s0 = 0.f, s1 = 0.f;
    for (int d = 0; d < 64; ++d) { s0 += qv[d] * bf2f(kp[d]); s1 += qv[64 + d] * bf2f(kp[64 + d]); }
    const int rel = key - q, n = rel < 0 ? -rel : rel;
    int bk;
    if (n < 8) bk = n; else { bk = 8 + (int)(logf((float)n / 8.f) / logf(16.f) * 8.f); bk = bk > 15 ? 15 : bk; }
    if (rel > 0) bk += 16;
    const float bias = relb[bk * 4 + h];
    s0 = s0 * 0.125f + bias; s1 = s1 * 0.125f + bias;
    sc[key] = s0; sc[8192 + key] = s1; mx0 = fmaxf(mx0, s0); mx1 = fmaxf(mx1, s1);
  }
  red[tid] = mx0; red[512 + tid] = mx1; __syncthreads();
  for (int o = 256; o > 0; o >>= 1) { if (tid < o) { red[tid] = fmaxf(red[tid], red[tid + o]); red[512 + tid] = fmaxf(red[512 + tid], red[512 + tid + o]); } __syncthreads(); }
  mx0 = red[0]; mx1 = red[512]; __syncthreads();
  float l0 = 0.f, l1 = 0.f;
  for (int key = tid; key < T; key += NTHREADS) { const float p0 = expf(sc[key] - mx0), p1 = expf(sc[8192 + key] - mx1); sc[key] = p0; sc[8192 + key] = p1; l0 += p0; l1 += p1; }
  red[tid] = l0; red[512 + tid] = l1; __syncthreads();
  for (int o = 256; o > 0; o >>= 1) { if (tid < o) { red[tid] += red[tid + o]; red[512 + tid] += red[512 + tid + o]; } __syncthreads(); }
  l0 = red[0]; l1 = red[512]; __syncthreads();
  float la = 0.f, lb = 0.f; for (int d = 0; d < 64; ++d) { la += lamp[d] * lamp[64 + d]; lb += lamp[128 + d] * lamp[192 + d]; }
  const float lam_init = 0.8f - 0.6f * expf(-0.3f * (float)layer);
  const float lam = expf(la) - expf(lb) + lam_init;
  { const int e = tid & 127, part = tid >> 7;
    const u16* vp = VT + ((size_t)((sq * 4 + h) * 128 + e)) * T;
    float o = 0.f;
    for (int key = part * 2048; key < (part + 1) * 2048; ++key) o += (sc[key] / l0 - lam * sc[8192 + key] / l1) * bf2f(vp[key]);
    red[tid] = o; }
  __syncthreads();
  if (tid < 128) ov[tid] = red[tid] + red[128 + tid] + red[256 + tid] + red[384 + tid];
  __syncthreads();
  if (tid < 128) {
    float ss = 0.f; for (int e = 0; e < 128; ++e) ss += ov[e] * ov[e];
    const float ref = ov[tid] * rsqrtf(ss / 128.f + LN_EPS) * subg[tid] * (1.f - lam_init);
    dbg_upd(slot, bf2f(PB[row * 1024 + h * 128 + tid]), ref, 1.f);
  }
}
struct ChkOp { float r, kd, kk, b, w, v; };
DI ChkOp chk_ops(const u16* PA, const u16* VV, const ScanW& w, size_t row, int h, int dir, int c, LAS float* tmp  , int tid) {
  ChkOp o;
  const int cg_ = h * 64 + c;
  o.r = tshift(PA, row, cg_, w.mu);
  const float k = tshift(PA, row, OFF_K + cg_, w.mu);
  float wl = w.w0[dir * 512 + cg_], al = w.a0[dir * 512 + cg_];
#pragma unroll 1
  for (int rr = 0; rr < 32; ++rr) {
    wl += tanhf(tshift(PA, row, OFF_WD + dir * 32 + rr, w.mu)) * w.du[(dir * 32 + rr) * 512 + cg_];
    al += tshift(PA, row, OFF_AD + dir * 32 + rr, w.mu) * w.iu[(dir * 32 + rr) * 512 + cg_];
  }
  const float sp = logf(1.f + expf(-wl));
  o.w = expf(-expf(-sp - 0.5f));
  const float a = 1.f / (1.f + expf(-al));
  const float kkv = k * w.kk_[cg_];
  __syncthreads(); tmp[tid] = kkv * kkv; __syncthreads();
  float ss = 0.f;
#pragma unroll 1
  for (int j = 0; j < 64; ++j) ss += tmp[j];
  o.kk = kkv * rsqrtf(ss + 1e-12f);
  o.kd = k * (1.f + (a - 1.f) * w.ka[cg_]);
  o.b = o.kk * a;
  o.v = bf2f(VV[row * 512 + cg_]);
  return o;
}
DI void chk_scan(LAS unsigned char* lds, const u16* PA, const u16* VV, const u16* YY, const float* BON, const ScanW w, float* slot) {
  if (blockIdx.x >= 48 || threadIdx.x >= 64) return;
  const int tid = threadIdx.x;
  LAS float* tmp = (LAS float*)lds; LAS float* red = tmp + 64;
  const int item = blockIdx.x * 4 + 1, dir = item & 1, h = (item >> 1) & 7, sq = item >> 4;
  const int t0 = dir == 0 ? 0 : T - 1, t1 = dir == 0 ? 1 : T - 2;
  const size_t row0 = (size_t)sq * T + t0, row1 = (size_t)sq * T + t1;
  const ChkOp a = chk_ops(PA, VV, w, row0, h, dir, tid, tmp, tid);
  const ChkOp b = chk_ops(PA, VV, w, row1, h, dir, tid, tmp, tid);
#define BSUM(dst, val) { __syncthreads(); red[tid] = (val); __syncthreads(); float sx_ = 0.f; _Pragma("unroll 1") for (int j_ = 0; j_ < 64; ++j_) sx_ += red[j_]; dst = sx_; }
  float ds0, ds1, ds2, ds3, ds4;
  BSUM(ds0, a.kd * a.r) BSUM(ds1, a.kd * b.w * b.r) BSUM(ds2, a.kd * (-b.kk)) BSUM(ds3, b.b * b.r) BSUM(ds4, b.kd * b.r)
  const float y0 = a.v * ds0;
  const float y1 = a.v * (ds1 + ds2 * ds3) + b.v * ds4;
  dbg_upd(slot, bf2f(YY[((size_t)dir * NT + row0) * 512 + h * 64 + tid]), y0, fabsf(y0) + 0.05f);
  dbg_upd(slot, bf2f(YY[((size_t)dir * NT + row1) * 512 + h * 64 + tid]), y1, fabsf(y1) + 0.05f);
  float bq = a.r * a.kd * w.rk[h * 64 + tid];
  __syncthreads(); red[tid] = bq; __syncthreads(); float bs = 0.f;
#pragma unroll 1
  for (int j = 0; j < 64; ++j) bs += red[j];
  dbg_upd(slot, BON[((size_t)dir * NT + row0) * 8 + h], bs, fabsf(bs) + 0.05f);
}
DI void chk_post(const u16* PA, const u16* PB, const u16* VV, const u16* YY, const float* BON, const float* mu, const float* gup, const float* gng, const float* gnb, float* slot) {
  const int gt = blockIdx.x * NTHREADS + threadIdx.x;
  if (gt >= 2048) return;
  const size_t row = hashu(gt * 2 + 21) % NT; const int c = hashu(gt * 2 + 22) % 512, h = c >> 6;
  float sm = 0.f;
  float yc = 0.f;
  for (int i = 0; i < 64; ++i) { const float y = bf2f(YY[row * 512 + h * 64 + i]) + bf2f(YY[((size_t)NT + row) * 512 + h * 64 + i]); sm += y; if (h * 64 + i == c) yc = y; }
  const float mean = sm / 64.f; float vq = 0.f;
  for (int i = 0; i < 64; ++i) { const float y = bf2f(YY[row * 512 + h * 64 + i]) + bf2f(YY[((size_t)NT + row) * 512 + h * 64 + i]) - mean; vq += y * y; }
  const float yn = (yc - mean) * rsqrtf(vq / 64.f + GN_EPS) * gng[c] + gnb[c];
  const float bon = (BON[row * 8 + h] + BON[((size_t)NT + row) * 8 + h]) * bf2f(VV[row * 512 + c]);
  float g = 0.f;
  for (int r = 0; r < 96; ++r) g += (1.f / (1.f + expf(-tshift(PA, row, OFF_GD + r, mu)))) * gup[r * 512 + c];
  const float ref = (yn + bon) * g;
  dbg_upd(slot, bf2f(PA[row * A_COLS + c]), ref, fabsf(ref) + 0.05f);
  dbg_upd(slot + 1, bf2f(PA[row * A_COLS + 512 + c]), bf2f(PB[row * 1024 + c]), 1.f);
}

#define XB_TMO      128
#define XB_XCNT(j)  (256  + 64 * (j))
#define XB_XSUB(j)  (1280 + 64 * (j))
#define XB_XGEN(j)  (2304 + 64 * (j))
#define XB_TOP      3328
#define XB_TOPGEN   3392
#define XCD_BAR_WORDS 3456
#define XB_SPIN_CAP (1u << 18)
DI unsigned xb_ld(unsigned* p)              { return __hip_atomic_load(p, __ATOMIC_RELAXED, __HIP_MEMORY_SCOPE_AGENT); }
DI unsigned xb_add(unsigned* p, unsigned v) { return __hip_atomic_fetch_add(p, v, __ATOMIC_RELAXED, __HIP_MEMORY_SCOPE_AGENT); }
DI unsigned xb_xcc_id() { return (unsigned)__builtin_amdgcn_s_getreg((3 << 11) | 20) & 0xFu; }
#define XB_SPIN(cond, bar) do { unsigned _sp = 0; while (cond) { __builtin_amdgcn_s_sleep(1); \
    if ((++_sp & 255u) == 0u) { if (xb_ld(&(bar)[XB_TMO])) break; if (_sp > XB_SPIN_CAP) { atomicAdd(&(bar)[XB_TMO], 1u); break; } } } } while (0)
DI void xcd_census(unsigned* bar, unsigned* st) {
  if (threadIdx.x == 0) {
    const unsigned x = xb_xcc_id();
    unsigned cnt = 0u, mine = 0u;
#pragma unroll
    for (unsigned j = 0; j < 16; ++j) { const unsigned c = xb_ld(&bar[XB_XCNT(j)]); cnt += (c > 0u) ? 1u : 0u; mine = (j == x) ? c : mine; }
    st[0] = mine > 0u ? mine : 1u; st[1] = cnt > 0u ? cnt : 1u;
  }
}
DI void xcd_barrier(unsigned* bar, unsigned* st) {
  asm volatile("s_waitcnt vmcnt(0)" ::: "memory");
  __syncthreads();
  if (threadIdx.x == 0) {
    __builtin_amdgcn_s_waitcnt(0);
    const unsigned x = xb_xcc_id();
    const unsigned nloc = st[0], nx = st[1];
    const unsigned old = xb_add(&bar[XB_XSUB(x)], 1u);
    const unsigned gen = old / nloc;
    if (old + 1u == (gen + 1u) * nloc) {
      __builtin_amdgcn_fence(__ATOMIC_RELEASE, "agent");
      asm volatile("s_waitcnt vmcnt(0)" ::: "memory");
      const unsigned og = xb_add(&bar[XB_TOP], 1u);
      const unsigned tg = og / nx;
      if (og + 1u == (tg + 1u) * nx) xb_add(&bar[XB_TOPGEN], 1u);
      else XB_SPIN(xb_ld(&bar[XB_TOPGEN]) == tg, bar);
      __builtin_amdgcn_fence(__ATOMIC_ACQUIRE, "agent");
      xb_add(&bar[XB_XGEN(x)], 1u);
      asm volatile("s_waitcnt vmcnt(0)" ::: "memory");
    } else {
      XB_SPIN(xb_ld(&bar[XB_XGEN(x)]) == gen, bar);
      __builtin_amdgcn_fence(__ATOMIC_ACQUIRE, "agent");
      asm volatile("s_waitcnt vmcnt(0)" ::: "memory");
    }
  }
  __syncthreads();
}

__global__ __launch_bounds__(NTHREADS, 2) void mega(Params p_unused) {
  extern __shared__ __attribute__((aligned(16))) char shm[];
  cg::grid_group grid = cg::this_grid();
  LAS unsigned char* lds = (LAS unsigned char*)shm;
#define WS_PTRS CParams p = get_params(); unsigned char* ws = p->ws; \
  u16* WIN = (u16*)(ws + OFF_WIN); u16* WOUT = (u16*)(ws + OFF_WOUT); u16* WUP = (u16*)(ws + OFF_WUP); u16* WDN = (u16*)(ws + OFF_WDN); \
  u16* XB = (u16*)(ws + OFF_XB); u16* PA = (u16*)(ws + OFF_PA); u16* PB = (u16*)(ws + OFF_PB); u16* VT = (u16*)(ws + OFF_VT); \
  u16* G = (u16*)(ws + OFF_PA); u16* VV = (u16*)(ws + OFF_VV); u16* YY = (u16*)p->out; float* BON = (float*)(ws + OFF_BON); float* XF = p->out; \
  (void)WIN; (void)WOUT; (void)WUP; (void)WDN; (void)XB; (void)PA; (void)PB; (void)VT; (void)G; (void)VV; (void)YY; (void)BON; (void)XF;
  int ph = 0;
  const int ph_lo = get_params()->ph_lo, ph_hi = get_params()->ph_hi;
  const bool fullrun = (ph_lo == 0 && ph_hi >= 1000);
  if (fullrun && threadIdx.x == 0) (void)xb_add((unsigned*)(get_params()->ws + OFF_XBAR) + XB_XCNT(xb_xcc_id()), 1u);
#define GSYNC() do { if (!fullrun || ph == 1) { grid.sync(); if (fullrun) xcd_census((unsigned*)(get_params()->ws + OFF_XBAR), (unsigned*)(get_params()->ws + OFF_XBAR) + XCD_BAR_WORDS + 2 * blockIdx.x); } \
    else xcd_barrier((unsigned*)(get_params()->ws + OFF_XBAR), (unsigned*)(get_params()->ws + OFF_XBAR) + XCD_BAR_WORDS + 2 * blockIdx.x); } while (0)
#ifndef ONLYMASK
#define ONLYMASK 0xffffffffu
#endif
#define PHASE_BEGIN if (((ONLYMASK >> (__COUNTER__ % 32)) & 1u) && ph >= ph_lo && ph < ph_hi) { WS_PTRS
#define PHASE_END } ++ph; if (ph > ph_lo && ph < ph_hi) GSYNC();

  PHASE_BEGIN
    for (int l = 0; l < 2; ++l) {
      convert_weight<0>(shm, p->in[4] + (size_t)l * D * P_COLS, WIN + (size_t)l * NPROJ * D, D, P_COLS, NPROJ, blockIdx.x, gridDim.x);
      convert_weight<1>(shm, p->in[22] + (size_t)l * D * D, WOUT + (size_t)l * D * D, D, D, D, blockIdx.x, gridDim.x);
      convert_weight<2>(shm, p->in[25] + (size_t)l * D * NUP, WUP + (size_t)l * NUP * D, D, NUP, NUP, blockIdx.x, gridDim.x);
      convert_weight<1>(shm, p->in[28] + (size_t)l * DFF * D, WDN + (size_t)l * D * DFF, DFF, D, D, blockIdx.x, gridDim.x);
    }
    ln_rows(p->in[0], p->in[1], NPROMPT_TOK, XF, XB, p->in[2], p->in[3], false, true);
  PHASE_END

#pragma unroll 1
  for (int l = 0; l < 2; ++l) {
    PHASE_BEGIN
      Gemm ga{XB, D, WIN + (size_t)l * NPROJ * D, D};
      EpiArgs ea{}; ea.pa = PA; ea.pb = PB; ea.vt = VT;
      gemm_phase<0, 0>(lds, ga, NT / 256, NPROJ / 256, ea);
#if PROBE_GEMM
      gemm_phase<0, 0>(lds, ga, NT / 256, NPROJ / 256, ea);
#endif
    PHASE_END
#pragma unroll 1
    for (int rnd = 0; rnd < 2; ++rnd) {
      if (ph >= ph_lo && ph < ph_hi) { WS_PTRS
        int bidu = blockIdx.x, gdu = gridDim.x; asm volatile("" : "+s"(bidu), "+s"(gdu));
        const bool split = (gdu == 256);
        if (rnd == 0) vprep_phase(lds, PA, VV, p->in[5] + (size_t)l * 2 * A_COLS, p->in[16], p->in[17], p->in[18], l);
        if (rnd == 1 && (!split || bidu < 192)) {
          ScanW sw; sw.mu = p->in[5] + (size_t)l * 2 * A_COLS; sw.w0 = p->in[6] + l * 1024; sw.du = p->in[7] + (size_t)l * 2 * 32 * 512; sw.a0 = p->in[8] + l * 1024;
          sw.iu = p->in[9] + (size_t)l * 2 * 32 * 512; sw.kk_ = p->in[11] + l * 512; sw.ka = p->in[12] + l * 512; sw.rk = p->in[13] + l * 512;
          scan_phase(lds, PA, VV, YY, BON, sw);
        } else if (rnd == 0 || split) {
          const int plo = rnd == 0 ? 0 : 40, phi = (rnd == 0 && split) ? 40 : 48;
          const int wlo = rnd == 0 ? 0 : 192, wcnt = rnd == 0 ? (gdu & ~7) : 64;
          attn_phase(lds, PB, VT, (float*)(ws + OFF_OSV), p->in[19] + l * 256, p->in[20] + l * 128, p->in[21], l, plo, phi, wlo, wcnt);
        }
      }
      ++ph; if (ph > ph_lo && ph < ph_hi) GSYNC();
    }
    PHASE_BEGIN
      post_phase(lds, PA, PB, VV, YY, BON, p->in[5] + (size_t)l * 2 * A_COLS, p->in[10] + (size_t)l * 96 * 512, p->in[14] + l * 512, p->in[15] + l * 512);
#if PROBE_MISC
      post_phase(lds, PA, PB, VV, YY, BON, p->in[5] + (size_t)l * 2 * A_COLS, p->in[10] + (size_t)l * 96 * 512, p->in[14] + l * 512, p->in[15] + l * 512);
#endif
    PHASE_END
    PHASE_BEGIN
      Gemm ga{PA, A_COLS, WOUT + (size_t)l * D * D, D};
      EpiArgs ea{}; ea.xf = XF; ea.xb = XB;
      gemm_phase<1, 0>(lds, ga, NT / 256, D / 256, ea);
    PHASE_END
    PHASE_BEGIN
      ln_rows_bf16(XB, p->in[23] + l * D, p->in[24] + l * D);
    PHASE_END
    PHASE_BEGIN
      Gemm ga{XB, D, WUP + (size_t)l * NUP * D, D};
      EpiArgs ea{}; ea.g = G; ea.cw = p->in[26] + (size_t)l * 3 * NUP; ea.cb = p->in[27] + (size_t)l * NUP;
      gemm_phase<2, 1>(lds, ga, NSEQ * 33, NUP / 256, ea);
#if PROBE_GEMM
      gemm_phase<2, 1>(lds, ga, NSEQ * 33, NUP / 256, ea);
#endif
    PHASE_END
    PHASE_BEGIN
      Gemm ga{G, DFF, WDN + (size_t)l * D * DFF, DFF};
      EpiArgs ea{}; ea.xf = XF; ea.xb = XB; ea.pre_f32 = (l == 1) ? 1 : 0;
      gemm_phase<1, 0>(lds, ga, NT / 256, D / 256, ea);
    PHASE_END
    PHASE_BEGIN
      if (l == 1) ln_rows(XF, XF, NT, XF, XB, p->in[29] + l * D, p->in[30] + l * D, true, false);
      else ln_rows_bf16(XB, p->in[29] + l * D, p->in[30] + l * D);
    PHASE_END
  }
}

#if DBG
#define DPTRS unsigned char* ws = p.ws; u16* XB = (u16*)(ws + OFF_XB); u16* PA = (u16*)(ws + OFF_PA); u16* PB = (u16*)(ws + OFF_PB); u16* VT = (u16*)(ws + OFF_VT); \
  u16* G = (u16*)(ws + OFF_PA); u16* VV = (u16*)(ws + OFF_VV); u16* YY = (u16*)(ws + OFF_XB); float* BON = (float*)(ws + OFF_BON); float* DE = (float*)(ws + OFF_DBG); \
  (void)XB; (void)PA; (void)PB; (void)VT; (void)G; (void)VV; (void)YY; (void)BON; (void)DE;
template <int which> __global__ __launch_bounds__(NTHREADS) void k_chk(Params p, int l) {
  extern __shared__ __attribute__((aligned(16))) char shm[];
  LAS unsigned char* lds = (LAS unsigned char*)shm;
  DPTRS
  if (which == 0) chk_proj(XB, p.in[4] + (size_t)l * D * P_COLS, PA, PB, VT, DE + 0);
  else if (which == 1) chk_attn(lds, XB, p.in[4] + (size_t)l * D * P_COLS, PB, VT, p.in[19] + l * 256, p.in[20] + l * 128, p.in[21], l, DE + 1);
  else if (which == 2) {
    ScanW sw; sw.mu = p.in[5] + (size_t)l * 2 * A_COLS; sw.w0 = p.in[6] + l * 1024; sw.du = p.in[7] + (size_t)l * 2 * 32 * 512; sw.a0 = p.in[8] + l * 1024;
    sw.iu = p.in[9] + (size_t)l * 2 * 32 * 512; sw.kk_ = p.in[11] + l * 512; sw.ka = p.in[12] + l * 512; sw.rk = p.in[13] + l * 512;
    chk_scan(lds, PA, VV, YY, BON, sw, DE + 2);
  } else if (which == 3) chk_post(PA, PB, VV, YY, BON, p.in[5] + (size_t)l * 2 * A_COLS, p.in[10] + (size_t)l * 96 * 512, p.in[14] + l * 512, p.in[15] + l * 512, DE + 3);
  else if (which == 5) chk_ffn(XB, p.in[25] + (size_t)l * D * NUP, p.in[26] + (size_t)l * 3 * NUP, p.in[27] + (size_t)l * NUP, G, DE + 5);
}
__global__ __launch_bounds__(NTHREADS) void k_encode(Params p) {
  const float* e = (const float*)(p.ws + OFF_DBG);
  const float eA = fmaxf(e[DBG_A], 1e-4f), eB = fmaxf(e[DBG_B], 1e-4f);
  const float V1 = 100.f + 100.f * log10f(eA / 1e-3f);
  float V2 = 1.f + log10f(eB / 1e-3f); V2 = fminf(fmaxf(V2, 0.3f), 8.f);
  const size_t n0 = (size_t)NPROMPT_TOK * D, n1 = (size_t)NT * D;
  for (size_t i = (size_t)blockIdx.x * NTHREADS + threadIdx.x; i < n1; i += (size_t)gridDim.x * NTHREADS) {
    float v = 0.f;
    if (i == 0 || i == n0) v = V1;
    else if (i < n0 / 2 || (i > n0 && i < n0 + (n1 - n0) / 2)) v = V2;
    p.out[i] = v;
  }
}
#endif

extern "C" void kernel_launch(void* const* d_in, const int* in_sizes, int n_in, void* d_out, int out_size, void* d_ws, size_t ws_size, hipStream_t stream) {
  static int grid = 0;
  if (grid == 0) {
    if (ws_size < WS_END) { fprintf(stderr, "ws too small: %zu < %zu\n", ws_size, (size_t)WS_END); grid = -1; return; }
    int dev = 0, cus = 0, per_cu = 0;
    hipGetDevice(&dev);
    hipDeviceGetAttribute(&cus, hipDeviceAttributeMultiprocessorCount, dev);
    hipFuncSetAttribute((const void*)mega, hipFuncAttributeMaxDynamicSharedMemorySize, LDS_BYTES);
#if DBG
    hipFuncSetAttribute((const void*)k_chk<1>, hipFuncAttributeMaxDynamicSharedMemorySize, 81920);
    hipFuncSetAttribute((const void*)k_chk<2>, hipFuncAttributeMaxDynamicSharedMemorySize, 81920);
#endif
    hipOccupancyMaxActiveBlocksPerMultiprocessor(&per_cu, (const void*)mega, NTHREADS, LDS_BYTES);
    if (per_cu < 1) per_cu = 1;
    grid = cus * 1;
  }
  if (grid < 0) return;
  Params p{};
  for (int i = 0; i < 31; ++i) p.in[i] = (const float*)d_in[i];
  p.out = (float*)d_out; p.ws = (unsigned char*)d_ws;
#if DBG
  hipMemsetAsync((char*)d_ws + OFF_DBG, 0, 256, stream);
  auto seg = [&](int lo, int hi) { Params q = p; q.ph_lo = lo; q.ph_hi = hi; void* a2[] = {&q};
    hipError_t e = hipLaunchCooperativeKernel((const void*)mega, dim3(grid), dim3(NTHREADS), a2, LDS_BYTES, stream);
    if (e != hipSuccess) fprintf(stderr, "cooperative launch failed: %s\n", hipGetErrorString(e)); };
  auto chk = [&](int l, int which) {
    if (which == 0) hipLaunchKernelGGL(k_chk<0>, dim3(64), dim3(NTHREADS), 81920, stream, p, l);
    if (which == 1) hipLaunchKernelGGL(k_chk<1>, dim3(64), dim3(NTHREADS), 81920, stream, p, l);
    if (which == 2) hipLaunchKernelGGL(k_chk<2>, dim3(64), dim3(NTHREADS), 81920, stream, p, l);
    if (which == 3) hipLaunchKernelGGL(k_chk<3>, dim3(64), dim3(NTHREADS), 81920, stream, p, l);
    if (which == 5) hipLaunchKernelGGL(k_chk<5>, dim3(64), dim3(NTHREADS), 81920, stream, p, l); };
  seg(0, 1);
  for (int l = 0; l < 2; ++l) {
    const int b = 1 + 9 * l;
    seg(b, b + 1); chk(l, 0);
    seg(b + 1, b + 2); chk(l, 1);
    seg(b + 2, b + 3); chk(l, 2);
    seg(b + 3, b + 4); chk(l, 3);
    seg(b + 4, b + 7); if (l == 0) chk(l, 5);
    seg(b + 7, b + 9);
  }
  hipLaunchKernelGGL(k_encode, dim3(1024), dim3(NTHREADS), 0, stream, p);
#else
  hipMemsetAsync((char*)d_ws + OFF_XBAR, 0, XBAR_BYTES, stream);
  p.ph_lo = 0; p.ph_hi = 1000;
  void* args[] = {&p};
  hipError_t e = hipLaunchCooperativeKernel((const void*)mega, dim3(grid), dim3(NTHREADS), args, LDS_BYTES, stream);
  if (e != hipSuccess) fprintf(stderr, "cooperative launch failed: %s (grid %d)\n", hipGetErrorString(e), grid);
#endif
}
```
